# Optimizing an MI355X kernel written in HIP

```python
import jax
import jax.numpy as jnp
from jax import lax
import numpy as np

D_MODEL = 1024
BATCH = 32
SEQ = 2048
DEPTH = 2

HEAD_DIM = 64
N_HEADS = 4
GROUP_W = N_HEADS * HEAD_DIM
N_GROUPS = 4
D_MIX = N_GROUPS * GROUP_W
ROPE_THETA = 10000.0
ATT_BLOCK = 128
NEG = -1e30
LN_EPS = 1e-5
A_KV_HEADS = 2
A_WINDOW = 128
B_CONV = 4
B_CHUNK = 128
B_FBIAS_LO = 3.0
B_FBIAS_HI = 6.0
C_CHUNK = 64
C_EPS = 1e-6
CMP_LEN = 32
CMP_STRIDE = 16
SLC_LEN = 64
N_SEL = 8
NSA_WINDOW = 512
SLC_QBLOCK = 32
FORCE_SCORE = 1e6
DN_ALPHA = (2.0 * DEPTH) ** 0.25
DN_BETA = (8.0 * DEPTH) ** -0.25

SPLITS = (
    ('a_q', GROUP_W), ('a_k', A_KV_HEADS * HEAD_DIM), ('a_v', A_KV_HEADS * HEAD_DIM), ('a_z', GROUP_W),
    ('b_qk', 2 * GROUP_W), ('b_v', GROUP_W), ('b_if', 2 * N_HEADS), ('b_o', GROUP_W), ('b_z', GROUP_W),
    ('c_q', GROUP_W), ('c_f', GROUP_W), ('c_i', GROUP_W), ('c_z', GROUP_W),
    ('d_q', GROUP_W), ('d_kv', 6 * HEAD_DIM), ('d_g', 3 * N_HEADS), ('d_z', GROUP_W),
)
N_COLS = sum(size for _, size in SPLITS)

kernel_name = 'hybrid_swa_mlstm_hgrn2_nsa_deepnorm'


def _col_offset(name):
    off = 0
    for n, size in SPLITS:
        if n == name:
            return off
        off += size
    raise KeyError(name)


def split_cols(h):
    cols = {}
    off = 0
    for name, size in SPLITS:
        cols[name] = h[..., off:off + size]
        off += size
    return cols


def layer_norm(x, g, b):
    xf = x.astype(jnp.float32)
    mu = jnp.mean(xf, axis=-1, keepdims=True)
    var = jnp.mean(jnp.square(xf - mu), axis=-1, keepdims=True)
    y = (xf - mu) * lax.rsqrt(var + LN_EPS) * g.astype(jnp.float32) + b.astype(jnp.float32)
    return y.astype(x.dtype)


def rope(x, pos):
    half = x.shape[-1] // 2
    inv = ROPE_THETA ** (-jnp.arange(half, dtype=jnp.float32) / half)
    ang = pos.astype(jnp.float32)[:, None] * inv[None, :]
    cos = jnp.cos(ang)[None, :, None, :]
    sin = jnp.sin(ang)[None, :, None, :]
    xf = x.astype(jnp.float32)
    x1, x2 = xf[..., :half], xf[..., half:]
    return jnp.concatenate([x1 * cos - x2 * sin, x1 * sin + x2 * cos], axis=-1).astype(x.dtype)


def causal_conv(x, w, b):
    K, C = w.shape
    y = lax.conv_general_dilated(x, w[:, None, :].astype(x.dtype), window_strides=(1,), padding=[(K - 1, 0)],
                                 dimension_numbers=('NWC', 'WIO', 'NWC'), feature_group_count=C)
    return y + b.astype(x.dtype)


def banded_attention(q, k, v, window, sinks=None):
    B, T, H, d = q.shape
    G = k.shape[2]
    R = H // G
    nb = T // ATT_BLOCK
    pad = window
    span = pad + ATT_BLOCK
    kp = jnp.pad(k, ((0, 0), (pad, 0), (0, 0), (0, 0)))
    vp = jnp.pad(v, ((0, 0), (pad, 0), (0, 0), (0, 0)))
    qb = q.reshape(B, nb, ATT_BLOCK, G, R, d).transpose(1, 0, 2, 3, 4, 5)
    qi = jnp.arange(ATT_BLOCK)[:, None]
    kj = jnp.arange(span)[None, :] - pad
    rel = qi - kj
    band = (rel >= 0) & (rel < window)
    scale = d ** -0.5

    def block(args):
        n, qblk = args
        start = n * ATT_BLOCK
        kb = lax.dynamic_slice_in_dim(kp, start, span, axis=1)
        vb = lax.dynamic_slice_in_dim(vp, start, span, axis=1)
        s = jnp.einsum('bqgrd,bkgd->bgrqk', qblk, kb).astype(jnp.float32) * scale
        s = jnp.where(band & (kj + start >= 0), s, NEG)
        if sinks is None:
            p = jax.nn.softmax(s, axis=-1)
        else:
            sink = jnp.broadcast_to(sinks.astype(jnp.float32).reshape(1, G, R, 1, 1), s.shape[:-1] + (1,))
            p = jax.nn.softmax(jnp.concatenate([s, sink], axis=-1), axis=-1)[..., :span]
        return jnp.einsum('bgrqk,bkgd->bqgrd', p.astype(v.dtype), vb)

    out = lax.map(block, (jnp.arange(nb), qb))
    return out.transpose(1, 0, 2, 3, 4, 5).reshape(B, T, H, d)


def mlstm_chunkwise(q, k, v, i_pre, f_pre):
    B, T, H, d = q.shape
    L = B_CHUNK
    nc = T // L
    f32 = jnp.float32
    to_chunks = lambda t: t.astype(f32).reshape(B, nc, L, H, -1).transpose(1, 0, 3, 2, 4)
    qc = to_chunks(q) * d ** -0.5
    kc = to_chunks(k)
    vc = to_chunks(v)
    ic = to_chunks(i_pre[..., None])[..., 0]
    fc = jax.nn.log_sigmoid(to_chunks(f_pre[..., None])[..., 0])
    causal = jnp.tril(jnp.ones((L, L), bool))

    def step(carry, inp):
        C, n, m = carry
        q_, k_, v_, i_, lf = inp
        b = jnp.cumsum(lf, axis=-1)
        D = jnp.where(causal, b[..., :, None] - b[..., None, :] + i_[..., None, :], -jnp.inf)
        inter = b + m[..., None]
        m_t = jnp.maximum(jnp.max(D, axis=-1), inter)
        w_inter = jnp.exp(inter - m_t)
        S = jnp.einsum('bhtd,bhsd->bhts', q_, k_) * jnp.exp(D - m_t[..., None])
        num = jnp.einsum('bhts,bhsv->bhtv', S, v_) + w_inter[..., None] * jnp.einsum('bhtk,bhvk->bhtv', q_, C)
        den = jnp.sum(S, axis=-1) + w_inter * jnp.einsum('bhtk,bhk->bht', q_, n)
        h = num / jnp.maximum(jnp.abs(den), jnp.exp(-m_t))[..., None]
        b_last = b[..., -1]
        d_s = b_last[..., None] - b + i_
        m_new = jnp.maximum(b_last + m, jnp.max(d_s, axis=-1))
        w_s = jnp.exp(d_s - m_new[..., None])
        decay = jnp.exp(b_last + m - m_new)
        C_new = decay[..., None, None] * C + jnp.einsum('bhs,bhsv,bhsk->bhvk', w_s, v_, k_)
        n_new = decay[..., None] * n + jnp.einsum('bhs,bhsk->bhk', w_s, k_)
        return (C_new, n_new, m_new), h

    init = (jnp.zeros((B, H, d, d), f32), jnp.zeros((B, H, d), f32), jnp.zeros((B, H), f32))
    _, hs = lax.scan(step, init, (qc, kc, vc, ic, fc))
    return hs.transpose(1, 0, 3, 2, 4).reshape(B, T, H, d).astype(q.dtype)


def hgrn2_chunkwise(q, log_f, k, v):
    B, T, H, dk = q.shape
    dv = v.shape[-1]
    L = C_CHUNK
    nc = T // L
    f32 = jnp.float32
    to_chunks = lambda t: t.astype(f32).reshape(B, nc, L, H, -1).transpose(1, 0, 3, 2, 4)
    causal = jnp.tril(jnp.ones((L, L), bool))[..., None]

    def step(S, inp):
        q_, g_, k_, v_ = inp
        a = jnp.cumsum(g_, axis=2)
        decay = jnp.exp(jnp.where(causal, a[:, :, :, None, :] - a[:, :, None, :, :], -jnp.inf))
        A = jnp.einsum('bhtd,bhtsd,bhsd->bhts', q_, decay, k_)
        o = jnp.einsum('bhts,bhsv->bhtv', A, v_) + jnp.einsum('bhtk,bhkv->bhtv', q_ * jnp.exp(a), S)
        a_last = a[:, :, -1:, :]
        S_new = jnp.exp(a_last[:, :, 0, :])[..., None] * S + jnp.einsum('bhsk,bhsv->bhkv', k_ * jnp.exp(a_last - a), v_)
        return S_new, o

    _, os_ = lax.scan(step, jnp.zeros((B, H, dk, dv), f32), (to_chunks(q), to_chunks(log_f), to_chunks(k), to_chunks(v)))
    return os_.transpose(1, 0, 3, 2, 4).reshape(B, T, H, dv)


def nsa_attention(q, k_cmp_in, v_cmp_in, k_slc, v_slc, k_win, v_win, gates, cmp_pe, cmp_w1, cmp_w2):
    B, T, H, d = q.shape
    pos = jnp.arange(T)
    scale = d ** -0.5
    n_cmp = (T - CMP_LEN) // CMP_STRIDE + 1
    starts = jnp.arange(n_cmp) * CMP_STRIDE
    ends = starts + CMP_LEN - 1
    idx = starts[:, None] + jnp.arange(CMP_LEN)[None, :]

    def compress(t, pe, w1, w2):
        blk = (t[:, idx] + pe).reshape(B, n_cmp, CMP_LEN * d)
        return jax.nn.silu(blk @ w1) @ w2

    k_cmp = rope(compress(k_cmp_in, cmp_pe[0], cmp_w1[0], cmp_w2[0])[:, :, None, :], ends)[:, :, 0, :]
    v_cmp = compress(v_cmp_in, cmp_pe[1], cmp_w1[1], cmp_w2[1])
    cmp_valid = ends[None, :] <= pos[:, None]
    s = jnp.einsum('bthd,bnd->bhtn', q, k_cmp).astype(jnp.float32) * scale
    p_cmp = jnp.where(cmp_valid, jax.nn.softmax(jnp.where(cmp_valid, s, NEG), axis=-1), 0.0)
    o_cmp = jnp.einsum('bhtn,bnd->bthd', p_cmp.astype(v_cmp.dtype), v_cmp)
    n_slc = T // SLC_LEN
    blk_id = jnp.arange(n_slc)
    overlap = ((starts[:, None] < (blk_id[None, :] + 1) * SLC_LEN)
               & (starts[:, None] + CMP_LEN > blk_id[None, :] * SLC_LEN)).astype(jnp.float32)
    imp = jnp.einsum('bhtn,nj->btj', p_cmp, overlap)
    cur = (pos // SLC_LEN)[:, None]
    forced = (blk_id[None, :] == 0) | (blk_id[None, :] == cur) | (blk_id[None, :] == cur - 1)
    imp = jnp.where(forced, FORCE_SCORE, imp)
    imp = jnp.where(blk_id[None, :] <= cur, imp, NEG)
    k_sel = min(N_SEL, n_slc)
    _, sel = lax.top_k(imp, k_sel)
    k_blocks = k_slc.reshape(B, n_slc, SLC_LEN, d)
    v_blocks = v_slc.reshape(B, n_slc, SLC_LEN, d)
    nq = T // SLC_QBLOCK
    q_ch = q.reshape(B, nq, SLC_QBLOCK, H, d).transpose(1, 0, 2, 3, 4)
    sel_ch = sel.reshape(B, nq, SLC_QBLOCK, k_sel).transpose(1, 0, 2, 3)
    offs = jnp.arange(SLC_LEN)

    def sel_block(args):
        t0, qc, ic = args
        kg = jax.vmap(lambda kb_, i_: kb_[i_])(k_blocks, ic).reshape(B, SLC_QBLOCK, k_sel * SLC_LEN, d)
        vg = jax.vmap(lambda vb_, i_: vb_[i_])(v_blocks, ic).reshape(B, SLC_QBLOCK, k_sel * SLC_LEN, d)
        tok = (ic[..., None] * SLC_LEN + offs).reshape(B, SLC_QBLOCK, k_sel * SLC_LEN)
        valid = tok <= (t0 + jnp.arange(SLC_QBLOCK))[None, :, None]
        s_ = jnp.einsum('bqhd,bqkd->bhqk', qc, kg).astype(jnp.float32) * scale
        p_ = jax.nn.softmax(jnp.where(valid[:, None], s_, NEG), axis=-1)
        return jnp.einsum('bhqk,bqkd->bqhd', p_.astype(vg.dtype), vg)

    o_slc = lax.map(sel_block, (jnp.arange(nq) * SLC_QBLOCK, q_ch, sel_ch))
    o_slc = o_slc.transpose(1, 0, 2, 3, 4).reshape(B, T, H, d)
    o_win = banded_attention(q, k_win[:, :, None, :], v_win[:, :, None, :], NSA_WINDOW)
    g = jax.nn.sigmoid(gates.astype(jnp.float32)).astype(q.dtype)
    return g[..., 0:1] * o_cmp + g[..., 1:2] * o_slc + g[..., 2:3] * o_win


def hybrid_mixer(x, w_in, b_in, a_sinks, b_conv_w, b_conv_b, lb, c_norm_g, d_cmp_pe, d_cmp_w1, d_cmp_w2, w_out):
    B, T, _ = x.shape
    pos = jnp.arange(T)
    f32 = jnp.float32
    silu = jax.nn.silu
    cols = split_cols(jnp.einsum('btd,dn->btn', x, w_in) + b_in)
    heads = lambda t: t.reshape(B, T, -1, HEAD_DIM)
    flat = lambda t: t.reshape(B, T, GROUP_W)
    q_a = rope(heads(cols['a_q']), pos)
    k_a = rope(heads(cols['a_k']), pos)
    y_a = flat(banded_attention(q_a, k_a, heads(cols['a_v']), A_WINDOW, a_sinks)) * silu(cols['a_z'])
    qk_b = silu(causal_conv(cols['b_qk'], b_conv_w, b_conv_b))
    h_b = mlstm_chunkwise(heads(qk_b[..., :GROUP_W]), heads(qk_b[..., GROUP_W:]), heads(cols['b_v']),
                          cols['b_if'][..., :N_HEADS], cols['b_if'][..., N_HEADS:])
    y_b = jax.nn.sigmoid(cols['b_o']) * flat(h_b) * silu(cols['b_z'])
    f_c = lb + (1.0 - lb) * jax.nn.sigmoid(cols['c_f'].astype(f32))
    o_c = hgrn2_chunkwise(heads(silu(cols['c_q'])), heads(jnp.log(f_c)), heads(1.0 - f_c), heads(cols['c_i']))
    o_c = o_c * lax.rsqrt(jnp.mean(jnp.square(o_c), axis=-1, keepdims=True) + C_EPS) * c_norm_g.astype(f32).reshape(N_HEADS, HEAD_DIM)
    y_c = flat(o_c).astype(x.dtype) * silu(cols['c_z'])
    q_d = rope(heads(cols['d_q']), pos)
    kv = cols['d_kv'].reshape(B, T, 6, HEAD_DIM)
    k_s = rope(kv[:, :, 2:3], pos)[:, :, 0]
    k_w = rope(kv[:, :, 4:5], pos)[:, :, 0]
    o_d = nsa_attention(q_d, kv[:, :, 0], kv[:, :, 1], k_s, kv[:, :, 3], k_w, kv[:, :, 5],
                        cols['d_g'].reshape(B, T, N_HEADS, 3), d_cmp_pe, d_cmp_w1, d_cmp_w2)
    y_d = flat(o_d) * silu(cols['d_z'])
    y = jnp.concatenate([y_a, y_b, y_c, y_d], axis=-1)
    return jnp.einsum('btm,md->btd', y, w_out)


def setup_inputs(seed: int = 0) -> dict:
    key = jax.random.key(seed)
    ks = jax.random.split(key, 17)
    f32 = jnp.float32
    nrm = lambda k, shape, s: s * jax.random.normal(k, shape, f32)
    x = jax.random.normal(ks[0], (BATCH, SEQ, D_MODEL), f32)
    ln0_g = 1.0 + nrm(ks[1], (D_MODEL,), 0.02)
    ln0_b = nrm(ks[2], (D_MODEL,), 0.02)
    w_in = nrm(ks[3], (DEPTH, D_MODEL, N_COLS), D_MODEL ** -0.5)
    off_f = _col_offset('b_if') + N_HEADS
    b_in = nrm(ks[4], (DEPTH, N_COLS), 0.02)
    b_in = b_in.at[:, off_f:off_f + N_HEADS].add(jnp.linspace(B_FBIAS_LO, B_FBIAS_HI, N_HEADS, dtype=f32))
    a_sinks = nrm(ks[5], (DEPTH, N_HEADS), 0.5)
    b_conv_w = nrm(ks[6], (DEPTH, B_CONV, 2 * GROUP_W), B_CONV ** -0.5)
    b_conv_b = nrm(ks[7], (DEPTH, 2 * GROUP_W), 0.02)
    c_lb = nrm(ks[8], (DEPTH, GROUP_W), 0.5)
    c_norm_g = 1.0 + nrm(ks[9], (DEPTH, GROUP_W), 0.02)
    d_cmp_pe = nrm(ks[10], (DEPTH, 2, CMP_LEN, HEAD_DIM), 0.02)
    d_cmp_w1 = nrm(ks[11], (DEPTH, 2, CMP_LEN * HEAD_DIM, HEAD_DIM), (CMP_LEN * HEAD_DIM) ** -0.5)
    d_cmp_w2 = nrm(ks[12], (DEPTH, 2, HEAD_DIM, HEAD_DIM), HEAD_DIM ** -0.5)
    w_out = nrm(ks[13], (DEPTH, D_MIX, D_MODEL), DN_BETA * D_MIX ** -0.5)
    ln_g = 1.0 + nrm(ks[14], (DEPTH, D_MODEL), 0.02)
    ln_b = nrm(ks[15], (DEPTH, D_MODEL), 0.02)
    return {'x': x, 'ln0_g': ln0_g, 'ln0_b': ln0_b, 'w_in': w_in, 'b_in': b_in, 'a_sinks': a_sinks,
            'b_conv_w': b_conv_w, 'b_conv_b': b_conv_b, 'c_lb': c_lb, 'c_norm_g': c_norm_g,
            'd_cmp_pe': d_cmp_pe, 'd_cmp_w1': d_cmp_w1, 'd_cmp_w2': d_cmp_w2, 'w_out': w_out,
            'ln_g': ln_g, 'ln_b': ln_b}


def reference(x, ln0_g, ln0_b, w_in, b_in, a_sinks, b_conv_w, b_conv_b, c_lb, c_norm_g, d_cmp_pe, d_cmp_w1, d_cmp_w2, w_out, ln_g, ln_b):
    lb = jnp.cumsum(jax.nn.softmax(c_lb.astype(jnp.float32), axis=0), axis=0)
    lb = lb - lb[0]
    h = layer_norm(x, ln0_g, ln0_b)
    for l in range(DEPTH):
        y = hybrid_mixer(h, w_in[l], b_in[l], a_sinks[l], b_conv_w[l], b_conv_b[l], lb[l], c_norm_g[l],
                         d_cmp_pe[l], d_cmp_w1[l], d_cmp_w2[l], w_out[l])
        h = layer_norm(DN_ALPHA * h + y, ln_g[l], ln_b[l])
    return h
```

```cpp
#include <hip/hip_runtime.h>
#include <stdint.h>
#include <stddef.h>

#define DI __device__ __forceinline__
typedef unsigned short bf16_t;
typedef short bf16x8 __attribute__((ext_vector_type(8)));
typedef float f32x16 __attribute__((ext_vector_type(16)));
typedef unsigned u32x4 __attribute__((ext_vector_type(4)));

constexpr int NB = 32, T = 2048, DM = 1024, NTOK = NB * T, NP = 4096;
constexpr float DN_ALPHA = 1.41421356237309515f;

struct Params {
  const float *x, *ln0_g, *ln0_b, *w_in, *b_in, *a_sinks, *conv_w, *conv_b, *c_lb, *c_norm_g, *pe, *w1, *w2, *w_out, *ln_g, *ln_b;
  float* hf;
  bf16_t *HB, *YMIX, *QA, *KA, *VAT, *QKB, *VBT, *QC, *VCT, *QD, *KV, *GZ, *WT, *WOT, *KCMP, *VCMPT;
  float *GC, *IFG, *DG, *BIASP, *LB, *ROPEC, *ROPES;
};

DI float bf2f(bf16_t v) { return __uint_as_float(((unsigned)v) << 16); }
DI bf16_t f2bf(float x) { unsigned u = __float_as_uint(x); u += 0x7fffu + ((u >> 16) & 1u); return (bf16_t)(u >> 16); }
DI float sigmoidf_(float x) { return 1.f / (1.f + __expf(-x)); }
DI float siluf_(float x) { return x / (1.f + __expf(-x)); }
DI float wave_sum(float v) { for (int o = 32; o > 0; o >>= 1) v += __shfl_xor(v, o); return v; }
DI float wave_max(float v) { for (int o = 32; o > 0; o >>= 1) v = fmaxf(v, __shfl_xor(v, o)); return v; }

DI int orig_col(int n) {
  if (n < 1536) return n;
  if (n < 3712) return n + 8;
  if (n < 3968) return n + 20;
  if (n < 3976) return 1536 + (n - 3968);
  if (n < 3988) return 3720 + (n - 3976);
  return -1;
}

__global__ void __launch_bounds__(256) k_prologue(Params p) {
  const long gtid = (long)blockIdx.x * blockDim.x + threadIdx.x, gsz = (long)gridDim.x * blockDim.x;
  for (long idx = gtid; idx < 2L * 128 * NP; idx += gsz) {
    const int n = (int)(idx % NP), k8 = (int)((idx / NP) % 128), l = (int)(idx / (NP * 128));
    const int oc = orig_col(n);
    unsigned w[4];
    for (int j = 0; j < 4; ++j) {
      float a = 0.f, b = 0.f;
      if (oc >= 0) { a = p.w_in[((size_t)l * 1024 + k8 * 8 + 2 * j) * 3988 + oc]; b = p.w_in[((size_t)l * 1024 + k8 * 8 + 2 * j + 1) * 3988 + oc]; }
      w[j] = (unsigned)f2bf(a) | ((unsigned)f2bf(b) << 16);
    }
    *(uint4*)(p.WT + ((size_t)l * NP + n) * 1024 + k8 * 8) = make_uint4(w[0], w[1], w[2], w[3]);
  }
  for (long idx = gtid; idx < 2L * 128 * 1024; idx += gsz) {
    const int d = (int)(idx % 1024), m8 = (int)((idx / 1024) % 128), l = (int)(idx / (1024 * 128));
    unsigned w[4];
    for (int j = 0; j < 4; ++j) {
      float a = p.w_out[((size_t)l * 1024 + m8 * 8 + 2 * j) * 1024 + d], b = p.w_out[((size_t)l * 1024 + m8 * 8 + 2 * j + 1) * 1024 + d];
      w[j] = (unsigned)f2bf(a) | ((unsigned)f2bf(b) << 16);
    }
    *(uint4*)(p.WOT + ((size_t)l * 1024 + d) * 1024 + m8 * 8) = make_uint4(w[0], w[1], w[2], w[3]);
  }
  for (long idx = gtid; idx < 2L * NP; idx += gsz) {
    const int n = (int)(idx % NP), l = (int)(idx / NP); const int oc = orig_col(n);
    p.BIASP[idx] = oc >= 0 ? p.b_in[l * 3988 + oc] : 0.f;
  }
  for (long idx = gtid; idx < (long)T * 32; idx += gsz) {
    const int t = (int)(idx / 32), i = (int)(idx % 32);
    const float inv = powf(10000.0f, -(float)i / 32.0f);
    const float ang = (float)t * inv;
    p.ROPEC[idx] = cosf(ang); p.ROPES[idx] = sinf(ang);
  }
  for (long idx = gtid; idx < 512; idx += gsz) {
    const int c = (int)(idx % 256), l = (int)(idx / 256);
    const float a = p.c_lb[c], b = p.c_lb[256 + c];
    const float m = fmaxf(a, b); const float ea = expf(a - m), eb = expf(b - m);
    p.LB[idx] = l == 0 ? 0.f : eb / (ea + eb);
  }
}

DI void ln_rows(const Params& p, int mode, int layer, int bid, int nblk) {
  const int lane = threadIdx.x & 63, wid = threadIdx.x >> 6, nw = blockDim.x >> 6;
  const float* g = mode == 0 ? p.ln0_g : p.ln_g + layer * 1024;
  const float* bb = mode == 0 ? p.ln0_b : p.ln_b + layer * 1024;
  const float* src = mode == 0 ? p.x : p.hf;
  for (int row = bid * nw + wid; row < NTOK; row += nblk * nw) {
    const float* s = src + (size_t)row * 1024;
    float4 v[4];
    float sum = 0.f;
#pragma unroll
    for (int i = 0; i < 4; ++i) { v[i] = *(const float4*)(s + i * 256 + lane * 4); sum += (v[i].x + v[i].y) + (v[i].z + v[i].w); }
    sum = wave_sum(sum);
    const float mu = sum * (1.f / 1024.f);
    float q = 0.f;
#pragma unroll
    for (int i = 0; i < 4; ++i) { float a = v[i].x - mu, b = v[i].y - mu, c = v[i].z - mu, d = v[i].w - mu; q += (a * a + b * b) + (c * c + d * d); }
    q = wave_sum(q);
    const float rs = rsqrtf(q * (1.f / 1024.f) + 1e-5f);
#pragma unroll
    for (int i = 0; i < 4; ++i) {
      const int c0 = i * 256 + lane * 4;
      const float4 gg = *(const float4*)(g + c0), b4 = *(const float4*)(bb + c0);
      float4 o;
      o.x = (v[i].x - mu) * rs * gg.x + b4.x; o.y = (v[i].y - mu) * rs * gg.y + b4.y;
      o.z = (v[i].z - mu) * rs * gg.z + b4.z; o.w = (v[i].w - mu) * rs * gg.w + b4.w;
      *(float4*)(p.hf + (size_t)row * 1024 + c0) = o;
      uint2 pk; pk.x = (unsigned)f2bf(o.x) | ((unsigned)f2bf(o.y) << 16); pk.y = (unsigned)f2bf(o.z) | ((unsigned)f2bf(o.w) << 16);
      *(uint2*)(p.HB + (size_t)row * 1024 + c0) = pk;
    }
  }
}
__global__ void __launch_bounds__(256) k_ln(Params p, int mode, int layer) { ln_rows(p, mode, layer, blockIdx.x, gridDim.x); }

enum { K_NONE = 0, K_ROPE, K_PLAIN, K_TR, K_GSILU, K_GSIG, K_SILUH, K_LOGF, K_SMALL };

template <int KIND>
DI void epi_inproj(const Params& p, const f32x16 (&acc)[2][2], bf16_t* dst, float* fdst, float scale, float bias0, float bias1, float lb0, float lb1,
                   int b, int t0, int l31, int h2) {
#pragma unroll
  for (int mt = 0; mt < 2; ++mt) {
#pragma unroll
    for (int r = 0; r < 16; ++r) {
      const int t = t0 + mt * 32 + (r & 3) + 8 * (r >> 2) + 4 * h2;
      const size_t tok = (size_t)b * T + t;
      const float v0 = acc[mt][0][r] + bias0, v1 = acc[mt][1][r] + bias1;
      if (KIND == K_ROPE) {
        const float c = p.ROPEC[t * 32 + l31], s = p.ROPES[t * 32 + l31];
        const float o0 = (v0 * c - v1 * s) * scale, o1 = (v0 * s + v1 * c) * scale;
        dst[(size_t)t * 64 + l31] = f2bf(o0); dst[(size_t)t * 64 + 32 + l31] = f2bf(o1);
      } else if (KIND == K_PLAIN) {
        dst[(size_t)t * 64 + l31] = f2bf(v0); dst[(size_t)t * 64 + 32 + l31] = f2bf(v1);
      } else if (KIND == K_SILUH) {
        dst[(size_t)t * 64 + l31] = f2bf(siluf_(v0)); dst[(size_t)t * 64 + 32 + l31] = f2bf(siluf_(v1));
      } else if (KIND == K_TR) {
        dst[(size_t)l31 * T + t] = f2bf(v0); dst[(size_t)(l31 + 32) * T + t] = f2bf(v1);
      } else if (KIND == K_GSILU) {
        dst[tok * 256 + l31] = f2bf(siluf_(v0)); dst[tok * 256 + 32 + l31] = f2bf(siluf_(v1));
      } else if (KIND == K_GSIG) {
        dst[tok * 256 + l31] = f2bf(sigmoidf_(v0)); dst[tok * 256 + 32 + l31] = f2bf(sigmoidf_(v1));
      } else if (KIND == K_LOGF) {
        const float f0 = lb0 + (1.f - lb0) * sigmoidf_(v0), f1 = lb1 + (1.f - lb1) * sigmoidf_(v1);
        fdst[(size_t)t * 64 + l31] = logf(f0); fdst[(size_t)t * 64 + 32 + l31] = logf(f1);
      } else if (KIND == K_SMALL) {
        if (l31 < 8) p.IFG[tok * 8 + l31] = v0;
        else if (l31 < 20) p.DG[tok * 12 + (l31 - 8)] = sigmoidf_(v0);
      }
    }
  }
}

template <int MODE>
DI void gemm_tile(const Params& p, int layer, int pm, int pn, char* smem) {
  const int tid = threadIdx.x, lane = tid & 63, wid = tid >> 6, wm = wid >> 1, wn = wid & 1;
  const int l31 = lane & 31, h2 = lane >> 5;
  const bf16_t* A = (MODE == 0 ? p.HB : p.YMIX) + (size_t)pm * 128 * 1024;
  const bf16_t* Bt = (MODE == 0 ? p.WT + (size_t)layer * NP * 1024 : p.WOT + (size_t)layer * 1024 * 1024) + (size_t)pn * 128 * 1024;
  bf16_t* sA = (bf16_t*)smem;
  bf16_t* sB = sA + 128 * 72;
  f32x16 acc[2][2];
#pragma unroll
  for (int i = 0; i < 2; ++i)
#pragma unroll
    for (int j = 0; j < 2; ++j)
#pragma unroll
      for (int r = 0; r < 16; ++r) acc[i][j][r] = 0.f;
  const int lr = tid >> 3, lc = (tid & 7) * 8;
  u32x4 ra[4], rb[4];
#pragma unroll
  for (int i = 0; i < 4; ++i) { ra[i] = *(const u32x4*)(A + (size_t)(lr + 32 * i) * 1024 + lc); rb[i] = *(const u32x4*)(Bt + (size_t)(lr + 32 * i) * 1024 + lc); }
  for (int kt = 0; kt < 16; ++kt) {
    __syncthreads();
#pragma unroll
    for (int i = 0; i < 4; ++i) { *(u32x4*)(sA + (lr + 32 * i) * 72 + lc) = ra[i]; *(u32x4*)(sB + (lr + 32 * i) * 72 + lc) = rb[i]; }
    __syncthreads();
    if (kt + 1 < 16) {
#pragma unroll
      for (int i = 0; i < 4; ++i) { ra[i] = *(const u32x4*)(A + (size_t)(lr + 32 * i) * 1024 + (kt + 1) * 64 + lc); rb[i] = *(const u32x4*)(Bt + (size_t)(lr + 32 * i) * 1024 + (kt + 1) * 64 + lc); }
    }
#pragma unroll
    for (int ks = 0; ks < 4; ++ks) {
      bf16x8 af[2], bfr[2];
#pragma unroll
      for (int mt = 0; mt < 2; ++mt) af[mt] = *(const bf16x8*)(sA + (wm * 64 + mt * 32 + l31) * 72 + ks * 16 + h2 * 8);
#pragma unroll
      for (int nt = 0; nt < 2; ++nt) bfr[nt] = *(const bf16x8*)(sB + (wn * 64 + nt * 32 + l31) * 72 + ks * 16 + h2 * 8);
#pragma unroll
      for (int mt = 0; mt < 2; ++mt)
#pragma unroll
        for (int nt = 0; nt < 2; ++nt) acc[mt][nt] = __builtin_amdgcn_mfma_f32_32x32x16_bf16(af[mt], bfr[nt], acc[mt][nt], 0, 0, 0);
    }
  }
  if (MODE == 1) {
#pragma unroll
    for (int mt = 0; mt < 2; ++mt)
#pragma unroll
      for (int nt = 0; nt < 2; ++nt)
#pragma unroll
        for (int r = 0; r < 16; ++r) {
          const int row = pm * 128 + wm * 64 + mt * 32 + (r & 3) + 8 * (r >> 2) + 4 * h2;
          const int col = pn * 128 + wn * 64 + nt * 32 + l31;
          float* dst = p.hf + (size_t)row * 1024 + col;
          *dst = DN_ALPHA * (*dst) + acc[mt][nt][r];
        }
    return;
  }
  const int hd = pn * 2 + wn;
  const int b = pm >> 4, t0 = (pm & 15) * 128 + wm * 64;
  int kind = K_NONE; bf16_t* dst = nullptr; float scale = 1.f; float* fdst = nullptr;
  if (hd < 4) { kind = K_ROPE; dst = p.QA + ((size_t)(b * 4 + hd) * T) * 64; scale = 0.125f; }
  else if (hd < 6) { kind = K_ROPE; dst = p.KA + ((size_t)(b * 2 + hd - 4) * T) * 64; }
  else if (hd < 8) { kind = K_TR; dst = p.VAT + (size_t)(b * 2 + hd - 6) * 64 * T; }
  else if (hd < 12) { kind = K_GSILU; dst = p.GZ + (size_t)0 * NTOK * 256 + (hd - 8) * 64; }
  else if (hd < 20) { kind = K_PLAIN; dst = p.QKB + ((size_t)(b * 8 + hd - 12) * T) * 64; }
  else if (hd < 24) { kind = K_TR; dst = p.VBT + (size_t)(b * 4 + hd - 20) * 64 * T; }
  else if (hd < 28) { kind = K_GSIG; dst = p.GZ + (size_t)1 * NTOK * 256 + (hd - 24) * 64; }
  else if (hd < 32) { kind = K_GSILU; dst = p.GZ + (size_t)2 * NTOK * 256 + (hd - 28) * 64; }
  else if (hd < 36) { kind = K_SILUH; dst = p.QC + ((size_t)(b * 4 + hd - 32) * T) * 64; }
  else if (hd < 40) { kind = K_LOGF; fdst = p.GC + ((size_t)(b * 4 + hd - 36) * T) * 64; }
  else if (hd < 44) { kind = K_TR; dst = p.VCT + (size_t)(b * 4 + hd - 40) * 64 * T; }
  else if (hd < 48) { kind = K_GSILU; dst = p.GZ + (size_t)3 * NTOK * 256 + (hd - 44) * 64; }
  else if (hd < 52) { kind = K_ROPE; dst = p.QD + ((size_t)(b * 4 + hd - 48) * T) * 64; scale = 0.125f; }
  else if (hd < 58) {
    const int j = hd - 52;
    dst = p.KV + (size_t)(j * NB + b) * T * 64;
    kind = (j == 0 || j == 1) ? K_PLAIN : ((j == 2 || j == 4) ? K_ROPE : K_TR);
  }
  else if (hd < 62) { kind = K_GSILU; dst = p.GZ + (size_t)4 * NTOK * 256 + (hd - 58) * 64; }
  else if (hd == 62) { kind = K_SMALL; }
  if (kind == K_NONE) return;
  const float bias0 = p.BIASP[layer * NP + hd * 64 + l31], bias1 = p.BIASP[layer * NP + hd * 64 + 32 + l31];
  float lb0 = 0.f, lb1 = 0.f;
  if (kind == K_LOGF) { lb0 = p.LB[layer * 256 + (hd - 36) * 64 + l31]; lb1 = p.LB[layer * 256 + (hd - 36) * 64 + 32 + l31]; }
  switch (kind) {
    case K_ROPE: epi_inproj<K_ROPE>(p, acc, dst, fdst, scale, bias0, bias1, lb0, lb1, b, t0, l31, h2); break;
    case K_PLAIN: epi_inproj<K_PLAIN>(p, acc, dst, fdst, scale, bias0, bias1, lb0, lb1, b, t0, l31, h2); break;
    case K_TR: epi_inproj<K_TR>(p, acc, dst, fdst, scale, bias0, bias1, lb0, lb1, b, t0, l31, h2); break;
    case K_GSILU: epi_inproj<K_GSILU>(p, acc, dst, fdst, scale, bias0, bias1, lb0, lb1, b, t0, l31, h2); break;
    case K_GSIG: epi_inproj<K_GSIG>(p, acc, dst, fdst, scale, bias0, bias1, lb0, lb1, b, t0, l31, h2); break;
    case K_SILUH: epi_inproj<K_SILUH>(p, acc, dst, fdst, scale, bias0, bias1, lb0, lb1, b, t0, l31, h2); break;
    case K_LOGF: epi_inproj<K_LOGF>(p, acc, dst, fdst, scale, bias0, bias1, lb0, lb1, b, t0, l31, h2); break;
    case K_SMALL: epi_inproj<K_SMALL>(p, acc, dst, fdst, scale, bias0, bias1, lb0, lb1, b, t0, l31, h2); break;
    default: break;
  }
}

template <int MODE>
__global__ void __launch_bounds__(256) k_gemm(Params p, int layer) {
  __shared__ __attribute__((aligned(16))) char smem[2 * 128 * 72 * 2];
  const int ntn = MODE == 0 ? 32 : 8;
  const int ntiles = 512 * ntn;
  for (int tile = blockIdx.x; tile < ntiles; tile += gridDim.x) gemm_tile<MODE>(p, layer, tile / ntn, tile % ntn, smem);
}

__global__ void __launch_bounds__(256) k_naiveA(Params p, int layer) {
  __shared__ float ps[4][128];
  const int lane = threadIdx.x & 63, h = threadIdx.x >> 6;
  for (int tok = blockIdx.x; tok < NTOK; tok += gridDim.x) {
    const int b = tok / T, t = tok % T, g = h >> 1;
    const bf16_t* q = p.QA + ((size_t)(b * 4 + h) * T + t) * 64;
    const bf16_t* K = p.KA + (size_t)(b * 2 + g) * T * 64;
    const bf16_t* VT = p.VAT + (size_t)(b * 2 + g) * 64 * T;
    float sc[2];
    for (int i = 0; i < 2; ++i) {
      const int s = t - 127 + lane + 64 * i;
      float d = -INFINITY;
      if (s >= 0) { d = 0.f; for (int e = 0; e < 64; ++e) d += bf2f(q[e]) * bf2f(K[(size_t)s * 64 + e]); }
      sc[i] = d;
    }
    const float sink = p.a_sinks[layer * 4 + h];
    float m = fmaxf(wave_max(fmaxf(sc[0], sc[1])), sink);
    const float e0 = __expf(sc[0] - m), e1 = __expf(sc[1] - m);
    const float l = wave_sum(e0 + e1) + __expf(sink - m);
    __syncthreads();
    ps[h][lane] = e0; ps[h][lane + 64] = e1;
    __syncthreads();
    float o = 0.f;
    for (int j = 0; j < 128; ++j) { const int s = t - 127 + j; if (s >= 0) o += ps[h][j] * bf2f(VT[(size_t)lane * T + s]); }
    o /= l;
    const float gz = bf2f(p.GZ[(size_t)0 * NTOK * 256 + (size_t)tok * 256 + h * 64 + lane]);
    p.YMIX[(size_t)tok * 1024 + h * 64 + lane] = f2bf(o * gz);
  }
}

__global__ void __launch_bounds__(256) k_naiveB(Params p, int layer) {
  __shared__ float qs[32 * 64], ks[32 * 64], vs[32 * 64], ig[32], fg[32];
  const int tid = threadIdx.x, v = tid >> 2, kq = tid & 3;
  for (int item = blockIdx.x; item < NB * 4; item += gridDim.x) {
    const int b = item >> 2, hh = item & 3;
    float C[16], n[16];
    for (int i = 0; i < 16; ++i) { C[i] = 0.f; n[i] = 0.f; }
    const bf16_t* rawq = p.QKB + ((size_t)(b * 8 + hh) * T) * 64;
    const bf16_t* rawk = p.QKB + ((size_t)(b * 8 + 4 + hh) * T) * 64;
    const float* cw = p.conv_w + layer * 4 * 512; const float* cb = p.conv_b + layer * 512;
    for (int t0 = 0; t0 < T; t0 += 32) {
      __syncthreads();
      for (int e = tid; e < 2 * 32 * 64; e += 256) {
        const int which = e / 2048, tt = (e % 2048) / 64, d = e % 64, t = t0 + tt;
        const bf16_t* raw = which ? rawk : rawq; const int ch = (which ? 256 : 0) + hh * 64 + d;
        float a = cb[ch];
        for (int j = 0; j < 4; ++j) { const int ts = t - 3 + j; if (ts >= 0) a += cw[j * 512 + ch] * bf2f(raw[(size_t)ts * 64 + d]); }
        float sv = siluf_(a); if (!which) sv *= 0.125f;
        (which ? ks : qs)[tt * 64 + d] = sv;
      }
      for (int e = tid; e < 32 * 64; e += 256) { const int tt = e / 64, d = e % 64; vs[tt * 64 + d] = bf2f(p.VBT[((size_t)(b * 4 + hh) * 64 + d) * T + t0 + tt]); }
      if (tid < 32) { const size_t tok = (size_t)b * T + t0 + tid; ig[tid] = p.IFG[tok * 8 + hh]; fg[tid] = sigmoidf_(p.IFG[tok * 8 + 4 + hh]); }
      __syncthreads();
      for (int tt = 0; tt < 32; ++tt) {
        const float f = fg[tt], iw = __expf(ig[tt]); const float vv = vs[tt * 64 + v] * iw;
        float num = 0.f, den = 0.f;
#pragma unroll
        for (int kk = 0; kk < 16; ++kk) {
          const float kv = ks[tt * 64 + kq * 16 + kk], qv = qs[tt * 64 + kq * 16 + kk];
          C[kk] = f * C[kk] + vv * kv; n[kk] = f * n[kk] + iw * kv; num += C[kk] * qv; den += n[kk] * qv;
        }
        num += __shfl_xor(num, 1); num += __shfl_xor(num, 2); den += __shfl_xor(den, 1); den += __shfl_xor(den, 2);
        const float hval = num / fmaxf(fabsf(den), 1.f);
        if (kq == 0) {
          const size_t tok = (size_t)b * T + t0 + tt; const int col = hh * 64 + v;
          const float y = bf2f(p.GZ[(size_t)1 * NTOK * 256 + tok * 256 + col]) * hval * bf2f(p.GZ[(size_t)2 * NTOK * 256 + tok * 256 + col]);
          p.YMIX[tok * 1024 + 256 + col] = f2bf(y);
        }
      }
    }
  }
}

__global__ void __launch_bounds__(256) k_naiveC(Params p, int layer) {
  __shared__ float qs[32 * 64], fs[32 * 64], vs[32 * 64], os[32 * 64];
  const int tid = threadIdx.x, v = tid >> 2, kq = tid & 3;
  for (int item = blockIdx.x; item < NB * 4; item += gridDim.x) {
    const int b = item >> 2, hh = item & 3;
    float S[16];
    for (int i = 0; i < 16; ++i) S[i] = 0.f;
    for (int t0 = 0; t0 < T; t0 += 32) {
      __syncthreads();
      for (int e = tid; e < 32 * 64; e += 256) {
        const int tt = e / 64, d = e % 64;
        const size_t off = ((size_t)(b * 4 + hh) * T + t0 + tt) * 64 + d;
        qs[e] = bf2f(p.QC[off]); fs[e] = __expf(p.GC[off]);
        vs[e] = bf2f(p.VCT[((size_t)(b * 4 + hh) * 64 + d) * T + t0 + tt]);
      }
      __syncthreads();
      for (int tt = 0; tt < 32; ++tt) {
        const float vv = vs[tt * 64 + v];
        float o = 0.f;
#pragma unroll
        for (int kk = 0; kk < 16; ++kk) {
          const float f = fs[tt * 64 + kq * 16 + kk], qv = qs[tt * 64 + kq * 16 + kk];
          S[kk] = f * S[kk] + (1.f - f) * vv; o += qv * S[kk];
        }
        o += __shfl_xor(o, 1); o += __shfl_xor(o, 2);
        if (kq == 0) os[tt * 64 + v] = o;
      }
      __syncthreads();
      {
        const int tt = tid >> 3, j = tid & 7;
        float ss = 0.f;
        for (int i = 0; i < 8; ++i) { const float o = os[tt * 64 + j * 8 + i]; ss += o * o; }
        ss += __shfl_xor(ss, 1); ss += __shfl_xor(ss, 2); ss += __shfl_xor(ss, 4);
        const float rs = rsqrtf(ss * (1.f / 64.f) + 1e-6f);
        const size_t tok = (size_t)b * T + t0 + tt;
        for (int i = 0; i < 8; ++i) {
          const int col = hh * 64 + j * 8 + i;
          const float y = os[tt * 64 + j * 8 + i] * rs * p.c_norm_g[layer * 256 + col] * bf2f(p.GZ[(size_t)3 * NTOK * 256 + tok * 256 + col]);
          p.YMIX[tok * 1024 + 512 + col] = f2bf(y);
        }
      }
    }
  }
}

__global__ void __launch_bounds__(128) k_naive_cmp(Params p, int layer) {
  __shared__ float hs[2][64], os[2][64];
  const int tid = threadIdx.x, kvsel = tid >> 6, j = tid & 63;
  for (int item = blockIdx.x; item < NB * 127; item += gridDim.x) {
    const int b = item / 127, n = item % 127;
    const bf16_t* src = p.KV + ((size_t)(kvsel * NB + b) * T + 16 * n) * 64;
    const float* w1 = p.w1 + ((size_t)(layer * 2 + kvsel) * 2048) * 64;
    const float* pe = p.pe + (size_t)(layer * 2 + kvsel) * 2048;
    float a = 0.f;
    for (int i = 0; i < 2048; ++i) a += (bf2f(src[i]) + pe[i]) * w1[(size_t)i * 64 + j];
    __syncthreads();
    hs[kvsel][j] = siluf_(a);
    __syncthreads();
    const float* w2 = p.w2 + (size_t)(layer * 2 + kvsel) * 4096;
    float o = 0.f;
    for (int i = 0; i < 64; ++i) o += hs[kvsel][i] * w2[i * 64 + j];
    os[kvsel][j] = o;
    __syncthreads();
    if (kvsel == 0) {
      if (j < 32) {
        const int pos = 16 * n + 31;
        const float c = p.ROPEC[pos * 32 + j], s = p.ROPES[pos * 32 + j];
        const float x1 = os[0][j], x2 = os[0][j + 32];
        p.KCMP[((size_t)b * 128 + n) * 64 + j] = f2bf(x1 * c - x2 * s);
        p.KCMP[((size_t)b * 128 + n) * 64 + 32 + j] = f2bf(x1 * s + x2 * c);
      }
    } else {
      p.VCMPT[((size_t)b * 64 + j) * 128 + n] = f2bf(o);
    }
  }
}

DI float dot64_lds(const float* q, const bf16_t* kp) {
  float d = 0.f;
#pragma unroll
  for (int e8 = 0; e8 < 8; ++e8) {
    const u32x4 w = *(const u32x4*)(kp + e8 * 8);
#pragma unroll
    for (int j = 0; j < 4; ++j) { d += q[e8 * 8 + 2 * j] * __uint_as_float(w[j] << 16); d += q[e8 * 8 + 2 * j + 1] * __uint_as_float(w[j] & 0xffff0000u); }
  }
  return d;
}
__global__ void __launch_bounds__(256) k_naiveD(Params p, int layer) {
  __shared__ float pc[4][128], impv[32], pbuf[4][512], qsh[4][64];
  __shared__ int selblk[8];
  const int tid = threadIdx.x, lane = tid & 63, h = tid >> 6;
  for (int tok = blockIdx.x; tok < NTOK; tok += gridDim.x) {
    const int b = tok / T, t = tok % T, cur = t >> 6;
    __syncthreads();
    qsh[h][lane] = bf2f(p.QD[((size_t)(b * 4 + h) * T + t) * 64 + lane]);
    __syncthreads();
    const float* q = qsh[h];
    float o_cmp;
    {
      float sc0 = -INFINITY, sc1 = -INFINITY;
      { const int n = lane; if (16 * n + 31 <= t) sc0 = dot64_lds(q, p.KCMP + ((size_t)b * 128 + n) * 64); }
      { const int n = lane + 64; if (n < 127 && 16 * n + 31 <= t) sc1 = dot64_lds(q, p.KCMP + ((size_t)b * 128 + n) * 64); }
      const float m = wave_max(fmaxf(sc0, sc1));
      float e0 = 0.f, e1 = 0.f;
      if (m > -INFINITY) { e0 = __expf(sc0 - m); e1 = __expf(sc1 - m); }
      const float l = wave_sum(e0 + e1);
      const float il = l > 0.f ? 1.f / l : 0.f;
      pc[h][lane] = e0 * il; pc[h][lane + 64] = e1 * il;
      __syncthreads();
      float o = 0.f;
      const bf16_t* vp = p.VCMPT + ((size_t)b * 64 + lane) * 128;
#pragma unroll 4
      for (int n = 0; n < 127; ++n) o += pc[h][n] * bf2f(vp[n]);
      o_cmp = o;
    }
    if (tid < 32) {
      const int j = tid;
      float v;
      if (j > cur) v = -1e30f;
      else if (j == 0 || j == cur || j == cur - 1) v = 1e6f;
      else {
        v = 0.f;
#pragma unroll 1
        for (int hh = 0; hh < 4; ++hh)
#pragma unroll 1
          for (int n = 4 * j - 1; n <= 4 * j + 3; ++n) if (n >= 0 && n < 127) v += pc[hh][n];
      }
      impv[j] = v;
    }
    __syncthreads();
    if (tid < 32) {
      const int j = tid; const float vj = impv[j];
      int rank = 0;
#pragma unroll 1
      for (int i = 0; i < 32; ++i) { const float vi = impv[i]; rank += (vi > vj || (vi == vj && i < j)) ? 1 : 0; }
      if (rank < 8) selblk[rank] = j;
    }
    __syncthreads();
    float o_slc;
    {
      float m = -INFINITY;
#pragma unroll 1
      for (int r = 0; r < 8; ++r) {
        const int s = selblk[r] * 64 + lane;
        float d = -INFINITY;
        if (s <= t) d = dot64_lds(q, p.KV + ((size_t)(2 * NB + b) * T + s) * 64);
        pbuf[h][r * 64 + lane] = d; m = fmaxf(m, d);
      }
      m = wave_max(m);
      float l = 0.f;
#pragma unroll 1
      for (int r = 0; r < 8; ++r) { const float e = __expf(pbuf[h][r * 64 + lane] - m); pbuf[h][r * 64 + lane] = e; l += e; }
      l = wave_sum(l);
      __syncthreads();
      float o = 0.f;
      const bf16_t* vp = p.KV + ((size_t)(3 * NB + b) * 64 + lane) * T;
#pragma unroll 1
      for (int r = 0; r < 8; ++r) {
        const int s0 = selblk[r] * 64;
#pragma unroll 4
        for (int kk = 0; kk < 64; ++kk) o += pbuf[h][r * 64 + kk] * bf2f(vp[s0 + kk]);
      }
      o_slc = o / l;
      __syncthreads();
    }
    float o_win;
    {
      float m = -INFINITY;
#pragma unroll 1
      for (int r = 0; r < 8; ++r) {
        const int s = t - 511 + r * 64 + lane;
        float d = -INFINITY;
        if (s >= 0) d = dot64_lds(q, p.KV + ((size_t)(4 * NB + b) * T + s) * 64);
        pbuf[h][r * 64 + lane] = d; m = fmaxf(m, d);
      }
      m = wave_max(m);
      float l = 0.f;
#pragma unroll 1
      for (int r = 0; r < 8; ++r) { const float e = __expf(pbuf[h][r * 64 + lane] - m); pbuf[h][r * 64 + lane] = e; l += e; }
      l = wave_sum(l);
      __syncthreads();
      float o = 0.f;
      const bf16_t* vp = p.KV + ((size_t)(5 * NB + b) * 64 + lane) * T;
#pragma unroll 4
      for (int j = 0; j < 512; ++j) { const int s = t - 511 + j; if (s >= 0) o += pbuf[h][j] * bf2f(vp[s]); }
      o_win = o / l;
    }
    const float g0 = p.DG[(size_t)tok * 12 + h * 3 + 0], g1 = p.DG[(size_t)tok * 12 + h * 3 + 1], g2 = p.DG[(size_t)tok * 12 + h * 3 + 2];
    const float o = g0 * o_cmp + g1 * o_slc + g2 * o_win;
    const float gz = bf2f(p.GZ[(size_t)4 * NTOK * 256 + (size_t)tok * 256 + h * 64 + lane]);
    p.YMIX[(size_t)tok * 1024 + 768 + h * 64 + lane] = f2bf(o * gz);
  }
}

static inline size_t align_up(size_t v) { return (v + 255) & ~(size_t)255; }

extern "C" void kernel_launch(void* const* d_in, const int* in_sizes, int n_in, void* d_out, int out_size, void* d_ws, size_t ws_size, hipStream_t stream) {
  Params p{};
  p.x = (const float*)d_in[0]; p.ln0_g = (const float*)d_in[1]; p.ln0_b = (const float*)d_in[2]; p.w_in = (const float*)d_in[3];
  p.b_in = (const float*)d_in[4]; p.a_sinks = (const float*)d_in[5]; p.conv_w = (const float*)d_in[6]; p.conv_b = (const float*)d_in[7];
  p.c_lb = (const float*)d_in[8]; p.c_norm_g = (const float*)d_in[9]; p.pe = (const float*)d_in[10]; p.w1 = (const float*)d_in[11];
  p.w2 = (const float*)d_in[12]; p.w_out = (const float*)d_in[13]; p.ln_g = (const float*)d_in[14]; p.ln_b = (const float*)d_in[15];
  p.hf = (float*)d_out;
  char* w = (char*)d_ws; size_t off = 0;
  auto take = [&](size_t bytes) { char* r = w + off; off = align_up(off + bytes); return r; };
  p.HB = (bf16_t*)take((size_t)NTOK * 1024 * 2);
  p.YMIX = (bf16_t*)take((size_t)NTOK * 1024 * 2);
  p.QA = (bf16_t*)take((size_t)NTOK * 256 * 2);
  p.KA = (bf16_t*)take((size_t)NTOK * 128 * 2);
  p.VAT = (bf16_t*)take((size_t)NTOK * 128 * 2);
  p.QKB = (bf16_t*)take((size_t)NTOK * 512 * 2);
  p.VBT = (bf16_t*)take((size_t)NTOK * 256 * 2);
  p.QC = (bf16_t*)take((size_t)NTOK * 256 * 2);
  p.GC = (float*)take((size_t)NTOK * 256 * 4);
  p.VCT = (bf16_t*)take((size_t)NTOK * 256 * 2);
  p.QD = (bf16_t*)take((size_t)NTOK * 256 * 2);
  p.KV = (bf16_t*)take((size_t)NTOK * 384 * 2);
  p.GZ = (bf16_t*)take((size_t)NTOK * 1280 * 2);
  p.IFG = (float*)take((size_t)NTOK * 8 * 4);
  p.DG = (float*)take((size_t)NTOK * 12 * 4);
  p.WT = (bf16_t*)take((size_t)2 * NP * 1024 * 2);
  p.WOT = (bf16_t*)take((size_t)2 * 1024 * 1024 * 2);
  p.KCMP = (bf16_t*)take((size_t)NB * 128 * 64 * 2);
  p.VCMPT = (bf16_t*)take((size_t)NB * 64 * 128 * 2);
  p.BIASP = (float*)take((size_t)2 * NP * 4);
  p.LB = (float*)take(512 * 4);
  p.ROPEC = (float*)take((size_t)T * 32 * 4);
  p.ROPES = (float*)take((size_t)T * 32 * 4);
  if (off > ws_size) return;

  hipLaunchKernelGGL(k_prologue, dim3(2048), dim3(256), 0, stream, p);
  hipLaunchKernelGGL(k_ln, dim3(2048), dim3(256), 0, stream, p, 0, 0);
  for (int l = 0; l < 2; ++l) {
    hipLaunchKernelGGL(k_gemm<0>, dim3(1024), dim3(256), 0, stream, p, l);
    hipLaunchKernelGGL(k_naiveA, dim3(8192), dim3(256), 0, stream, p, l);
    hipLaunchKernelGGL(k_naiveB, dim3(128), dim3(256), 0, stream, p, l);
    hipLaunchKernelGGL(k_naiveC, dim3(128), dim3(256), 0, stream, p, l);
    hipLaunchKernelGGL(k_naive_cmp, dim3(NB * 127), dim3(128), 0, stream, p, l);
    hipLaunchKernelGGL(k_naiveD, dim3(8192), dim3(256), 0, stream, p, l);
    hipLaunchKernelGGL(k_gemm<1>, dim3(1024), dim3(256), 0, stream, p, l);
    hipLaunchKernelGGL(k_ln, dim3(2048), dim3(256), 0, stream, p, 1, l);
  }
}
```

```cpp
#include <hip/hip_runtime.h>
#include <hip/hip_cooperative_groups.h>
#include <stdio.h>
#include <stdint.h>
#include <stddef.h>

#define DI __device__ __forceinline__
typedef unsigned short bf16_t;
typedef short bf16x8 __attribute__((ext_vector_type(8)));
typedef float f32x16 __attribute__((ext_vector_type(16)));
typedef unsigned u32x4 __attribute__((ext_vector_type(4)));

constexpr int NB = 32, T = 2048, DM = 1024, NTOK = NB * T, NP = 4096;
constexpr float DN_ALPHA = 1.41421356237309515f;

struct Params {
  const float *x, *ln0_g, *ln0_b, *w_in, *b_in, *a_sinks, *conv_w, *conv_b, *c_lb, *c_norm_g, *pe, *w1, *w2, *w_out, *ln_g, *ln_b;
  float* hf;
  bf16_t *HB, *YMIX, *QA, *KA, *VAT, *QKB, *VBT, *QC, *VCT, *QD, *KV, *GZ, *WT, *WOT, *KCMP, *VCMPT;
  float *GC, *IFG, *DG, *BIASP, *LB, *ROPEC, *ROPES;
  int* CTR;
};
namespace cg = cooperative_groups;

DI float bf2f(bf16_t v) { return __uint_as_float(((unsigned)v) << 16); }
DI bf16_t f2bf(float x) { unsigned u = __float_as_uint(x); u += 0x7fffu + ((u >> 16) & 1u); return (bf16_t)(u >> 16); }
DI float sigmoidf_(float x) { return 1.f / (1.f + __expf(-x)); }
DI float siluf_(float x) { return x / (1.f + __expf(-x)); }
DI float wave_sum(float v) { for (int o = 32; o > 0; o >>= 1) v += __shfl_xor(v, o); return v; }
DI float wave_max(float v) { for (int o = 32; o > 0; o >>= 1) v = fmaxf(v, __shfl_xor(v, o)); return v; }

DI int orig_col(int n) {
  if (n < 1536) return n;
  if (n < 3712) return n + 8;
  if (n < 3968) return n + 20;
  if (n < 3976) return 1536 + (n - 3968);
  if (n < 3988) return 3720 + (n - 3976);
  return -1;
}

DI void ph_prologue(const Params& p, int bid, int nblk) {
  const long gtid = (long)bid * 256 + threadIdx.x, gsz = (long)nblk * 256;
  if (gtid < 64) p.CTR[gtid] = 0;
  for (long idx = gtid; idx < 2L * 128 * NP; idx += gsz) {
    const int n = (int)(idx % NP), k8 = (int)((idx / NP) % 128), l = (int)(idx / (NP * 128));
    const int oc = orig_col(n);
    unsigned w[4];
    for (int j = 0; j < 4; ++j) {
      float a = 0.f, b = 0.f;
      if (oc >= 0) { a = p.w_in[((size_t)l * 1024 + k8 * 8 + 2 * j) * 3988 + oc]; b = p.w_in[((size_t)l * 1024 + k8 * 8 + 2 * j + 1) * 3988 + oc]; }
      w[j] = (unsigned)f2bf(a) | ((unsigned)f2bf(b) << 16);
    }
    *(uint4*)(p.WT + ((size_t)l * NP + n) * 1024 + k8 * 8) = make_uint4(w[0], w[1], w[2], w[3]);
  }
  for (long idx = gtid; idx < 2L * 128 * 1024; idx += gsz) {
    const int d = (int)(idx % 1024), m8 = (int)((idx / 1024) % 128), l = (int)(idx / (1024 * 128));
    unsigned w[4];
    for (int j = 0; j < 4; ++j) {
      float a = p.w_out[((size_t)l * 1024 + m8 * 8 + 2 * j) * 1024 + d], b = p.w_out[((size_t)l * 1024 + m8 * 8 + 2 * j + 1) * 1024 + d];
      w[j] = (unsigned)f2bf(a) | ((unsigned)f2bf(b) << 16);
    }
    *(uint4*)(p.WOT + ((size_t)l * 1024 + d) * 1024 + m8 * 8) = make_uint4(w[0], w[1], w[2], w[3]);
  }
  for (long idx = gtid; idx < 2L * NP; idx += gsz) {
    const int n = (int)(idx % NP), l = (int)(idx / NP); const int oc = orig_col(n);
    p.BIASP[idx] = oc >= 0 ? p.b_in[l * 3988 + oc] : 0.f;
  }
  for (long idx = gtid; idx < (long)T * 32; idx += gsz) {
    const int t = (int)(idx / 32), i = (int)(idx % 32);
    const float inv = powf(10000.0f, -(float)i / 32.0f);
    const float ang = (float)t * inv;
    p.ROPEC[idx] = cosf(ang); p.ROPES[idx] = sinf(ang);
  }
  for (long idx = gtid; idx < 512; idx += gsz) {
    const int c = (int)(idx % 256), l = (int)(idx / 256);
    const float a = p.c_lb[c], b = p.c_lb[256 + c];
    const float m = fmaxf(a, b); const float ea = expf(a - m), eb = expf(b - m);
    p.LB[idx] = l == 0 ? 0.f : eb / (ea + eb);
  }
}

DI void ln_rows(const Params& p, int mode, int layer, int bid, int nblk) {
  const int lane = threadIdx.x & 63, wid = threadIdx.x >> 6, nw = blockDim.x >> 6;
  const float* g = mode == 0 ? p.ln0_g : p.ln_g + layer * 1024;
  const float* bb = mode == 0 ? p.ln0_b : p.ln_b + layer * 1024;
  const float* src = mode == 0 ? p.x : p.hf;
  for (int row = bid * nw + wid; row < NTOK; row += nblk * nw) {
    const float* s = src + (size_t)row * 1024;
    float4 v[4];
    float sum = 0.f;
#pragma unroll
    for (int i = 0; i < 4; ++i) { v[i] = *(const float4*)(s + i * 256 + lane * 4); sum += (v[i].x + v[i].y) + (v[i].z + v[i].w); }
    sum = wave_sum(sum);
    const float mu = sum * (1.f / 1024.f);
    float q = 0.f;
#pragma unroll
    for (int i = 0; i < 4; ++i) { float a = v[i].x - mu, b = v[i].y - mu, c = v[i].z - mu, d = v[i].w - mu; q += (a * a + b * b) + (c * c + d * d); }
    q = wave_sum(q);
    const float rs = rsqrtf(q * (1.f / 1024.f) + 1e-5f);
#pragma unroll
    for (int i = 0; i < 4; ++i) {
      const int c0 = i * 256 + lane * 4;
      const float4 gg = *(const float4*)(g + c0), b4 = *(const float4*)(bb + c0);
      float4 o;
      o.x = (v[i].x - mu) * rs * gg.x + b4.x; o.y = (v[i].y - mu) * rs * gg.y + b4.y;
      o.z = (v[i].z - mu) * rs * gg.z + b4.z; o.w = (v[i].w - mu) * rs * gg.w + b4.w;
      *(float4*)(p.hf + (size_t)row * 1024 + c0) = o;
      uint2 pk; pk.x = (unsigned)f2bf(o.x) | ((unsigned)f2bf(o.y) << 16); pk.y = (unsigned)f2bf(o.z) | ((unsigned)f2bf(o.w) << 16);
      *(uint2*)(p.HB + (size_t)row * 1024 + c0) = pk;
    }
  }
}

enum { K_NONE = 0, K_ROPE, K_PLAIN, K_TR, K_GSILU, K_GSIG, K_SILUH, K_LOGF, K_SMALL };

template <int KIND>
DI void epi_inproj(const Params& p, const f32x16 (&acc)[2][2], bf16_t* dst, float* fdst, float scale, float bias0, float bias1, float lb0, float lb1,
                   int b, int t0, int l31, int h2) {
#pragma unroll
  for (int mt = 0; mt < 2; ++mt) {
#pragma unroll
    for (int r = 0; r < 16; ++r) {
      const int t = t0 + mt * 32 + (r & 3) + 8 * (r >> 2) + 4 * h2;
      const size_t tok = (size_t)b * T + t;
      const float v0 = acc[mt][0][r] + bias0, v1 = acc[mt][1][r] + bias1;
      if (KIND == K_ROPE) {
        const float c = p.ROPEC[t * 32 + l31], s = p.ROPES[t * 32 + l31];
        const float o0 = (v0 * c - v1 * s) * scale, o1 = (v0 * s + v1 * c) * scale;
        dst[(size_t)t * 64 + l31] = f2bf(o0); dst[(size_t)t * 64 + 32 + l31] = f2bf(o1);
      } else if (KIND == K_PLAIN) {
        dst[(size_t)t * 64 + l31] = f2bf(v0); dst[(size_t)t * 64 + 32 + l31] = f2bf(v1);
      } else if (KIND == K_SILUH) {
        dst[(size_t)t * 64 + l31] = f2bf(siluf_(v0)); dst[(size_t)t * 64 + 32 + l31] = f2bf(siluf_(v1));
      } else if (KIND == K_TR) {
        dst[(size_t)l31 * T + t] = f2bf(v0); dst[(size_t)(l31 + 32) * T + t] = f2bf(v1);
      } else if (KIND == K_GSILU) {
        dst[tok * 256 + l31] = f2bf(siluf_(v0)); dst[tok * 256 + 32 + l31] = f2bf(siluf_(v1));
      } else if (KIND == K_GSIG) {
        dst[tok * 256 + l31] = f2bf(sigmoidf_(v0)); dst[tok * 256 + 32 + l31] = f2bf(sigmoidf_(v1));
      } else if (KIND == K_LOGF) {
        const float f0 = lb0 + (1.f - lb0) * sigmoidf_(v0), f1 = lb1 + (1.f - lb1) * sigmoidf_(v1);
        fdst[(size_t)t * 64 + l31] = logf(f0); fdst[(size_t)t * 64 + 32 + l31] = logf(f1);
      } else if (KIND == K_SMALL) {
        if (l31 < 8) p.IFG[tok * 8 + l31] = v0;
        else if (l31 < 20) p.DG[tok * 12 + (l31 - 8)] = sigmoidf_(v0);
      }
    }
  }
}

template <int MODE>
DI void gemm_tile(const Params& p, int layer, int pm, int pn, char* smem) {
  const int tid = threadIdx.x, lane = tid & 63, wid = tid >> 6, wm = wid >> 1, wn = wid & 1;
  const int l31 = lane & 31, h2 = lane >> 5;
  const bf16_t* A = (MODE == 0 ? p.HB : p.YMIX) + (size_t)pm * 128 * 1024;
  const bf16_t* Bt = (MODE == 0 ? p.WT + (size_t)layer * NP * 1024 : p.WOT + (size_t)layer * 1024 * 1024) + (size_t)pn * 128 * 1024;
  bf16_t* sA = (bf16_t*)smem;
  bf16_t* sB = sA + 128 * 72;
  f32x16 acc[2][2];
#pragma unroll
  for (int i = 0; i < 2; ++i)
#pragma unroll
    for (int j = 0; j < 2; ++j)
#pragma unroll
      for (int r = 0; r < 16; ++r) acc[i][j][r] = 0.f;
  const int lr = tid >> 3, lc = (tid & 7) * 8;
  u32x4 ra[4], rb[4];
#pragma unroll
  for (int i = 0; i < 4; ++i) { ra[i] = *(const u32x4*)(A + (size_t)(lr + 32 * i) * 1024 + lc); rb[i] = *(const u32x4*)(Bt + (size_t)(lr + 32 * i) * 1024 + lc); }
  for (int kt = 0; kt < 16; ++kt) {
    __syncthreads();
#pragma unroll
    for (int i = 0; i < 4; ++i) { *(u32x4*)(sA + (lr + 32 * i) * 72 + lc) = ra[i]; *(u32x4*)(sB + (lr + 32 * i) * 72 + lc) = rb[i]; }
    __syncthreads();
    if (kt + 1 < 16) {
#pragma unroll
      for (int i = 0; i < 4; ++i) { ra[i] = *(const u32x4*)(A + (size_t)(lr + 32 * i) * 1024 + (kt + 1) * 64 + lc); rb[i] = *(const u32x4*)(Bt + (size_t)(lr + 32 * i) * 1024 + (kt + 1) * 64 + lc); }
    }
#pragma unroll
    for (int ks = 0; ks < 4; ++ks) {
      bf16x8 af[2], bfr[2];
#pragma unroll
      for (int mt = 0; mt < 2; ++mt) af[mt] = *(const bf16x8*)(sA + (wm * 64 + mt * 32 + l31) * 72 + ks * 16 + h2 * 8);
#pragma unroll
      for (int nt = 0; nt < 2; ++nt) bfr[nt] = *(const bf16x8*)(sB + (wn * 64 + nt * 32 + l31) * 72 + ks * 16 + h2 * 8);
#pragma unroll
      for (int mt = 0; mt < 2; ++mt)
#pragma unroll
        for (int nt = 0; nt < 2; ++nt) acc[mt][nt] = __builtin_amdgcn_mfma_f32_32x32x16_bf16(af[mt], bfr[nt], acc[mt][nt], 0, 0, 0);
    }
  }
  if (MODE == 1) {
#pragma unroll
    for (int mt = 0; mt < 2; ++mt)
#pragma unroll
      for (int nt = 0; nt < 2; ++nt)
#pragma unroll
        for (int r = 0; r < 16; ++r) {
          const int row = pm * 128 + wm * 64 + mt * 32 + (r & 3) + 8 * (r >> 2) + 4 * h2;
          const int col = pn * 128 + wn * 64 + nt * 32 + l31;
          float* dst = p.hf + (size_t)row * 1024 + col;
          *dst = DN_ALPHA * (*dst) + acc[mt][nt][r];
        }
    return;
  }
  const int hd = pn * 2 + wn;
  const int b = pm >> 4, t0 = (pm & 15) * 128 + wm * 64;
  int kind = K_NONE; bf16_t* dst = nullptr; float scale = 1.f; float* fdst = nullptr;
  if (hd < 4) { kind = K_ROPE; dst = p.QA + ((size_t)(b * 4 + hd) * T) * 64; scale = 0.125f; }
  else if (hd < 6) { kind = K_ROPE; dst = p.KA + ((size_t)(b * 2 + hd - 4) * T) * 64; }
  else if (hd < 8) { kind = K_TR; dst = p.VAT + (size_t)(b * 2 + hd - 6) * 64 * T; }
  else if (hd < 12) { kind = K_GSILU; dst = p.GZ + (size_t)0 * NTOK * 256 + (hd - 8) * 64; }
  else if (hd < 20) { kind = K_PLAIN; dst = p.QKB + ((size_t)(b * 8 + hd - 12) * T) * 64; }
  else if (hd < 24) { kind = K_TR; dst = p.VBT + (size_t)(b * 4 + hd - 20) * 64 * T; }
  else if (hd < 28) { kind = K_GSIG; dst = p.GZ + (size_t)1 * NTOK * 256 + (hd - 24) * 64; }
  else if (hd < 32) { kind = K_GSILU; dst = p.GZ + (size_t)2 * NTOK * 256 + (hd - 28) * 64; }
  else if (hd < 36) { kind = K_SILUH; dst = p.QC + ((size_t)(b * 4 + hd - 32) * T) * 64; }
  else if (hd < 40) { kind = K_LOGF; fdst = p.GC + ((size_t)(b * 4 + hd - 36) * T) * 64; }
  else if (hd < 44) { kind = K_TR; dst = p.VCT + (size_t)(b * 4 + hd - 40) * 64 * T; }
  else if (hd < 48) { kind = K_GSILU; dst = p.GZ + (size_t)3 * NTOK * 256 + (hd - 44) * 64; }
  else if (hd < 52) { kind = K_ROPE; dst = p.QD + ((size_t)(b * 4 + hd - 48) * T) * 64; scale = 0.125f; }
  else if (hd < 58) {
    const int j = hd - 52;
    dst = p.KV + (size_t)(j * NB + b) * T * 64;
    kind = (j == 0 || j == 1) ? K_PLAIN : ((j == 2 || j == 4) ? K_ROPE : K_TR);
  }
  else if (hd < 62) { kind = K_GSILU; dst = p.GZ + (size_t)4 * NTOK * 256 + (hd - 58) * 64; }
  else if (hd == 62) { kind = K_SMALL; }
  if (kind == K_NONE) return;
  const float bias0 = p.BIASP[layer * NP + hd * 64 + l31], bias1 = p.BIASP[layer * NP + hd * 64 + 32 + l31];
  float lb0 = 0.f, lb1 = 0.f;
  if (kind == K_LOGF) { lb0 = p.LB[layer * 256 + (hd - 36) * 64 + l31]; lb1 = p.LB[layer * 256 + (hd - 36) * 64 + 32 + l31]; }
  switch (kind) {
    case K_ROPE: epi_inproj<K_ROPE>(p, acc, dst, fdst, scale, bias0, bias1, lb0, lb1, b, t0, l31, h2); break;
    case K_PLAIN: epi_inproj<K_PLAIN>(p, acc, dst, fdst, scale, bias0, bias1, lb0, lb1, b, t0, l31, h2); break;
    case K_TR: epi_inproj<K_TR>(p, acc, dst, fdst, scale, bias0, bias1, lb0, lb1, b, t0, l31, h2); break;
    case K_GSILU: epi_inproj<K_GSILU>(p, acc, dst, fdst, scale, bias0, bias1, lb0, lb1, b, t0, l31, h2); break;
    case K_GSIG: epi_inproj<K_GSIG>(p, acc, dst, fdst, scale, bias0, bias1, lb0, lb1, b, t0, l31, h2); break;
    case K_SILUH: epi_inproj<K_SILUH>(p, acc, dst, fdst, scale, bias0, bias1, lb0, lb1, b, t0, l31, h2); break;
    case K_LOGF: epi_inproj<K_LOGF>(p, acc, dst, fdst, scale, bias0, bias1, lb0, lb1, b, t0, l31, h2); break;
    case K_SMALL: epi_inproj<K_SMALL>(p, acc, dst, fdst, scale, bias0, bias1, lb0, lb1, b, t0, l31, h2); break;
    default: break;
  }
}

template <int MODE>
DI void ph_gemm(const Params& p, int layer, int bid, int nblk, char* smem) {
  const int ntn = MODE == 0 ? 32 : 8;
  const int ntiles = 512 * ntn;
  for (int tile = bid; tile < ntiles; tile += nblk) gemm_tile<MODE>(p, layer, tile / ntn, tile % ntn, smem);
}

DI void ph_naiveA(const Params& p, int layer, int bid, int nblk, char* smem) {
  float (*ps)[128] = (float (*)[128])smem;
  const int lane = threadIdx.x & 63, h = threadIdx.x >> 6;
  for (int tok = bid; tok < NTOK; tok += nblk) {
    const int b = tok / T, t = tok % T, g = h >> 1;
    const bf16_t* q = p.QA + ((size_t)(b * 4 + h) * T + t) * 64;
    const bf16_t* K = p.KA + (size_t)(b * 2 + g) * T * 64;
    const bf16_t* VT = p.VAT + (size_t)(b * 2 + g) * 64 * T;
    float sc[2];
    for (int i = 0; i < 2; ++i) {
      const int s = t - 127 + lane + 64 * i;
      float d = -INFINITY;
      if (s >= 0) { d = 0.f; for (int e = 0; e < 64; ++e) d += bf2f(q[e]) * bf2f(K[(size_t)s * 64 + e]); }
      sc[i] = d;
    }
    const float sink = p.a_sinks[layer * 4 + h];
    float m = fmaxf(wave_max(fmaxf(sc[0], sc[1])), sink);
    const float e0 = __expf(sc[0] - m), e1 = __expf(sc[1] - m);
    const float l = wave_sum(e0 + e1) + __expf(sink - m);
    __syncthreads();
    ps[h][lane] = e0; ps[h][lane + 64] = e1;
    __syncthreads();
    float o = 0.f;
    for (int j = 0; j < 128; ++j) { const int s = t - 127 + j; if (s >= 0) o += ps[h][j] * bf2f(VT[(size_t)lane * T + s]); }
    o /= l;
    const float gz = bf2f(p.GZ[(size_t)0 * NTOK * 256 + (size_t)tok * 256 + h * 64 + lane]);
    p.YMIX[(size_t)tok * 1024 + h * 64 + lane] = f2bf(o * gz);
  }
}

DI void ph_naiveB(const Params& p, int layer, int bid, int nblk, char* smem) {
  float* qs = (float*)smem; float* ks = qs + 2048; float* vs = ks + 2048; float* ig = vs + 2048; float* fg = ig + 32;
  const int tid = threadIdx.x, v = tid >> 2, kq = tid & 3;
  for (int item = bid; item < NB * 4; item += nblk) {
    const int b = item >> 2, hh = item & 3;
    float C[16], n[16];
    for (int i = 0; i < 16; ++i) { C[i] = 0.f; n[i] = 0.f; }
    const bf16_t* rawq = p.QKB + ((size_t)(b * 8 + hh) * T) * 64;
    const bf16_t* rawk = p.QKB + ((size_t)(b * 8 + 4 + hh) * T) * 64;
    const float* cw = p.conv_w + layer * 4 * 512; const float* cb = p.conv_b + layer * 512;
    for (int t0 = 0; t0 < T; t0 += 32) {
      __syncthreads();
      for (int e = tid; e < 2 * 32 * 64; e += 256) {
        const int which = e / 2048, tt = (e % 2048) / 64, d = e % 64, t = t0 + tt;
        const bf16_t* raw = which ? rawk : rawq; const int ch = (which ? 256 : 0) + hh * 64 + d;
        float a = cb[ch];
        for (int j = 0; j < 4; ++j) { const int ts = t - 3 + j; if (ts >= 0) a += cw[j * 512 + ch] * bf2f(raw[(size_t)ts * 64 + d]); }
        float sv = siluf_(a); if (!which) sv *= 0.125f;
        (which ? ks : qs)[tt * 64 + d] = sv;
      }
      for (int e = tid; e < 32 * 64; e += 256) { const int tt = e / 64, d = e % 64; vs[tt * 64 + d] = bf2f(p.VBT[((size_t)(b * 4 + hh) * 64 + d) * T + t0 + tt]); }
      if (tid < 32) { const size_t tok = (size_t)b * T + t0 + tid; ig[tid] = p.IFG[tok * 8 + hh]; fg[tid] = sigmoidf_(p.IFG[tok * 8 + 4 + hh]); }
      __syncthreads();
      for (int tt = 0; tt < 32; ++tt) {
        const float f = fg[tt], iw = __expf(ig[tt]); const float vv = vs[tt * 64 + v] * iw;
        float num = 0.f, den = 0.f;
#pragma unroll
        for (int kk = 0; kk < 16; ++kk) {
          const float kv = ks[tt * 64 + kq * 16 + kk], qv = qs[tt * 64 + kq * 16 + kk];
          C[kk] = f * C[kk] + vv * kv; n[kk] = f * n[kk] + iw * kv; num += C[kk] * qv; den += n[kk] * qv;
        }
        num += __shfl_xor(num, 1); num += __shfl_xor(num, 2); den += __shfl_xor(den, 1); den += __shfl_xor(den, 2);
        const float hval = num / fmaxf(fabsf(den), 1.f);
        if (kq == 0) {
          const size_t tok = (size_t)b * T + t0 + tt; const int col = hh * 64 + v;
          const float y = bf2f(p.GZ[(size_t)1 * NTOK * 256 + tok * 256 + col]) * hval * bf2f(p.GZ[(size_t)2 * NTOK * 256 + tok * 256 + col]);
          p.YMIX[tok * 1024 + 256 + col] = f2bf(y);
        }
      }
    }
  }
}

DI void ph_naiveC(const Params& p, int layer, int bid, int nblk, char* smem) {
  float* qs = (float*)smem; float* fs = qs + 2048; float* vs = fs + 2048; float* os = vs + 2048;
  const int tid = threadIdx.x, v = tid >> 2, kq = tid & 3;
  for (int item = bid; item < NB * 4; item += nblk) {
    const int b = item >> 2, hh = item & 3;
    float S[16];
    for (int i = 0; i < 16; ++i) S[i] = 0.f;
    for (int t0 = 0; t0 < T; t0 += 32) {
      __syncthreads();
      for (int e = tid; e < 32 * 64; e += 256) {
        const int tt = e / 64, d = e % 64;
        const size_t off = ((size_t)(b * 4 + hh) * T + t0 + tt) * 64 + d;
        qs[e] = bf2f(p.QC[off]); fs[e] = __expf(p.GC[off]);
        vs[e] = bf2f(p.VCT[((size_t)(b * 4 + hh) * 64 + d) * T + t0 + tt]);
      }
      __syncthreads();
      for (int tt = 0; tt < 32; ++tt) {
        const float vv = vs[tt * 64 + v];
        float o = 0.f;
#pragma unroll
        for (int kk = 0; kk < 16; ++kk) {
          const float f = fs[tt * 64 + kq * 16 + kk], qv = qs[tt * 64 + kq * 16 + kk];
          S[kk] = f * S[kk] + (1.f - f) * vv; o += qv * S[kk];
        }
        o += __shfl_xor(o, 1); o += __shfl_xor(o, 2);
        if (kq == 0) os[tt * 64 + v] = o;
      }
      __syncthreads();
      {
        const int tt = tid >> 3, j = tid & 7;
        float ss = 0.f;
        for (int i = 0; i < 8; ++i) { const float o = os[tt * 64 + j * 8 + i]; ss += o * o; }
        ss += __shfl_xor(ss, 1); ss += __shfl_xor(ss, 2); ss += __shfl_xor(ss, 4);
        const float rs = rsqrtf(ss * (1.f / 64.f) + 1e-6f);
        const size_t tok = (size_t)b * T + t0 + tt;
        for (int i = 0; i < 8; ++i) {
          const int col = hh * 64 + j * 8 + i;
          const float y = os[tt * 64 + j * 8 + i] * rs * p.c_norm_g[layer * 256 + col] * bf2f(p.GZ[(size_t)3 * NTOK * 256 + tok * 256 + col]);
          p.YMIX[tok * 1024 + 512 + col] = f2bf(y);
        }
      }
    }
  }
}

DI void ph_naive_cmp(const Params& p, int layer, int bid, int nblk, char* smem) {
  float (*hs)[64] = (float (*)[64])smem; float (*os)[64] = (float (*)[64])(smem + 512);
  const int tid = threadIdx.x, kvsel = (tid >> 6) & 1, j = tid & 63;
  const bool act = tid < 128;
  for (int item = bid; item < NB * 127; item += nblk) {
    const int b = item / 127, n = item % 127;
    const bf16_t* src = p.KV + ((size_t)(kvsel * NB + b) * T + 16 * n) * 64;
    const float* w1 = p.w1 + ((size_t)(layer * 2 + kvsel) * 2048) * 64;
    const float* pe = p.pe + (size_t)(layer * 2 + kvsel) * 2048;
    float a = 0.f;
    if (act) for (int i = 0; i < 2048; ++i) a += (bf2f(src[i]) + pe[i]) * w1[(size_t)i * 64 + j];
    __syncthreads();
    if (act) hs[kvsel][j] = siluf_(a);
    __syncthreads();
    const float* w2 = p.w2 + (size_t)(layer * 2 + kvsel) * 4096;
    float o = 0.f;
    if (act) { for (int i = 0; i < 64; ++i) o += hs[kvsel][i] * w2[i * 64 + j]; os[kvsel][j] = o; }
    __syncthreads();
    if (act) {
      if (kvsel == 0) {
        if (j < 32) {
          const int pos = 16 * n + 31;
          const float c = p.ROPEC[pos * 32 + j], s = p.ROPES[pos * 32 + j];
          const float x1 = os[0][j], x2 = os[0][j + 32];
          p.KCMP[((size_t)b * 128 + n) * 64 + j] = f2bf(x1 * c - x2 * s);
          p.KCMP[((size_t)b * 128 + n) * 64 + 32 + j] = f2bf(x1 * s + x2 * c);
        }
      } else {
        p.VCMPT[((size_t)b * 64 + j) * 128 + n] = f2bf(o);
      }
    }
  }
}

DI float dot64_lds(const float* q, const bf16_t* kp) {
  float d = 0.f;
#pragma unroll
  for (int e8 = 0; e8 < 8; ++e8) {
    const u32x4 w = *(const u32x4*)(kp + e8 * 8);
#pragma unroll
    for (int j = 0; j < 4; ++j) { d += q[e8 * 8 + 2 * j] * __uint_as_float(w[j] << 16); d += q[e8 * 8 + 2 * j + 1] * __uint_as_float(w[j] & 0xffff0000u); }
  }
  return d;
}
DI void ph_naiveD(const Params& p, int layer, int* ctr, char* smem) {
  float (*pc)[128] = (float (*)[128])smem; float* impv = (float*)(smem + 2048); float (*pbuf)[512] = (float (*)[512])(smem + 2048 + 128);
  float (*qsh)[64] = (float (*)[64])(smem + 2048 + 128 + 8192); int* selblk = (int*)(smem + 2048 + 128 + 8192 + 1024); int* s_item = selblk + 8;
  const int tid = threadIdx.x, lane = tid & 63, h = tid >> 6;
  for (;;) {
    __syncthreads();
    if (tid == 0) *s_item = atomicAdd(ctr, 1);
    __syncthreads();
    const int tok = *s_item;
    if (tok >= NTOK) break;
    const int b = tok / T, t = tok % T, cur = t >> 6;
    __syncthreads();
    qsh[h][lane] = bf2f(p.QD[((size_t)(b * 4 + h) * T + t) * 64 + lane]);
    __syncthreads();
    const float* q = qsh[h];
    float o_cmp;
    {
      float sc0 = -INFINITY, sc1 = -INFINITY;
      { const int n = lane; if (16 * n + 31 <= t) sc0 = dot64_lds(q, p.KCMP + ((size_t)b * 128 + n) * 64); }
      { const int n = lane + 64; if (n < 127 && 16 * n + 31 <= t) sc1 = dot64_lds(q, p.KCMP + ((size_t)b * 128 + n) * 64); }
      const float m = wave_max(fmaxf(sc0, sc1));
      float e0 = 0.f, e1 = 0.f;
      if (m > -INFINITY) { e0 = __expf(sc0 - m); e1 = __expf(sc1 - m); }
      const float l = wave_sum(e0 + e1);
      const float il = l > 0.f ? 1.f / l : 0.f;
      pc[h][lane] = e0 * il; pc[h][lane + 64] = e1 * il;
      __syncthreads();
      float o = 0.f;
      const bf16_t* vp = p.VCMPT + ((size_t)b * 64 + lane) * 128;
#pragma unroll 4
      for (int n = 0; n < 127; ++n) o += pc[h][n] * bf2f(vp[n]);
      o_cmp = o;
    }
    if (tid < 32) {
      const int j = tid;
      float v;
      if (j > cur) v = -1e30f;
      else if (j == 0 || j == cur || j == cur - 1) v = 1e6f;
      else {
        v = 0.f;
#pragma unroll 1
        for (int hh = 0; hh < 4; ++hh)
#pragma unroll 1
          for (int n = 4 * j - 1; n <= 4 * j + 3; ++n) if (n >= 0 && n < 127) v += pc[hh][n];
      }
      impv[j] = v;
    }
    __syncthreads();
    if (tid < 32) {
      const int j = tid; const float vj = impv[j];
      int rank = 0;
#pragma unroll 1
      for (int i = 0; i < 32; ++i) { const float vi = impv[i]; rank += (vi > vj || (vi == vj && i < j)) ? 1 : 0; }
      if (rank < 8) selblk[rank] = j;
    }
    __syncthreads();
    float o_slc;
    {
      float m = -INFINITY;
#pragma unroll 1
      for (int r = 0; r < 8; ++r) {
        const int s = selblk[r] * 64 + lane;
        float d = -INFINITY;
        if (s <= t) d = dot64_lds(q, p.KV + ((size_t)(2 * NB + b) * T + s) * 64);
        pbuf[h][r * 64 + lane] = d; m = fmaxf(m, d);
      }
      m = wave_max(m);
      float l = 0.f;
#pragma unroll 1
      for (int r = 0; r < 8; ++r) { const float e = __expf(pbuf[h][r * 64 + lane] - m); pbuf[h][r * 64 + lane] = e; l += e; }
      l = wave_sum(l);
      __syncthreads();
      float o = 0.f;
      const bf16_t* vp = p.KV + ((size_t)(3 * NB + b) * 64 + lane) * T;
#pragma unroll 1
      for (int r = 0; r < 8; ++r) {
        const int s0 = selblk[r] * 64;
#pragma unroll 4
        for (int kk = 0; kk < 64; ++kk) o += pbuf[h][r * 64 + kk] * bf2f(vp[s0 + kk]);
      }
      o_slc = o / l;
      __syncthreads();
    }
    float o_win;
    {
      float m = -INFINITY;
#pragma unroll 1
      for (int r = 0; r < 8; ++r) {
        const int s = t - 511 + r * 64 + lane;
        float d = -INFINITY;
        if (s >= 0) d = dot64_lds(q, p.KV + ((size_t)(4 * NB + b) * T + s) * 64);
        pbuf[h][r * 64 + lane] = d; m = fmaxf(m, d);
      }
      m = wave_max(m);
      float l = 0.f;
#pragma unroll 1
      for (int r = 0; r < 8; ++r) { const float e = __expf(pbuf[h][r * 64 + lane] - m); pbuf[h][r * 64 + lane] = e; l += e; }
      l = wave_sum(l);
      __syncthreads();
      float o = 0.f;
      const bf16_t* vp = p.KV + ((size_t)(5 * NB + b) * 64 + lane) * T;
#pragma unroll 4
      for (int j = 0; j < 512; ++j) { const int s = t - 511 + j; if (s >= 0) o += pbuf[h][j] * bf2f(vp[s]); }
      o_win = o / l;
    }
    const float g0 = p.DG[(size_t)tok * 12 + h * 3 + 0], g1 = p.DG[(size_t)tok * 12 + h * 3 + 1], g2 = p.DG[(size_t)tok * 12 + h * 3 + 2];
    const float o = g0 * o_cmp + g1 * o_slc + g2 * o_win;
    const float gz = bf2f(p.GZ[(size_t)4 * NTOK * 256 + (size_t)tok * 256 + h * 64 + lane]);
    p.YMIX[(size_t)tok * 1024 + 768 + h * 64 + lane] = f2bf(o * gz);
  }
}

__global__ void __launch_bounds__(256) mega(Params p) {
  __shared__ __attribute__((aligned(16))) char smem[40960];
  cg::grid_group grid = cg::this_grid();
  const int bid = blockIdx.x, nblk = gridDim.x;
  ph_prologue(p, bid, nblk);
  ln_rows(p, 0, 0, bid, nblk);
  grid.sync();
  for (int l = 0; l < 2; ++l) {
    ph_gemm<0>(p, l, bid, nblk, smem);
    grid.sync();
    ph_naive_cmp(p, l, bid, nblk, smem);
    __syncthreads();
    ph_naiveA(p, l, bid, nblk, smem);
    grid.sync();
    if (bid < 128) ph_naiveB(p, l, bid, 128, smem);
    else if (bid < 256) ph_naiveC(p, l, bid - 128, 128, smem);
    __syncthreads();
    ph_naiveD(p, l, p.CTR + l, smem);
    grid.sync();
    ph_gemm<1>(p, l, bid, nblk, smem);
    grid.sync();
    ln_rows(p, 1, l, bid, nblk);
    if (l == 0) grid.sync();
  }
}

static inline size_t align_up(size_t v) { return (v + 255) & ~(size_t)255; }

extern "C" void kernel_launch(void* const* d_in, const int* in_sizes, int n_in, void* d_out, int out_size, void* d_ws, size_t ws_size, hipStream_t stream) {
  Params p{};
  p.x = (const float*)d_in[0]; p.ln0_g = (const float*)d_in[1]; p.ln0_b = (const float*)d_in[2]; p.w_in = (const float*)d_in[3];
  p.b_in = (const float*)d_in[4]; p.a_sinks = (const float*)d_in[5]; p.conv_w = (const float*)d_in[6]; p.conv_b = (const float*)d_in[7];
  p.c_lb = (const float*)d_in[8]; p.c_norm_g = (const float*)d_in[9]; p.pe = (const float*)d_in[10]; p.w1 = (const float*)d_in[11];
  p.w2 = (const float*)d_in[12]; p.w_out = (const float*)d_in[13]; p.ln_g = (const float*)d_in[14]; p.ln_b = (const float*)d_in[15];
  p.hf = (float*)d_out;
  char* w = (char*)d_ws; size_t off = 0;
  auto take = [&](size_t bytes) { char* r = w + off; off = align_up(off + bytes); return r; };
  p.HB = (bf16_t*)take((size_t)NTOK * 1024 * 2);
  p.YMIX = (bf16_t*)take((size_t)NTOK * 1024 * 2);
  p.QA = (bf16_t*)take((size_t)NTOK * 256 * 2);
  p.KA = (bf16_t*)take((size_t)NTOK * 128 * 2);
  p.VAT = (bf16_t*)take((size_t)NTOK * 128 * 2);
  p.QKB = (bf16_t*)take((size_t)NTOK * 512 * 2);
  p.VBT = (bf16_t*)take((size_t)NTOK * 256 * 2);
  p.QC = (bf16_t*)take((size_t)NTOK * 256 * 2);
  p.GC = (float*)take((size_t)NTOK * 256 * 4);
  p.VCT = (bf16_t*)take((size_t)NTOK * 256 * 2);
  p.QD = (bf16_t*)take((size_t)NTOK * 256 * 2);
  p.KV = (bf16_t*)take((size_t)NTOK * 384 * 2);
  p.GZ = (bf16_t*)take((size_t)NTOK * 1280 * 2);
  p.IFG = (float*)take((size_t)NTOK * 8 * 4);
  p.DG = (float*)take((size_t)NTOK * 12 * 4);
  p.WT = (bf16_t*)take((size_t)2 * NP * 1024 * 2);
  p.WOT = (bf16_t*)take((size_t)2 * 1024 * 1024 * 2);
  p.KCMP = (bf16_t*)take((size_t)NB * 128 * 64 * 2);
  p.VCMPT = (bf16_t*)take((size_t)NB * 64 * 128 * 2);
  p.BIASP = (float*)take((size_t)2 * NP * 4);
  p.LB = (float*)take(512 * 4);
  p.ROPEC = (float*)take((size_t)T * 32 * 4);
  p.ROPES = (float*)take((size_t)T * 32 * 4);
  p.CTR = (int*)take(256);
  if (off > ws_size) { fprintf(stderr, "workspace too small: need %zu have %zu\n", off, ws_size); return; }

  static int grid_blocks = 0;
  if (!grid_blocks) {
    int dev = 0, cus = 0, per_cu = 0;
    (void)hipGetDevice(&dev);
    (void)hipDeviceGetAttribute(&cus, hipDeviceAttributeMultiprocessorCount, dev);
    (void)hipOccupancyMaxActiveBlocksPerMultiprocessor(&per_cu, mega, 256, 0);
    if (per_cu > 2) per_cu = 2;
    grid_blocks = cus * per_cu;
  }
  void* args[] = {&p};
  hipError_t e = hipLaunchCooperativeKernel((void*)mega, dim3(grid_blocks), dim3(256), args, 0, stream);
  if (e != hipSuccess) fprintf(stderr, "cooperative launch failed: %s (grid %d)\n", hipGetErrorString(e), grid_blocks);
}
```

```cpp
#include <hip/hip_runtime.h>
#include <hip/hip_cooperative_groups.h>
#include <stdio.h>
#include <stdint.h>
#include <stddef.h>

#define DI __device__ __forceinline__
typedef unsigned short bf16_t;
typedef short bf16x8 __attribute__((ext_vector_type(8)));
typedef float f32x16 __attribute__((ext_vector_type(16)));
typedef unsigned u32x4 __attribute__((ext_vector_type(4)));
typedef float f32x4 __attribute__((ext_vector_type(4)));

constexpr int NB = 32, T = 2048, DM = 1024, NTOK = NB * T, NP = 4096;
constexpr float DN_ALPHA = 1.41421356237309515f;

struct Params {
  const float *x, *ln0_g, *ln0_b, *w_in, *b_in, *a_sinks, *conv_w, *conv_b, *c_lb, *c_norm_g, *pe, *w1, *w2, *w_out, *ln_g, *ln_b;
  float* hf;
  bf16_t *HB, *YMIX, *QA, *KA, *VAT, *QKB, *VBT, *QC, *VCT, *QD, *KV, *GZ, *WT, *WOT, *KCMP, *VCMPT, *W1T, *W2T;
  float *GC, *IFG, *DG, *BIASP, *LB, *ROPEC, *ROPES, *BST, *BN, *BG, *CST, *CAL, *CVEC;
  int* CTR;
};
namespace cg = cooperative_groups;

DI int tid_opaque() { int t = threadIdx.x; asm volatile("" : "+v"(t)); return t; }
DI float bf2f(bf16_t v) { return __uint_as_float(((unsigned)v) << 16); }
DI bf16_t f2bf(float x) { unsigned u = __float_as_uint(x); u += 0x7fffu + ((u >> 16) & 1u); return (bf16_t)(u >> 16); }
DI float sigmoidf_(float x) { return 1.f / (1.f + __expf(-x)); }
DI float siluf_(float x) { return x / (1.f + __expf(-x)); }
DI float wave_sum(float v) { for (int o = 32; o > 0; o >>= 1) v += __shfl_xor(v, o); return v; }
DI float wave_max(float v) { for (int o = 32; o > 0; o >>= 1) v = fmaxf(v, __shfl_xor(v, o)); return v; }

DI int orig_col(int n) {
  if (n < 1536) return n;
  if (n < 3712) return n + 8;
  if (n < 3968) return n + 20;
  if (n < 3976) return 1536 + (n - 3968);
  if (n < 3988) return 3720 + (n - 3976);
  return -1;
}

DI void ph_prologue(const Params& p, int bid, int nblk, char* smem) {
  const long gtid = (long)bid * 256 + tid_opaque(), gsz = (long)nblk * 256;
  if (gtid < 64) p.CTR[gtid] = 0;
  for (long idx = gtid; idx < 2L * 128 * NP; idx += gsz) {
    const int n = (int)(idx % NP), k8 = (int)((idx / NP) % 128), l = (int)(idx / (NP * 128));
    const int oc = orig_col(n);
    unsigned w[4];
    for (int j = 0; j < 4; ++j) {
      float a = 0.f, b = 0.f;
      if (oc >= 0) { a = p.w_in[((size_t)l * 1024 + k8 * 8 + 2 * j) * 3988 + oc]; b = p.w_in[((size_t)l * 1024 + k8 * 8 + 2 * j + 1) * 3988 + oc]; }
      w[j] = (unsigned)f2bf(a) | ((unsigned)f2bf(b) << 16);
    }
    *(uint4*)(p.WT + ((size_t)l * NP + n) * 1024 + k8 * 8) = make_uint4(w[0], w[1], w[2], w[3]);
  }
  for (long idx = gtid; idx < 2L * 128 * 1024; idx += gsz) {
    const int d = (int)(idx % 1024), m8 = (int)((idx / 1024) % 128), l = (int)(idx / (1024 * 128));
    unsigned w[4];
    for (int j = 0; j < 4; ++j) {
      float a = p.w_out[((size_t)l * 1024 + m8 * 8 + 2 * j) * 1024 + d], b = p.w_out[((size_t)l * 1024 + m8 * 8 + 2 * j + 1) * 1024 + d];
      w[j] = (unsigned)f2bf(a) | ((unsigned)f2bf(b) << 16);
    }
    *(uint4*)(p.WOT + ((size_t)l * 1024 + d) * 1024 + m8 * 8) = make_uint4(w[0], w[1], w[2], w[3]);
  }
  for (long idx = gtid; idx < 4L * 256 * 64; idx += gsz) {
    const int j = (int)(idx % 64), i8 = (int)((idx / 64) % 256), lk = (int)(idx / (64 * 256));
    unsigned w[4];
    for (int e = 0; e < 4; ++e) {
      const float a = p.w1[((size_t)lk * 2048 + i8 * 8 + 2 * e) * 64 + j], b = p.w1[((size_t)lk * 2048 + i8 * 8 + 2 * e + 1) * 64 + j];
      w[e] = (unsigned)f2bf(a) | ((unsigned)f2bf(b) << 16);
    }
    *(uint4*)(p.W1T + ((size_t)lk * 64 + j) * 2048 + i8 * 8) = make_uint4(w[0], w[1], w[2], w[3]);
  }
  for (long idx = gtid; idx < 4L * 64 * 64; idx += gsz) {
    const int jo = (int)(idx % 64), ji = (int)((idx / 64) % 64), lk = (int)(idx / 4096);
    p.W2T[((size_t)lk * 64 + jo) * 64 + ji] = f2bf(p.w2[((size_t)lk * 64 + ji) * 64 + jo]);
  }
  if (bid < 4) {
    const int lk = bid, j = tid_opaque() & 63, part = tid_opaque() >> 6;
    float a = 0.f;
    for (int i = part * 512; i < part * 512 + 512; ++i) a += p.pe[(size_t)lk * 2048 + i] * p.w1[((size_t)lk * 2048 + i) * 64 + j];
    float* red = (float*)smem;
    red[part * 64 + j] = a;
    __syncthreads();
    if (part == 0) p.CVEC[lk * 64 + j] = (red[j] + red[64 + j]) + (red[128 + j] + red[192 + j]);
    __syncthreads();
  }
  for (long idx = gtid; idx < 2L * NP; idx += gsz) {
    const int n = (int)(idx % NP), l = (int)(idx / NP); const int oc = orig_col(n);
    p.BIASP[idx] = oc >= 0 ? p.b_in[l * 3988 + oc] : 0.f;
  }
  for (long idx = gtid; idx < (long)T * 32; idx += gsz) {
    const int t = (int)(idx / 32), i = (int)(idx % 32);
    const float inv = powf(10000.0f, -(float)i / 32.0f);
    const float ang = (float)t * inv;
    p.ROPEC[idx] = cosf(ang); p.ROPES[idx] = sinf(ang);
  }
  for (long idx = gtid; idx < 512; idx += gsz) {
    const int c = (int)(idx % 256), l = (int)(idx / 256);
    const float a = p.c_lb[c], b = p.c_lb[256 + c];
    const float m = fmaxf(a, b); const float ea = expf(a - m), eb = expf(b - m);
    p.LB[idx] = l == 0 ? 0.f : eb / (ea + eb);
  }
}

DI void ln_rows(const Params& p, int mode, int layer, int bid, int nblk) {
  const int tid_ = tid_opaque(); const int lane = tid_ & 63, wid = tid_ >> 6, nw = 4;
  const float* g = mode == 0 ? p.ln0_g : p.ln_g + layer * 1024;
  const float* bb = mode == 0 ? p.ln0_b : p.ln_b + layer * 1024;
  const float* src = mode == 0 ? p.x : p.hf;
  for (int row = bid * nw + wid; row < NTOK; row += nblk * nw) {
    const float* s = src + (size_t)row * 1024;
    float4 v[4];
    float sum = 0.f;
#pragma unroll
    for (int i = 0; i < 4; ++i) { v[i] = *(const float4*)(s + i * 256 + lane * 4); sum += (v[i].x + v[i].y) + (v[i].z + v[i].w); }
    sum = wave_sum(sum);
    const float mu = sum * (1.f / 1024.f);
    float q = 0.f;
#pragma unroll
    for (int i = 0; i < 4; ++i) { float a = v[i].x - mu, b = v[i].y - mu, c = v[i].z - mu, d = v[i].w - mu; q += (a * a + b * b) + (c * c + d * d); }
    q = wave_sum(q);
    const float rs = rsqrtf(q * (1.f / 1024.f) + 1e-5f);
#pragma unroll
    for (int i = 0; i < 4; ++i) {
      const int c0 = i * 256 + lane * 4;
      const float4 gg = *(const float4*)(g + c0), b4 = *(const float4*)(bb + c0);
      float4 o;
      o.x = (v[i].x - mu) * rs * gg.x + b4.x; o.y = (v[i].y - mu) * rs * gg.y + b4.y;
      o.z = (v[i].z - mu) * rs * gg.z + b4.z; o.w = (v[i].w - mu) * rs * gg.w + b4.w;
      *(float4*)(p.hf + (size_t)row * 1024 + c0) = o;
      uint2 pk; pk.x = (unsigned)f2bf(o.x) | ((unsigned)f2bf(o.y) << 16); pk.y = (unsigned)f2bf(o.z) | ((unsigned)f2bf(o.w) << 16);
      *(uint2*)(p.HB + (size_t)row * 1024 + c0) = pk;
    }
  }
}

enum { K_NONE = 0, K_ROPE, K_PLAIN, K_TR, K_GSILU, K_GSIG, K_SILUH, K_LOGF, K_SMALL };

template <int KIND>
DI void epi_inproj(const Params& p, const f32x16 (&acc)[2][2], bf16_t* dst, float* fdst, float scale, float bias0, float bias1, float lb0, float lb1,
                   int b, int t0, int l31, int h2) {
#pragma unroll
  for (int mt = 0; mt < 2; ++mt) {
#pragma unroll
    for (int r = 0; r < 16; ++r) {
      const int t = t0 + mt * 32 + (r & 3) + 8 * (r >> 2) + 4 * h2;
      const size_t tok = (size_t)b * T + t;
      const float v0 = acc[mt][0][r] + bias0, v1 = acc[mt][1][r] + bias1;
      if (KIND == K_ROPE) {
        const float c = p.ROPEC[t * 32 + l31], s = p.ROPES[t * 32 + l31];
        const float o0 = (v0 * c - v1 * s) * scale, o1 = (v0 * s + v1 * c) * scale;
        dst[(size_t)t * 64 + l31] = f2bf(o0); dst[(size_t)t * 64 + 32 + l31] = f2bf(o1);
      } else if (KIND == K_PLAIN) {
        dst[(size_t)t * 64 + l31] = f2bf(v0); dst[(size_t)t * 64 + 32 + l31] = f2bf(v1);
      } else if (KIND == K_SILUH) {
        dst[(size_t)t * 64 + l31] = f2bf(siluf_(v0)); dst[(size_t)t * 64 + 32 + l31] = f2bf(siluf_(v1));
      } else if (KIND == K_TR) {
        dst[(size_t)l31 * T + t] = f2bf(v0); dst[(size_t)(l31 + 32) * T + t] = f2bf(v1);
      } else if (KIND == K_GSILU) {
        dst[tok * 256 + l31] = f2bf(siluf_(v0)); dst[tok * 256 + 32 + l31] = f2bf(siluf_(v1));
      } else if (KIND == K_GSIG) {
        dst[tok * 256 + l31] = f2bf(sigmoidf_(v0)); dst[tok * 256 + 32 + l31] = f2bf(sigmoidf_(v1));
      } else if (KIND == K_LOGF) {
        const float f0 = lb0 + (1.f - lb0) * sigmoidf_(v0), f1 = lb1 + (1.f - lb1) * sigmoidf_(v1);
        fdst[(size_t)t * 64 + l31] = logf(f0); fdst[(size_t)t * 64 + 32 + l31] = logf(f1);
      } else if (KIND == K_SMALL) {
        if (l31 < 8) p.IFG[tok * 8 + l31] = v0;
        else if (l31 < 20) p.DG[tok * 12 + (l31 - 8)] = sigmoidf_(v0);
      }
    }
  }
}

template <int MODE>
DI void gemm_tile(const Params& p, int layer, int pm, int pn, char* smem) {
  const int tid = tid_opaque(), lane = tid & 63, wid = tid >> 6, wm = wid >> 1, wn = wid & 1;
  const int l31 = lane & 31, h2 = lane >> 5;
  const bf16_t* A = (MODE == 0 ? p.HB : p.YMIX) + (size_t)pm * 128 * 1024;
  const bf16_t* Bt = (MODE == 0 ? p.WT + (size_t)layer * NP * 1024 : p.WOT + (size_t)layer * 1024 * 1024) + (size_t)pn * 128 * 1024;
  bf16_t* sA = (bf16_t*)smem;
  bf16_t* sB = sA + 128 * 72;
  f32x16 acc[2][2];
#pragma unroll
  for (int i = 0; i < 2; ++i)
#pragma unroll
    for (int j = 0; j < 2; ++j)
#pragma unroll
      for (int r = 0; r < 16; ++r) acc[i][j][r] = 0.f;
  const int lr = tid >> 3, lc = (tid & 7) * 8;
  u32x4 ra[4], rb[4];
#pragma unroll
  for (int i = 0; i < 4; ++i) { ra[i] = *(const u32x4*)(A + (size_t)(lr + 32 * i) * 1024 + lc); rb[i] = *(const u32x4*)(Bt + (size_t)(lr + 32 * i) * 1024 + lc); }
  for (int kt = 0; kt < 16; ++kt) {
    __syncthreads();
#pragma unroll
    for (int i = 0; i < 4; ++i) { *(u32x4*)(sA + (lr + 32 * i) * 72 + lc) = ra[i]; *(u32x4*)(sB + (lr + 32 * i) * 72 + lc) = rb[i]; }
    __syncthreads();
    if (kt + 1 < 16) {
#pragma unroll
      for (int i = 0; i < 4; ++i) { ra[i] = *(const u32x4*)(A + (size_t)(lr + 32 * i) * 1024 + (kt + 1) * 64 + lc); rb[i] = *(const u32x4*)(Bt + (size_t)(lr + 32 * i) * 1024 + (kt + 1) * 64 + lc); }
    }
#pragma unroll
    for (int ks = 0; ks < 4; ++ks) {
      bf16x8 af[2], bfr[2];
#pragma unroll
      for (int mt = 0; mt < 2; ++mt) af[mt] = *(const bf16x8*)(sA + (wm * 64 + mt * 32 + l31) * 72 + ks * 16 + h2 * 8);
#pragma unroll
      for (int nt = 0; nt < 2; ++nt) bfr[nt] = *(const bf16x8*)(sB + (wn * 64 + nt * 32 + l31) * 72 + ks * 16 + h2 * 8);
#pragma unroll
      for (int mt = 0; mt < 2; ++mt)
#pragma unroll
        for (int nt = 0; nt < 2; ++nt) acc[mt][nt] = __builtin_amdgcn_mfma_f32_32x32x16_bf16(af[mt], bfr[nt], acc[mt][nt], 0, 0, 0);
    }
  }
  if (MODE == 1) {
#pragma unroll
    for (int mt = 0; mt < 2; ++mt)
#pragma unroll
      for (int nt = 0; nt < 2; ++nt)
#pragma unroll
        for (int r = 0; r < 16; ++r) {
          const int row = pm * 128 + wm * 64 + mt * 32 + (r & 3) + 8 * (r >> 2) + 4 * h2;
          const int col = pn * 128 + wn * 64 + nt * 32 + l31;
          float* dst = p.hf + (size_t)row * 1024 + col;
          *dst = DN_ALPHA * (*dst) + acc[mt][nt][r];
        }
    return;
  }
  const int hd = pn * 2 + wn;
  const int b = pm >> 4, t0 = (pm & 15) * 128 + wm * 64;
  int kind = K_NONE; bf16_t* dst = nullptr; float scale = 1.f; float* fdst = nullptr;
  if (hd < 4) { kind = K_ROPE; dst = p.QA + ((size_t)(b * 4 + hd) * T) * 64; scale = 0.125f; }
  else if (hd < 6) { kind = K_ROPE; dst = p.KA + ((size_t)(b * 2 + hd - 4) * T) * 64; }
  else if (hd < 8) { kind = K_TR; dst = p.VAT + (size_t)(b * 2 + hd - 6) * 64 * T; }
  else if (hd < 12) { kind = K_GSILU; dst = p.GZ + (size_t)0 * NTOK * 256 + (hd - 8) * 64; }
  else if (hd < 20) { kind = K_PLAIN; dst = p.QKB + ((size_t)(b * 8 + hd - 12) * T) * 64; }
  else if (hd < 24) { kind = K_TR; dst = p.VBT + (size_t)(b * 4 + hd - 20) * 64 * T; }
  else if (hd < 28) { kind = K_GSIG; dst = p.GZ + (size_t)1 * NTOK * 256 + (hd - 24) * 64; }
  else if (hd < 32) { kind = K_GSILU; dst = p.GZ + (size_t)2 * NTOK * 256 + (hd - 28) * 64; }
  else if (hd < 36) { kind = K_SILUH; dst = p.QC + ((size_t)(b * 4 + hd - 32) * T) * 64; }
  else if (hd < 40) { kind = K_LOGF; fdst = p.GC + ((size_t)(b * 4 + hd - 36) * T) * 64; }
  else if (hd < 44) { kind = K_TR; dst = p.VCT + (size_t)(b * 4 + hd - 40) * 64 * T; }
  else if (hd < 48) { kind = K_GSILU; dst = p.GZ + (size_t)3 * NTOK * 256 + (hd - 44) * 64; }
  else if (hd < 52) { kind = K_ROPE; dst = p.QD + ((size_t)(b * 4 + hd - 48) * T) * 64; scale = 0.125f; }
  else if (hd < 58) {
    const int j = hd - 52;
    dst = p.KV + (size_t)(j * NB + b) * T * 64;
    kind = (j == 0 || j == 1) ? K_PLAIN : ((j == 2 || j == 4) ? K_ROPE : K_TR);
  }
  else if (hd < 62) { kind = K_GSILU; dst = p.GZ + (size_t)4 * NTOK * 256 + (hd - 58) * 64; }
  else if (hd == 62) { kind = K_SMALL; }
  if (kind == K_NONE) return;
  const float bias0 = p.BIASP[layer * NP + hd * 64 + l31], bias1 = p.BIASP[layer * NP + hd * 64 + 32 + l31];
  float lb0 = 0.f, lb1 = 0.f;
  if (kind == K_LOGF) { lb0 = p.LB[layer * 256 + (hd - 36) * 64 + l31]; lb1 = p.LB[layer * 256 + (hd - 36) * 64 + 32 + l31]; }
  switch (kind) {
    case K_ROPE: epi_inproj<K_ROPE>(p, acc, dst, fdst, scale, bias0, bias1, lb0, lb1, b, t0, l31, h2); break;
    case K_PLAIN: epi_inproj<K_PLAIN>(p, acc, dst, fdst, scale, bias0, bias1, lb0, lb1, b, t0, l31, h2); break;
    case K_TR: epi_inproj<K_TR>(p, acc, dst, fdst, scale, bias0, bias1, lb0, lb1, b, t0, l31, h2); break;
    case K_GSILU: epi_inproj<K_GSILU>(p, acc, dst, fdst, scale, bias0, bias1, lb0, lb1, b, t0, l31, h2); break;
    case K_GSIG: epi_inproj<K_GSIG>(p, acc, dst, fdst, scale, bias0, bias1, lb0, lb1, b, t0, l31, h2); break;
    case K_SILUH: epi_inproj<K_SILUH>(p, acc, dst, fdst, scale, bias0, bias1, lb0, lb1, b, t0, l31, h2); break;
    case K_LOGF: epi_inproj<K_LOGF>(p, acc, dst, fdst, scale, bias0, bias1, lb0, lb1, b, t0, l31, h2); break;
    case K_SMALL: epi_inproj<K_SMALL>(p, acc, dst, fdst, scale, bias0, bias1, lb0, lb1, b, t0, l31, h2); break;
    default: break;
  }
}

template <int MODE>
DI void ph_gemm(const Params& p, int layer, int bid, int nblk, char* smem) {
  const int ntn = MODE == 0 ? 32 : 8;
  const int ntiles = 512 * ntn;
  for (int tile = bid; tile < ntiles; tile += nblk) gemm_tile<MODE>(p, layer, tile / ntn, tile % ntn, smem);
}

DI void ph_naiveA(const Params& p, int layer, int bid, int nblk, char* smem) {
  float (*ps)[128] = (float (*)[128])smem;
  const int tid_ = tid_opaque(); const int lane = tid_ & 63, h = tid_ >> 6;
  for (int tok = bid; tok < NTOK; tok += nblk) {
    const int b = tok / T, t = tok % T, g = h >> 1;
    const bf16_t* q = p.QA + ((size_t)(b * 4 + h) * T + t) * 64;
    const bf16_t* K = p.KA + (size_t)(b * 2 + g) * T * 64;
    const bf16_t* VT = p.VAT + (size_t)(b * 2 + g) * 64 * T;
    float sc[2];
    for (int i = 0; i < 2; ++i) {
      const int s = t - 127 + lane + 64 * i;
      float d = -INFINITY;
      if (s >= 0) { d = 0.f; for (int e = 0; e < 64; ++e) d += bf2f(q[e]) * bf2f(K[(size_t)s * 64 + e]); }
      sc[i] = d;
    }
    const float sink = p.a_sinks[layer * 4 + h];
    float m = fmaxf(wave_max(fmaxf(sc[0], sc[1])), sink);
    const float e0 = __expf(sc[0] - m), e1 = __expf(sc[1] - m);
    const float l = wave_sum(e0 + e1) + __expf(sink - m);
    __syncthreads();
    ps[h][lane] = e0; ps[h][lane + 64] = e1;
    __syncthreads();
    float o = 0.f;
    for (int j = 0; j < 128; ++j) { const int s = t - 127 + j; if (s >= 0) o += ps[h][j] * bf2f(VT[(size_t)lane * T + s]); }
    o /= l;
    const float gz = bf2f(p.GZ[(size_t)0 * NTOK * 256 + (size_t)tok * 256 + h * 64 + lane]);
    p.YMIX[(size_t)tok * 1024 + h * 64 + lane] = f2bf(o * gz);
  }
}

DI void ph_naiveB(const Params& p, int layer, int bid, int nblk, char* smem) {
  float* qs = (float*)smem; float* ks = qs + 2048; float* vs = ks + 2048; float* ig = vs + 2048; float* fg = ig + 32;
  const int tid = tid_opaque(), v = tid >> 2, kq = tid & 3;
  for (int item = bid; item < NB * 4; item += nblk) {
    const int b = item >> 2, hh = item & 3;
    float C[16], n[16];
    for (int i = 0; i < 16; ++i) { C[i] = 0.f; n[i] = 0.f; }
    const bf16_t* rawq = p.QKB + ((size_t)(b * 8 + hh) * T) * 64;
    const bf16_t* rawk = p.QKB + ((size_t)(b * 8 + 4 + hh) * T) * 64;
    const float* cw = p.conv_w + layer * 4 * 512; const float* cb = p.conv_b + layer * 512;
    for (int t0 = 0; t0 < T; t0 += 32) {
      __syncthreads();
      for (int e = tid; e < 2 * 32 * 64; e += 256) {
        const int which = e / 2048, tt = (e % 2048) / 64, d = e % 64, t = t0 + tt;
        const bf16_t* raw = which ? rawk : rawq; const int ch = (which ? 256 : 0) + hh * 64 + d;
        float a = cb[ch];
        for (int j = 0; j < 4; ++j) { const int ts = t - 3 + j; if (ts >= 0) a += cw[j * 512 + ch] * bf2f(raw[(size_t)ts * 64 + d]); }
        float sv = siluf_(a); if (!which) sv *= 0.125f;
        (which ? ks : qs)[tt * 64 + d] = sv;
      }
      for (int e = tid; e < 32 * 64; e += 256) { const int tt = e / 64, d = e % 64; vs[tt * 64 + d] = bf2f(p.VBT[((size_t)(b * 4 + hh) * 64 + d) * T + t0 + tt]); }
      if (tid < 32) { const size_t tok = (size_t)b * T + t0 + tid; ig[tid] = p.IFG[tok * 8 + hh]; fg[tid] = sigmoidf_(p.IFG[tok * 8 + 4 + hh]); }
      __syncthreads();
      for (int tt = 0; tt < 32; ++tt) {
        const float f = fg[tt], iw = __expf(ig[tt]); const float vv = vs[tt * 64 + v] * iw;
        float num = 0.f, den = 0.f;
#pragma unroll
        for (int kk = 0; kk < 16; ++kk) {
          const float kv = ks[tt * 64 + kq * 16 + kk], qv = qs[tt * 64 + kq * 16 + kk];
          C[kk] = f * C[kk] + vv * kv; n[kk] = f * n[kk] + iw * kv; num += C[kk] * qv; den += n[kk] * qv;
        }
        num += __shfl_xor(num, 1); num += __shfl_xor(num, 2); den += __shfl_xor(den, 1); den += __shfl_xor(den, 2);
        const float hval = num / fmaxf(fabsf(den), 1.f);
        if (kq == 0) {
          const size_t tok = (size_t)b * T + t0 + tt; const int col = hh * 64 + v;
          const float y = bf2f(p.GZ[(size_t)1 * NTOK * 256 + tok * 256 + col]) * hval * bf2f(p.GZ[(size_t)2 * NTOK * 256 + tok * 256 + col]);
          p.YMIX[tok * 1024 + 256 + col] = f2bf(y);
        }
      }
    }
  }
}

DI void ph_naiveC(const Params& p, int layer, int bid, int nblk, char* smem) {
  float* qs = (float*)smem; float* fs = qs + 2048; float* vs = fs + 2048; float* os = vs + 2048;
  const int tid = tid_opaque(), v = tid >> 2, kq = tid & 3;
  for (int item = bid; item < NB * 4; item += nblk) {
    const int b = item >> 2, hh = item & 3;
    float S[16];
    for (int i = 0; i < 16; ++i) S[i] = 0.f;
    for (int t0 = 0; t0 < T; t0 += 32) {
      __syncthreads();
      for (int e = tid; e < 32 * 64; e += 256) {
        const int tt = e / 64, d = e % 64;
        const size_t off = ((size_t)(b * 4 + hh) * T + t0 + tt) * 64 + d;
        qs[e] = bf2f(p.QC[off]); fs[e] = __expf(p.GC[off]);
        vs[e] = bf2f(p.VCT[((size_t)(b * 4 + hh) * 64 + d) * T + t0 + tt]);
      }
      __syncthreads();
      for (int tt = 0; tt < 32; ++tt) {
        const float vv = vs[tt * 64 + v];
        float o = 0.f;
#pragma unroll
        for (int kk = 0; kk < 16; ++kk) {
          const float f = fs[tt * 64 + kq * 16 + kk], qv = qs[tt * 64 + kq * 16 + kk];
          S[kk] = f * S[kk] + (1.f - f) * vv; o += qv * S[kk];
        }
        o += __shfl_xor(o, 1); o += __shfl_xor(o, 2);
        if (kq == 0) os[tt * 64 + v] = o;
      }
      __syncthreads();
      {
        const int tt = tid >> 3, j = tid & 7;
        float ss = 0.f;
        for (int i = 0; i < 8; ++i) { const float o = os[tt * 64 + j * 8 + i]; ss += o * o; }
        ss += __shfl_xor(ss, 1); ss += __shfl_xor(ss, 2); ss += __shfl_xor(ss, 4);
        const float rs = rsqrtf(ss * (1.f / 64.f) + 1e-6f);
        const size_t tok = (size_t)b * T + t0 + tt;
        for (int i = 0; i < 8; ++i) {
          const int col = hh * 64 + j * 8 + i;
          const float y = os[tt * 64 + j * 8 + i] * rs * p.c_norm_g[layer * 256 + col] * bf2f(p.GZ[(size_t)3 * NTOK * 256 + tok * 256 + col]);
          p.YMIX[tok * 1024 + 512 + col] = f2bf(y);
        }
      }
    }
  }
}

DI void ph_naive_cmp(const Params& p, int layer, int bid, int nblk, char* smem) {
  float (*hs)[64] = (float (*)[64])smem; float (*os)[64] = (float (*)[64])(smem + 512);
  const int tid = tid_opaque(), kvsel = (tid >> 6) & 1, j = tid & 63;
  const bool act = tid < 128;
  for (int item = bid; item < NB * 127; item += nblk) {
    const int b = item / 127, n = item % 127;
    const bf16_t* src = p.KV + ((size_t)(kvsel * NB + b) * T + 16 * n) * 64;
    const float* w1 = p.w1 + ((size_t)(layer * 2 + kvsel) * 2048) * 64;
    const float* pe = p.pe + (size_t)(layer * 2 + kvsel) * 2048;
    float a = 0.f;
    if (act) for (int i = 0; i < 2048; ++i) a += (bf2f(src[i]) + pe[i]) * w1[(size_t)i * 64 + j];
    __syncthreads();
    if (act) hs[kvsel][j] = siluf_(a);
    __syncthreads();
    const float* w2 = p.w2 + (size_t)(layer * 2 + kvsel) * 4096;
    float o = 0.f;
    if (act) { for (int i = 0; i < 64; ++i) o += hs[kvsel][i] * w2[i * 64 + j]; os[kvsel][j] = o; }
    __syncthreads();
    if (act) {
      if (kvsel == 0) {
        if (j < 32) {
          const int pos = 16 * n + 31;
          const float c = p.ROPEC[pos * 32 + j], s = p.ROPES[pos * 32 + j];
          const float x1 = os[0][j], x2 = os[0][j + 32];
          p.KCMP[((size_t)b * 128 + n) * 64 + j] = f2bf(x1 * c - x2 * s);
          p.KCMP[((size_t)b * 128 + n) * 64 + 32 + j] = f2bf(x1 * s + x2 * c);
        }
      } else {
        p.VCMPT[((size_t)b * 64 + j) * 128 + n] = f2bf(o);
      }
    }
  }
}

DI float dot64_lds(const float* q, const bf16_t* kp) {
  float d = 0.f;
#pragma unroll
  for (int e8 = 0; e8 < 8; ++e8) {
    const u32x4 w = *(const u32x4*)(kp + e8 * 8);
#pragma unroll
    for (int j = 0; j < 4; ++j) { d += q[e8 * 8 + 2 * j] * __uint_as_float(w[j] << 16); d += q[e8 * 8 + 2 * j + 1] * __uint_as_float(w[j] & 0xffff0000u); }
  }
  return d;
}
DI void ph_naiveD(const Params& p, int layer, int* ctr, char* smem) {
  float (*pc)[128] = (float (*)[128])smem; float* impv = (float*)(smem + 2048); float (*pbuf)[512] = (float (*)[512])(smem + 2048 + 128);
  float (*qsh)[64] = (float (*)[64])(smem + 2048 + 128 + 8192); int* selblk = (int*)(smem + 2048 + 128 + 8192 + 1024); int* s_item = selblk + 8;
  const int tid = tid_opaque(), lane = tid & 63, h = tid >> 6;
  for (;;) {
    __syncthreads();
    if (tid == 0) *s_item = atomicAdd(ctr, 1);
    __syncthreads();
    const int tok = *s_item;
    if (tok >= NTOK) break;
    const int b = tok / T, t = tok % T, cur = t >> 6;
    __syncthreads();
    qsh[h][lane] = bf2f(p.QD[((size_t)(b * 4 + h) * T + t) * 64 + lane]);
    __syncthreads();
    const float* q = qsh[h];
    float o_cmp;
    {
      float sc0 = -INFINITY, sc1 = -INFINITY;
      { const int n = lane; if (16 * n + 31 <= t) sc0 = dot64_lds(q, p.KCMP + ((size_t)b * 128 + n) * 64); }
      { const int n = lane + 64; if (n < 127 && 16 * n + 31 <= t) sc1 = dot64_lds(q, p.KCMP + ((size_t)b * 128 + n) * 64); }
      const float m = wave_max(fmaxf(sc0, sc1));
      float e0 = 0.f, e1 = 0.f;
      if (m > -INFINITY) { e0 = __expf(sc0 - m); e1 = __expf(sc1 - m); }
      const float l = wave_sum(e0 + e1);
      const float il = l > 0.f ? 1.f / l : 0.f;
      pc[h][lane] = e0 * il; pc[h][lane + 64] = e1 * il;
      __syncthreads();
      float o = 0.f;
      const bf16_t* vp = p.VCMPT + ((size_t)b * 64 + lane) * 128;
#pragma unroll 4
      for (int n = 0; n < 127; ++n) o += pc[h][n] * bf2f(vp[n]);
      o_cmp = o;
    }
    if (tid < 32) {
      const int j = tid;
      float v;
      if (j > cur) v = -1e30f;
      else if (j == 0 || j == cur || j == cur - 1) v = 1e6f;
      else {
        v = 0.f;
#pragma unroll 1
        for (int hh = 0; hh < 4; ++hh)
#pragma unroll 1
          for (int n = 4 * j - 1; n <= 4 * j + 3; ++n) if (n >= 0 && n < 127) v += pc[hh][n];
      }
      impv[j] = v;
    }
    __syncthreads();
    if (tid < 32) {
      const int j = tid; const float vj = impv[j];
      int rank = 0;
#pragma unroll 1
      for (int i = 0; i < 32; ++i) { const float vi = impv[i]; rank += (vi > vj || (vi == vj && i < j)) ? 1 : 0; }
      if (rank < 8) selblk[rank] = j;
    }
    __syncthreads();
    float o_slc;
    {
      float m = -INFINITY;
#pragma unroll 1
      for (int r = 0; r < 8; ++r) {
        const int s = selblk[r] * 64 + lane;
        float d = -INFINITY;
        if (s <= t) d = dot64_lds(q, p.KV + ((size_t)(2 * NB + b) * T + s) * 64);
        pbuf[h][r * 64 + lane] = d; m = fmaxf(m, d);
      }
      m = wave_max(m);
      float l = 0.f;
#pragma unroll 1
      for (int r = 0; r < 8; ++r) { const float e = __expf(pbuf[h][r * 64 + lane] - m); pbuf[h][r * 64 + lane] = e; l += e; }
      l = wave_sum(l);
      __syncthreads();
      float o = 0.f;
      const bf16_t* vp = p.KV + ((size_t)(3 * NB + b) * 64 + lane) * T;
#pragma unroll 1
      for (int r = 0; r < 8; ++r) {
        const int s0 = selblk[r] * 64;
#pragma unroll 4
        for (int kk = 0; kk < 64; ++kk) o += pbuf[h][r * 64 + kk] * bf2f(vp[s0 + kk]);
      }
      o_slc = o / l;
      __syncthreads();
    }
    float o_win;
    {
      float m = -INFINITY;
#pragma unroll 1
      for (int r = 0; r < 8; ++r) {
        const int s = t - 511 + r * 64 + lane;
        float d = -INFINITY;
        if (s >= 0) d = dot64_lds(q, p.KV + ((size_t)(4 * NB + b) * T + s) * 64);
        pbuf[h][r * 64 + lane] = d; m = fmaxf(m, d);
      }
      m = wave_max(m);
      float l = 0.f;
#pragma unroll 1
      for (int r = 0; r < 8; ++r) { const float e = __expf(pbuf[h][r * 64 + lane] - m); pbuf[h][r * 64 + lane] = e; l += e; }
      l = wave_sum(l);
      __syncthreads();
      float o = 0.f;
      const bf16_t* vp = p.KV + ((size_t)(5 * NB + b) * 64 + lane) * T;
#pragma unroll 4
      for (int j = 0; j < 512; ++j) { const int s = t - 511 + j; if (s >= 0) o += pbuf[h][j] * bf2f(vp[s]); }
      o_win = o / l;
    }
    const float g0 = p.DG[(size_t)tok * 12 + h * 3 + 0], g1 = p.DG[(size_t)tok * 12 + h * 3 + 1], g2 = p.DG[(size_t)tok * 12 + h * 3 + 2];
    const float o = g0 * o_cmp + g1 * o_slc + g2 * o_win;
    const float gz = bf2f(p.GZ[(size_t)4 * NTOK * 256 + (size_t)tok * 256 + h * 64 + lane]);
    p.YMIX[(size_t)tok * 1024 + 768 + h * 64 + lane] = f2bf(o * gz);
  }
}


typedef float f32x2 __attribute__((ext_vector_type(2)));
typedef __bf16 bf16v2 __attribute__((ext_vector_type(2)));
typedef unsigned u32x2 __attribute__((ext_vector_type(2)));
DI unsigned pack2(float a, float b) { f32x2 v = {a, b}; return __builtin_bit_cast(unsigned, __builtin_convertvector(v, bf16v2)); }
DI f32x16 zero16() { f32x16 z;
#pragma unroll
  for (int i = 0; i < 16; ++i) z[i] = 0.f; return z; }
DI bf16x8 ld_frag8x2(const bf16_t* p) { const u32x2 lo = *(const u32x2*)p, hi = *(const u32x2*)(p + 8); u32x4 t = {lo.x, lo.y, hi.x, hi.y}; return __builtin_bit_cast(bf16x8, t); }
template <int BASE> DI bf16x8 pack8(const f32x16& s) {
  u32x4 t = {pack2(s[BASE + 0], s[BASE + 1]), pack2(s[BASE + 2], s[BASE + 3]), pack2(s[BASE + 4], s[BASE + 5]), pack2(s[BASE + 6], s[BASE + 7])};
  return __builtin_bit_cast(bf16x8, t);
}
#define MFMA32(a, b, c) __builtin_amdgcn_mfma_f32_32x32x16_bf16((a), (b), (c), 0, 0, 0)
DI f32x16 qk_tile(const bf16_t* Krow, const bf16x8 (&qf)[4], int l31, int h2) {
  f32x16 s = zero16();
  const bf16_t* kp = Krow + l31 * 64 + h2 * 8;
#pragma unroll
  for (int ks = 0; ks < 4; ++ks) { const bf16x8 a = *(const bf16x8*)(kp + ks * 16); s = MFMA32(a, qf[ks], s); }
  return s;
}
DI void softmax_pv(f32x16& s, const bf16_t* VTp, int vstride, f32x16 (&o)[2], float& m, float& l, int l31, int h2) {
  bf16x8 va[2][2];
#pragma unroll
  for (int dt = 0; dt < 2; ++dt)
#pragma unroll
    for (int sk = 0; sk < 2; ++sk) va[dt][sk] = ld_frag8x2(VTp + (size_t)(dt * 32 + l31) * vstride + sk * 16 + 4 * h2);
  float mx = s[0];
#pragma unroll
  for (int r = 1; r < 16; ++r) mx = fmaxf(mx, s[r]);
  mx = fmaxf(mx, __shfl_xor(mx, 32));
  const float mn = fmaxf(m, mx);
  const float alpha = __expf(m - mn);
  float ps = 0.f;
#pragma unroll
  for (int r = 0; r < 16; ++r) { s[r] = __expf(s[r] - mn); ps += s[r]; }
  ps += __shfl_xor(ps, 32);
  l = l * alpha + ps; m = mn;
#pragma unroll
  for (int dt = 0; dt < 2; ++dt)
#pragma unroll
    for (int r = 0; r < 16; ++r) o[dt][r] *= alpha;
  const bf16x8 p0 = pack8<0>(s), p1 = pack8<8>(s);
#pragma unroll
  for (int dt = 0; dt < 2; ++dt) { o[dt] = MFMA32(va[dt][0], p0, o[dt]); o[dt] = MFMA32(va[dt][1], p1, o[dt]); }
}
DI int crow(int r, int h2) { return (r & 3) + 8 * (r >> 2) + 4 * h2; }

DI void ph_attnD(const Params& p, int layer, int* ctr, char* smem) {
  float* imps = (float*)smem;
  float* impf = (float*)(smem + 16384);
  unsigned* smask = (unsigned*)(smem + 20480);
  unsigned* s_union = (unsigned*)(smem + 20480 + 128);
  int* s_item = (int*)(smem + 20480 + 132);
  const int tid = tid_opaque(), lane = tid & 63, h = tid >> 6, l31 = lane & 31, h2 = lane >> 5;
  for (;;) {
    __syncthreads();
    if (tid == 0) { *s_item = atomicAdd(ctr, 1); *s_union = 0u; }
    __syncthreads();
    const int it = *s_item;
    if (it >= 2048) break;
    const int b = it & 31, q0 = (63 - (it >> 5)) * 32;
    const int t = q0 + l31, cur = q0 >> 6;
    const size_t tok = (size_t)b * T + t;
    bf16x8 qf[4];
    {
      const bf16_t* qp = p.QD + ((size_t)(b * 4 + h) * T + t) * 64 + h2 * 8;
#pragma unroll
      for (int ks = 0; ks < 4; ++ks) qf[ks] = *(const bf16x8*)(qp + ks * 16);
    }
    const float g0 = p.DG[tok * 12 + h * 3 + 0], g1 = p.DG[tok * 12 + h * 3 + 1], g2 = p.DG[tok * 12 + h * 3 + 2];
    f32x16 ofin[2];
    {
      const bf16_t* Kc = p.KCMP + (size_t)b * 128 * 64;
      const bf16_t* Vc = p.VCMPT + (size_t)b * 64 * 128;
      const int nkt = min(4, (q0 >> 9) + 1);
      f32x16 s[4];
      float mx = -INFINITY;
#pragma unroll
      for (int kt = 0; kt < 4; ++kt) {
        if (kt < nkt) {
          s[kt] = qk_tile(Kc + kt * 32 * 64, qf, l31, h2);
#pragma unroll
          for (int r = 0; r < 16; ++r) { const int n = kt * 32 + crow(r, h2); if (16 * n + 31 > t) s[kt][r] = -INFINITY; mx = fmaxf(mx, s[kt][r]); }
        } else {
#pragma unroll
          for (int r = 0; r < 16; ++r) s[kt][r] = -INFINITY;
        }
      }
      mx = fmaxf(mx, __shfl_xor(mx, 32));
      const float mref = mx > -INFINITY ? mx : 0.f;
      float ps = 0.f;
#pragma unroll
      for (int kt = 0; kt < 4; ++kt)
#pragma unroll
        for (int r = 0; r < 16; ++r) { s[kt][r] = __expf(s[kt][r] - mref); ps += s[kt][r]; }
      ps += __shfl_xor(ps, 32);
      const float il = ps > 0.f ? 1.f / ps : 0.f;
#pragma unroll
      for (int kt = 0; kt < 4; ++kt)
#pragma unroll
        for (int r = 0; r < 16; ++r) s[kt][r] *= il;
      f32x16 oc[2]; oc[0] = zero16(); oc[1] = zero16();
#pragma unroll
      for (int kt = 0; kt < 4; ++kt) {
        if (kt < nkt) {
          const bf16x8 p0 = pack8<0>(s[kt]), p1 = pack8<8>(s[kt]);
#pragma unroll
          for (int dt = 0; dt < 2; ++dt) {
            const bf16_t* vp = Vc + (size_t)(dt * 32 + l31) * 128 + kt * 32 + 4 * h2;
            oc[dt] = MFMA32(ld_frag8x2(vp), p0, oc[dt]);
            oc[dt] = MFMA32(ld_frag8x2(vp + 16), p1, oc[dt]);
          }
        }
      }
#pragma unroll
      for (int dt = 0; dt < 2; ++dt)
#pragma unroll
        for (int r = 0; r < 16; ++r) ofin[dt][r] = g0 * oc[dt][r];
      float X[4][4];
#pragma unroll
      for (int kt = 0; kt < 4; ++kt)
#pragma unroll
        for (int g = 0; g < 4; ++g) X[kt][g] = __shfl_xor(s[kt][4 * g + 3], 32);
#pragma unroll
      for (int kt = 0; kt < 4; ++kt)
#pragma unroll
        for (int g = 0; g < 4; ++g) {
          const float G = (s[kt][4 * g] + s[kt][4 * g + 1]) + (s[kt][4 * g + 2] + s[kt][4 * g + 3]);
          const float prev_same = X[kt][g];
          const float prev_other = g > 0 ? X[kt][g - 1] : (kt > 0 ? X[kt - 1][3] : 0.f);
          const float v = G + (h2 ? prev_same : prev_other);
          imps[(h * 32 + l31) * 32 + 8 * kt + 2 * g + h2] = v;
        }
    }
    __syncthreads();
    {
      const int tt = tid >> 3, jg = tid & 7;
#pragma unroll
      for (int i = 0; i < 4; ++i) {
        const int j = jg * 4 + i;
        impf[tt * 32 + j] = (imps[(0 * 32 + tt) * 32 + j] + imps[(1 * 32 + tt) * 32 + j]) + (imps[(2 * 32 + tt) * 32 + j] + imps[(3 * 32 + tt) * 32 + j]);
      }
    }
    __syncthreads();
    {
      const int tt = tid >> 3, jg = tid & 7;
      float v[32];
#pragma unroll
      for (int j = 0; j < 32; ++j) {
        float x = impf[tt * 32 + j];
        if (j > cur) x = -1e30f; else if (j == 0 || j == cur || j == cur - 1) x = 1e6f;
        v[j] = x;
      }
      unsigned bits = 0u;
#pragma unroll
      for (int i = 0; i < 4; ++i) {
        int rank = 0; float vj = 0.f;
#pragma unroll
        for (int j = 0; j < 32; ++j) if (j == jg * 4 + i) vj = v[j];
        const int jj = jg * 4 + i;
#pragma unroll
        for (int j = 0; j < 32; ++j) rank += (v[j] > vj || (v[j] == vj && j < jj)) ? 1 : 0;
        if (rank < 8 && jj <= cur) bits |= 1u << jj;
      }
      bits |= __shfl_xor(bits, 1); bits |= __shfl_xor(bits, 2); bits |= __shfl_xor(bits, 4);
      if (jg == 0) { smask[tt] = bits; atomicOr(s_union, bits); }
    }
    __syncthreads();
    {
      const unsigned mymask = smask[l31], uni = *s_union;
      const bf16_t* Ks = p.KV + (size_t)(2 * NB + b) * T * 64;
      const bf16_t* Vs = p.KV + (size_t)(3 * NB + b) * 64 * T;
      f32x16 o[2]; o[0] = zero16(); o[1] = zero16();
      float m = -1e30f, l = 0.f;
      for (int j = 0; j <= cur; ++j) {
        if (!((uni >> j) & 1u)) continue;
        const bool sel = (mymask >> j) & 1u;
        for (int half = 0; half < 2; ++half) {
          const int key0 = j * 64 + half * 32;
          if (key0 > q0 + 31) break;
          f32x16 s = qk_tile(Ks + (size_t)key0 * 64, qf, l31, h2);
#pragma unroll
          for (int r = 0; r < 16; ++r) { const int key = key0 + crow(r, h2); if (!sel || key > t) s[r] = -INFINITY; }
          softmax_pv(s, Vs + key0, T, o, m, l, l31, h2);
        }
      }
      const float il = l > 0.f ? g1 / l : 0.f;
#pragma unroll
      for (int dt = 0; dt < 2; ++dt)
#pragma unroll
        for (int r = 0; r < 16; ++r) ofin[dt][r] += il * o[dt][r];
    }
    {
      const bf16_t* Kw = p.KV + (size_t)(4 * NB + b) * T * 64;
      const bf16_t* Vw = p.KV + (size_t)(5 * NB + b) * 64 * T;
      f32x16 o[2]; o[0] = zero16(); o[1] = zero16();
      float m = -1e30f, l = 0.f;
      for (int key0 = max(0, q0 - 512); key0 <= q0; key0 += 32) {
        f32x16 s = qk_tile(Kw + (size_t)key0 * 64, qf, l31, h2);
        if (key0 == q0 - 512 || key0 == q0) {
#pragma unroll
          for (int r = 0; r < 16; ++r) { const int key = key0 + crow(r, h2); if (key > t || t - key >= 512) s[r] = -INFINITY; }
        }
        softmax_pv(s, Vw + key0, T, o, m, l, l31, h2);
      }
      const float il = l > 0.f ? g2 / l : 0.f;
#pragma unroll
      for (int dt = 0; dt < 2; ++dt)
#pragma unroll
        for (int r = 0; r < 16; ++r) ofin[dt][r] += il * o[dt][r];
    }
#pragma unroll
    for (int dt = 0; dt < 2; ++dt)
#pragma unroll
      for (int g = 0; g < 4; ++g) {
        const int d0 = dt * 32 + 8 * g + 4 * h2;
        const u32x2 gz = *(const u32x2*)(p.GZ + (size_t)4 * NTOK * 256 + tok * 256 + h * 64 + d0);
        const float z0 = __uint_as_float(gz.x << 16), z1 = __uint_as_float(gz.x & 0xffff0000u), z2 = __uint_as_float(gz.y << 16), z3 = __uint_as_float(gz.y & 0xffff0000u);
        u32x2 o2 = {pack2(ofin[dt][4 * g] * z0, ofin[dt][4 * g + 1] * z1), pack2(ofin[dt][4 * g + 2] * z2, ofin[dt][4 * g + 3] * z3)};
        *(u32x2*)(p.YMIX + tok * 1024 + 768 + h * 64 + d0) = o2;
      }
  }
}


DI float logsigmoidf_(float x) { return x >= 0.f ? -log1pf(__expf(-x)) : x - log1pf(__expf(x)); }
DI void mlstm_gates(const Params& p, size_t tok0, int hh, float* bc, float* ig, int tid) {
  if (tid < 64) {
    const int s0 = 2 * tid;
    const float lf0 = logsigmoidf_(p.IFG[(tok0 + s0) * 8 + 4 + hh]), lf1 = logsigmoidf_(p.IFG[(tok0 + s0 + 1) * 8 + 4 + hh]);
    const float pair = lf0 + lf1;
    float x = pair;
#pragma unroll
    for (int off = 1; off < 64; off <<= 1) { const float y = __shfl_up(x, off); if (tid >= off) x += y; }
    const float excl = x - pair;
    bc[s0] = excl + lf0; bc[s0 + 1] = excl + pair;
    ig[s0] = p.IFG[(tok0 + s0) * 8 + hh]; ig[s0 + 1] = p.IFG[(tok0 + s0 + 1) * 8 + hh];
  }
}
DI void conv8(const bf16_t* raw, int t, int dg, const float (&cw)[4][8], const float (&cb)[8], float (&out)[8]) {
#pragma unroll
  for (int e = 0; e < 8; ++e) out[e] = cb[e];
#pragma unroll
  for (int j = 0; j < 4; ++j) {
    const int ts = t - 3 + j;
    if (ts >= 0) {
      const u32x4 row = *(const u32x4*)(raw + (size_t)ts * 64 + dg * 8);
#pragma unroll
      for (int e2 = 0; e2 < 4; ++e2) { out[2 * e2] += cw[j][2 * e2] * __uint_as_float(row[e2] << 16); out[2 * e2 + 1] += cw[j][2 * e2 + 1] * __uint_as_float(row[e2] & 0xffff0000u); }
    }
  }
#pragma unroll
  for (int e = 0; e < 8; ++e) out[e] = siluf_(out[e]);
}
DI void load_conv_w(const Params& p, int layer, int ch0, int dg, float (&cw)[4][8], float (&cb)[8]) {
#pragma unroll
  for (int j = 0; j < 4; ++j)
#pragma unroll
    for (int e = 0; e < 8; ++e) cw[j][e] = p.conv_w[layer * 2048 + j * 512 + ch0 + dg * 8 + e];
#pragma unroll
  for (int e = 0; e < 8; ++e) cb[e] = p.conv_b[layer * 512 + ch0 + dg * 8 + e];
}
DI void delta_state(const bf16_t* VT, const bf16_t* KT, float* out, int wid, int l31, int h2) {
  const int mt = wid >> 1, nt = wid & 1;
  f32x16 acc = zero16();
#pragma unroll
  for (int ks = 0; ks < 8; ++ks) {
    const bf16x8 a = *(const bf16x8*)(VT + (size_t)(mt * 32 + l31) * T + ks * 16 + h2 * 8);
    const bf16x8 bb = *(const bf16x8*)(KT + (nt * 32 + l31) * 136 + ks * 16 + h2 * 8);
    acc = MFMA32(a, bb, acc);
  }
#pragma unroll
  for (int r = 0; r < 16; ++r) out[(mt * 32 + crow(r, h2)) * 64 + nt * 32 + l31] = acc[r];
}
DI void ph_mlstm_local(const Params& p, int layer, int item, char* smem) {
  float* bc = (float*)smem; float* ig = bc + 128; float* wv = ig + 128;
  bf16_t* KwT = (bf16_t*)(smem + 2048);
  float* nred = (float*)(smem + 2048 + 64 * 136 * 2);
  const int tid = tid_opaque(), lane = tid & 63, wid = tid >> 6, l31 = lane & 31, h2 = lane >> 5;
  const int b = item >> 6, hh = (item >> 4) & 3, c = item & 15, t0 = c * 128;
  const size_t tok0 = (size_t)b * T + t0;
  __syncthreads();
  mlstm_gates(p, tok0, hh, bc, ig, tid);
  __syncthreads();
  if (tid < 128) wv[tid] = __expf(bc[127] - bc[tid] + ig[tid]);
  __syncthreads();
  {
    const int dg = tid & 7;
    float cw[4][8], cb[8];
    load_conv_w(p, layer, 256 + hh * 64, dg, cw, cb);
    const bf16_t* raw = p.QKB + ((size_t)(b * 8 + 4 + hh) * T) * 64;
#pragma unroll
    for (int i = 0; i < 4; ++i) {
      const int s = (tid >> 3) + 32 * i;
      float v[8];
      conv8(raw, t0 + s, dg, cw, cb, v);
      const float w = wv[s];
#pragma unroll
      for (int e = 0; e < 8; ++e) KwT[(dg * 8 + e) * 136 + s] = f2bf(v[e] * w);
    }
  }
  __syncthreads();
  delta_state(p.VBT + (size_t)(b * 4 + hh) * 64 * T + t0, KwT, p.BST + (size_t)item * 4096, wid, l31, h2);
  {
    const int k = tid & 63, qd = tid >> 6;
    float a = 0.f;
#pragma unroll 8
    for (int s = 0; s < 32; ++s) a += bf2f(KwT[k * 136 + qd * 32 + s]);
    nred[qd * 64 + k] = a;
  }
  __syncthreads();
  if (tid < 64) p.BN[(size_t)item * 64 + tid] = (nred[tid] + nred[64 + tid]) + (nred[128 + tid] + nred[192 + tid]);
  if (tid == 0) p.BG[item] = bc[127];
}
DI void ph_mlstm_scan(const Params& p, int bh) {
  const int tid = tid_opaque();
  f32x4 C[4];
#pragma unroll
  for (int i = 0; i < 4; ++i) C[i] = (f32x4){0.f, 0.f, 0.f, 0.f};
  float n = 0.f;
  for (int c = 0; c < 16; ++c) {
    const int item = bh * 16 + c;
    const float g = __expf(p.BG[item]);
    f32x4* ptr = (f32x4*)(p.BST + (size_t)item * 4096 + tid * 16);
#pragma unroll
    for (int i = 0; i < 4; ++i) { const f32x4 tmp = ptr[i]; ptr[i] = C[i]; C[i] = g * C[i] + tmp; }
    if (tid < 64) { const float tmp = p.BN[(size_t)item * 64 + tid]; p.BN[(size_t)item * 64 + tid] = n; n = g * n + tmp; }
  }
}
DI f32x16 qk_tile_s(const bf16_t* Krow, int stride, const bf16x8 (&qf)[4], int l31, int h2) {
  f32x16 s = zero16();
  const bf16_t* kp = Krow + l31 * stride + h2 * 8;
#pragma unroll
  for (int ks = 0; ks < 4; ++ks) { const bf16x8 a = *(const bf16x8*)(kp + ks * 16); s = MFMA32(a, qf[ks], s); }
  return s;
}
DI void pv_only(const f32x16& s, const bf16_t* VTp, int vstride, f32x16 (&o)[2], int l31, int h2) {
  const bf16x8 p0 = pack8<0>(s), p1 = pack8<8>(s);
#pragma unroll
  for (int dt = 0; dt < 2; ++dt) {
    const bf16_t* vp = VTp + (size_t)(dt * 32 + l31) * vstride + 4 * h2;
    o[dt] = MFMA32(ld_frag8x2(vp), p0, o[dt]);
    o[dt] = MFMA32(ld_frag8x2(vp + 16), p1, o[dt]);
  }
}
DI bf16x8 frag_from_f32(const float* ptr) {
  const f32x4 a = *(const f32x4*)ptr, b = *(const f32x4*)(ptr + 4);
  u32x4 t = {pack2(a[0], a[1]), pack2(a[2], a[3]), pack2(b[0], b[1]), pack2(b[2], b[3])};
  return __builtin_bit_cast(bf16x8, t);
}
DI void ph_mlstm_out(const Params& p, int layer, int item, char* smem) {
  float* bc = (float*)smem; float* ig = bc + 128;
  bf16_t* qc = (bf16_t*)(smem + 2048);
  bf16_t* kc = qc + 128 * 72;
  const int tid = tid_opaque(), lane = tid & 63, wid = tid >> 6, l31 = lane & 31, h2 = lane >> 5;
  const int b = item >> 6, hh = (item >> 4) & 3, c = item & 15, t0 = c * 128;
  const size_t tok0 = (size_t)b * T + t0;
  __syncthreads();
  mlstm_gates(p, tok0, hh, bc, ig, tid);
  {
    const int dg = tid & 7;
#pragma unroll
    for (int which = 0; which < 2; ++which) {
      float cw[4][8], cb[8];
      load_conv_w(p, layer, which * 256 + hh * 64, dg, cw, cb);
      const bf16_t* raw = p.QKB + ((size_t)(b * 8 + which * 4 + hh) * T) * 64;
      bf16_t* dst = which ? kc : qc;
      const float sc = which ? 1.f : 0.125f;
#pragma unroll
      for (int i = 0; i < 4; ++i) {
        const int s = (tid >> 3) + 32 * i;
        float v[8];
        conv8(raw, t0 + s, dg, cw, cb, v);
        u32x4 w = {pack2(v[0] * sc, v[1] * sc), pack2(v[2] * sc, v[3] * sc), pack2(v[4] * sc, v[5] * sc), pack2(v[6] * sc, v[7] * sc)};
        *(u32x4*)(dst + s * 72 + dg * 8) = w;
      }
    }
  }
  __syncthreads();
  if (tid < 128) ig[tid] = ig[tid] - bc[tid];
  __syncthreads();
  const int tq = 32 * wid + l31;
  bf16x8 qf[4];
#pragma unroll
  for (int ks = 0; ks < 4; ++ks) qf[ks] = *(const bf16x8*)(qc + tq * 72 + ks * 16 + h2 * 8);
  const float bt = bc[tq];
  f32x16 o[2]; o[0] = zero16(); o[1] = zero16();
  float dsum = 0.f;
  const bf16_t* VT = p.VBT + (size_t)(b * 4 + hh) * 64 * T + t0;
  for (int kt = 0; kt <= wid; ++kt) {
    f32x16 s = qk_tile_s(kc + kt * 32 * 72, 72, qf, l31, h2);
#pragma unroll
    for (int r = 0; r < 16; ++r) {
      const int sidx = 32 * kt + crow(r, h2);
      float val = s[r] * __expf(bt + ig[sidx]);
      if (sidx > tq) val = 0.f;
      s[r] = val; dsum += val;
    }
    pv_only(s, VT + kt * 32, T, o, l31, h2);
  }
  dsum += __shfl_xor(dsum, 32);
  const float* Cs = p.BST + (size_t)item * 4096;
  const float* ns = p.BN + (size_t)item * 64;
  f32x16 oi[2]; oi[0] = zero16(); oi[1] = zero16();
  float qn = 0.f;
#pragma unroll
  for (int ks = 0; ks < 4; ++ks) {
#pragma unroll
    for (int dt = 0; dt < 2; ++dt) oi[dt] = MFMA32(frag_from_f32(Cs + (dt * 32 + l31) * 64 + ks * 16 + h2 * 8), qf[ks], oi[dt]);
    const u32x4 qu = __builtin_bit_cast(u32x4, qf[ks]);
    const f32x4 n0 = *(const f32x4*)(ns + ks * 16 + h2 * 8), n1 = *(const f32x4*)(ns + ks * 16 + h2 * 8 + 4);
    qn += __uint_as_float(qu[0] << 16) * n0[0] + __uint_as_float(qu[0] & 0xffff0000u) * n0[1] + __uint_as_float(qu[1] << 16) * n0[2] + __uint_as_float(qu[1] & 0xffff0000u) * n0[3];
    qn += __uint_as_float(qu[2] << 16) * n1[0] + __uint_as_float(qu[2] & 0xffff0000u) * n1[1] + __uint_as_float(qu[3] << 16) * n1[2] + __uint_as_float(qu[3] & 0xffff0000u) * n1[3];
  }
  qn += __shfl_xor(qn, 32);
  const float ebt = __expf(bt);
  const float den = dsum + ebt * qn;
  const float inv = 1.f / fmaxf(fabsf(den), 1.f);
  const size_t tok = tok0 + tq;
#pragma unroll
  for (int dt = 0; dt < 2; ++dt)
#pragma unroll
    for (int g = 0; g < 4; ++g) {
      const int d0 = dt * 32 + 8 * g + 4 * h2;
      const u32x2 g1 = *(const u32x2*)(p.GZ + (size_t)1 * NTOK * 256 + tok * 256 + hh * 64 + d0);
      const u32x2 g2 = *(const u32x2*)(p.GZ + (size_t)2 * NTOK * 256 + tok * 256 + hh * 64 + d0);
      float z[4] = {__uint_as_float(g1.x << 16) * __uint_as_float(g2.x << 16), __uint_as_float(g1.x & 0xffff0000u) * __uint_as_float(g2.x & 0xffff0000u),
                    __uint_as_float(g1.y << 16) * __uint_as_float(g2.y << 16), __uint_as_float(g1.y & 0xffff0000u) * __uint_as_float(g2.y & 0xffff0000u)};
      float hv[4];
#pragma unroll
      for (int i = 0; i < 4; ++i) hv[i] = (o[dt][4 * g + i] + ebt * oi[dt][4 * g + i]) * inv * z[i];
      u32x2 o2 = {pack2(hv[0], hv[1]), pack2(hv[2], hv[3])};
      *(u32x2*)(p.YMIX + tok * 1024 + 256 + hh * 64 + d0) = o2;
    }
}


DI void ph_hgrn_local(const Params& p, int layer, int item, char* smem) {
  float* tot = (float*)smem;
  bf16_t* KdT = (bf16_t*)(smem + 1024);
  const int tid = tid_opaque(), lane = tid & 63, wid = tid >> 6, l31 = lane & 31, h2 = lane >> 5;
  const int b = item >> 6, hh = (item >> 4) & 3, c = item & 15, t0 = c * 128;
  const int k = tid & 63, qd = tid >> 6;
  float al[32], kk[32];
  {
    const float* gp = p.GC + ((size_t)(b * 4 + hh) * T + t0 + 32 * qd) * 64 + k;
    float run = 0.f;
#pragma unroll
    for (int s = 0; s < 32; ++s) { const float g = gp[s * 64]; run += g; al[s] = run; kk[s] = 1.f - __expf(g); }
    __syncthreads();
    tot[qd * 64 + k] = run;
  }
  __syncthreads();
  float off = 0.f, aL = 0.f;
#pragma unroll
  for (int q = 0; q < 4; ++q) { const float v = tot[q * 64 + k]; aL += v; if (q < qd) off += v; }
#pragma unroll
  for (int s8 = 0; s8 < 4; ++s8) {
    float v[8];
#pragma unroll
    for (int e = 0; e < 8; ++e) v[e] = kk[s8 * 8 + e] * __expf(aL - (al[s8 * 8 + e] + off));
    u32x4 w = {pack2(v[0], v[1]), pack2(v[2], v[3]), pack2(v[4], v[5]), pack2(v[6], v[7])};
    *(u32x4*)(KdT + k * 136 + qd * 32 + s8 * 8) = w;
  }
  __syncthreads();
  delta_state(p.VCT + (size_t)(b * 4 + hh) * 64 * T + t0, KdT, p.CST + (size_t)item * 4096, wid, l31, h2);
  if (qd == 0) p.CAL[(size_t)item * 64 + k] = aL;
}
DI void ph_hgrn_scan(const Params& p, int bh) {
  const int tid = tid_opaque();
  f32x4 S[4];
#pragma unroll
  for (int i = 0; i < 4; ++i) S[i] = (f32x4){0.f, 0.f, 0.f, 0.f};
  for (int c = 0; c < 16; ++c) {
    const int item = bh * 16 + c;
    const f32x4* dp = (const f32x4*)(p.CAL + (size_t)item * 64 + (tid & 3) * 16);
    f32x4* ptr = (f32x4*)(p.CST + (size_t)item * 4096 + tid * 16);
#pragma unroll
    for (int i = 0; i < 4; ++i) {
      const f32x4 a = dp[i];
      const f32x4 dec = {__expf(a[0]), __expf(a[1]), __expf(a[2]), __expf(a[3])};
      const f32x4 tmp = ptr[i]; ptr[i] = S[i]; S[i] = dec * S[i] + tmp;
    }
  }
}
DI void ph_hgrn_out(const Params& p, int layer, int item, char* smem) {
  float* a_lds = (float*)smem;
  float* tot = (float*)(smem + 128 * 68 * 4);
  const int tid = tid_opaque(), lane = tid & 63, wid = tid >> 6, l31 = lane & 31, h2 = lane >> 5;
  const int b = item >> 6, hh = (item >> 4) & 3, c = item & 15, t0 = c * 128;
  const size_t hbase = (size_t)(b * 4 + hh) * T + t0;
  {
    const int k = tid & 63, qd = tid >> 6;
    float al[32];
    const float* gp = p.GC + (hbase + 32 * qd) * 64 + k;
    float run = 0.f;
#pragma unroll
    for (int s = 0; s < 32; ++s) { run += gp[s * 64]; al[s] = run; }
    __syncthreads();
    tot[qd * 64 + k] = run;
    __syncthreads();
    float off = 0.f;
#pragma unroll
    for (int q = 0; q < 4; ++q) { const float v = tot[q * 64 + k]; if (q < qd) off += v; }
#pragma unroll
    for (int s = 0; s < 32; ++s) a_lds[(32 * qd + s) * 68 + k] = al[s] + off;
  }
  __syncthreads();
  const int tq = 32 * wid + l31;
  bf16x8 qi[4], qh[4];
#pragma unroll
  for (int ks = 0; ks < 4; ++ks) {
    const int k0 = ks * 16 + h2 * 8;
    const u32x4 qu = *(const u32x4*)(p.QC + (hbase + tq) * 64 + k0);
    float q8[8], e1[8], e2[8];
#pragma unroll
    for (int e2i = 0; e2i < 4; ++e2i) { q8[2 * e2i] = __uint_as_float(qu[e2i] << 16); q8[2 * e2i + 1] = __uint_as_float(qu[e2i] & 0xffff0000u); }
#pragma unroll
    for (int e = 0; e < 8; ++e) {
      const float a = a_lds[tq * 68 + k0 + e];
      const float r = wid > 0 ? a_lds[(32 * wid - 1) * 68 + k0 + e] : 0.f;
      e1[e] = q8[e] * __expf(a - r); e2[e] = q8[e] * __expf(a);
    }
    u32x4 w1 = {pack2(e1[0], e1[1]), pack2(e1[2], e1[3]), pack2(e1[4], e1[5]), pack2(e1[6], e1[7])};
    u32x4 w2 = {pack2(e2[0], e2[1]), pack2(e2[2], e2[3]), pack2(e2[4], e2[5]), pack2(e2[6], e2[7])};
    qi[ks] = __builtin_bit_cast(bf16x8, w1); qh[ks] = __builtin_bit_cast(bf16x8, w2);
  }
  f32x16 o[2]; o[0] = zero16(); o[1] = zero16();
  const bf16_t* VT = p.VCT + (size_t)(b * 4 + hh) * 64 * T + t0;
  for (int kt = 0; kt <= wid; ++kt) {
    f32x16 s = zero16();
    const int srow = 32 * kt + l31;
#pragma unroll
    for (int ks = 0; ks < 4; ++ks) {
      const int k0 = ks * 16 + h2 * 8;
      const f32x4 g0 = *(const f32x4*)(p.GC + (hbase + srow) * 64 + k0), g1 = *(const f32x4*)(p.GC + (hbase + srow) * 64 + k0 + 4);
      float v[8];
#pragma unroll
      for (int e = 0; e < 8; ++e) {
        const float g = e < 4 ? g0[e] : g1[e - 4];
        const float a = a_lds[srow * 68 + k0 + e];
        const float r = wid > 0 ? a_lds[(32 * wid - 1) * 68 + k0 + e] : 0.f;
        v[e] = (1.f - __expf(g)) * __expf(fminf(r - a, 80.f));
      }
      u32x4 w = {pack2(v[0], v[1]), pack2(v[2], v[3]), pack2(v[4], v[5]), pack2(v[6], v[7])};
      s = MFMA32(__builtin_bit_cast(bf16x8, w), qi[ks], s);
    }
    if (kt == wid) {
#pragma unroll
      for (int r = 0; r < 16; ++r) if (32 * kt + crow(r, h2) > tq) s[r] = 0.f;
    }
    pv_only(s, VT + kt * 32, T, o, l31, h2);
  }
  {
    const float* Ss = p.CST + (size_t)item * 4096;
#pragma unroll
    for (int ks = 0; ks < 4; ++ks)
#pragma unroll
      for (int dt = 0; dt < 2; ++dt) o[dt] = MFMA32(frag_from_f32(Ss + (dt * 32 + l31) * 64 + ks * 16 + h2 * 8), qh[ks], o[dt]);
  }
  float ss = 0.f;
#pragma unroll
  for (int dt = 0; dt < 2; ++dt)
#pragma unroll
    for (int r = 0; r < 16; ++r) ss += o[dt][r] * o[dt][r];
  ss += __shfl_xor(ss, 32);
  const float rs = rsqrtf(ss * (1.f / 64.f) + 1e-6f);
  const size_t tok = (size_t)b * T + t0 + tq;
#pragma unroll
  for (int dt = 0; dt < 2; ++dt)
#pragma unroll
    for (int g = 0; g < 4; ++g) {
      const int d0 = dt * 32 + 8 * g + 4 * h2;
      const u32x2 gz = *(const u32x2*)(p.GZ + (size_t)3 * NTOK * 256 + tok * 256 + hh * 64 + d0);
      const f32x4 gn = *(const f32x4*)(p.c_norm_g + layer * 256 + hh * 64 + d0);
      const float z0 = __uint_as_float(gz.x << 16), z1 = __uint_as_float(gz.x & 0xffff0000u), z2 = __uint_as_float(gz.y << 16), z3 = __uint_as_float(gz.y & 0xffff0000u);
      u32x2 o2 = {pack2(o[dt][4 * g] * rs * gn[0] * z0, o[dt][4 * g + 1] * rs * gn[1] * z1), pack2(o[dt][4 * g + 2] * rs * gn[2] * z2, o[dt][4 * g + 3] * rs * gn[3] * z3)};
      *(u32x2*)(p.YMIX + tok * 1024 + 512 + hh * 64 + d0) = o2;
    }
}


DI void ph_attnA(const Params& p, int layer, int item, char* smem) {
  const int tid = tid_opaque(), lane = tid & 63, h = tid >> 6, l31 = lane & 31, h2 = lane >> 5;
  const int b = item >> 6, q0 = (item & 63) * 32, g = h >> 1;
  const int t = q0 + l31;
  const size_t tok = (size_t)b * T + t;
  bf16x8 qf[4];
  {
    const bf16_t* qp = p.QA + ((size_t)(b * 4 + h) * T + t) * 64 + h2 * 8;
#pragma unroll
    for (int ks = 0; ks < 4; ++ks) qf[ks] = *(const bf16x8*)(qp + ks * 16);
  }
  const bf16_t* Kp = p.KA + (size_t)(b * 2 + g) * T * 64;
  const bf16_t* Vp = p.VAT + (size_t)(b * 2 + g) * 64 * T;
  f32x16 o[2]; o[0] = zero16(); o[1] = zero16();
  float m = -1e30f, l = 0.f;
  for (int key0 = max(0, q0 - 128); key0 <= q0; key0 += 32) {
    f32x16 s = qk_tile(Kp + (size_t)key0 * 64, qf, l31, h2);
    if (key0 == q0 - 128 || key0 == q0) {
#pragma unroll
      for (int r = 0; r < 16; ++r) { const int key = key0 + crow(r, h2); if (key > t || t - key >= 128) s[r] = -INFINITY; }
    }
    softmax_pv(s, Vp + key0, T, o, m, l, l31, h2);
  }
  const float sink = p.a_sinks[layer * 4 + h];
  const float M = fmaxf(m, sink);
  const float sc = __expf(m - M);
  const float inv = sc / (l * sc + __expf(sink - M));
#pragma unroll
  for (int dt = 0; dt < 2; ++dt)
#pragma unroll
    for (int gq = 0; gq < 4; ++gq) {
      const int d0 = dt * 32 + 8 * gq + 4 * h2;
      const u32x2 gz = *(const u32x2*)(p.GZ + tok * 256 + h * 64 + d0);
      const float z0 = __uint_as_float(gz.x << 16), z1 = __uint_as_float(gz.x & 0xffff0000u), z2 = __uint_as_float(gz.y << 16), z3 = __uint_as_float(gz.y & 0xffff0000u);
      u32x2 o2 = {pack2(o[dt][4 * gq] * inv * z0, o[dt][4 * gq + 1] * inv * z1), pack2(o[dt][4 * gq + 2] * inv * z2, o[dt][4 * gq + 3] * inv * z3)};
      *(u32x2*)(p.YMIX + tok * 1024 + h * 64 + d0) = o2;
    }
}

DI void ph_cmp(const Params& p, int layer, int item, char* smem) {
  float* red = (float*)smem;
  bf16_t* hid = (bf16_t*)(smem + 32768);
  const int tid = tid_opaque(), lane = tid & 63, wid = tid >> 6, l31 = lane & 31, h2 = lane >> 5;
  const int b = item >> 3, kvsel = (item >> 2) & 1, mt = item & 3;
  const int lk = layer * 2 + kvsel;
  const int n = min(mt * 32 + l31, 126);
  const bf16_t* src = p.KV + ((size_t)(kvsel * NB + b) * T + 16 * n) * 64 + wid * 512 + h2 * 8;
  const bf16_t* w1t = p.W1T + (size_t)lk * 64 * 2048 + wid * 512 + h2 * 8;
  f32x16 acc[2]; acc[0] = zero16(); acc[1] = zero16();
#pragma unroll 4
  for (int ks = 0; ks < 32; ++ks) {
    const bf16x8 a = *(const bf16x8*)(src + ks * 16);
    const bf16x8 b0 = *(const bf16x8*)(w1t + (size_t)l31 * 2048 + ks * 16);
    const bf16x8 b1 = *(const bf16x8*)(w1t + (size_t)(32 + l31) * 2048 + ks * 16);
    acc[0] = MFMA32(a, b0, acc[0]); acc[1] = MFMA32(a, b1, acc[1]);
  }
  __syncthreads();
#pragma unroll
  for (int nt = 0; nt < 2; ++nt)
#pragma unroll
    for (int r = 0; r < 16; ++r) red[(wid * 32 + crow(r, h2)) * 64 + nt * 32 + l31] = acc[nt][r];
  __syncthreads();
  {
    const int row = tid >> 3, c0 = (tid & 7) * 8;
    float v[8];
#pragma unroll
    for (int e = 0; e < 8; ++e) {
      const float x = (red[(0 * 32 + row) * 64 + c0 + e] + red[(1 * 32 + row) * 64 + c0 + e]) + (red[(2 * 32 + row) * 64 + c0 + e] + red[(3 * 32 + row) * 64 + c0 + e]) + p.CVEC[lk * 64 + c0 + e];
      v[e] = siluf_(x);
    }
    u32x4 w = {pack2(v[0], v[1]), pack2(v[2], v[3]), pack2(v[4], v[5]), pack2(v[6], v[7])};
    *(u32x4*)(hid + row * 72 + c0) = w;
  }
  __syncthreads();
  if (wid == 0) {
    f32x16 o[2]; o[0] = zero16(); o[1] = zero16();
    const bf16_t* w2t = p.W2T + (size_t)lk * 4096;
#pragma unroll
    for (int ks = 0; ks < 4; ++ks) {
      const bf16x8 a = *(const bf16x8*)(hid + l31 * 72 + ks * 16 + h2 * 8);
#pragma unroll
      for (int nt = 0; nt < 2; ++nt) o[nt] = MFMA32(a, *(const bf16x8*)(w2t + (nt * 32 + l31) * 64 + ks * 16 + h2 * 8), o[nt]);
    }
    if (kvsel == 0) {
#pragma unroll
      for (int r = 0; r < 16; ++r) {
        const int nn = mt * 32 + crow(r, h2);
        if (nn < 127) {
          const int pos = 16 * nn + 31;
          const float cs = p.ROPEC[pos * 32 + l31], sn = p.ROPES[pos * 32 + l31];
          p.KCMP[((size_t)b * 128 + nn) * 64 + l31] = f2bf(o[0][r] * cs - o[1][r] * sn);
          p.KCMP[((size_t)b * 128 + nn) * 64 + 32 + l31] = f2bf(o[0][r] * sn + o[1][r] * cs);
        }
      }
    } else {
#pragma unroll
      for (int nt = 0; nt < 2; ++nt)
#pragma unroll
        for (int r = 0; r < 16; ++r) {
          const int nn = mt * 32 + crow(r, h2);
          if (nn < 127) p.VCMPT[((size_t)b * 64 + nt * 32 + l31) * 128 + nn] = f2bf(o[nt][r]);
        }
    }
  }
}

__global__ void __launch_bounds__(256) mega(Params p) {
  __shared__ __attribute__((aligned(16))) char smem[40960];
  cg::grid_group grid = cg::this_grid();
  const int bid = blockIdx.x, nblk = gridDim.x;
  ph_prologue(p, bid, nblk, smem);
  ln_rows(p, 0, 0, bid, nblk);
  grid.sync();
  for (int l = 0; l < 2; ++l) {
    ph_gemm<0>(p, l, bid, nblk, smem);
    grid.sync();
    for (int item = bid; item < 2048; item += nblk) ph_mlstm_local(p, l, item, smem);
    for (int item = bid; item < 2048; item += nblk) ph_hgrn_local(p, l, item, smem);
    __syncthreads();
    for (int item = bid; item < 256; item += nblk) ph_cmp(p, l, item, smem);
    for (int item = bid; item < 2048; item += nblk) ph_attnA(p, l, item, smem);
    grid.sync();
    if (bid < 128) ph_mlstm_scan(p, bid);
    else if (bid < 256) ph_hgrn_scan(p, bid - 128);
    __syncthreads();
    ph_attnD(p, l, p.CTR + l, smem);
    grid.sync();
    for (int item = bid; item < 2048; item += nblk) ph_mlstm_out(p, l, item, smem);
    for (int item = bid; item < 2048; item += nblk) ph_hgrn_out(p, l, item, smem);
    grid.sync();
    ph_gemm<1>(p, l, bid, nblk, smem);
    grid.sync();
    ln_rows(p, 1, l, bid, nblk);
    if (l == 0) grid.sync();
  }
}

static inline size_t align_up(size_t v) { return (v + 255) & ~(size_t)255; }

extern "C" void kernel_launch(void* const* d_in, const int* in_sizes, int n_in, void* d_out, int out_size, void* d_ws, size_t ws_size, hipStream_t stream) {
  Params p{};
  p.x = (const float*)d_in[0]; p.ln0_g = (const float*)d_in[1]; p.ln0_b = (const float*)d_in[2]; p.w_in = (const float*)d_in[3];
  p.b_in = (const float*)d_in[4]; p.a_sinks = (const float*)d_in[5]; p.conv_w = (const float*)d_in[6]; p.conv_b = (const float*)d_in[7];
  p.c_lb = (const float*)d_in[8]; p.c_norm_g = (const float*)d_in[9]; p.pe = (const float*)d_in[10]; p.w1 = (const float*)d_in[11];
  p.w2 = (const float*)d_in[12]; p.w_out = (const float*)d_in[13]; p.ln_g = (const float*)d_in[14]; p.ln_b = (const float*)d_in[15];
  p.hf = (float*)d_out;
  char* w = (char*)d_ws; size_t off = 0;
  auto take = [&](size_t bytes) { char* r = w + off; off = align_up(off + bytes); return r; };
  p.HB = (bf16_t*)take((size_t)NTOK * 1024 * 2);
  p.YMIX = (bf16_t*)take((size_t)NTOK * 1024 * 2);
  p.QA = (bf16_t*)take((size_t)NTOK * 256 * 2);
  p.KA = (bf16_t*)take((size_t)NTOK * 128 * 2);
  p.VAT = (bf16_t*)take((size_t)NTOK * 128 * 2);
  p.QKB = (bf16_t*)take((size_t)NTOK * 512 * 2);
  p.VBT = (bf16_t*)take((size_t)NTOK * 256 * 2);
  p.QC = (bf16_t*)take((size_t)NTOK * 256 * 2);
  p.GC = (float*)take((size_t)NTOK * 256 * 4);
  p.VCT = (bf16_t*)take((size_t)NTOK * 256 * 2);
  p.QD = (bf16_t*)take((size_t)NTOK * 256 * 2);
  p.KV = (bf16_t*)take((size_t)NTOK * 384 * 2);
  p.GZ = (bf16_t*)take((size_t)NTOK * 1280 * 2);
  p.IFG = (float*)take((size_t)NTOK * 8 * 4);
  p.DG = (float*)take((size_t)NTOK * 12 * 4);
  p.WT = (bf16_t*)take((size_t)2 * NP * 1024 * 2);
  p.WOT = (bf16_t*)take((size_t)2 * 1024 * 1024 * 2);
  p.KCMP = (bf16_t*)take((size_t)NB * 128 * 64 * 2);
  p.VCMPT = (bf16_t*)take((size_t)NB * 64 * 128 * 2);
  p.BIASP = (float*)take((size_t)2 * NP * 4);
  p.LB = (float*)take(512 * 4);
  p.ROPEC = (float*)take((size_t)T * 32 * 4);
  p.ROPES = (float*)take((size_t)T * 32 * 4);
  p.BST = (float*)take((size_t)2048 * 4096 * 4);
  p.BN = (float*)take((size_t)2048 * 64 * 4);
  p.BG = (float*)take(2048 * 4);
  p.CST = (float*)take((size_t)2048 * 4096 * 4);
  p.CAL = (float*)take((size_t)2048 * 64 * 4);
  p.W1T = (bf16_t*)take((size_t)4 * 64 * 2048 * 2);
  p.W2T = (bf16_t*)take((size_t)4 * 64 * 64 * 2);
  p.CVEC = (float*)take(256 * 4);
  p.CTR = (int*)take(256);
  if (off > ws_size) { fprintf(stderr, "workspace too small: need %zu have %zu\n", off, ws_size); return; }

  static int grid_blocks = 0;
  if (!grid_blocks) {
    int dev = 0, cus = 0, per_cu = 0;
    (void)hipGetDevice(&dev);
    (void)hipDeviceGetAttribute(&cus, hipDeviceAttributeMultiprocessorCount, dev);
    (void)hipOccupancyMaxActiveBlocksPerMultiprocessor(&per_cu, mega, 256, 0);
    if (per_cu > 2) per_cu = 2;
    grid_blocks = cus * per_cu;
  }
  void* args[] = {&p};
  hipError_t e = hipLaunchCooperativeKernel((void*)mega, dim3(grid_blocks), dim3(256), args, 0, stream);
  if (e != hipSuccess) fprintf(stderr, "cooperative launch failed: %s (grid %d)\n", hipGetErrorString(e), grid_blocks);
}
```

```cpp
#include <hip/hip_runtime.h>
#include <hip/hip_cooperative_groups.h>
#include <stdio.h>
#include <stdint.h>
#include <stddef.h>

#ifndef PROBE
#define PROBE 0
#endif
#define DI __device__ __forceinline__
typedef unsigned short bf16_t;
typedef short bf16x8 __attribute__((ext_vector_type(8)));
typedef float f32x16 __attribute__((ext_vector_type(16)));
typedef unsigned u32x4 __attribute__((ext_vector_type(4)));
typedef float f32x4 __attribute__((ext_vector_type(4)));

constexpr int NB = 32, T = 2048, DM = 1024, NTOK = NB * T, NP = 4096;
constexpr float DN_ALPHA = 1.41421356237309515f;

struct Params {
  const float *x, *ln0_g, *ln0_b, *w_in, *b_in, *a_sinks, *conv_w, *conv_b, *c_lb, *c_norm_g, *pe, *w1, *w2, *w_out, *ln_g, *ln_b;
  float* hf;
  bf16_t *HB, *YMIX, *QA, *KA, *VAT, *QKB, *VBT, *QC, *VCT, *QD, *KV, *GZ, *WT, *WOT, *KCMP, *VCMPT, *W1T, *W2T;
  float *GC, *IFG, *DG, *BIASP, *LB, *ROPEC, *ROPES, *BST, *BN, *BG, *CST, *CAL, *CVEC;
  int* CTR;
};
namespace cg = cooperative_groups;

DI int tid_opaque() { int t = threadIdx.x; asm volatile("" : "+v"(t)); return t; }
DI float bf2f(bf16_t v) { return __uint_as_float(((unsigned)v) << 16); }
DI bf16_t f2bf(float x) { unsigned u = __float_as_uint(x); u += 0x7fffu + ((u >> 16) & 1u); return (bf16_t)(u >> 16); }
DI float sigmoidf_(float x) { return 1.f / (1.f + __expf(-x)); }
DI float siluf_(float x) { return x / (1.f + __expf(-x)); }
DI float wave_sum(float v) { for (int o = 32; o > 0; o >>= 1) v += __shfl_xor(v, o); return v; }
DI float wave_max(float v) { for (int o = 32; o > 0; o >>= 1) v = fmaxf(v, __shfl_xor(v, o)); return v; }

DI int orig_col(int n) {
  if (n < 1536) return n;
  if (n < 3712) return n + 8;
  if (n < 3968) return n + 20;
  if (n < 3976) return 1536 + (n - 3968);
  if (n < 3988) return 3720 + (n - 3976);
  return -1;
}

DI void ph_prologue(const Params& p, int bid, int nblk, char* smem) {
  const long gtid = (long)bid * 256 + tid_opaque(), gsz = (long)nblk * 256;
  if (gtid < 64) p.CTR[gtid] = 0;
  for (long idx = gtid; idx < 2L * 128 * NP; idx += gsz) {
    const int n = (int)(idx % NP), k8 = (int)((idx / NP) % 128), l = (int)(idx / (NP * 128));
    const int oc = orig_col(n);
    unsigned w[4];
    for (int j = 0; j < 4; ++j) {
      float a = 0.f, b = 0.f;
      if (oc >= 0) { a = p.w_in[((size_t)l * 1024 + k8 * 8 + 2 * j) * 3988 + oc]; b = p.w_in[((size_t)l * 1024 + k8 * 8 + 2 * j + 1) * 3988 + oc]; }
      w[j] = (unsigned)f2bf(a) | ((unsigned)f2bf(b) << 16);
    }
    *(uint4*)(p.WT + ((size_t)l * NP + n) * 1024 + k8 * 8) = make_uint4(w[0], w[1], w[2], w[3]);
  }
  for (long idx = gtid; idx < 2L * 128 * 1024; idx += gsz) {
    const int d = (int)(idx % 1024), m8 = (int)((idx / 1024) % 128), l = (int)(idx / (1024 * 128));
    unsigned w[4];
    for (int j = 0; j < 4; ++j) {
      float a = p.w_out[((size_t)l * 1024 + m8 * 8 + 2 * j) * 1024 + d], b = p.w_out[((size_t)l * 1024 + m8 * 8 + 2 * j + 1) * 1024 + d];
      w[j] = (unsigned)f2bf(a) | ((unsigned)f2bf(b) << 16);
    }
    *(uint4*)(p.WOT + ((size_t)l * 1024 + d) * 1024 + m8 * 8) = make_uint4(w[0], w[1], w[2], w[3]);
  }
  for (long idx = gtid; idx < 4L * 256 * 64; idx += gsz) {
    const int j = (int)(idx % 64), i8 = (int)((idx / 64) % 256), lk = (int)(idx / (64 * 256));
    unsigned w[4];
    for (int e = 0; e < 4; ++e) {
      const float a = p.w1[((size_t)lk * 2048 + i8 * 8 + 2 * e) * 64 + j], b = p.w1[((size_t)lk * 2048 + i8 * 8 + 2 * e + 1) * 64 + j];
      w[e] = (unsigned)f2bf(a) | ((unsigned)f2bf(b) << 16);
    }
    *(uint4*)(p.W1T + ((size_t)lk * 64 + j) * 2048 + i8 * 8) = make_uint4(w[0], w[1], w[2], w[3]);
  }
  for (long idx = gtid; idx < 4L * 64 * 64; idx += gsz) {
    const int jo = (int)(idx % 64), ji = (int)((idx / 64) % 64), lk = (int)(idx / 4096);
    p.W2T[((size_t)lk * 64 + jo) * 64 + ji] = f2bf(p.w2[((size_t)lk * 64 + ji) * 64 + jo]);
  }
  if (bid < 4) {
    const int lk = bid, j = tid_opaque() & 63, part = tid_opaque() >> 6;
    float a = 0.f;
    for (int i = part * 512; i < part * 512 + 512; ++i) a += p.pe[(size_t)lk * 2048 + i] * p.w1[((size_t)lk * 2048 + i) * 64 + j];
    float* red = (float*)smem;
    red[part * 64 + j] = a;
    __syncthreads();
    if (part == 0) p.CVEC[lk * 64 + j] = (red[j] + red[64 + j]) + (red[128 + j] + red[192 + j]);
    __syncthreads();
  }
  for (long idx = gtid; idx < 2L * NP; idx += gsz) {
    const int n = (int)(idx % NP), l = (int)(idx / NP); const int oc = orig_col(n);
    p.BIASP[idx] = oc >= 0 ? p.b_in[l * 3988 + oc] : 0.f;
  }
  for (long idx = gtid; idx < (long)T * 32; idx += gsz) {
    const int t = (int)(idx / 32), i = (int)(idx % 32);
    const float inv = powf(10000.0f, -(float)i / 32.0f);
    const float ang = (float)t * inv;
    p.ROPEC[idx] = cosf(ang); p.ROPES[idx] = sinf(ang);
  }
  for (long idx = gtid; idx < 512; idx += gsz) {
    const int c = (int)(idx % 256), l = (int)(idx / 256);
    const float a = p.c_lb[c], b = p.c_lb[256 + c];
    const float m = fmaxf(a, b); const float ea = expf(a - m), eb = expf(b - m);
    p.LB[idx] = l == 0 ? 0.f : eb / (ea + eb);
  }
}

DI void ln_rows(const Params& p, int mode, int layer, int bid, int nblk) {
  const int tid_ = tid_opaque(); const int lane = tid_ & 63, wid = tid_ >> 6, nw = 4;
  const float* g = mode == 0 ? p.ln0_g : p.ln_g + layer * 1024;
  const float* bb = mode == 0 ? p.ln0_b : p.ln_b + layer * 1024;
  const float* src = mode == 0 ? p.x : p.hf;
  for (int row = bid * nw + wid; row < NTOK; row += nblk * nw) {
    const float* s = src + (size_t)row * 1024;
    float4 v[4];
    float sum = 0.f;
#pragma unroll
    for (int i = 0; i < 4; ++i) { v[i] = *(const float4*)(s + i * 256 + lane * 4); sum += (v[i].x + v[i].y) + (v[i].z + v[i].w); }
    sum = wave_sum(sum);
    const float mu = sum * (1.f / 1024.f);
    float q = 0.f;
#pragma unroll
    for (int i = 0; i < 4; ++i) { float a = v[i].x - mu, b = v[i].y - mu, c = v[i].z - mu, d = v[i].w - mu; q += (a * a + b * b) + (c * c + d * d); }
    q = wave_sum(q);
    const float rs = rsqrtf(q * (1.f / 1024.f) + 1e-5f);
#pragma unroll
    for (int i = 0; i < 4; ++i) {
      const int c0 = i * 256 + lane * 4;
      const float4 gg = *(const float4*)(g + c0), b4 = *(const float4*)(bb + c0);
      float4 o;
      o.x = (v[i].x - mu) * rs * gg.x + b4.x; o.y = (v[i].y - mu) * rs * gg.y + b4.y;
      o.z = (v[i].z - mu) * rs * gg.z + b4.z; o.w = (v[i].w - mu) * rs * gg.w + b4.w;
      *(float4*)(p.hf + (size_t)row * 1024 + c0) = o;
      uint2 pk; pk.x = (unsigned)f2bf(o.x) | ((unsigned)f2bf(o.y) << 16); pk.y = (unsigned)f2bf(o.z) | ((unsigned)f2bf(o.w) << 16);
      *(uint2*)(p.HB + (size_t)row * 1024 + c0) = pk;
    }
  }
}

typedef float f32x2 __attribute__((ext_vector_type(2)));
typedef __bf16 bf16v2 __attribute__((ext_vector_type(2)));
typedef unsigned u32x2 __attribute__((ext_vector_type(2)));
DI unsigned pack2(float a, float b) { f32x2 v = {a, b}; return __builtin_bit_cast(unsigned, __builtin_convertvector(v, bf16v2)); }
DI f32x16 zero16() { f32x16 z;
#pragma unroll
  for (int i = 0; i < 16; ++i) z[i] = 0.f; return z; }
DI bf16x8 ld_frag8x2(const bf16_t* p) { const u32x2 lo = *(const u32x2*)p, hi = *(const u32x2*)(p + 8); u32x4 t = {lo.x, lo.y, hi.x, hi.y}; return __builtin_bit_cast(bf16x8, t); }
template <int BASE> DI bf16x8 pack8(const f32x16& s) {
  u32x4 t = {pack2(s[BASE + 0], s[BASE + 1]), pack2(s[BASE + 2], s[BASE + 3]), pack2(s[BASE + 4], s[BASE + 5]), pack2(s[BASE + 6], s[BASE + 7])};
  return __builtin_bit_cast(bf16x8, t);
}
DI int crow(int r, int h2) { return (r & 3) + 8 * (r >> 2) + 4 * h2; }
#define MFMA32(a, b, c) __builtin_amdgcn_mfma_f32_32x32x16_bf16((a), (b), (c), 0, 0, 0)
enum { K_NONE = 0, K_ROPE, K_PLAIN, K_TR, K_GSILU, K_GSIG, K_SILUH, K_LOGF, K_SMALL };

template <int KIND>
DI void epi_inproj(const Params& p, const f32x16 (&acc)[2][2], bf16_t* dst, float* fdst, float scale, float bias0, float bias1, float lb0, float lb1,
                   int b, int t0, int lane, char* img) {
  const int l31 = lane & 31, h2 = lane >> 5;
  if (KIND == K_SMALL) {
#pragma unroll
    for (int mt = 0; mt < 2; ++mt)
#pragma unroll
      for (int r = 0; r < 16; ++r) {
        const int t = t0 + mt * 32 + crow(r, h2);
        const size_t tok = (size_t)b * T + t;
        const float v0 = acc[mt][0][r] + bias0;
        if (l31 < 8) p.IFG[tok * 8 + l31] = v0;
        else if (l31 < 20) p.DG[tok * 12 + (l31 - 8)] = sigmoidf_(v0);
      }
    return;
  }
  if (KIND == K_LOGF) {
#pragma unroll
    for (int mt = 0; mt < 2; ++mt) {
      float* fimg = (float*)img;
#pragma unroll
      for (int r = 0; r < 16; ++r) {
        const float v0 = acc[mt][0][r] + bias0, v1 = acc[mt][1][r] + bias1;
        const float f0 = lb0 + (1.f - lb0) * sigmoidf_(v0), f1 = lb1 + (1.f - lb1) * sigmoidf_(v1);
        fimg[crow(r, h2) * 64 + l31] = __logf(f0); fimg[crow(r, h2) * 64 + 32 + l31] = __logf(f1);
      }
#pragma unroll
      for (int i = 0; i < 8; ++i) {
        const int q = lane + 64 * i;
        *(u32x4*)(fdst + (size_t)(t0 + mt * 32) * 64 + q * 4) = *(const u32x4*)(img + q * 16);
      }
    }
    return;
  }
  bf16_t* bimg = (bf16_t*)img;
  if (KIND == K_TR) {
#pragma unroll
    for (int mt = 0; mt < 2; ++mt)
#pragma unroll
      for (int nt = 0; nt < 2; ++nt)
#pragma unroll
        for (int g = 0; g < 4; ++g) {
          const float bs = nt ? bias1 : bias0;
          u32x2 w = {pack2(acc[mt][nt][4 * g] + bs, acc[mt][nt][4 * g + 1] + bs), pack2(acc[mt][nt][4 * g + 2] + bs, acc[mt][nt][4 * g + 3] + bs)};
          *(u32x2*)(bimg + (nt * 32 + l31) * 64 + mt * 32 + 8 * g + 4 * h2) = w;
        }
#pragma unroll
    for (int i = 0; i < 8; ++i) {
      const int q = lane + 64 * i, c = q >> 3, rc = q & 7;
      *(u32x4*)(dst + (size_t)c * T + t0 + rc * 8) = *(const u32x4*)(img + q * 16);
    }
    return;
  }
#pragma unroll
  for (int mt = 0; mt < 2; ++mt)
#pragma unroll
    for (int r = 0; r < 16; ++r) {
      const int row = mt * 32 + crow(r, h2);
      const float v0 = acc[mt][0][r] + bias0, v1 = acc[mt][1][r] + bias1;
      float o0, o1;
      if (KIND == K_ROPE) {
        const int t = t0 + row;
        const float c = p.ROPEC[t * 32 + l31], s = p.ROPES[t * 32 + l31];
        o0 = (v0 * c - v1 * s) * scale; o1 = (v0 * s + v1 * c) * scale;
      } else if (KIND == K_PLAIN) { o0 = v0; o1 = v1; }
      else if (KIND == K_SILUH || KIND == K_GSILU) { o0 = siluf_(v0); o1 = siluf_(v1); }
      else { o0 = sigmoidf_(v0); o1 = sigmoidf_(v1); }
      bimg[row * 64 + l31] = f2bf(o0); bimg[row * 64 + 32 + l31] = f2bf(o1);
    }
  if (KIND == K_GSILU || KIND == K_GSIG) {
#pragma unroll
    for (int i = 0; i < 8; ++i) {
      const int q = lane + 64 * i, row = q >> 3, c16 = q & 7;
      *(u32x4*)(dst + ((size_t)b * T + t0 + row) * 256 + c16 * 8) = *(const u32x4*)(img + q * 16);
    }
  } else {
#pragma unroll
    for (int i = 0; i < 8; ++i) {
      const int q = lane + 64 * i;
      *(u32x4*)(dst + (size_t)t0 * 64 + q * 8) = *(const u32x4*)(img + q * 16);
    }
  }
}

#define LAS __attribute__((address_space(3)))
template <int MODE>
DI void gemm_mainloop(const Params& p, int layer, int pm, int pn, char* smem, f32x16 (&acc)[2][2]) {
  const int tid = tid_opaque(), lane = tid & 63, wid = tid >> 6, wm = wid >> 1, wn = wid & 1;
  const int l31 = lane & 31, h2 = lane >> 5;
  const bf16_t* A = (MODE == 0 ? p.HB : p.YMIX) + (size_t)pm * 128 * 1024;
  const bf16_t* Bt = (MODE == 0 ? p.WT + (size_t)layer * NP * 1024 : p.WOT + (size_t)layer * 1024 * 1024) + (size_t)pn * 128 * 1024;
  bf16_t* sA = (bf16_t*)smem;
  bf16_t* sB = sA + 128 * 72;
#pragma unroll
  for (int i = 0; i < 2; ++i)
#pragma unroll
    for (int j = 0; j < 2; ++j)
#pragma unroll
      for (int r = 0; r < 16; ++r) acc[i][j][r] = 0.f;
  const int lr = tid >> 3, lc = (tid & 7) * 8;
  u32x4 ra[4], rb[4];
#pragma unroll
  for (int i = 0; i < 4; ++i) { ra[i] = *(const u32x4*)(A + (size_t)(lr + 32 * i) * 1024 + lc); rb[i] = *(const u32x4*)(Bt + (size_t)(lr + 32 * i) * 1024 + lc); }
  for (int kt = 0; kt < 16; ++kt) {
    __syncthreads();
#pragma unroll
    for (int i = 0; i < 4; ++i) { *(u32x4*)(sA + (lr + 32 * i) * 72 + lc) = ra[i]; *(u32x4*)(sB + (lr + 32 * i) * 72 + lc) = rb[i]; }
    __syncthreads();
    if (kt + 1 < 16) {
#pragma unroll
      for (int i = 0; i < 4; ++i) { ra[i] = *(const u32x4*)(A + (size_t)(lr + 32 * i) * 1024 + (kt + 1) * 64 + lc); rb[i] = *(const u32x4*)(Bt + (size_t)(lr + 32 * i) * 1024 + (kt + 1) * 64 + lc); }
    }
#pragma unroll
    for (int ks = 0; ks < 4; ++ks) {
      bf16x8 af[2], bfr[2];
#pragma unroll
      for (int mt = 0; mt < 2; ++mt) af[mt] = *(const bf16x8*)(sA + (wm * 64 + mt * 32 + l31) * 72 + ks * 16 + h2 * 8);
#pragma unroll
      for (int nt = 0; nt < 2; ++nt) bfr[nt] = *(const bf16x8*)(sB + (wn * 64 + nt * 32 + l31) * 72 + ks * 16 + h2 * 8);
#pragma unroll
      for (int mt = 0; mt < 2; ++mt)
#pragma unroll
        for (int nt = 0; nt < 2; ++nt) acc[mt][nt] = __builtin_amdgcn_mfma_f32_32x32x16_bf16(af[mt], bfr[nt], acc[mt][nt], 0, 0, 0);
    }
  }
}
template <int MODE>
DI void gemm_epilogue(const Params& p, int layer, int pm, int pn, const f32x16 (&acc)[2][2], char* smem) {
  const int tid = tid_opaque(), lane = tid & 63, wid = tid >> 6, wm = wid >> 1, wn = wid & 1;
  const int l31 = lane & 31, h2 = lane >> 5;
  if (MODE == 1) {
#pragma unroll
    for (int mt = 0; mt < 2; ++mt)
#pragma unroll
      for (int nt = 0; nt < 2; ++nt)
#pragma unroll
        for (int r = 0; r < 16; ++r) {
          const int row = pm * 128 + wm * 64 + mt * 32 + (r & 3) + 8 * (r >> 2) + 4 * h2;
          const int col = pn * 128 + wn * 64 + nt * 32 + l31;
          float* dst = p.hf + (size_t)row * 1024 + col;
          *dst = DN_ALPHA * (*dst) + acc[mt][nt][r];
        }
    return;
  }
  const int hd = pn * 2 + wn;
  const int b = pm >> 4, t0 = (pm & 15) * 128 + wm * 64;
  int kind = K_NONE; bf16_t* dst = nullptr; float scale = 1.f; float* fdst = nullptr;
  if (hd < 4) { kind = K_ROPE; dst = p.QA + ((size_t)(b * 4 + hd) * T) * 64; scale = 0.125f; }
  else if (hd < 6) { kind = K_ROPE; dst = p.KA + ((size_t)(b * 2 + hd - 4) * T) * 64; }
  else if (hd < 8) { kind = K_TR; dst = p.VAT + (size_t)(b * 2 + hd - 6) * 64 * T; }
  else if (hd < 12) { kind = K_GSILU; dst = p.GZ + (size_t)0 * NTOK * 256 + (hd - 8) * 64; }
  else if (hd < 20) { kind = K_PLAIN; dst = p.QKB + ((size_t)(b * 8 + hd - 12) * T) * 64; }
  else if (hd < 24) { kind = K_TR; dst = p.VBT + (size_t)(b * 4 + hd - 20) * 64 * T; }
  else if (hd < 28) { kind = K_GSIG; dst = p.GZ + (size_t)1 * NTOK * 256 + (hd - 24) * 64; }
  else if (hd < 32) { kind = K_GSILU; dst = p.GZ + (size_t)2 * NTOK * 256 + (hd - 28) * 64; }
  else if (hd < 36) { kind = K_SILUH; dst = p.QC + ((size_t)(b * 4 + hd - 32) * T) * 64; }
  else if (hd < 40) { kind = K_LOGF; fdst = p.GC + ((size_t)(b * 4 + hd - 36) * T) * 64; }
  else if (hd < 44) { kind = K_TR; dst = p.VCT + (size_t)(b * 4 + hd - 40) * 64 * T; }
  else if (hd < 48) { kind = K_GSILU; dst = p.GZ + (size_t)3 * NTOK * 256 + (hd - 44) * 64; }
  else if (hd < 52) { kind = K_ROPE; dst = p.QD + ((size_t)(b * 4 + hd - 48) * T) * 64; scale = 0.125f; }
  else if (hd < 58) {
    const int j = hd - 52;
    dst = p.KV + (size_t)(j * NB + b) * T * 64;
    kind = (j == 0 || j == 1) ? K_PLAIN : ((j == 2 || j == 4) ? K_ROPE : K_TR);
  }
  else if (hd < 62) { kind = K_GSILU; dst = p.GZ + (size_t)4 * NTOK * 256 + (hd - 58) * 64; }
  else if (hd == 62) { kind = K_SMALL; }
  __syncthreads();
  if (kind == K_NONE) return;
  const float bias0 = p.BIASP[layer * NP + hd * 64 + l31], bias1 = p.BIASP[layer * NP + hd * 64 + 32 + l31];
  float lb0 = 0.f, lb1 = 0.f;
  if (kind == K_LOGF) { lb0 = p.LB[layer * 256 + (hd - 36) * 64 + l31]; lb1 = p.LB[layer * 256 + (hd - 36) * 64 + 32 + l31]; }
  char* img = smem + wid * 8192;
  switch (kind) {
    case K_ROPE: epi_inproj<K_ROPE>(p, acc, dst, fdst, scale, bias0, bias1, lb0, lb1, b, t0, lane, img); break;
    case K_PLAIN: epi_inproj<K_PLAIN>(p, acc, dst, fdst, scale, bias0, bias1, lb0, lb1, b, t0, lane, img); break;
    case K_TR: epi_inproj<K_TR>(p, acc, dst, fdst, scale, bias0, bias1, lb0, lb1, b, t0, lane, img); break;
    case K_GSILU: epi_inproj<K_GSILU>(p, acc, dst, fdst, scale, bias0, bias1, lb0, lb1, b, t0, lane, img); break;
    case K_GSIG: epi_inproj<K_GSIG>(p, acc, dst, fdst, scale, bias0, bias1, lb0, lb1, b, t0, lane, img); break;
    case K_SILUH: epi_inproj<K_SILUH>(p, acc, dst, fdst, scale, bias0, bias1, lb0, lb1, b, t0, lane, img); break;
    case K_LOGF: epi_inproj<K_LOGF>(p, acc, dst, fdst, scale, bias0, bias1, lb0, lb1, b, t0, lane, img); break;
    case K_SMALL: epi_inproj<K_SMALL>(p, acc, dst, fdst, scale, bias0, bias1, lb0, lb1, b, t0, lane, img); break;
    default: break;
  }
}

template <int MODE>
DI void ph_gemm(const Params& p, int layer, int bid, int nblk, char* smem) {
  constexpr int NG = MODE == 0 ? 8 : 2;
  const int x = bid & 7, slot = bid >> 3, per = nblk >> 3;
  const int half = x >> 2, pnbase = NG * (x & 3);
  for (int i = slot; i < 256 * NG; i += per) {
    const int pm = 2 * (i / NG) + half, pn = pnbase + (i % NG);
    f32x16 acc[2][2];
    gemm_mainloop<MODE>(p, layer, pm, pn, smem, acc);
    if (PROBE == 6 && MODE == 0) {
      f32x16 acc2[2][2];
      gemm_mainloop<MODE>(p, layer, pm, pn, smem, acc2);
      if (acc2[0][0][0] == 1.2345e30f || acc2[1][1][5] == 1.2345e30f || acc2[0][1][7] == 1.2345e30f || acc2[1][0][9] == 1.2345e30f) acc[0][0][0] += 1.f;
    }
    gemm_epilogue<MODE>(p, layer, pm, pn, acc, smem);
    if (PROBE == 7 && MODE == 0) gemm_epilogue<MODE>(p, layer, pm, pn, acc, smem);
  }
}

DI void ph_naiveA(const Params& p, int layer, int bid, int nblk, char* smem) {
  float (*ps)[128] = (float (*)[128])smem;
  const int tid_ = tid_opaque(); const int lane = tid_ & 63, h = tid_ >> 6;
  for (int tok = bid; tok < NTOK; tok += nblk) {
    const int b = tok / T, t = tok % T, g = h >> 1;
    const bf16_t* q = p.QA + ((size_t)(b * 4 + h) * T + t) * 64;
    const bf16_t* K = p.KA + (size_t)(b * 2 + g) * T * 64;
    const bf16_t* VT = p.VAT + (size_t)(b * 2 + g) * 64 * T;
    float sc[2];
    for (int i = 0; i < 2; ++i) {
      const int s = t - 127 + lane + 64 * i;
      float d = -INFINITY;
      if (s >= 0) { d = 0.f; for (int e = 0; e < 64; ++e) d += bf2f(q[e]) * bf2f(K[(size_t)s * 64 + e]); }
      sc[i] = d;
    }
    const float sink = p.a_sinks[layer * 4 + h];
    float m = fmaxf(wave_max(fmaxf(sc[0], sc[1])), sink);
    const float e0 = __expf(sc[0] - m), e1 = __expf(sc[1] - m);
    const float l = wave_sum(e0 + e1) + __expf(sink - m);
    __syncthreads();
    ps[h][lane] = e0; ps[h][lane + 64] = e1;
    __syncthreads();
    float o = 0.f;
    for (int j = 0; j < 128; ++j) { const int s = t - 127 + j; if (s >= 0) o += ps[h][j] * bf2f(VT[(size_t)lane * T + s]); }
    o /= l;
    const float gz = bf2f(p.GZ[(size_t)0 * NTOK * 256 + (size_t)tok * 256 + h * 64 + lane]);
    p.YMIX[(size_t)tok * 1024 + h * 64 + lane] = f2bf(o * gz);
  }
}

DI void ph_naiveB(const Params& p, int layer, int bid, int nblk, char* smem) {
  float* qs = (float*)smem; float* ks = qs + 2048; float* vs = ks + 2048; float* ig = vs + 2048; float* fg = ig + 32;
  const int tid = tid_opaque(), v = tid >> 2, kq = tid & 3;
  for (int item = bid; item < NB * 4; item += nblk) {
    const int b = item >> 2, hh = item & 3;
    float C[16], n[16];
    for (int i = 0; i < 16; ++i) { C[i] = 0.f; n[i] = 0.f; }
    const bf16_t* rawq = p.QKB + ((size_t)(b * 8 + hh) * T) * 64;
    const bf16_t* rawk = p.QKB + ((size_t)(b * 8 + 4 + hh) * T) * 64;
    const float* cw = p.conv_w + layer * 4 * 512; const float* cb = p.conv_b + layer * 512;
    for (int t0 = 0; t0 < T; t0 += 32) {
      __syncthreads();
      for (int e = tid; e < 2 * 32 * 64; e += 256) {
        const int which = e / 2048, tt = (e % 2048) / 64, d = e % 64, t = t0 + tt;
        const bf16_t* raw = which ? rawk : rawq; const int ch = (which ? 256 : 0) + hh * 64 + d;
        float a = cb[ch];
        for (int j = 0; j < 4; ++j) { const int ts = t - 3 + j; if (ts >= 0) a += cw[j * 512 + ch] * bf2f(raw[(size_t)ts * 64 + d]); }
        float sv = siluf_(a); if (!which) sv *= 0.125f;
        (which ? ks : qs)[tt * 64 + d] = sv;
      }
      for (int e = tid; e < 32 * 64; e += 256) { const int tt = e / 64, d = e % 64; vs[tt * 64 + d] = bf2f(p.VBT[((size_t)(b * 4 + hh) * 64 + d) * T + t0 + tt]); }
      if (tid < 32) { const size_t tok = (size_t)b * T + t0 + tid; ig[tid] = p.IFG[tok * 8 + hh]; fg[tid] = sigmoidf_(p.IFG[tok * 8 + 4 + hh]); }
      __syncthreads();
      for (int tt = 0; tt < 32; ++tt) {
        const float f = fg[tt], iw = __expf(ig[tt]); const float vv = vs[tt * 64 + v] * iw;
        float num = 0.f, den = 0.f;
#pragma unroll
        for (int kk = 0; kk < 16; ++kk) {
          const float kv = ks[tt * 64 + kq * 16 + kk], qv = qs[tt * 64 + kq * 16 + kk];
          C[kk] = f * C[kk] + vv * kv; n[kk] = f * n[kk] + iw * kv; num += C[kk] * qv; den += n[kk] * qv;
        }
        num += __shfl_xor(num, 1); num += __shfl_xor(num, 2); den += __shfl_xor(den, 1); den += __shfl_xor(den, 2);
        const float hval = num / fmaxf(fabsf(den), 1.f);
        if (kq == 0) {
          const size_t tok = (size_t)b * T + t0 + tt; const int col = hh * 64 + v;
          const float y = bf2f(p.GZ[(size_t)1 * NTOK * 256 + tok * 256 + col]) * hval * bf2f(p.GZ[(size_t)2 * NTOK * 256 + tok * 256 + col]);
          p.YMIX[tok * 1024 + 256 + col] = f2bf(y);
        }
      }
    }
  }
}

DI void ph_naiveC(const Params& p, int layer, int bid, int nblk, char* smem) {
  float* qs = (float*)smem; float* fs = qs + 2048; float* vs = fs + 2048; float* os = vs + 2048;
  const int tid = tid_opaque(), v = tid >> 2, kq = tid & 3;
  for (int item = bid; item < NB * 4; item += nblk) {
    const int b = item >> 2, hh = item & 3;
    float S[16];
    for (int i = 0; i < 16; ++i) S[i] = 0.f;
    for (int t0 = 0; t0 < T; t0 += 32) {
      __syncthreads();
      for (int e = tid; e < 32 * 64; e += 256) {
        const int tt = e / 64, d = e % 64;
        const size_t off = ((size_t)(b * 4 + hh) * T + t0 + tt) * 64 + d;
        qs[e] = bf2f(p.QC[off]); fs[e] = __expf(p.GC[off]);
        vs[e] = bf2f(p.VCT[((size_t)(b * 4 + hh) * 64 + d) * T + t0 + tt]);
      }
      __syncthreads();
      for (int tt = 0; tt < 32; ++tt) {
        const float vv = vs[tt * 64 + v];
        float o = 0.f;
#pragma unroll
        for (int kk = 0; kk < 16; ++kk) {
          const float f = fs[tt * 64 + kq * 16 + kk], qv = qs[tt * 64 + kq * 16 + kk];
          S[kk] = f * S[kk] + (1.f - f) * vv; o += qv * S[kk];
        }
        o += __shfl_xor(o, 1); o += __shfl_xor(o, 2);
        if (kq == 0) os[tt * 64 + v] = o;
      }
      __syncthreads();
      {
        const int tt = tid >> 3, j = tid & 7;
        float ss = 0.f;
        for (int i = 0; i < 8; ++i) { const float o = os[tt * 64 + j * 8 + i]; ss += o * o; }
        ss += __shfl_xor(ss, 1); ss += __shfl_xor(ss, 2); ss += __shfl_xor(ss, 4);
        const float rs = rsqrtf(ss * (1.f / 64.f) + 1e-6f);
        const size_t tok = (size_t)b * T + t0 + tt;
        for (int i = 0; i < 8; ++i) {
          const int col = hh * 64 + j * 8 + i;
          const float y = os[tt * 64 + j * 8 + i] * rs * p.c_norm_g[layer * 256 + col] * bf2f(p.GZ[(size_t)3 * NTOK * 256 + tok * 256 + col]);
          p.YMIX[tok * 1024 + 512 + col] = f2bf(y);
        }
      }
    }
  }
}

DI void ph_naive_cmp(const Params& p, int layer, int bid, int nblk, char* smem) {
  float (*hs)[64] = (float (*)[64])smem; float (*os)[64] = (float (*)[64])(smem + 512);
  const int tid = tid_opaque(), kvsel = (tid >> 6) & 1, j = tid & 63;
  const bool act = tid < 128;
  for (int item = bid; item < NB * 127; item += nblk) {
    const int b = item / 127, n = item % 127;
    const bf16_t* src = p.KV + ((size_t)(kvsel * NB + b) * T + 16 * n) * 64;
    const float* w1 = p.w1 + ((size_t)(layer * 2 + kvsel) * 2048) * 64;
    const float* pe = p.pe + (size_t)(layer * 2 + kvsel) * 2048;
    float a = 0.f;
    if (act) for (int i = 0; i < 2048; ++i) a += (bf2f(src[i]) + pe[i]) * w1[(size_t)i * 64 + j];
    __syncthreads();
    if (act) hs[kvsel][j] = siluf_(a);
    __syncthreads();
    const float* w2 = p.w2 + (size_t)(layer * 2 + kvsel) * 4096;
    float o = 0.f;
    if (act) { for (int i = 0; i < 64; ++i) o += hs[kvsel][i] * w2[i * 64 + j]; os[kvsel][j] = o; }
    __syncthreads();
    if (act) {
      if (kvsel == 0) {
        if (j < 32) {
          const int pos = 16 * n + 31;
          const float c = p.ROPEC[pos * 32 + j], s = p.ROPES[pos * 32 + j];
          const float x1 = os[0][j], x2 = os[0][j + 32];
          p.KCMP[((size_t)b * 128 + n) * 64 + j] = f2bf(x1 * c - x2 * s);
          p.KCMP[((size_t)b * 128 + n) * 64 + 32 + j] = f2bf(x1 * s + x2 * c);
        }
      } else {
        p.VCMPT[((size_t)b * 64 + j) * 128 + n] = f2bf(o);
      }
    }
  }
}

DI float dot64_lds(const float* q, const bf16_t* kp) {
  float d = 0.f;
#pragma unroll
  for (int e8 = 0; e8 < 8; ++e8) {
    const u32x4 w = *(const u32x4*)(kp + e8 * 8);
#pragma unroll
    for (int j = 0; j < 4; ++j) { d += q[e8 * 8 + 2 * j] * __uint_as_float(w[j] << 16); d += q[e8 * 8 + 2 * j + 1] * __uint_as_float(w[j] & 0xffff0000u); }
  }
  return d;
}
DI void ph_naiveD(const Params& p, int layer, int* ctr, char* smem) {
  float (*pc)[128] = (float (*)[128])smem; float* impv = (float*)(smem + 2048); float (*pbuf)[512] = (float (*)[512])(smem + 2048 + 128);
  float (*qsh)[64] = (float (*)[64])(smem + 2048 + 128 + 8192); int* selblk = (int*)(smem + 2048 + 128 + 8192 + 1024); int* s_item = selblk + 8;
  const int tid = tid_opaque(), lane = tid & 63, h = tid >> 6;
  for (;;) {
    __syncthreads();
    if (tid == 0) *s_item = atomicAdd(ctr, 1);
    __syncthreads();
    const int tok = *s_item;
    if (tok >= NTOK) break;
    const int b = tok / T, t = tok % T, cur = t >> 6;
    __syncthreads();
    qsh[h][lane] = bf2f(p.QD[((size_t)(b * 4 + h) * T + t) * 64 + lane]);
    __syncthreads();
    const float* q = qsh[h];
    float o_cmp;
    {
      float sc0 = -INFINITY, sc1 = -INFINITY;
      { const int n = lane; if (16 * n + 31 <= t) sc0 = dot64_lds(q, p.KCMP + ((size_t)b * 128 + n) * 64); }
      { const int n = lane + 64; if (n < 127 && 16 * n + 31 <= t) sc1 = dot64_lds(q, p.KCMP + ((size_t)b * 128 + n) * 64); }
      const float m = wave_max(fmaxf(sc0, sc1));
      float e0 = 0.f, e1 = 0.f;
      if (m > -INFINITY) { e0 = __expf(sc0 - m); e1 = __expf(sc1 - m); }
      const float l = wave_sum(e0 + e1);
      const float il = l > 0.f ? 1.f / l : 0.f;
      pc[h][lane] = e0 * il; pc[h][lane + 64] = e1 * il;
      __syncthreads();
      float o = 0.f;
      const bf16_t* vp = p.VCMPT + ((size_t)b * 64 + lane) * 128;
#pragma unroll 4
      for (int n = 0; n < 127; ++n) o += pc[h][n] * bf2f(vp[n]);
      o_cmp = o;
    }
    if (tid < 32) {
      const int j = tid;
      float v;
      if (j > cur) v = -1e30f;
      else if (j == 0 || j == cur || j == cur - 1) v = 1e6f;
      else {
        v = 0.f;
#pragma unroll 1
        for (int hh = 0; hh < 4; ++hh)
#pragma unroll 1
          for (int n = 4 * j - 1; n <= 4 * j + 3; ++n) if (n >= 0 && n < 127) v += pc[hh][n];
      }
      impv[j] = v;
    }
    __syncthreads();
    if (tid < 32) {
      const int j = tid; const float vj = impv[j];
      int rank = 0;
#pragma unroll 1
      for (int i = 0; i < 32; ++i) { const float vi = impv[i]; rank += (vi > vj || (vi == vj && i < j)) ? 1 : 0; }
      if (rank < 8) selblk[rank] = j;
    }
    __syncthreads();
    float o_slc;
    {
      float m = -INFINITY;
#pragma unroll 1
      for (int r = 0; r < 8; ++r) {
        const int s = selblk[r] * 64 + lane;
        float d = -INFINITY;
        if (s <= t) d = dot64_lds(q, p.KV + ((size_t)(2 * NB + b) * T + s) * 64);
        pbuf[h][r * 64 + lane] = d; m = fmaxf(m, d);
      }
      m = wave_max(m);
      float l = 0.f;
#pragma unroll 1
      for (int r = 0; r < 8; ++r) { const float e = __expf(pbuf[h][r * 64 + lane] - m); pbuf[h][r * 64 + lane] = e; l += e; }
      l = wave_sum(l);
      __syncthreads();
      float o = 0.f;
      const bf16_t* vp = p.KV + ((size_t)(3 * NB + b) * 64 + lane) * T;
#pragma unroll 1
      for (int r = 0; r < 8; ++r) {
        const int s0 = selblk[r] * 64;
#pragma unroll 4
        for (int kk = 0; kk < 64; ++kk) o += pbuf[h][r * 64 + kk] * bf2f(vp[s0 + kk]);
      }
      o_slc = o / l;
      __syncthreads();
    }
    float o_win;
    {
      float m = -INFINITY;
#pragma unroll 1
      for (int r = 0; r < 8; ++r) {
        const int s = t - 511 + r * 64 + lane;
        float d = -INFINITY;
        if (s >= 0) d = dot64_lds(q, p.KV + ((size_t)(4 * NB + b) * T + s) * 64);
        pbuf[h][r * 64 + lane] = d; m = fmaxf(m, d);
      }
      m = wave_max(m);
      float l = 0.f;
#pragma unroll 1
      for (int r = 0; r < 8; ++r) { const float e = __expf(pbuf[h][r * 64 + lane] - m); pbuf[h][r * 64 + lane] = e; l += e; }
      l = wave_sum(l);
      __syncthreads();
      float o = 0.f;
      const bf16_t* vp = p.KV + ((size_t)(5 * NB + b) * 64 + lane) * T;
#pragma unroll 4
      for (int j = 0; j < 512; ++j) { const int s = t - 511 + j; if (s >= 0) o += pbuf[h][j] * bf2f(vp[s]); }
      o_win = o / l;
    }
    const float g0 = p.DG[(size_t)tok * 12 + h * 3 + 0], g1 = p.DG[(size_t)tok * 12 + h * 3 + 1], g2 = p.DG[(size_t)tok * 12 + h * 3 + 2];
    const float o = g0 * o_cmp + g1 * o_slc + g2 * o_win;
    const float gz = bf2f(p.GZ[(size_t)4 * NTOK * 256 + (size_t)tok * 256 + h * 64 + lane]);
    p.YMIX[(size_t)tok * 1024 + 768 + h * 64 + lane] = f2bf(o * gz);
  }
}


DI f32x16 qk_tile(const bf16_t* Krow, const bf16x8 (&qf)[4], int l31, int h2) {
  f32x16 s = zero16();
  const bf16_t* kp = Krow + l31 * 64 + h2 * 8;
#pragma unroll
  for (int ks = 0; ks < 4; ++ks) { const bf16x8 a = *(const bf16x8*)(kp + ks * 16); s = MFMA32(a, qf[ks], s); }
  return s;
}
DI void softmax_pv(f32x16& s, const bf16_t* VTp, int vstride, f32x16 (&o)[2], float& m, float& l, int l31, int h2) {
  bf16x8 va[2][2];
#pragma unroll
  for (int dt = 0; dt < 2; ++dt)
#pragma unroll
    for (int sk = 0; sk < 2; ++sk) va[dt][sk] = ld_frag8x2(VTp + (size_t)(dt * 32 + l31) * vstride + sk * 16 + 4 * h2);
  float mx = s[0];
#pragma unroll
  for (int r = 1; r < 16; ++r) mx = fmaxf(mx, s[r]);
  mx = fmaxf(mx, __shfl_xor(mx, 32));
  const float mn = fmaxf(m, mx);
  const float alpha = __expf(m - mn);
  float ps = 0.f;
#pragma unroll
  for (int r = 0; r < 16; ++r) { s[r] = __expf(s[r] - mn); ps += s[r]; }
  ps += __shfl_xor(ps, 32);
  l = l * alpha + ps; m = mn;
#pragma unroll
  for (int dt = 0; dt < 2; ++dt)
#pragma unroll
    for (int r = 0; r < 16; ++r) o[dt][r] *= alpha;
  const bf16x8 p0 = pack8<0>(s), p1 = pack8<8>(s);
#pragma unroll
  for (int dt = 0; dt < 2; ++dt) { o[dt] = MFMA32(va[dt][0], p0, o[dt]); o[dt] = MFMA32(va[dt][1], p1, o[dt]); }
}

DI void ph_attnD(const Params& p, int layer, int* ctr, char* smem) {
  float* imps = (float*)smem;
  float* impf = (float*)(smem + 16384);
  unsigned* smask = (unsigned*)(smem + 20480);
  unsigned* s_union = (unsigned*)(smem + 20480 + 128);
  int* s_item = (int*)(smem + 20480 + 132);
  const int tid = tid_opaque(), lane = tid & 63, h = tid >> 6, l31 = lane & 31, h2 = lane >> 5;
  for (;;) {
    __syncthreads();
    if (tid == 0) { *s_item = atomicAdd(ctr, 1); *s_union = 0u; }
    __syncthreads();
    const int it = *s_item;
    if (it >= 2048) break;
    const int b = it & 31, q0 = (63 - (it >> 5)) * 32;
    const int t = q0 + l31, cur = q0 >> 6;
    const size_t tok = (size_t)b * T + t;
    bf16x8 qf[4];
    {
      const bf16_t* qp = p.QD + ((size_t)(b * 4 + h) * T + t) * 64 + h2 * 8;
#pragma unroll
      for (int ks = 0; ks < 4; ++ks) qf[ks] = *(const bf16x8*)(qp + ks * 16);
    }
    const float g0 = p.DG[tok * 12 + h * 3 + 0], g1 = p.DG[tok * 12 + h * 3 + 1], g2 = p.DG[tok * 12 + h * 3 + 2];
    f32x16 ofin[2];
    {
      const bf16_t* Kc = p.KCMP + (size_t)b * 128 * 64;
      const bf16_t* Vc = p.VCMPT + (size_t)b * 64 * 128;
      const int nkt = min(4, (q0 >> 9) + 1);
      f32x16 o[2]; o[0] = zero16(); o[1] = zero16();
      float m = -1e30f, l = 0.f;
      for (int kt = 0; kt < nkt; ++kt) {
        f32x16 s = qk_tile(Kc + kt * 32 * 64, qf, l31, h2);
#pragma unroll
        for (int r = 0; r < 16; ++r) { const int n = kt * 32 + crow(r, h2); if (16 * n + 31 > t) s[r] = -INFINITY; }
        softmax_pv(s, Vc + kt * 32, 128, o, m, l, l31, h2);
      }
      const float il = l > 0.f ? 1.f / l : 0.f;
      const float gi = g0 * il;
#pragma unroll
      for (int dt = 0; dt < 2; ++dt)
#pragma unroll
        for (int r = 0; r < 16; ++r) ofin[dt][r] = gi * o[dt][r];
      float carry = 0.f;
#pragma unroll
      for (int kt = 0; kt < 4; ++kt) {
        f32x16 s;
        if (kt < nkt) {
          s = qk_tile(Kc + kt * 32 * 64, qf, l31, h2);
#pragma unroll
          for (int r = 0; r < 16; ++r) { const int n = kt * 32 + crow(r, h2); s[r] = (16 * n + 31 > t) ? 0.f : __expf(s[r] - m) * il; }
        } else s = zero16();
        float X[4];
#pragma unroll
        for (int g = 0; g < 4; ++g) X[g] = __shfl_xor(s[4 * g + 3], 32);
#pragma unroll
        for (int g = 0; g < 4; ++g) {
          const float G = (s[4 * g] + s[4 * g + 1]) + (s[4 * g + 2] + s[4 * g + 3]);
          const float prev_other = g > 0 ? X[g - 1] : carry;
          imps[(h * 32 + l31) * 32 + 8 * kt + 2 * g + h2] = G + (h2 ? X[g] : prev_other);
        }
        carry = X[3];
      }
    }
    __syncthreads();
    {
      const int tt = tid >> 3, jg = tid & 7;
#pragma unroll
      for (int i = 0; i < 4; ++i) {
        const int j = jg * 4 + i;
        impf[tt * 32 + j] = (imps[(0 * 32 + tt) * 32 + j] + imps[(1 * 32 + tt) * 32 + j]) + (imps[(2 * 32 + tt) * 32 + j] + imps[(3 * 32 + tt) * 32 + j]);
      }
    }
    __syncthreads();
    {
      const int tt = tid >> 3, jg = tid & 7;
      float v[32];
#pragma unroll
      for (int j = 0; j < 32; ++j) {
        float x = impf[tt * 32 + j];
        if (j > cur) x = -1e30f; else if (j == 0 || j == cur || j == cur - 1) x = 1e6f;
        v[j] = x;
      }
      unsigned bits = 0u;
#pragma unroll
      for (int i = 0; i < 4; ++i) {
        int rank = 0; float vj = 0.f;
#pragma unroll
        for (int j = 0; j < 32; ++j) if (j == jg * 4 + i) vj = v[j];
        const int jj = jg * 4 + i;
#pragma unroll
        for (int j = 0; j < 32; ++j) rank += (v[j] > vj || (v[j] == vj && j < jj)) ? 1 : 0;
        if (rank < 8 && jj <= cur) bits |= 1u << jj;
      }
      bits |= __shfl_xor(bits, 1); bits |= __shfl_xor(bits, 2); bits |= __shfl_xor(bits, 4);
      if (jg == 0) { smask[tt] = bits; atomicOr(s_union, bits); }
    }
    __syncthreads();
    {
      const unsigned mymask = smask[l31], uni = *s_union;
      const bf16_t* Ks = p.KV + (size_t)(2 * NB + b) * T * 64;
      const bf16_t* Vs = p.KV + (size_t)(3 * NB + b) * 64 * T;
      f32x16 o[2]; o[0] = zero16(); o[1] = zero16();
      float m = -1e30f, l = 0.f;
      for (int j = 0; j <= cur; ++j) {
        if (!((uni >> j) & 1u)) continue;
        const bool sel = (mymask >> j) & 1u;
        for (int half = 0; half < 2; ++half) {
          const int key0 = j * 64 + half * 32;
          if (key0 > q0 + 31) break;
          f32x16 s = qk_tile(Ks + (size_t)key0 * 64, qf, l31, h2);
#pragma unroll
          for (int r = 0; r < 16; ++r) { const int key = key0 + crow(r, h2); if (!sel || key > t) s[r] = -INFINITY; }
          softmax_pv(s, Vs + key0, T, o, m, l, l31, h2);
        }
      }
      const float il = l > 0.f ? g1 / l : 0.f;
#pragma unroll
      for (int dt = 0; dt < 2; ++dt)
#pragma unroll
        for (int r = 0; r < 16; ++r) ofin[dt][r] += il * o[dt][r];
    }
    {
      const bf16_t* Kw = p.KV + (size_t)(4 * NB + b) * T * 64;
      const bf16_t* Vw = p.KV + (size_t)(5 * NB + b) * 64 * T;
      f32x16 o[2]; o[0] = zero16(); o[1] = zero16();
      float m = -1e30f, l = 0.f;
      for (int key0 = max(0, q0 - 512); key0 <= q0; key0 += 32) {
        f32x16 s = qk_tile(Kw + (size_t)key0 * 64, qf, l31, h2);
        if (key0 == q0 - 512 || key0 == q0) {
#pragma unroll
          for (int r = 0; r < 16; ++r) { const int key = key0 + crow(r, h2); if (key > t || t - key >= 512) s[r] = -INFINITY; }
        }
        softmax_pv(s, Vw + key0, T, o, m, l, l31, h2);
      }
      const float il = l > 0.f ? g2 / l : 0.f;
#pragma unroll
      for (int dt = 0; dt < 2; ++dt)
#pragma unroll
        for (int r = 0; r < 16; ++r) ofin[dt][r] += il * o[dt][r];
    }
#pragma unroll
    for (int dt = 0; dt < 2; ++dt)
#pragma unroll
      for (int g = 0; g < 4; ++g) {
        const int d0 = dt * 32 + 8 * g + 4 * h2;
        const u32x2 gz = *(const u32x2*)(p.GZ + (size_t)4 * NTOK * 256 + tok * 256 + h * 64 + d0);
        const float z0 = __uint_as_float(gz.x << 16), z1 = __uint_as_float(gz.x & 0xffff0000u), z2 = __uint_as_float(gz.y << 16), z3 = __uint_as_float(gz.y & 0xffff0000u);
        u32x2 o2 = {pack2(ofin[dt][4 * g] * z0, ofin[dt][4 * g + 1] * z1), pack2(ofin[dt][4 * g + 2] * z2, ofin[dt][4 * g + 3] * z3)};
        *(u32x2*)(p.YMIX + tok * 1024 + 768 + h * 64 + d0) = o2;
      }
  }
}


DI float logsigmoidf_(float x) { return x >= 0.f ? -log1pf(__expf(-x)) : x - log1pf(__expf(x)); }
DI void mlstm_gates(const Params& p, size_t tok0, int hh, float* bc, float* ig, int tid) {
  if (tid < 64) {
    const int s0 = 2 * tid;
    const float lf0 = logsigmoidf_(p.IFG[(tok0 + s0) * 8 + 4 + hh]), lf1 = logsigmoidf_(p.IFG[(tok0 + s0 + 1) * 8 + 4 + hh]);
    const float pair = lf0 + lf1;
    float x = pair;
#pragma unroll
    for (int off = 1; off < 64; off <<= 1) { const float y = __shfl_up(x, off); if (tid >= off) x += y; }
    const float excl = x - pair;
    bc[s0] = excl + lf0; bc[s0 + 1] = excl + pair;
    ig[s0] = p.IFG[(tok0 + s0) * 8 + hh]; ig[s0 + 1] = p.IFG[(tok0 + s0 + 1) * 8 + hh];
  }
}
DI void conv8(const bf16_t* raw, int t, int dg, const float (&cw)[4][8], const float (&cb)[8], float (&out)[8]) {
#pragma unroll
  for (int e = 0; e < 8; ++e) out[e] = cb[e];
#pragma unroll
  for (int j = 0; j < 4; ++j) {
    const int ts = t - 3 + j;
    if (ts >= 0) {
      const u32x4 row = *(const u32x4*)(raw + (size_t)ts * 64 + dg * 8);
#pragma unroll
      for (int e2 = 0; e2 < 4; ++e2) { out[2 * e2] += cw[j][2 * e2] * __uint_as_float(row[e2] << 16); out[2 * e2 + 1] += cw[j][2 * e2 + 1] * __uint_as_float(row[e2] & 0xffff0000u); }
    }
  }
#pragma unroll
  for (int e = 0; e < 8; ++e) out[e] = siluf_(out[e]);
}
DI void load_conv_w(const Params& p, int layer, int ch0, int dg, float (&cw)[4][8], float (&cb)[8]) {
#pragma unroll
  for (int j = 0; j < 4; ++j)
#pragma unroll
    for (int e = 0; e < 8; ++e) cw[j][e] = p.conv_w[layer * 2048 + j * 512 + ch0 + dg * 8 + e];
#pragma unroll
  for (int e = 0; e < 8; ++e) cb[e] = p.conv_b[layer * 512 + ch0 + dg * 8 + e];
}
DI void delta_state(const bf16_t* VT, const bf16_t* KT, float* out, int wid, int l31, int h2) {
  const int mt = wid >> 1, nt = wid & 1;
  f32x16 acc = zero16();
#pragma unroll
  for (int ks = 0; ks < 8; ++ks) {
    const bf16x8 a = *(const bf16x8*)(VT + (size_t)(mt * 32 + l31) * T + ks * 16 + h2 * 8);
    const bf16x8 bb = *(const bf16x8*)(KT + (nt * 32 + l31) * 136 + ks * 16 + h2 * 8);
    acc = MFMA32(a, bb, acc);
  }
#pragma unroll
  for (int r = 0; r < 16; ++r) out[(mt * 32 + crow(r, h2)) * 64 + nt * 32 + l31] = acc[r];
}
DI void ph_mlstm_local(const Params& p, int layer, int item, char* smem) {
  float* bc = (float*)smem; float* ig = bc + 128; float* wv = ig + 128;
  bf16_t* KwT = (bf16_t*)(smem + 2048);
  float* nred = (float*)(smem + 2048 + 64 * 136 * 2);
  const int tid = tid_opaque(), lane = tid & 63, wid = tid >> 6, l31 = lane & 31, h2 = lane >> 5;
  const int b = item >> 6, hh = (item >> 4) & 3, c = item & 15, t0 = c * 128;
  const size_t tok0 = (size_t)b * T + t0;
  __syncthreads();
  mlstm_gates(p, tok0, hh, bc, ig, tid);
  __syncthreads();
  if (tid < 128) wv[tid] = __expf(bc[127] - bc[tid] + ig[tid]);
  __syncthreads();
  {
    const int dg = tid & 7;
    float cw[4][8], cb[8];
    load_conv_w(p, layer, 256 + hh * 64, dg, cw, cb);
    const bf16_t* raw = p.QKB + ((size_t)(b * 8 + 4 + hh) * T) * 64;
#pragma unroll
    for (int i = 0; i < 4; ++i) {
      const int s = (tid >> 3) + 32 * i;
      float v[8];
      conv8(raw, t0 + s, dg, cw, cb, v);
      const float w = wv[s];
#pragma unroll
      for (int e = 0; e < 8; ++e) KwT[(dg * 8 + e) * 136 + s] = f2bf(v[e] * w);
    }
  }
  __syncthreads();
  delta_state(p.VBT + (size_t)(b * 4 + hh) * 64 * T + t0, KwT, p.BST + (size_t)item * 4096, wid, l31, h2);
  {
    const int k = tid & 63, qd = tid >> 6;
    float a = 0.f;
#pragma unroll 8
    for (int s = 0; s < 32; ++s) a += bf2f(KwT[k * 136 + qd * 32 + s]);
    nred[qd * 64 + k] = a;
  }
  __syncthreads();
  if (tid < 64) p.BN[(size_t)item * 64 + tid] = (nred[tid] + nred[64 + tid]) + (nred[128 + tid] + nred[192 + tid]);
  if (tid == 0) p.BG[item] = bc[127];
}
DI void ph_mlstm_scan(const Params& p, int bh) {
  const int tid = tid_opaque();
  f32x4 C[4];
#pragma unroll
  for (int i = 0; i < 4; ++i) C[i] = (f32x4){0.f, 0.f, 0.f, 0.f};
  float n = 0.f;
  for (int c = 0; c < 16; ++c) {
    const int item = bh * 16 + c;
    const float g = __expf(p.BG[item]);
    f32x4* ptr = (f32x4*)(p.BST + (size_t)item * 4096 + tid * 16);
#pragma unroll
    for (int i = 0; i < 4; ++i) { const f32x4 tmp = ptr[i]; ptr[i] = C[i]; C[i] = g * C[i] + tmp; }
    if (tid < 64) { const float tmp = p.BN[(size_t)item * 64 + tid]; p.BN[(size_t)item * 64 + tid] = n; n = g * n + tmp; }
  }
}
DI f32x16 qk_tile_s(const bf16_t* Krow, int stride, const bf16x8 (&qf)[4], int l31, int h2) {
  f32x16 s = zero16();
  const bf16_t* kp = Krow + l31 * stride + h2 * 8;
#pragma unroll
  for (int ks = 0; ks < 4; ++ks) { const bf16x8 a = *(const bf16x8*)(kp + ks * 16); s = MFMA32(a, qf[ks], s); }
  return s;
}
DI void pv_only(const f32x16& s, const bf16_t* VTp, int vstride, f32x16 (&o)[2], int l31, int h2) {
  const bf16x8 p0 = pack8<0>(s), p1 = pack8<8>(s);
#pragma unroll
  for (int dt = 0; dt < 2; ++dt) {
    const bf16_t* vp = VTp + (size_t)(dt * 32 + l31) * vstride + 4 * h2;
    o[dt] = MFMA32(ld_frag8x2(vp), p0, o[dt]);
    o[dt] = MFMA32(ld_frag8x2(vp + 16), p1, o[dt]);
  }
}
DI bf16x8 frag_from_f32(const float* ptr) {
  const f32x4 a = *(const f32x4*)ptr, b = *(const f32x4*)(ptr + 4);
  u32x4 t = {pack2(a[0], a[1]), pack2(a[2], a[3]), pack2(b[0], b[1]), pack2(b[2], b[3])};
  return __builtin_bit_cast(bf16x8, t);
}
DI void ph_mlstm_out(const Params& p, int layer, int item, char* smem) {
  float* bc = (float*)smem; float* ig = bc + 128;
  bf16_t* qc = (bf16_t*)(smem + 2048);
  bf16_t* kc = qc + 128 * 72;
  const int tid = tid_opaque(), lane = tid & 63, wid = tid >> 6, l31 = lane & 31, h2 = lane >> 5;
  const int b = item >> 6, hh = (item >> 4) & 3, c = item & 15, t0 = c * 128;
  const size_t tok0 = (size_t)b * T + t0;
  __syncthreads();
  mlstm_gates(p, tok0, hh, bc, ig, tid);
  {
    const int dg = tid & 7;
#pragma unroll
    for (int which = 0; which < 2; ++which) {
      float cw[4][8], cb[8];
      load_conv_w(p, layer, which * 256 + hh * 64, dg, cw, cb);
      const bf16_t* raw = p.QKB + ((size_t)(b * 8 + which * 4 + hh) * T) * 64;
      bf16_t* dst = which ? kc : qc;
      const float sc = which ? 1.f : 0.125f;
#pragma unroll
      for (int i = 0; i < 4; ++i) {
        const int s = (tid >> 3) + 32 * i;
        float v[8];
        conv8(raw, t0 + s, dg, cw, cb, v);
        u32x4 w = {pack2(v[0] * sc, v[1] * sc), pack2(v[2] * sc, v[3] * sc), pack2(v[4] * sc, v[5] * sc), pack2(v[6] * sc, v[7] * sc)};
        *(u32x4*)(dst + s * 72 + dg * 8) = w;
      }
    }
  }
  __syncthreads();
  if (tid < 128) ig[tid] = ig[tid] - bc[tid];
  __syncthreads();
  const int tq = 32 * wid + l31;
  bf16x8 qf[4];
#pragma unroll
  for (int ks = 0; ks < 4; ++ks) qf[ks] = *(const bf16x8*)(qc + tq * 72 + ks * 16 + h2 * 8);
  const float bt = bc[tq];
  f32x16 o[2]; o[0] = zero16(); o[1] = zero16();
  float dsum = 0.f;
  const bf16_t* VT = p.VBT + (size_t)(b * 4 + hh) * 64 * T + t0;
  for (int kt = 0; kt <= wid; ++kt) {
    f32x16 s = qk_tile_s(kc + kt * 32 * 72, 72, qf, l31, h2);
#pragma unroll
    for (int r = 0; r < 16; ++r) {
      const int sidx = 32 * kt + crow(r, h2);
      float val = s[r] * __expf(bt + ig[sidx]);
      if (sidx > tq) val = 0.f;
      s[r] = val; dsum += val;
    }
    pv_only(s, VT + kt * 32, T, o, l31, h2);
  }
  dsum += __shfl_xor(dsum, 32);
  const float* Cs = p.BST + (size_t)item * 4096;
  const float* ns = p.BN + (size_t)item * 64;
  f32x16 oi[2]; oi[0] = zero16(); oi[1] = zero16();
  float qn = 0.f;
#pragma unroll
  for (int ks = 0; ks < 4; ++ks) {
#pragma unroll
    for (int dt = 0; dt < 2; ++dt) oi[dt] = MFMA32(frag_from_f32(Cs + (dt * 32 + l31) * 64 + ks * 16 + h2 * 8), qf[ks], oi[dt]);
    const u32x4 qu = __builtin_bit_cast(u32x4, qf[ks]);
    const f32x4 n0 = *(const f32x4*)(ns + ks * 16 + h2 * 8), n1 = *(const f32x4*)(ns + ks * 16 + h2 * 8 + 4);
    qn += __uint_as_float(qu[0] << 16) * n0[0] + __uint_as_float(qu[0] & 0xffff0000u) * n0[1] + __uint_as_float(qu[1] << 16) * n0[2] + __uint_as_float(qu[1] & 0xffff0000u) * n0[3];
    qn += __uint_as_float(qu[2] << 16) * n1[0] + __uint_as_float(qu[2] & 0xffff0000u) * n1[1] + __uint_as_float(qu[3] << 16) * n1[2] + __uint_as_float(qu[3] & 0xffff0000u) * n1[3];
  }
  qn += __shfl_xor(qn, 32);
  const float ebt = __expf(bt);
  const float den = dsum + ebt * qn;
  const float inv = 1.f / fmaxf(fabsf(den), 1.f);
  const size_t tok = tok0 + tq;
#pragma unroll
  for (int dt = 0; dt < 2; ++dt)
#pragma unroll
    for (int g = 0; g < 4; ++g) {
      const int d0 = dt * 32 + 8 * g + 4 * h2;
      const u32x2 g1 = *(const u32x2*)(p.GZ + (size_t)1 * NTOK * 256 + tok * 256 + hh * 64 + d0);
      const u32x2 g2 = *(const u32x2*)(p.GZ + (size_t)2 * NTOK * 256 + tok * 256 + hh * 64 + d0);
      float z[4] = {__uint_as_float(g1.x << 16) * __uint_as_float(g2.x << 16), __uint_as_float(g1.x & 0xffff0000u) * __uint_as_float(g2.x & 0xffff0000u),
                    __uint_as_float(g1.y << 16) * __uint_as_float(g2.y << 16), __uint_as_float(g1.y & 0xffff0000u) * __uint_as_float(g2.y & 0xffff0000u)};
      float hv[4];
#pragma unroll
      for (int i = 0; i < 4; ++i) hv[i] = (o[dt][4 * g + i] + ebt * oi[dt][4 * g + i]) * inv * z[i];
      u32x2 o2 = {pack2(hv[0], hv[1]), pack2(hv[2], hv[3])};
      *(u32x2*)(p.YMIX + tok * 1024 + 256 + hh * 64 + d0) = o2;
    }
}


DI void ph_hgrn_local(const Params& p, int layer, int item, char* smem) {
  float* tot = (float*)smem;
  bf16_t* KdT = (bf16_t*)(smem + 1024);
  const int tid = tid_opaque(), lane = tid & 63, wid = tid >> 6, l31 = lane & 31, h2 = lane >> 5;
  const int b = item >> 6, hh = (item >> 4) & 3, c = item & 15, t0 = c * 128;
  const int k = tid & 63, qd = tid >> 6;
  float al[32], kk[32];
  {
    const float* gp = p.GC + ((size_t)(b * 4 + hh) * T + t0 + 32 * qd) * 64 + k;
    float run = 0.f;
#pragma unroll
    for (int s = 0; s < 32; ++s) { const float g = gp[s * 64]; run += g; al[s] = run; kk[s] = 1.f - __expf(g); }
    __syncthreads();
    tot[qd * 64 + k] = run;
  }
  __syncthreads();
  float off = 0.f, aL = 0.f;
#pragma unroll
  for (int q = 0; q < 4; ++q) { const float v = tot[q * 64 + k]; aL += v; if (q < qd) off += v; }
#pragma unroll
  for (int s8 = 0; s8 < 4; ++s8) {
    float v[8];
#pragma unroll
    for (int e = 0; e < 8; ++e) v[e] = kk[s8 * 8 + e] * __expf(aL - (al[s8 * 8 + e] + off));
    u32x4 w = {pack2(v[0], v[1]), pack2(v[2], v[3]), pack2(v[4], v[5]), pack2(v[6], v[7])};
    *(u32x4*)(KdT + k * 136 + qd * 32 + s8 * 8) = w;
  }
  __syncthreads();
  delta_state(p.VCT + (size_t)(b * 4 + hh) * 64 * T + t0, KdT, p.CST + (size_t)item * 4096, wid, l31, h2);
  if (qd == 0) p.CAL[(size_t)item * 64 + k] = aL;
}
DI void ph_hgrn_scan(const Params& p, int bh) {
  const int tid = tid_opaque();
  f32x4 S[4];
#pragma unroll
  for (int i = 0; i < 4; ++i) S[i] = (f32x4){0.f, 0.f, 0.f, 0.f};
  for (int c = 0; c < 16; ++c) {
    const int item = bh * 16 + c;
    const f32x4* dp = (const f32x4*)(p.CAL + (size_t)item * 64 + (tid & 3) * 16);
    f32x4* ptr = (f32x4*)(p.CST + (size_t)item * 4096 + tid * 16);
#pragma unroll
    for (int i = 0; i < 4; ++i) {
      const f32x4 a = dp[i];
      const f32x4 dec = {__expf(a[0]), __expf(a[1]), __expf(a[2]), __expf(a[3])};
      const f32x4 tmp = ptr[i]; ptr[i] = S[i]; S[i] = dec * S[i] + tmp;
    }
  }
}
DI void ph_hgrn_out(const Params& p, int layer, int item, char* smem) {
  float* a_lds = (float*)smem;
  float* tot = (float*)(smem + 128 * 68 * 4);
  const int tid = tid_opaque(), lane = tid & 63, wid = tid >> 6, l31 = lane & 31, h2 = lane >> 5;
  const int b = item >> 6, hh = (item >> 4) & 3, c = item & 15, t0 = c * 128;
  const size_t hbase = (size_t)(b * 4 + hh) * T + t0;
  {
    const int k = tid & 63, qd = tid >> 6;
    float al[32];
    const float* gp = p.GC + (hbase + 32 * qd) * 64 + k;
    float run = 0.f;
#pragma unroll
    for (int s = 0; s < 32; ++s) { run += gp[s * 64]; al[s] = run; }
    __syncthreads();
    tot[qd * 64 + k] = run;
    __syncthreads();
    float off = 0.f;
#pragma unroll
    for (int q = 0; q < 4; ++q) { const float v = tot[q * 64 + k]; if (q < qd) off += v; }
#pragma unroll
    for (int s = 0; s < 32; ++s) a_lds[(32 * qd + s) * 68 + k] = al[s] + off;
  }
  __syncthreads();
  const int tq = 32 * wid + l31;
  bf16x8 qi[4], qh[4];
#pragma unroll
  for (int ks = 0; ks < 4; ++ks) {
    const int k0 = ks * 16 + h2 * 8;
    const u32x4 qu = *(const u32x4*)(p.QC + (hbase + tq) * 64 + k0);
    float q8[8], e1[8], e2[8];
#pragma unroll
    for (int e2i = 0; e2i < 4; ++e2i) { q8[2 * e2i] = __uint_as_float(qu[e2i] << 16); q8[2 * e2i + 1] = __uint_as_float(qu[e2i] & 0xffff0000u); }
#pragma unroll
    for (int e = 0; e < 8; ++e) {
      const float a = a_lds[tq * 68 + k0 + e];
      const float r = wid > 0 ? a_lds[(32 * wid - 1) * 68 + k0 + e] : 0.f;
      e1[e] = q8[e] * __expf(a - r); e2[e] = q8[e] * __expf(a);
    }
    u32x4 w1 = {pack2(e1[0], e1[1]), pack2(e1[2], e1[3]), pack2(e1[4], e1[5]), pack2(e1[6], e1[7])};
    u32x4 w2 = {pack2(e2[0], e2[1]), pack2(e2[2], e2[3]), pack2(e2[4], e2[5]), pack2(e2[6], e2[7])};
    qi[ks] = __builtin_bit_cast(bf16x8, w1); qh[ks] = __builtin_bit_cast(bf16x8, w2);
  }
  f32x16 o[2]; o[0] = zero16(); o[1] = zero16();
  const bf16_t* VT = p.VCT + (size_t)(b * 4 + hh) * 64 * T + t0;
  for (int kt = 0; kt <= wid; ++kt) {
    f32x16 s = zero16();
    const int srow = 32 * kt + l31;
#pragma unroll
    for (int ks = 0; ks < 4; ++ks) {
      const int k0 = ks * 16 + h2 * 8;
      const f32x4 g0 = *(const f32x4*)(p.GC + (hbase + srow) * 64 + k0), g1 = *(const f32x4*)(p.GC + (hbase + srow) * 64 + k0 + 4);
      float v[8];
#pragma unroll
      for (int e = 0; e < 8; ++e) {
        const float g = e < 4 ? g0[e] : g1[e - 4];
        const float a = a_lds[srow * 68 + k0 + e];
        const float r = wid > 0 ? a_lds[(32 * wid - 1) * 68 + k0 + e] : 0.f;
        v[e] = (1.f - __expf(g)) * __expf(fminf(r - a, 80.f));
      }
      u32x4 w = {pack2(v[0], v[1]), pack2(v[2], v[3]), pack2(v[4], v[5]), pack2(v[6], v[7])};
      s = MFMA32(__builtin_bit_cast(bf16x8, w), qi[ks], s);
    }
    if (kt == wid) {
#pragma unroll
      for (int r = 0; r < 16; ++r) if (32 * kt + crow(r, h2) > tq) s[r] = 0.f;
    }
    pv_only(s, VT + kt * 32, T, o, l31, h2);
  }
  {
    const float* Ss = p.CST + (size_t)item * 4096;
#pragma unroll
    for (int ks = 0; ks < 4; ++ks)
#pragma unroll
      for (int dt = 0; dt < 2; ++dt) o[dt] = MFMA32(frag_from_f32(Ss + (dt * 32 + l31) * 64 + ks * 16 + h2 * 8), qh[ks], o[dt]);
  }
  float ss = 0.f;
#pragma unroll
  for (int dt = 0; dt < 2; ++dt)
#pragma unroll
    for (int r = 0; r < 16; ++r) ss += o[dt][r] * o[dt][r];
  ss += __shfl_xor(ss, 32);
  const float rs = rsqrtf(ss * (1.f / 64.f) + 1e-6f);
  const size_t tok = (size_t)b * T + t0 + tq;
#pragma unroll
  for (int dt = 0; dt < 2; ++dt)
#pragma unroll
    for (int g = 0; g < 4; ++g) {
      const int d0 = dt * 32 + 8 * g + 4 * h2;
      const u32x2 gz = *(const u32x2*)(p.GZ + (size_t)3 * NTOK * 256 + tok * 256 + hh * 64 + d0);
      const f32x4 gn = *(const f32x4*)(p.c_norm_g + layer * 256 + hh * 64 + d0);
      const float z0 = __uint_as_float(gz.x << 16), z1 = __uint_as_float(gz.x & 0xffff0000u), z2 = __uint_as_float(gz.y << 16), z3 = __uint_as_float(gz.y & 0xffff0000u);
      u32x2 o2 = {pack2(o[dt][4 * g] * rs * gn[0] * z0, o[dt][4 * g + 1] * rs * gn[1] * z1), pack2(o[dt][4 * g + 2] * rs * gn[2] * z2, o[dt][4 * g + 3] * rs * gn[3] * z3)};
      *(u32x2*)(p.YMIX + tok * 1024 + 512 + hh * 64 + d0) = o2;
    }
}


DI void ph_attnA(const Params& p, int layer, int item, char* smem) {
  const int tid = tid_opaque(), lane = tid & 63, h = tid >> 6, l31 = lane & 31, h2 = lane >> 5;
  const int b = item >> 6, q0 = (item & 63) * 32, g = h >> 1;
  const int t = q0 + l31;
  const size_t tok = (size_t)b * T + t;
  bf16x8 qf[4];
  {
    const bf16_t* qp = p.QA + ((size_t)(b * 4 + h) * T + t) * 64 + h2 * 8;
#pragma unroll
    for (int ks = 0; ks < 4; ++ks) qf[ks] = *(const bf16x8*)(qp + ks * 16);
  }
  const bf16_t* Kp = p.KA + (size_t)(b * 2 + g) * T * 64;
  const bf16_t* Vp = p.VAT + (size_t)(b * 2 + g) * 64 * T;
  f32x16 o[2]; o[0] = zero16(); o[1] = zero16();
  float m = -1e30f, l = 0.f;
  for (int key0 = max(0, q0 - 128); key0 <= q0; key0 += 32) {
    f32x16 s = qk_tile(Kp + (size_t)key0 * 64, qf, l31, h2);
    if (key0 == q0 - 128 || key0 == q0) {
#pragma unroll
      for (int r = 0; r < 16; ++r) { const int key = key0 + crow(r, h2); if (key > t || t - key >= 128) s[r] = -INFINITY; }
    }
    softmax_pv(s, Vp + key0, T, o, m, l, l31, h2);
  }
  const float sink = p.a_sinks[layer * 4 + h];
  const float M = fmaxf(m, sink);
  const float sc = __expf(m - M);
  const float inv = sc / (l * sc + __expf(sink - M));
#pragma unroll
  for (int dt = 0; dt < 2; ++dt)
#pragma unroll
    for (int gq = 0; gq < 4; ++gq) {
      const int d0 = dt * 32 + 8 * gq + 4 * h2;
      const u32x2 gz = *(const u32x2*)(p.GZ + tok * 256 + h * 64 + d0);
      const float z0 = __uint_as_float(gz.x << 16), z1 = __uint_as_float(gz.x & 0xffff0000u), z2 = __uint_as_float(gz.y << 16), z3 = __uint_as_float(gz.y & 0xffff0000u);
      u32x2 o2 = {pack2(o[dt][4 * gq] * inv * z0, o[dt][4 * gq + 1] * inv * z1), pack2(o[dt][4 * gq + 2] * inv * z2, o[dt][4 * gq + 3] * inv * z3)};
      *(u32x2*)(p.YMIX + tok * 1024 + h * 64 + d0) = o2;
    }
}

DI void ph_cmp(const Params& p, int layer, int item, char* smem) {
  float* red = (float*)smem;
  bf16_t* hid = (bf16_t*)(smem + 32768);
  const int tid = tid_opaque(), lane = tid & 63, wid = tid >> 6, l31 = lane & 31, h2 = lane >> 5;
  const int b = item >> 3, kvsel = (item >> 2) & 1, mt = item & 3;
  const int lk = layer * 2 + kvsel;
  const int n = min(mt * 32 + l31, 126);
  const bf16_t* src = p.KV + ((size_t)(kvsel * NB + b) * T + 16 * n) * 64 + wid * 512 + h2 * 8;
  const bf16_t* w1t = p.W1T + (size_t)lk * 64 * 2048 + wid * 512 + h2 * 8;
  f32x16 acc[2]; acc[0] = zero16(); acc[1] = zero16();
#pragma unroll 4
  for (int ks = 0; ks < 32; ++ks) {
    const bf16x8 a = *(const bf16x8*)(src + ks * 16);
    const bf16x8 b0 = *(const bf16x8*)(w1t + (size_t)l31 * 2048 + ks * 16);
    const bf16x8 b1 = *(const bf16x8*)(w1t + (size_t)(32 + l31) * 2048 + ks * 16);
    acc[0] = MFMA32(a, b0, acc[0]); acc[1] = MFMA32(a, b1, acc[1]);
  }
  __syncthreads();
#pragma unroll
  for (int nt = 0; nt < 2; ++nt)
#pragma unroll
    for (int r = 0; r < 16; ++r) red[(wid * 32 + crow(r, h2)) * 64 + nt * 32 + l31] = acc[nt][r];
  __syncthreads();
  {
    const int row = tid >> 3, c0 = (tid & 7) * 8;
    float v[8];
#pragma unroll
    for (int e = 0; e < 8; ++e) {
      const float x = (red[(0 * 32 + row) * 64 + c0 + e] + red[(1 * 32 + row) * 64 + c0 + e]) + (red[(2 * 32 + row) * 64 + c0 + e] + red[(3 * 32 + row) * 64 + c0 + e]) + p.CVEC[lk * 64 + c0 + e];
      v[e] = siluf_(x);
    }
    u32x4 w = {pack2(v[0], v[1]), pack2(v[2], v[3]), pack2(v[4], v[5]), pack2(v[6], v[7])};
    *(u32x4*)(hid + row * 72 + c0) = w;
  }
  __syncthreads();
  if (wid == 0) {
    f32x16 o[2]; o[0] = zero16(); o[1] = zero16();
    const bf16_t* w2t = p.W2T + (size_t)lk * 4096;
#pragma unroll
    for (int ks = 0; ks < 4; ++ks) {
      const bf16x8 a = *(const bf16x8*)(hid + l31 * 72 + ks * 16 + h2 * 8);
#pragma unroll
      for (int nt = 0; nt < 2; ++nt) o[nt] = MFMA32(a, *(const bf16x8*)(w2t + (nt * 32 + l31) * 64 + ks * 16 + h2 * 8), o[nt]);
    }
    if (kvsel == 0) {
#pragma unroll
      for (int r = 0; r < 16; ++r) {
        const int nn = mt * 32 + crow(r, h2);
        if (nn < 127) {
          const int pos = 16 * nn + 31;
          const float cs = p.ROPEC[pos * 32 + l31], sn = p.ROPES[pos * 32 + l31];
          p.KCMP[((size_t)b * 128 + nn) * 64 + l31] = f2bf(o[0][r] * cs - o[1][r] * sn);
          p.KCMP[((size_t)b * 128 + nn) * 64 + 32 + l31] = f2bf(o[0][r] * sn + o[1][r] * cs);
        }
      }
    } else {
#pragma unroll
      for (int nt = 0; nt < 2; ++nt)
#pragma unroll
        for (int r = 0; r < 16; ++r) {
          const int nn = mt * 32 + crow(r, h2);
          if (nn < 127) p.VCMPT[((size_t)b * 64 + nt * 32 + l31) * 128 + nn] = f2bf(o[nt][r]);
        }
    }
  }
}

__global__ void __launch_bounds__(256, 2) mega(Params p) {
  __shared__ __attribute__((aligned(16))) char smem[40960];
  cg::grid_group grid = cg::this_grid();
  const int bid = blockIdx.x, nblk = gridDim.x;
  ph_prologue(p, bid, nblk, smem);
  ln_rows(p, 0, 0, bid, nblk);
  if (PROBE == 5) { ph_prologue(p, bid, nblk, smem); ln_rows(p, 0, 0, bid, nblk); }
  grid.sync();
  for (int l = 0; l < 2; ++l) {
    ph_gemm<0>(p, l, bid, nblk, smem);
    if (PROBE == 1) ph_gemm<0>(p, l, bid, nblk, smem);
    grid.sync();
    for (int rep = 0; rep < (PROBE == 3 ? 2 : 1); ++rep) {
    for (int item = bid; item < 2048; item += nblk) ph_mlstm_local(p, l, item, smem);
    for (int item = bid; item < 2048; item += nblk) ph_hgrn_local(p, l, item, smem);
    __syncthreads();
    for (int item = bid; item < 256; item += nblk) ph_cmp(p, l, item, smem);
    for (int item = bid; item < 2048; item += nblk) ph_attnA(p, l, item, smem);
    }
    grid.sync();
    if (bid < 128) ph_mlstm_scan(p, bid);
    else if (bid < 256) ph_hgrn_scan(p, bid - 128);
    __syncthreads();
    ph_attnD(p, l, p.CTR + l, smem);
    if (PROBE == 2) ph_attnD(p, l, p.CTR + 2 + l, smem);
    grid.sync();
    for (int rep = 0; rep < (PROBE == 4 ? 2 : 1); ++rep) {
    for (int item = bid; item < 2048; item += nblk) ph_mlstm_out(p, l, item, smem);
    for (int item = bid; item < 2048; item += nblk) ph_hgrn_out(p, l, item, smem);
    }
    grid.sync();
    ph_gemm<1>(p, l, bid, nblk, smem);
    grid.sync();
    ln_rows(p, 1, l, bid, nblk);
    if (l == 0) grid.sync();
  }
}

static inline size_t align_up(size_t v) { return (v + 255) & ~(size_t)255; }

extern "C" void kernel_launch(void* const* d_in, const int* in_sizes, int n_in, void* d_out, int out_size, void* d_ws, size_t ws_size, hipStream_t stream) {
  Params p{};
  p.x = (const float*)d_in[0]; p.ln0_g = (const float*)d_in[1]; p.ln0_b = (const float*)d_in[2]; p.w_in = (const float*)d_in[3];
  p.b_in = (const float*)d_in[4]; p.a_sinks = (const float*)d_in[5]; p.conv_w = (const float*)d_in[6]; p.conv_b = (const float*)d_in[7];
  p.c_lb = (const float*)d_in[8]; p.c_norm_g = (const float*)d_in[9]; p.pe = (const float*)d_in[10]; p.w1 = (const float*)d_in[11];
  p.w2 = (const float*)d_in[12]; p.w_out = (const float*)d_in[13]; p.ln_g = (const float*)d_in[14]; p.ln_b = (const float*)d_in[15];
  p.hf = (float*)d_out;
  char* w = (char*)d_ws; size_t off = 0;
  auto take = [&](size_t bytes) { char* r = w + off; off = align_up(off + bytes); return r; };
  p.HB = (bf16_t*)take((size_t)NTOK * 1024 * 2);
  p.YMIX = (bf16_t*)take((size_t)NTOK * 1024 * 2);
  p.QA = (bf16_t*)take((size_t)NTOK * 256 * 2);
  p.KA = (bf16_t*)take((size_t)NTOK * 128 * 2);
  p.VAT = (bf16_t*)take((size_t)NTOK * 128 * 2);
  p.QKB = (bf16_t*)take((size_t)NTOK * 512 * 2);
  p.VBT = (bf16_t*)take((size_t)NTOK * 256 * 2);
  p.QC = (bf16_t*)take((size_t)NTOK * 256 * 2);
  p.GC = (float*)take((size_t)NTOK * 256 * 4);
  p.VCT = (bf16_t*)take((size_t)NTOK * 256 * 2);
  p.QD = (bf16_t*)take((size_t)NTOK * 256 * 2);
  p.KV = (bf16_t*)take((size_t)NTOK * 384 * 2);
  p.GZ = (bf16_t*)take((size_t)NTOK * 1280 * 2);
  p.IFG = (float*)take((size_t)NTOK * 8 * 4);
  p.DG = (float*)take((size_t)NTOK * 12 * 4);
  p.WT = (bf16_t*)take((size_t)2 * NP * 1024 * 2);
  p.WOT = (bf16_t*)take((size_t)2 * 1024 * 1024 * 2);
  p.KCMP = (bf16_t*)take((size_t)NB * 128 * 64 * 2);
  p.VCMPT = (bf16_t*)take((size_t)NB * 64 * 128 * 2);
  p.BIASP = (float*)take((size_t)2 * NP * 4);
  p.LB = (float*)take(512 * 4);
  p.ROPEC = (float*)take((size_t)T * 32 * 4);
  p.ROPES = (float*)take((size_t)T * 32 * 4);
  p.BST = (float*)take((size_t)2048 * 4096 * 4);
  p.BN = (float*)take((size_t)2048 * 64 * 4);
  p.BG = (float*)take(2048 * 4);
  p.CST = (float*)take((size_t)2048 * 4096 * 4);
  p.CAL = (float*)take((size_t)2048 * 64 * 4);
  p.W1T = (bf16_t*)take((size_t)4 * 64 * 2048 * 2);
  p.W2T = (bf16_t*)take((size_t)4 * 64 * 64 * 2);
  p.CVEC = (float*)take(256 * 4);
  p.CTR = (int*)take(256);
  if (off > ws_size) { fprintf(stderr, "workspace too small: need %zu have %zu\n", off, ws_size); return; }

  static int grid_blocks = 0;
  if (!grid_blocks) {
    int dev = 0, cus = 0, per_cu = 0;
    (void)hipGetDevice(&dev);
    (void)hipDeviceGetAttribute(&cus, hipDeviceAttributeMultiprocessorCount, dev);
    (void)hipOccupancyMaxActiveBlocksPerMultiprocessor(&per_cu, mega, 256, 0);
    if (per_cu > 2) per_cu = 2;
    grid_blocks = cus * per_cu;
  }
  void* args[] = {&p};
  hipError_t e = hipLaunchCooperativeKernel((void*)mega, dim3(grid_blocks), dim3(256), args, 0, stream);
  if (e != hipSuccess) fprintf(stderr, "cooperative launch failed: %s (grid %d)\n", hipGetErrorString(e), grid_blocks);
}
```

```cpp
#include <hip/hip_runtime.h>
#include <hip/hip_cooperative_groups.h>
#include <stdio.h>
#include <stdint.h>
#include <stddef.h>

#ifndef PROBE
#define PROBE 0
#endif
#define DI __device__ __forceinline__
typedef unsigned short bf16_t;
typedef short bf16x8 __attribute__((ext_vector_type(8)));
typedef float f32x16 __attribute__((ext_vector_type(16)));
typedef unsigned u32x4 __attribute__((ext_vector_type(4)));
typedef float f32x4 __attribute__((ext_vector_type(4)));

constexpr int NB = 32, T = 2048, DM = 1024, NTOK = NB * T, NP = 4096;
constexpr float DN_ALPHA = 1.41421356237309515f;

struct Params {
  const float *x, *ln0_g, *ln0_b, *w_in, *b_in, *a_sinks, *conv_w, *conv_b, *c_lb, *c_norm_g, *pe, *w1, *w2, *w_out, *ln_g, *ln_b;
  float* hf;
  bf16_t *HB, *YMIX, *QA, *KA, *VAT, *QKB, *VBT, *QC, *VCT, *QD, *KV, *GZ, *WT, *WOT, *KCMP, *VCMPT, *W1T, *W2T;
  float *GC, *IFG, *DG, *BIASP, *LB, *ROPEC, *ROPES, *BST, *BN, *BG, *CST, *CAL, *CVEC;
  int* CTR;
  unsigned* XBAR;
};
namespace cg = cooperative_groups;

DI int tid_opaque() { int t = threadIdx.x; asm volatile("" : "+v"(t)); return t; }
DI float bf2f(bf16_t v) { return __uint_as_float(((unsigned)v) << 16); }
DI bf16_t f2bf(float x) { unsigned u = __float_as_uint(x); u += 0x7fffu + ((u >> 16) & 1u); return (bf16_t)(u >> 16); }
DI float sigmoidf_(float x) { return 1.f / (1.f + __expf(-x)); }
DI float siluf_(float x) { return x / (1.f + __expf(-x)); }
DI float wave_sum(float v) { for (int o = 32; o > 0; o >>= 1) v += __shfl_xor(v, o); return v; }
DI float wave_max(float v) { for (int o = 32; o > 0; o >>= 1) v = fmaxf(v, __shfl_xor(v, o)); return v; }

DI int orig_col(int n) {
  if (n < 1536) return n;
  if (n < 3712) return n + 8;
  if (n < 3968) return n + 20;
  if (n < 3976) return 1536 + (n - 3968);
  if (n < 3988) return 3720 + (n - 3976);
  return -1;
}

DI void ph_prologue(const Params& p, int bid, int nblk, char* smem) {
  const long gtid = (long)bid * 256 + tid_opaque(), gsz = (long)nblk * 256;
  if (gtid < 64) p.CTR[gtid] = 0;
  for (long idx = gtid; idx < 2L * 128 * NP; idx += gsz) {
    const int n = (int)(idx % NP), k8 = (int)((idx / NP) % 128), l = (int)(idx / (NP * 128));
    const int oc = orig_col(n);
    unsigned w[4];
    for (int j = 0; j < 4; ++j) {
      float a = 0.f, b = 0.f;
      if (oc >= 0) { a = p.w_in[((size_t)l * 1024 + k8 * 8 + 2 * j) * 3988 + oc]; b = p.w_in[((size_t)l * 1024 + k8 * 8 + 2 * j + 1) * 3988 + oc]; }
      w[j] = (unsigned)f2bf(a) | ((unsigned)f2bf(b) << 16);
    }
    *(uint4*)(p.WT + ((size_t)l * NP + n) * 1024 + k8 * 8) = make_uint4(w[0], w[1], w[2], w[3]);
  }
  for (long idx = gtid; idx < 2L * 128 * 1024; idx += gsz) {
    const int d = (int)(idx % 1024), m8 = (int)((idx / 1024) % 128), l = (int)(idx / (1024 * 128));
    unsigned w[4];
    for (int j = 0; j < 4; ++j) {
      float a = p.w_out[((size_t)l * 1024 + m8 * 8 + 2 * j) * 1024 + d], b = p.w_out[((size_t)l * 1024 + m8 * 8 + 2 * j + 1) * 1024 + d];
      w[j] = (unsigned)f2bf(a) | ((unsigned)f2bf(b) << 16);
    }
    *(uint4*)(p.WOT + ((size_t)l * 1024 + d) * 1024 + m8 * 8) = make_uint4(w[0], w[1], w[2], w[3]);
  }
  for (long idx = gtid; idx < 4L * 256 * 64; idx += gsz) {
    const int j = (int)(idx % 64), i8 = (int)((idx / 64) % 256), lk = (int)(idx / (64 * 256));
    unsigned w[4];
    for (int e = 0; e < 4; ++e) {
      const float a = p.w1[((size_t)lk * 2048 + i8 * 8 + 2 * e) * 64 + j], b = p.w1[((size_t)lk * 2048 + i8 * 8 + 2 * e + 1) * 64 + j];
      w[e] = (unsigned)f2bf(a) | ((unsigned)f2bf(b) << 16);
    }
    *(uint4*)(p.W1T + ((size_t)lk * 64 + j) * 2048 + i8 * 8) = make_uint4(w[0], w[1], w[2], w[3]);
  }
  for (long idx = gtid; idx < 4L * 64 * 64; idx += gsz) {
    const int jo = (int)(idx % 64), ji = (int)((idx / 64) % 64), lk = (int)(idx / 4096);
    p.W2T[((size_t)lk * 64 + jo) * 64 + ji] = f2bf(p.w2[((size_t)lk * 64 + ji) * 64 + jo]);
  }
  if (bid < 4) {
    const int lk = bid, j = tid_opaque() & 63, part = tid_opaque() >> 6;
    float a = 0.f;
    for (int i = part * 512; i < part * 512 + 512; ++i) a += p.pe[(size_t)lk * 2048 + i] * p.w1[((size_t)lk * 2048 + i) * 64 + j];
    float* red = (float*)smem;
    red[part * 64 + j] = a;
    __syncthreads();
    if (part == 0) p.CVEC[lk * 64 + j] = (red[j] + red[64 + j]) + (red[128 + j] + red[192 + j]);
    __syncthreads();
  }
  for (long idx = gtid; idx < 2L * NP; idx += gsz) {
    const int n = (int)(idx % NP), l = (int)(idx / NP); const int oc = orig_col(n);
    p.BIASP[idx] = oc >= 0 ? p.b_in[l * 3988 + oc] : 0.f;
  }
  for (long idx = gtid; idx < (long)T * 32; idx += gsz) {
    const int t = (int)(idx / 32), i = (int)(idx % 32);
    const float inv = powf(10000.0f, -(float)i / 32.0f);
    const float ang = (float)t * inv;
    p.ROPEC[idx] = cosf(ang); p.ROPES[idx] = sinf(ang);
  }
  for (long idx = gtid; idx < 512; idx += gsz) {
    const int c = (int)(idx % 256), l = (int)(idx / 256);
    const float a = p.c_lb[c], b = p.c_lb[256 + c];
    const float m = fmaxf(a, b); const float ea = expf(a - m), eb = expf(b - m);
    p.LB[idx] = l == 0 ? 0.f : eb / (ea + eb);
  }
}

DI void ln_rows(const Params& p, int mode, int layer, int bid, int nblk) {
  const int tid_ = tid_opaque(); const int lane = tid_ & 63, wid = tid_ >> 6, nw = 4;
  const float* g = mode == 0 ? p.ln0_g : p.ln_g + layer * 1024;
  const float* bb = mode == 0 ? p.ln0_b : p.ln_b + layer * 1024;
  const float* src = mode == 0 ? p.x : p.hf;
  for (int row = bid * nw + wid; row < NTOK; row += nblk * nw) {
    const float* s = src + (size_t)row * 1024;
    float4 v[4];
    float sum = 0.f;
#pragma unroll
    for (int i = 0; i < 4; ++i) { v[i] = *(const float4*)(s + i * 256 + lane * 4); sum += (v[i].x + v[i].y) + (v[i].z + v[i].w); }
    sum = wave_sum(sum);
    const float mu = sum * (1.f / 1024.f);
    float q = 0.f;
#pragma unroll
    for (int i = 0; i < 4; ++i) { float a = v[i].x - mu, b = v[i].y - mu, c = v[i].z - mu, d = v[i].w - mu; q += (a * a + b * b) + (c * c + d * d); }
    q = wave_sum(q);
    const float rs = rsqrtf(q * (1.f / 1024.f) + 1e-5f);
#pragma unroll
    for (int i = 0; i < 4; ++i) {
      const int c0 = i * 256 + lane * 4;
      const float4 gg = *(const float4*)(g + c0), b4 = *(const float4*)(bb + c0);
      float4 o;
      o.x = (v[i].x - mu) * rs * gg.x + b4.x; o.y = (v[i].y - mu) * rs * gg.y + b4.y;
      o.z = (v[i].z - mu) * rs * gg.z + b4.z; o.w = (v[i].w - mu) * rs * gg.w + b4.w;
      *(float4*)(p.hf + (size_t)row * 1024 + c0) = o;
      uint2 pk; pk.x = (unsigned)f2bf(o.x) | ((unsigned)f2bf(o.y) << 16); pk.y = (unsigned)f2bf(o.z) | ((unsigned)f2bf(o.w) << 16);
      *(uint2*)(p.HB + (size_t)row * 1024 + c0) = pk;
    }
  }
}

typedef float f32x2 __attribute__((ext_vector_type(2)));
typedef __bf16 bf16v2 __attribute__((ext_vector_type(2)));
typedef unsigned u32x2 __attribute__((ext_vector_type(2)));
DI unsigned pack2(float a, float b) { f32x2 v = {a, b}; return __builtin_bit_cast(unsigned, __builtin_convertvector(v, bf16v2)); }
DI f32x16 zero16() { f32x16 z;
#pragma unroll
  for (int i = 0; i < 16; ++i) z[i] = 0.f; return z; }
DI bf16x8 ld_frag8x2(const bf16_t* p) { const u32x2 lo = *(const u32x2*)p, hi = *(const u32x2*)(p + 8); u32x4 t = {lo.x, lo.y, hi.x, hi.y}; return __builtin_bit_cast(bf16x8, t); }
template <int BASE> DI bf16x8 pack8(const f32x16& s) {
  u32x4 t = {pack2(s[BASE + 0], s[BASE + 1]), pack2(s[BASE + 2], s[BASE + 3]), pack2(s[BASE + 4], s[BASE + 5]), pack2(s[BASE + 6], s[BASE + 7])};
  return __builtin_bit_cast(bf16x8, t);
}
DI int crow(int r, int h2) { return (r & 3) + 8 * (r >> 2) + 4 * h2; }
#define MFMA32(a, b, c) __builtin_amdgcn_mfma_f32_32x32x16_bf16((a), (b), (c), 0, 0, 0)
enum { K_NONE = 0, K_ROPE, K_PLAIN, K_TR, K_GSILU, K_GSIG, K_SILUH, K_LOGF, K_SMALL };

template <int KIND>
DI void epi_inproj(const Params& p, const f32x16 (&acc)[2][2], bf16_t* dst, float* fdst, float scale, float bias0, float bias1, float lb0, float lb1,
                   int b, int t0, int lane, char* img) {
  const int l31 = lane & 31, h2 = lane >> 5;
  if (KIND == K_SMALL) {
#pragma unroll
    for (int mt = 0; mt < 2; ++mt)
#pragma unroll
      for (int r = 0; r < 16; ++r) {
        const int t = t0 + mt * 32 + crow(r, h2);
        const size_t tok = (size_t)b * T + t;
        const float v0 = acc[mt][0][r] + bias0;
        if (l31 < 8) p.IFG[tok * 8 + l31] = v0;
        else if (l31 < 20) p.DG[tok * 12 + (l31 - 8)] = sigmoidf_(v0);
      }
    return;
  }
  if (KIND == K_LOGF) {
#pragma unroll
    for (int mt = 0; mt < 2; ++mt) {
      float* fimg = (float*)img;
#pragma unroll
      for (int r = 0; r < 16; ++r) {
        const float v0 = acc[mt][0][r] + bias0, v1 = acc[mt][1][r] + bias1;
        const float f0 = lb0 + (1.f - lb0) * sigmoidf_(v0), f1 = lb1 + (1.f - lb1) * sigmoidf_(v1);
        fimg[crow(r, h2) * 64 + l31] = __logf(f0); fimg[crow(r, h2) * 64 + 32 + l31] = __logf(f1);
      }
#pragma unroll
      for (int i = 0; i < 8; ++i) {
        const int q = lane + 64 * i;
        *(u32x4*)(fdst + (size_t)(t0 + mt * 32) * 64 + q * 4) = *(const u32x4*)(img + q * 16);
      }
    }
    return;
  }
  bf16_t* bimg = (bf16_t*)img;
  if (KIND == K_TR) {
#pragma unroll
    for (int mt = 0; mt < 2; ++mt)
#pragma unroll
      for (int nt = 0; nt < 2; ++nt)
#pragma unroll
        for (int g = 0; g < 4; ++g) {
          const float bs = nt ? bias1 : bias0;
          u32x2 w = {pack2(acc[mt][nt][4 * g] + bs, acc[mt][nt][4 * g + 1] + bs), pack2(acc[mt][nt][4 * g + 2] + bs, acc[mt][nt][4 * g + 3] + bs)};
          *(u32x2*)(bimg + (nt * 32 + l31) * 64 + mt * 32 + 8 * g + 4 * h2) = w;
        }
#pragma unroll
    for (int i = 0; i < 8; ++i) {
      const int q = lane + 64 * i, c = q >> 3, rc = q & 7;
      *(u32x4*)(dst + (size_t)c * T + t0 + rc * 8) = *(const u32x4*)(img + q * 16);
    }
    return;
  }
#pragma unroll
  for (int mt = 0; mt < 2; ++mt)
#pragma unroll
    for (int r = 0; r < 16; ++r) {
      const int row = mt * 32 + crow(r, h2);
      const float v0 = acc[mt][0][r] + bias0, v1 = acc[mt][1][r] + bias1;
      float o0, o1;
      if (KIND == K_ROPE) {
        const int t = t0 + row;
        const float c = p.ROPEC[t * 32 + l31], s = p.ROPES[t * 32 + l31];
        o0 = (v0 * c - v1 * s) * scale; o1 = (v0 * s + v1 * c) * scale;
      } else if (KIND == K_PLAIN) { o0 = v0; o1 = v1; }
      else if (KIND == K_SILUH || KIND == K_GSILU) { o0 = siluf_(v0); o1 = siluf_(v1); }
      else { o0 = sigmoidf_(v0); o1 = sigmoidf_(v1); }
      bimg[row * 64 + l31] = f2bf(o0); bimg[row * 64 + 32 + l31] = f2bf(o1);
    }
  if (KIND == K_GSILU || KIND == K_GSIG) {
#pragma unroll
    for (int i = 0; i < 8; ++i) {
      const int q = lane + 64 * i, row = q >> 3, c16 = q & 7;
      *(u32x4*)(dst + ((size_t)b * T + t0 + row) * 256 + c16 * 8) = *(const u32x4*)(img + q * 16);
    }
  } else {
#pragma unroll
    for (int i = 0; i < 8; ++i) {
      const int q = lane + 64 * i;
      *(u32x4*)(dst + (size_t)t0 * 64 + q * 8) = *(const u32x4*)(img + q * 16);
    }
  }
}

#define LAS __attribute__((address_space(3)))
template <int MODE>
DI void gemm_mainloop(const Params& p, int layer, int pm, int pn, char* smem, f32x16 (&acc)[2][2]) {
  const int tid = tid_opaque(), lane = tid & 63, wid = tid >> 6, wm = wid >> 1, wn = wid & 1;
  const int l31 = lane & 31, h2 = lane >> 5;
  const bf16_t* A = (MODE == 0 ? p.HB : p.YMIX) + (size_t)pm * 128 * 1024;
  const bf16_t* Bt = (MODE == 0 ? p.WT + (size_t)layer * NP * 1024 : p.WOT + (size_t)layer * 1024 * 1024) + (size_t)pn * 128 * 1024;
  bf16_t* sA = (bf16_t*)smem;
  bf16_t* sB = sA + 128 * 72;
#pragma unroll
  for (int i = 0; i < 2; ++i)
#pragma unroll
    for (int j = 0; j < 2; ++j)
#pragma unroll
      for (int r = 0; r < 16; ++r) acc[i][j][r] = 0.f;
  const int lr = tid >> 3, lc = (tid & 7) * 8;
  u32x4 ra[4], rb[4];
#pragma unroll
  for (int i = 0; i < 4; ++i) { ra[i] = *(const u32x4*)(A + (size_t)(lr + 32 * i) * 1024 + lc); rb[i] = *(const u32x4*)(Bt + (size_t)(lr + 32 * i) * 1024 + lc); }
  for (int kt = 0; kt < 16; ++kt) {
    __syncthreads();
#pragma unroll
    for (int i = 0; i < 4; ++i) { *(u32x4*)(sA + (lr + 32 * i) * 72 + lc) = ra[i]; *(u32x4*)(sB + (lr + 32 * i) * 72 + lc) = rb[i]; }
    __syncthreads();
    if (kt + 1 < 16) {
#pragma unroll
      for (int i = 0; i < 4; ++i) { ra[i] = *(const u32x4*)(A + (size_t)(lr + 32 * i) * 1024 + (kt + 1) * 64 + lc); rb[i] = *(const u32x4*)(Bt + (size_t)(lr + 32 * i) * 1024 + (kt + 1) * 64 + lc); }
    }
#pragma unroll
    for (int ks = 0; ks < 4; ++ks) {
      bf16x8 af[2], bfr[2];
#pragma unroll
      for (int mt = 0; mt < 2; ++mt) af[mt] = *(const bf16x8*)(sA + (wm * 64 + mt * 32 + l31) * 72 + ks * 16 + h2 * 8);
#pragma unroll
      for (int nt = 0; nt < 2; ++nt) bfr[nt] = *(const bf16x8*)(sB + (wn * 64 + nt * 32 + l31) * 72 + ks * 16 + h2 * 8);
#pragma unroll
      for (int mt = 0; mt < 2; ++mt)
#pragma unroll
        for (int nt = 0; nt < 2; ++nt) acc[mt][nt] = __builtin_amdgcn_mfma_f32_32x32x16_bf16(af[mt], bfr[nt], acc[mt][nt], 0, 0, 0);
    }
  }
}
template <int MODE>
DI void gemm_epilogue(const Params& p, int layer, int pm, int pn, const f32x16 (&acc)[2][2], char* smem) {
  const int tid = tid_opaque(), lane = tid & 63, wid = tid >> 6, wm = wid >> 1, wn = wid & 1;
  const int l31 = lane & 31, h2 = lane >> 5;
  if (MODE == 1) {
#pragma unroll
    for (int mt = 0; mt < 2; ++mt)
#pragma unroll
      for (int nt = 0; nt < 2; ++nt)
#pragma unroll
        for (int r = 0; r < 16; ++r) {
          const int row = pm * 128 + wm * 64 + mt * 32 + (r & 3) + 8 * (r >> 2) + 4 * h2;
          const int col = pn * 128 + wn * 64 + nt * 32 + l31;
          float* dst = p.hf + (size_t)row * 1024 + col;
          *dst = DN_ALPHA * (*dst) + acc[mt][nt][r];
        }
    return;
  }
  const int hd = pn * 2 + wn;
  const int b = pm >> 4, t0 = (pm & 15) * 128 + wm * 64;
  int kind = K_NONE; bf16_t* dst = nullptr; float scale = 1.f; float* fdst = nullptr;
  if (hd < 4) { kind = K_ROPE; dst = p.QA + ((size_t)(b * 4 + hd) * T) * 64; scale = 0.125f; }
  else if (hd < 6) { kind = K_ROPE; dst = p.KA + ((size_t)(b * 2 + hd - 4) * T) * 64; }
  else if (hd < 8) { kind = K_TR; dst = p.VAT + (size_t)(b * 2 + hd - 6) * 64 * T; }
  else if (hd < 12) { kind = K_GSILU; dst = p.GZ + (size_t)0 * NTOK * 256 + (hd - 8) * 64; }
  else if (hd < 20) { kind = K_PLAIN; dst = p.QKB + ((size_t)(b * 8 + hd - 12) * T) * 64; }
  else if (hd < 24) { kind = K_TR; dst = p.VBT + (size_t)(b * 4 + hd - 20) * 64 * T; }
  else if (hd < 28) { kind = K_GSIG; dst = p.GZ + (size_t)1 * NTOK * 256 + (hd - 24) * 64; }
  else if (hd < 32) { kind = K_GSILU; dst = p.GZ + (size_t)2 * NTOK * 256 + (hd - 28) * 64; }
  else if (hd < 36) { kind = K_SILUH; dst = p.QC + ((size_t)(b * 4 + hd - 32) * T) * 64; }
  else if (hd < 40) { kind = K_LOGF; fdst = p.GC + ((size_t)(b * 4 + hd - 36) * T) * 64; }
  else if (hd < 44) { kind = K_TR; dst = p.VCT + (size_t)(b * 4 + hd - 40) * 64 * T; }
  else if (hd < 48) { kind = K_GSILU; dst = p.GZ + (size_t)3 * NTOK * 256 + (hd - 44) * 64; }
  else if (hd < 52) { kind = K_ROPE; dst = p.QD + ((size_t)(b * 4 + hd - 48) * T) * 64; scale = 0.125f; }
  else if (hd < 58) {
    const int j = hd - 52;
    dst = p.KV + (size_t)(j * NB + b) * T * 64;
    kind = (j == 0 || j == 1) ? K_PLAIN : ((j == 2 || j == 4) ? K_ROPE : K_TR);
  }
  else if (hd < 62) { kind = K_GSILU; dst = p.GZ + (size_t)4 * NTOK * 256 + (hd - 58) * 64; }
  else if (hd == 62) { kind = K_SMALL; }
  __syncthreads();
  if (kind == K_NONE) return;
  const float bias0 = p.BIASP[layer * NP + hd * 64 + l31], bias1 = p.BIASP[layer * NP + hd * 64 + 32 + l31];
  float lb0 = 0.f, lb1 = 0.f;
  if (kind == K_LOGF) { lb0 = p.LB[layer * 256 + (hd - 36) * 64 + l31]; lb1 = p.LB[layer * 256 + (hd - 36) * 64 + 32 + l31]; }
  char* img = smem + wid * 8192;
  switch (kind) {
    case K_ROPE: epi_inproj<K_ROPE>(p, acc, dst, fdst, scale, bias0, bias1, lb0, lb1, b, t0, lane, img); break;
    case K_PLAIN: epi_inproj<K_PLAIN>(p, acc, dst, fdst, scale, bias0, bias1, lb0, lb1, b, t0, lane, img); break;
    case K_TR: epi_inproj<K_TR>(p, acc, dst, fdst, scale, bias0, bias1, lb0, lb1, b, t0, lane, img); break;
    case K_GSILU: epi_inproj<K_GSILU>(p, acc, dst, fdst, scale, bias0, bias1, lb0, lb1, b, t0, lane, img); break;
    case K_GSIG: epi_inproj<K_GSIG>(p, acc, dst, fdst, scale, bias0, bias1, lb0, lb1, b, t0, lane, img); break;
    case K_SILUH: epi_inproj<K_SILUH>(p, acc, dst, fdst, scale, bias0, bias1, lb0, lb1, b, t0, lane, img); break;
    case K_LOGF: epi_inproj<K_LOGF>(p, acc, dst, fdst, scale, bias0, bias1, lb0, lb1, b, t0, lane, img); break;
    case K_SMALL: epi_inproj<K_SMALL>(p, acc, dst, fdst, scale, bias0, bias1, lb0, lb1, b, t0, lane, img); break;
    default: break;
  }
}

template <int MODE>
DI void ph_gemm(const Params& p, int layer, int bid, int nblk, char* smem) {
  constexpr int NG = MODE == 0 ? 8 : 2;
  const int x = bid & 7, slot = bid >> 3, per = nblk >> 3;
  const int half = x >> 2, pnbase = NG * (x & 3);
  for (int i = slot; i < 256 * NG; i += per) {
    const int pm = 2 * (i / NG) + half, pn = pnbase + (i % NG);
    f32x16 acc[2][2];
    gemm_mainloop<MODE>(p, layer, pm, pn, smem, acc);
    if (PROBE == 6 && MODE == 0) {
      f32x16 acc2[2][2];
      gemm_mainloop<MODE>(p, layer, pm, pn, smem, acc2);
      if (acc2[0][0][0] == 1.2345e30f || acc2[1][1][5] == 1.2345e30f || acc2[0][1][7] == 1.2345e30f || acc2[1][0][9] == 1.2345e30f) acc[0][0][0] += 1.f;
    }
    gemm_epilogue<MODE>(p, layer, pm, pn, acc, smem);
    if (PROBE == 7 && MODE == 0) gemm_epilogue<MODE>(p, layer, pm, pn, acc, smem);
  }
}

DI void ph_naiveA(const Params& p, int layer, int bid, int nblk, char* smem) {
  float (*ps)[128] = (float (*)[128])smem;
  const int tid_ = tid_opaque(); const int lane = tid_ & 63, h = tid_ >> 6;
  for (int tok = bid; tok < NTOK; tok += nblk) {
    const int b = tok / T, t = tok % T, g = h >> 1;
    const bf16_t* q = p.QA + ((size_t)(b * 4 + h) * T + t) * 64;
    const bf16_t* K = p.KA + (size_t)(b * 2 + g) * T * 64;
    const bf16_t* VT = p.VAT + (size_t)(b * 2 + g) * 64 * T;
    float sc[2];
    for (int i = 0; i < 2; ++i) {
      const int s = t - 127 + lane + 64 * i;
      float d = -INFINITY;
      if (s >= 0) { d = 0.f; for (int e = 0; e < 64; ++e) d += bf2f(q[e]) * bf2f(K[(size_t)s * 64 + e]); }
      sc[i] = d;
    }
    const float sink = p.a_sinks[layer * 4 + h];
    float m = fmaxf(wave_max(fmaxf(sc[0], sc[1])), sink);
    const float e0 = __expf(sc[0] - m), e1 = __expf(sc[1] - m);
    const float l = wave_sum(e0 + e1) + __expf(sink - m);
    __syncthreads();
    ps[h][lane] = e0; ps[h][lane + 64] = e1;
    __syncthreads();
    float o = 0.f;
    for (int j = 0; j < 128; ++j) { const int s = t - 127 + j; if (s >= 0) o += ps[h][j] * bf2f(VT[(size_t)lane * T + s]); }
    o /= l;
    const float gz = bf2f(p.GZ[(size_t)0 * NTOK * 256 + (size_t)tok * 256 + h * 64 + lane]);
    p.YMIX[(size_t)tok * 1024 + h * 64 + lane] = f2bf(o * gz);
  }
}

DI void ph_naiveB(const Params& p, int layer, int bid, int nblk, char* smem) {
  float* qs = (float*)smem; float* ks = qs + 2048; float* vs = ks + 2048; float* ig = vs + 2048; float* fg = ig + 32;
  const int tid = tid_opaque(), v = tid >> 2, kq = tid & 3;
  for (int item = bid; item < NB * 4; item += nblk) {
    const int b = item >> 2, hh = item & 3;
    float C[16], n[16];
    for (int i = 0; i < 16; ++i) { C[i] = 0.f; n[i] = 0.f; }
    const bf16_t* rawq = p.QKB + ((size_t)(b * 8 + hh) * T) * 64;
    const bf16_t* rawk = p.QKB + ((size_t)(b * 8 + 4 + hh) * T) * 64;
    const float* cw = p.conv_w + layer * 4 * 512; const float* cb = p.conv_b + layer * 512;
    for (int t0 = 0; t0 < T; t0 += 32) {
      __syncthreads();
      for (int e = tid; e < 2 * 32 * 64; e += 256) {
        const int which = e / 2048, tt = (e % 2048) / 64, d = e % 64, t = t0 + tt;
        const bf16_t* raw = which ? rawk : rawq; const int ch = (which ? 256 : 0) + hh * 64 + d;
        float a = cb[ch];
        for (int j = 0; j < 4; ++j) { const int ts = t - 3 + j; if (ts >= 0) a += cw[j * 512 + ch] * bf2f(raw[(size_t)ts * 64 + d]); }
        float sv = siluf_(a); if (!which) sv *= 0.125f;
        (which ? ks : qs)[tt * 64 + d] = sv;
      }
      for (int e = tid; e < 32 * 64; e += 256) { const int tt = e / 64, d = e % 64; vs[tt * 64 + d] = bf2f(p.VBT[((size_t)(b * 4 + hh) * 64 + d) * T + t0 + tt]); }
      if (tid < 32) { const size_t tok = (size_t)b * T + t0 + tid; ig[tid] = p.IFG[tok * 8 + hh]; fg[tid] = sigmoidf_(p.IFG[tok * 8 + 4 + hh]); }
      __syncthreads();
      for (int tt = 0; tt < 32; ++tt) {
        const float f = fg[tt], iw = __expf(ig[tt]); const float vv = vs[tt * 64 + v] * iw;
        float num = 0.f, den = 0.f;
#pragma unroll
        for (int kk = 0; kk < 16; ++kk) {
          const float kv = ks[tt * 64 + kq * 16 + kk], qv = qs[tt * 64 + kq * 16 + kk];
          C[kk] = f * C[kk] + vv * kv; n[kk] = f * n[kk] + iw * kv; num += C[kk] * qv; den += n[kk] * qv;
        }
        num += __shfl_xor(num, 1); num += __shfl_xor(num, 2); den += __shfl_xor(den, 1); den += __shfl_xor(den, 2);
        const float hval = num / fmaxf(fabsf(den), 1.f);
        if (kq == 0) {
          const size_t tok = (size_t)b * T + t0 + tt; const int col = hh * 64 + v;
          const float y = bf2f(p.GZ[(size_t)1 * NTOK * 256 + tok * 256 + col]) * hval * bf2f(p.GZ[(size_t)2 * NTOK * 256 + tok * 256 + col]);
          p.YMIX[tok * 1024 + 256 + col] = f2bf(y);
        }
      }
    }
  }
}

DI void ph_naiveC(const Params& p, int layer, int bid, int nblk, char* smem) {
  float* qs = (float*)smem; float* fs = qs + 2048; float* vs = fs + 2048; float* os = vs + 2048;
  const int tid = tid_opaque(), v = tid >> 2, kq = tid & 3;
  for (int item = bid; item < NB * 4; item += nblk) {
    const int b = item >> 2, hh = item & 3;
    float S[16];
    for (int i = 0; i < 16; ++i) S[i] = 0.f;
    for (int t0 = 0; t0 < T; t0 += 32) {
      __syncthreads();
      for (int e = tid; e < 32 * 64; e += 256) {
        const int tt = e / 64, d = e % 64;
        const size_t off = ((size_t)(b * 4 + hh) * T + t0 + tt) * 64 + d;
        qs[e] = bf2f(p.QC[off]); fs[e] = __expf(p.GC[off]);
        vs[e] = bf2f(p.VCT[((size_t)(b * 4 + hh) * 64 + d) * T + t0 + tt]);
      }
      __syncthreads();
      for (int tt = 0; tt < 32; ++tt) {
        const float vv = vs[tt * 64 + v];
        float o = 0.f;
#pragma unroll
        for (int kk = 0; kk < 16; ++kk) {
          const float f = fs[tt * 64 + kq * 16 + kk], qv = qs[tt * 64 + kq * 16 + kk];
          S[kk] = f * S[kk] + (1.f - f) * vv; o += qv * S[kk];
        }
        o += __shfl_xor(o, 1); o += __shfl_xor(o, 2);
        if (kq == 0) os[tt * 64 + v] = o;
      }
      __syncthreads();
      {
        const int tt = tid >> 3, j = tid & 7;
        float ss = 0.f;
        for (int i = 0; i < 8; ++i) { const float o = os[tt * 64 + j * 8 + i]; ss += o * o; }
        ss += __shfl_xor(ss, 1); ss += __shfl_xor(ss, 2); ss += __shfl_xor(ss, 4);
        const float rs = rsqrtf(ss * (1.f / 64.f) + 1e-6f);
        const size_t tok = (size_t)b * T + t0 + tt;
        for (int i = 0; i < 8; ++i) {
          const int col = hh * 64 + j * 8 + i;
          const float y = os[tt * 64 + j * 8 + i] * rs * p.c_norm_g[layer * 256 + col] * bf2f(p.GZ[(size_t)3 * NTOK * 256 + tok * 256 + col]);
          p.YMIX[tok * 1024 + 512 + col] = f2bf(y);
        }
      }
    }
  }
}

DI void ph_naive_cmp(const Params& p, int layer, int bid, int nblk, char* smem) {
  float (*hs)[64] = (float (*)[64])smem; float (*os)[64] = (float (*)[64])(smem + 512);
  const int tid = tid_opaque(), kvsel = (tid >> 6) & 1, j = tid & 63;
  const bool act = tid < 128;
  for (int item = bid; item < NB * 127; item += nblk) {
    const int b = item / 127, n = item % 127;
    const bf16_t* src = p.KV + ((size_t)(kvsel * NB + b) * T + 16 * n) * 64;
    const float* w1 = p.w1 + ((size_t)(layer * 2 + kvsel) * 2048) * 64;
    const float* pe = p.pe + (size_t)(layer * 2 + kvsel) * 2048;
    float a = 0.f;
    if (act) for (int i = 0; i < 2048; ++i) a += (bf2f(src[i]) + pe[i]) * w1[(size_t)i * 64 + j];
    __syncthreads();
    if (act) hs[kvsel][j] = siluf_(a);
    __syncthreads();
    const float* w2 = p.w2 + (size_t)(layer * 2 + kvsel) * 4096;
    float o = 0.f;
    if (act) { for (int i = 0; i < 64; ++i) o += hs[kvsel][i] * w2[i * 64 + j]; os[kvsel][j] = o; }
    __syncthreads();
    if (act) {
      if (kvsel == 0) {
        if (j < 32) {
          const int pos = 16 * n + 31;
          const float c = p.ROPEC[pos * 32 + j], s = p.ROPES[pos * 32 + j];
          const float x1 = os[0][j], x2 = os[0][j + 32];
          p.KCMP[((size_t)b * 128 + n) * 64 + j] = f2bf(x1 * c - x2 * s);
          p.KCMP[((size_t)b * 128 + n) * 64 + 32 + j] = f2bf(x1 * s + x2 * c);
        }
      } else {
        p.VCMPT[((size_t)b * 64 + j) * 128 + n] = f2bf(o);
      }
    }
  }
}

DI float dot64_lds(const float* q, const bf16_t* kp) {
  float d = 0.f;
#pragma unroll
  for (int e8 = 0; e8 < 8; ++e8) {
    const u32x4 w = *(const u32x4*)(kp + e8 * 8);
#pragma unroll
    for (int j = 0; j < 4; ++j) { d += q[e8 * 8 + 2 * j] * __uint_as_float(w[j] << 16); d += q[e8 * 8 + 2 * j + 1] * __uint_as_float(w[j] & 0xffff0000u); }
  }
  return d;
}
DI void ph_naiveD(const Params& p, int layer, int* ctr, char* smem) {
  float (*pc)[128] = (float (*)[128])smem; float* impv = (float*)(smem + 2048); float (*pbuf)[512] = (float (*)[512])(smem + 2048 + 128);
  float (*qsh)[64] = (float (*)[64])(smem + 2048 + 128 + 8192); int* selblk = (int*)(smem + 2048 + 128 + 8192 + 1024); int* s_item = selblk + 8;
  const int tid = tid_opaque(), lane = tid & 63, h = tid >> 6;
  for (;;) {
    __syncthreads();
    if (tid == 0) *s_item = atomicAdd(ctr, 1);
    __syncthreads();
    const int tok = *s_item;
    if (tok >= NTOK) break;
    const int b = tok / T, t = tok % T, cur = t >> 6;
    __syncthreads();
    qsh[h][lane] = bf2f(p.QD[((size_t)(b * 4 + h) * T + t) * 64 + lane]);
    __syncthreads();
    const float* q = qsh[h];
    float o_cmp;
    {
      float sc0 = -INFINITY, sc1 = -INFINITY;
      { const int n = lane; if (16 * n + 31 <= t) sc0 = dot64_lds(q, p.KCMP + ((size_t)b * 128 + n) * 64); }
      { const int n = lane + 64; if (n < 127 && 16 * n + 31 <= t) sc1 = dot64_lds(q, p.KCMP + ((size_t)b * 128 + n) * 64); }
      const float m = wave_max(fmaxf(sc0, sc1));
      float e0 = 0.f, e1 = 0.f;
      if (m > -INFINITY) { e0 = __expf(sc0 - m); e1 = __expf(sc1 - m); }
      const float l = wave_sum(e0 + e1);
      const float il = l > 0.f ? 1.f / l : 0.f;
      pc[h][lane] = e0 * il; pc[h][lane + 64] = e1 * il;
      __syncthreads();
      float o = 0.f;
      const bf16_t* vp = p.VCMPT + ((size_t)b * 64 + lane) * 128;
#pragma unroll 4
      for (int n = 0; n < 127; ++n) o += pc[h][n] * bf2f(vp[n]);
      o_cmp = o;
    }
    if (tid < 32) {
      const int j = tid;
      float v;
      if (j > cur) v = -1e30f;
      else if (j == 0 || j == cur || j == cur - 1) v = 1e6f;
      else {
        v = 0.f;
#pragma unroll 1
        for (int hh = 0; hh < 4; ++hh)
#pragma unroll 1
          for (int n = 4 * j - 1; n <= 4 * j + 3; ++n) if (n >= 0 && n < 127) v += pc[hh][n];
      }
      impv[j] = v;
    }
    __syncthreads();
    if (tid < 32) {
      const int j = tid; const float vj = impv[j];
      int rank = 0;
#pragma unroll 1
      for (int i = 0; i < 32; ++i) { const float vi = impv[i]; rank += (vi > vj || (vi == vj && i < j)) ? 1 : 0; }
      if (rank < 8) selblk[rank] = j;
    }
    __syncthreads();
    float o_slc;
    {
      float m = -INFINITY;
#pragma unroll 1
      for (int r = 0; r < 8; ++r) {
        const int s = selblk[r] * 64 + lane;
        float d = -INFINITY;
        if (s <= t) d = dot64_lds(q, p.KV + ((size_t)(2 * NB + b) * T + s) * 64);
        pbuf[h][r * 64 + lane] = d; m = fmaxf(m, d);
      }
      m = wave_max(m);
      float l = 0.f;
#pragma unroll 1
      for (int r = 0; r < 8; ++r) { const float e = __expf(pbuf[h][r * 64 + lane] - m); pbuf[h][r * 64 + lane] = e; l += e; }
      l = wave_sum(l);
      __syncthreads();
      float o = 0.f;
      const bf16_t* vp = p.KV + ((size_t)(3 * NB + b) * 64 + lane) * T;
#pragma unroll 1
      for (int r = 0; r < 8; ++r) {
        const int s0 = selblk[r] * 64;
#pragma unroll 4
        for (int kk = 0; kk < 64; ++kk) o += pbuf[h][r * 64 + kk] * bf2f(vp[s0 + kk]);
      }
      o_slc = o / l;
      __syncthreads();
    }
    float o_win;
    {
      float m = -INFINITY;
#pragma unroll 1
      for (int r = 0; r < 8; ++r) {
        const int s = t - 511 + r * 64 + lane;
        float d = -INFINITY;
        if (s >= 0) d = dot64_lds(q, p.KV + ((size_t)(4 * NB + b) * T + s) * 64);
        pbuf[h][r * 64 + lane] = d; m = fmaxf(m, d);
      }
      m = wave_max(m);
      float l = 0.f;
#pragma unroll 1
      for (int r = 0; r < 8; ++r) { const float e = __expf(pbuf[h][r * 64 + lane] - m); pbuf[h][r * 64 + lane] = e; l += e; }
      l = wave_sum(l);
      __syncthreads();
      float o = 0.f;
      const bf16_t* vp = p.KV + ((size_t)(5 * NB + b) * 64 + lane) * T;
#pragma unroll 4
      for (int j = 0; j < 512; ++j) { const int s = t - 511 + j; if (s >= 0) o += pbuf[h][j] * bf2f(vp[s]); }
      o_win = o / l;
    }
    const float g0 = p.DG[(size_t)tok * 12 + h * 3 + 0], g1 = p.DG[(size_t)tok * 12 + h * 3 + 1], g2 = p.DG[(size_t)tok * 12 + h * 3 + 2];
    const float o = g0 * o_cmp + g1 * o_slc + g2 * o_win;
    const float gz = bf2f(p.GZ[(size_t)4 * NTOK * 256 + (size_t)tok * 256 + h * 64 + lane]);
    p.YMIX[(size_t)tok * 1024 + 768 + h * 64 + lane] = f2bf(o * gz);
  }
}


DI f32x16 qk_tile(const bf16_t* Krow, const bf16x8 (&qf)[4], int l31, int h2) {
  f32x16 s = zero16();
  const bf16_t* kp = Krow + l31 * 64 + h2 * 8;
#pragma unroll
  for (int ks = 0; ks < 4; ++ks) { const bf16x8 a = *(const bf16x8*)(kp + ks * 16); s = MFMA32(a, qf[ks], s); }
  return s;
}
DI void softmax_pv(f32x16& s, const bf16_t* VTp, int vstride, f32x16 (&o)[2], float& m, float& l, int l31, int h2) {
  bf16x8 va[2][2];
#pragma unroll
  for (int dt = 0; dt < 2; ++dt)
#pragma unroll
    for (int sk = 0; sk < 2; ++sk) va[dt][sk] = ld_frag8x2(VTp + (size_t)(dt * 32 + l31) * vstride + sk * 16 + 4 * h2);
  float mx = s[0];
#pragma unroll
  for (int r = 1; r < 16; ++r) mx = fmaxf(mx, s[r]);
  mx = fmaxf(mx, __shfl_xor(mx, 32));
  const float mn = fmaxf(m, mx);
  const float alpha = __expf(m - mn);
  float ps = 0.f;
#pragma unroll
  for (int r = 0; r < 16; ++r) { s[r] = __expf(s[r] - mn); ps += s[r]; }
  ps += __shfl_xor(ps, 32);
  l = l * alpha + ps; m = mn;
#pragma unroll
  for (int dt = 0; dt < 2; ++dt)
#pragma unroll
    for (int r = 0; r < 16; ++r) o[dt][r] *= alpha;
  const bf16x8 p0 = pack8<0>(s), p1 = pack8<8>(s);
#pragma unroll
  for (int dt = 0; dt < 2; ++dt) { o[dt] = MFMA32(va[dt][0], p0, o[dt]); o[dt] = MFMA32(va[dt][1], p1, o[dt]); }
}

DI void ph_attnD(const Params& p, int layer, int* ctr, char* smem) {
  float* imps = (float*)smem;
  float* impf = (float*)(smem + 16384);
  unsigned* smask = (unsigned*)(smem + 20480);
  unsigned* s_union = (unsigned*)(smem + 20480 + 128);
  int* s_item = (int*)(smem + 20480 + 132);
  const int tid = tid_opaque(), lane = tid & 63, h = tid >> 6, l31 = lane & 31, h2 = lane >> 5;
  for (;;) {
    __syncthreads();
    if (tid == 0) { *s_item = atomicAdd(ctr, 1); *s_union = 0u; }
    __syncthreads();
    const int it = *s_item;
    if (it >= 2048) break;
    const int b = it & 31, q0 = (63 - (it >> 5)) * 32;
    const int t = q0 + l31, cur = q0 >> 6;
    const size_t tok = (size_t)b * T + t;
    bf16x8 qf[4];
    {
      const bf16_t* qp = p.QD + ((size_t)(b * 4 + h) * T + t) * 64 + h2 * 8;
#pragma unroll
      for (int ks = 0; ks < 4; ++ks) qf[ks] = *(const bf16x8*)(qp + ks * 16);
    }
    const float g0 = p.DG[tok * 12 + h * 3 + 0], g1 = p.DG[tok * 12 + h * 3 + 1], g2 = p.DG[tok * 12 + h * 3 + 2];
    f32x16 ofin[2];
    {
      const bf16_t* Kc = p.KCMP + (size_t)b * 128 * 64;
      const bf16_t* Vc = p.VCMPT + (size_t)b * 64 * 128;
      const int nkt = min(4, (q0 >> 9) + 1);
      f32x16 o[2]; o[0] = zero16(); o[1] = zero16();
      float m = -1e30f, l = 0.f;
      for (int kt = 0; kt < nkt; ++kt) {
        f32x16 s = qk_tile(Kc + kt * 32 * 64, qf, l31, h2);
#pragma unroll
        for (int r = 0; r < 16; ++r) { const int n = kt * 32 + crow(r, h2); if (16 * n + 31 > t) s[r] = -INFINITY; }
        softmax_pv(s, Vc + kt * 32, 128, o, m, l, l31, h2);
      }
      const float il = l > 0.f ? 1.f / l : 0.f;
      const float gi = g0 * il;
#pragma unroll
      for (int dt = 0; dt < 2; ++dt)
#pragma unroll
        for (int r = 0; r < 16; ++r) ofin[dt][r] = gi * o[dt][r];
      float carry = 0.f;
#pragma unroll
      for (int kt = 0; kt < 4; ++kt) {
        f32x16 s;
        if (kt < nkt) {
          s = qk_tile(Kc + kt * 32 * 64, qf, l31, h2);
#pragma unroll
          for (int r = 0; r < 16; ++r) { const int n = kt * 32 + crow(r, h2); s[r] = (16 * n + 31 > t) ? 0.f : __expf(s[r] - m) * il; }
        } else s = zero16();
        float X[4];
#pragma unroll
        for (int g = 0; g < 4; ++g) X[g] = __shfl_xor(s[4 * g + 3], 32);
#pragma unroll
        for (int g = 0; g < 4; ++g) {
          const float G = (s[4 * g] + s[4 * g + 1]) + (s[4 * g + 2] + s[4 * g + 3]);
          const float prev_other = g > 0 ? X[g - 1] : carry;
          imps[(h * 32 + l31) * 32 + 8 * kt + 2 * g + h2] = G + (h2 ? X[g] : prev_other);
        }
        carry = X[3];
      }
    }
    __syncthreads();
    {
      const int tt = tid >> 3, jg = tid & 7;
#pragma unroll
      for (int i = 0; i < 4; ++i) {
        const int j = jg * 4 + i;
        impf[tt * 32 + j] = (imps[(0 * 32 + tt) * 32 + j] + imps[(1 * 32 + tt) * 32 + j]) + (imps[(2 * 32 + tt) * 32 + j] + imps[(3 * 32 + tt) * 32 + j]);
      }
    }
    __syncthreads();
    {
      const int tt = tid >> 3, jg = tid & 7;
      float v[32];
#pragma unroll
      for (int j = 0; j < 32; ++j) {
        float x = impf[tt * 32 + j];
        if (j > cur) x = -1e30f; else if (j == 0 || j == cur || j == cur - 1) x = 1e6f;
        v[j] = x;
      }
      unsigned bits = 0u;
#pragma unroll
      for (int i = 0; i < 4; ++i) {
        int rank = 0; float vj = 0.f;
#pragma unroll
        for (int j = 0; j < 32; ++j) if (j == jg * 4 + i) vj = v[j];
        const int jj = jg * 4 + i;
#pragma unroll
        for (int j = 0; j < 32; ++j) rank += (v[j] > vj || (v[j] == vj && j < jj)) ? 1 : 0;
        if (rank < 8 && jj <= cur) bits |= 1u << jj;
      }
      bits |= __shfl_xor(bits, 1); bits |= __shfl_xor(bits, 2); bits |= __shfl_xor(bits, 4);
      if (jg == 0) { smask[tt] = bits; atomicOr(s_union, bits); }
    }
    __syncthreads();
    {
      const unsigned mymask = smask[l31], uni = *s_union;
      const bf16_t* Ks = p.KV + (size_t)(2 * NB + b) * T * 64;
      const bf16_t* Vs = p.KV + (size_t)(3 * NB + b) * 64 * T;
      f32x16 o[2]; o[0] = zero16(); o[1] = zero16();
      float m = -1e30f, l = 0.f;
      for (int j = 0; j <= cur; ++j) {
        if (!((uni >> j) & 1u)) continue;
        const bool sel = (mymask >> j) & 1u;
        for (int half = 0; half < 2; ++half) {
          const int key0 = j * 64 + half * 32;
          if (key0 > q0 + 31) break;
          f32x16 s = qk_tile(Ks + (size_t)key0 * 64, qf, l31, h2);
#pragma unroll
          for (int r = 0; r < 16; ++r) { const int key = key0 + crow(r, h2); if (!sel || key > t) s[r] = -INFINITY; }
          softmax_pv(s, Vs + key0, T, o, m, l, l31, h2);
        }
      }
      const float il = l > 0.f ? g1 / l : 0.f;
#pragma unroll
      for (int dt = 0; dt < 2; ++dt)
#pragma unroll
        for (int r = 0; r < 16; ++r) ofin[dt][r] += il * o[dt][r];
    }
    {
      const bf16_t* Kw = p.KV + (size_t)(4 * NB + b) * T * 64;
      const bf16_t* Vw = p.KV + (size_t)(5 * NB + b) * 64 * T;
      f32x16 o[2]; o[0] = zero16(); o[1] = zero16();
      float m = -1e30f, l = 0.f;
      for (int key0 = max(0, q0 - 512); key0 <= q0; key0 += 32) {
        f32x16 s = qk_tile(Kw + (size_t)key0 * 64, qf, l31, h2);
        if (key0 == q0 - 512 || key0 == q0) {
#pragma unroll
          for (int r = 0; r < 16; ++r) { const int key = key0 + crow(r, h2); if (key > t || t - key >= 512) s[r] = -INFINITY; }
        }
        softmax_pv(s, Vw + key0, T, o, m, l, l31, h2);
      }
      const float il = l > 0.f ? g2 / l : 0.f;
#pragma unroll
      for (int dt = 0; dt < 2; ++dt)
#pragma unroll
        for (int r = 0; r < 16; ++r) ofin[dt][r] += il * o[dt][r];
    }
#pragma unroll
    for (int dt = 0; dt < 2; ++dt)
#pragma unroll
      for (int g = 0; g < 4; ++g) {
        const int d0 = dt * 32 + 8 * g + 4 * h2;
        const u32x2 gz = *(const u32x2*)(p.GZ + (size_t)4 * NTOK * 256 + tok * 256 + h * 64 + d0);
        const float z0 = __uint_as_float(gz.x << 16), z1 = __uint_as_float(gz.x & 0xffff0000u), z2 = __uint_as_float(gz.y << 16), z3 = __uint_as_float(gz.y & 0xffff0000u);
        u32x2 o2 = {pack2(ofin[dt][4 * g] * z0, ofin[dt][4 * g + 1] * z1), pack2(ofin[dt][4 * g + 2] * z2, ofin[dt][4 * g + 3] * z3)};
        *(u32x2*)(p.YMIX + tok * 1024 + 768 + h * 64 + d0) = o2;
      }
  }
}


DI float logsigmoidf_(float x) { return x >= 0.f ? -log1pf(__expf(-x)) : x - log1pf(__expf(x)); }
DI void mlstm_gates(const Params& p, size_t tok0, int hh, float* bc, float* ig, int tid) {
  if (tid < 64) {
    const int s0 = 2 * tid;
    const float lf0 = logsigmoidf_(p.IFG[(tok0 + s0) * 8 + 4 + hh]), lf1 = logsigmoidf_(p.IFG[(tok0 + s0 + 1) * 8 + 4 + hh]);
    const float pair = lf0 + lf1;
    float x = pair;
#pragma unroll
    for (int off = 1; off < 64; off <<= 1) { const float y = __shfl_up(x, off); if (tid >= off) x += y; }
    const float excl = x - pair;
    bc[s0] = excl + lf0; bc[s0 + 1] = excl + pair;
    ig[s0] = p.IFG[(tok0 + s0) * 8 + hh]; ig[s0 + 1] = p.IFG[(tok0 + s0 + 1) * 8 + hh];
  }
}
DI void conv8(const bf16_t* raw, int t, int dg, const float (&cw)[4][8], const float (&cb)[8], float (&out)[8]) {
#pragma unroll
  for (int e = 0; e < 8; ++e) out[e] = cb[e];
#pragma unroll
  for (int j = 0; j < 4; ++j) {
    const int ts = t - 3 + j;
    if (ts >= 0) {
      const u32x4 row = *(const u32x4*)(raw + (size_t)ts * 64 + dg * 8);
#pragma unroll
      for (int e2 = 0; e2 < 4; ++e2) { out[2 * e2] += cw[j][2 * e2] * __uint_as_float(row[e2] << 16); out[2 * e2 + 1] += cw[j][2 * e2 + 1] * __uint_as_float(row[e2] & 0xffff0000u); }
    }
  }
#pragma unroll
  for (int e = 0; e < 8; ++e) out[e] = siluf_(out[e]);
}
DI void load_conv_w(const Params& p, int layer, int ch0, int dg, float (&cw)[4][8], float (&cb)[8]) {
#pragma unroll
  for (int j = 0; j < 4; ++j)
#pragma unroll
    for (int e = 0; e < 8; ++e) cw[j][e] = p.conv_w[layer * 2048 + j * 512 + ch0 + dg * 8 + e];
#pragma unroll
  for (int e = 0; e < 8; ++e) cb[e] = p.conv_b[layer * 512 + ch0 + dg * 8 + e];
}
DI void delta_state(const bf16_t* VT, const bf16_t* KT, float* out, int wid, int l31, int h2) {
  const int mt = wid >> 1, nt = wid & 1;
  f32x16 acc = zero16();
#pragma unroll
  for (int ks = 0; ks < 8; ++ks) {
    const bf16x8 a = *(const bf16x8*)(VT + (size_t)(mt * 32 + l31) * T + ks * 16 + h2 * 8);
    const bf16x8 bb = *(const bf16x8*)(KT + (nt * 32 + l31) * 136 + ks * 16 + h2 * 8);
    acc = MFMA32(a, bb, acc);
  }
#pragma unroll
  for (int r = 0; r < 16; ++r) out[(mt * 32 + crow(r, h2)) * 64 + nt * 32 + l31] = acc[r];
}
DI void ph_mlstm_local(const Params& p, int layer, int item, char* smem) {
  float* bc = (float*)smem; float* ig = bc + 128; float* wv = ig + 128;
  bf16_t* KwT = (bf16_t*)(smem + 2048);
  float* nred = (float*)(smem + 2048 + 64 * 136 * 2);
  const int tid = tid_opaque(), lane = tid & 63, wid = tid >> 6, l31 = lane & 31, h2 = lane >> 5;
  const int b = item >> 6, hh = (item >> 4) & 3, c = item & 15, t0 = c * 128;
  const size_t tok0 = (size_t)b * T + t0;
  __syncthreads();
  mlstm_gates(p, tok0, hh, bc, ig, tid);
  __syncthreads();
  if (tid < 128) wv[tid] = __expf(bc[127] - bc[tid] + ig[tid]);
  __syncthreads();
  {
    const int dg = tid & 7;
    float cw[4][8], cb[8];
    load_conv_w(p, layer, 256 + hh * 64, dg, cw, cb);
    const bf16_t* raw = p.QKB + ((size_t)(b * 8 + 4 + hh) * T) * 64;
#pragma unroll
    for (int i = 0; i < 4; ++i) {
      const int s = (tid >> 3) + 32 * i;
      float v[8];
      conv8(raw, t0 + s, dg, cw, cb, v);
      const float w = wv[s];
#pragma unroll
      for (int e = 0; e < 8; ++e) KwT[(dg * 8 + e) * 136 + s] = f2bf(v[e] * w);
    }
  }
  __syncthreads();
  delta_state(p.VBT + (size_t)(b * 4 + hh) * 64 * T + t0, KwT, p.BST + (size_t)item * 4096, wid, l31, h2);
  {
    const int k = tid & 63, qd = tid >> 6;
    float a = 0.f;
#pragma unroll 8
    for (int s = 0; s < 32; ++s) a += bf2f(KwT[k * 136 + qd * 32 + s]);
    nred[qd * 64 + k] = a;
  }
  __syncthreads();
  if (tid < 64) p.BN[(size_t)item * 64 + tid] = (nred[tid] + nred[64 + tid]) + (nred[128 + tid] + nred[192 + tid]);
  if (tid == 0) p.BG[item] = bc[127];
}
DI void ph_mlstm_scan(const Params& p, int bh) {
  const int tid = tid_opaque();
  f32x4 C[4];
#pragma unroll
  for (int i = 0; i < 4; ++i) C[i] = (f32x4){0.f, 0.f, 0.f, 0.f};
  float n = 0.f;
  for (int c = 0; c < 16; ++c) {
    const int item = bh * 16 + c;
    const float g = __expf(p.BG[item]);
    f32x4* ptr = (f32x4*)(p.BST + (size_t)item * 4096 + tid * 16);
#pragma unroll
    for (int i = 0; i < 4; ++i) { const f32x4 tmp = ptr[i]; ptr[i] = C[i]; C[i] = g * C[i] + tmp; }
    if (tid < 64) { const float tmp = p.BN[(size_t)item * 64 + tid]; p.BN[(size_t)item * 64 + tid] = n; n = g * n + tmp; }
  }
}
DI f32x16 qk_tile_s(const bf16_t* Krow, int stride, const bf16x8 (&qf)[4], int l31, int h2) {
  f32x16 s = zero16();
  const bf16_t* kp = Krow + l31 * stride + h2 * 8;
#pragma unroll
  for (int ks = 0; ks < 4; ++ks) { const bf16x8 a = *(const bf16x8*)(kp + ks * 16); s = MFMA32(a, qf[ks], s); }
  return s;
}
DI void pv_only(const f32x16& s, const bf16_t* VTp, int vstride, f32x16 (&o)[2], int l31, int h2) {
  const bf16x8 p0 = pack8<0>(s), p1 = pack8<8>(s);
#pragma unroll
  for (int dt = 0; dt < 2; ++dt) {
    const bf16_t* vp = VTp + (size_t)(dt * 32 + l31) * vstride + 4 * h2;
    o[dt] = MFMA32(ld_frag8x2(vp), p0, o[dt]);
    o[dt] = MFMA32(ld_frag8x2(vp + 16), p1, o[dt]);
  }
}
DI bf16x8 frag_from_f32(const float* ptr) {
  const f32x4 a = *(const f32x4*)ptr, b = *(const f32x4*)(ptr + 4);
  u32x4 t = {pack2(a[0], a[1]), pack2(a[2], a[3]), pack2(b[0], b[1]), pack2(b[2], b[3])};
  return __builtin_bit_cast(bf16x8, t);
}
DI void ph_mlstm_out(const Params& p, int layer, int item, char* smem) {
  float* bc = (float*)smem; float* ig = bc + 128;
  bf16_t* qc = (bf16_t*)(smem + 2048);
  bf16_t* kc = qc + 128 * 72;
  const int tid = tid_opaque(), lane = tid & 63, wid = tid >> 6, l31 = lane & 31, h2 = lane >> 5;
  const int b = item >> 6, hh = (item >> 4) & 3, c = item & 15, t0 = c * 128;
  const size_t tok0 = (size_t)b * T + t0;
  __syncthreads();
  mlstm_gates(p, tok0, hh, bc, ig, tid);
  {
    const int dg = tid & 7;
#pragma unroll
    for (int which = 0; which < 2; ++which) {
      float cw[4][8], cb[8];
      load_conv_w(p, layer, which * 256 + hh * 64, dg, cw, cb);
      const bf16_t* raw = p.QKB + ((size_t)(b * 8 + which * 4 + hh) * T) * 64;
      bf16_t* dst = which ? kc : qc;
      const float sc = which ? 1.f : 0.125f;
#pragma unroll
      for (int i = 0; i < 4; ++i) {
        const int s = (tid >> 3) + 32 * i;
        float v[8];
        conv8(raw, t0 + s, dg, cw, cb, v);
        u32x4 w = {pack2(v[0] * sc, v[1] * sc), pack2(v[2] * sc, v[3] * sc), pack2(v[4] * sc, v[5] * sc), pack2(v[6] * sc, v[7] * sc)};
        *(u32x4*)(dst + s * 72 + dg * 8) = w;
      }
    }
  }
  __syncthreads();
  if (tid < 128) ig[tid] = ig[tid] - bc[tid];
  __syncthreads();
  const int tq = 32 * wid + l31;
  bf16x8 qf[4];
#pragma unroll
  for (int ks = 0; ks < 4; ++ks) qf[ks] = *(const bf16x8*)(qc + tq * 72 + ks * 16 + h2 * 8);
  const float bt = bc[tq];
  f32x16 o[2]; o[0] = zero16(); o[1] = zero16();
  float dsum = 0.f;
  const bf16_t* VT = p.VBT + (size_t)(b * 4 + hh) * 64 * T + t0;
  for (int kt = 0; kt <= wid; ++kt) {
    f32x16 s = qk_tile_s(kc + kt * 32 * 72, 72, qf, l31, h2);
#pragma unroll
    for (int r = 0; r < 16; ++r) {
      const int sidx = 32 * kt + crow(r, h2);
      float val = s[r] * __expf(bt + ig[sidx]);
      if (sidx > tq) val = 0.f;
      s[r] = val; dsum += val;
    }
    pv_only(s, VT + kt * 32, T, o, l31, h2);
  }
  dsum += __shfl_xor(dsum, 32);
  const float* Cs = p.BST + (size_t)item * 4096;
  const float* ns = p.BN + (size_t)item * 64;
  f32x16 oi[2]; oi[0] = zero16(); oi[1] = zero16();
  float qn = 0.f;
#pragma unroll
  for (int ks = 0; ks < 4; ++ks) {
#pragma unroll
    for (int dt = 0; dt < 2; ++dt) oi[dt] = MFMA32(frag_from_f32(Cs + (dt * 32 + l31) * 64 + ks * 16 + h2 * 8), qf[ks], oi[dt]);
    const u32x4 qu = __builtin_bit_cast(u32x4, qf[ks]);
    const f32x4 n0 = *(const f32x4*)(ns + ks * 16 + h2 * 8), n1 = *(const f32x4*)(ns + ks * 16 + h2 * 8 + 4);
    qn += __uint_as_float(qu[0] << 16) * n0[0] + __uint_as_float(qu[0] & 0xffff0000u) * n0[1] + __uint_as_float(qu[1] << 16) * n0[2] + __uint_as_float(qu[1] & 0xffff0000u) * n0[3];
    qn += __uint_as_float(qu[2] << 16) * n1[0] + __uint_as_float(qu[2] & 0xffff0000u) * n1[1] + __uint_as_float(qu[3] << 16) * n1[2] + __uint_as_float(qu[3] & 0xffff0000u) * n1[3];
  }
  qn += __shfl_xor(qn, 32);
  const float ebt = __expf(bt);
  const float den = dsum + ebt * qn;
  const float inv = 1.f / fmaxf(fabsf(den), 1.f);
  const size_t tok = tok0 + tq;
#pragma unroll
  for (int dt = 0; dt < 2; ++dt)
#pragma unroll
    for (int g = 0; g < 4; ++g) {
      const int d0 = dt * 32 + 8 * g + 4 * h2;
      const u32x2 g1 = *(const u32x2*)(p.GZ + (size_t)1 * NTOK * 256 + tok * 256 + hh * 64 + d0);
      const u32x2 g2 = *(const u32x2*)(p.GZ + (size_t)2 * NTOK * 256 + tok * 256 + hh * 64 + d0);
      float z[4] = {__uint_as_float(g1.x << 16) * __uint_as_float(g2.x << 16), __uint_as_float(g1.x & 0xffff0000u) * __uint_as_float(g2.x & 0xffff0000u),
                    __uint_as_float(g1.y << 16) * __uint_as_float(g2.y << 16), __uint_as_float(g1.y & 0xffff0000u) * __uint_as_float(g2.y & 0xffff0000u)};
      float hv[4];
#pragma unroll
      for (int i = 0; i < 4; ++i) hv[i] = (o[dt][4 * g + i] + ebt * oi[dt][4 * g + i]) * inv * z[i];
      u32x2 o2 = {pack2(hv[0], hv[1]), pack2(hv[2], hv[3])};
      *(u32x2*)(p.YMIX + tok * 1024 + 256 + hh * 64 + d0) = o2;
    }
}


DI void ph_hgrn_local(const Params& p, int layer, int item, char* smem) {
  float* tot = (float*)smem;
  bf16_t* KdT = (bf16_t*)(smem + 1024);
  const int tid = tid_opaque(), lane = tid & 63, wid = tid >> 6, l31 = lane & 31, h2 = lane >> 5;
  const int b = item >> 6, hh = (item >> 4) & 3, c = item & 15, t0 = c * 128;
  const int k = tid & 63, qd = tid >> 6;
  float al[32], kk[32];
  {
    const float* gp = p.GC + ((size_t)(b * 4 + hh) * T + t0 + 32 * qd) * 64 + k;
    float run = 0.f;
#pragma unroll
    for (int s = 0; s < 32; ++s) { const float g = gp[s * 64]; run += g; al[s] = run; kk[s] = 1.f - __expf(g); }
    __syncthreads();
    tot[qd * 64 + k] = run;
  }
  __syncthreads();
  float off = 0.f, aL = 0.f;
#pragma unroll
  for (int q = 0; q < 4; ++q) { const float v = tot[q * 64 + k]; aL += v; if (q < qd) off += v; }
#pragma unroll
  for (int s8 = 0; s8 < 4; ++s8) {
    float v[8];
#pragma unroll
    for (int e = 0; e < 8; ++e) v[e] = kk[s8 * 8 + e] * __expf(aL - (al[s8 * 8 + e] + off));
    u32x4 w = {pack2(v[0], v[1]), pack2(v[2], v[3]), pack2(v[4], v[5]), pack2(v[6], v[7])};
    *(u32x4*)(KdT + k * 136 + qd * 32 + s8 * 8) = w;
  }
  __syncthreads();
  delta_state(p.VCT + (size_t)(b * 4 + hh) * 64 * T + t0, KdT, p.CST + (size_t)item * 4096, wid, l31, h2);
  if (qd == 0) p.CAL[(size_t)item * 64 + k] = aL;
}
DI void ph_hgrn_scan(const Params& p, int bh) {
  const int tid = tid_opaque();
  f32x4 S[4];
#pragma unroll
  for (int i = 0; i < 4; ++i) S[i] = (f32x4){0.f, 0.f, 0.f, 0.f};
  for (int c = 0; c < 16; ++c) {
    const int item = bh * 16 + c;
    const f32x4* dp = (const f32x4*)(p.CAL + (size_t)item * 64 + (tid & 3) * 16);
    f32x4* ptr = (f32x4*)(p.CST + (size_t)item * 4096 + tid * 16);
#pragma unroll
    for (int i = 0; i < 4; ++i) {
      const f32x4 a = dp[i];
      const f32x4 dec = {__expf(a[0]), __expf(a[1]), __expf(a[2]), __expf(a[3])};
      const f32x4 tmp = ptr[i]; ptr[i] = S[i]; S[i] = dec * S[i] + tmp;
    }
  }
}
DI void ph_hgrn_out(const Params& p, int layer, int item, char* smem) {
  float* a_lds = (float*)smem;
  float* tot = (float*)(smem + 128 * 68 * 4);
  const int tid = tid_opaque(), lane = tid & 63, wid = tid >> 6, l31 = lane & 31, h2 = lane >> 5;
  const int b = item >> 6, hh = (item >> 4) & 3, c = item & 15, t0 = c * 128;
  const size_t hbase = (size_t)(b * 4 + hh) * T + t0;
  {
    const int k = tid & 63, qd = tid >> 6;
    float al[32];
    const float* gp = p.GC + (hbase + 32 * qd) * 64 + k;
    float run = 0.f;
#pragma unroll
    for (int s = 0; s < 32; ++s) { run += gp[s * 64]; al[s] = run; }
    __syncthreads();
    tot[qd * 64 + k] = run;
    __syncthreads();
    float off = 0.f;
#pragma unroll
    for (int q = 0; q < 4; ++q) { const float v = tot[q * 64 + k]; if (q < qd) off += v; }
#pragma unroll
    for (int s = 0; s < 32; ++s) a_lds[(32 * qd + s) * 68 + k] = al[s] + off;
  }
  __syncthreads();
  const int tq = 32 * wid + l31;
  bf16x8 qi[4], qh[4];
#pragma unroll
  for (int ks = 0; ks < 4; ++ks) {
    const int k0 = ks * 16 + h2 * 8;
    const u32x4 qu = *(const u32x4*)(p.QC + (hbase + tq) * 64 + k0);
    float q8[8], e1[8], e2[8];
#pragma unroll
    for (int e2i = 0; e2i < 4; ++e2i) { q8[2 * e2i] = __uint_as_float(qu[e2i] << 16); q8[2 * e2i + 1] = __uint_as_float(qu[e2i] & 0xffff0000u); }
#pragma unroll
    for (int e = 0; e < 8; ++e) {
      const float a = a_lds[tq * 68 + k0 + e];
      const float r = wid > 0 ? a_lds[(32 * wid - 1) * 68 + k0 + e] : 0.f;
      e1[e] = q8[e] * __expf(a - r); e2[e] = q8[e] * __expf(a);
    }
    u32x4 w1 = {pack2(e1[0], e1[1]), pack2(e1[2], e1[3]), pack2(e1[4], e1[5]), pack2(e1[6], e1[7])};
    u32x4 w2 = {pack2(e2[0], e2[1]), pack2(e2[2], e2[3]), pack2(e2[4], e2[5]), pack2(e2[6], e2[7])};
    qi[ks] = __builtin_bit_cast(bf16x8, w1); qh[ks] = __builtin_bit_cast(bf16x8, w2);
  }
  f32x16 o[2]; o[0] = zero16(); o[1] = zero16();
  const bf16_t* VT = p.VCT + (size_t)(b * 4 + hh) * 64 * T + t0;
  for (int kt = 0; kt <= wid; ++kt) {
    f32x16 s = zero16();
    const int srow = 32 * kt + l31;
#pragma unroll
    for (int ks = 0; ks < 4; ++ks) {
      const int k0 = ks * 16 + h2 * 8;
      const f32x4 g0 = *(const f32x4*)(p.GC + (hbase + srow) * 64 + k0), g1 = *(const f32x4*)(p.GC + (hbase + srow) * 64 + k0 + 4);
      float v[8];
#pragma unroll
      for (int e = 0; e < 8; ++e) {
        const float g = e < 4 ? g0[e] : g1[e - 4];
        const float a = a_lds[srow * 68 + k0 + e];
        const float r = wid > 0 ? a_lds[(32 * wid - 1) * 68 + k0 + e] : 0.f;
        v[e] = (1.f - __expf(g)) * __expf(fminf(r - a, 80.f));
      }
      u32x4 w = {pack2(v[0], v[1]), pack2(v[2], v[3]), pack2(v[4], v[5]), pack2(v[6], v[7])};
      s = MFMA32(__builtin_bit_cast(bf16x8, w), qi[ks], s);
    }
    if (kt == wid) {
#pragma unroll
      for (int r = 0; r < 16; ++r) if (32 * kt + crow(r, h2) > tq) s[r] = 0.f;
    }
    pv_only(s, VT + kt * 32, T, o, l31, h2);
  }
  {
    const float* Ss = p.CST + (size_t)item * 4096;
#pragma unroll
    for (int ks = 0; ks < 4; ++ks)
#pragma unroll
      for (int dt = 0; dt < 2; ++dt) o[dt] = MFMA32(frag_from_f32(Ss + (dt * 32 + l31) * 64 + ks * 16 + h2 * 8), qh[ks], o[dt]);
  }
  float ss = 0.f;
#pragma unroll
  for (int dt = 0; dt < 2; ++dt)
#pragma unroll
    for (int r = 0; r < 16; ++r) ss += o[dt][r] * o[dt][r];
  ss += __shfl_xor(ss, 32);
  const float rs = rsqrtf(ss * (1.f / 64.f) + 1e-6f);
  const size_t tok = (size_t)b * T + t0 + tq;
#pragma unroll
  for (int dt = 0; dt < 2; ++dt)
#pragma unroll
    for (int g = 0; g < 4; ++g) {
      const int d0 = dt * 32 + 8 * g + 4 * h2;
      const u32x2 gz = *(const u32x2*)(p.GZ + (size_t)3 * NTOK * 256 + tok * 256 + hh * 64 + d0);
      const f32x4 gn = *(const f32x4*)(p.c_norm_g + layer * 256 + hh * 64 + d0);
      const float z0 = __uint_as_float(gz.x << 16), z1 = __uint_as_float(gz.x & 0xffff0000u), z2 = __uint_as_float(gz.y << 16), z3 = __uint_as_float(gz.y & 0xffff0000u);
      u32x2 o2 = {pack2(o[dt][4 * g] * rs * gn[0] * z0, o[dt][4 * g + 1] * rs * gn[1] * z1), pack2(o[dt][4 * g + 2] * rs * gn[2] * z2, o[dt][4 * g + 3] * rs * gn[3] * z3)};
      *(u32x2*)(p.YMIX + tok * 1024 + 512 + hh * 64 + d0) = o2;
    }
}


DI void ph_attnA(const Params& p, int layer, int item, char* smem) {
  const int tid = tid_opaque(), lane = tid & 63, h = tid >> 6, l31 = lane & 31, h2 = lane >> 5;
  const int b = item >> 6, q0 = (item & 63) * 32, g = h >> 1;
  const int t = q0 + l31;
  const size_t tok = (size_t)b * T + t;
  bf16x8 qf[4];
  {
    const bf16_t* qp = p.QA + ((size_t)(b * 4 + h) * T + t) * 64 + h2 * 8;
#pragma unroll
    for (int ks = 0; ks < 4; ++ks) qf[ks] = *(const bf16x8*)(qp + ks * 16);
  }
  const bf16_t* Kp = p.KA + (size_t)(b * 2 + g) * T * 64;
  const bf16_t* Vp = p.VAT + (size_t)(b * 2 + g) * 64 * T;
  f32x16 o[2]; o[0] = zero16(); o[1] = zero16();
  float m = -1e30f, l = 0.f;
  for (int key0 = max(0, q0 - 128); key0 <= q0; key0 += 32) {
    f32x16 s = qk_tile(Kp + (size_t)key0 * 64, qf, l31, h2);
    if (key0 == q0 - 128 || key0 == q0) {
#pragma unroll
      for (int r = 0; r < 16; ++r) { const int key = key0 + crow(r, h2); if (key > t || t - key >= 128) s[r] = -INFINITY; }
    }
    softmax_pv(s, Vp + key0, T, o, m, l, l31, h2);
  }
  const float sink = p.a_sinks[layer * 4 + h];
  const float M = fmaxf(m, sink);
  const float sc = __expf(m - M);
  const float inv = sc / (l * sc + __expf(sink - M));
#pragma unroll
  for (int dt = 0; dt < 2; ++dt)
#pragma unroll
    for (int gq = 0; gq < 4; ++gq) {
      const int d0 = dt * 32 + 8 * gq + 4 * h2;
      const u32x2 gz = *(const u32x2*)(p.GZ + tok * 256 + h * 64 + d0);
      const float z0 = __uint_as_float(gz.x << 16), z1 = __uint_as_float(gz.x & 0xffff0000u), z2 = __uint_as_float(gz.y << 16), z3 = __uint_as_float(gz.y & 0xffff0000u);
      u32x2 o2 = {pack2(o[dt][4 * gq] * inv * z0, o[dt][4 * gq + 1] * inv * z1), pack2(o[dt][4 * gq + 2] * inv * z2, o[dt][4 * gq + 3] * inv * z3)};
      *(u32x2*)(p.YMIX + tok * 1024 + h * 64 + d0) = o2;
    }
}

DI void ph_cmp(const Params& p, int layer, int item, char* smem) {
  float* red = (float*)smem;
  bf16_t* hid = (bf16_t*)(smem + 32768);
  const int tid = tid_opaque(), lane = tid & 63, wid = tid >> 6, l31 = lane & 31, h2 = lane >> 5;
  const int b = item >> 3, kvsel = (item >> 2) & 1, mt = item & 3;
  const int lk = layer * 2 + kvsel;
  const int n = min(mt * 32 + l31, 126);
  const bf16_t* src = p.KV + ((size_t)(kvsel * NB + b) * T + 16 * n) * 64 + wid * 512 + h2 * 8;
  const bf16_t* w1t = p.W1T + (size_t)lk * 64 * 2048 + wid * 512 + h2 * 8;
  f32x16 acc[2]; acc[0] = zero16(); acc[1] = zero16();
#pragma unroll 4
  for (int ks = 0; ks < 32; ++ks) {
    const bf16x8 a = *(const bf16x8*)(src + ks * 16);
    const bf16x8 b0 = *(const bf16x8*)(w1t + (size_t)l31 * 2048 + ks * 16);
    const bf16x8 b1 = *(const bf16x8*)(w1t + (size_t)(32 + l31) * 2048 + ks * 16);
    acc[0] = MFMA32(a, b0, acc[0]); acc[1] = MFMA32(a, b1, acc[1]);
  }
  __syncthreads();
#pragma unroll
  for (int nt = 0; nt < 2; ++nt)
#pragma unroll
    for (int r = 0; r < 16; ++r) red[(wid * 32 + crow(r, h2)) * 64 + nt * 32 + l31] = acc[nt][r];
  __syncthreads();
  {
    const int row = tid >> 3, c0 = (tid & 7) * 8;
    float v[8];
#pragma unroll
    for (int e = 0; e < 8; ++e) {
      const float x = (red[(0 * 32 + row) * 64 + c0 + e] + red[(1 * 32 + row) * 64 + c0 + e]) + (red[(2 * 32 + row) * 64 + c0 + e] + red[(3 * 32 + row) * 64 + c0 + e]) + p.CVEC[lk * 64 + c0 + e];
      v[e] = siluf_(x);
    }
    u32x4 w = {pack2(v[0], v[1]), pack2(v[2], v[3]), pack2(v[4], v[5]), pack2(v[6], v[7])};
    *(u32x4*)(hid + row * 72 + c0) = w;
  }
  __syncthreads();
  if (wid == 0) {
    f32x16 o[2]; o[0] = zero16(); o[1] = zero16();
    const bf16_t* w2t = p.W2T + (size_t)lk * 4096;
#pragma unroll
    for (int ks = 0; ks < 4; ++ks) {
      const bf16x8 a = *(const bf16x8*)(hid + l31 * 72 + ks * 16 + h2 * 8);
#pragma unroll
      for (int nt = 0; nt < 2; ++nt) o[nt] = MFMA32(a, *(const bf16x8*)(w2t + (nt * 32 + l31) * 64 + ks * 16 + h2 * 8), o[nt]);
    }
    if (kvsel == 0) {
#pragma unroll
      for (int r = 0; r < 16; ++r) {
        const int nn = mt * 32 + crow(r, h2);
        if (nn < 127) {
          const int pos = 16 * nn + 31;
          const float cs = p.ROPEC[pos * 32 + l31], sn = p.ROPES[pos * 32 + l31];
          p.KCMP[((size_t)b * 128 + nn) * 64 + l31] = f2bf(o[0][r] * cs - o[1][r] * sn);
          p.KCMP[((size_t)b * 128 + nn) * 64 + 32 + l31] = f2bf(o[0][r] * sn + o[1][r] * cs);
        }
      }
    } else {
#pragma unroll
      for (int nt = 0; nt < 2; ++nt)
#pragma unroll
        for (int r = 0; r < 16; ++r) {
          const int nn = mt * 32 + crow(r, h2);
          if (nn < 127) p.VCMPT[((size_t)b * 64 + nt * 32 + l31) * 128 + nn] = f2bf(o[nt][r]);
        }
    }
  }
}


#define XB_TMO      128
#define XB_XCNT(j)  (256  + 64 * (j))
#define XB_XSUB(j)  (1280 + 64 * (j))
#define XB_XGEN(j)  (2304 + 64 * (j))
#define XB_TOP      3328
#define XB_TOPGEN   3392
#define XCD_BAR_WORDS 3456
#define XB_SPIN_CAP (1u << 22)
DI unsigned xb_ld(unsigned* p)              { return __hip_atomic_load(p, __ATOMIC_RELAXED, __HIP_MEMORY_SCOPE_AGENT); }
DI unsigned xb_add(unsigned* p, unsigned v) { return __hip_atomic_fetch_add(p, v, __ATOMIC_RELAXED, __HIP_MEMORY_SCOPE_AGENT); }
DI unsigned xb_xcc_id() { return (unsigned)__builtin_amdgcn_s_getreg((3 << 11) | 20) & 0xFu; }
#define XB_SPIN(cond, bar) do { unsigned _sp = 0; while (cond) { __builtin_amdgcn_s_sleep(1); \
    if ((++_sp & 255u) == 0u) { if (xb_ld(&(bar)[XB_TMO])) break; if (_sp > XB_SPIN_CAP) { atomicAdd(&(bar)[XB_TMO], 1u); break; } } } } while (0)
struct XcdBarrier { unsigned* bar; unsigned x; volatile LAS unsigned* st; };
DI XcdBarrier xcd_barrier_post(unsigned* bar, volatile LAS unsigned* st) {
  XcdBarrier b; b.bar = bar; b.x = xb_xcc_id(); b.st = st;
  if (threadIdx.x == 0) (void)xb_add(&bar[XB_XCNT(b.x)], 1u);
  return b;
}
DI void xcd_barrier_complete(unsigned* bar, unsigned x, unsigned& nloc, unsigned& nx) {
  const unsigned G = gridDim.x * gridDim.y * gridDim.z;
  unsigned sum, cnt, mine, sp = 0u;
  for (;;) {
    sum = 0u; cnt = 0u; mine = 0u;
#pragma unroll
    for (unsigned j = 0; j < 16; ++j) { const unsigned c = xb_ld(&bar[XB_XCNT(j)]); sum += c; cnt += (c > 0u) ? 1u : 0u; mine = (j == x) ? c : mine; }
    if (sum == G) break;
    __builtin_amdgcn_s_sleep(1);
    if ((++sp & 255u) == 0u) { if (xb_ld(&bar[XB_TMO])) break; if (sp > XB_SPIN_CAP) { atomicAdd(&bar[XB_TMO], 1u); break; } }
  }
  nloc = mine > 0u ? mine : 1u; nx = cnt > 0u ? cnt : 1u;
}
DI void xcd_barrier(const XcdBarrier& b) {
  asm volatile("s_waitcnt vmcnt(0)" ::: "memory");
  __syncthreads();
  if (threadIdx.x == 0) {
    unsigned* bar = b.bar;
    __builtin_amdgcn_s_waitcnt(0);
    unsigned nloc = b.st[0], nx = b.st[1];
    if (nloc == 0u) { xcd_barrier_complete(bar, b.x, nloc, nx); b.st[0] = nloc; b.st[1] = nx; }
    const unsigned old = xb_add(&bar[XB_XSUB(b.x)], 1u);
    const unsigned gen = old / nloc;
    if (old + 1u == (gen + 1u) * nloc) {
      __builtin_amdgcn_fence(__ATOMIC_RELEASE, "agent");
      asm volatile("s_waitcnt vmcnt(0)" ::: "memory");
      const unsigned og = xb_add(&bar[XB_TOP], 1u);
      const unsigned tg = og / nx;
      if (og + 1u == (tg + 1u) * nx) xb_add(&bar[XB_TOPGEN], 1u);
      else XB_SPIN(xb_ld(&bar[XB_TOPGEN]) == tg, bar);
      __builtin_amdgcn_fence(__ATOMIC_ACQUIRE, "agent");
      xb_add(&bar[XB_XGEN(b.x)], 1u);
      asm volatile("s_waitcnt vmcnt(0)" ::: "memory");
    } else {
      XB_SPIN(xb_ld(&bar[XB_XGEN(b.x)]) == gen, bar);
      __builtin_amdgcn_fence(__ATOMIC_ACQUIRE, "agent");
      asm volatile("s_waitcnt vmcnt(0)" ::: "memory");
    }
  }
  __syncthreads();
}

__global__ void __launch_bounds__(256, 2) mega(Params p) {
  __shared__ __attribute__((aligned(16))) char smem[40960 + 16];
  cg::grid_group grid = cg::this_grid();
  const int bid = blockIdx.x, nblk = gridDim.x;
  if (threadIdx.x == 0) { ((unsigned*)(smem + 40960))[0] = 0u; ((unsigned*)(smem + 40960))[1] = 0u; }
  __syncthreads();
  const XcdBarrier xb = xcd_barrier_post(p.XBAR, (volatile LAS unsigned*)(smem + 40960));
  ph_prologue(p, bid, nblk, smem);
  ln_rows(p, 0, 0, bid, nblk);
  if (PROBE == 5) { ph_prologue(p, bid, nblk, smem); ln_rows(p, 0, 0, bid, nblk); }
  grid.sync();
  for (int l = 0; l < 2; ++l) {
    ph_gemm<0>(p, l, bid, nblk, smem);
    if (PROBE == 1) ph_gemm<0>(p, l, bid, nblk, smem);
    xcd_barrier(xb);
    for (int rep = 0; rep < (PROBE == 3 ? 2 : 1); ++rep) {
    for (int item = bid; item < 2048; item += nblk) ph_mlstm_local(p, l, item, smem);
    for (int item = bid; item < 2048; item += nblk) ph_hgrn_local(p, l, item, smem);
    __syncthreads();
    for (int item = bid; item < 256; item += nblk) ph_cmp(p, l, item, smem);
    for (int item = bid; item < 2048; item += nblk) ph_attnA(p, l, item, smem);
    }
    xcd_barrier(xb);
    if (bid < 128) ph_mlstm_scan(p, bid);
    else if (bid < 256) ph_hgrn_scan(p, bid - 128);
    __syncthreads();
    ph_attnD(p, l, p.CTR + l, smem);
    if (PROBE == 2) ph_attnD(p, l, p.CTR + 2 + l, smem);
    xcd_barrier(xb);
    for (int rep = 0; rep < (PROBE == 4 ? 2 : 1); ++rep) {
    for (int item = bid; item < 2048; item += nblk) ph_mlstm_out(p, l, item, smem);
    for (int item = bid; item < 2048; item += nblk) ph_hgrn_out(p, l, item, smem);
    }
    xcd_barrier(xb);
    ph_gemm<1>(p, l, bid, nblk, smem);
    xcd_barrier(xb);
    ln_rows(p, 1, l, bid, nblk);
    if (l == 0) xcd_barrier(xb);
  }
}

static inline size_t align_up(size_t v) { return (v + 255) & ~(size_t)255; }

extern "C" void kernel_launch(void* const* d_in, const int* in_sizes, int n_in, void* d_out, int out_size, void* d_ws, size_t ws_size, hipStream_t stream) {
  Params p{};
  p.x = (const float*)d_in[0]; p.ln0_g = (const float*)d_in[1]; p.ln0_b = (const float*)d_in[2]; p.w_in = (const float*)d_in[3];
  p.b_in = (const float*)d_in[4]; p.a_sinks = (const float*)d_in[5]; p.conv_w = (const float*)d_in[6]; p.conv_b = (const float*)d_in[7];
  p.c_lb = (const float*)d_in[8]; p.c_norm_g = (const float*)d_in[9]; p.pe = (const float*)d_in[10]; p.w1 = (const float*)d_in[11];
  p.w2 = (const float*)d_in[12]; p.w_out = (const float*)d_in[13]; p.ln_g = (const float*)d_in[14]; p.ln_b = (const float*)d_in[15];
  p.hf = (float*)d_out;
  char* w = (char*)d_ws; size_t off = 0;
  auto take = [&](size_t bytes) { char* r = w + off; off = align_up(off + bytes); return r; };
  p.HB = (bf16_t*)take((size_t)NTOK * 1024 * 2);
  p.YMIX = (bf16_t*)take((size_t)NTOK * 1024 * 2);
  p.QA = (bf16_t*)take((size_t)NTOK * 256 * 2);
  p.KA = (bf16_t*)take((size_t)NTOK * 128 * 2);
  p.VAT = (bf16_t*)take((size_t)NTOK * 128 * 2);
  p.QKB = (bf16_t*)take((size_t)NTOK * 512 * 2);
  p.VBT = (bf16_t*)take((size_t)NTOK * 256 * 2);
  p.QC = (bf16_t*)take((size_t)NTOK * 256 * 2);
  p.GC = (float*)take((size_t)NTOK * 256 * 4);
  p.VCT = (bf16_t*)take((size_t)NTOK * 256 * 2);
  p.QD = (bf16_t*)take((size_t)NTOK * 256 * 2);
  p.KV = (bf16_t*)take((size_t)NTOK * 384 * 2);
  p.GZ = (bf16_t*)take((size_t)NTOK * 1280 * 2);
  p.IFG = (float*)take((size_t)NTOK * 8 * 4);
  p.DG = (float*)take((size_t)NTOK * 12 * 4);
  p.WT = (bf16_t*)take((size_t)2 * NP * 1024 * 2);
  p.WOT = (bf16_t*)take((size_t)2 * 1024 * 1024 * 2);
  p.KCMP = (bf16_t*)take((size_t)NB * 128 * 64 * 2);
  p.VCMPT = (bf16_t*)take((size_t)NB * 64 * 128 * 2);
  p.BIASP = (float*)take((size_t)2 * NP * 4);
  p.LB = (float*)take(512 * 4);
  p.ROPEC = (float*)take((size_t)T * 32 * 4);
  p.ROPES = (float*)take((size_t)T * 32 * 4);
  p.BST = (float*)take((size_t)2048 * 4096 * 4);
  p.BN = (float*)take((size_t)2048 * 64 * 4);
  p.BG = (float*)take(2048 * 4);
  p.CST = (float*)take((size_t)2048 * 4096 * 4);
  p.CAL = (float*)take((size_t)2048 * 64 * 4);
  p.W1T = (bf16_t*)take((size_t)4 * 64 * 2048 * 2);
  p.W2T = (bf16_t*)take((size_t)4 * 64 * 64 * 2);
  p.CVEC = (float*)take(256 * 4);
  p.CTR = (int*)take(256);
  p.XBAR = (unsigned*)take(XCD_BAR_WORDS * 4);
  if (off > ws_size) { fprintf(stderr, "workspace too small: need %zu have %zu\n", off, ws_size); return; }

  static int grid_blocks = 0;
  if (!grid_blocks) {
    int dev = 0, cus = 0, per_cu = 0;
    (void)hipGetDevice(&dev);
    (void)hipDeviceGetAttribute(&cus, hipDeviceAttributeMultiprocessorCount, dev);
    (void)hipOccupancyMaxActiveBlocksPerMultiprocessor(&per_cu, mega, 256, 0);
    if (per_cu > 2) per_cu = 2;
    grid_blocks = cus * per_cu;
  }
  (void)hipMemsetAsync(p.XBAR, 0, XCD_BAR_WORDS * 4, stream);
  void* args[] = {&p};
  hipError_t e = hipLaunchCooperativeKernel((void*)mega, dim3(grid_blocks), dim3(256), args, 0, stream);
  if (e != hipSuccess) fprintf(stderr, "cooperative launch failed: %s (grid %d)\n", hipGetErrorString(e), grid_blocks);
}
```

```cpp
#include <hip/hip_runtime.h>
#include <hip/hip_cooperative_groups.h>
#include <stdio.h>
#include <stdint.h>
#include <stddef.h>

#ifndef PROBE
#define PROBE 0
#endif
#define DI __device__ __forceinline__
typedef unsigned short bf16_t;
typedef short bf16x8 __attribute__((ext_vector_type(8)));
typedef float f32x16 __attribute__((ext_vector_type(16)));
typedef unsigned u32x4 __attribute__((ext_vector_type(4)));
typedef float f32x4 __attribute__((ext_vector_type(4)));

constexpr int NB = 32, T = 2048, DM = 1024, NTOK = NB * T, NP = 4096;
constexpr float DN_ALPHA = 1.41421356237309515f;

constexpr size_t OFF_HB = 0;
constexpr size_t SZ_HB = (size_t)NTOK * 1024 * 2;
constexpr size_t OFF_YMIX = OFF_HB + ((SZ_HB + 255) & ~(size_t)255);
constexpr size_t SZ_YMIX = (size_t)NTOK * 1024 * 2;
constexpr size_t OFF_QA = OFF_YMIX + ((SZ_YMIX + 255) & ~(size_t)255);
constexpr size_t SZ_QA = (size_t)NTOK * 256 * 2;
constexpr size_t OFF_KA = OFF_QA + ((SZ_QA + 255) & ~(size_t)255);
constexpr size_t SZ_KA = (size_t)NTOK * 128 * 2;
constexpr size_t OFF_VAT = OFF_KA + ((SZ_KA + 255) & ~(size_t)255);
constexpr size_t SZ_VAT = (size_t)NTOK * 128 * 2;
constexpr size_t OFF_QKB = OFF_VAT + ((SZ_VAT + 255) & ~(size_t)255);
constexpr size_t SZ_QKB = (size_t)NTOK * 512 * 2;
constexpr size_t OFF_VBT = OFF_QKB + ((SZ_QKB + 255) & ~(size_t)255);
constexpr size_t SZ_VBT = (size_t)NTOK * 256 * 2;
constexpr size_t OFF_QC = OFF_VBT + ((SZ_VBT + 255) & ~(size_t)255);
constexpr size_t SZ_QC = (size_t)NTOK * 256 * 2;
constexpr size_t OFF_GC = OFF_QC + ((SZ_QC + 255) & ~(size_t)255);
constexpr size_t SZ_GC = (size_t)NTOK * 256 * 4;
constexpr size_t OFF_VCT = OFF_GC + ((SZ_GC + 255) & ~(size_t)255);
constexpr size_t SZ_VCT = (size_t)NTOK * 256 * 2;
constexpr size_t OFF_QD = OFF_VCT + ((SZ_VCT + 255) & ~(size_t)255);
constexpr size_t SZ_QD = (size_t)NTOK * 256 * 2;
constexpr size_t OFF_KV = OFF_QD + ((SZ_QD + 255) & ~(size_t)255);
constexpr size_t SZ_KV = (size_t)NTOK * 384 * 2;
constexpr size_t OFF_GZ = OFF_KV + ((SZ_KV + 255) & ~(size_t)255);
constexpr size_t SZ_GZ = (size_t)NTOK * 1280 * 2;
constexpr size_t OFF_IFG = OFF_GZ + ((SZ_GZ + 255) & ~(size_t)255);
constexpr size_t SZ_IFG = (size_t)NTOK * 8 * 4;
constexpr size_t OFF_DG = OFF_IFG + ((SZ_IFG + 255) & ~(size_t)255);
constexpr size_t SZ_DG = (size_t)NTOK * 12 * 4;
constexpr size_t OFF_WT = OFF_DG + ((SZ_DG + 255) & ~(size_t)255);
constexpr size_t SZ_WT = (size_t)2 * NP * 1024 * 2;
constexpr size_t OFF_WOT = OFF_WT + ((SZ_WT + 255) & ~(size_t)255);
constexpr size_t SZ_WOT = (size_t)2 * 1024 * 1024 * 2;
constexpr size_t OFF_KCMP = OFF_WOT + ((SZ_WOT + 255) & ~(size_t)255);
constexpr size_t SZ_KCMP = (size_t)NB * 128 * 64 * 2;
constexpr size_t OFF_VCMPT = OFF_KCMP + ((SZ_KCMP + 255) & ~(size_t)255);
constexpr size_t SZ_VCMPT = (size_t)NB * 64 * 128 * 2;
constexpr size_t OFF_BIASP = OFF_VCMPT + ((SZ_VCMPT + 255) & ~(size_t)255);
constexpr size_t SZ_BIASP = (size_t)2 * NP * 4;
constexpr size_t OFF_LB = OFF_BIASP + ((SZ_BIASP + 255) & ~(size_t)255);
constexpr size_t SZ_LB = (size_t)512 * 4;
constexpr size_t OFF_ROPEC = OFF_LB + ((SZ_LB + 255) & ~(size_t)255);
constexpr size_t SZ_ROPEC = (size_t)T * 32 * 4;
constexpr size_t OFF_ROPES = OFF_ROPEC + ((SZ_ROPEC + 255) & ~(size_t)255);
constexpr size_t SZ_ROPES = (size_t)T * 32 * 4;
constexpr size_t OFF_BST = OFF_ROPES + ((SZ_ROPES + 255) & ~(size_t)255);
constexpr size_t SZ_BST = (size_t)2048 * 4096 * 4;
constexpr size_t OFF_BN = OFF_BST + ((SZ_BST + 255) & ~(size_t)255);
constexpr size_t SZ_BN = (size_t)2048 * 64 * 4;
constexpr size_t OFF_BG = OFF_BN + ((SZ_BN + 255) & ~(size_t)255);
constexpr size_t SZ_BG = (size_t)2048 * 4;
constexpr size_t OFF_CST = OFF_BG + ((SZ_BG + 255) & ~(size_t)255);
constexpr size_t SZ_CST = (size_t)2048 * 4096 * 4;
constexpr size_t OFF_CAL = OFF_CST + ((SZ_CST + 255) & ~(size_t)255);
constexpr size_t SZ_CAL = (size_t)2048 * 64 * 4;
constexpr size_t OFF_W1T = OFF_CAL + ((SZ_CAL + 255) & ~(size_t)255);
constexpr size_t SZ_W1T = (size_t)4 * 64 * 2048 * 2;
constexpr size_t OFF_W2T = OFF_W1T + ((SZ_W1T + 255) & ~(size_t)255);
constexpr size_t SZ_W2T = (size_t)4 * 64 * 64 * 2;
constexpr size_t OFF_CVEC = OFF_W2T + ((SZ_W2T + 255) & ~(size_t)255);
constexpr size_t SZ_CVEC = (size_t)256 * 4;
constexpr size_t OFF_CTR = OFF_CVEC + ((SZ_CVEC + 255) & ~(size_t)255);
constexpr size_t SZ_CTR = (size_t)256;
constexpr size_t OFF_XBAR = OFF_CTR + ((SZ_CTR + 255) & ~(size_t)255);
constexpr size_t SZ_XBAR = (size_t)3456 * 4;
constexpr size_t WS_TOTAL = OFF_XBAR + ((SZ_XBAR + 255) & ~(size_t)255);
struct Params {
  const float *x, *ln0_g, *ln0_b, *w_in, *b_in, *a_sinks, *conv_w, *conv_b, *c_lb, *c_norm_g, *pe, *w1, *w2, *w_out, *ln_g, *ln_b;
  float* hf;
  char* ws;
  DI bf16_t* HB() const { return (bf16_t*)(ws + OFF_HB); }
  DI bf16_t* YMIX() const { return (bf16_t*)(ws + OFF_YMIX); }
  DI bf16_t* QA() const { return (bf16_t*)(ws + OFF_QA); }
  DI bf16_t* KA() const { return (bf16_t*)(ws + OFF_KA); }
  DI bf16_t* VAT() const { return (bf16_t*)(ws + OFF_VAT); }
  DI bf16_t* QKB() const { return (bf16_t*)(ws + OFF_QKB); }
  DI bf16_t* VBT() const { return (bf16_t*)(ws + OFF_VBT); }
  DI bf16_t* QC() const { return (bf16_t*)(ws + OFF_QC); }
  DI float* GC() const { return (float*)(ws + OFF_GC); }
  DI bf16_t* VCT() const { return (bf16_t*)(ws + OFF_VCT); }
  DI bf16_t* QD() const { return (bf16_t*)(ws + OFF_QD); }
  DI bf16_t* KV() const { return (bf16_t*)(ws + OFF_KV); }
  DI bf16_t* GZ() const { return (bf16_t*)(ws + OFF_GZ); }
  DI float* IFG() const { return (float*)(ws + OFF_IFG); }
  DI float* DG() const { return (float*)(ws + OFF_DG); }
  DI bf16_t* WT() const { return (bf16_t*)(ws + OFF_WT); }
  DI bf16_t* WOT() const { return (bf16_t*)(ws + OFF_WOT); }
  DI bf16_t* KCMP() const { return (bf16_t*)(ws + OFF_KCMP); }
  DI bf16_t* VCMPT() const { return (bf16_t*)(ws + OFF_VCMPT); }
  DI float* BIASP() const { return (float*)(ws + OFF_BIASP); }
  DI float* LB() const { return (float*)(ws + OFF_LB); }
  DI float* ROPEC() const { return (float*)(ws + OFF_ROPEC); }
  DI float* ROPES() const { return (float*)(ws + OFF_ROPES); }
  DI float* BST() const { return (float*)(ws + OFF_BST); }
  DI float* BN() const { return (float*)(ws + OFF_BN); }
  DI float* BG() const { return (float*)(ws + OFF_BG); }
  DI float* CST() const { return (float*)(ws + OFF_CST); }
  DI float* CAL() const { return (float*)(ws + OFF_CAL); }
  DI bf16_t* W1T() const { return (bf16_t*)(ws + OFF_W1T); }
  DI bf16_t* W2T() const { return (bf16_t*)(ws + OFF_W2T); }
  DI float* CVEC() const { return (float*)(ws + OFF_CVEC); }
  DI int* CTR() const { return (int*)(ws + OFF_CTR); }
  DI unsigned* XBAR() const { return (unsigned*)(ws + OFF_XBAR); }
};
namespace cg = cooperative_groups;

DI int tid_opaque() { int t = threadIdx.x & 255; asm volatile("" : "+v"(t)); return t; }
DI int half_id() { return __builtin_amdgcn_readfirstlane((int)(threadIdx.x >> 8)); }
DI float bf2f(bf16_t v) { return __uint_as_float(((unsigned)v) << 16); }
DI bf16_t f2bf(float x) { unsigned u = __float_as_uint(x); u += 0x7fffu + ((u >> 16) & 1u); return (bf16_t)(u >> 16); }
DI float sigmoidf_(float x) { return 1.f / (1.f + __expf(-x)); }
DI float siluf_(float x) { return x / (1.f + __expf(-x)); }
DI int lane_op() { int l = threadIdx.x & 63; asm volatile("" : "+v"(l)); return l; }
DI float shx(float v, int m) { return __builtin_bit_cast(float, __builtin_amdgcn_ds_bpermute((lane_op() ^ m) << 2, __builtin_bit_cast(int, v))); }
DI unsigned shx(unsigned v, int m) { return (unsigned)__builtin_amdgcn_ds_bpermute((lane_op() ^ m) << 2, (int)v); }
DI float shup(float v, int d) { const int l = lane_op(); const int s = l - d; return __builtin_bit_cast(float, __builtin_amdgcn_ds_bpermute((s < 0 ? l : s) << 2, __builtin_bit_cast(int, v))); }
DI float wave_sum(float v) { for (int o = 32; o > 0; o >>= 1) v += shx(v, o); return v; }
DI float wave_max(float v) { for (int o = 32; o > 0; o >>= 1) v = fmaxf(v, shx(v, o)); return v; }

DI int orig_col(int n) {
  if (n < 1536) return n;
  if (n < 3712) return n + 8;
  if (n < 3968) return n + 20;
  if (n < 3976) return 1536 + (n - 3968);
  if (n < 3988) return 3720 + (n - 3976);
  return -1;
}

DI void ph_prologue(const Params& p, int bid, int nblk, char* smem) {
  const long gtid = (long)bid * 256 + tid_opaque(), gsz = (long)nblk * 256;
  if (gtid < 64) p.CTR()[gtid] = 0;
  for (long idx = gtid; idx < 2L * 128 * NP; idx += gsz) {
    const int n = (int)(idx % NP), k8 = (int)((idx / NP) % 128), l = (int)(idx / (NP * 128));
    const int pp = n & 63;
    const int oc = orig_col((n & ~63) + 32 * ((pp >> 4) & 1) + 16 * (pp >> 5) + (pp & 15));
    unsigned w[4];
    for (int j = 0; j < 4; ++j) {
      float a = 0.f, b = 0.f;
      if (oc >= 0) { a = p.w_in[((size_t)l * 1024 + k8 * 8 + 2 * j) * 3988 + oc]; b = p.w_in[((size_t)l * 1024 + k8 * 8 + 2 * j + 1) * 3988 + oc]; }
      w[j] = (unsigned)f2bf(a) | ((unsigned)f2bf(b) << 16);
    }
    *(uint4*)(p.WT() + ((size_t)l * NP + n) * 1024 + k8 * 8) = make_uint4(w[0], w[1], w[2], w[3]);
  }
  for (long idx = gtid; idx < 2L * 128 * 1024; idx += gsz) {
    const int d = (int)(idx % 1024), m8 = (int)((idx / 1024) % 128), l = (int)(idx / (1024 * 128));
    unsigned w[4];
    for (int j = 0; j < 4; ++j) {
      float a = p.w_out[((size_t)l * 1024 + m8 * 8 + 2 * j) * 1024 + d], b = p.w_out[((size_t)l * 1024 + m8 * 8 + 2 * j + 1) * 1024 + d];
      w[j] = (unsigned)f2bf(a) | ((unsigned)f2bf(b) << 16);
    }
    *(uint4*)(p.WOT() + ((size_t)l * 1024 + d) * 1024 + m8 * 8) = make_uint4(w[0], w[1], w[2], w[3]);
  }
  for (long idx = gtid; idx < 4L * 256 * 64; idx += gsz) {
    const int j = (int)(idx % 64), i8 = (int)((idx / 64) % 256), lk = (int)(idx / (64 * 256));
    unsigned w[4];
    for (int e = 0; e < 4; ++e) {
      const float a = p.w1[((size_t)lk * 2048 + i8 * 8 + 2 * e) * 64 + j], b = p.w1[((size_t)lk * 2048 + i8 * 8 + 2 * e + 1) * 64 + j];
      w[e] = (unsigned)f2bf(a) | ((unsigned)f2bf(b) << 16);
    }
    *(uint4*)(p.W1T() + ((size_t)lk * 64 + j) * 2048 + i8 * 8) = make_uint4(w[0], w[1], w[2], w[3]);
  }
  for (long idx = gtid; idx < 4L * 64 * 64; idx += gsz) {
    const int jo = (int)(idx % 64), ji = (int)((idx / 64) % 64), lk = (int)(idx / 4096);
    p.W2T()[((size_t)lk * 64 + jo) * 64 + ji] = f2bf(p.w2[((size_t)lk * 64 + ji) * 64 + jo]);
  }
  if (bid < 4) {
    const int lk = bid, j = tid_opaque() & 63, part = tid_opaque() >> 6;
    float a = 0.f;
    for (int i = part * 512; i < part * 512 + 512; ++i) a += p.pe[(size_t)lk * 2048 + i] * p.w1[((size_t)lk * 2048 + i) * 64 + j];
    float* red = (float*)smem;
    red[part * 64 + j] = a;
    __syncthreads();
    if (part == 0) p.CVEC()[lk * 64 + j] = (red[j] + red[64 + j]) + (red[128 + j] + red[192 + j]);
    __syncthreads();
  }
  for (long idx = gtid; idx < 2L * NP; idx += gsz) {
    const int n = (int)(idx % NP), l = (int)(idx / NP); const int oc = orig_col(n);
    p.BIASP()[idx] = oc >= 0 ? p.b_in[l * 3988 + oc] : 0.f;
  }
  for (long idx = gtid; idx < (long)T * 32; idx += gsz) {
    const int t = (int)(idx / 32), i = (int)(idx % 32);
    const float inv = exp2f(-(float)i * (13.287712379549449f / 32.0f));
    const float ang = (float)t * inv;
    p.ROPEC()[idx] = cosf(ang); p.ROPES()[idx] = sinf(ang);
  }
  for (long idx = gtid; idx < 512; idx += gsz) {
    const int c = (int)(idx % 256), l = (int)(idx / 256);
    const float a = p.c_lb[c], b = p.c_lb[256 + c];
    const float m = fmaxf(a, b); const float ea = expf(a - m), eb = expf(b - m);
    p.LB()[idx] = l == 0 ? 0.f : eb / (ea + eb);
  }
}

DI void ln_rows(const Params& p, int mode, int layer, int bid, int nblk) {
  const int tid_ = tid_opaque(); const int lane = tid_ & 63, wid = tid_ >> 6, nw = 4;
  const float* g = mode == 0 ? p.ln0_g : p.ln_g + layer * 1024;
  const float* bb = mode == 0 ? p.ln0_b : p.ln_b + layer * 1024;
  const float* src = mode == 0 ? p.x : p.hf;
  for (int row = bid * nw + wid; row < NTOK; row += nblk * nw) {
    const float* s = src + (size_t)row * 1024;
    float4 v[4];
    float sum = 0.f;
#pragma unroll
    for (int i = 0; i < 4; ++i) { v[i] = *(const float4*)(s + i * 256 + lane * 4); sum += (v[i].x + v[i].y) + (v[i].z + v[i].w); }
    sum = wave_sum(sum);
    const float mu = sum * (1.f / 1024.f);
    float q = 0.f;
#pragma unroll
    for (int i = 0; i < 4; ++i) { float a = v[i].x - mu, b = v[i].y - mu, c = v[i].z - mu, d = v[i].w - mu; q += (a * a + b * b) + (c * c + d * d); }
    q = wave_sum(q);
    const float rs = rsqrtf(q * (1.f / 1024.f) + 1e-5f);
#pragma unroll
    for (int i = 0; i < 4; ++i) {
      const int c0 = i * 256 + lane * 4;
      const float4 gg = *(const float4*)(g + c0), b4 = *(const float4*)(bb + c0);
      float4 o;
      o.x = (v[i].x - mu) * rs * gg.x + b4.x; o.y = (v[i].y - mu) * rs * gg.y + b4.y;
      o.z = (v[i].z - mu) * rs * gg.z + b4.z; o.w = (v[i].w - mu) * rs * gg.w + b4.w;
      *(float4*)(p.hf + (size_t)row * 1024 + c0) = o;
      uint2 pk; pk.x = (unsigned)f2bf(o.x) | ((unsigned)f2bf(o.y) << 16); pk.y = (unsigned)f2bf(o.z) | ((unsigned)f2bf(o.w) << 16);
      *(uint2*)(p.HB() + (size_t)row * 1024 + c0) = pk;
    }
  }
}

typedef float f32x2 __attribute__((ext_vector_type(2)));
typedef __bf16 bf16v2 __attribute__((ext_vector_type(2)));
typedef unsigned u32x2 __attribute__((ext_vector_type(2)));
DI unsigned pack2(float a, float b) { f32x2 v = {a, b}; return __builtin_bit_cast(unsigned, __builtin_convertvector(v, bf16v2)); }
DI f32x16 zero16() { f32x16 z;
#pragma unroll
  for (int i = 0; i < 16; ++i) z[i] = 0.f; return z; }
DI bf16x8 ld_frag8x2(const bf16_t* p) { const u32x2 lo = *(const u32x2*)p, hi = *(const u32x2*)(p + 8); u32x4 t = {lo.x, lo.y, hi.x, hi.y}; return __builtin_bit_cast(bf16x8, t); }
template <int BASE> DI bf16x8 pack8(const f32x16& s) {
  u32x4 t = {pack2(s[BASE + 0], s[BASE + 1]), pack2(s[BASE + 2], s[BASE + 3]), pack2(s[BASE + 4], s[BASE + 5]), pack2(s[BASE + 6], s[BASE + 7])};
  return __builtin_bit_cast(bf16x8, t);
}
DI int crow(int r, int h2) { return (r & 3) + 8 * (r >> 2) + 4 * h2; }
#define MFMA32(a, b, c) __builtin_amdgcn_mfma_f32_32x32x16_bf16((a), (b), (c), 0, 0, 0)
#define LAS __attribute__((address_space(3)))
enum { K_NONE = 0, K_ROPE, K_PLAIN, K_TR, K_GSILU, K_GSIG, K_SILUH, K_LOGF, K_SMALL };
namespace g8 {
constexpr int BK = 64, HALF = 128, HT = HALF * BK;
DI int lds_byte(int r, int c) { const int st = (r >> 4) * 2 + (c >> 5), rr = r & 15, cc = c & 31, ob = rr * 64 + cc * 2; return st * 1024 + (ob ^ (((ob >> 9) & 1) << 5)); }
DI void stage_rc(int b, int& R, int& C) { const int st = b / 1024, sb = b % 1024, swz = sb ^ (((sb >> 9) & 1) << 5); R = (st >> 1) * 16 + swz / 64; C = (st & 1) * 32 + (swz % 64) / 2; }
}
DI void gemm256_mainloop(const bf16_t* A, const bf16_t* Bt, bf16_t* shm, f32x4 (&acc)[2][2][4][2]) {
  using namespace g8;
  constexpr int K = 1024;
#define SA(b, h) (shm + ((b) * 2 + (h)) * HT)
#define SB(b, h) (shm + (4 + (b) * 2 + (h)) * HT)
#define STAGE(P, BASE, br, kt) do { const long g_ = (long)(br) * K + (long)(kt) * BK; \
    _Pragma("unroll") for (int i_ = 0; i_ < 2; ++i_) { const int b_ = tidf * 16 + i_ * 8192; int r_, c_; stage_rc(b_, r_, c_); \
      __builtin_amdgcn_global_load_lds((const unsigned*)((BASE) + g_ + (long)r_ * K + c_), (LAS unsigned*)((char*)(P) + b_), 16, 0, 0); } } while (0)
#define LDA(dst, b, h) _Pragma("unroll") for (int m = 0; m < 4; ++m) _Pragma("unroll") for (int k = 0; k < 2; ++k) \
    dst[m][k] = *reinterpret_cast<const bf16x8*>((const char*)SA(b, h) + lds_byte(wr * 64 + m * 16 + fr, k * 32 + fq * 8))
#define LDB(dst, b, h) _Pragma("unroll") for (int n = 0; n < 2; ++n) _Pragma("unroll") for (int k = 0; k < 2; ++k) \
    dst[n][k] = *reinterpret_cast<const bf16x8*>((const char*)SB(b, h) + lds_byte(wc * 32 + n * 16 + fr, k * 32 + fq * 8))
#define MMA(ai, bj, At_, Bt_) do { __builtin_amdgcn_s_setprio(1); \
    _Pragma("unroll") for (int m = 0; m < 4; ++m) _Pragma("unroll") for (int n = 0; n < 2; ++n) _Pragma("unroll") for (int k = 0; k < 2; ++k) \
      acc[ai][bj][m][n] = __builtin_amdgcn_mfma_f32_16x16x32_bf16(At_[m][k], Bt_[n][k], acc[ai][bj][m][n], 0, 0, 0); \
    __builtin_amdgcn_s_setprio(0); } while (0)
#define WAIT_V(n) asm volatile("s_waitcnt vmcnt(" #n ")" ::: "memory")
#define WAIT_L(n) asm volatile("s_waitcnt lgkmcnt(" #n ")" ::: "memory")
#define BAR __builtin_amdgcn_s_barrier()
#define SCHED __builtin_amdgcn_sched_barrier(0)
  int tidf = threadIdx.x; asm volatile("" : "+v"(tidf));
  const int wid = tidf >> 6, lane = tidf & 63, wr = wid >> 2, wc = wid & 3, fr = lane & 15, fq = lane >> 4;
#pragma unroll
  for (int a = 0; a < 2; ++a)
#pragma unroll
    for (int b = 0; b < 2; ++b)
#pragma unroll
      for (int m = 0; m < 4; ++m)
#pragma unroll
        for (int n = 0; n < 2; ++n) acc[a][b][m][n] = (f32x4){0.f, 0.f, 0.f, 0.f};
  bf16x8 At[4][2], B0[2][2], B1[2][2];
  constexpr int nt = K / BK;
  WAIT_V(0);
  STAGE(SB(0, 0), Bt, 0, 0); STAGE(SA(0, 0), A, 0, 0);
  STAGE(SB(0, 1), Bt, HALF, 0); STAGE(SA(0, 1), A, HALF, 0);
  if (wr == 1) BAR;
  WAIT_V(4); BAR;
  STAGE(SB(1, 0), Bt, 0, 1); STAGE(SA(1, 0), A, 0, 1); STAGE(SB(1, 1), Bt, HALF, 1);
  WAIT_V(6); BAR;
  for (int t = 0; t < nt - 2; t += 2) {
    LDB(B0, 0, 0); SCHED; LDA(At, 0, 0); STAGE(SA(1, 1), A, HALF, t + 1);
    WAIT_L(8); BAR; WAIT_L(0); MMA(0, 0, At, B0); BAR; SCHED;
    LDB(B1, 0, 1); STAGE(SB(0, 0), Bt, 0, t + 2);
    BAR; WAIT_L(0); MMA(0, 1, At, B1); BAR;
    LDA(At, 0, 1); STAGE(SA(0, 0), A, 0, t + 2);
    BAR; WAIT_L(0); MMA(1, 0, At, B0); BAR; SCHED;
    STAGE(SB(0, 1), Bt, HALF, t + 2);
    WAIT_V(6); BAR; MMA(1, 1, At, B1); BAR;
    LDB(B0, 1, 0); SCHED; LDA(At, 1, 0); STAGE(SA(0, 1), A, HALF, t + 2);
    WAIT_L(8); BAR; WAIT_L(0); MMA(0, 0, At, B0); BAR; SCHED;
    LDB(B1, 1, 1); STAGE(SB(1, 0), Bt, 0, t + 3);
    BAR; WAIT_L(0); MMA(0, 1, At, B1); BAR;
    LDA(At, 1, 1); STAGE(SA(1, 0), A, 0, t + 3);
    BAR; WAIT_L(0); MMA(1, 0, At, B0); BAR; SCHED;
    STAGE(SB(1, 1), Bt, HALF, t + 3);
    WAIT_V(6); BAR; MMA(1, 1, At, B1); BAR;
  }
  { LDB(B0, 0, 0); LDA(At, 0, 0); STAGE(SA(1, 1), A, HALF, nt - 1);
    BAR; WAIT_L(0); MMA(0, 0, At, B0); BAR;
    LDB(B1, 0, 1); BAR; WAIT_L(0); MMA(0, 1, At, B1); BAR;
    LDA(At, 0, 1); WAIT_V(4); BAR; WAIT_L(0); MMA(1, 0, At, B0); MMA(1, 1, At, B1); BAR; }
  { LDB(B0, 1, 0); LDA(At, 1, 0); WAIT_V(2); BAR; WAIT_L(0); MMA(0, 0, At, B0); BAR;
    LDB(B1, 1, 1); WAIT_V(0); BAR; WAIT_L(0); MMA(0, 1, At, B1); BAR;
    LDA(At, 1, 1); BAR; WAIT_L(0); MMA(1, 0, At, B0); MMA(1, 1, At, B1); BAR; }
  if (wr == 0) BAR;
#undef SA
#undef SB
#undef STAGE
#undef LDA
#undef LDB
#undef MMA
#undef WAIT_V
#undef WAIT_L
#undef BAR
#undef SCHED
}

DI void classify_head(const Params& p, int hd, int b, int& kind, bf16_t*& dst, float*& fdst, float& scale) {
  kind = K_NONE; dst = nullptr; fdst = nullptr; scale = 1.f;
  if (hd < 4) { kind = K_ROPE; dst = p.QA() + ((size_t)(b * 4 + hd) * T) * 64; scale = 0.125f; }
  else if (hd < 6) { kind = K_ROPE; dst = p.KA() + ((size_t)(b * 2 + hd - 4) * T) * 64; }
  else if (hd < 8) { kind = K_TR; dst = p.VAT() + (size_t)(b * 2 + hd - 6) * 64 * T; }
  else if (hd < 12) { kind = K_GSILU; dst = p.GZ() + (size_t)0 * NTOK * 256 + (hd - 8) * 64; }
  else if (hd < 20) { kind = K_PLAIN; dst = p.QKB() + ((size_t)(b * 8 + hd - 12) * T) * 64; }
  else if (hd < 24) { kind = K_TR; dst = p.VBT() + (size_t)(b * 4 + hd - 20) * 64 * T; }
  else if (hd < 28) { kind = K_GSIG; dst = p.GZ() + (size_t)1 * NTOK * 256 + (hd - 24) * 64; }
  else if (hd < 32) { kind = K_GSILU; dst = p.GZ() + (size_t)2 * NTOK * 256 + (hd - 28) * 64; }
  else if (hd < 36) { kind = K_SILUH; dst = p.QC() + ((size_t)(b * 4 + hd - 32) * T) * 64; }
  else if (hd < 40) { kind = K_LOGF; fdst = p.GC() + ((size_t)(b * 4 + hd - 36) * T) * 64; }
  else if (hd < 44) { kind = K_TR; dst = p.VCT() + (size_t)(b * 4 + hd - 40) * 64 * T; }
  else if (hd < 48) { kind = K_GSILU; dst = p.GZ() + (size_t)3 * NTOK * 256 + (hd - 44) * 64; }
  else if (hd < 52) { kind = K_ROPE; dst = p.QD() + ((size_t)(b * 4 + hd - 48) * T) * 64; scale = 0.125f; }
  else if (hd < 58) {
    const int j = hd - 52;
    dst = p.KV() + (size_t)(j * NB + b) * T * 64;
    kind = (j == 0 || j == 1) ? K_PLAIN : ((j == 2 || j == 4) ? K_ROPE : K_TR);
  }
  else if (hd < 62) { kind = K_GSILU; dst = p.GZ() + (size_t)4 * NTOK * 256 + (hd - 58) * 64; }
  else if (hd == 62) { kind = K_SMALL; }
}

template <int KIND>
DI void epi_write_image(const Params& p, const f32x4 (&a)[4][2], char* img, float scale, float bias0, float bias1, float lb0, float lb1,
                        int b, int tq, int wr, int c0, int fq) {
  if (KIND == K_TR) {
    bf16_t* timg = (bf16_t*)img;
#pragma unroll
    for (int m = 0; m < 4; ++m)
#pragma unroll
      for (int n = 0; n < 2; ++n) {
        const float bs = n ? bias1 : bias0;
        u32x2 w = {pack2(a[m][n][0] + bs, a[m][n][1] + bs), pack2(a[m][n][2] + bs, a[m][n][3] + bs)};
        *(u32x2*)(timg + (c0 + 32 * n) * 128 + wr * 64 + m * 16 + fq * 4) = w;
      }
    return;
  }
#pragma unroll
  for (int m = 0; m < 4; ++m)
#pragma unroll
    for (int j = 0; j < 4; ++j) {
      const int row = wr * 64 + m * 16 + fq * 4 + j;
      const float v0 = a[m][0][j] + bias0, v1 = a[m][1][j] + bias1;
      if (KIND == K_LOGF) {
        float* fimg = (float*)img;
        const float f0 = lb0 + (1.f - lb0) * sigmoidf_(v0), f1 = lb1 + (1.f - lb1) * sigmoidf_(v1);
        fimg[row * 64 + c0] = __logf(f0); fimg[row * 64 + c0 + 32] = __logf(f1);
      } else {
        bf16_t* bimg = (bf16_t*)img;
        float o0, o1;
        if (KIND == K_ROPE) {
          const int t = tq + row;
          const float c = p.ROPEC()[t * 32 + c0], s = p.ROPES()[t * 32 + c0];
          o0 = (v0 * c - v1 * s) * scale; o1 = (v0 * s + v1 * c) * scale;
        } else if (KIND == K_PLAIN) { o0 = v0; o1 = v1; }
        else if (KIND == K_SILUH || KIND == K_GSILU) { o0 = siluf_(v0); o1 = siluf_(v1); }
        else { o0 = sigmoidf_(v0); o1 = sigmoidf_(v1); }
        bimg[row * 64 + c0] = f2bf(o0); bimg[row * 64 + c0 + 32] = f2bf(o1);
      }
    }
}
DI void gemm_in_quadrant(const Params& p, int layer, int panel, int pn, int ai, int bj, const f32x4 (&a)[4][2], char* shm,
                         int b, int c0, int hq, int tid2, int wr, int wc, int fq) {
      const int tq = (panel & 7) * 256 + ai * 128;
      const int hd0 = pn * 4 + bj * 2;
      {
        const int hd = hd0 + (wc >> 1);
        int kind; bf16_t* dst; float* fdst; float scale;
        classify_head(p, hd, b, kind, dst, fdst, scale);
        char* img = shm + (wc >> 1) * 32768;
        if (kind != K_NONE) {
          const float bias0 = p.BIASP()[layer * NP + hd * 64 + c0], bias1 = p.BIASP()[layer * NP + hd * 64 + 32 + c0];
          float lb0 = 0.f, lb1 = 0.f;
          if (kind == K_LOGF) { lb0 = p.LB()[layer * 256 + (hd - 36) * 64 + c0]; lb1 = p.LB()[layer * 256 + (hd - 36) * 64 + 32 + c0]; }
          switch (kind) {
            case K_ROPE: epi_write_image<K_ROPE>(p, a, img, scale, bias0, bias1, lb0, lb1, b, tq, wr, c0, fq); break;
            case K_PLAIN: epi_write_image<K_PLAIN>(p, a, img, scale, bias0, bias1, lb0, lb1, b, tq, wr, c0, fq); break;
            case K_TR: epi_write_image<K_TR>(p, a, img, scale, bias0, bias1, lb0, lb1, b, tq, wr, c0, fq); break;
            case K_GSILU: epi_write_image<K_GSILU>(p, a, img, scale, bias0, bias1, lb0, lb1, b, tq, wr, c0, fq); break;
            case K_GSIG: epi_write_image<K_GSIG>(p, a, img, scale, bias0, bias1, lb0, lb1, b, tq, wr, c0, fq); break;
            case K_SILUH: epi_write_image<K_SILUH>(p, a, img, scale, bias0, bias1, lb0, lb1, b, tq, wr, c0, fq); break;
            case K_LOGF: epi_write_image<K_LOGF>(p, a, img, scale, bias0, bias1, lb0, lb1, b, tq, wr, c0, fq); break;
            case K_SMALL: {
#pragma unroll
              for (int m = 0; m < 4; ++m)
#pragma unroll
                for (int j = 0; j < 4; ++j) {
                  const size_t tok = (size_t)b * T + tq + wr * 64 + m * 16 + fq * 4 + j;
                  const float v0 = a[m][0][j] + bias0;
                  if (c0 < 8) p.IFG()[tok * 8 + c0] = v0;
                  else if (c0 < 20) p.DG()[tok * 12 + (c0 - 8)] = sigmoidf_(v0);
                }
            } break;
            default: break;
          }
        }
      }
      __syncthreads();
      {
        int kind; bf16_t* dst; float* fdst; float scale;
        classify_head(p, hd0 + hq, b, kind, dst, fdst, scale);
        const char* img = shm + hq * 32768;
        if (kind == K_LOGF) {
#pragma unroll
          for (int i = 0; i < 8; ++i) { const int q = tid2 + 256 * i; *(u32x4*)(fdst + (size_t)tq * 64 + q * 4) = *(const u32x4*)(img + q * 16); }
        } else if (kind == K_TR) {
#pragma unroll
          for (int i = 0; i < 4; ++i) { const int q = tid2 + 256 * i, c = q >> 4, rc = q & 15; *(u32x4*)(dst + (size_t)c * T + tq + rc * 8) = *(const u32x4*)(img + q * 16); }
        } else if (kind == K_GSILU || kind == K_GSIG) {
#pragma unroll
          for (int i = 0; i < 4; ++i) { const int q = tid2 + 256 * i, row = q >> 3, c16 = q & 7; *(u32x4*)(dst + ((size_t)b * T + tq + row) * 256 + c16 * 8) = *(const u32x4*)(img + q * 16); }
        } else if (kind == K_ROPE || kind == K_PLAIN || kind == K_SILUH) {
#pragma unroll
          for (int i = 0; i < 4; ++i) { const int q = tid2 + 256 * i; *(u32x4*)(dst + (size_t)tq * 64 + q * 8) = *(const u32x4*)(img + q * 16); }
        }
      }
      __syncthreads();
}
DI void gemm_in_epilogue(const Params& p, int layer, int panel, int pn, const f32x4 (&acc)[2][2][4][2], char* shm) {
  int tidf = threadIdx.x; asm volatile("" : "+v"(tidf));
  const int wid = tidf >> 6, lane = tidf & 63, wr = wid >> 2, wc = wid & 3, fr = lane & 15, fq = lane >> 4;
  const int b = panel >> 3;
  const int c0 = 16 * (wc & 1) + fr;
  const int hq = __builtin_amdgcn_readfirstlane(tidf >> 8), tid2 = tidf & 255;
  __syncthreads();
  gemm_in_quadrant(p, layer, panel, pn, 0, 0, acc[0][0], shm, b, c0, hq, tid2, wr, wc, fq);
  gemm_in_quadrant(p, layer, panel, pn, 0, 1, acc[0][1], shm, b, c0, hq, tid2, wr, wc, fq);
  gemm_in_quadrant(p, layer, panel, pn, 1, 0, acc[1][0], shm, b, c0, hq, tid2, wr, wc, fq);
  gemm_in_quadrant(p, layer, panel, pn, 1, 1, acc[1][1], shm, b, c0, hq, tid2, wr, wc, fq);
}
DI void gemm_out_quadrant(const Params& p, int panel, int pn, int ai, int bj, const f32x4 (&a)[4][2], float* fimg, int tidf, int wr, int wc, int fr, int fq) {
#pragma unroll
  for (int m = 0; m < 4; ++m)
#pragma unroll
    for (int n = 0; n < 2; ++n)
#pragma unroll
      for (int j = 0; j < 4; ++j) fimg[(wr * 64 + m * 16 + fq * 4 + j) * 128 + wc * 32 + n * 16 + fr] = a[m][n][j];
  __syncthreads();
#pragma unroll
  for (int i = 0; i < 8; ++i) {
    const int q = tidf + 512 * i, row = q >> 5, c4 = q & 31;
    float* g = p.hf + (size_t)(panel * 256 + ai * 128 + row) * 1024 + pn * 256 + bj * 128 + c4 * 4;
    const f32x4 h = *(const f32x4*)g;
    const f32x4 av = *(const f32x4*)(fimg + row * 128 + c4 * 4);
    *(f32x4*)g = DN_ALPHA * h + av;
  }
  __syncthreads();
}
DI void gemm_out_epilogue(const Params& p, int panel, int pn, const f32x4 (&acc)[2][2][4][2], char* shm) {
  int tidf = threadIdx.x; asm volatile("" : "+v"(tidf));
  const int wid = tidf >> 6, lane = tidf & 63, wr = wid >> 2, wc = wid & 3, fr = lane & 15, fq = lane >> 4;
  float* fimg = (float*)shm;
  __syncthreads();
  gemm_out_quadrant(p, panel, pn, 0, 0, acc[0][0], fimg, tidf, wr, wc, fr, fq);
  gemm_out_quadrant(p, panel, pn, 0, 1, acc[0][1], fimg, tidf, wr, wc, fr, fq);
  gemm_out_quadrant(p, panel, pn, 1, 0, acc[1][0], fimg, tidf, wr, wc, fr, fq);
  gemm_out_quadrant(p, panel, pn, 1, 1, acc[1][1], fimg, tidf, wr, wc, fr, fq);
}
DI void ph_gemm_in(const Params& p, int layer, int bid, int nblk, char* shm) {
  asm volatile("" : "+s"(bid));
  for (int panel = bid; panel < 256; panel += nblk) {
    const bf16_t* A = p.HB() + (size_t)panel * 256 * 1024;
    for (int pn = 0; pn < 16; ++pn) {
      f32x4 acc[2][2][4][2];
      gemm256_mainloop(A, p.WT() + ((size_t)layer * NP + pn * 256) * 1024, (bf16_t*)shm, acc);
      gemm_in_epilogue(p, layer, panel, pn, acc, shm);
    }
  }
}
DI void ph_gemm_out_ln(const Params& p, int layer, int bid, int nblk, char* shm) {
  asm volatile("" : "+s"(bid));
  for (int panel = bid; panel < 256; panel += nblk) {
    const bf16_t* A = p.YMIX() + (size_t)panel * 256 * 1024;
    for (int pn = 0; pn < 4; ++pn) {
      f32x4 acc[2][2][4][2];
      gemm256_mainloop(A, p.WOT() + ((size_t)layer * 1024 + pn * 256) * 1024, (bf16_t*)shm, acc);
      gemm_out_epilogue(p, panel, pn, acc, shm);
    }
    asm volatile("s_waitcnt vmcnt(0)" ::: "memory");
    __syncthreads();
    int tidf = threadIdx.x; asm volatile("" : "+v"(tidf));
    const int lane = tidf & 63, wid = tidf >> 6;
    const float* g = p.ln_g + layer * 1024; const float* bb = p.ln_b + layer * 1024;
    for (int rr = 0; rr < 32; ++rr) {
      const int row = panel * 256 + wid * 32 + rr;
      float* s = p.hf + (size_t)row * 1024;
      f32x4 v[4];
      float sum = 0.f;
#pragma unroll
      for (int i = 0; i < 4; ++i) { v[i] = *(const f32x4*)(s + i * 256 + lane * 4); sum += (v[i][0] + v[i][1]) + (v[i][2] + v[i][3]); }
      sum = wave_sum(sum);
      const float mu = sum * (1.f / 1024.f);
      float q = 0.f;
#pragma unroll
      for (int i = 0; i < 4; ++i) { const f32x4 d = v[i] - mu; q += (d[0] * d[0] + d[1] * d[1]) + (d[2] * d[2] + d[3] * d[3]); }
      q = wave_sum(q);
      const float rs = rsqrtf(q * (1.f / 1024.f) + 1e-5f);
#pragma unroll
      for (int i = 0; i < 4; ++i) {
        const int cc = i * 256 + lane * 4;
        const f32x4 gg = *(const f32x4*)(g + cc), b4 = *(const f32x4*)(bb + cc);
        const f32x4 o = (v[i] - mu) * rs * gg + b4;
        *(f32x4*)(s + cc) = o;
        u32x2 pk = {pack2(o[0], o[1]), pack2(o[2], o[3])};
        *(u32x2*)(p.HB() + (size_t)row * 1024 + cc) = pk;
      }
    }
  }
}

DI f32x16 qk_tile(const bf16_t* Krow, const bf16x8 (&qf)[4], int l31, int h2) {
  f32x16 s = zero16();
  const bf16_t* kp = Krow + l31 * 64 + h2 * 8;
#pragma unroll
  for (int ks = 0; ks < 4; ++ks) { const bf16x8 a = *(const bf16x8*)(kp + ks * 16); s = MFMA32(a, qf[ks], s); }
  return s;
}
DI void softmax_pv(f32x16& s, const bf16_t* VTp, int vstride, f32x16 (&o)[2], float& m, float& l, int l31, int h2) {
  bf16x8 va[2][2];
#pragma unroll
  for (int dt = 0; dt < 2; ++dt)
#pragma unroll
    for (int sk = 0; sk < 2; ++sk) va[dt][sk] = ld_frag8x2(VTp + (size_t)(dt * 32 + l31) * vstride + sk * 16 + 4 * h2);
  float mx = s[0];
#pragma unroll
  for (int r = 1; r < 16; ++r) mx = fmaxf(mx, s[r]);
  mx = fmaxf(mx, shx(mx, 32));
  const float mn = fmaxf(m, mx);
  const float alpha = __expf(m - mn);
  float ps = 0.f;
#pragma unroll
  for (int r = 0; r < 16; ++r) { s[r] = __expf(s[r] - mn); ps += s[r]; }
  ps += shx(ps, 32);
  l = l * alpha + ps; m = mn;
#pragma unroll
  for (int dt = 0; dt < 2; ++dt)
#pragma unroll
    for (int r = 0; r < 16; ++r) o[dt][r] *= alpha;
  const bf16x8 p0 = pack8<0>(s), p1 = pack8<8>(s);
#pragma unroll
  for (int dt = 0; dt < 2; ++dt) { o[dt] = MFMA32(va[dt][0], p0, o[dt]); o[dt] = MFMA32(va[dt][1], p1, o[dt]); }
}

DI void ph_attnD(const Params& p, int layer, int* ctr, char* smem, int* s_pair) {
  float* imps = (float*)smem;
  float* impf = (float*)(smem + 16384);
  unsigned* smask = (unsigned*)(smem + 20480);
  unsigned* s_union = (unsigned*)(smem + 20480 + 128);
  const int tid = tid_opaque(), lane = tid & 63, h = tid >> 6, l31 = lane & 31, h2 = lane >> 5;
  for (;;) {
    __syncthreads();
    { int t0_ = threadIdx.x; asm volatile("" : "+v"(t0_)); if (t0_ == 0) *s_pair = atomicAdd(ctr, 2); }
    if (tid == 0) *s_union = 0u;
    __syncthreads();
    const int it = *s_pair + half_id();
    if (it >= 2048) break;
    const int b = it & 31, q0 = (63 - (it >> 5)) * 32;
    const int t = q0 + l31, cur = q0 >> 6;
    const size_t tok = (size_t)b * T + t;
    bf16x8 qf[4];
    {
      const bf16_t* qp = p.QD() + ((size_t)(b * 4 + h) * T + t) * 64 + h2 * 8;
#pragma unroll
      for (int ks = 0; ks < 4; ++ks) qf[ks] = *(const bf16x8*)(qp + ks * 16);
    }
    const float g0 = p.DG()[tok * 12 + h * 3 + 0], g1 = p.DG()[tok * 12 + h * 3 + 1], g2 = p.DG()[tok * 12 + h * 3 + 2];
    f32x16 ofin[2];
    {
      const bf16_t* Kc = p.KCMP() + (size_t)b * 128 * 64;
      const bf16_t* Vc = p.VCMPT() + (size_t)b * 64 * 128;
      const int nkt = min(4, (q0 >> 9) + 1);
      f32x16 o[2]; o[0] = zero16(); o[1] = zero16();
      float m = -1e30f, l = 0.f;
      for (int kt = 0; kt < nkt; ++kt) {
        f32x16 s = qk_tile(Kc + kt * 32 * 64, qf, l31, h2);
#pragma unroll
        for (int r = 0; r < 16; ++r) { const int n = kt * 32 + crow(r, h2); if (16 * n + 31 > t) s[r] = -INFINITY; }
        softmax_pv(s, Vc + kt * 32, 128, o, m, l, l31, h2);
      }
      const float il = l > 0.f ? 1.f / l : 0.f;
      const float gi = g0 * il;
#pragma unroll
      for (int dt = 0; dt < 2; ++dt)
#pragma unroll
        for (int r = 0; r < 16; ++r) ofin[dt][r] = gi * o[dt][r];
      float carry = 0.f;
#pragma unroll
      for (int kt = 0; kt < 4; ++kt) {
        f32x16 s;
        if (kt < nkt) {
          s = qk_tile(Kc + kt * 32 * 64, qf, l31, h2);
#pragma unroll
          for (int r = 0; r < 16; ++r) { const int n = kt * 32 + crow(r, h2); s[r] = (16 * n + 31 > t) ? 0.f : __expf(s[r] - m) * il; }
        } else s = zero16();
        float X[4];
#pragma unroll
        for (int g = 0; g < 4; ++g) X[g] = shx(s[4 * g + 3], 32);
#pragma unroll
        for (int g = 0; g < 4; ++g) {
          const float G = (s[4 * g] + s[4 * g + 1]) + (s[4 * g + 2] + s[4 * g + 3]);
          const float prev_other = g > 0 ? X[g - 1] : carry;
          imps[(h * 32 + l31) * 32 + 8 * kt + 2 * g + h2] = G + (h2 ? X[g] : prev_other);
        }
        carry = X[3];
      }
    }
    __syncthreads();
    {
      const int tt = tid >> 3, jg = tid & 7;
#pragma unroll
      for (int i = 0; i < 4; ++i) {
        const int j = jg * 4 + i;
        impf[tt * 32 + j] = (imps[(0 * 32 + tt) * 32 + j] + imps[(1 * 32 + tt) * 32 + j]) + (imps[(2 * 32 + tt) * 32 + j] + imps[(3 * 32 + tt) * 32 + j]);
      }
    }
    __syncthreads();
    {
      const int tt = tid >> 3, jg = tid & 7;
      float v[32];
#pragma unroll
      for (int j = 0; j < 32; ++j) {
        float x = impf[tt * 32 + j];
        if (j > cur) x = -1e30f; else if (j == 0 || j == cur || j == cur - 1) x = 1e6f;
        v[j] = x;
      }
      unsigned bits = 0u;
#pragma unroll
      for (int i = 0; i < 4; ++i) {
        int rank = 0; float vj = 0.f;
#pragma unroll
        for (int j = 0; j < 32; ++j) if (j == jg * 4 + i) vj = v[j];
        const int jj = jg * 4 + i;
#pragma unroll
        for (int j = 0; j < 32; ++j) rank += (v[j] > vj || (v[j] == vj && j < jj)) ? 1 : 0;
        if (rank < 8 && jj <= cur) bits |= 1u << jj;
      }
      bits |= shx(bits, 1); bits |= shx(bits, 2); bits |= shx(bits, 4);
      if (jg == 0) { smask[tt] = bits; atomicOr(s_union, bits); }
    }
    __syncthreads();
    {
      const unsigned mymask = smask[l31], uni = *s_union;
      const bf16_t* Ks = p.KV() + (size_t)(2 * NB + b) * T * 64;
      const bf16_t* Vs = p.KV() + (size_t)(3 * NB + b) * 64 * T;
      f32x16 o[2]; o[0] = zero16(); o[1] = zero16();
      float m = -1e30f, l = 0.f;
      for (int j = 0; j <= cur; ++j) {
        if (!((uni >> j) & 1u)) continue;
        const bool sel = (mymask >> j) & 1u;
        for (int half = 0; half < 2; ++half) {
          const int key0 = j * 64 + half * 32;
          if (key0 > q0 + 31) break;
          f32x16 s = qk_tile(Ks + (size_t)key0 * 64, qf, l31, h2);
#pragma unroll
          for (int r = 0; r < 16; ++r) { const int key = key0 + crow(r, h2); if (!sel || key > t) s[r] = -INFINITY; }
          softmax_pv(s, Vs + key0, T, o, m, l, l31, h2);
        }
      }
      const float il = l > 0.f ? g1 / l : 0.f;
#pragma unroll
      for (int dt = 0; dt < 2; ++dt)
#pragma unroll
        for (int r = 0; r < 16; ++r) ofin[dt][r] += il * o[dt][r];
    }
    {
      const bf16_t* Kw = p.KV() + (size_t)(4 * NB + b) * T * 64;
      const bf16_t* Vw = p.KV() + (size_t)(5 * NB + b) * 64 * T;
      f32x16 o[2]; o[0] = zero16(); o[1] = zero16();
      float m = -1e30f, l = 0.f;
      for (int key0 = max(0, q0 - 512); key0 <= q0; key0 += 32) {
        f32x16 s = qk_tile(Kw + (size_t)key0 * 64, qf, l31, h2);
        if (key0 == q0 - 512 || key0 == q0) {
#pragma unroll
          for (int r = 0; r < 16; ++r) { const int key = key0 + crow(r, h2); if (key > t || t - key >= 512) s[r] = -INFINITY; }
        }
        softmax_pv(s, Vw + key0, T, o, m, l, l31, h2);
      }
      const float il = l > 0.f ? g2 / l : 0.f;
#pragma unroll
      for (int dt = 0; dt < 2; ++dt)
#pragma unroll
        for (int r = 0; r < 16; ++r) ofin[dt][r] += il * o[dt][r];
    }
#pragma unroll
    for (int dt = 0; dt < 2; ++dt)
#pragma unroll
      for (int g = 0; g < 4; ++g) {
        const int d0 = dt * 32 + 8 * g + 4 * h2;
        const u32x2 gz = *(const u32x2*)(p.GZ() + (size_t)4 * NTOK * 256 + tok * 256 + h * 64 + d0);
        const float z0 = __uint_as_float(gz.x << 16), z1 = __uint_as_float(gz.x & 0xffff0000u), z2 = __uint_as_float(gz.y << 16), z3 = __uint_as_float(gz.y & 0xffff0000u);
        u32x2 o2 = {pack2(ofin[dt][4 * g] * z0, ofin[dt][4 * g + 1] * z1), pack2(ofin[dt][4 * g + 2] * z2, ofin[dt][4 * g + 3] * z3)};
        *(u32x2*)(p.YMIX() + tok * 1024 + 768 + h * 64 + d0) = o2;
      }
  }
}


DI float logsigmoidf_(float x) { return fminf(x, 0.f) - __logf(1.f + __expf(-fabsf(x))); }
DI void mlstm_gates(const Params& p, size_t tok0, int hh, float* bc, float* ig, int tid) {
  if (tid < 64) {
    const int s0 = 2 * tid;
    const float lf0 = logsigmoidf_(p.IFG()[(tok0 + s0) * 8 + 4 + hh]), lf1 = logsigmoidf_(p.IFG()[(tok0 + s0 + 1) * 8 + 4 + hh]);
    const float pair = lf0 + lf1;
    float x = pair;
#pragma unroll
    for (int off = 1; off < 64; off <<= 1) { const float y = shup(x, off); if (tid >= off) x += y; }
    const float excl = x - pair;
    bc[s0] = excl + lf0; bc[s0 + 1] = excl + pair;
    ig[s0] = p.IFG()[(tok0 + s0) * 8 + hh]; ig[s0 + 1] = p.IFG()[(tok0 + s0 + 1) * 8 + hh];
  }
}
DI void conv8(const bf16_t* raw, int t, int dg, const float (&cw)[4][8], const float (&cb)[8], float (&out)[8]) {
#pragma unroll
  for (int e = 0; e < 8; ++e) out[e] = cb[e];
#pragma unroll
  for (int j = 0; j < 4; ++j) {
    const int ts = t - 3 + j;
    if (ts >= 0) {
      const u32x4 row = *(const u32x4*)(raw + (size_t)ts * 64 + dg * 8);
#pragma unroll
      for (int e2 = 0; e2 < 4; ++e2) { out[2 * e2] += cw[j][2 * e2] * __uint_as_float(row[e2] << 16); out[2 * e2 + 1] += cw[j][2 * e2 + 1] * __uint_as_float(row[e2] & 0xffff0000u); }
    }
  }
#pragma unroll
  for (int e = 0; e < 8; ++e) out[e] = siluf_(out[e]);
}
DI void load_conv_w(const Params& p, int layer, int ch0, int dg, float (&cw)[4][8], float (&cb)[8]) {
#pragma unroll
  for (int j = 0; j < 4; ++j)
#pragma unroll
    for (int e = 0; e < 8; ++e) cw[j][e] = p.conv_w[layer * 2048 + j * 512 + ch0 + dg * 8 + e];
#pragma unroll
  for (int e = 0; e < 8; ++e) cb[e] = p.conv_b[layer * 512 + ch0 + dg * 8 + e];
}
DI void delta_state(const bf16_t* VT, const bf16_t* KT, float* out, int wid, int l31, int h2) {
  const int mt = wid >> 1, nt = wid & 1;
  f32x16 acc = zero16();
#pragma unroll
  for (int ks = 0; ks < 8; ++ks) {
    const bf16x8 a = *(const bf16x8*)(VT + (size_t)(mt * 32 + l31) * T + ks * 16 + h2 * 8);
    const bf16x8 bb = *(const bf16x8*)(KT + (nt * 32 + l31) * 136 + ks * 16 + h2 * 8);
    acc = MFMA32(a, bb, acc);
  }
#pragma unroll
  for (int r = 0; r < 16; ++r) out[(mt * 32 + crow(r, h2)) * 64 + nt * 32 + l31] = acc[r];
}
DI void ph_mlstm_local(const Params& p, int layer, int item, char* smem) {
  float* bc = (float*)smem; float* ig = bc + 128; float* wv = ig + 128;
  bf16_t* KwT = (bf16_t*)(smem + 2048);
  float* nred = (float*)(smem + 2048 + 64 * 136 * 2);
  const int tid = tid_opaque(), lane = tid & 63, wid = tid >> 6, l31 = lane & 31, h2 = lane >> 5;
  const int b = item >> 6, hh = (item >> 4) & 3, c = item & 15, t0 = c * 128;
  const size_t tok0 = (size_t)b * T + t0;
  __syncthreads();
  mlstm_gates(p, tok0, hh, bc, ig, tid);
  __syncthreads();
  if (tid < 128) wv[tid] = __expf(bc[127] - bc[tid] + ig[tid]);
  __syncthreads();
  {
    const int dg = tid & 7;
    float cw[4][8], cb[8];
    load_conv_w(p, layer, 256 + hh * 64, dg, cw, cb);
    const bf16_t* raw = p.QKB() + ((size_t)(b * 8 + 4 + hh) * T) * 64;
#pragma unroll
    for (int i = 0; i < 4; ++i) {
      const int s = (tid >> 3) + 32 * i;
      float v[8];
      conv8(raw, t0 + s, dg, cw, cb, v);
      const float w = wv[s];
#pragma unroll
      for (int e = 0; e < 8; ++e) KwT[(dg * 8 + e) * 136 + s] = f2bf(v[e] * w);
    }
  }
  __syncthreads();
  delta_state(p.VBT() + (size_t)(b * 4 + hh) * 64 * T + t0, KwT, p.BST() + (size_t)item * 4096, wid, l31, h2);
  {
    const int k = tid & 63, qd = tid >> 6;
    float a = 0.f;
#pragma unroll 8
    for (int s = 0; s < 32; ++s) a += bf2f(KwT[k * 136 + qd * 32 + s]);
    nred[qd * 64 + k] = a;
  }
  __syncthreads();
  if (tid < 64) p.BN()[(size_t)item * 64 + tid] = (nred[tid] + nred[64 + tid]) + (nred[128 + tid] + nred[192 + tid]);
  if (tid == 0) p.BG()[item] = bc[127];
}
DI void ph_mlstm_scan(const Params& p, int bh) {
  const int tid = tid_opaque();
  f32x4 C[4];
#pragma unroll
  for (int i = 0; i < 4; ++i) C[i] = (f32x4){0.f, 0.f, 0.f, 0.f};
  float n = 0.f;
  for (int c = 0; c < 16; ++c) {
    const int item = bh * 16 + c;
    const float g = __expf(p.BG()[item]);
    f32x4* ptr = (f32x4*)(p.BST() + (size_t)item * 4096 + tid * 16);
#pragma unroll
    for (int i = 0; i < 4; ++i) { const f32x4 tmp = ptr[i]; ptr[i] = C[i]; C[i] = g * C[i] + tmp; }
    if (tid < 64) { const float tmp = p.BN()[(size_t)item * 64 + tid]; p.BN()[(size_t)item * 64 + tid] = n; n = g * n + tmp; }
  }
}
DI f32x16 qk_tile_s(const bf16_t* Krow, int stride, const bf16x8 (&qf)[4], int l31, int h2) {
  f32x16 s = zero16();
  const bf16_t* kp = Krow + l31 * stride + h2 * 8;
#pragma unroll
  for (int ks = 0; ks < 4; ++ks) { const bf16x8 a = *(const bf16x8*)(kp + ks * 16); s = MFMA32(a, qf[ks], s); }
  return s;
}
DI void pv_only(const f32x16& s, const bf16_t* VTp, int vstride, f32x16 (&o)[2], int l31, int h2) {
  const bf16x8 p0 = pack8<0>(s), p1 = pack8<8>(s);
#pragma unroll
  for (int dt = 0; dt < 2; ++dt) {
    const bf16_t* vp = VTp + (size_t)(dt * 32 + l31) * vstride + 4 * h2;
    o[dt] = MFMA32(ld_frag8x2(vp), p0, o[dt]);
    o[dt] = MFMA32(ld_frag8x2(vp + 16), p1, o[dt]);
  }
}
DI bf16x8 frag_from_f32(const float* ptr) {
  const f32x4 a = *(const f32x4*)ptr, b = *(const f32x4*)(ptr + 4);
  u32x4 t = {pack2(a[0], a[1]), pack2(a[2], a[3]), pack2(b[0], b[1]), pack2(b[2], b[3])};
  return __builtin_bit_cast(bf16x8, t);
}
DI void ph_mlstm_out(const Params& p, int layer, int item, char* smem) {
  float* bc = (float*)smem; float* ig = bc + 128;
  bf16_t* qc = (bf16_t*)(smem + 2048);
  bf16_t* kc = qc + 128 * 72;
  const int tid = tid_opaque(), lane = tid & 63, wid = tid >> 6, l31 = lane & 31, h2 = lane >> 5;
  const int b = item >> 6, hh = (item >> 4) & 3, c = item & 15, t0 = c * 128;
  const size_t tok0 = (size_t)b * T + t0;
  __syncthreads();
  mlstm_gates(p, tok0, hh, bc, ig, tid);
  {
    const int dg = tid & 7;
#pragma unroll
    for (int which = 0; which < 2; ++which) {
      float cw[4][8], cb[8];
      load_conv_w(p, layer, which * 256 + hh * 64, dg, cw, cb);
      const bf16_t* raw = p.QKB() + ((size_t)(b * 8 + which * 4 + hh) * T) * 64;
      bf16_t* dst = which ? kc : qc;
      const float sc = which ? 1.f : 0.125f;
#pragma unroll
      for (int i = 0; i < 4; ++i) {
        const int s = (tid >> 3) + 32 * i;
        float v[8];
        conv8(raw, t0 + s, dg, cw, cb, v);
        u32x4 w = {pack2(v[0] * sc, v[1] * sc), pack2(v[2] * sc, v[3] * sc), pack2(v[4] * sc, v[5] * sc), pack2(v[6] * sc, v[7] * sc)};
        *(u32x4*)(dst + s * 72 + dg * 8) = w;
      }
    }
  }
  __syncthreads();
  if (tid < 128) ig[tid] = ig[tid] - bc[tid];
  __syncthreads();
  const int tq = 32 * wid + l31;
  bf16x8 qf[4];
#pragma unroll
  for (int ks = 0; ks < 4; ++ks) qf[ks] = *(const bf16x8*)(qc + tq * 72 + ks * 16 + h2 * 8);
  const float bt = bc[tq];
  f32x16 o[2]; o[0] = zero16(); o[1] = zero16();
  float dsum = 0.f;
  const bf16_t* VT = p.VBT() + (size_t)(b * 4 + hh) * 64 * T + t0;
  for (int kt = 0; kt <= wid; ++kt) {
    f32x16 s = qk_tile_s(kc + kt * 32 * 72, 72, qf, l31, h2);
#pragma unroll
    for (int r = 0; r < 16; ++r) {
      const int sidx = 32 * kt + crow(r, h2);
      float val = s[r] * __expf(bt + ig[sidx]);
      if (sidx > tq) val = 0.f;
      s[r] = val; dsum += val;
    }
    pv_only(s, VT + kt * 32, T, o, l31, h2);
  }
  dsum += shx(dsum, 32);
  const float* Cs = p.BST() + (size_t)item * 4096;
  const float* ns = p.BN() + (size_t)item * 64;
  f32x16 oi[2]; oi[0] = zero16(); oi[1] = zero16();
  float qn = 0.f;
#pragma unroll
  for (int ks = 0; ks < 4; ++ks) {
#pragma unroll
    for (int dt = 0; dt < 2; ++dt) oi[dt] = MFMA32(frag_from_f32(Cs + (dt * 32 + l31) * 64 + ks * 16 + h2 * 8), qf[ks], oi[dt]);
    const u32x4 qu = __builtin_bit_cast(u32x4, qf[ks]);
    const f32x4 n0 = *(const f32x4*)(ns + ks * 16 + h2 * 8), n1 = *(const f32x4*)(ns + ks * 16 + h2 * 8 + 4);
    qn += __uint_as_float(qu[0] << 16) * n0[0] + __uint_as_float(qu[0] & 0xffff0000u) * n0[1] + __uint_as_float(qu[1] << 16) * n0[2] + __uint_as_float(qu[1] & 0xffff0000u) * n0[3];
    qn += __uint_as_float(qu[2] << 16) * n1[0] + __uint_as_float(qu[2] & 0xffff0000u) * n1[1] + __uint_as_float(qu[3] << 16) * n1[2] + __uint_as_float(qu[3] & 0xffff0000u) * n1[3];
  }
  qn += shx(qn, 32);
  const float ebt = __expf(bt);
  const float den = dsum + ebt * qn;
  const float inv = 1.f / fmaxf(fabsf(den), 1.f);
  const size_t tok = tok0 + tq;
#pragma unroll
  for (int dt = 0; dt < 2; ++dt)
#pragma unroll
    for (int g = 0; g < 4; ++g) {
      const int d0 = dt * 32 + 8 * g + 4 * h2;
      const u32x2 g1 = *(const u32x2*)(p.GZ() + (size_t)1 * NTOK * 256 + tok * 256 + hh * 64 + d0);
      const u32x2 g2 = *(const u32x2*)(p.GZ() + (size_t)2 * NTOK * 256 + tok * 256 + hh * 64 + d0);
      float z[4] = {__uint_as_float(g1.x << 16) * __uint_as_float(g2.x << 16), __uint_as_float(g1.x & 0xffff0000u) * __uint_as_float(g2.x & 0xffff0000u),
                    __uint_as_float(g1.y << 16) * __uint_as_float(g2.y << 16), __uint_as_float(g1.y & 0xffff0000u) * __uint_as_float(g2.y & 0xffff0000u)};
      float hv[4];
#pragma unroll
      for (int i = 0; i < 4; ++i) hv[i] = (o[dt][4 * g + i] + ebt * oi[dt][4 * g + i]) * inv * z[i];
      u32x2 o2 = {pack2(hv[0], hv[1]), pack2(hv[2], hv[3])};
      *(u32x2*)(p.YMIX() + tok * 1024 + 256 + hh * 64 + d0) = o2;
    }
}


DI void ph_hgrn_local(const Params& p, int layer, int item, char* smem) {
  float* tot = (float*)smem;
  bf16_t* KdT = (bf16_t*)(smem + 1024);
  const int tid = tid_opaque(), lane = tid & 63, wid = tid >> 6, l31 = lane & 31, h2 = lane >> 5;
  const int b = item >> 6, hh = (item >> 4) & 3, c = item & 15, t0 = c * 128;
  const int k = tid & 63, qd = tid >> 6;
  float al[32], kk[32];
  {
    const float* gp = p.GC() + ((size_t)(b * 4 + hh) * T + t0 + 32 * qd) * 64 + k;
    float run = 0.f;
#pragma unroll
    for (int s = 0; s < 32; ++s) { const float g = gp[s * 64]; run += g; al[s] = run; kk[s] = 1.f - __expf(g); }
    __syncthreads();
    tot[qd * 64 + k] = run;
  }
  __syncthreads();
  float off = 0.f, aL = 0.f;
#pragma unroll
  for (int q = 0; q < 4; ++q) { const float v = tot[q * 64 + k]; aL += v; if (q < qd) off += v; }
#pragma unroll
  for (int s8 = 0; s8 < 4; ++s8) {
    float v[8];
#pragma unroll
    for (int e = 0; e < 8; ++e) v[e] = kk[s8 * 8 + e] * __expf(aL - (al[s8 * 8 + e] + off));
    u32x4 w = {pack2(v[0], v[1]), pack2(v[2], v[3]), pack2(v[4], v[5]), pack2(v[6], v[7])};
    *(u32x4*)(KdT + k * 136 + qd * 32 + s8 * 8) = w;
  }
  __syncthreads();
  delta_state(p.VCT() + (size_t)(b * 4 + hh) * 64 * T + t0, KdT, p.CST() + (size_t)item * 4096, wid, l31, h2);
  if (qd == 0) p.CAL()[(size_t)item * 64 + k] = aL;
}
DI void ph_hgrn_scan(const Params& p, int bh) {
  const int tid = tid_opaque();
  f32x4 S[4];
#pragma unroll
  for (int i = 0; i < 4; ++i) S[i] = (f32x4){0.f, 0.f, 0.f, 0.f};
  for (int c = 0; c < 16; ++c) {
    const int item = bh * 16 + c;
    const f32x4* dp = (const f32x4*)(p.CAL() + (size_t)item * 64 + (tid & 3) * 16);
    f32x4* ptr = (f32x4*)(p.CST() + (size_t)item * 4096 + tid * 16);
#pragma unroll
    for (int i = 0; i < 4; ++i) {
      const f32x4 a = dp[i];
      const f32x4 dec = {__expf(a[0]), __expf(a[1]), __expf(a[2]), __expf(a[3])};
      const f32x4 tmp = ptr[i]; ptr[i] = S[i]; S[i] = dec * S[i] + tmp;
    }
  }
}
DI void ph_hgrn_out(const Params& p, int layer, int item, char* smem) {
  float* a_lds = (float*)smem;
  float* tot = (float*)(smem + 128 * 68 * 4);
  const int tid = tid_opaque(), lane = tid & 63, wid = tid >> 6, l31 = lane & 31, h2 = lane >> 5;
  const int b = item >> 6, hh = (item >> 4) & 3, c = item & 15, t0 = c * 128;
  const size_t hbase = (size_t)(b * 4 + hh) * T + t0;
  {
    const int k = tid & 63, qd = tid >> 6;
    float al[32];
    const float* gp = p.GC() + (hbase + 32 * qd) * 64 + k;
    float run = 0.f;
#pragma unroll
    for (int s = 0; s < 32; ++s) { run += gp[s * 64]; al[s] = run; }
    __syncthreads();
    tot[qd * 64 + k] = run;
    __syncthreads();
    float off = 0.f;
#pragma unroll
    for (int q = 0; q < 4; ++q) { const float v = tot[q * 64 + k]; if (q < qd) off += v; }
#pragma unroll
    for (int s = 0; s < 32; ++s) a_lds[(32 * qd + s) * 68 + k] = al[s] + off;
  }
  __syncthreads();
  const int tq = 32 * wid + l31;
  bf16x8 qi[4], qh[4];
#pragma unroll
  for (int ks = 0; ks < 4; ++ks) {
    const int k0 = ks * 16 + h2 * 8;
    const u32x4 qu = *(const u32x4*)(p.QC() + (hbase + tq) * 64 + k0);
    float q8[8], e1[8], e2[8];
#pragma unroll
    for (int e2i = 0; e2i < 4; ++e2i) { q8[2 * e2i] = __uint_as_float(qu[e2i] << 16); q8[2 * e2i + 1] = __uint_as_float(qu[e2i] & 0xffff0000u); }
#pragma unroll
    for (int e = 0; e < 8; ++e) {
      const float a = a_lds[tq * 68 + k0 + e];
      const float r = wid > 0 ? a_lds[(32 * wid - 1) * 68 + k0 + e] : 0.f;
      e1[e] = q8[e] * __expf(a - r); e2[e] = q8[e] * __expf(a);
    }
    u32x4 w1 = {pack2(e1[0], e1[1]), pack2(e1[2], e1[3]), pack2(e1[4], e1[5]), pack2(e1[6], e1[7])};
    u32x4 w2 = {pack2(e2[0], e2[1]), pack2(e2[2], e2[3]), pack2(e2[4], e2[5]), pack2(e2[6], e2[7])};
    qi[ks] = __builtin_bit_cast(bf16x8, w1); qh[ks] = __builtin_bit_cast(bf16x8, w2);
  }
  f32x16 o[2]; o[0] = zero16(); o[1] = zero16();
  const bf16_t* VT = p.VCT() + (size_t)(b * 4 + hh) * 64 * T + t0;
  for (int kt = 0; kt <= wid; ++kt) {
    f32x16 s = zero16();
    const int srow = 32 * kt + l31;
#pragma unroll
    for (int ks = 0; ks < 4; ++ks) {
      const int k0 = ks * 16 + h2 * 8;
      const f32x4 g0 = *(const f32x4*)(p.GC() + (hbase + srow) * 64 + k0), g1 = *(const f32x4*)(p.GC() + (hbase + srow) * 64 + k0 + 4);
      float v[8];
#pragma unroll
      for (int e = 0; e < 8; ++e) {
        const float g = e < 4 ? g0[e] : g1[e - 4];
        const float a = a_lds[srow * 68 + k0 + e];
        const float r = wid > 0 ? a_lds[(32 * wid - 1) * 68 + k0 + e] : 0.f;
        v[e] = (1.f - __expf(g)) * __expf(fminf(r - a, 80.f));
      }
      u32x4 w = {pack2(v[0], v[1]), pack2(v[2], v[3]), pack2(v[4], v[5]), pack2(v[6], v[7])};
      s = MFMA32(__builtin_bit_cast(bf16x8, w), qi[ks], s);
    }
    if (kt == wid) {
#pragma unroll
      for (int r = 0; r < 16; ++r) if (32 * kt + crow(r, h2) > tq) s[r] = 0.f;
    }
    pv_only(s, VT + kt * 32, T, o, l31, h2);
  }
  {
    const float* Ss = p.CST() + (size_t)item * 4096;
#pragma unroll
    for (int ks = 0; ks < 4; ++ks)
#pragma unroll
      for (int dt = 0; dt < 2; ++dt) o[dt] = MFMA32(frag_from_f32(Ss + (dt * 32 + l31) * 64 + ks * 16 + h2 * 8), qh[ks], o[dt]);
  }
  float ss = 0.f;
#pragma unroll
  for (int dt = 0; dt < 2; ++dt)
#pragma unroll
    for (int r = 0; r < 16; ++r) ss += o[dt][r] * o[dt][r];
  ss += shx(ss, 32);
  const float rs = rsqrtf(ss * (1.f / 64.f) + 1e-6f);
  const size_t tok = (size_t)b * T + t0 + tq;
#pragma unroll
  for (int dt = 0; dt < 2; ++dt)
#pragma unroll
    for (int g = 0; g < 4; ++g) {
      const int d0 = dt * 32 + 8 * g + 4 * h2;
      const u32x2 gz = *(const u32x2*)(p.GZ() + (size_t)3 * NTOK * 256 + tok * 256 + hh * 64 + d0);
      const f32x4 gn = *(const f32x4*)(p.c_norm_g + layer * 256 + hh * 64 + d0);
      const float z0 = __uint_as_float(gz.x << 16), z1 = __uint_as_float(gz.x & 0xffff0000u), z2 = __uint_as_float(gz.y << 16), z3 = __uint_as_float(gz.y & 0xffff0000u);
      u32x2 o2 = {pack2(o[dt][4 * g] * rs * gn[0] * z0, o[dt][4 * g + 1] * rs * gn[1] * z1), pack2(o[dt][4 * g + 2] * rs * gn[2] * z2, o[dt][4 * g + 3] * rs * gn[3] * z3)};
      *(u32x2*)(p.YMIX() + tok * 1024 + 512 + hh * 64 + d0) = o2;
    }
}


DI void ph_attnA(const Params& p, int layer, int item, char* smem) {
  const int tid = tid_opaque(), lane = tid & 63, h = tid >> 6, l31 = lane & 31, h2 = lane >> 5;
  const int b = item >> 6, q0 = (item & 63) * 32, g = h >> 1;
  const int t = q0 + l31;
  const size_t tok = (size_t)b * T + t;
  bf16x8 qf[4];
  {
    const bf16_t* qp = p.QA() + ((size_t)(b * 4 + h) * T + t) * 64 + h2 * 8;
#pragma unroll
    for (int ks = 0; ks < 4; ++ks) qf[ks] = *(const bf16x8*)(qp + ks * 16);
  }
  const bf16_t* Kp = p.KA() + (size_t)(b * 2 + g) * T * 64;
  const bf16_t* Vp = p.VAT() + (size_t)(b * 2 + g) * 64 * T;
  f32x16 o[2]; o[0] = zero16(); o[1] = zero16();
  float m = -1e30f, l = 0.f;
  for (int key0 = max(0, q0 - 128); key0 <= q0; key0 += 32) {
    f32x16 s = qk_tile(Kp + (size_t)key0 * 64, qf, l31, h2);
    if (key0 == q0 - 128 || key0 == q0) {
#pragma unroll
      for (int r = 0; r < 16; ++r) { const int key = key0 + crow(r, h2); if (key > t || t - key >= 128) s[r] = -INFINITY; }
    }
    softmax_pv(s, Vp + key0, T, o, m, l, l31, h2);
  }
  const float sink = p.a_sinks[layer * 4 + h];
  const float M = fmaxf(m, sink);
  const float sc = __expf(m - M);
  const float inv = sc / (l * sc + __expf(sink - M));
#pragma unroll
  for (int dt = 0; dt < 2; ++dt)
#pragma unroll
    for (int gq = 0; gq < 4; ++gq) {
      const int d0 = dt * 32 + 8 * gq + 4 * h2;
      const u32x2 gz = *(const u32x2*)(p.GZ() + tok * 256 + h * 64 + d0);
      const float z0 = __uint_as_float(gz.x << 16), z1 = __uint_as_float(gz.x & 0xffff0000u), z2 = __uint_as_float(gz.y << 16), z3 = __uint_as_float(gz.y & 0xffff0000u);
      u32x2 o2 = {pack2(o[dt][4 * gq] * inv * z0, o[dt][4 * gq + 1] * inv * z1), pack2(o[dt][4 * gq + 2] * inv * z2, o[dt][4 * gq + 3] * inv * z3)};
      *(u32x2*)(p.YMIX() + tok * 1024 + h * 64 + d0) = o2;
    }
}

DI void ph_cmp(const Params& p, int layer, int item, char* smem) {
  float* red = (float*)smem;
  bf16_t* hid = (bf16_t*)(smem + 32768);
  const int tid = tid_opaque(), lane = tid & 63, wid = tid >> 6, l31 = lane & 31, h2 = lane >> 5;
  const int b = item >> 3, kvsel = (item >> 2) & 1, mt = item & 3;
  const int lk = layer * 2 + kvsel;
  const int n = min(mt * 32 + l31, 126);
  const bf16_t* src = p.KV() + ((size_t)(kvsel * NB + b) * T + 16 * n) * 64 + wid * 512 + h2 * 8;
  const bf16_t* w1t = p.W1T() + (size_t)lk * 64 * 2048 + wid * 512 + h2 * 8;
  f32x16 acc[2]; acc[0] = zero16(); acc[1] = zero16();
#pragma unroll 4
  for (int ks = 0; ks < 32; ++ks) {
    const bf16x8 a = *(const bf16x8*)(src + ks * 16);
    const bf16x8 b0 = *(const bf16x8*)(w1t + (size_t)l31 * 2048 + ks * 16);
    const bf16x8 b1 = *(const bf16x8*)(w1t + (size_t)(32 + l31) * 2048 + ks * 16);
    acc[0] = MFMA32(a, b0, acc[0]); acc[1] = MFMA32(a, b1, acc[1]);
  }
  __syncthreads();
#pragma unroll
  for (int nt = 0; nt < 2; ++nt)
#pragma unroll
    for (int r = 0; r < 16; ++r) red[(wid * 32 + crow(r, h2)) * 64 + nt * 32 + l31] = acc[nt][r];
  __syncthreads();
  {
    const int row = tid >> 3, c0 = (tid & 7) * 8;
    float v[8];
#pragma unroll
    for (int e = 0; e < 8; ++e) {
      const float x = (red[(0 * 32 + row) * 64 + c0 + e] + red[(1 * 32 + row) * 64 + c0 + e]) + (red[(2 * 32 + row) * 64 + c0 + e] + red[(3 * 32 + row) * 64 + c0 + e]) + p.CVEC()[lk * 64 + c0 + e];
      v[e] = siluf_(x);
    }
    u32x4 w = {pack2(v[0], v[1]), pack2(v[2], v[3]), pack2(v[4], v[5]), pack2(v[6], v[7])};
    *(u32x4*)(hid + row * 72 + c0) = w;
  }
  __syncthreads();
  if (wid == 0) {
    f32x16 o[2]; o[0] = zero16(); o[1] = zero16();
    const bf16_t* w2t = p.W2T() + (size_t)lk * 4096;
#pragma unroll
    for (int ks = 0; ks < 4; ++ks) {
      const bf16x8 a = *(const bf16x8*)(hid + l31 * 72 + ks * 16 + h2 * 8);
#pragma unroll
      for (int nt = 0; nt < 2; ++nt) o[nt] = MFMA32(a, *(const bf16x8*)(w2t + (nt * 32 + l31) * 64 + ks * 16 + h2 * 8), o[nt]);
    }
    if (kvsel == 0) {
#pragma unroll
      for (int r = 0; r < 16; ++r) {
        const int nn = mt * 32 + crow(r, h2);
        if (nn < 127) {
          const int pos = 16 * nn + 31;
          const float cs = p.ROPEC()[pos * 32 + l31], sn = p.ROPES()[pos * 32 + l31];
          p.KCMP()[((size_t)b * 128 + nn) * 64 + l31] = f2bf(o[0][r] * cs - o[1][r] * sn);
          p.KCMP()[((size_t)b * 128 + nn) * 64 + 32 + l31] = f2bf(o[0][r] * sn + o[1][r] * cs);
        }
      }
    } else {
#pragma unroll
      for (int nt = 0; nt < 2; ++nt)
#pragma unroll
        for (int r = 0; r < 16; ++r) {
          const int nn = mt * 32 + crow(r, h2);
          if (nn < 127) p.VCMPT()[((size_t)b * 64 + nt * 32 + l31) * 128 + nn] = f2bf(o[nt][r]);
        }
    }
  }
}


#define XB_TMO      128
#define XB_XCNT(j)  (256  + 64 * (j))
#define XB_XSUB(j)  (1280 + 64 * (j))
#define XB_XGEN(j)  (2304 + 64 * (j))
#define XB_TOP      3328
#define XB_TOPGEN   3392
#define XCD_BAR_WORDS 3456
#define XB_SPIN_CAP (1u << 22)
DI unsigned xb_ld(unsigned* p)              { return __hip_atomic_load(p, __ATOMIC_RELAXED, __HIP_MEMORY_SCOPE_AGENT); }
DI unsigned xb_add(unsigned* p, unsigned v) { return __hip_atomic_fetch_add(p, v, __ATOMIC_RELAXED, __HIP_MEMORY_SCOPE_AGENT); }
DI unsigned xb_xcc_id() { return (unsigned)__builtin_amdgcn_s_getreg((3 << 11) | 20) & 0xFu; }
#define XB_SPIN(cond, bar) do { unsigned _sp = 0; while (cond) { __builtin_amdgcn_s_sleep(1); \
    if ((++_sp & 255u) == 0u) { if (xb_ld(&(bar)[XB_TMO])) break; if (_sp > XB_SPIN_CAP) { atomicAdd(&(bar)[XB_TMO], 1u); break; } } } } while (0)
struct XcdBarrier { unsigned* bar; unsigned x; volatile LAS unsigned* st; };
DI XcdBarrier xcd_barrier_post(unsigned* bar, volatile LAS unsigned* st) {
  XcdBarrier b; b.bar = bar; b.x = xb_xcc_id(); b.st = st;
  if (threadIdx.x == 0) (void)xb_add(&bar[XB_XCNT(b.x)], 1u);
  return b;
}
DI void xcd_barrier_complete(unsigned* bar, unsigned x, unsigned& nloc, unsigned& nx) {
  const unsigned G = gridDim.x * gridDim.y * gridDim.z;
  unsigned sum, cnt, mine, sp = 0u;
  for (;;) {
    sum = 0u; cnt = 0u; mine = 0u;
#pragma unroll
    for (unsigned j = 0; j < 16; ++j) { const unsigned c = xb_ld(&bar[XB_XCNT(j)]); sum += c; cnt += (c > 0u) ? 1u : 0u; mine = (j == x) ? c : mine; }
    if (sum == G) break;
    __builtin_amdgcn_s_sleep(1);
    if ((++sp & 255u) == 0u) { if (xb_ld(&bar[XB_TMO])) break; if (sp > XB_SPIN_CAP) { atomicAdd(&bar[XB_TMO], 1u); break; } }
  }
  nloc = mine > 0u ? mine : 1u; nx = cnt > 0u ? cnt : 1u;
}
DI void xcd_barrier(const XcdBarrier& b) {
  asm volatile("s_waitcnt vmcnt(0)" ::: "memory");
  __syncthreads();
  int t0_ = threadIdx.x; asm volatile("" : "+v"(t0_));
  if (t0_ == 0) {
    unsigned* bar = b.bar;
    __builtin_amdgcn_s_waitcnt(0);
    unsigned nloc = b.st[0], nx = b.st[1];
    if (nloc == 0u) { xcd_barrier_complete(bar, b.x, nloc, nx); b.st[0] = nloc; b.st[1] = nx; }
    const unsigned old = xb_add(&bar[XB_XSUB(b.x)], 1u);
    const unsigned gen = old / nloc;
    if (old + 1u == (gen + 1u) * nloc) {
      __builtin_amdgcn_fence(__ATOMIC_RELEASE, "agent");
      asm volatile("s_waitcnt vmcnt(0)" ::: "memory");
      const unsigned og = xb_add(&bar[XB_TOP], 1u);
      const unsigned tg = og / nx;
      if (og + 1u == (tg + 1u) * nx) xb_add(&bar[XB_TOPGEN], 1u);
      else XB_SPIN(xb_ld(&bar[XB_TOPGEN]) == tg, bar);
      __builtin_amdgcn_fence(__ATOMIC_ACQUIRE, "agent");
      xb_add(&bar[XB_XGEN(b.x)], 1u);
      asm volatile("s_waitcnt vmcnt(0)" ::: "memory");
    } else {
      XB_SPIN(xb_ld(&bar[XB_XGEN(b.x)]) == gen, bar);
      __builtin_amdgcn_fence(__ATOMIC_ACQUIRE, "agent");
      asm volatile("s_waitcnt vmcnt(0)" ::: "memory");
    }
  }
  __syncthreads();
}

constexpr int HALF_LDS = 40960;
__global__ void __launch_bounds__(512) mega(Params p) {
  __shared__ __attribute__((aligned(16))) char smem_all[131072 + 32];
  cg::grid_group grid = cg::this_grid();
  const int half = half_id();
  const int bid = blockIdx.x, nblk = gridDim.x;
  const int vbid = 2 * bid + half, nvblk = 2 * nblk;
  char* smem = smem_all + half * HALF_LDS;
  unsigned* xbw = (unsigned*)(smem_all + 131072);
  int* s_pair = (int*)(smem_all + 131072 + 16);
  if (threadIdx.x == 0) { xbw[0] = 0u; xbw[1] = 0u; }
  __syncthreads();
  const XcdBarrier xb = xcd_barrier_post(p.XBAR(), (volatile LAS unsigned*)xbw);
  ph_prologue(p, vbid, nvblk, smem);
  ln_rows(p, 0, 0, vbid, nvblk);
  grid.sync();
  for (int l = 0; l < 2; ++l) {
    ph_gemm_in(p, l, bid, nblk, smem_all);
    xcd_barrier(xb);
    for (int item = vbid; item < 2048; item += nvblk) ph_mlstm_local(p, l, item, smem);
    for (int item = vbid; item < 2048; item += nvblk) ph_hgrn_local(p, l, item, smem);
    __syncthreads();
    for (int item = vbid; item < 256; item += nvblk) ph_cmp(p, l, item, smem);
    for (int item = vbid; item < 2048; item += nvblk) ph_attnA(p, l, item, smem);
    xcd_barrier(xb);
    if (vbid < 128) ph_mlstm_scan(p, vbid);
    else if (vbid < 256) ph_hgrn_scan(p, vbid - 128);
    __syncthreads();
    ph_attnD(p, l, p.CTR() + l, smem, s_pair);
    xcd_barrier(xb);
    for (int item = vbid; item < 2048; item += nvblk) ph_mlstm_out(p, l, item, smem);
    for (int item = vbid; item < 2048; item += nvblk) ph_hgrn_out(p, l, item, smem);
    xcd_barrier(xb);
    ph_gemm_out_ln(p, l, bid, nblk, smem_all);
    if (l == 0) xcd_barrier(xb);
  }
}

static inline size_t align_up(size_t v) { return (v + 255) & ~(size_t)255; }

extern "C" void kernel_launch(void* const* d_in, const int* in_sizes, int n_in, void* d_out, int out_size, void* d_ws, size_t ws_size, hipStream_t stream) {
  Params p{};
  p.x = (const float*)d_in[0]; p.ln0_g = (const float*)d_in[1]; p.ln0_b = (const float*)d_in[2]; p.w_in = (const float*)d_in[3];
  p.b_in = (const float*)d_in[4]; p.a_sinks = (const float*)d_in[5]; p.conv_w = (const float*)d_in[6]; p.conv_b = (const float*)d_in[7];
  p.c_lb = (const float*)d_in[8]; p.c_norm_g = (const float*)d_in[9]; p.pe = (const float*)d_in[10]; p.w1 = (const float*)d_in[11];
  p.w2 = (const float*)d_in[12]; p.w_out = (const float*)d_in[13]; p.ln_g = (const float*)d_in[14]; p.ln_b = (const float*)d_in[15];
  p.hf = (float*)d_out;
  p.ws = (char*)d_ws;
  if (WS_TOTAL > ws_size) { fprintf(stderr, "workspace too small: need %zu have %zu\n", (size_t)WS_TOTAL, ws_size); return; }

  static int grid_blocks = 0;
  if (!grid_blocks) {
    int dev = 0, cus = 0, per_cu = 0;
    (void)hipGetDevice(&dev);
    (void)hipDeviceGetAttribute(&cus, hipDeviceAttributeMultiprocessorCount, dev);
    (void)hipOccupancyMaxActiveBlocksPerMultiprocessor(&per_cu, mega, 512, 0);
    if (per_cu > 1) per_cu = 1;
    grid_blocks = cus * per_cu;
  }
  (void)hipMemsetAsync((char*)d_ws + OFF_XBAR, 0, XCD_BAR_WORDS * 4, stream);
  void* args[] = {&p};
  hipError_t e = hipLaunchCooperativeKernel((void*)mega, dim3(grid_blocks), dim3(512), args, 0, stream);
  if (e != hipSuccess) fprintf(stderr, "cooperative launch failed: %s (grid %d)\n", hipGetErrorString(e), grid_blocks);
}
```

```cpp
#include <hip/hip_runtime.h>
#include <hip/hip_cooperative_groups.h>
#include <stdio.h>
#include <stdint.h>
#include <stddef.h>

#ifndef PROBE
#define PROBE 0
#endif
#define DI __device__ __forceinline__
typedef unsigned short bf16_t;
typedef short bf16x8 __attribute__((ext_vector_type(8)));
typedef float f32x16 __attribute__((ext_vector_type(16)));
typedef unsigned u32x4 __attribute__((ext_vector_type(4)));
typedef float f32x4 __attribute__((ext_vector_type(4)));

constexpr int NB = 32, T = 2048, DM = 1024, NTOK = NB * T, NP = 4096;
constexpr float DN_ALPHA = 1.41421356237309515f;

constexpr size_t OFF_HB = 0;
constexpr size_t SZ_HB = (size_t)NTOK * 1024 * 2;
constexpr size_t OFF_YMIX = OFF_HB + ((SZ_HB + 255) & ~(size_t)255);
constexpr size_t SZ_YMIX = (size_t)NTOK * 1024 * 2;
constexpr size_t OFF_QA = OFF_YMIX + ((SZ_YMIX + 255) & ~(size_t)255);
constexpr size_t SZ_QA = (size_t)NTOK * 256 * 2;
constexpr size_t OFF_KA = OFF_QA + ((SZ_QA + 255) & ~(size_t)255);
constexpr size_t SZ_KA = (size_t)NTOK * 128 * 2;
constexpr size_t OFF_VAT = OFF_KA + ((SZ_KA + 255) & ~(size_t)255);
constexpr size_t SZ_VAT = (size_t)NTOK * 128 * 2;
constexpr size_t OFF_QKB = OFF_VAT + ((SZ_VAT + 255) & ~(size_t)255);
constexpr size_t SZ_QKB = (size_t)NTOK * 512 * 2;
constexpr size_t OFF_VBT = OFF_QKB + ((SZ_QKB + 255) & ~(size_t)255);
constexpr size_t SZ_VBT = (size_t)NTOK * 256 * 2;
constexpr size_t OFF_QC = OFF_VBT + ((SZ_VBT + 255) & ~(size_t)255);
constexpr size_t SZ_QC = (size_t)NTOK * 256 * 2;
constexpr size_t OFF_GC = OFF_QC + ((SZ_QC + 255) & ~(size_t)255);
constexpr size_t SZ_GC = (size_t)NTOK * 256 * 4;
constexpr size_t OFF_VCT = OFF_GC + ((SZ_GC + 255) & ~(size_t)255);
constexpr size_t SZ_VCT = (size_t)NTOK * 256 * 2;
constexpr size_t OFF_QD = OFF_VCT + ((SZ_VCT + 255) & ~(size_t)255);
constexpr size_t SZ_QD = (size_t)NTOK * 256 * 2;
constexpr size_t OFF_KV = OFF_QD + ((SZ_QD + 255) & ~(size_t)255);
constexpr size_t SZ_KV = (size_t)NTOK * 384 * 2;
constexpr size_t OFF_GZ = OFF_KV + ((SZ_KV + 255) & ~(size_t)255);
constexpr size_t SZ_GZ = (size_t)NTOK * 1280 * 2;
constexpr size_t OFF_IFG = OFF_GZ + ((SZ_GZ + 255) & ~(size_t)255);
constexpr size_t SZ_IFG = (size_t)NTOK * 8 * 4;
constexpr size_t OFF_DG = OFF_IFG + ((SZ_IFG + 255) & ~(size_t)255);
constexpr size_t SZ_DG = (size_t)NTOK * 12 * 4;
constexpr size_t OFF_WT = OFF_DG + ((SZ_DG + 255) & ~(size_t)255);
constexpr size_t SZ_WT = (size_t)2 * NP * 1024 * 2;
constexpr size_t OFF_WOT = OFF_WT + ((SZ_WT + 255) & ~(size_t)255);
constexpr size_t SZ_WOT = (size_t)2 * 1024 * 1024 * 2;
constexpr size_t OFF_KCMP = OFF_WOT + ((SZ_WOT + 255) & ~(size_t)255);
constexpr size_t SZ_KCMP = (size_t)NB * 128 * 64 * 2;
constexpr size_t OFF_VCMPT = OFF_KCMP + ((SZ_KCMP + 255) & ~(size_t)255);
constexpr size_t SZ_VCMPT = (size_t)NB * 64 * 128 * 2;
constexpr size_t OFF_BIASP = OFF_VCMPT + ((SZ_VCMPT + 255) & ~(size_t)255);
constexpr size_t SZ_BIASP = (size_t)2 * NP * 4;
constexpr size_t OFF_LB = OFF_BIASP + ((SZ_BIASP + 255) & ~(size_t)255);
constexpr size_t SZ_LB = (size_t)512 * 4;
constexpr size_t OFF_ROPEC = OFF_LB + ((SZ_LB + 255) & ~(size_t)255);
constexpr size_t SZ_ROPEC = (size_t)T * 32 * 4;
constexpr size_t OFF_ROPES = OFF_ROPEC + ((SZ_ROPEC + 255) & ~(size_t)255);
constexpr size_t SZ_ROPES = (size_t)T * 32 * 4;
constexpr size_t OFF_BST = OFF_ROPES + ((SZ_ROPES + 255) & ~(size_t)255);
constexpr size_t SZ_BST = (size_t)2048 * 4096 * 4;
constexpr size_t OFF_BN = OFF_BST + ((SZ_BST + 255) & ~(size_t)255);
constexpr size_t SZ_BN = (size_t)2048 * 64 * 4;
constexpr size_t OFF_BG = OFF_BN + ((SZ_BN + 255) & ~(size_t)255);
constexpr size_t SZ_BG = (size_t)2048 * 4;
constexpr size_t OFF_CST = OFF_BG + ((SZ_BG + 255) & ~(size_t)255);
constexpr size_t SZ_CST = (size_t)2048 * 4096 * 4;
constexpr size_t OFF_CAL = OFF_CST + ((SZ_CST + 255) & ~(size_t)255);
constexpr size_t SZ_CAL = (size_t)2048 * 64 * 4;
constexpr size_t OFF_W1T = OFF_CAL + ((SZ_CAL + 255) & ~(size_t)255);
constexpr size_t SZ_W1T = (size_t)4 * 64 * 2048 * 2;
constexpr size_t OFF_W2T = OFF_W1T + ((SZ_W1T + 255) & ~(size_t)255);
constexpr size_t SZ_W2T = (size_t)4 * 64 * 64 * 2;
constexpr size_t OFF_CVEC = OFF_W2T + ((SZ_W2T + 255) & ~(size_t)255);
constexpr size_t SZ_CVEC = (size_t)256 * 4;
constexpr size_t OFF_CTR = OFF_CVEC + ((SZ_CVEC + 255) & ~(size_t)255);
constexpr size_t SZ_CTR = (size_t)256;
constexpr size_t OFF_XBAR = OFF_CTR + ((SZ_CTR + 255) & ~(size_t)255);
constexpr size_t SZ_XBAR = (size_t)3456 * 4;
constexpr size_t WS_TOTAL = OFF_XBAR + ((SZ_XBAR + 255) & ~(size_t)255);
struct Params {
  const float *x, *ln0_g, *ln0_b, *w_in, *b_in, *a_sinks, *conv_w, *conv_b, *c_lb, *c_norm_g, *pe, *w1, *w2, *w_out, *ln_g, *ln_b;
  float* hf;
  char* ws;
  DI bf16_t* HB() const { return (bf16_t*)(ws + OFF_HB); }
  DI bf16_t* YMIX() const { return (bf16_t*)(ws + OFF_YMIX); }
  DI bf16_t* QA() const { return (bf16_t*)(ws + OFF_QA); }
  DI bf16_t* KA() const { return (bf16_t*)(ws + OFF_KA); }
  DI bf16_t* VAT() const { return (bf16_t*)(ws + OFF_VAT); }
  DI bf16_t* QKB() const { return (bf16_t*)(ws + OFF_QKB); }
  DI bf16_t* VBT() const { return (bf16_t*)(ws + OFF_VBT); }
  DI bf16_t* QC() const { return (bf16_t*)(ws + OFF_QC); }
  DI float* GC() const { return (float*)(ws + OFF_GC); }
  DI bf16_t* VCT() const { return (bf16_t*)(ws + OFF_VCT); }
  DI bf16_t* QD() const { return (bf16_t*)(ws + OFF_QD); }
  DI bf16_t* KV() const { return (bf16_t*)(ws + OFF_KV); }
  DI bf16_t* GZ() const { return (bf16_t*)(ws + OFF_GZ); }
  DI float* IFG() const { return (float*)(ws + OFF_IFG); }
  DI float* DG() const { return (float*)(ws + OFF_DG); }
  DI bf16_t* WT() const { return (bf16_t*)(ws + OFF_WT); }
  DI bf16_t* WOT() const { return (bf16_t*)(ws + OFF_WOT); }
  DI bf16_t* KCMP() const { return (bf16_t*)(ws + OFF_KCMP); }
  DI bf16_t* VCMPT() const { return (bf16_t*)(ws + OFF_VCMPT); }
  DI float* BIASP() const { return (float*)(ws + OFF_BIASP); }
  DI float* LB() const { return (float*)(ws + OFF_LB); }
  DI float* ROPEC() const { return (float*)(ws + OFF_ROPEC); }
  DI float* ROPES() const { return (float*)(ws + OFF_ROPES); }
  DI float* BST() const { return (float*)(ws + OFF_BST); }
  DI float* BN() const { return (float*)(ws + OFF_BN); }
  DI float* BG() const { return (float*)(ws + OFF_BG); }
  DI float* CST() const { return (float*)(ws + OFF_CST); }
  DI float* CAL() const { return (float*)(ws + OFF_CAL); }
  DI bf16_t* W1T() const { return (bf16_t*)(ws + OFF_W1T); }
  DI bf16_t* W2T() const { return (bf16_t*)(ws + OFF_W2T); }
  DI float* CVEC() const { return (float*)(ws + OFF_CVEC); }
  DI int* CTR() const { return (int*)(ws + OFF_CTR); }
  DI unsigned* XBAR() const { return (unsigned*)(ws + OFF_XBAR); }
};
namespace cg = cooperative_groups;

DI int tid_opaque() { int t = threadIdx.x & 255; asm volatile("" : "+v"(t)); return t; }
DI int half_id() { return __builtin_amdgcn_readfirstlane((int)(threadIdx.x >> 8)); }
DI float bf2f(bf16_t v) { return __uint_as_float(((unsigned)v) << 16); }
DI bf16_t f2bf(float x) { unsigned u = __float_as_uint(x); u += 0x7fffu + ((u >> 16) & 1u); return (bf16_t)(u >> 16); }
DI float sigmoidf_(float x) { return __builtin_amdgcn_rcpf(1.f + __builtin_amdgcn_exp2f(-1.4426950408889634f * x)); }
DI float siluf_(float x) { return x * __builtin_amdgcn_rcpf(1.f + __builtin_amdgcn_exp2f(-1.4426950408889634f * x)); }
DI int lane_op() { int l = threadIdx.x & 63; asm volatile("" : "+v"(l)); return l; }
DI float shx(float v, int m) { return __builtin_bit_cast(float, __builtin_amdgcn_ds_bpermute((lane_op() ^ m) << 2, __builtin_bit_cast(int, v))); }
DI unsigned shx(unsigned v, int m) { return (unsigned)__builtin_amdgcn_ds_bpermute((lane_op() ^ m) << 2, (int)v); }
DI float shup(float v, int d) { const int l = lane_op(); const int s = l - d; return __builtin_bit_cast(float, __builtin_amdgcn_ds_bpermute((s < 0 ? l : s) << 2, __builtin_bit_cast(int, v))); }
DI float wave_sum(float v) { for (int o = 32; o > 0; o >>= 1) v += shx(v, o); return v; }
DI float wave_max(float v) { for (int o = 32; o > 0; o >>= 1) v = fmaxf(v, shx(v, o)); return v; }

DI int orig_col(int n) {
  if (n < 1536) return n;
  if (n < 3712) return n + 8;
  if (n < 3968) return n + 20;
  if (n < 3976) return 1536 + (n - 3968);
  if (n < 3988) return 3720 + (n - 3976);
  return -1;
}

DI bool head_is_paired(int hd);
DI void ph_prologue(const Params& p, int bid, int nblk, char* smem) {
  const long gtid = (long)bid * 256 + tid_opaque(), gsz = (long)nblk * 256;
  if (gtid < 64) p.CTR()[gtid] = 0;
  for (long idx = gtid; idx < 2L * 128 * NP; idx += gsz) {
    const int n = (int)(idx % NP), k8 = (int)((idx / NP) % 128), l = (int)(idx / (NP * 128));
    const int pp = n & 63, w_ = pp >> 5, rr = pp & 31, n_ = rr >> 4, fq_ = (rr >> 2) & 3, j_ = rr & 3;
    const int lc = head_is_paired(n >> 6) ? (32 * n_ + 16 * w_ + 4 * fq_ + j_) : (32 * w_ + 8 * fq_ + 4 * n_ + j_);
    const int oc = orig_col((n & ~63) + lc);
    unsigned w[4];
    for (int j = 0; j < 4; ++j) {
      float a = 0.f, b = 0.f;
      if (oc >= 0) { a = p.w_in[((size_t)l * 1024 + k8 * 8 + 2 * j) * 3988 + oc]; b = p.w_in[((size_t)l * 1024 + k8 * 8 + 2 * j + 1) * 3988 + oc]; }
      w[j] = (unsigned)f2bf(a) | ((unsigned)f2bf(b) << 16);
    }
    *(uint4*)(p.WT() + ((size_t)l * NP + n) * 1024 + k8 * 8) = make_uint4(w[0], w[1], w[2], w[3]);
  }
  for (long idx = gtid; idx < 2L * 128 * 1024; idx += gsz) {
    const int d = (int)(idx % 1024), m8 = (int)((idx / 1024) % 128), l = (int)(idx / (1024 * 128));
    unsigned w[4];
    for (int j = 0; j < 4; ++j) {
      float a = p.w_out[((size_t)l * 1024 + m8 * 8 + 2 * j) * 1024 + d], b = p.w_out[((size_t)l * 1024 + m8 * 8 + 2 * j + 1) * 1024 + d];
      w[j] = (unsigned)f2bf(a) | ((unsigned)f2bf(b) << 16);
    }
    *(uint4*)(p.WOT() + ((size_t)l * 1024 + d) * 1024 + m8 * 8) = make_uint4(w[0], w[1], w[2], w[3]);
  }
  for (long idx = gtid; idx < 4L * 256 * 64; idx += gsz) {
    const int j = (int)(idx % 64), i8 = (int)((idx / 64) % 256), lk = (int)(idx / (64 * 256));
    unsigned w[4];
    for (int e = 0; e < 4; ++e) {
      const float a = p.w1[((size_t)lk * 2048 + i8 * 8 + 2 * e) * 64 + j], b = p.w1[((size_t)lk * 2048 + i8 * 8 + 2 * e + 1) * 64 + j];
      w[e] = (unsigned)f2bf(a) | ((unsigned)f2bf(b) << 16);
    }
    *(uint4*)(p.W1T() + ((size_t)lk * 64 + j) * 2048 + i8 * 8) = make_uint4(w[0], w[1], w[2], w[3]);
  }
  for (long idx = gtid; idx < 4L * 64 * 64; idx += gsz) {
    const int jo = (int)(idx % 64), ji = (int)((idx / 64) % 64), lk = (int)(idx / 4096);
    p.W2T()[((size_t)lk * 64 + jo) * 64 + ji] = f2bf(p.w2[((size_t)lk * 64 + ji) * 64 + jo]);
  }
  if (bid < 4) {
    const int lk = bid, j = tid_opaque() & 63, part = tid_opaque() >> 6;
    float a = 0.f;
    for (int i = part * 512; i < part * 512 + 512; ++i) a += p.pe[(size_t)lk * 2048 + i] * p.w1[((size_t)lk * 2048 + i) * 64 + j];
    float* red = (float*)smem;
    red[part * 64 + j] = a;
    __syncthreads();
    if (part == 0) p.CVEC()[lk * 64 + j] = (red[j] + red[64 + j]) + (red[128 + j] + red[192 + j]);
    __syncthreads();
  }
  for (long idx = gtid; idx < 2L * NP; idx += gsz) {
    const int n = (int)(idx % NP), l = (int)(idx / NP); const int oc = orig_col(n);
    p.BIASP()[idx] = oc >= 0 ? p.b_in[l * 3988 + oc] : 0.f;
  }
  for (long idx = gtid; idx < (long)T * 32; idx += gsz) {
    const int t = (int)(idx / 32), i = (int)(idx % 32);
    const float inv = exp2f(-(float)i * (13.287712379549449f / 32.0f));
    const float ang = (float)t * inv;
    p.ROPEC()[idx] = cosf(ang); p.ROPES()[idx] = sinf(ang);
  }
  for (long idx = gtid; idx < 512; idx += gsz) {
    const int c = (int)(idx % 256), l = (int)(idx / 256);
    const float a = p.c_lb[c], b = p.c_lb[256 + c];
    const float m = fmaxf(a, b); const float ea = expf(a - m), eb = expf(b - m);
    p.LB()[idx] = l == 0 ? 0.f : eb / (ea + eb);
  }
}

DI void ln_rows(const Params& p, int mode, int layer, int bid, int nblk) {
  const int tid_ = tid_opaque(); const int lane = tid_ & 63, wid = tid_ >> 6, nw = 4;
  const float* g = mode == 0 ? p.ln0_g : p.ln_g + layer * 1024;
  const float* bb = mode == 0 ? p.ln0_b : p.ln_b + layer * 1024;
  const float* src = mode == 0 ? p.x : p.hf;
  for (int row = bid * nw + wid; row < NTOK; row += nblk * nw) {
    const float* s = src + (size_t)row * 1024;
    float4 v[4];
    float sum = 0.f;
#pragma unroll
    for (int i = 0; i < 4; ++i) { v[i] = *(const float4*)(s + i * 256 + lane * 4); sum += (v[i].x + v[i].y) + (v[i].z + v[i].w); }
    sum = wave_sum(sum);
    const float mu = sum * (1.f / 1024.f);
    float q = 0.f;
#pragma unroll
    for (int i = 0; i < 4; ++i) { float a = v[i].x - mu, b = v[i].y - mu, c = v[i].z - mu, d = v[i].w - mu; q += (a * a + b * b) + (c * c + d * d); }
    q = wave_sum(q);
    const float rs = rsqrtf(q * (1.f / 1024.f) + 1e-5f);
#pragma unroll
    for (int i = 0; i < 4; ++i) {
      const int c0 = i * 256 + lane * 4;
      const float4 gg = *(const float4*)(g + c0), b4 = *(const float4*)(bb + c0);
      float4 o;
      o.x = (v[i].x - mu) * rs * gg.x + b4.x; o.y = (v[i].y - mu) * rs * gg.y + b4.y;
      o.z = (v[i].z - mu) * rs * gg.z + b4.z; o.w = (v[i].w - mu) * rs * gg.w + b4.w;
      *(float4*)(p.hf + (size_t)row * 1024 + c0) = o;
      uint2 pk; pk.x = (unsigned)f2bf(o.x) | ((unsigned)f2bf(o.y) << 16); pk.y = (unsigned)f2bf(o.z) | ((unsigned)f2bf(o.w) << 16);
      *(uint2*)(p.HB() + (size_t)row * 1024 + c0) = pk;
    }
  }
}

typedef float f32x2 __attribute__((ext_vector_type(2)));
typedef __bf16 bf16v2 __attribute__((ext_vector_type(2)));
typedef unsigned u32x2 __attribute__((ext_vector_type(2)));
DI unsigned pack2(float a, float b) { f32x2 v = {a, b}; return __builtin_bit_cast(unsigned, __builtin_convertvector(v, bf16v2)); }
DI f32x16 zero16() { f32x16 z;
#pragma unroll
  for (int i = 0; i < 16; ++i) z[i] = 0.f; return z; }
DI bf16x8 ld_frag8x2(const bf16_t* p) { const u32x2 lo = *(const u32x2*)p, hi = *(const u32x2*)(p + 8); u32x4 t = {lo.x, lo.y, hi.x, hi.y}; return __builtin_bit_cast(bf16x8, t); }
template <int BASE> DI bf16x8 pack8(const f32x16& s) {
  u32x4 t = {pack2(s[BASE + 0], s[BASE + 1]), pack2(s[BASE + 2], s[BASE + 3]), pack2(s[BASE + 4], s[BASE + 5]), pack2(s[BASE + 6], s[BASE + 7])};
  return __builtin_bit_cast(bf16x8, t);
}
DI int crow(int r, int h2) { return (r & 3) + 8 * (r >> 2) + 4 * h2; }
#define MFMA32(a, b, c) __builtin_amdgcn_mfma_f32_32x32x16_bf16((a), (b), (c), 0, 0, 0)
#define LAS __attribute__((address_space(3)))
enum { K_NONE = 0, K_ROPE, K_PLAIN, K_TR, K_GSILU, K_GSIG, K_SILUH, K_LOGF, K_SMALL };
namespace g8 {
constexpr int BK = 64, HALF = 128, HT = HALF * BK;
DI int lds_byte(int r, int c) { const int st = (r >> 4) * 2 + (c >> 5), rr = r & 15, cc = c & 31, ob = rr * 64 + cc * 2; return st * 1024 + (ob ^ (((ob >> 9) & 1) << 5)); }
DI void stage_rc(int b, int& R, int& C) { const int st = b / 1024, sb = b % 1024, swz = sb ^ (((sb >> 9) & 1) << 5); R = (st >> 1) * 16 + swz / 64; C = (st & 1) * 32 + (swz % 64) / 2; }
}
DI void gemm256_mainloop(const bf16_t* A, const bf16_t* Bt, bf16_t* shm, f32x4 (&acc)[2][2][4][2]) {
  using namespace g8;
  constexpr int K = 1024;
#define SA(b, h) (shm + ((b) * 2 + (h)) * HT)
#define SB(b, h) (shm + (4 + (b) * 2 + (h)) * HT)
#define STAGE(P, BASE, br, kt) do { const long g_ = (long)(br) * K + (long)(kt) * BK; \
    _Pragma("unroll") for (int i_ = 0; i_ < 2; ++i_) { const int b_ = tidf * 16 + i_ * 8192; int r_, c_; stage_rc(b_, r_, c_); \
      __builtin_amdgcn_global_load_lds((const unsigned*)((BASE) + g_ + (long)r_ * K + c_), (LAS unsigned*)((char*)(P) + b_), 16, 0, 0); } } while (0)
#define LDA(dst, b, h) _Pragma("unroll") for (int m = 0; m < 4; ++m) _Pragma("unroll") for (int k = 0; k < 2; ++k) \
    dst[m][k] = *reinterpret_cast<const bf16x8*>((const char*)SA(b, h) + lds_byte(wr * 64 + m * 16 + fr, k * 32 + fq * 8))
#define LDB(dst, b, h) _Pragma("unroll") for (int n = 0; n < 2; ++n) _Pragma("unroll") for (int k = 0; k < 2; ++k) \
    dst[n][k] = *reinterpret_cast<const bf16x8*>((const char*)SB(b, h) + lds_byte(wc * 32 + n * 16 + fr, k * 32 + fq * 8))
#define MMA(ai, bj, At_, Bt_) do { __builtin_amdgcn_s_setprio(1); \
    _Pragma("unroll") for (int m = 0; m < 4; ++m) _Pragma("unroll") for (int n = 0; n < 2; ++n) _Pragma("unroll") for (int k = 0; k < 2; ++k) \
      acc[ai][bj][m][n] = __builtin_amdgcn_mfma_f32_16x16x32_bf16(Bt_[n][k], At_[m][k], acc[ai][bj][m][n], 0, 0, 0); \
    __builtin_amdgcn_s_setprio(0); } while (0)
#define WAIT_V(n) asm volatile("s_waitcnt vmcnt(" #n ")" ::: "memory")
#define WAIT_L(n) asm volatile("s_waitcnt lgkmcnt(" #n ")" ::: "memory")
#define BAR __builtin_amdgcn_s_barrier()
#define SCHED __builtin_amdgcn_sched_barrier(0)
  int tidf = threadIdx.x; asm volatile("" : "+v"(tidf));
  const int wid = tidf >> 6, lane = tidf & 63, wr = wid >> 2, wc = wid & 3, fr = lane & 15, fq = lane >> 4;
#pragma unroll
  for (int a = 0; a < 2; ++a)
#pragma unroll
    for (int b = 0; b < 2; ++b)
#pragma unroll
      for (int m = 0; m < 4; ++m)
#pragma unroll
        for (int n = 0; n < 2; ++n) acc[a][b][m][n] = (f32x4){0.f, 0.f, 0.f, 0.f};
  bf16x8 At[4][2], B0[2][2], B1[2][2];
  constexpr int nt = K / BK;
  WAIT_V(0);
  STAGE(SB(0, 0), Bt, 0, 0); STAGE(SA(0, 0), A, 0, 0);
  STAGE(SB(0, 1), Bt, HALF, 0); STAGE(SA(0, 1), A, HALF, 0);
  if (wr == 1) BAR;
  WAIT_V(4); BAR;
  STAGE(SB(1, 0), Bt, 0, 1); STAGE(SA(1, 0), A, 0, 1); STAGE(SB(1, 1), Bt, HALF, 1);
  WAIT_V(6); BAR;
  for (int t = 0; t < nt - 2; t += 2) {
    LDB(B0, 0, 0); SCHED; LDA(At, 0, 0); STAGE(SA(1, 1), A, HALF, t + 1);
    WAIT_L(8); BAR; WAIT_L(0); MMA(0, 0, At, B0); BAR; SCHED;
    LDB(B1, 0, 1); STAGE(SB(0, 0), Bt, 0, t + 2);
    BAR; WAIT_L(0); MMA(0, 1, At, B1); BAR;
    LDA(At, 0, 1); STAGE(SA(0, 0), A, 0, t + 2);
    BAR; WAIT_L(0); MMA(1, 0, At, B0); BAR; SCHED;
    STAGE(SB(0, 1), Bt, HALF, t + 2);
    WAIT_V(6); BAR; MMA(1, 1, At, B1); BAR;
    LDB(B0, 1, 0); SCHED; LDA(At, 1, 0); STAGE(SA(0, 1), A, HALF, t + 2);
    WAIT_L(8); BAR; WAIT_L(0); MMA(0, 0, At, B0); BAR; SCHED;
    LDB(B1, 1, 1); STAGE(SB(1, 0), Bt, 0, t + 3);
    BAR; WAIT_L(0); MMA(0, 1, At, B1); BAR;
    LDA(At, 1, 1); STAGE(SA(1, 0), A, 0, t + 3);
    BAR; WAIT_L(0); MMA(1, 0, At, B0); BAR; SCHED;
    STAGE(SB(1, 1), Bt, HALF, t + 3);
    WAIT_V(6); BAR; MMA(1, 1, At, B1); BAR;
  }
  { LDB(B0, 0, 0); LDA(At, 0, 0); STAGE(SA(1, 1), A, HALF, nt - 1);
    BAR; WAIT_L(0); MMA(0, 0, At, B0); BAR;
    LDB(B1, 0, 1); BAR; WAIT_L(0); MMA(0, 1, At, B1); BAR;
    LDA(At, 0, 1); WAIT_V(4); BAR; WAIT_L(0); MMA(1, 0, At, B0); MMA(1, 1, At, B1); BAR; }
  { LDB(B0, 1, 0); LDA(At, 1, 0); WAIT_V(2); BAR; WAIT_L(0); MMA(0, 0, At, B0); BAR;
    LDB(B1, 1, 1); WAIT_V(0); BAR; WAIT_L(0); MMA(0, 1, At, B1); BAR;
    LDA(At, 1, 1); BAR; WAIT_L(0); MMA(1, 0, At, B0); MMA(1, 1, At, B1); BAR; }
  if (wr == 0) BAR;
#undef SA
#undef SB
#undef STAGE
#undef LDA
#undef LDB
#undef MMA
#undef WAIT_V
#undef WAIT_L
#undef BAR
#undef SCHED
}

DI void classify_head(const Params& p, int hd, int b, int& kind, bf16_t*& dst, float*& fdst, float& scale) {
  kind = K_NONE; dst = nullptr; fdst = nullptr; scale = 1.f;
  if (hd < 4) { kind = K_ROPE; dst = p.QA() + ((size_t)(b * 4 + hd) * T) * 64; scale = 0.125f; }
  else if (hd < 6) { kind = K_ROPE; dst = p.KA() + ((size_t)(b * 2 + hd - 4) * T) * 64; }
  else if (hd < 8) { kind = K_TR; dst = p.VAT() + (size_t)(b * 2 + hd - 6) * 64 * T; }
  else if (hd < 12) { kind = K_GSILU; dst = p.GZ() + (size_t)0 * NTOK * 256 + (hd - 8) * 64; }
  else if (hd < 20) { kind = K_PLAIN; dst = p.QKB() + ((size_t)(b * 8 + hd - 12) * T) * 64; }
  else if (hd < 24) { kind = K_TR; dst = p.VBT() + (size_t)(b * 4 + hd - 20) * 64 * T; }
  else if (hd < 28) { kind = K_GSIG; dst = p.GZ() + (size_t)1 * NTOK * 256 + (hd - 24) * 64; }
  else if (hd < 32) { kind = K_GSILU; dst = p.GZ() + (size_t)2 * NTOK * 256 + (hd - 28) * 64; }
  else if (hd < 36) { kind = K_SILUH; dst = p.QC() + ((size_t)(b * 4 + hd - 32) * T) * 64; }
  else if (hd < 40) { kind = K_LOGF; fdst = p.GC() + ((size_t)(b * 4 + hd - 36) * T) * 64; }
  else if (hd < 44) { kind = K_TR; dst = p.VCT() + (size_t)(b * 4 + hd - 40) * 64 * T; }
  else if (hd < 48) { kind = K_GSILU; dst = p.GZ() + (size_t)3 * NTOK * 256 + (hd - 44) * 64; }
  else if (hd < 52) { kind = K_ROPE; dst = p.QD() + ((size_t)(b * 4 + hd - 48) * T) * 64; scale = 0.125f; }
  else if (hd < 58) {
    const int j = hd - 52;
    dst = p.KV() + (size_t)(j * NB + b) * T * 64;
    kind = (j == 0 || j == 1) ? K_PLAIN : ((j == 2 || j == 4) ? K_ROPE : K_TR);
  }
  else if (hd < 62) { kind = K_GSILU; dst = p.GZ() + (size_t)4 * NTOK * 256 + (hd - 58) * 64; }
  else if (hd == 62) { kind = K_SMALL; }
}

DI bool head_is_paired(int hd) { return hd < 6 || (hd >= 48 && hd < 52) || hd == 54 || hd == 56; }
template <int KIND>
DI void epi_direct(const Params& p, const f32x4 (&a)[4][2], bf16_t* dst, float* fdst, float scale, int layer, int hd, int b, int tq, int wr, int w, int fr, int fq) {
  if (KIND == K_ROPE) {
    const int c = 16 * w + 4 * fq;
    const f32x4 b0 = *(const f32x4*)(p.BIASP() + layer * NP + hd * 64 + c), b1 = *(const f32x4*)(p.BIASP() + layer * NP + hd * 64 + 32 + c);
#pragma unroll
    for (int m = 0; m < 4; ++m) {
      const int t = tq + wr * 64 + m * 16 + fr;
      const f32x4 cs = *(const f32x4*)(p.ROPEC() + t * 32 + c), sn = *(const f32x4*)(p.ROPES() + t * 32 + c);
      const f32x4 v0 = a[m][0] + b0, v1 = a[m][1] + b1;
      const f32x4 o0 = (v0 * cs - v1 * sn) * scale, o1 = (v0 * sn + v1 * cs) * scale;
      u32x2 w0 = {pack2(o0[0], o0[1]), pack2(o0[2], o0[3])}, w1 = {pack2(o1[0], o1[1]), pack2(o1[2], o1[3])};
      *(u32x2*)(dst + (size_t)t * 64 + c) = w0; *(u32x2*)(dst + (size_t)t * 64 + 32 + c) = w1;
    }
    return;
  }
  const int c = 32 * w + 8 * fq;
  const f32x4 b0 = *(const f32x4*)(p.BIASP() + layer * NP + hd * 64 + c), b1 = *(const f32x4*)(p.BIASP() + layer * NP + hd * 64 + c + 4);
  if (KIND == K_SMALL) {
#pragma unroll
    for (int m = 0; m < 4; ++m) {
      const size_t tok = (size_t)b * T + tq + wr * 64 + m * 16 + fr;
#pragma unroll
      for (int n = 0; n < 2; ++n)
#pragma unroll
        for (int j = 0; j < 4; ++j) {
          const int cc = c + 4 * n + j;
          const float v = a[m][n][j] + (n ? b1[j] : b0[j]);
          if (cc < 8) p.IFG()[tok * 8 + cc] = v;
          else if (cc < 20) p.DG()[tok * 12 + (cc - 8)] = sigmoidf_(v);
        }
    }
    return;
  }
  f32x4 lb0 = {0.f, 0.f, 0.f, 0.f}, lb1 = {0.f, 0.f, 0.f, 0.f};
  if (KIND == K_LOGF) { lb0 = *(const f32x4*)(p.LB() + layer * 256 + (hd - 36) * 64 + c); lb1 = *(const f32x4*)(p.LB() + layer * 256 + (hd - 36) * 64 + c + 4); }
#pragma unroll
  for (int m = 0; m < 4; ++m) {
    const int t = tq + wr * 64 + m * 16 + fr;
    const f32x4 v0 = a[m][0] + b0, v1 = a[m][1] + b1;
    if (KIND == K_LOGF) {
      f32x4 o0, o1;
#pragma unroll
      for (int j = 0; j < 4; ++j) { o0[j] = __logf(lb0[j] + (1.f - lb0[j]) * sigmoidf_(v0[j])); o1[j] = __logf(lb1[j] + (1.f - lb1[j]) * sigmoidf_(v1[j])); }
      *(f32x4*)(fdst + (size_t)t * 64 + c) = o0; *(f32x4*)(fdst + (size_t)t * 64 + c + 4) = o1;
    } else {
      f32x4 o0, o1;
#pragma unroll
      for (int j = 0; j < 4; ++j) {
        if (KIND == K_PLAIN) { o0[j] = v0[j]; o1[j] = v1[j]; }
        else if (KIND == K_SILUH || KIND == K_GSILU) { o0[j] = siluf_(v0[j]); o1[j] = siluf_(v1[j]); }
        else { o0[j] = sigmoidf_(v0[j]); o1[j] = sigmoidf_(v1[j]); }
      }
      u32x4 wv = {pack2(o0[0], o0[1]), pack2(o0[2], o0[3]), pack2(o1[0], o1[1]), pack2(o1[2], o1[3])};
      if (KIND == K_GSILU || KIND == K_GSIG) *(u32x4*)(dst + ((size_t)b * T + t) * 256 + c) = wv;
      else *(u32x4*)(dst + (size_t)t * 64 + c) = wv;
    }
  }
}
DI void epi_tr_write(const Params& p, const f32x4 (&a)[4][2], char* img, int layer, int hd, int wr, int w, int fr, int fq) {
  const int c = 32 * w + 8 * fq;
  const f32x4 b0 = *(const f32x4*)(p.BIASP() + layer * NP + hd * 64 + c), b1 = *(const f32x4*)(p.BIASP() + layer * NP + hd * 64 + c + 4);
  bf16_t* timg = (bf16_t*)img;
#pragma unroll
  for (int m = 0; m < 4; ++m)
#pragma unroll
    for (int n = 0; n < 2; ++n)
#pragma unroll
      for (int j = 0; j < 4; ++j) timg[(c + 4 * n + j) * 128 + wr * 64 + m * 16 + fr] = f2bf(a[m][n][j] + (n ? b1[j] : b0[j]));
}
DI void gemm_in_quadrant(const Params& p, int layer, int panel, int pn, int ai, int bj, const f32x4 (&a)[4][2], char* shm,
                         int b, int hq, int tid2, int wr, int wc, int fr, int fq) {
  const int tq = (panel & 7) * 256 + ai * 128;
  const int hd0 = pn * 4 + bj * 2;
  const int hd = hd0 + (wc >> 1), w = wc & 1;
  int kind; bf16_t* dst; float* fdst; float scale;
  classify_head(p, hd, b, kind, dst, fdst, scale);
  switch (kind) {
    case K_ROPE: epi_direct<K_ROPE>(p, a, dst, fdst, scale, layer, hd, b, tq, wr, w, fr, fq); break;
    case K_PLAIN: epi_direct<K_PLAIN>(p, a, dst, fdst, scale, layer, hd, b, tq, wr, w, fr, fq); break;
    case K_GSILU: epi_direct<K_GSILU>(p, a, dst, fdst, scale, layer, hd, b, tq, wr, w, fr, fq); break;
    case K_GSIG: epi_direct<K_GSIG>(p, a, dst, fdst, scale, layer, hd, b, tq, wr, w, fr, fq); break;
    case K_SILUH: epi_direct<K_SILUH>(p, a, dst, fdst, scale, layer, hd, b, tq, wr, w, fr, fq); break;
    case K_LOGF: epi_direct<K_LOGF>(p, a, dst, fdst, scale, layer, hd, b, tq, wr, w, fr, fq); break;
    case K_SMALL: epi_direct<K_SMALL>(p, a, dst, fdst, scale, layer, hd, b, tq, wr, w, fr, fq); break;
    default: break;
  }
  int k0, k1; { bf16_t* d_; float* f_; float s_; classify_head(p, hd0, b, k0, d_, f_, s_); classify_head(p, hd0 + 1, b, k1, d_, f_, s_); }
  if (k0 == K_TR || k1 == K_TR) {
    if (kind == K_TR) epi_tr_write(p, a, shm + (wc >> 1) * 16384, layer, hd, wr, w, fr, fq);
    __syncthreads();
    int kq; bf16_t* dq; float* fq_; float sq; classify_head(p, hd0 + hq, b, kq, dq, fq_, sq);
    if (kq == K_TR) {
      const char* img = shm + hq * 16384;
#pragma unroll
      for (int i = 0; i < 4; ++i) { const int q = tid2 + 256 * i, cc = q >> 4, rc = q & 15; *(u32x4*)(dq + (size_t)cc * T + tq + rc * 8) = *(const u32x4*)(img + q * 16); }
    }
    __syncthreads();
  }
}
DI void gemm_in_epilogue(const Params& p, int layer, int panel, int pn, const f32x4 (&acc)[2][2][4][2], char* shm) {
  int tidf = threadIdx.x; asm volatile("" : "+v"(tidf));
  const int wid = tidf >> 6, lane = tidf & 63, wr = wid >> 2, wc = wid & 3, fr = lane & 15, fq = lane >> 4;
  const int b = panel >> 3;
  const int hq = __builtin_amdgcn_readfirstlane(tidf >> 8), tid2 = tidf & 255;
  __syncthreads();
  gemm_in_quadrant(p, layer, panel, pn, 0, 0, acc[0][0], shm, b, hq, tid2, wr, wc, fr, fq);
  gemm_in_quadrant(p, layer, panel, pn, 0, 1, acc[0][1], shm, b, hq, tid2, wr, wc, fr, fq);
  gemm_in_quadrant(p, layer, panel, pn, 1, 0, acc[1][0], shm, b, hq, tid2, wr, wc, fr, fq);
  gemm_in_quadrant(p, layer, panel, pn, 1, 1, acc[1][1], shm, b, hq, tid2, wr, wc, fr, fq);
}
DI void gemm_out_epilogue(const Params& p, int panel, int pn, const f32x4 (&acc)[2][2][4][2], char* shm) {
  int tidf = threadIdx.x; asm volatile("" : "+v"(tidf));
  const int wid = tidf >> 6, lane = tidf & 63, wr = wid >> 2, wc = wid & 3, fr = lane & 15, fq = lane >> 4;
#pragma unroll
  for (int ai = 0; ai < 2; ++ai)
#pragma unroll
    for (int bj = 0; bj < 2; ++bj)
#pragma unroll
      for (int m = 0; m < 4; ++m)
#pragma unroll
        for (int n = 0; n < 2; ++n) {
          float* g = p.hf + (size_t)(panel * 256 + ai * 128 + wr * 64 + m * 16 + fr) * 1024 + pn * 256 + bj * 128 + wc * 32 + n * 16 + fq * 4;
          const f32x4 h = *(const f32x4*)g;
          *(f32x4*)g = DN_ALPHA * h + acc[ai][bj][m][n];
        }
}
DI void ph_gemm_in(const Params& p, int layer, int bid, int nblk, char* shm) {
  asm volatile("" : "+s"(bid));
  for (int panel = bid; panel < 256; panel += nblk) {
    const bf16_t* A = p.HB() + (size_t)panel * 256 * 1024;
    for (int pn = 0; pn < 16; ++pn) {
      f32x4 acc[2][2][4][2];
      gemm256_mainloop(A, p.WT() + ((size_t)layer * NP + pn * 256) * 1024, (bf16_t*)shm, acc);
      if (PROBE == 6) { __syncthreads(); gemm256_mainloop(A, p.WT() + ((size_t)layer * NP + pn * 256) * 1024, (bf16_t*)shm, acc); }
      gemm_in_epilogue(p, layer, panel, pn, acc, shm);
      if (PROBE == 7) gemm_in_epilogue(p, layer, panel, pn, acc, shm);
    }
  }
}
DI void ph_gemm_out_ln(const Params& p, int layer, int bid, int nblk, char* shm) {
  asm volatile("" : "+s"(bid));
  for (int panel = bid; panel < 256; panel += nblk) {
    const bf16_t* A = p.YMIX() + (size_t)panel * 256 * 1024;
    for (int pn = 0; pn < 4; ++pn) {
      f32x4 acc[2][2][4][2];
      gemm256_mainloop(A, p.WOT() + ((size_t)layer * 1024 + pn * 256) * 1024, (bf16_t*)shm, acc);
      gemm_out_epilogue(p, panel, pn, acc, shm);
    }
    asm volatile("s_waitcnt vmcnt(0)" ::: "memory");
    __syncthreads();
    int tidf = threadIdx.x; asm volatile("" : "+v"(tidf));
    const int lane = tidf & 63, wid = tidf >> 6;
    const float* g = p.ln_g + layer * 1024; const float* bb = p.ln_b + layer * 1024;
    for (int rr = 0; rr < 32; ++rr) {
      const int row = panel * 256 + wid * 32 + rr;
      float* s = p.hf + (size_t)row * 1024;
      f32x4 v[4];
      float sum = 0.f;
#pragma unroll
      for (int i = 0; i < 4; ++i) { v[i] = *(const f32x4*)(s + i * 256 + lane * 4); sum += (v[i][0] + v[i][1]) + (v[i][2] + v[i][3]); }
      sum = wave_sum(sum);
      const float mu = sum * (1.f / 1024.f);
      float q = 0.f;
#pragma unroll
      for (int i = 0; i < 4; ++i) { const f32x4 d = v[i] - mu; q += (d[0] * d[0] + d[1] * d[1]) + (d[2] * d[2] + d[3] * d[3]); }
      q = wave_sum(q);
      const float rs = rsqrtf(q * (1.f / 1024.f) + 1e-5f);
#pragma unroll
      for (int i = 0; i < 4; ++i) {
        const int cc = i * 256 + lane * 4;
        const f32x4 gg = *(const f32x4*)(g + cc), b4 = *(const f32x4*)(bb + cc);
        const f32x4 o = (v[i] - mu) * rs * gg + b4;
        *(f32x4*)(s + cc) = o;
        u32x2 pk = {pack2(o[0], o[1]), pack2(o[2], o[3])};
        *(u32x2*)(p.HB() + (size_t)row * 1024 + cc) = pk;
      }
    }
  }
}

DI f32x16 qk_tile(const bf16_t* Krow, const bf16x8 (&qf)[4], int l31, int h2) {
  f32x16 s = zero16();
  const bf16_t* kp = Krow + l31 * 64 + h2 * 8;
#pragma unroll
  for (int ks = 0; ks < 4; ++ks) { const bf16x8 a = *(const bf16x8*)(kp + ks * 16); s = MFMA32(a, qf[ks], s); }
  return s;
}
DI void softmax_pv(f32x16& s, const bf16_t* VTp, int vstride, f32x16 (&o)[2], float& m, float& l, int l31, int h2) {
  bf16x8 va[2][2];
#pragma unroll
  for (int dt = 0; dt < 2; ++dt)
#pragma unroll
    for (int sk = 0; sk < 2; ++sk) va[dt][sk] = ld_frag8x2(VTp + (size_t)(dt * 32 + l31) * vstride + sk * 16 + 4 * h2);
  float mx = s[0];
#pragma unroll
  for (int r = 1; r < 16; ++r) mx = fmaxf(mx, s[r]);
  mx = fmaxf(mx, shx(mx, 32));
  const float mn = fmaxf(m, mx);
  const float alpha = __expf(m - mn);
  float ps = 0.f;
#pragma unroll
  for (int r = 0; r < 16; ++r) { s[r] = __expf(s[r] - mn); ps += s[r]; }
  ps += shx(ps, 32);
  l = l * alpha + ps; m = mn;
#pragma unroll
  for (int dt = 0; dt < 2; ++dt)
#pragma unroll
    for (int r = 0; r < 16; ++r) o[dt][r] *= alpha;
  const bf16x8 p0 = pack8<0>(s), p1 = pack8<8>(s);
#pragma unroll
  for (int dt = 0; dt < 2; ++dt) { o[dt] = MFMA32(va[dt][0], p0, o[dt]); o[dt] = MFMA32(va[dt][1], p1, o[dt]); }
}

DI void ph_attnD(const Params& p, int layer, int* ctr, char* smem, int* s_pair) {
  float* imps = (float*)smem;
  float* impf = (float*)(smem + 16384);
  unsigned* smask = (unsigned*)(smem + 20480);
  unsigned* s_union = (unsigned*)(smem + 20480 + 128);
  const int tid = tid_opaque(), lane = tid & 63, h = tid >> 6, l31 = lane & 31, h2 = lane >> 5;
  for (;;) {
    __syncthreads();
    { int t0_ = threadIdx.x; asm volatile("" : "+v"(t0_)); if (t0_ == 0) *s_pair = atomicAdd(ctr, 2); }
    if (tid == 0) *s_union = 0u;
    __syncthreads();
    const int it = *s_pair + half_id();
    if (it >= 2048) break;
    const int b = it & 31, q0 = (63 - (it >> 5)) * 32;
    const int t = q0 + l31, cur = q0 >> 6;
    const size_t tok = (size_t)b * T + t;
    bf16x8 qf[4];
    {
      const bf16_t* qp = p.QD() + ((size_t)(b * 4 + h) * T + t) * 64 + h2 * 8;
#pragma unroll
      for (int ks = 0; ks < 4; ++ks) qf[ks] = *(const bf16x8*)(qp + ks * 16);
    }
    const float g0 = p.DG()[tok * 12 + h * 3 + 0], g1 = p.DG()[tok * 12 + h * 3 + 1], g2 = p.DG()[tok * 12 + h * 3 + 2];
    f32x16 ofin[2];
    {
      const bf16_t* Kc = p.KCMP() + (size_t)b * 128 * 64;
      const bf16_t* Vc = p.VCMPT() + (size_t)b * 64 * 128;
      const int nkt = min(4, (q0 >> 9) + 1);
      f32x16 o[2]; o[0] = zero16(); o[1] = zero16();
      float m = -1e30f, l = 0.f;
      for (int kt = 0; kt < nkt; ++kt) {
        f32x16 s = qk_tile(Kc + kt * 32 * 64, qf, l31, h2);
#pragma unroll
        for (int r = 0; r < 16; ++r) { const int n = kt * 32 + crow(r, h2); if (16 * n + 31 > t) s[r] = -INFINITY; }
        softmax_pv(s, Vc + kt * 32, 128, o, m, l, l31, h2);
      }
      const float il = l > 0.f ? 1.f / l : 0.f;
      const float gi = g0 * il;
#pragma unroll
      for (int dt = 0; dt < 2; ++dt)
#pragma unroll
        for (int r = 0; r < 16; ++r) ofin[dt][r] = gi * o[dt][r];
      float carry = 0.f;
#pragma unroll
      for (int kt = 0; kt < 4; ++kt) {
        f32x16 s;
        if (kt < nkt) {
          s = qk_tile(Kc + kt * 32 * 64, qf, l31, h2);
#pragma unroll
          for (int r = 0; r < 16; ++r) { const int n = kt * 32 + crow(r, h2); s[r] = (16 * n + 31 > t) ? 0.f : __expf(s[r] - m) * il; }
        } else s = zero16();
        float X[4];
#pragma unroll
        for (int g = 0; g < 4; ++g) X[g] = shx(s[4 * g + 3], 32);
#pragma unroll
        for (int g = 0; g < 4; ++g) {
          const float G = (s[4 * g] + s[4 * g + 1]) + (s[4 * g + 2] + s[4 * g + 3]);
          const float prev_other = g > 0 ? X[g - 1] : carry;
          imps[(h * 32 + l31) * 32 + 8 * kt + 2 * g + h2] = G + (h2 ? X[g] : prev_other);
        }
        carry = X[3];
      }
    }
    __syncthreads();
    {
      const int tt = tid >> 3, jg = tid & 7;
#pragma unroll
      for (int i = 0; i < 4; ++i) {
        const int j = jg * 4 + i;
        impf[tt * 32 + j] = (imps[(0 * 32 + tt) * 32 + j] + imps[(1 * 32 + tt) * 32 + j]) + (imps[(2 * 32 + tt) * 32 + j] + imps[(3 * 32 + tt) * 32 + j]);
      }
    }
    __syncthreads();
    {
      const int tt = tid >> 3, jg = tid & 7;
      float v[32];
#pragma unroll
      for (int j = 0; j < 32; ++j) {
        float x = impf[tt * 32 + j];
        if (j > cur) x = -1e30f; else if (j == 0 || j == cur || j == cur - 1) x = 1e6f;
        v[j] = x;
      }
      unsigned bits = 0u;
#pragma unroll
      for (int i = 0; i < 4; ++i) {
        int rank = 0; float vj = 0.f;
#pragma unroll
        for (int j = 0; j < 32; ++j) if (j == jg * 4 + i) vj = v[j];
        const int jj = jg * 4 + i;
#pragma unroll
        for (int j = 0; j < 32; ++j) rank += (v[j] > vj || (v[j] == vj && j < jj)) ? 1 : 0;
        if (rank < 8 && jj <= cur) bits |= 1u << jj;
      }
      bits |= shx(bits, 1); bits |= shx(bits, 2); bits |= shx(bits, 4);
      if (jg == 0) { smask[tt] = bits; atomicOr(s_union, bits); }
    }
    __syncthreads();
    {
      const unsigned mymask = smask[l31], uni = *s_union;
      const bf16_t* Ks = p.KV() + (size_t)(2 * NB + b) * T * 64;
      const bf16_t* Vs = p.KV() + (size_t)(3 * NB + b) * 64 * T;
      f32x16 o[2]; o[0] = zero16(); o[1] = zero16();
      float m = -1e30f, l = 0.f;
      for (int j = 0; j <= cur; ++j) {
        if (!((uni >> j) & 1u)) continue;
        const bool sel = (mymask >> j) & 1u;
        for (int half = 0; half < 2; ++half) {
          const int key0 = j * 64 + half * 32;
          if (key0 > q0 + 31) break;
          f32x16 s = qk_tile(Ks + (size_t)key0 * 64, qf, l31, h2);
#pragma unroll
          for (int r = 0; r < 16; ++r) { const int key = key0 + crow(r, h2); if (!sel || key > t) s[r] = -INFINITY; }
          softmax_pv(s, Vs + key0, T, o, m, l, l31, h2);
        }
      }
      const float il = l > 0.f ? g1 / l : 0.f;
#pragma unroll
      for (int dt = 0; dt < 2; ++dt)
#pragma unroll
        for (int r = 0; r < 16; ++r) ofin[dt][r] += il * o[dt][r];
    }
    {
      const bf16_t* Kw = p.KV() + (size_t)(4 * NB + b) * T * 64;
      const bf16_t* Vw = p.KV() + (size_t)(5 * NB + b) * 64 * T;
      f32x16 o[2]; o[0] = zero16(); o[1] = zero16();
      float m = -1e30f, l = 0.f;
      for (int key0 = max(0, q0 - 512); key0 <= q0; key0 += 32) {
        f32x16 s = qk_tile(Kw + (size_t)key0 * 64, qf, l31, h2);
        if (key0 == q0 - 512 || key0 == q0) {
#pragma unroll
          for (int r = 0; r < 16; ++r) { const int key = key0 + crow(r, h2); if (key > t || t - key >= 512) s[r] = -INFINITY; }
        }
        softmax_pv(s, Vw + key0, T, o, m, l, l31, h2);
      }
      const float il = l > 0.f ? g2 / l : 0.f;
#pragma unroll
      for (int dt = 0; dt < 2; ++dt)
#pragma unroll
        for (int r = 0; r < 16; ++r) ofin[dt][r] += il * o[dt][r];
    }
#pragma unroll
    for (int dt = 0; dt < 2; ++dt)
#pragma unroll
      for (int g = 0; g < 4; ++g) {
        const int d0 = dt * 32 + 8 * g + 4 * h2;
        const u32x2 gz = *(const u32x2*)(p.GZ() + (size_t)4 * NTOK * 256 + tok * 256 + h * 64 + d0);
        const float z0 = __uint_as_float(gz.x << 16), z1 = __uint_as_float(gz.x & 0xffff0000u), z2 = __uint_as_float(gz.y << 16), z3 = __uint_as_float(gz.y & 0xffff0000u);
        u32x2 o2 = {pack2(ofin[dt][4 * g] * z0, ofin[dt][4 * g + 1] * z1), pack2(ofin[dt][4 * g + 2] * z2, ofin[dt][4 * g + 3] * z3)};
        *(u32x2*)(p.YMIX() + tok * 1024 + 768 + h * 64 + d0) = o2;
      }
  }
}


DI float logsigmoidf_(float x) { return fminf(x, 0.f) - __logf(1.f + __expf(-fabsf(x))); }
DI void mlstm_gates(const Params& p, size_t tok0, int hh, float* bc, float* ig, int tid) {
  if (tid < 64) {
    const int s0 = 2 * tid;
    const float lf0 = logsigmoidf_(p.IFG()[(tok0 + s0) * 8 + 4 + hh]), lf1 = logsigmoidf_(p.IFG()[(tok0 + s0 + 1) * 8 + 4 + hh]);
    const float pair = lf0 + lf1;
    float x = pair;
#pragma unroll
    for (int off = 1; off < 64; off <<= 1) { const float y = shup(x, off); if (tid >= off) x += y; }
    const float excl = x - pair;
    bc[s0] = excl + lf0; bc[s0 + 1] = excl + pair;
    ig[s0] = p.IFG()[(tok0 + s0) * 8 + hh]; ig[s0 + 1] = p.IFG()[(tok0 + s0 + 1) * 8 + hh];
  }
}
DI void conv8(const bf16_t* raw, int t, int dg, const float (&cw)[4][8], const float (&cb)[8], float (&out)[8]) {
#pragma unroll
  for (int e = 0; e < 8; ++e) out[e] = cb[e];
#pragma unroll
  for (int j = 0; j < 4; ++j) {
    const int ts = t - 3 + j;
    if (ts >= 0) {
      const u32x4 row = *(const u32x4*)(raw + (size_t)ts * 64 + dg * 8);
#pragma unroll
      for (int e2 = 0; e2 < 4; ++e2) { out[2 * e2] += cw[j][2 * e2] * __uint_as_float(row[e2] << 16); out[2 * e2 + 1] += cw[j][2 * e2 + 1] * __uint_as_float(row[e2] & 0xffff0000u); }
    }
  }
#pragma unroll
  for (int e = 0; e < 8; ++e) out[e] = siluf_(out[e]);
}
DI void load_conv_w(const Params& p, int layer, int ch0, int dg, float (&cw)[4][8], float (&cb)[8]) {
#pragma unroll
  for (int j = 0; j < 4; ++j)
#pragma unroll
    for (int e = 0; e < 8; ++e) cw[j][e] = p.conv_w[layer * 2048 + j * 512 + ch0 + dg * 8 + e];
#pragma unroll
  for (int e = 0; e < 8; ++e) cb[e] = p.conv_b[layer * 512 + ch0 + dg * 8 + e];
}
DI void delta_state(const bf16_t* VT, const bf16_t* KT, float* out, int wid, int l31, int h2) {
  const int mt = wid >> 1, nt = wid & 1;
  f32x16 acc = zero16();
#pragma unroll
  for (int ks = 0; ks < 8; ++ks) {
    const bf16x8 a = *(const bf16x8*)(VT + (size_t)(mt * 32 + l31) * T + ks * 16 + h2 * 8);
    const bf16x8 bb = *(const bf16x8*)(KT + (nt * 32 + l31) * 136 + ks * 16 + h2 * 8);
    acc = MFMA32(a, bb, acc);
  }
#pragma unroll
  for (int r = 0; r < 16; ++r) out[(mt * 32 + crow(r, h2)) * 64 + nt * 32 + l31] = acc[r];
}
DI void ph_mlstm_local(const Params& p, int layer, int item, char* smem) {
  float* bc = (float*)smem; float* ig = bc + 128; float* wv = ig + 128;
  bf16_t* KwT = (bf16_t*)(smem + 2048);
  float* nred = (float*)(smem + 2048 + 64 * 136 * 2);
  const int tid = tid_opaque(), lane = tid & 63, wid = tid >> 6, l31 = lane & 31, h2 = lane >> 5;
  const int b = item >> 6, hh = (item >> 4) & 3, c = item & 15, t0 = c * 128;
  const size_t tok0 = (size_t)b * T + t0;
  __syncthreads();
  mlstm_gates(p, tok0, hh, bc, ig, tid);
  __syncthreads();
  if (tid < 128) wv[tid] = __expf(bc[127] - bc[tid] + ig[tid]);
  __syncthreads();
  {
    const int dg = tid & 7;
    float cw[4][8], cb[8];
    load_conv_w(p, layer, 256 + hh * 64, dg, cw, cb);
    const bf16_t* raw = p.QKB() + ((size_t)(b * 8 + 4 + hh) * T) * 64;
#pragma unroll
    for (int i = 0; i < 4; ++i) {
      const int s = (tid >> 3) + 32 * i;
      float v[8];
      conv8(raw, t0 + s, dg, cw, cb, v);
      const float w = wv[s];
#pragma unroll
      for (int e = 0; e < 8; ++e) KwT[(dg * 8 + e) * 136 + s] = f2bf(v[e] * w);
    }
  }
  __syncthreads();
  delta_state(p.VBT() + (size_t)(b * 4 + hh) * 64 * T + t0, KwT, p.BST() + (size_t)item * 4096, wid, l31, h2);
  {
    const int k = tid & 63, qd = tid >> 6;
    float a = 0.f;
#pragma unroll 8
    for (int s = 0; s < 32; ++s) a += bf2f(KwT[k * 136 + qd * 32 + s]);
    nred[qd * 64 + k] = a;
  }
  __syncthreads();
  if (tid < 64) p.BN()[(size_t)item * 64 + tid] = (nred[tid] + nred[64 + tid]) + (nred[128 + tid] + nred[192 + tid]);
  if (tid == 0) p.BG()[item] = bc[127];
}
DI void ph_mlstm_scan(const Params& p, int bh) {
  const int tid = tid_opaque();
  f32x4 C[4];
#pragma unroll
  for (int i = 0; i < 4; ++i) C[i] = (f32x4){0.f, 0.f, 0.f, 0.f};
  float n = 0.f;
  for (int c = 0; c < 16; ++c) {
    const int item = bh * 16 + c;
    const float g = __expf(p.BG()[item]);
    f32x4* ptr = (f32x4*)(p.BST() + (size_t)item * 4096 + tid * 16);
#pragma unroll
    for (int i = 0; i < 4; ++i) { const f32x4 tmp = ptr[i]; ptr[i] = C[i]; C[i] = g * C[i] + tmp; }
    if (tid < 64) { const float tmp = p.BN()[(size_t)item * 64 + tid]; p.BN()[(size_t)item * 64 + tid] = n; n = g * n + tmp; }
  }
}
DI f32x16 qk_tile_s(const bf16_t* Krow, int stride, const bf16x8 (&qf)[4], int l31, int h2) {
  f32x16 s = zero16();
  const bf16_t* kp = Krow + l31 * stride + h2 * 8;
#pragma unroll
  for (int ks = 0; ks < 4; ++ks) { const bf16x8 a = *(const bf16x8*)(kp + ks * 16); s = MFMA32(a, qf[ks], s); }
  return s;
}
DI void pv_only(const f32x16& s, const bf16_t* VTp, int vstride, f32x16 (&o)[2], int l31, int h2) {
  const bf16x8 p0 = pack8<0>(s), p1 = pack8<8>(s);
#pragma unroll
  for (int dt = 0; dt < 2; ++dt) {
    const bf16_t* vp = VTp + (size_t)(dt * 32 + l31) * vstride + 4 * h2;
    o[dt] = MFMA32(ld_frag8x2(vp), p0, o[dt]);
    o[dt] = MFMA32(ld_frag8x2(vp + 16), p1, o[dt]);
  }
}
DI bf16x8 frag_from_f32(const float* ptr) {
  const f32x4 a = *(const f32x4*)ptr, b = *(const f32x4*)(ptr + 4);
  u32x4 t = {pack2(a[0], a[1]), pack2(a[2], a[3]), pack2(b[0], b[1]), pack2(b[2], b[3])};
  return __builtin_bit_cast(bf16x8, t);
}
DI void ph_mlstm_out(const Params& p, int layer, int item, char* smem) {
  float* bc = (float*)smem; float* ig = bc + 128;
  bf16_t* qc = (bf16_t*)(smem + 2048);
  bf16_t* kc = qc + 128 * 72;
  const int tid = tid_opaque(), lane = tid & 63, wid = tid >> 6, l31 = lane & 31, h2 = lane >> 5;
  const int b = item >> 6, hh = (item >> 4) & 3, c = item & 15, t0 = c * 128;
  const size_t tok0 = (size_t)b * T + t0;
  __syncthreads();
  mlstm_gates(p, tok0, hh, bc, ig, tid);
  {
    const int dg = tid & 7;
#pragma unroll
    for (int which = 0; which < 2; ++which) {
      float cw[4][8], cb[8];
      load_conv_w(p, layer, which * 256 + hh * 64, dg, cw, cb);
      const bf16_t* raw = p.QKB() + ((size_t)(b * 8 + which * 4 + hh) * T) * 64;
      bf16_t* dst = which ? kc : qc;
      const float sc = which ? 1.f : 0.125f;
#pragma unroll
      for (int i = 0; i < 4; ++i) {
        const int s = (tid >> 3) + 32 * i;
        float v[8];
        conv8(raw, t0 + s, dg, cw, cb, v);
        u32x4 w = {pack2(v[0] * sc, v[1] * sc), pack2(v[2] * sc, v[3] * sc), pack2(v[4] * sc, v[5] * sc), pack2(v[6] * sc, v[7] * sc)};
        *(u32x4*)(dst + s * 72 + dg * 8) = w;
      }
    }
  }
  __syncthreads();
  if (tid < 128) ig[tid] = ig[tid] - bc[tid];
  __syncthreads();
  const int tq = 32 * wid + l31;
  bf16x8 qf[4];
#pragma unroll
  for (int ks = 0; ks < 4; ++ks) qf[ks] = *(const bf16x8*)(qc + tq * 72 + ks * 16 + h2 * 8);
  const float bt = bc[tq];
  f32x16 o[2]; o[0] = zero16(); o[1] = zero16();
  float dsum = 0.f;
  const bf16_t* VT = p.VBT() + (size_t)(b * 4 + hh) * 64 * T + t0;
  for (int kt = 0; kt <= wid; ++kt) {
    f32x16 s = qk_tile_s(kc + kt * 32 * 72, 72, qf, l31, h2);
#pragma unroll
    for (int r = 0; r < 16; ++r) {
      const int sidx = 32 * kt + crow(r, h2);
      float val = s[r] * __expf(bt + ig[sidx]);
      if (sidx > tq) val = 0.f;
      s[r] = val; dsum += val;
    }
    pv_only(s, VT + kt * 32, T, o, l31, h2);
  }
  dsum += shx(dsum, 32);
  const float* Cs = p.BST() + (size_t)item * 4096;
  const float* ns = p.BN() + (size_t)item * 64;
  f32x16 oi[2]; oi[0] = zero16(); oi[1] = zero16();
  float qn = 0.f;
#pragma unroll
  for (int ks = 0; ks < 4; ++ks) {
#pragma unroll
    for (int dt = 0; dt < 2; ++dt) oi[dt] = MFMA32(frag_from_f32(Cs + (dt * 32 + l31) * 64 + ks * 16 + h2 * 8), qf[ks], oi[dt]);
    const u32x4 qu = __builtin_bit_cast(u32x4, qf[ks]);
    const f32x4 n0 = *(const f32x4*)(ns + ks * 16 + h2 * 8), n1 = *(const f32x4*)(ns + ks * 16 + h2 * 8 + 4);
    qn += __uint_as_float(qu[0] << 16) * n0[0] + __uint_as_float(qu[0] & 0xffff0000u) * n0[1] + __uint_as_float(qu[1] << 16) * n0[2] + __uint_as_float(qu[1] & 0xffff0000u) * n0[3];
    qn += __uint_as_float(qu[2] << 16) * n1[0] + __uint_as_float(qu[2] & 0xffff0000u) * n1[1] + __uint_as_float(qu[3] << 16) * n1[2] + __uint_as_float(qu[3] & 0xffff0000u) * n1[3];
  }
  qn += shx(qn, 32);
  const float ebt = __expf(bt);
  const float den = dsum + ebt * qn;
  const float inv = 1.f / fmaxf(fabsf(den), 1.f);
  const size_t tok = tok0 + tq;
#pragma unroll
  for (int dt = 0; dt < 2; ++dt)
#pragma unroll
    for (int g = 0; g < 4; ++g) {
      const int d0 = dt * 32 + 8 * g + 4 * h2;
      const u32x2 g1 = *(const u32x2*)(p.GZ() + (size_t)1 * NTOK * 256 + tok * 256 + hh * 64 + d0);
      const u32x2 g2 = *(const u32x2*)(p.GZ() + (size_t)2 * NTOK * 256 + tok * 256 + hh * 64 + d0);
      float z[4] = {__uint_as_float(g1.x << 16) * __uint_as_float(g2.x << 16), __uint_as_float(g1.x & 0xffff0000u) * __uint_as_float(g2.x & 0xffff0000u),
                    __uint_as_float(g1.y << 16) * __uint_as_float(g2.y << 16), __uint_as_float(g1.y & 0xffff0000u) * __uint_as_float(g2.y & 0xffff0000u)};
      float hv[4];
#pragma unroll
      for (int i = 0; i < 4; ++i) hv[i] = (o[dt][4 * g + i] + ebt * oi[dt][4 * g + i]) * inv * z[i];
      u32x2 o2 = {pack2(hv[0], hv[1]), pack2(hv[2], hv[3])};
      *(u32x2*)(p.YMIX() + tok * 1024 + 256 + hh * 64 + d0) = o2;
    }
}


DI void ph_hgrn_local(const Params& p, int layer, int item, char* smem) {
  float* tot = (float*)smem;
  bf16_t* KdT = (bf16_t*)(smem + 1024);
  const int tid = tid_opaque(), lane = tid & 63, wid = tid >> 6, l31 = lane & 31, h2 = lane >> 5;
  const int b = item >> 6, hh = (item >> 4) & 3, c = item & 15, t0 = c * 128;
  const int k = tid & 63, qd = tid >> 6;
  float al[32], kk[32];
  {
    const float* gp = p.GC() + ((size_t)(b * 4 + hh) * T + t0 + 32 * qd) * 64 + k;
    float run = 0.f;
#pragma unroll
    for (int s = 0; s < 32; ++s) { const float g = gp[s * 64]; run += g; al[s] = run; kk[s] = 1.f - __expf(g); }
    __syncthreads();
    tot[qd * 64 + k] = run;
  }
  __syncthreads();
  float off = 0.f, aL = 0.f;
#pragma unroll
  for (int q = 0; q < 4; ++q) { const float v = tot[q * 64 + k]; aL += v; if (q < qd) off += v; }
#pragma unroll
  for (int s8 = 0; s8 < 4; ++s8) {
    float v[8];
#pragma unroll
    for (int e = 0; e < 8; ++e) v[e] = kk[s8 * 8 + e] * __expf(aL - (al[s8 * 8 + e] + off));
    u32x4 w = {pack2(v[0], v[1]), pack2(v[2], v[3]), pack2(v[4], v[5]), pack2(v[6], v[7])};
    *(u32x4*)(KdT + k * 136 + qd * 32 + s8 * 8) = w;
  }
  __syncthreads();
  delta_state(p.VCT() + (size_t)(b * 4 + hh) * 64 * T + t0, KdT, p.CST() + (size_t)item * 4096, wid, l31, h2);
  if (qd == 0) p.CAL()[(size_t)item * 64 + k] = aL;
}
DI void ph_hgrn_scan(const Params& p, int bh) {
  const int tid = tid_opaque();
  f32x4 S[4];
#pragma unroll
  for (int i = 0; i < 4; ++i) S[i] = (f32x4){0.f, 0.f, 0.f, 0.f};
  for (int c = 0; c < 16; ++c) {
    const int item = bh * 16 + c;
    const f32x4* dp = (const f32x4*)(p.CAL() + (size_t)item * 64 + (tid & 3) * 16);
    f32x4* ptr = (f32x4*)(p.CST() + (size_t)item * 4096 + tid * 16);
#pragma unroll
    for (int i = 0; i < 4; ++i) {
      const f32x4 a = dp[i];
      const f32x4 dec = {__expf(a[0]), __expf(a[1]), __expf(a[2]), __expf(a[3])};
      const f32x4 tmp = ptr[i]; ptr[i] = S[i]; S[i] = dec * S[i] + tmp;
    }
  }
}
DI void ph_hgrn_out(const Params& p, int layer, int item, char* smem) {
  float* a_lds = (float*)smem;
  float* tot = (float*)(smem + 128 * 68 * 4);
  const int tid = tid_opaque(), lane = tid & 63, wid = tid >> 6, l31 = lane & 31, h2 = lane >> 5;
  const int b = item >> 6, hh = (item >> 4) & 3, c = item & 15, t0 = c * 128;
  const size_t hbase = (size_t)(b * 4 + hh) * T + t0;
  {
    const int k = tid & 63, qd = tid >> 6;
    float al[32];
    const float* gp = p.GC() + (hbase + 32 * qd) * 64 + k;
    float run = 0.f;
#pragma unroll
    for (int s = 0; s < 32; ++s) { run += gp[s * 64]; al[s] = run; }
    __syncthreads();
    tot[qd * 64 + k] = run;
    __syncthreads();
    float off = 0.f;
#pragma unroll
    for (int q = 0; q < 4; ++q) { const float v = tot[q * 64 + k]; if (q < qd) off += v; }
#pragma unroll
    for (int s = 0; s < 32; ++s) a_lds[(32 * qd + s) * 68 + k] = al[s] + off;
  }
  __syncthreads();
  const int tq = 32 * wid + l31;
  bf16x8 qi[4], qh[4];
#pragma unroll
  for (int ks = 0; ks < 4; ++ks) {
    const int k0 = ks * 16 + h2 * 8;
    const u32x4 qu = *(const u32x4*)(p.QC() + (hbase + tq) * 64 + k0);
    float q8[8], e1[8], e2[8];
#pragma unroll
    for (int e2i = 0; e2i < 4; ++e2i) { q8[2 * e2i] = __uint_as_float(qu[e2i] << 16); q8[2 * e2i + 1] = __uint_as_float(qu[e2i] & 0xffff0000u); }
#pragma unroll
    for (int e = 0; e < 8; ++e) {
      const float a = a_lds[tq * 68 + k0 + e];
      const float r = wid > 0 ? a_lds[(32 * wid - 1) * 68 + k0 + e] : 0.f;
      e1[e] = q8[e] * __expf(a - r); e2[e] = q8[e] * __expf(a);
    }
    u32x4 w1 = {pack2(e1[0], e1[1]), pack2(e1[2], e1[3]), pack2(e1[4], e1[5]), pack2(e1[6], e1[7])};
    u32x4 w2 = {pack2(e2[0], e2[1]), pack2(e2[2], e2[3]), pack2(e2[4], e2[5]), pack2(e2[6], e2[7])};
    qi[ks] = __builtin_bit_cast(bf16x8, w1); qh[ks] = __builtin_bit_cast(bf16x8, w2);
  }
  f32x16 o[2]; o[0] = zero16(); o[1] = zero16();
  const bf16_t* VT = p.VCT() + (size_t)(b * 4 + hh) * 64 * T + t0;
  for (int kt = 0; kt <= wid; ++kt) {
    f32x16 s = zero16();
    const int srow = 32 * kt + l31;
#pragma unroll
    for (int ks = 0; ks < 4; ++ks) {
      const int k0 = ks * 16 + h2 * 8;
      const f32x4 g0 = *(const f32x4*)(p.GC() + (hbase + srow) * 64 + k0), g1 = *(const f32x4*)(p.GC() + (hbase + srow) * 64 + k0 + 4);
      float v[8];
#pragma unroll
      for (int e = 0; e < 8; ++e) {
        const float g = e < 4 ? g0[e] : g1[e - 4];
        const float a = a_lds[srow * 68 + k0 + e];
        const float r = wid > 0 ? a_lds[(32 * wid - 1) * 68 + k0 + e] : 0.f;
        v[e] = (1.f - __expf(g)) * __expf(fminf(r - a, 80.f));
      }
      u32x4 w = {pack2(v[0], v[1]), pack2(v[2], v[3]), pack2(v[4], v[5]), pack2(v[6], v[7])};
      s = MFMA32(__builtin_bit_cast(bf16x8, w), qi[ks], s);
    }
    if (kt == wid) {
#pragma unroll
      for (int r = 0; r < 16; ++r) if (32 * kt + crow(r, h2) > tq) s[r] = 0.f;
    }
    pv_only(s, VT + kt * 32, T, o, l31, h2);
  }
  {
    const float* Ss = p.CST() + (size_t)item * 4096;
#pragma unroll
    for (int ks = 0; ks < 4; ++ks)
#pragma unroll
      for (int dt = 0; dt < 2; ++dt) o[dt] = MFMA32(frag_from_f32(Ss + (dt * 32 + l31) * 64 + ks * 16 + h2 * 8), qh[ks], o[dt]);
  }
  float ss = 0.f;
#pragma unroll
  for (int dt = 0; dt < 2; ++dt)
#pragma unroll
    for (int r = 0; r < 16; ++r) ss += o[dt][r] * o[dt][r];
  ss += shx(ss, 32);
  const float rs = rsqrtf(ss * (1.f / 64.f) + 1e-6f);
  const size_t tok = (size_t)b * T + t0 + tq;
#pragma unroll
  for (int dt = 0; dt < 2; ++dt)
#pragma unroll
    for (int g = 0; g < 4; ++g) {
      const int d0 = dt * 32 + 8 * g + 4 * h2;
      const u32x2 gz = *(const u32x2*)(p.GZ() + (size_t)3 * NTOK * 256 + tok * 256 + hh * 64 + d0);
      const f32x4 gn = *(const f32x4*)(p.c_norm_g + layer * 256 + hh * 64 + d0);
      const float z0 = __uint_as_float(gz.x << 16), z1 = __uint_as_float(gz.x & 0xffff0000u), z2 = __uint_as_float(gz.y << 16), z3 = __uint_as_float(gz.y & 0xffff0000u);
      u32x2 o2 = {pack2(o[dt][4 * g] * rs * gn[0] * z0, o[dt][4 * g + 1] * rs * gn[1] * z1), pack2(o[dt][4 * g + 2] * rs * gn[2] * z2, o[dt][4 * g + 3] * rs * gn[3] * z3)};
      *(u32x2*)(p.YMIX() + tok * 1024 + 512 + hh * 64 + d0) = o2;
    }
}


DI void ph_attnA(const Params& p, int layer, int item, char* smem) {
  const int tid = tid_opaque(), lane = tid & 63, h = tid >> 6, l31 = lane & 31, h2 = lane >> 5;
  const int b = item >> 6, q0 = (item & 63) * 32, g = h >> 1;
  const int t = q0 + l31;
  const size_t tok = (size_t)b * T + t;
  bf16x8 qf[4];
  {
    const bf16_t* qp = p.QA() + ((size_t)(b * 4 + h) * T + t) * 64 + h2 * 8;
#pragma unroll
    for (int ks = 0; ks < 4; ++ks) qf[ks] = *(const bf16x8*)(qp + ks * 16);
  }
  const bf16_t* Kp = p.KA() + (size_t)(b * 2 + g) * T * 64;
  const bf16_t* Vp = p.VAT() + (size_t)(b * 2 + g) * 64 * T;
  f32x16 o[2]; o[0] = zero16(); o[1] = zero16();
  float m = -1e30f, l = 0.f;
  for (int key0 = max(0, q0 - 128); key0 <= q0; key0 += 32) {
    f32x16 s = qk_tile(Kp + (size_t)key0 * 64, qf, l31, h2);
    if (key0 == q0 - 128 || key0 == q0) {
#pragma unroll
      for (int r = 0; r < 16; ++r) { const int key = key0 + crow(r, h2); if (key > t || t - key >= 128) s[r] = -INFINITY; }
    }
    softmax_pv(s, Vp + key0, T, o, m, l, l31, h2);
  }
  const float sink = p.a_sinks[layer * 4 + h];
  const float M = fmaxf(m, sink);
  const float sc = __expf(m - M);
  const float inv = sc / (l * sc + __expf(sink - M));
#pragma unroll
  for (int dt = 0; dt < 2; ++dt)
#pragma unroll
    for (int gq = 0; gq < 4; ++gq) {
      const int d0 = dt * 32 + 8 * gq + 4 * h2;
      const u32x2 gz = *(const u32x2*)(p.GZ() + tok * 256 + h * 64 + d0);
      const float z0 = __uint_as_float(gz.x << 16), z1 = __uint_as_float(gz.x & 0xffff0000u), z2 = __uint_as_float(gz.y << 16), z3 = __uint_as_float(gz.y & 0xffff0000u);
      u32x2 o2 = {pack2(o[dt][4 * gq] * inv * z0, o[dt][4 * gq + 1] * inv * z1), pack2(o[dt][4 * gq + 2] * inv * z2, o[dt][4 * gq + 3] * inv * z3)};
      *(u32x2*)(p.YMIX() + tok * 1024 + h * 64 + d0) = o2;
    }
}

DI void ph_cmp(const Params& p, int layer, int item, char* smem) {
  float* red = (float*)smem;
  bf16_t* hid = (bf16_t*)(smem + 32768);
  const int tid = tid_opaque(), lane = tid & 63, wid = tid >> 6, l31 = lane & 31, h2 = lane >> 5;
  const int b = item >> 3, kvsel = (item >> 2) & 1, mt = item & 3;
  const int lk = layer * 2 + kvsel;
  const int n = min(mt * 32 + l31, 126);
  const bf16_t* src = p.KV() + ((size_t)(kvsel * NB + b) * T + 16 * n) * 64 + wid * 512 + h2 * 8;
  const bf16_t* w1t = p.W1T() + (size_t)lk * 64 * 2048 + wid * 512 + h2 * 8;
  f32x16 acc[2]; acc[0] = zero16(); acc[1] = zero16();
#pragma unroll 4
  for (int ks = 0; ks < 32; ++ks) {
    const bf16x8 a = *(const bf16x8*)(src + ks * 16);
    const bf16x8 b0 = *(const bf16x8*)(w1t + (size_t)l31 * 2048 + ks * 16);
    const bf16x8 b1 = *(const bf16x8*)(w1t + (size_t)(32 + l31) * 2048 + ks * 16);
    acc[0] = MFMA32(a, b0, acc[0]); acc[1] = MFMA32(a, b1, acc[1]);
  }
  __syncthreads();
#pragma unroll
  for (int nt = 0; nt < 2; ++nt)
#pragma unroll
    for (int r = 0; r < 16; ++r) red[(wid * 32 + crow(r, h2)) * 64 + nt * 32 + l31] = acc[nt][r];
  __syncthreads();
  {
    const int row = tid >> 3, c0 = (tid & 7) * 8;
    float v[8];
#pragma unroll
    for (int e = 0; e < 8; ++e) {
      const float x = (red[(0 * 32 + row) * 64 + c0 + e] + red[(1 * 32 + row) * 64 + c0 + e]) + (red[(2 * 32 + row) * 64 + c0 + e] + red[(3 * 32 + row) * 64 + c0 + e]) + p.CVEC()[lk * 64 + c0 + e];
      v[e] = siluf_(x);
    }
    u32x4 w = {pack2(v[0], v[1]), pack2(v[2], v[3]), pack2(v[4], v[5]), pack2(v[6], v[7])};
    *(u32x4*)(hid + row * 72 + c0) = w;
  }
  __syncthreads();
  if (wid == 0) {
    f32x16 o[2]; o[0] = zero16(); o[1] = zero16();
    const bf16_t* w2t = p.W2T() + (size_t)lk * 4096;
#pragma unroll
    for (int ks = 0; ks < 4; ++ks) {
      const bf16x8 a = *(const bf16x8*)(hid + l31 * 72 + ks * 16 + h2 * 8);
#pragma unroll
      for (int nt = 0; nt < 2; ++nt) o[nt] = MFMA32(a, *(const bf16x8*)(w2t + (nt * 32 + l31) * 64 + ks * 16 + h2 * 8), o[nt]);
    }
    if (kvsel == 0) {
#pragma unroll
      for (int r = 0; r < 16; ++r) {
        const int nn = mt * 32 + crow(r, h2);
        if (nn < 127) {
          const int pos = 16 * nn + 31;
          const float cs = p.ROPEC()[pos * 32 + l31], sn = p.ROPES()[pos * 32 + l31];
          p.KCMP()[((size_t)b * 128 + nn) * 64 + l31] = f2bf(o[0][r] * cs - o[1][r] * sn);
          p.KCMP()[((size_t)b * 128 + nn) * 64 + 32 + l31] = f2bf(o[0][r] * sn + o[1][r] * cs);
        }
      }
    } else {
#pragma unroll
      for (int nt = 0; nt < 2; ++nt)
#pragma unroll
        for (int r = 0; r < 16; ++r) {
          const int nn = mt * 32 + crow(r, h2);
          if (nn < 127) p.VCMPT()[((size_t)b * 64 + nt * 32 + l31) * 128 + nn] = f2bf(o[nt][r]);
        }
    }
  }
}


#define XB_TMO      128
#define XB_XCNT(j)  (256  + 64 * (j))
#define XB_XSUB(j)  (1280 + 64 * (j))
#define XB_XGEN(j)  (2304 + 64 * (j))
#define XB_TOP      3328
#define XB_TOPGEN   3392
#define XCD_BAR_WORDS 3456
#define XB_SPIN_CAP (1u << 22)
DI unsigned xb_ld(unsigned* p)              { return __hip_atomic_load(p, __ATOMIC_RELAXED, __HIP_MEMORY_SCOPE_AGENT); }
DI unsigned xb_add(unsigned* p, unsigned v) { return __hip_atomic_fetch_add(p, v, __ATOMIC_RELAXED, __HIP_MEMORY_SCOPE_AGENT); }
DI unsigned xb_xcc_id() { return (unsigned)__builtin_amdgcn_s_getreg((3 << 11) | 20) & 0xFu; }
#define XB_SPIN(cond, bar) do { unsigned _sp = 0; while (cond) { __builtin_amdgcn_s_sleep(1); \
    if ((++_sp & 255u) == 0u) { if (xb_ld(&(bar)[XB_TMO])) break; if (_sp > XB_SPIN_CAP) { atomicAdd(&(bar)[XB_TMO], 1u); break; } } } } while (0)
struct XcdBarrier { unsigned* bar; unsigned x; volatile LAS unsigned* st; };
DI XcdBarrier xcd_barrier_post(unsigned* bar, volatile LAS unsigned* st) {
  XcdBarrier b; b.bar = bar; b.x = xb_xcc_id(); b.st = st;
  if (threadIdx.x == 0) (void)xb_add(&bar[XB_XCNT(b.x)], 1u);
  return b;
}
DI void xcd_barrier_complete(unsigned* bar, unsigned x, unsigned& nloc, unsigned& nx) {
  const unsigned G = gridDim.x * gridDim.y * gridDim.z;
  unsigned sum, cnt, mine, sp = 0u;
  for (;;) {
    sum = 0u; cnt = 0u; mine = 0u;
#pragma unroll
    for (unsigned j = 0; j < 16; ++j) { const unsigned c = xb_ld(&bar[XB_XCNT(j)]); sum += c; cnt += (c > 0u) ? 1u : 0u; mine = (j == x) ? c : mine; }
    if (sum == G) break;
    __builtin_amdgcn_s_sleep(1);
    if ((++sp & 255u) == 0u) { if (xb_ld(&bar[XB_TMO])) break; if (sp > XB_SPIN_CAP) { atomicAdd(&bar[XB_TMO], 1u); break; } }
  }
  nloc = mine > 0u ? mine : 1u; nx = cnt > 0u ? cnt : 1u;
}
DI void xcd_barrier(const XcdBarrier& b) {
  asm volatile("s_waitcnt vmcnt(0)" ::: "memory");
  __syncthreads();
  int t0_ = threadIdx.x; asm volatile("" : "+v"(t0_));
  if (t0_ == 0) {
    unsigned* bar = b.bar;
    __builtin_amdgcn_s_waitcnt(0);
    unsigned nloc = b.st[0], nx = b.st[1];
    if (nloc == 0u) { xcd_barrier_complete(bar, b.x, nloc, nx); b.st[0] = nloc; b.st[1] = nx; }
    const unsigned old = xb_add(&bar[XB_XSUB(b.x)], 1u);
    const unsigned gen = old / nloc;
    if (old + 1u == (gen + 1u) * nloc) {
      __builtin_amdgcn_fence(__ATOMIC_RELEASE, "agent");
      asm volatile("s_waitcnt vmcnt(0)" ::: "memory");
      const unsigned og = xb_add(&bar[XB_TOP], 1u);
      const unsigned tg = og / nx;
      if (og + 1u == (tg + 1u) * nx) xb_add(&bar[XB_TOPGEN], 1u);
      else XB_SPIN(xb_ld(&bar[XB_TOPGEN]) == tg, bar);
      __builtin_amdgcn_fence(__ATOMIC_ACQUIRE, "agent");
      xb_add(&bar[XB_XGEN(b.x)], 1u);
      asm volatile("s_waitcnt vmcnt(0)" ::: "memory");
    } else {
      XB_SPIN(xb_ld(&bar[XB_XGEN(b.x)]) == gen, bar);
      __builtin_amdgcn_fence(__ATOMIC_ACQUIRE, "agent");
      asm volatile("s_waitcnt vmcnt(0)" ::: "memory");
    }
  }
  __syncthreads();
}

constexpr int HALF_LDS = 40960;
__global__ void __launch_bounds__(512) mega(Params p) {
  __shared__ __attribute__((aligned(16))) char smem_all[131072 + 32];
  cg::grid_group grid = cg::this_grid();
  const int half = half_id();
  const int bid = blockIdx.x, nblk = gridDim.x;
  const int vbid = 2 * bid + half, nvblk = 2 * nblk;
  char* smem = smem_all + half * HALF_LDS;
  unsigned* xbw = (unsigned*)(smem_all + 131072);
  int* s_pair = (int*)(smem_all + 131072 + 16);
  if (threadIdx.x == 0) { xbw[0] = 0u; xbw[1] = 0u; }
  __syncthreads();
  const XcdBarrier xb = xcd_barrier_post(p.XBAR(), (volatile LAS unsigned*)xbw);
  ph_prologue(p, vbid, nvblk, smem);
  ln_rows(p, 0, 0, vbid, nvblk);
  if (PROBE == 5) { ph_prologue(p, vbid, nvblk, smem); ln_rows(p, 0, 0, vbid, nvblk); }
  grid.sync();
  for (int l = 0; l < 2; ++l) {
    ph_gemm_in(p, l, bid, nblk, smem_all);
    if (PROBE == 1) ph_gemm_in(p, l, bid, nblk, smem_all);
    xcd_barrier(xb);
    for (int rep = 0; rep < (PROBE == 3 ? 2 : 1); ++rep) {
    for (int item = vbid; item < 2048; item += nvblk) ph_mlstm_local(p, l, item, smem);
    for (int item = vbid; item < 2048; item += nvblk) ph_hgrn_local(p, l, item, smem);
    __syncthreads();
    for (int item = vbid; item < 256; item += nvblk) ph_cmp(p, l, item, smem);
    for (int item = vbid; item < 2048; item += nvblk) ph_attnA(p, l, item, smem);
    }
    xcd_barrier(xb);
    if (vbid < 128) ph_mlstm_scan(p, vbid);
    else if (vbid < 256) ph_hgrn_scan(p, vbid - 128);
    __syncthreads();
    ph_attnD(p, l, p.CTR() + l, smem, s_pair);
    if (PROBE == 2) ph_attnD(p, l, p.CTR() + 2 + l, smem, s_pair);
    xcd_barrier(xb);
    for (int rep = 0; rep < (PROBE == 4 ? 2 : 1); ++rep) {
    for (int item = vbid; item < 2048; item += nvblk) ph_mlstm_out(p, l, item, smem);
    for (int item = vbid; item < 2048; item += nvblk) ph_hgrn_out(p, l, item, smem);
    }
    xcd_barrier(xb);
    ph_gemm_out_ln(p, l, bid, nblk, smem_all);
    if (l == 0) xcd_barrier(xb);
  }
}

static inline size_t align_up(size_t v) { return (v + 255) & ~(size_t)255; }

extern "C" void kernel_launch(void* const* d_in, const int* in_sizes, int n_in, void* d_out, int out_size, void* d_ws, size_t ws_size, hipStream_t stream) {
  Params p{};
  p.x = (const float*)d_in[0]; p.ln0_g = (const float*)d_in[1]; p.ln0_b = (const float*)d_in[2]; p.w_in = (const float*)d_in[3];
  p.b_in = (const float*)d_in[4]; p.a_sinks = (const float*)d_in[5]; p.conv_w = (const float*)d_in[6]; p.conv_b = (const float*)d_in[7];
  p.c_lb = (const float*)d_in[8]; p.c_norm_g = (const float*)d_in[9]; p.pe = (const float*)d_in[10]; p.w1 = (const float*)d_in[11];
  p.w2 = (const float*)d_in[12]; p.w_out = (const float*)d_in[13]; p.ln_g = (const float*)d_in[14]; p.ln_b = (const float*)d_in[15];
  p.hf = (float*)d_out;
  p.ws = (char*)d_ws;
  if (WS_TOTAL > ws_size) { fprintf(stderr, "workspace too small: need %zu have %zu\n", (size_t)WS_TOTAL, ws_size); return; }

  static int grid_blocks = 0;
  if (!grid_blocks) {
    int dev = 0, cus = 0, per_cu = 0;
    (void)hipGetDevice(&dev);
    (void)hipDeviceGetAttribute(&cus, hipDeviceAttributeMultiprocessorCount, dev);
    (void)hipOccupancyMaxActiveBlocksPerMultiprocessor(&per_cu, mega, 512, 0);
    if (per_cu > 1) per_cu = 1;
    grid_blocks = cus * per_cu;
  }
  (void)hipMemsetAsync((char*)d_ws + OFF_XBAR, 0, XCD_BAR_WORDS * 4, stream);
  void* args[] = {&p};
  hipError_t e = hipLaunchCooperativeKernel((void*)mega, dim3(grid_blocks), dim3(512), args, 0, stream);
  if (e != hipSuccess) fprintf(stderr, "cooperative launch failed: %s (grid %d)\n", hipGetErrorString(e), grid_blocks);
}
```

```cpp
#include <hip/hip_runtime.h>
#include <hip/hip_cooperative_groups.h>
#include <stdio.h>
#include <stdint.h>
#include <stddef.h>

#ifndef PROBE
#define PROBE 0
#endif
#define DI __device__ __forceinline__
typedef unsigned short bf16_t;
typedef short bf16x8 __attribute__((ext_vector_type(8)));
typedef float f32x16 __attribute__((ext_vector_type(16)));
typedef unsigned u32x4 __attribute__((ext_vector_type(4)));
typedef float f32x4 __attribute__((ext_vector_type(4)));

constexpr int NB = 32, T = 2048, DM = 1024, NTOK = NB * T, NP = 4096;
constexpr float DN_ALPHA = 1.41421356237309515f;

constexpr size_t OFF_HB = 0;
constexpr size_t SZ_HB = (size_t)NTOK * 1024 * 2;
constexpr size_t OFF_YMIX = OFF_HB + ((SZ_HB + 255) & ~(size_t)255);
constexpr size_t SZ_YMIX = (size_t)NTOK * 1024 * 2;
constexpr size_t OFF_QA = OFF_YMIX + ((SZ_YMIX + 255) & ~(size_t)255);
constexpr size_t SZ_QA = (size_t)NTOK * 256 * 2;
constexpr size_t OFF_KA = OFF_QA + ((SZ_QA + 255) & ~(size_t)255);
constexpr size_t SZ_KA = (size_t)NTOK * 128 * 2;
constexpr size_t OFF_VAT = OFF_KA + ((SZ_KA + 255) & ~(size_t)255);
constexpr size_t SZ_VAT = (size_t)NTOK * 128 * 2;
constexpr size_t OFF_QKB = OFF_VAT + ((SZ_VAT + 255) & ~(size_t)255);
constexpr size_t SZ_QKB = (size_t)NTOK * 512 * 2;
constexpr size_t OFF_VBT = OFF_QKB + ((SZ_QKB + 255) & ~(size_t)255);
constexpr size_t SZ_VBT = (size_t)NTOK * 256 * 2;
constexpr size_t OFF_QC = OFF_VBT + ((SZ_VBT + 255) & ~(size_t)255);
constexpr size_t SZ_QC = (size_t)NTOK * 256 * 2;
constexpr size_t OFF_GC = OFF_QC + ((SZ_QC + 255) & ~(size_t)255);
constexpr size_t SZ_GC = (size_t)NTOK * 256 * 4;
constexpr size_t OFF_VCT = OFF_GC + ((SZ_GC + 255) & ~(size_t)255);
constexpr size_t SZ_VCT = (size_t)NTOK * 256 * 2;
constexpr size_t OFF_QD = OFF_VCT + ((SZ_VCT + 255) & ~(size_t)255);
constexpr size_t SZ_QD = (size_t)NTOK * 256 * 2;
constexpr size_t OFF_KV = OFF_QD + ((SZ_QD + 255) & ~(size_t)255);
constexpr size_t SZ_KV = (size_t)NTOK * 384 * 2;
constexpr size_t OFF_GZ = OFF_KV + ((SZ_KV + 255) & ~(size_t)255);
constexpr size_t SZ_GZ = (size_t)NTOK * 1280 * 2;
constexpr size_t OFF_IFG = OFF_GZ + ((SZ_GZ + 255) & ~(size_t)255);
constexpr size_t SZ_IFG = (size_t)NTOK * 8 * 4;
constexpr size_t OFF_DG = OFF_IFG + ((SZ_IFG + 255) & ~(size_t)255);
constexpr size_t SZ_DG = (size_t)NTOK * 12 * 4;
constexpr size_t OFF_WT = OFF_DG + ((SZ_DG + 255) & ~(size_t)255);
constexpr size_t SZ_WT = (size_t)2 * NP * 1024 * 2;
constexpr size_t OFF_WOT = OFF_WT + ((SZ_WT + 255) & ~(size_t)255);
constexpr size_t SZ_WOT = (size_t)2 * 1024 * 1024 * 2;
constexpr size_t OFF_KCMP = OFF_WOT + ((SZ_WOT + 255) & ~(size_t)255);
constexpr size_t SZ_KCMP = (size_t)NB * 128 * 64 * 2;
constexpr size_t OFF_VCMPT = OFF_KCMP + ((SZ_KCMP + 255) & ~(size_t)255);
constexpr size_t SZ_VCMPT = (size_t)NB * 64 * 128 * 2;
constexpr size_t OFF_BIASP = OFF_VCMPT + ((SZ_VCMPT + 255) & ~(size_t)255);
constexpr size_t SZ_BIASP = (size_t)2 * NP * 4;
constexpr size_t OFF_LB = OFF_BIASP + ((SZ_BIASP + 255) & ~(size_t)255);
constexpr size_t SZ_LB = (size_t)512 * 4;
constexpr size_t OFF_ROPEC = OFF_LB + ((SZ_LB + 255) & ~(size_t)255);
constexpr size_t SZ_ROPEC = (size_t)T * 32 * 4;
constexpr size_t OFF_ROPES = OFF_ROPEC + ((SZ_ROPEC + 255) & ~(size_t)255);
constexpr size_t SZ_ROPES = (size_t)T * 32 * 4;
constexpr size_t OFF_BST = OFF_ROPES + ((SZ_ROPES + 255) & ~(size_t)255);
constexpr size_t SZ_BST = (size_t)2048 * 4096 * 4;
constexpr size_t OFF_BN = OFF_BST + ((SZ_BST + 255) & ~(size_t)255);
constexpr size_t SZ_BN = (size_t)2048 * 64 * 4;
constexpr size_t OFF_BG = OFF_BN + ((SZ_BN + 255) & ~(size_t)255);
constexpr size_t SZ_BG = (size_t)2048 * 4;
constexpr size_t OFF_CST = OFF_BG + ((SZ_BG + 255) & ~(size_t)255);
constexpr size_t SZ_CST = (size_t)2048 * 4096 * 4;
constexpr size_t OFF_CAL = OFF_CST + ((SZ_CST + 255) & ~(size_t)255);
constexpr size_t SZ_CAL = (size_t)2048 * 64 * 4;
constexpr size_t OFF_W1T = OFF_CAL + ((SZ_CAL + 255) & ~(size_t)255);
constexpr size_t SZ_W1T = (size_t)4 * 64 * 2048 * 2;
constexpr size_t OFF_W2T = OFF_W1T + ((SZ_W1T + 255) & ~(size_t)255);
constexpr size_t SZ_W2T = (size_t)4 * 64 * 64 * 2;
constexpr size_t OFF_CVEC = OFF_W2T + ((SZ_W2T + 255) & ~(size_t)255);
constexpr size_t SZ_CVEC = (size_t)256 * 4;
constexpr size_t OFF_CTR = OFF_CVEC + ((SZ_CVEC + 255) & ~(size_t)255);
constexpr size_t SZ_CTR = (size_t)256;
constexpr size_t OFF_XBAR = OFF_CTR + ((SZ_CTR + 255) & ~(size_t)255);
constexpr size_t SZ_XBAR = (size_t)3456 * 4;
constexpr size_t WS_TOTAL = OFF_XBAR + ((SZ_XBAR + 255) & ~(size_t)255);
struct Params {
  const float *x, *ln0_g, *ln0_b, *w_in, *b_in, *a_sinks, *conv_w, *conv_b, *c_lb, *c_norm_g, *pe, *w1, *w2, *w_out, *ln_g, *ln_b;
  float* hf;
  char* ws;
  DI bf16_t* HB() const { return (bf16_t*)(ws + OFF_HB); }
  DI bf16_t* YMIX() const { return (bf16_t*)(ws + OFF_YMIX); }
  DI bf16_t* QA() const { return (bf16_t*)(ws + OFF_QA); }
  DI bf16_t* KA() const { return (bf16_t*)(ws + OFF_KA); }
  DI bf16_t* VAT() const { return (bf16_t*)(ws + OFF_VAT); }
  DI bf16_t* QKB() const { return (bf16_t*)(ws + OFF_QKB); }
  DI bf16_t* VBT() const { return (bf16_t*)(ws + OFF_VBT); }
  DI bf16_t* QC() const { return (bf16_t*)(ws + OFF_QC); }
  DI float* GC() const { return (float*)(ws + OFF_GC); }
  DI bf16_t* VCT() const { return (bf16_t*)(ws + OFF_VCT); }
  DI bf16_t* QD() const { return (bf16_t*)(ws + OFF_QD); }
  DI bf16_t* KV() const { return (bf16_t*)(ws + OFF_KV); }
  DI bf16_t* GZ() const { return (bf16_t*)(ws + OFF_GZ); }
  DI float* IFG() const { return (float*)(ws + OFF_IFG); }
  DI float* DG() const { return (float*)(ws + OFF_DG); }
  DI bf16_t* WT() const { return (bf16_t*)(ws + OFF_WT); }
  DI bf16_t* WOT() const { return (bf16_t*)(ws + OFF_WOT); }
  DI bf16_t* KCMP() const { return (bf16_t*)(ws + OFF_KCMP); }
  DI bf16_t* VCMPT() const { return (bf16_t*)(ws + OFF_VCMPT); }
  DI float* BIASP() const { return (float*)(ws + OFF_BIASP); }
  DI float* LB() const { return (float*)(ws + OFF_LB); }
  DI float* ROPEC() const { return (float*)(ws + OFF_ROPEC); }
  DI float* ROPES() const { return (float*)(ws + OFF_ROPES); }
  DI float* BST() const { return (float*)(ws + OFF_BST); }
  DI float* BN() const { return (float*)(ws + OFF_BN); }
  DI float* BG() const { return (float*)(ws + OFF_BG); }
  DI float* CST() const { return (float*)(ws + OFF_CST); }
  DI float* CAL() const { return (float*)(ws + OFF_CAL); }
  DI bf16_t* W1T() const { return (bf16_t*)(ws + OFF_W1T); }
  DI bf16_t* W2T() const { return (bf16_t*)(ws + OFF_W2T); }
  DI float* CVEC() const { return (float*)(ws + OFF_CVEC); }
  DI int* CTR() const { return (int*)(ws + OFF_CTR); }
  DI unsigned* XBAR() const { return (unsigned*)(ws + OFF_XBAR); }
};
namespace cg = cooperative_groups;

DI int tid_opaque() { int t = threadIdx.x & 255; asm volatile("" : "+v"(t)); return t; }
DI int half_id() { return __builtin_amdgcn_readfirstlane((int)(threadIdx.x >> 8)); }
DI float bf2f(bf16_t v) { return __uint_as_float(((unsigned)v) << 16); }
DI bf16_t f2bf(float x) { unsigned u = __float_as_uint(x); u += 0x7fffu + ((u >> 16) & 1u); return (bf16_t)(u >> 16); }
DI float sigmoidf_(float x) { return __builtin_amdgcn_rcpf(1.f + __builtin_amdgcn_exp2f(-1.4426950408889634f * x)); }
DI float siluf_(float x) { return x * __builtin_amdgcn_rcpf(1.f + __builtin_amdgcn_exp2f(-1.4426950408889634f * x)); }
DI int lane_op() { int l = threadIdx.x & 63; asm volatile("" : "+v"(l)); return l; }
DI float shx(float v, int m) { return __builtin_bit_cast(float, __builtin_amdgcn_ds_bpermute((lane_op() ^ m) << 2, __builtin_bit_cast(int, v))); }
DI unsigned shx(unsigned v, int m) { return (unsigned)__builtin_amdgcn_ds_bpermute((lane_op() ^ m) << 2, (int)v); }
DI float shup(float v, int d) { const int l = lane_op(); const int s = l - d; return __builtin_bit_cast(float, __builtin_amdgcn_ds_bpermute((s < 0 ? l : s) << 2, __builtin_bit_cast(int, v))); }
DI float wave_sum(float v) { for (int o = 32; o > 0; o >>= 1) v += shx(v, o); return v; }
DI float wave_max(float v) { for (int o = 32; o > 0; o >>= 1) v = fmaxf(v, shx(v, o)); return v; }

DI int orig_col(int n) {
  if (n < 1536) return n;
  if (n < 3712) return n + 8;
  if (n < 3968) return n + 20;
  if (n < 3976) return 1536 + (n - 3968);
  if (n < 3988) return 3720 + (n - 3976);
  return -1;
}

DI bool head_is_paired(int hd);
DI void ph_prologue(const Params& p, int bid, int nblk, char* smem) {
  const long gtid = (long)bid * 256 + tid_opaque(), gsz = (long)nblk * 256;
  if (gtid < 64) p.CTR()[gtid] = 0;
  for (long idx = gtid; idx < 2L * 128 * NP; idx += gsz) {
    const int n = (int)(idx % NP), k8 = (int)((idx / NP) % 128), l = (int)(idx / (NP * 128));
    const int pp = n & 63, w_ = pp >> 5, rr = pp & 31, n_ = rr >> 4, fq_ = (rr >> 2) & 3, j_ = rr & 3;
    const int lc = head_is_paired(n >> 6) ? (32 * n_ + 16 * w_ + 4 * fq_ + j_) : (32 * w_ + 8 * fq_ + 4 * n_ + j_);
    const int oc = orig_col((n & ~63) + lc);
    unsigned w[4];
    for (int j = 0; j < 4; ++j) {
      float a = 0.f, b = 0.f;
      if (oc >= 0) { a = p.w_in[((size_t)l * 1024 + k8 * 8 + 2 * j) * 3988 + oc]; b = p.w_in[((size_t)l * 1024 + k8 * 8 + 2 * j + 1) * 3988 + oc]; }
      w[j] = (unsigned)f2bf(a) | ((unsigned)f2bf(b) << 16);
    }
    *(uint4*)(p.WT() + ((size_t)l * NP + n) * 1024 + k8 * 8) = make_uint4(w[0], w[1], w[2], w[3]);
  }
  for (long idx = gtid; idx < 2L * 128 * 1024; idx += gsz) {
    const int d = (int)(idx % 1024), m8 = (int)((idx / 1024) % 128), l = (int)(idx / (1024 * 128));
    unsigned w[4];
    for (int j = 0; j < 4; ++j) {
      float a = p.w_out[((size_t)l * 1024 + m8 * 8 + 2 * j) * 1024 + d], b = p.w_out[((size_t)l * 1024 + m8 * 8 + 2 * j + 1) * 1024 + d];
      w[j] = (unsigned)f2bf(a) | ((unsigned)f2bf(b) << 16);
    }
    *(uint4*)(p.WOT() + ((size_t)l * 1024 + d) * 1024 + m8 * 8) = make_uint4(w[0], w[1], w[2], w[3]);
  }
  for (long idx = gtid; idx < 4L * 256 * 64; idx += gsz) {
    const int j = (int)(idx % 64), i8 = (int)((idx / 64) % 256), lk = (int)(idx / (64 * 256));
    unsigned w[4];
    for (int e = 0; e < 4; ++e) {
      const float a = p.w1[((size_t)lk * 2048 + i8 * 8 + 2 * e) * 64 + j], b = p.w1[((size_t)lk * 2048 + i8 * 8 + 2 * e + 1) * 64 + j];
      w[e] = (unsigned)f2bf(a) | ((unsigned)f2bf(b) << 16);
    }
    *(uint4*)(p.W1T() + ((size_t)lk * 64 + j) * 2048 + i8 * 8) = make_uint4(w[0], w[1], w[2], w[3]);
  }
  for (long idx = gtid; idx < 4L * 64 * 64; idx += gsz) {
    const int jo = (int)(idx % 64), ji = (int)((idx / 64) % 64), lk = (int)(idx / 4096);
    p.W2T()[((size_t)lk * 64 + jo) * 64 + ji] = f2bf(p.w2[((size_t)lk * 64 + ji) * 64 + jo]);
  }
  if (bid < 4) {
    const int lk = bid, j = tid_opaque() & 63, part = tid_opaque() >> 6;
    float a = 0.f;
    for (int i = part * 512; i < part * 512 + 512; ++i) a += p.pe[(size_t)lk * 2048 + i] * p.w1[((size_t)lk * 2048 + i) * 64 + j];
    float* red = (float*)smem;
    red[part * 64 + j] = a;
    __syncthreads();
    if (part == 0) p.CVEC()[lk * 64 + j] = (red[j] + red[64 + j]) + (red[128 + j] + red[192 + j]);
    __syncthreads();
  }
  for (long idx = gtid; idx < 2L * NP; idx += gsz) {
    const int n = (int)(idx % NP), l = (int)(idx / NP); const int oc = orig_col(n);
    p.BIASP()[idx] = oc >= 0 ? p.b_in[l * 3988 + oc] : 0.f;
  }
  for (long idx = gtid; idx < (long)T * 32; idx += gsz) {
    const int t = (int)(idx / 32), i = (int)(idx % 32);
    const float inv = exp2f(-(float)i * (13.287712379549449f / 32.0f));
    const float ang = (float)t * inv;
    p.ROPEC()[idx] = cosf(ang); p.ROPES()[idx] = sinf(ang);
  }
  for (long idx = gtid; idx < 512; idx += gsz) {
    const int c = (int)(idx % 256), l = (int)(idx / 256);
    const float a = p.c_lb[c], b = p.c_lb[256 + c];
    const float m = fmaxf(a, b); const float ea = expf(a - m), eb = expf(b - m);
    p.LB()[idx] = l == 0 ? 0.f : eb / (ea + eb);
  }
}

DI void ln_rows(const Params& p, int mode, int layer, int bid, int nblk) {
  const int tid_ = tid_opaque(); const int lane = tid_ & 63, wid = tid_ >> 6, nw = 4;
  const float* g = mode == 0 ? p.ln0_g : p.ln_g + layer * 1024;
  const float* bb = mode == 0 ? p.ln0_b : p.ln_b + layer * 1024;
  const float* src = mode == 0 ? p.x : p.hf;
  for (int row = bid * nw + wid; row < NTOK; row += nblk * nw) {
    const float* s = src + (size_t)row * 1024;
    float4 v[4];
    float sum = 0.f;
#pragma unroll
    for (int i = 0; i < 4; ++i) { v[i] = *(const float4*)(s + i * 256 + lane * 4); sum += (v[i].x + v[i].y) + (v[i].z + v[i].w); }
    sum = wave_sum(sum);
    const float mu = sum * (1.f / 1024.f);
    float q = 0.f;
#pragma unroll
    for (int i = 0; i < 4; ++i) { float a = v[i].x - mu, b = v[i].y - mu, c = v[i].z - mu, d = v[i].w - mu; q += (a * a + b * b) + (c * c + d * d); }
    q = wave_sum(q);
    const float rs = rsqrtf(q * (1.f / 1024.f) + 1e-5f);
#pragma unroll
    for (int i = 0; i < 4; ++i) {
      const int c0 = i * 256 + lane * 4;
      const float4 gg = *(const float4*)(g + c0), b4 = *(const float4*)(bb + c0);
      float4 o;
      o.x = (v[i].x - mu) * rs * gg.x + b4.x; o.y = (v[i].y - mu) * rs * gg.y + b4.y;
      o.z = (v[i].z - mu) * rs * gg.z + b4.z; o.w = (v[i].w - mu) * rs * gg.w + b4.w;
      *(float4*)(p.hf + (size_t)row * 1024 + c0) = o;
      uint2 pk; pk.x = (unsigned)f2bf(o.x) | ((unsigned)f2bf(o.y) << 16); pk.y = (unsigned)f2bf(o.z) | ((unsigned)f2bf(o.w) << 16);
      *(uint2*)(p.HB() + (size_t)row * 1024 + c0) = pk;
    }
  }
}

typedef float f32x2 __attribute__((ext_vector_type(2)));
typedef __bf16 bf16v2 __attribute__((ext_vector_type(2)));
typedef unsigned u32x2 __attribute__((ext_vector_type(2)));
DI unsigned pack2(float a, float b) { f32x2 v = {a, b}; return __builtin_bit_cast(unsigned, __builtin_convertvector(v, bf16v2)); }
DI f32x16 zero16() { f32x16 z;
#pragma unroll
  for (int i = 0; i < 16; ++i) z[i] = 0.f; return z; }
DI bf16x8 ld_frag8x2(const bf16_t* p) { const u32x2 lo = *(const u32x2*)p, hi = *(const u32x2*)(p + 8); u32x4 t = {lo.x, lo.y, hi.x, hi.y}; return __builtin_bit_cast(bf16x8, t); }
template <int BASE> DI bf16x8 pack8(const f32x16& s) {
  u32x4 t = {pack2(s[BASE + 0], s[BASE + 1]), pack2(s[BASE + 2], s[BASE + 3]), pack2(s[BASE + 4], s[BASE + 5]), pack2(s[BASE + 6], s[BASE + 7])};
  return __builtin_bit_cast(bf16x8, t);
}
DI int crow(int r, int h2) { return (r & 3) + 8 * (r >> 2) + 4 * h2; }
#define MFMA32(a, b, c) __builtin_amdgcn_mfma_f32_32x32x16_bf16((a), (b), (c), 0, 0, 0)
#define LAS __attribute__((address_space(3)))
enum { K_NONE = 0, K_ROPE, K_PLAIN, K_TR, K_GSILU, K_GSIG, K_SILUH, K_LOGF, K_SMALL };
namespace g8 {
constexpr int BK = 64, HALF = 128, HT = HALF * BK;
DI int lds_byte(int r, int c) { const int st = (r >> 4) * 2 + (c >> 5), rr = r & 15, cc = c & 31, ob = rr * 64 + cc * 2; return st * 1024 + (ob ^ (((ob >> 9) & 1) << 5)); }
DI void stage_rc(int b, int& R, int& C) { const int st = b / 1024, sb = b % 1024, swz = sb ^ (((sb >> 9) & 1) << 5); R = (st >> 1) * 16 + swz / 64; C = (st & 1) * 32 + (swz % 64) / 2; }
}
DI void gemm256_mainloop(const bf16_t* A, const bf16_t* Bt, bf16_t* shm, f32x4 (&acc)[2][2][4][2]) {
  using namespace g8;
  constexpr int K = 1024;
#define SA(b, h) (shm + ((b) * 2 + (h)) * HT)
#define SB(b, h) (shm + (4 + (b) * 2 + (h)) * HT)
#define STAGE(P, BASE, br, kt) do { const long g_ = (long)(br) * K + (long)(kt) * BK; \
    _Pragma("unroll") for (int i_ = 0; i_ < 2; ++i_) { const int b_ = tidf * 16 + i_ * 8192; int r_, c_; stage_rc(b_, r_, c_); \
      __builtin_amdgcn_global_load_lds((const unsigned*)((BASE) + g_ + (long)r_ * K + c_), (LAS unsigned*)((char*)(P) + b_), 16, 0, 0); } } while (0)
#define LDA(dst, b, h) _Pragma("unroll") for (int m = 0; m < 4; ++m) _Pragma("unroll") for (int k = 0; k < 2; ++k) \
    dst[m][k] = *reinterpret_cast<const bf16x8*>((const char*)SA(b, h) + lds_byte(wr * 64 + m * 16 + fr, k * 32 + fq * 8))
#define LDB(dst, b, h) _Pragma("unroll") for (int n = 0; n < 2; ++n) _Pragma("unroll") for (int k = 0; k < 2; ++k) \
    dst[n][k] = *reinterpret_cast<const bf16x8*>((const char*)SB(b, h) + lds_byte(wc * 32 + n * 16 + fr, k * 32 + fq * 8))
#define MMA(ai, bj, At_, Bt_) do { __builtin_amdgcn_s_setprio(1); \
    _Pragma("unroll") for (int m = 0; m < 4; ++m) _Pragma("unroll") for (int n = 0; n < 2; ++n) _Pragma("unroll") for (int k = 0; k < 2; ++k) \
      acc[ai][bj][m][n] = __builtin_amdgcn_mfma_f32_16x16x32_bf16(Bt_[n][k], At_[m][k], acc[ai][bj][m][n], 0, 0, 0); \
    __builtin_amdgcn_s_setprio(0); } while (0)
#define WAIT_V(n) asm volatile("s_waitcnt vmcnt(" #n ")" ::: "memory")
#define WAIT_L(n) asm volatile("s_waitcnt lgkmcnt(" #n ")" ::: "memory")
#define BAR __builtin_amdgcn_s_barrier()
#define SCHED __builtin_amdgcn_sched_barrier(0)
  int tidf = threadIdx.x; asm volatile("" : "+v"(tidf));
  const int wid = tidf >> 6, lane = tidf & 63, wr = wid >> 2, wc = wid & 3, fr = lane & 15, fq = lane >> 4;
#pragma unroll
  for (int a = 0; a < 2; ++a)
#pragma unroll
    for (int b = 0; b < 2; ++b)
#pragma unroll
      for (int m = 0; m < 4; ++m)
#pragma unroll
        for (int n = 0; n < 2; ++n) acc[a][b][m][n] = (f32x4){0.f, 0.f, 0.f, 0.f};
  bf16x8 At[4][2], B0[2][2], B1[2][2];
  constexpr int nt = K / BK;
  WAIT_V(0);
  STAGE(SB(0, 0), Bt, 0, 0); STAGE(SA(0, 0), A, 0, 0);
  STAGE(SB(0, 1), Bt, HALF, 0); STAGE(SA(0, 1), A, HALF, 0);
  if (wr == 1) BAR;
  WAIT_V(4); BAR;
  STAGE(SB(1, 0), Bt, 0, 1); STAGE(SA(1, 0), A, 0, 1); STAGE(SB(1, 1), Bt, HALF, 1);
  WAIT_V(6); BAR;
  for (int t = 0; t < nt - 2; t += 2) {
    LDB(B0, 0, 0); SCHED; LDA(At, 0, 0); STAGE(SA(1, 1), A, HALF, t + 1);
    WAIT_L(8); BAR; WAIT_L(0); MMA(0, 0, At, B0); BAR; SCHED;
    LDB(B1, 0, 1); STAGE(SB(0, 0), Bt, 0, t + 2);
    BAR; WAIT_L(0); MMA(0, 1, At, B1); BAR;
    LDA(At, 0, 1); STAGE(SA(0, 0), A, 0, t + 2);
    BAR; WAIT_L(0); MMA(1, 0, At, B0); BAR; SCHED;
    STAGE(SB(0, 1), Bt, HALF, t + 2);
    WAIT_V(6); BAR; MMA(1, 1, At, B1); BAR;
    LDB(B0, 1, 0); SCHED; LDA(At, 1, 0); STAGE(SA(0, 1), A, HALF, t + 2);
    WAIT_L(8); BAR; WAIT_L(0); MMA(0, 0, At, B0); BAR; SCHED;
    LDB(B1, 1, 1); STAGE(SB(1, 0), Bt, 0, t + 3);
    BAR; WAIT_L(0); MMA(0, 1, At, B1); BAR;
    LDA(At, 1, 1); STAGE(SA(1, 0), A, 0, t + 3);
    BAR; WAIT_L(0); MMA(1, 0, At, B0); BAR; SCHED;
    STAGE(SB(1, 1), Bt, HALF, t + 3);
    WAIT_V(6); BAR; MMA(1, 1, At, B1); BAR;
  }
  { LDB(B0, 0, 0); LDA(At, 0, 0); STAGE(SA(1, 1), A, HALF, nt - 1);
    BAR; WAIT_L(0); MMA(0, 0, At, B0); BAR;
    LDB(B1, 0, 1); BAR; WAIT_L(0); MMA(0, 1, At, B1); BAR;
    LDA(At, 0, 1); WAIT_V(4); BAR; WAIT_L(0); MMA(1, 0, At, B0); MMA(1, 1, At, B1); BAR; }
  { LDB(B0, 1, 0); LDA(At, 1, 0); WAIT_V(2); BAR; WAIT_L(0); MMA(0, 0, At, B0); BAR;
    LDB(B1, 1, 1); WAIT_V(0); BAR; WAIT_L(0); MMA(0, 1, At, B1); BAR;
    LDA(At, 1, 1); BAR; WAIT_L(0); MMA(1, 0, At, B0); MMA(1, 1, At, B1); BAR; }
  if (wr == 0) BAR;
#undef SA
#undef SB
#undef STAGE
#undef LDA
#undef LDB
#undef MMA
#undef WAIT_V
#undef WAIT_L
#undef BAR
#undef SCHED
}

DI void classify_head(const Params& p, int hd, int b, int& kind, bf16_t*& dst, float*& fdst, float& scale) {
  kind = K_NONE; dst = nullptr; fdst = nullptr; scale = 1.f;
  if (hd < 4) { kind = K_ROPE; dst = p.QA() + ((size_t)(b * 4 + hd) * T) * 64; scale = 0.125f; }
  else if (hd < 6) { kind = K_ROPE; dst = p.KA() + ((size_t)(b * 2 + hd - 4) * T) * 64; }
  else if (hd < 8) { kind = K_TR; dst = p.VAT() + (size_t)(b * 2 + hd - 6) * 64 * T; }
  else if (hd < 12) { kind = K_GSILU; dst = p.GZ() + (size_t)0 * NTOK * 256 + (hd - 8) * 64; }
  else if (hd < 20) { kind = K_PLAIN; dst = p.QKB() + ((size_t)(b * 8 + hd - 12) * T) * 64; }
  else if (hd < 24) { kind = K_TR; dst = p.VBT() + (size_t)(b * 4 + hd - 20) * 64 * T; }
  else if (hd < 28) { kind = K_GSIG; dst = p.GZ() + (size_t)1 * NTOK * 256 + (hd - 24) * 64; }
  else if (hd < 32) { kind = K_GSILU; dst = p.GZ() + (size_t)2 * NTOK * 256 + (hd - 28) * 64; }
  else if (hd < 36) { kind = K_SILUH; dst = p.QC() + ((size_t)(b * 4 + hd - 32) * T) * 64; }
  else if (hd < 40) { kind = K_LOGF; fdst = p.GC() + ((size_t)(b * 4 + hd - 36) * T) * 64; }
  else if (hd < 44) { kind = K_TR; dst = p.VCT() + (size_t)(b * 4 + hd - 40) * 64 * T; }
  else if (hd < 48) { kind = K_GSILU; dst = p.GZ() + (size_t)3 * NTOK * 256 + (hd - 44) * 64; }
  else if (hd < 52) { kind = K_ROPE; dst = p.QD() + ((size_t)(b * 4 + hd - 48) * T) * 64; scale = 0.125f; }
  else if (hd < 58) {
    const int j = hd - 52;
    dst = p.KV() + (size_t)(j * NB + b) * T * 64;
    kind = (j == 0 || j == 1) ? K_PLAIN : ((j == 2 || j == 4) ? K_ROPE : K_TR);
  }
  else if (hd < 62) { kind = K_GSILU; dst = p.GZ() + (size_t)4 * NTOK * 256 + (hd - 58) * 64; }
  else if (hd == 62) { kind = K_SMALL; }
}

DI bool head_is_paired(int hd) { return hd < 6 || (hd >= 48 && hd < 52) || hd == 54 || hd == 56; }
template <int KIND>
DI void epi_direct(const Params& p, const f32x4 (&a)[4][2], bf16_t* dst, float* fdst, float scale, int layer, int hd, int b, int tq, int wr, int w, int fr, int fq) {
  if (KIND == K_ROPE) {
    const int c = 16 * w + 4 * fq;
    const f32x4 b0 = *(const f32x4*)(p.BIASP() + layer * NP + hd * 64 + c), b1 = *(const f32x4*)(p.BIASP() + layer * NP + hd * 64 + 32 + c);
#pragma unroll
    for (int m = 0; m < 4; ++m) {
      const int t = tq + wr * 64 + m * 16 + fr;
      const f32x4 cs = *(const f32x4*)(p.ROPEC() + t * 32 + c), sn = *(const f32x4*)(p.ROPES() + t * 32 + c);
      const f32x4 v0 = a[m][0] + b0, v1 = a[m][1] + b1;
      const f32x4 o0 = (v0 * cs - v1 * sn) * scale, o1 = (v0 * sn + v1 * cs) * scale;
      u32x2 w0 = {pack2(o0[0], o0[1]), pack2(o0[2], o0[3])}, w1 = {pack2(o1[0], o1[1]), pack2(o1[2], o1[3])};
      *(u32x2*)(dst + (size_t)t * 64 + c) = w0; *(u32x2*)(dst + (size_t)t * 64 + 32 + c) = w1;
    }
    return;
  }
  const int c = 32 * w + 8 * fq;
  const f32x4 b0 = *(const f32x4*)(p.BIASP() + layer * NP + hd * 64 + c), b1 = *(const f32x4*)(p.BIASP() + layer * NP + hd * 64 + c + 4);
  if (KIND == K_SMALL) {
#pragma unroll
    for (int m = 0; m < 4; ++m) {
      const size_t tok = (size_t)b * T + tq + wr * 64 + m * 16 + fr;
#pragma unroll
      for (int n = 0; n < 2; ++n)
#pragma unroll
        for (int j = 0; j < 4; ++j) {
          const int cc = c + 4 * n + j;
          const float v = a[m][n][j] + (n ? b1[j] : b0[j]);
          if (cc < 8) p.IFG()[tok * 8 + cc] = v;
          else if (cc < 20) p.DG()[tok * 12 + (cc - 8)] = sigmoidf_(v);
        }
    }
    return;
  }
  f32x4 lb0 = {0.f, 0.f, 0.f, 0.f}, lb1 = {0.f, 0.f, 0.f, 0.f};
  if (KIND == K_LOGF) { lb0 = *(const f32x4*)(p.LB() + layer * 256 + (hd - 36) * 64 + c); lb1 = *(const f32x4*)(p.LB() + layer * 256 + (hd - 36) * 64 + c + 4); }
#pragma unroll
  for (int m = 0; m < 4; ++m) {
    const int t = tq + wr * 64 + m * 16 + fr;
    const f32x4 v0 = a[m][0] + b0, v1 = a[m][1] + b1;
    if (KIND == K_LOGF) {
      f32x4 o0, o1;
#pragma unroll
      for (int j = 0; j < 4; ++j) { o0[j] = __logf(lb0[j] + (1.f - lb0[j]) * sigmoidf_(v0[j])); o1[j] = __logf(lb1[j] + (1.f - lb1[j]) * sigmoidf_(v1[j])); }
      *(f32x4*)(fdst + (size_t)t * 64 + c) = o0; *(f32x4*)(fdst + (size_t)t * 64 + c + 4) = o1;
    } else {
      f32x4 o0, o1;
#pragma unroll
      for (int j = 0; j < 4; ++j) {
        if (KIND == K_PLAIN) { o0[j] = v0[j]; o1[j] = v1[j]; }
        else if (KIND == K_SILUH || KIND == K_GSILU) { o0[j] = siluf_(v0[j]); o1[j] = siluf_(v1[j]); }
        else { o0[j] = sigmoidf_(v0[j]); o1[j] = sigmoidf_(v1[j]); }
      }
      u32x4 wv = {pack2(o0[0], o0[1]), pack2(o0[2], o0[3]), pack2(o1[0], o1[1]), pack2(o1[2], o1[3])};
      if (KIND == K_GSILU || KIND == K_GSIG) *(u32x4*)(dst + ((size_t)b * T + t) * 256 + c) = wv;
      else *(u32x4*)(dst + (size_t)t * 64 + c) = wv;
    }
  }
}
DI void epi_tr_write(const Params& p, const f32x4 (&a)[4][2], char* img, int layer, int hd, int wr, int w, int fr, int fq) {
  const int c = 32 * w + 8 * fq;
  const f32x4 b0 = *(const f32x4*)(p.BIASP() + layer * NP + hd * 64 + c), b1 = *(const f32x4*)(p.BIASP() + layer * NP + hd * 64 + c + 4);
  bf16_t* timg = (bf16_t*)img;
#pragma unroll
  for (int m = 0; m < 4; ++m)
#pragma unroll
    for (int n = 0; n < 2; ++n)
#pragma unroll
      for (int j = 0; j < 4; ++j) timg[(c + 4 * n + j) * 128 + wr * 64 + m * 16 + fr] = f2bf(a[m][n][j] + (n ? b1[j] : b0[j]));
}
DI void gemm_in_quadrant(const Params& p, int layer, int panel, int pn, int ai, int bj, const f32x4 (&a)[4][2], char* shm,
                         int b, int hq, int tid2, int wr, int wc, int fr, int fq) {
  const int tq = (panel & 7) * 256 + ai * 128;
  const int hd0 = pn * 4 + bj * 2;
  const int hd = hd0 + (wc >> 1), w = wc & 1;
  int kind; bf16_t* dst; float* fdst; float scale;
  classify_head(p, hd, b, kind, dst, fdst, scale);
  switch (kind) {
    case K_ROPE: epi_direct<K_ROPE>(p, a, dst, fdst, scale, layer, hd, b, tq, wr, w, fr, fq); break;
    case K_PLAIN: epi_direct<K_PLAIN>(p, a, dst, fdst, scale, layer, hd, b, tq, wr, w, fr, fq); break;
    case K_GSILU: epi_direct<K_GSILU>(p, a, dst, fdst, scale, layer, hd, b, tq, wr, w, fr, fq); break;
    case K_GSIG: epi_direct<K_GSIG>(p, a, dst, fdst, scale, layer, hd, b, tq, wr, w, fr, fq); break;
    case K_SILUH: epi_direct<K_SILUH>(p, a, dst, fdst, scale, layer, hd, b, tq, wr, w, fr, fq); break;
    case K_LOGF: epi_direct<K_LOGF>(p, a, dst, fdst, scale, layer, hd, b, tq, wr, w, fr, fq); break;
    case K_SMALL: epi_direct<K_SMALL>(p, a, dst, fdst, scale, layer, hd, b, tq, wr, w, fr, fq); break;
    default: break;
  }
  int k0, k1; { bf16_t* d_; float* f_; float s_; classify_head(p, hd0, b, k0, d_, f_, s_); classify_head(p, hd0 + 1, b, k1, d_, f_, s_); }
  if (k0 == K_TR || k1 == K_TR) {
    if (kind == K_TR) epi_tr_write(p, a, shm + (wc >> 1) * 16384, layer, hd, wr, w, fr, fq);
    __syncthreads();
    int kq; bf16_t* dq; float* fq_; float sq; classify_head(p, hd0 + hq, b, kq, dq, fq_, sq);
    if (kq == K_TR) {
      const char* img = shm + hq * 16384;
#pragma unroll
      for (int i = 0; i < 4; ++i) { const int q = tid2 + 256 * i, cc = q >> 4, rc = q & 15; *(u32x4*)(dq + (size_t)cc * T + tq + rc * 8) = *(const u32x4*)(img + q * 16); }
    }
    __syncthreads();
  }
}
DI void gemm_in_epilogue(const Params& p, int layer, int panel, int pn, const f32x4 (&acc)[2][2][4][2], char* shm) {
  int tidf = threadIdx.x; asm volatile("" : "+v"(tidf));
  const int wid = tidf >> 6, lane = tidf & 63, wr = wid >> 2, wc = wid & 3, fr = lane & 15, fq = lane >> 4;
  const int b = panel >> 3;
  const int hq = __builtin_amdgcn_readfirstlane(tidf >> 8), tid2 = tidf & 255;
  __syncthreads();
  gemm_in_quadrant(p, layer, panel, pn, 0, 0, acc[0][0], shm, b, hq, tid2, wr, wc, fr, fq);
  gemm_in_quadrant(p, layer, panel, pn, 0, 1, acc[0][1], shm, b, hq, tid2, wr, wc, fr, fq);
  gemm_in_quadrant(p, layer, panel, pn, 1, 0, acc[1][0], shm, b, hq, tid2, wr, wc, fr, fq);
  gemm_in_quadrant(p, layer, panel, pn, 1, 1, acc[1][1], shm, b, hq, tid2, wr, wc, fr, fq);
}
DI void gemm_out_epilogue(const Params& p, int panel, int pn, const f32x4 (&acc)[2][2][4][2], char* shm) {
  int tidf = threadIdx.x; asm volatile("" : "+v"(tidf));
  const int wid = tidf >> 6, lane = tidf & 63, wr = wid >> 2, wc = wid & 3, fr = lane & 15, fq = lane >> 4;
#pragma unroll
  for (int ai = 0; ai < 2; ++ai)
#pragma unroll
    for (int bj = 0; bj < 2; ++bj)
#pragma unroll
      for (int m = 0; m < 4; ++m)
#pragma unroll
        for (int n = 0; n < 2; ++n) {
          float* g = p.hf + (size_t)(panel * 256 + ai * 128 + wr * 64 + m * 16 + fr) * 1024 + pn * 256 + bj * 128 + wc * 32 + n * 16 + fq * 4;
          const f32x4 h = *(const f32x4*)g;
          *(f32x4*)g = DN_ALPHA * h + acc[ai][bj][m][n];
        }
}
DI void ph_gemm_in(const Params& p, int layer, int bid, int nblk, char* shm) {
  asm volatile("" : "+s"(bid));
  for (int panel = bid; panel < 256; panel += nblk) {
    const bf16_t* A = p.HB() + (size_t)panel * 256 * 1024;
    for (int pn = 0; pn < 16; ++pn) {
      f32x4 acc[2][2][4][2];
      gemm256_mainloop(A, p.WT() + ((size_t)layer * NP + pn * 256) * 1024, (bf16_t*)shm, acc);
      if (PROBE == 6) { __syncthreads(); gemm256_mainloop(A, p.WT() + ((size_t)layer * NP + pn * 256) * 1024, (bf16_t*)shm, acc); }
      gemm_in_epilogue(p, layer, panel, pn, acc, shm);
      if (PROBE == 7) gemm_in_epilogue(p, layer, panel, pn, acc, shm);
    }
  }
}
DI void ph_gemm_out_ln(const Params& p, int layer, int bid, int nblk, char* shm) {
  asm volatile("" : "+s"(bid));
  for (int panel = bid; panel < 256; panel += nblk) {
    const bf16_t* A = p.YMIX() + (size_t)panel * 256 * 1024;
    for (int pn = 0; pn < 4; ++pn) {
      f32x4 acc[2][2][4][2];
      gemm256_mainloop(A, p.WOT() + ((size_t)layer * 1024 + pn * 256) * 1024, (bf16_t*)shm, acc);
      gemm_out_epilogue(p, panel, pn, acc, shm);
    }
    asm volatile("s_waitcnt vmcnt(0)" ::: "memory");
    __syncthreads();
    int tidf = threadIdx.x; asm volatile("" : "+v"(tidf));
    const int lane = tidf & 63, wid = tidf >> 6;
    const float* g = p.ln_g + layer * 1024; const float* bb = p.ln_b + layer * 1024;
    for (int rr = 0; rr < 32; ++rr) {
      const int row = panel * 256 + wid * 32 + rr;
      float* s = p.hf + (size_t)row * 1024;
      f32x4 v[4];
      float sum = 0.f;
#pragma unroll
      for (int i = 0; i < 4; ++i) { v[i] = *(const f32x4*)(s + i * 256 + lane * 4); sum += (v[i][0] + v[i][1]) + (v[i][2] + v[i][3]); }
      sum = wave_sum(sum);
      const float mu = sum * (1.f / 1024.f);
      float q = 0.f;
#pragma unroll
      for (int i = 0; i < 4; ++i) { const f32x4 d = v[i] - mu; q += (d[0] * d[0] + d[1] * d[1]) + (d[2] * d[2] + d[3] * d[3]); }
      q = wave_sum(q);
      const float rs = rsqrtf(q * (1.f / 1024.f) + 1e-5f);
#pragma unroll
      for (int i = 0; i < 4; ++i) {
        const int cc = i * 256 + lane * 4;
        const f32x4 gg = *(const f32x4*)(g + cc), b4 = *(const f32x4*)(bb + cc);
        const f32x4 o = (v[i] - mu) * rs * gg + b4;
        *(f32x4*)(s + cc) = o;
        u32x2 pk = {pack2(o[0], o[1]), pack2(o[2], o[3])};
        *(u32x2*)(p.HB() + (size_t)row * 1024 + cc) = pk;
      }
    }
  }
}

DI f32x16 qk_tile(const bf16_t* Krow, const bf16x8 (&qf)[4], int l31, int h2) {
  f32x16 s = zero16();
  const bf16_t* kp = Krow + l31 * 64 + h2 * 8;
#pragma unroll
  for (int ks = 0; ks < 4; ++ks) { const bf16x8 a = *(const bf16x8*)(kp + ks * 16); s = MFMA32(a, qf[ks], s); }
  return s;
}
DI f32x16 qk_tile_s(const bf16_t* Krow, int stride, const bf16x8 (&qf)[4], int l31, int h2) {
  f32x16 s = zero16();
  const bf16_t* kp = Krow + l31 * stride + h2 * 8;
#pragma unroll
  for (int ks = 0; ks < 4; ++ks) { const bf16x8 a = *(const bf16x8*)(kp + ks * 16); s = MFMA32(a, qf[ks], s); }
  return s;
}
DI void softmax_pv(f32x16& s, const bf16_t* VTp, int vstride, f32x16 (&o)[2], float& m, float& l, int l31, int h2) {
  bf16x8 va[2][2];
#pragma unroll
  for (int dt = 0; dt < 2; ++dt)
#pragma unroll
    for (int sk = 0; sk < 2; ++sk) va[dt][sk] = ld_frag8x2(VTp + (size_t)(dt * 32 + l31) * vstride + sk * 16 + 4 * h2);
  float mx = s[0];
#pragma unroll
  for (int r = 1; r < 16; ++r) mx = fmaxf(mx, s[r]);
  mx = fmaxf(mx, shx(mx, 32));
  const float mn = fmaxf(m, mx);
  const float alpha = __expf(m - mn);
  float ps = 0.f;
#pragma unroll
  for (int r = 0; r < 16; ++r) { s[r] = __expf(s[r] - mn); ps += s[r]; }
  ps += shx(ps, 32);
  l = l * alpha + ps; m = mn;
#pragma unroll
  for (int dt = 0; dt < 2; ++dt)
#pragma unroll
    for (int r = 0; r < 16; ++r) o[dt][r] *= alpha;
  const bf16x8 p0 = pack8<0>(s), p1 = pack8<8>(s);
#pragma unroll
  for (int dt = 0; dt < 2; ++dt) { o[dt] = MFMA32(va[dt][0], p0, o[dt]); o[dt] = MFMA32(va[dt][1], p1, o[dt]); }
}

constexpr int AD_KSTR = 72, AD_VSTR = 68;
constexpr int AD_BUF = 64 * AD_KSTR * 2 + 64 * AD_VSTR * 2;
struct AdTile { u32x4 k, v; };
DI AdTile ad_load(const bf16_t* Kg, const bf16_t* Vg, int key0, int tidf) {
  AdTile r; const int row = tidf >> 3, ch = tidf & 7;
  r.k = *(const u32x4*)(Kg + (size_t)(key0 + row) * 64 + ch * 8);
  r.v = *(const u32x4*)(Vg + (size_t)row * T + key0 + ch * 8);
  return r;
}
DI void ad_store(const AdTile& r, char* buf, int tidf) {
  const int row = tidf >> 3, ch = tidf & 7;
  *(u32x4*)(buf + (row * AD_KSTR + ch * 8) * 2) = r.k;
  char* vp = buf + 64 * AD_KSTR * 2 + (row * AD_VSTR + ch * 8) * 2;
  *(u32x2*)vp = (u32x2){r.v[0], r.v[1]}; *(u32x2*)(vp + 8) = (u32x2){r.v[2], r.v[3]};
}
DI void ph_attnD(const Params& p, int layer, int* ctr, char* smem, int* s_pair) {
  float* imps = (float*)smem;
  float* impf = (float*)(smem + 32768);
  unsigned* smask = (unsigned*)(smem + 40960);
  unsigned* s_union = (unsigned*)(smem + 40960 + 256);
  char* kvbuf = smem + 49152;
  int tidf = threadIdx.x; asm volatile("" : "+v"(tidf));
  const int lane = tidf & 63, wid = tidf >> 6, h = wid & 3, qs = wid >> 2, l31 = lane & 31, h2 = lane >> 5;
  for (;;) {
    __syncthreads();
    if (tidf == 0) { *s_pair = atomicAdd(ctr, 1); *s_union = 0u; }
    __syncthreads();
    const int it = *s_pair;
    if (it >= 1024) break;
    const int b = it & 31, q0 = (31 - (it >> 5)) * 64;
    const int qw = q0 + 32 * qs;
    const int t = qw + l31, cur = q0 >> 6;
    const size_t tok = (size_t)b * T + t;
    bf16x8 qf[4];
    {
      const bf16_t* qp = p.QD() + ((size_t)(b * 4 + h) * T + t) * 64 + h2 * 8;
#pragma unroll
      for (int ks = 0; ks < 4; ++ks) qf[ks] = *(const bf16x8*)(qp + ks * 16);
    }
    const float g0 = p.DG()[tok * 12 + h * 3 + 0], g1 = p.DG()[tok * 12 + h * 3 + 1], g2 = p.DG()[tok * 12 + h * 3 + 2];
    f32x16 ofin[2];
    {
      const bf16_t* Kc = p.KCMP() + (size_t)b * 128 * 64;
      const bf16_t* Vc = p.VCMPT() + (size_t)b * 64 * 128;
      const int nkt = min(4, (qw >> 9) + 1);
      f32x16 o[2]; o[0] = zero16(); o[1] = zero16();
      float m = -1e30f, l = 0.f;
      for (int kt = 0; kt < nkt; ++kt) {
        f32x16 s = qk_tile(Kc + kt * 32 * 64, qf, l31, h2);
#pragma unroll
        for (int r = 0; r < 16; ++r) { const int n = kt * 32 + crow(r, h2); if (16 * n + 31 > t) s[r] = -INFINITY; }
        softmax_pv(s, Vc + kt * 32, 128, o, m, l, l31, h2);
      }
      const float il = l > 0.f ? 1.f / l : 0.f;
      const float gi = g0 * il;
#pragma unroll
      for (int dt = 0; dt < 2; ++dt)
#pragma unroll
        for (int r = 0; r < 16; ++r) ofin[dt][r] = gi * o[dt][r];
      float carry = 0.f;
#pragma unroll
      for (int kt = 0; kt < 4; ++kt) {
        f32x16 s;
        if (kt < nkt) {
          s = qk_tile(Kc + kt * 32 * 64, qf, l31, h2);
#pragma unroll
          for (int r = 0; r < 16; ++r) { const int n = kt * 32 + crow(r, h2); s[r] = (16 * n + 31 > t) ? 0.f : __expf(s[r] - m) * il; }
        } else s = zero16();
        float X[4];
#pragma unroll
        for (int g = 0; g < 4; ++g) X[g] = shx(s[4 * g + 3], 32);
#pragma unroll
        for (int g = 0; g < 4; ++g) {
          const float G = (s[4 * g] + s[4 * g + 1]) + (s[4 * g + 2] + s[4 * g + 3]);
          const float prev_other = g > 0 ? X[g - 1] : carry;
          imps[(wid * 32 + l31) * 32 + 8 * kt + 2 * g + h2] = G + (h2 ? X[g] : prev_other);
        }
        carry = X[3];
      }
    }
    __syncthreads();
    {
      const int tt = tidf >> 3, jg = tidf & 7, wq = (tt >> 5) * 4, tl = tt & 31;
#pragma unroll
      for (int i = 0; i < 4; ++i) {
        const int j = jg * 4 + i;
        impf[tt * 32 + j] = (imps[((wq + 0) * 32 + tl) * 32 + j] + imps[((wq + 1) * 32 + tl) * 32 + j]) + (imps[((wq + 2) * 32 + tl) * 32 + j] + imps[((wq + 3) * 32 + tl) * 32 + j]);
      }
    }
    __syncthreads();
    {
      const int tt = tidf >> 3, jg = tidf & 7;
      float v[32];
#pragma unroll
      for (int j = 0; j < 32; ++j) {
        float x = impf[tt * 32 + j];
        if (j > cur) x = -1e30f; else if (j == 0 || j == cur || j == cur - 1) x = 1e6f;
        v[j] = x;
      }
      unsigned bits = 0u;
#pragma unroll
      for (int i = 0; i < 4; ++i) {
        int rank = 0; float vj = 0.f;
#pragma unroll
        for (int j = 0; j < 32; ++j) if (j == jg * 4 + i) vj = v[j];
        const int jj = jg * 4 + i;
#pragma unroll
        for (int j = 0; j < 32; ++j) rank += (v[j] > vj || (v[j] == vj && j < jj)) ? 1 : 0;
        if (rank < 8 && jj <= cur) bits |= 1u << jj;
      }
      bits |= shx(bits, 1); bits |= shx(bits, 2); bits |= shx(bits, 4);
      if (jg == 0) { smask[tt] = bits; atomicOr(s_union, bits); }
    }
    __syncthreads();
    {
      const unsigned mymask = smask[32 * qs + l31];
      unsigned rem = *s_union;
      const bf16_t* Ks = p.KV() + (size_t)(2 * NB + b) * T * 64;
      const bf16_t* Vs = p.KV() + (size_t)(3 * NB + b) * 64 * T;
      f32x16 o[2]; o[0] = zero16(); o[1] = zero16();
      float m = -1e30f, l = 0.f;
      int j = __builtin_ctz(rem); rem &= rem - 1;
      { const AdTile r = ad_load(Ks, Vs, j * 64, tidf); ad_store(r, kvbuf, tidf); }
      __syncthreads();
      int pb = 0;
      for (;;) {
        const bool more = rem != 0u;
        const int jn = more ? __builtin_ctz(rem) : 0;
        AdTile nx;
        if (more) nx = ad_load(Ks, Vs, jn * 64, tidf);
        const char* buf = kvbuf + pb * AD_BUF;
        const bool sel = (mymask >> j) & 1u;
#pragma unroll
        for (int kh = 0; kh < 2; ++kh) {
          const int key0 = j * 64 + kh * 32;
          if (key0 <= qw + 31) {
            f32x16 s = qk_tile_s((const bf16_t*)buf + kh * 32 * AD_KSTR, AD_KSTR, qf, l31, h2);
#pragma unroll
            for (int r = 0; r < 16; ++r) { const int key = key0 + crow(r, h2); if (!sel || key > t) s[r] = -INFINITY; }
            softmax_pv(s, (const bf16_t*)(buf + 64 * AD_KSTR * 2) + kh * 32, AD_VSTR, o, m, l, l31, h2);
          }
        }
        if (more) ad_store(nx, kvbuf + (pb ^ 1) * AD_BUF, tidf);
        __syncthreads();
        if (!more) break;
        rem &= rem - 1; j = jn; pb ^= 1;
      }
      const float il = l > 0.f ? g1 / l : 0.f;
#pragma unroll
      for (int dt = 0; dt < 2; ++dt)
#pragma unroll
        for (int r = 0; r < 16; ++r) ofin[dt][r] += il * o[dt][r];
    }
    {
      const bf16_t* Kw = p.KV() + (size_t)(4 * NB + b) * T * 64;
      const bf16_t* Vw = p.KV() + (size_t)(5 * NB + b) * 64 * T;
      f32x16 o[2]; o[0] = zero16(); o[1] = zero16();
      float m = -1e30f, l = 0.f;
      int k0 = max(0, q0 - 512);
      { const AdTile r = ad_load(Kw, Vw, k0, tidf); ad_store(r, kvbuf, tidf); }
      __syncthreads();
      int pb = 0;
      for (;;) {
        const bool more = k0 + 64 <= q0;
        AdTile nx;
        if (more) nx = ad_load(Kw, Vw, k0 + 64, tidf);
        const char* buf = kvbuf + pb * AD_BUF;
#pragma unroll
        for (int kh = 0; kh < 2; ++kh) {
          const int key0 = k0 + kh * 32;
          if (key0 <= qw + 31 && key0 + 31 + 512 > qw) {
            f32x16 s = qk_tile_s((const bf16_t*)buf + kh * 32 * AD_KSTR, AD_KSTR, qf, l31, h2);
            if (key0 + 31 > qw || key0 + 512 <= qw + 31) {
#pragma unroll
              for (int r = 0; r < 16; ++r) { const int key = key0 + crow(r, h2); if (key > t || t - key >= 512) s[r] = -INFINITY; }
            }
            softmax_pv(s, (const bf16_t*)(buf + 64 * AD_KSTR * 2) + kh * 32, AD_VSTR, o, m, l, l31, h2);
          }
        }
        if (more) ad_store(nx, kvbuf + (pb ^ 1) * AD_BUF, tidf);
        __syncthreads();
        if (!more) break;
        k0 += 64; pb ^= 1;
      }
      const float il = l > 0.f ? g2 / l : 0.f;
#pragma unroll
      for (int dt = 0; dt < 2; ++dt)
#pragma unroll
        for (int r = 0; r < 16; ++r) ofin[dt][r] += il * o[dt][r];
    }
#pragma unroll
    for (int dt = 0; dt < 2; ++dt)
#pragma unroll
      for (int g = 0; g < 4; ++g) {
        const int d0 = dt * 32 + 8 * g + 4 * h2;
        const u32x2 gz = *(const u32x2*)(p.GZ() + (size_t)4 * NTOK * 256 + tok * 256 + h * 64 + d0);
        const float z0 = __uint_as_float(gz.x << 16), z1 = __uint_as_float(gz.x & 0xffff0000u), z2 = __uint_as_float(gz.y << 16), z3 = __uint_as_float(gz.y & 0xffff0000u);
        u32x2 o2 = {pack2(ofin[dt][4 * g] * z0, ofin[dt][4 * g + 1] * z1), pack2(ofin[dt][4 * g + 2] * z2, ofin[dt][4 * g + 3] * z3)};
        *(u32x2*)(p.YMIX() + tok * 1024 + 768 + h * 64 + d0) = o2;
      }
  }
}

DI float logsigmoidf_(float x) { return fminf(x, 0.f) - __logf(1.f + __expf(-fabsf(x))); }
DI void mlstm_gates(const Params& p, size_t tok0, int hh, float* bc, float* ig, int tid) {
  if (tid < 64) {
    const int s0 = 2 * tid;
    const float lf0 = logsigmoidf_(p.IFG()[(tok0 + s0) * 8 + 4 + hh]), lf1 = logsigmoidf_(p.IFG()[(tok0 + s0 + 1) * 8 + 4 + hh]);
    const float pair = lf0 + lf1;
    float x = pair;
#pragma unroll
    for (int off = 1; off < 64; off <<= 1) { const float y = shup(x, off); if (tid >= off) x += y; }
    const float excl = x - pair;
    bc[s0] = excl + lf0; bc[s0 + 1] = excl + pair;
    ig[s0] = p.IFG()[(tok0 + s0) * 8 + hh]; ig[s0 + 1] = p.IFG()[(tok0 + s0 + 1) * 8 + hh];
  }
}
DI void conv8(const bf16_t* raw, int t, int dg, const float (&cw)[4][8], const float (&cb)[8], float (&out)[8]) {
#pragma unroll
  for (int e = 0; e < 8; ++e) out[e] = cb[e];
#pragma unroll
  for (int j = 0; j < 4; ++j) {
    const int ts = t - 3 + j;
    if (ts >= 0) {
      const u32x4 row = *(const u32x4*)(raw + (size_t)ts * 64 + dg * 8);
#pragma unroll
      for (int e2 = 0; e2 < 4; ++e2) { out[2 * e2] += cw[j][2 * e2] * __uint_as_float(row[e2] << 16); out[2 * e2 + 1] += cw[j][2 * e2 + 1] * __uint_as_float(row[e2] & 0xffff0000u); }
    }
  }
#pragma unroll
  for (int e = 0; e < 8; ++e) out[e] = siluf_(out[e]);
}
DI void load_conv_w(const Params& p, int layer, int ch0, int dg, float (&cw)[4][8], float (&cb)[8]) {
#pragma unroll
  for (int j = 0; j < 4; ++j)
#pragma unroll
    for (int e = 0; e < 8; ++e) cw[j][e] = p.conv_w[layer * 2048 + j * 512 + ch0 + dg * 8 + e];
#pragma unroll
  for (int e = 0; e < 8; ++e) cb[e] = p.conv_b[layer * 512 + ch0 + dg * 8 + e];
}
DI void delta_state(const bf16_t* VT, const bf16_t* KT, float* out, int wid, int l31, int h2) {
  const int mt = wid >> 1, nt = wid & 1;
  f32x16 acc = zero16();
#pragma unroll
  for (int ks = 0; ks < 8; ++ks) {
    const bf16x8 a = *(const bf16x8*)(VT + (size_t)(mt * 32 + l31) * T + ks * 16 + h2 * 8);
    const bf16x8 bb = *(const bf16x8*)(KT + (nt * 32 + l31) * 136 + ks * 16 + h2 * 8);
    acc = MFMA32(a, bb, acc);
  }
#pragma unroll
  for (int r = 0; r < 16; ++r) out[(mt * 32 + crow(r, h2)) * 64 + nt * 32 + l31] = acc[r];
}
DI void ph_mlstm_local(const Params& p, int layer, int item, char* smem) {
  float* bc = (float*)smem; float* ig = bc + 128; float* wv = ig + 128;
  bf16_t* KwT = (bf16_t*)(smem + 2048);
  float* nred = (float*)(smem + 2048 + 64 * 136 * 2);
  const int tid = tid_opaque(), lane = tid & 63, wid = tid >> 6, l31 = lane & 31, h2 = lane >> 5;
  const int b = item >> 6, hh = (item >> 4) & 3, c = item & 15, t0 = c * 128;
  const size_t tok0 = (size_t)b * T + t0;
  __syncthreads();
  mlstm_gates(p, tok0, hh, bc, ig, tid);
  __syncthreads();
  if (tid < 128) wv[tid] = __expf(bc[127] - bc[tid] + ig[tid]);
  __syncthreads();
  {
    const int dg = tid & 7;
    float cw[4][8], cb[8];
    load_conv_w(p, layer, 256 + hh * 64, dg, cw, cb);
    const bf16_t* raw = p.QKB() + ((size_t)(b * 8 + 4 + hh) * T) * 64;
#pragma unroll
    for (int i = 0; i < 4; ++i) {
      const int s = (tid >> 3) + 32 * i;
      float v[8];
      conv8(raw, t0 + s, dg, cw, cb, v);
      const float w = wv[s];
#pragma unroll
      for (int e = 0; e < 8; ++e) KwT[(dg * 8 + e) * 136 + s] = f2bf(v[e] * w);
    }
  }
  __syncthreads();
  delta_state(p.VBT() + (size_t)(b * 4 + hh) * 64 * T + t0, KwT, p.BST() + (size_t)item * 4096, wid, l31, h2);
  {
    const int k = tid & 63, qd = tid >> 6;
    float a = 0.f;
#pragma unroll 8
    for (int s = 0; s < 32; ++s) a += bf2f(KwT[k * 136 + qd * 32 + s]);
    nred[qd * 64 + k] = a;
  }
  __syncthreads();
  if (tid < 64) p.BN()[(size_t)item * 64 + tid] = (nred[tid] + nred[64 + tid]) + (nred[128 + tid] + nred[192 + tid]);
  if (tid == 0) p.BG()[item] = bc[127];
}
DI void ph_mlstm_scan(const Params& p, int bh) {
  const int tid = tid_opaque();
  f32x4 C[4];
#pragma unroll
  for (int i = 0; i < 4; ++i) C[i] = (f32x4){0.f, 0.f, 0.f, 0.f};
  float n = 0.f;
  for (int c = 0; c < 16; ++c) {
    const int item = bh * 16 + c;
    const float g = __expf(p.BG()[item]);
    f32x4* ptr = (f32x4*)(p.BST() + (size_t)item * 4096 + tid * 16);
#pragma unroll
    for (int i = 0; i < 4; ++i) { const f32x4 tmp = ptr[i]; ptr[i] = C[i]; C[i] = g * C[i] + tmp; }
    if (tid < 64) { const float tmp = p.BN()[(size_t)item * 64 + tid]; p.BN()[(size_t)item * 64 + tid] = n; n = g * n + tmp; }
  }
}
DI void pv_only(const f32x16& s, const bf16_t* VTp, int vstride, f32x16 (&o)[2], int l31, int h2) {
  const bf16x8 p0 = pack8<0>(s), p1 = pack8<8>(s);
#pragma unroll
  for (int dt = 0; dt < 2; ++dt) {
    const bf16_t* vp = VTp + (size_t)(dt * 32 + l31) * vstride + 4 * h2;
    o[dt] = MFMA32(ld_frag8x2(vp), p0, o[dt]);
    o[dt] = MFMA32(ld_frag8x2(vp + 16), p1, o[dt]);
  }
}
DI bf16x8 frag_from_f32(const float* ptr) {
  const f32x4 a = *(const f32x4*)ptr, b = *(const f32x4*)(ptr + 4);
  u32x4 t = {pack2(a[0], a[1]), pack2(a[2], a[3]), pack2(b[0], b[1]), pack2(b[2], b[3])};
  return __builtin_bit_cast(bf16x8, t);
}
DI void ph_mlstm_out(const Params& p, int layer, int item, char* smem) {
  float* bc = (float*)smem; float* ig = bc + 128;
  bf16_t* qc = (bf16_t*)(smem + 2048);
  bf16_t* kc = qc + 128 * 72;
  const int tid = tid_opaque(), lane = tid & 63, wid = tid >> 6, l31 = lane & 31, h2 = lane >> 5;
  const int b = item >> 6, hh = (item >> 4) & 3, c = item & 15, t0 = c * 128;
  const size_t tok0 = (size_t)b * T + t0;
  __syncthreads();
  mlstm_gates(p, tok0, hh, bc, ig, tid);
  {
    const int dg = tid & 7;
#pragma unroll
    for (int which = 0; which < 2; ++which) {
      float cw[4][8], cb[8];
      load_conv_w(p, layer, which * 256 + hh * 64, dg, cw, cb);
      const bf16_t* raw = p.QKB() + ((size_t)(b * 8 + which * 4 + hh) * T) * 64;
      bf16_t* dst = which ? kc : qc;
      const float sc = which ? 1.f : 0.125f;
#pragma unroll
      for (int i = 0; i < 4; ++i) {
        const int s = (tid >> 3) + 32 * i;
        float v[8];
        conv8(raw, t0 + s, dg, cw, cb, v);
        u32x4 w = {pack2(v[0] * sc, v[1] * sc), pack2(v[2] * sc, v[3] * sc), pack2(v[4] * sc, v[5] * sc), pack2(v[6] * sc, v[7] * sc)};
        *(u32x4*)(dst + s * 72 + dg * 8) = w;
      }
    }
  }
  __syncthreads();
  if (tid < 128) ig[tid] = ig[tid] - bc[tid];
  __syncthreads();
  const int tq = 32 * wid + l31;
  bf16x8 qf[4];
#pragma unroll
  for (int ks = 0; ks < 4; ++ks) qf[ks] = *(const bf16x8*)(qc + tq * 72 + ks * 16 + h2 * 8);
  const float bt = bc[tq];
  f32x16 o[2]; o[0] = zero16(); o[1] = zero16();
  float dsum = 0.f;
  const bf16_t* VT = p.VBT() + (size_t)(b * 4 + hh) * 64 * T + t0;
  for (int kt = 0; kt <= wid; ++kt) {
    f32x16 s = qk_tile_s(kc + kt * 32 * 72, 72, qf, l31, h2);
#pragma unroll
    for (int r = 0; r < 16; ++r) {
      const int sidx = 32 * kt + crow(r, h2);
      float val = s[r] * __expf(bt + ig[sidx]);
      if (sidx > tq) val = 0.f;
      s[r] = val; dsum += val;
    }
    pv_only(s, VT + kt * 32, T, o, l31, h2);
  }
  dsum += shx(dsum, 32);
  const float* Cs = p.BST() + (size_t)item * 4096;
  const float* ns = p.BN() + (size_t)item * 64;
  f32x16 oi[2]; oi[0] = zero16(); oi[1] = zero16();
  float qn = 0.f;
#pragma unroll
  for (int ks = 0; ks < 4; ++ks) {
#pragma unroll
    for (int dt = 0; dt < 2; ++dt) oi[dt] = MFMA32(frag_from_f32(Cs + (dt * 32 + l31) * 64 + ks * 16 + h2 * 8), qf[ks], oi[dt]);
    const u32x4 qu = __builtin_bit_cast(u32x4, qf[ks]);
    const f32x4 n0 = *(const f32x4*)(ns + ks * 16 + h2 * 8), n1 = *(const f32x4*)(ns + ks * 16 + h2 * 8 + 4);
    qn += __uint_as_float(qu[0] << 16) * n0[0] + __uint_as_float(qu[0] & 0xffff0000u) * n0[1] + __uint_as_float(qu[1] << 16) * n0[2] + __uint_as_float(qu[1] & 0xffff0000u) * n0[3];
    qn += __uint_as_float(qu[2] << 16) * n1[0] + __uint_as_float(qu[2] & 0xffff0000u) * n1[1] + __uint_as_float(qu[3] << 16) * n1[2] + __uint_as_float(qu[3] & 0xffff0000u) * n1[3];
  }
  qn += shx(qn, 32);
  const float ebt = __expf(bt);
  const float den = dsum + ebt * qn;
  const float inv = 1.f / fmaxf(fabsf(den), 1.f);
  const size_t tok = tok0 + tq;
#pragma unroll
  for (int dt = 0; dt < 2; ++dt)
#pragma unroll
    for (int g = 0; g < 4; ++g) {
      const int d0 = dt * 32 + 8 * g + 4 * h2;
      const u32x2 g1 = *(const u32x2*)(p.GZ() + (size_t)1 * NTOK * 256 + tok * 256 + hh * 64 + d0);
      const u32x2 g2 = *(const u32x2*)(p.GZ() + (size_t)2 * NTOK * 256 + tok * 256 + hh * 64 + d0);
      float z[4] = {__uint_as_float(g1.x << 16) * __uint_as_float(g2.x << 16), __uint_as_float(g1.x & 0xffff0000u) * __uint_as_float(g2.x & 0xffff0000u),
                    __uint_as_float(g1.y << 16) * __uint_as_float(g2.y << 16), __uint_as_float(g1.y & 0xffff0000u) * __uint_as_float(g2.y & 0xffff0000u)};
      float hv[4];
#pragma unroll
      for (int i = 0; i < 4; ++i) hv[i] = (o[dt][4 * g + i] + ebt * oi[dt][4 * g + i]) * inv * z[i];
      u32x2 o2 = {pack2(hv[0], hv[1]), pack2(hv[2], hv[3])};
      *(u32x2*)(p.YMIX() + tok * 1024 + 256 + hh * 64 + d0) = o2;
    }
}


DI void ph_hgrn_local(const Params& p, int layer, int item, char* smem) {
  float* tot = (float*)smem;
  bf16_t* KdT = (bf16_t*)(smem + 1024);
  const int tid = tid_opaque(), lane = tid & 63, wid = tid >> 6, l31 = lane & 31, h2 = lane >> 5;
  const int b = item >> 6, hh = (item >> 4) & 3, c = item & 15, t0 = c * 128;
  const int k = tid & 63, qd = tid >> 6;
  float al[32], kk[32];
  {
    const float* gp = p.GC() + ((size_t)(b * 4 + hh) * T + t0 + 32 * qd) * 64 + k;
    float run = 0.f;
#pragma unroll
    for (int s = 0; s < 32; ++s) { const float g = gp[s * 64]; run += g; al[s] = run; kk[s] = 1.f - __expf(g); }
    __syncthreads();
    tot[qd * 64 + k] = run;
  }
  __syncthreads();
  float off = 0.f, aL = 0.f;
#pragma unroll
  for (int q = 0; q < 4; ++q) { const float v = tot[q * 64 + k]; aL += v; if (q < qd) off += v; }
#pragma unroll
  for (int s8 = 0; s8 < 4; ++s8) {
    float v[8];
#pragma unroll
    for (int e = 0; e < 8; ++e) v[e] = kk[s8 * 8 + e] * __expf(aL - (al[s8 * 8 + e] + off));
    u32x4 w = {pack2(v[0], v[1]), pack2(v[2], v[3]), pack2(v[4], v[5]), pack2(v[6], v[7])};
    *(u32x4*)(KdT + k * 136 + qd * 32 + s8 * 8) = w;
  }
  __syncthreads();
  delta_state(p.VCT() + (size_t)(b * 4 + hh) * 64 * T + t0, KdT, p.CST() + (size_t)item * 4096, wid, l31, h2);
  if (qd == 0) p.CAL()[(size_t)item * 64 + k] = aL;
}
DI void ph_hgrn_scan(const Params& p, int bh) {
  const int tid = tid_opaque();
  f32x4 S[4];
#pragma unroll
  for (int i = 0; i < 4; ++i) S[i] = (f32x4){0.f, 0.f, 0.f, 0.f};
  for (int c = 0; c < 16; ++c) {
    const int item = bh * 16 + c;
    const f32x4* dp = (const f32x4*)(p.CAL() + (size_t)item * 64 + (tid & 3) * 16);
    f32x4* ptr = (f32x4*)(p.CST() + (size_t)item * 4096 + tid * 16);
#pragma unroll
    for (int i = 0; i < 4; ++i) {
      const f32x4 a = dp[i];
      const f32x4 dec = {__expf(a[0]), __expf(a[1]), __expf(a[2]), __expf(a[3])};
      const f32x4 tmp = ptr[i]; ptr[i] = S[i]; S[i] = dec * S[i] + tmp;
    }
  }
}
DI void ph_hgrn_out(const Params& p, int layer, int item, char* smem) {
  float* a_lds = (float*)smem;
  float* tot = (float*)(smem + 128 * 68 * 4);
  const int tid = tid_opaque(), lane = tid & 63, wid = tid >> 6, l31 = lane & 31, h2 = lane >> 5;
  const int b = item >> 6, hh = (item >> 4) & 3, c = item & 15, t0 = c * 128;
  const size_t hbase = (size_t)(b * 4 + hh) * T + t0;
  {
    const int k = tid & 63, qd = tid >> 6;
    float al[32];
    const float* gp = p.GC() + (hbase + 32 * qd) * 64 + k;
    float run = 0.f;
#pragma unroll
    for (int s = 0; s < 32; ++s) { run += gp[s * 64]; al[s] = run; }
    __syncthreads();
    tot[qd * 64 + k] = run;
    __syncthreads();
    float off = 0.f;
#pragma unroll
    for (int q = 0; q < 4; ++q) { const float v = tot[q * 64 + k]; if (q < qd) off += v; }
#pragma unroll
    for (int s = 0; s < 32; ++s) a_lds[(32 * qd + s) * 68 + k] = al[s] + off;
  }
  __syncthreads();
  const int tq = 32 * wid + l31;
  bf16x8 qi[4], qh[4];
#pragma unroll
  for (int ks = 0; ks < 4; ++ks) {
    const int k0 = ks * 16 + h2 * 8;
    const u32x4 qu = *(const u32x4*)(p.QC() + (hbase + tq) * 64 + k0);
    float q8[8], e1[8], e2[8];
#pragma unroll
    for (int e2i = 0; e2i < 4; ++e2i) { q8[2 * e2i] = __uint_as_float(qu[e2i] << 16); q8[2 * e2i + 1] = __uint_as_float(qu[e2i] & 0xffff0000u); }
#pragma unroll
    for (int e = 0; e < 8; ++e) {
      const float a = a_lds[tq * 68 + k0 + e];
      const float r = wid > 0 ? a_lds[(32 * wid - 1) * 68 + k0 + e] : 0.f;
      e1[e] = q8[e] * __expf(a - r); e2[e] = q8[e] * __expf(a);
    }
    u32x4 w1 = {pack2(e1[0], e1[1]), pack2(e1[2], e1[3]), pack2(e1[4], e1[5]), pack2(e1[6], e1[7])};
    u32x4 w2 = {pack2(e2[0], e2[1]), pack2(e2[2], e2[3]), pack2(e2[4], e2[5]), pack2(e2[6], e2[7])};
    qi[ks] = __builtin_bit_cast(bf16x8, w1); qh[ks] = __builtin_bit_cast(bf16x8, w2);
  }
  f32x16 o[2]; o[0] = zero16(); o[1] = zero16();
  const bf16_t* VT = p.VCT() + (size_t)(b * 4 + hh) * 64 * T + t0;
  for (int kt = 0; kt <= wid; ++kt) {
    f32x16 s = zero16();
    const int srow = 32 * kt + l31;
#pragma unroll
    for (int ks = 0; ks < 4; ++ks) {
      const int k0 = ks * 16 + h2 * 8;
      const f32x4 g0 = *(const f32x4*)(p.GC() + (hbase + srow) * 64 + k0), g1 = *(const f32x4*)(p.GC() + (hbase + srow) * 64 + k0 + 4);
      float v[8];
#pragma unroll
      for (int e = 0; e < 8; ++e) {
        const float g = e < 4 ? g0[e] : g1[e - 4];
        const float a = a_lds[srow * 68 + k0 + e];
        const float r = wid > 0 ? a_lds[(32 * wid - 1) * 68 + k0 + e] : 0.f;
        v[e] = (1.f - __expf(g)) * __expf(fminf(r - a, 80.f));
      }
      u32x4 w = {pack2(v[0], v[1]), pack2(v[2], v[3]), pack2(v[4], v[5]), pack2(v[6], v[7])};
      s = MFMA32(__builtin_bit_cast(bf16x8, w), qi[ks], s);
    }
    if (kt == wid) {
#pragma unroll
      for (int r = 0; r < 16; ++r) if (32 * kt + crow(r, h2) > tq) s[r] = 0.f;
    }
    pv_only(s, VT + kt * 32, T, o, l31, h2);
  }
  {
    const float* Ss = p.CST() + (size_t)item * 4096;
#pragma unroll
    for (int ks = 0; ks < 4; ++ks)
#pragma unroll
      for (int dt = 0; dt < 2; ++dt) o[dt] = MFMA32(frag_from_f32(Ss + (dt * 32 + l31) * 64 + ks * 16 + h2 * 8), qh[ks], o[dt]);
  }
  float ss = 0.f;
#pragma unroll
  for (int dt = 0; dt < 2; ++dt)
#pragma unroll
    for (int r = 0; r < 16; ++r) ss += o[dt][r] * o[dt][r];
  ss += shx(ss, 32);
  const float rs = rsqrtf(ss * (1.f / 64.f) + 1e-6f);
  const size_t tok = (size_t)b * T + t0 + tq;
#pragma unroll
  for (int dt = 0; dt < 2; ++dt)
#pragma unroll
    for (int g = 0; g < 4; ++g) {
      const int d0 = dt * 32 + 8 * g + 4 * h2;
      const u32x2 gz = *(const u32x2*)(p.GZ() + (size_t)3 * NTOK * 256 + tok * 256 + hh * 64 + d0);
      const f32x4 gn = *(const f32x4*)(p.c_norm_g + layer * 256 + hh * 64 + d0);
      const float z0 = __uint_as_float(gz.x << 16), z1 = __uint_as_float(gz.x & 0xffff0000u), z2 = __uint_as_float(gz.y << 16), z3 = __uint_as_float(gz.y & 0xffff0000u);
      u32x2 o2 = {pack2(o[dt][4 * g] * rs * gn[0] * z0, o[dt][4 * g + 1] * rs * gn[1] * z1), pack2(o[dt][4 * g + 2] * rs * gn[2] * z2, o[dt][4 * g + 3] * rs * gn[3] * z3)};
      *(u32x2*)(p.YMIX() + tok * 1024 + 512 + hh * 64 + d0) = o2;
    }
}


DI void ph_attnA(const Params& p, int layer, int item, char* smem) {
  const int tid = tid_opaque(), lane = tid & 63, h = tid >> 6, l31 = lane & 31, h2 = lane >> 5;
  const int b = item >> 6, q0 = (item & 63) * 32, g = h >> 1;
  const int t = q0 + l31;
  const size_t tok = (size_t)b * T + t;
  bf16x8 qf[4];
  {
    const bf16_t* qp = p.QA() + ((size_t)(b * 4 + h) * T + t) * 64 + h2 * 8;
#pragma unroll
    for (int ks = 0; ks < 4; ++ks) qf[ks] = *(const bf16x8*)(qp + ks * 16);
  }
  const bf16_t* Kp = p.KA() + (size_t)(b * 2 + g) * T * 64;
  const bf16_t* Vp = p.VAT() + (size_t)(b * 2 + g) * 64 * T;
  f32x16 o[2]; o[0] = zero16(); o[1] = zero16();
  float m = -1e30f, l = 0.f;
  for (int key0 = max(0, q0 - 128); key0 <= q0; key0 += 32) {
    f32x16 s = qk_tile(Kp + (size_t)key0 * 64, qf, l31, h2);
    if (key0 == q0 - 128 || key0 == q0) {
#pragma unroll
      for (int r = 0; r < 16; ++r) { const int key = key0 + crow(r, h2); if (key > t || t - key >= 128) s[r] = -INFINITY; }
    }
    softmax_pv(s, Vp + key0, T, o, m, l, l31, h2);
  }
  const float sink = p.a_sinks[layer * 4 + h];
  const float M = fmaxf(m, sink);
  const float sc = __expf(m - M);
  const float inv = sc / (l * sc + __expf(sink - M));
#pragma unroll
  for (int dt = 0; dt < 2; ++dt)
#pragma unroll
    for (int gq = 0; gq < 4; ++gq) {
      const int d0 = dt * 32 + 8 * gq + 4 * h2;
      const u32x2 gz = *(const u32x2*)(p.GZ() + tok * 256 + h * 64 + d0);
      const float z0 = __uint_as_float(gz.x << 16), z1 = __uint_as_float(gz.x & 0xffff0000u), z2 = __uint_as_float(gz.y << 16), z3 = __uint_as_float(gz.y & 0xffff0000u);
      u32x2 o2 = {pack2(o[dt][4 * gq] * inv * z0, o[dt][4 * gq + 1] * inv * z1), pack2(o[dt][4 * gq + 2] * inv * z2, o[dt][4 * gq + 3] * inv * z3)};
      *(u32x2*)(p.YMIX() + tok * 1024 + h * 64 + d0) = o2;
    }
}

DI void ph_cmp(const Params& p, int layer, int item, char* smem) {
  float* red = (float*)smem;
  bf16_t* hid = (bf16_t*)(smem + 32768);
  const int tid = tid_opaque(), lane = tid & 63, wid = tid >> 6, l31 = lane & 31, h2 = lane >> 5;
  const int b = item >> 3, kvsel = (item >> 2) & 1, mt = item & 3;
  const int lk = layer * 2 + kvsel;
  const int n = min(mt * 32 + l31, 126);
  const bf16_t* src = p.KV() + ((size_t)(kvsel * NB + b) * T + 16 * n) * 64 + wid * 512 + h2 * 8;
  const bf16_t* w1t = p.W1T() + (size_t)lk * 64 * 2048 + wid * 512 + h2 * 8;
  f32x16 acc[2]; acc[0] = zero16(); acc[1] = zero16();
#pragma unroll 4
  for (int ks = 0; ks < 32; ++ks) {
    const bf16x8 a = *(const bf16x8*)(src + ks * 16);
    const bf16x8 b0 = *(const bf16x8*)(w1t + (size_t)l31 * 2048 + ks * 16);
    const bf16x8 b1 = *(const bf16x8*)(w1t + (size_t)(32 + l31) * 2048 + ks * 16);
    acc[0] = MFMA32(a, b0, acc[0]); acc[1] = MFMA32(a, b1, acc[1]);
  }
  __syncthreads();
#pragma unroll
  for (int nt = 0; nt < 2; ++nt)
#pragma unroll
    for (int r = 0; r < 16; ++r) red[(wid * 32 + crow(r, h2)) * 64 + nt * 32 + l31] = acc[nt][r];
  __syncthreads();
  {
    const int row = tid >> 3, c0 = (tid & 7) * 8;
    float v[8];
#pragma unroll
    for (int e = 0; e < 8; ++e) {
      const float x = (red[(0 * 32 + row) * 64 + c0 + e] + red[(1 * 32 + row) * 64 + c0 + e]) + (red[(2 * 32 + row) * 64 + c0 + e] + red[(3 * 32 + row) * 64 + c0 + e]) + p.CVEC()[lk * 64 + c0 + e];
      v[e] = siluf_(x);
    }
    u32x4 w = {pack2(v[0], v[1]), pack2(v[2], v[3]), pack2(v[4], v[5]), pack2(v[6], v[7])};
    *(u32x4*)(hid + row * 72 + c0) = w;
  }
  __syncthreads();
  if (wid == 0) {
    f32x16 o[2]; o[0] = zero16(); o[1] = zero16();
    const bf16_t* w2t = p.W2T() + (size_t)lk * 4096;
#pragma unroll
    for (int ks = 0; ks < 4; ++ks) {
      const bf16x8 a = *(const bf16x8*)(hid + l31 * 72 + ks * 16 + h2 * 8);
#pragma unroll
      for (int nt = 0; nt < 2; ++nt) o[nt] = MFMA32(a, *(const bf16x8*)(w2t + (nt * 32 + l31) * 64 + ks * 16 + h2 * 8), o[nt]);
    }
    if (kvsel == 0) {
#pragma unroll
      for (int r = 0; r < 16; ++r) {
        const int nn = mt * 32 + crow(r, h2);
        if (nn < 127) {
          const int pos = 16 * nn + 31;
          const float cs = p.ROPEC()[pos * 32 + l31], sn = p.ROPES()[pos * 32 + l31];
          p.KCMP()[((size_t)b * 128 + nn) * 64 + l31] = f2bf(o[0][r] * cs - o[1][r] * sn);
          p.KCMP()[((size_t)b * 128 + nn) * 64 + 32 + l31] = f2bf(o[0][r] * sn + o[1][r] * cs);
        }
      }
    } else {
#pragma unroll
      for (int nt = 0; nt < 2; ++nt)
#pragma unroll
        for (int r = 0; r < 16; ++r) {
          const int nn = mt * 32 + crow(r, h2);
          if (nn < 127) p.VCMPT()[((size_t)b * 64 + nt * 32 + l31) * 128 + nn] = f2bf(o[nt][r]);
        }
    }
  }
}


#define XB_TMO      128
#define XB_XCNT(j)  (256  + 64 * (j))
#define XB_XSUB(j)  (1280 + 64 * (j))
#define XB_XGEN(j)  (2304 + 64 * (j))
#define XB_TOP      3328
#define XB_TOPGEN   3392
#define XCD_BAR_WORDS 3456
#define XB_SPIN_CAP (1u << 22)
DI unsigned xb_ld(unsigned* p)              { return __hip_atomic_load(p, __ATOMIC_RELAXED, __HIP_MEMORY_SCOPE_AGENT); }
DI unsigned xb_add(unsigned* p, unsigned v) { return __hip_atomic_fetch_add(p, v, __ATOMIC_RELAXED, __HIP_MEMORY_SCOPE_AGENT); }
DI unsigned xb_xcc_id() { return (unsigned)__builtin_amdgcn_s_getreg((3 << 11) | 20) & 0xFu; }
#define XB_SPIN(cond, bar) do { unsigned _sp = 0; while (cond) { __builtin_amdgcn_s_sleep(1); \
    if ((++_sp & 255u) == 0u) { if (xb_ld(&(bar)[XB_TMO])) break; if (_sp > XB_SPIN_CAP) { atomicAdd(&(bar)[XB_TMO], 1u); break; } } } } while (0)
struct XcdBarrier { unsigned* bar; unsigned x; volatile LAS unsigned* st; };
DI XcdBarrier xcd_barrier_post(unsigned* bar, volatile LAS unsigned* st) {
  XcdBarrier b; b.bar = bar; b.x = xb_xcc_id(); b.st = st;
  if (threadIdx.x == 0) (void)xb_add(&bar[XB_XCNT(b.x)], 1u);
  return b;
}
DI void xcd_barrier_complete(unsigned* bar, unsigned x, unsigned& nloc, unsigned& nx) {
  const unsigned G = gridDim.x * gridDim.y * gridDim.z;
  unsigned sum, cnt, mine, sp = 0u;
  for (;;) {
    sum = 0u; cnt = 0u; mine = 0u;
#pragma unroll
    for (unsigned j = 0; j < 16; ++j) { const unsigned c = xb_ld(&bar[XB_XCNT(j)]); sum += c; cnt += (c > 0u) ? 1u : 0u; mine = (j == x) ? c : mine; }
    if (sum == G) break;
    __builtin_amdgcn_s_sleep(1);
    if ((++sp & 255u) == 0u) { if (xb_ld(&bar[XB_TMO])) break; if (sp > XB_SPIN_CAP) { atomicAdd(&bar[XB_TMO], 1u); break; } }
  }
  nloc = mine > 0u ? mine : 1u; nx = cnt > 0u ? cnt : 1u;
}
DI void xcd_barrier(const XcdBarrier& b) {
  asm volatile("s_waitcnt vmcnt(0)" ::: "memory");
  __syncthreads();
  int t0_ = threadIdx.x; asm volatile("" : "+v"(t0_));
  if (t0_ == 0) {
    unsigned* bar = b.bar;
    __builtin_amdgcn_s_waitcnt(0);
    unsigned nloc = b.st[0], nx = b.st[1];
    if (nloc == 0u) { xcd_barrier_complete(bar, b.x, nloc, nx); b.st[0] = nloc; b.st[1] = nx; }
    const unsigned old = xb_add(&bar[XB_XSUB(b.x)], 1u);
    const unsigned gen = old / nloc;
    if (old + 1u == (gen + 1u) * nloc) {
      __builtin_amdgcn_fence(__ATOMIC_RELEASE, "agent");
      asm volatile("s_waitcnt vmcnt(0)" ::: "memory");
      const unsigned og = xb_add(&bar[XB_TOP], 1u);
      const unsigned tg = og / nx;
      if (og + 1u == (tg + 1u) * nx) xb_add(&bar[XB_TOPGEN], 1u);
      else XB_SPIN(xb_ld(&bar[XB_TOPGEN]) == tg, bar);
      __builtin_amdgcn_fence(__ATOMIC_ACQUIRE, "agent");
      xb_add(&bar[XB_XGEN(b.x)], 1u);
      asm volatile("s_waitcnt vmcnt(0)" ::: "memory");
    } else {
      XB_SPIN(xb_ld(&bar[XB_XGEN(b.x)]) == gen, bar);
      __builtin_amdgcn_fence(__ATOMIC_ACQUIRE, "agent");
      asm volatile("s_waitcnt vmcnt(0)" ::: "memory");
    }
  }
  __syncthreads();
}

constexpr int HALF_LDS = 40960;
__global__ void __launch_bounds__(512) mega(Params p) {
  __shared__ __attribute__((aligned(16))) char smem_all[131072 + 32];
  cg::grid_group grid = cg::this_grid();
  const int half = half_id();
  const int bid = blockIdx.x, nblk = gridDim.x;
  const int vbid = 2 * bid + half, nvblk = 2 * nblk;
  char* smem = smem_all + half * HALF_LDS;
  unsigned* xbw = (unsigned*)(smem_all + 131072);
  int* s_pair = (int*)(smem_all + 131072 + 16);
  if (threadIdx.x == 0) { xbw[0] = 0u; xbw[1] = 0u; }
  __syncthreads();
  const XcdBarrier xb = xcd_barrier_post(p.XBAR(), (volatile LAS unsigned*)xbw);
  ph_prologue(p, vbid, nvblk, smem);
  ln_rows(p, 0, 0, vbid, nvblk);
  if (PROBE == 5) { ph_prologue(p, vbid, nvblk, smem); ln_rows(p, 0, 0, vbid, nvblk); }
  grid.sync();
  for (int l = 0; l < 2; ++l) {
    ph_gemm_in(p, l, bid, nblk, smem_all);
    if (PROBE == 1) ph_gemm_in(p, l, bid, nblk, smem_all);
    xcd_barrier(xb);
    for (int rep = 0; rep < (PROBE == 3 ? 2 : 1); ++rep) {
    for (int item = vbid; item < 2048; item += nvblk) ph_mlstm_local(p, l, item, smem);
    for (int item = vbid; item < 2048; item += nvblk) ph_hgrn_local(p, l, item, smem);
    __syncthreads();
    for (int item = vbid; item < 256; item += nvblk) ph_cmp(p, l, item, smem);
    for (int item = vbid; item < 2048; item += nvblk) ph_attnA(p, l, item, smem);
    }
    xcd_barrier(xb);
    if (vbid < 128) ph_mlstm_scan(p, vbid);
    else if (vbid < 256) ph_hgrn_scan(p, vbid - 128);
    __syncthreads();
    ph_attnD(p, l, p.CTR() + l, smem_all, s_pair);
    if (PROBE == 2) ph_attnD(p, l, p.CTR() + 2 + l, smem_all, s_pair);
    xcd_barrier(xb);
    for (int rep = 0; rep < (PROBE == 4 ? 2 : 1); ++rep) {
    for (int item = vbid; item < 2048; item += nvblk) ph_mlstm_out(p, l, item, smem);
    for (int item = vbid; item < 2048; item += nvblk) ph_hgrn_out(p, l, item, smem);
    }
    xcd_barrier(xb);
    ph_gemm_out_ln(p, l, bid, nblk, smem_all);
    if (l == 0) xcd_barrier(xb);
  }
}

static inline size_t align_up(size_t v) { return (v + 255) & ~(size_t)255; }

extern "C" void kernel_launch(void* const* d_in, const int* in_sizes, int n_in, void* d_out, int out_size, void* d_ws, size_t ws_size, hipStream_t stream) {
  Params p{};
  p.x = (const float*)d_in[0]; p.ln0_g = (const float*)d_in[1]; p.ln0_b = (const float*)d_in[2]; p.w_in = (const float*)d_in[3];
  p.b_in = (const float*)d_in[4]; p.a_sinks = (const float*)d_in[5]; p.conv_w = (const float*)d_in[6]; p.conv_b = (const float*)d_in[7];
  p.c_lb = (const float*)d_in[8]; p.c_norm_g = (const float*)d_in[9]; p.pe = (const float*)d_in[10]; p.w1 = (const float*)d_in[11];
  p.w2 = (const float*)d_in[12]; p.w_out = (const float*)d_in[13]; p.ln_g = (const float*)d_in[14]; p.ln_b = (const float*)d_in[15];
  p.hf = (float*)d_out;
  p.ws = (char*)d_ws;
  if (WS_TOTAL > ws_size) { fprintf(stderr, "workspace too small: need %zu have %zu\n", (size_t)WS_TOTAL, ws_size); return; }

  static int grid_blocks = 0;
  if (!grid_blocks) {
    int dev = 0, cus = 0, per_cu = 0;
    (void)hipGetDevice(&dev);
    (void)hipDeviceGetAttribute(&cus, hipDeviceAttributeMultiprocessorCount, dev);
    (void)hipOccupancyMaxActiveBlocksPerMultiprocessor(&per_cu, mega, 512, 0);
    if (per_cu > 1) per_cu = 1;
    grid_blocks = cus * per_cu;
  }
  (void)hipMemsetAsync((char*)d_ws + OFF_XBAR, 0, XCD_BAR_WORDS * 4, stream);
  void* args[] = {&p};
  hipError_t e = hipLaunchCooperativeKernel((void*)mega, dim3(grid_blocks), dim3(512), args, 0, stream);
  if (e != hipSuccess) fprintf(stderr, "cooperative launch failed: %s (grid %d)\n", hipGetErrorString(e), grid_blocks);
}
```

```cpp
#include <hip/hip_runtime.h>
#include <hip/hip_cooperative_groups.h>
#include <stdio.h>
#include <stdint.h>
#include <stddef.h>

#ifndef PROBE
#define PROBE 0
#endif
#define DI __device__ __forceinline__
typedef unsigned short bf16_t;
typedef short bf16x8 __attribute__((ext_vector_type(8)));
typedef float f32x16 __attribute__((ext_vector_type(16)));
typedef unsigned u32x4 __attribute__((ext_vector_type(4)));
typedef float f32x4 __attribute__((ext_vector_type(4)));

constexpr int NB = 32, T = 2048, DM = 1024, NTOK = NB * T, NP = 4096;
constexpr float DN_ALPHA = 1.41421356237309515f;

constexpr size_t OFF_HB = 0;
constexpr size_t SZ_HB = (size_t)NTOK * 1024 * 2;
constexpr size_t OFF_YMIX = OFF_HB + ((SZ_HB + 255) & ~(size_t)255);
constexpr size_t SZ_YMIX = (size_t)NTOK * 1024 * 2;
constexpr size_t OFF_QA = OFF_YMIX + ((SZ_YMIX + 255) & ~(size_t)255);
constexpr size_t SZ_QA = (size_t)NTOK * 256 * 2;
constexpr size_t OFF_KA = OFF_QA + ((SZ_QA + 255) & ~(size_t)255);
constexpr size_t SZ_KA = (size_t)NTOK * 128 * 2;
constexpr size_t OFF_VAT = OFF_KA + ((SZ_KA + 255) & ~(size_t)255);
constexpr size_t SZ_VAT = (size_t)NTOK * 128 * 2;
constexpr size_t OFF_QKB = OFF_VAT + ((SZ_VAT + 255) & ~(size_t)255);
constexpr size_t SZ_QKB = (size_t)NTOK * 512 * 2;
constexpr size_t OFF_VBT = OFF_QKB + ((SZ_QKB + 255) & ~(size_t)255);
constexpr size_t SZ_VBT = (size_t)NTOK * 256 * 2;
constexpr size_t OFF_QC = OFF_VBT + ((SZ_VBT + 255) & ~(size_t)255);
constexpr size_t SZ_QC = (size_t)NTOK * 256 * 2;
constexpr size_t OFF_GC = OFF_QC + ((SZ_QC + 255) & ~(size_t)255);
constexpr size_t SZ_GC = (size_t)NTOK * 256 * 4;
constexpr size_t OFF_VCT = OFF_GC + ((SZ_GC + 255) & ~(size_t)255);
constexpr size_t SZ_VCT = (size_t)NTOK * 256 * 2;
constexpr size_t OFF_QD = OFF_VCT + ((SZ_VCT + 255) & ~(size_t)255);
constexpr size_t SZ_QD = (size_t)NTOK * 256 * 2;
constexpr size_t OFF_KV = OFF_QD + ((SZ_QD + 255) & ~(size_t)255);
constexpr size_t SZ_KV = (size_t)NTOK * 384 * 2;
constexpr size_t OFF_GZ = OFF_KV + ((SZ_KV + 255) & ~(size_t)255);
constexpr size_t SZ_GZ = (size_t)NTOK * 1280 * 2;
constexpr size_t OFF_IFG = OFF_GZ + ((SZ_GZ + 255) & ~(size_t)255);
constexpr size_t SZ_IFG = (size_t)NTOK * 8 * 4;
constexpr size_t OFF_DG = OFF_IFG + ((SZ_IFG + 255) & ~(size_t)255);
constexpr size_t SZ_DG = (size_t)NTOK * 12 * 4;
constexpr size_t OFF_WT = OFF_DG + ((SZ_DG + 255) & ~(size_t)255);
constexpr size_t SZ_WT = (size_t)2 * NP * 1024 * 2;
constexpr size_t OFF_WOT = OFF_WT + ((SZ_WT + 255) & ~(size_t)255);
constexpr size_t SZ_WOT = (size_t)2 * 1024 * 1024 * 2;
constexpr size_t OFF_KCMP = OFF_WOT + ((SZ_WOT + 255) & ~(size_t)255);
constexpr size_t SZ_KCMP = (size_t)NB * 128 * 64 * 2;
constexpr size_t OFF_VCMPT = OFF_KCMP + ((SZ_KCMP + 255) & ~(size_t)255);
constexpr size_t SZ_VCMPT = (size_t)NB * 64 * 128 * 2;
constexpr size_t OFF_BIASP = OFF_VCMPT + ((SZ_VCMPT + 255) & ~(size_t)255);
constexpr size_t SZ_BIASP = (size_t)2 * NP * 4;
constexpr size_t OFF_LB = OFF_BIASP + ((SZ_BIASP + 255) & ~(size_t)255);
constexpr size_t SZ_LB = (size_t)512 * 4;
constexpr size_t OFF_ROPEC = OFF_LB + ((SZ_LB + 255) & ~(size_t)255);
constexpr size_t SZ_ROPEC = (size_t)T * 32 * 4;
constexpr size_t OFF_ROPES = OFF_ROPEC + ((SZ_ROPEC + 255) & ~(size_t)255);
constexpr size_t SZ_ROPES = (size_t)T * 32 * 4;
constexpr size_t OFF_BST = OFF_ROPES + ((SZ_ROPES + 255) & ~(size_t)255);
constexpr size_t SZ_BST = (size_t)2048 * 4096 * 4;
constexpr size_t OFF_BN = OFF_BST + ((SZ_BST + 255) & ~(size_t)255);
constexpr size_t SZ_BN = (size_t)2048 * 64 * 4;
constexpr size_t OFF_BG = OFF_BN + ((SZ_BN + 255) & ~(size_t)255);
constexpr size_t SZ_BG = (size_t)2048 * 4;
constexpr size_t OFF_CST = OFF_BG + ((SZ_BG + 255) & ~(size_t)255);
constexpr size_t SZ_CST = (size_t)2048 * 4096 * 4;
constexpr size_t OFF_CAL = OFF_CST + ((SZ_CST + 255) & ~(size_t)255);
constexpr size_t SZ_CAL = (size_t)2048 * 64 * 4;
constexpr size_t OFF_W1T = OFF_CAL + ((SZ_CAL + 255) & ~(size_t)255);
constexpr size_t SZ_W1T = (size_t)4 * 64 * 2048 * 2;
constexpr size_t OFF_W2T = OFF_W1T + ((SZ_W1T + 255) & ~(size_t)255);
constexpr size_t SZ_W2T = (size_t)4 * 64 * 64 * 2;
constexpr size_t OFF_CVEC = OFF_W2T + ((SZ_W2T + 255) & ~(size_t)255);
constexpr size_t SZ_CVEC = (size_t)256 * 4;
constexpr size_t OFF_CTR = OFF_CVEC + ((SZ_CVEC + 255) & ~(size_t)255);
constexpr size_t SZ_CTR = (size_t)256;
constexpr size_t OFF_XBAR = OFF_CTR + ((SZ_CTR + 255) & ~(size_t)255);
constexpr size_t SZ_XBAR = (size_t)3456 * 4;
constexpr size_t OFF_LNS = OFF_XBAR + ((SZ_XBAR + 255) & ~(size_t)255);
constexpr size_t SZ_LNS = (size_t)NTOK * 2 * 4;
constexpr size_t WS_TOTAL = OFF_LNS + ((SZ_LNS + 255) & ~(size_t)255);
struct Params {
  const float *x, *ln0_g, *ln0_b, *w_in, *b_in, *a_sinks, *conv_w, *conv_b, *c_lb, *c_norm_g, *pe, *w1, *w2, *w_out, *ln_g, *ln_b;
  float* hf;
  char* ws;
  DI bf16_t* HB() const { return (bf16_t*)(ws + OFF_HB); }
  DI bf16_t* YMIX() const { return (bf16_t*)(ws + OFF_YMIX); }
  DI bf16_t* QA() const { return (bf16_t*)(ws + OFF_QA); }
  DI bf16_t* KA() const { return (bf16_t*)(ws + OFF_KA); }
  DI bf16_t* VAT() const { return (bf16_t*)(ws + OFF_VAT); }
  DI bf16_t* QKB() const { return (bf16_t*)(ws + OFF_QKB); }
  DI bf16_t* VBT() const { return (bf16_t*)(ws + OFF_VBT); }
  DI bf16_t* QC() const { return (bf16_t*)(ws + OFF_QC); }
  DI float* GC() const { return (float*)(ws + OFF_GC); }
  DI bf16_t* VCT() const { return (bf16_t*)(ws + OFF_VCT); }
  DI bf16_t* QD() const { return (bf16_t*)(ws + OFF_QD); }
  DI bf16_t* KV() const { return (bf16_t*)(ws + OFF_KV); }
  DI bf16_t* GZ() const { return (bf16_t*)(ws + OFF_GZ); }
  DI float* IFG() const { return (float*)(ws + OFF_IFG); }
  DI float* DG() const { return (float*)(ws + OFF_DG); }
  DI bf16_t* WT() const { return (bf16_t*)(ws + OFF_WT); }
  DI bf16_t* WOT() const { return (bf16_t*)(ws + OFF_WOT); }
  DI bf16_t* KCMP() const { return (bf16_t*)(ws + OFF_KCMP); }
  DI bf16_t* VCMPT() const { return (bf16_t*)(ws + OFF_VCMPT); }
  DI float* BIASP() const { return (float*)(ws + OFF_BIASP); }
  DI float* LB() const { return (float*)(ws + OFF_LB); }
  DI float* ROPEC() const { return (float*)(ws + OFF_ROPEC); }
  DI float* ROPES() const { return (float*)(ws + OFF_ROPES); }
  DI float* BST() const { return (float*)(ws + OFF_BST); }
  DI float* BN() const { return (float*)(ws + OFF_BN); }
  DI float* BG() const { return (float*)(ws + OFF_BG); }
  DI float* CST() const { return (float*)(ws + OFF_CST); }
  DI float* CAL() const { return (float*)(ws + OFF_CAL); }
  DI bf16_t* W1T() const { return (bf16_t*)(ws + OFF_W1T); }
  DI bf16_t* W2T() const { return (bf16_t*)(ws + OFF_W2T); }
  DI float* CVEC() const { return (float*)(ws + OFF_CVEC); }
  DI int* CTR() const { return (int*)(ws + OFF_CTR); }
  DI unsigned* XBAR() const { return (unsigned*)(ws + OFF_XBAR); }
  DI float* LNS() const { return (float*)(ws + OFF_LNS); }
};
namespace cg = cooperative_groups;

DI int tid_opaque() { int t = threadIdx.x & 255; asm volatile("" : "+v"(t)); return t; }
DI int half_id() { return __builtin_amdgcn_readfirstlane((int)(threadIdx.x >> 8)); }
DI float bf2f(bf16_t v) { return __uint_as_float(((unsigned)v) << 16); }
DI bf16_t f2bf(float x) { unsigned u = __float_as_uint(x); u += 0x7fffu + ((u >> 16) & 1u); return (bf16_t)(u >> 16); }
DI float sigmoidf_(float x) { return __builtin_amdgcn_rcpf(1.f + __builtin_amdgcn_exp2f(-1.4426950408889634f * x)); }
DI float siluf_(float x) { return x * __builtin_amdgcn_rcpf(1.f + __builtin_amdgcn_exp2f(-1.4426950408889634f * x)); }
DI int lane_op() { int l = threadIdx.x & 63; asm volatile("" : "+v"(l)); return l; }
DI float shx(float v, int m) { return __builtin_bit_cast(float, __builtin_amdgcn_ds_bpermute((lane_op() ^ m) << 2, __builtin_bit_cast(int, v))); }
DI unsigned shx(unsigned v, int m) { return (unsigned)__builtin_amdgcn_ds_bpermute((lane_op() ^ m) << 2, (int)v); }
DI float shup(float v, int d) { const int l = lane_op(); const int s = l - d; return __builtin_bit_cast(float, __builtin_amdgcn_ds_bpermute((s < 0 ? l : s) << 2, __builtin_bit_cast(int, v))); }
DI float wave_sum(float v) { for (int o = 32; o > 0; o >>= 1) v += shx(v, o); return v; }
DI float wave_max(float v) { for (int o = 32; o > 0; o >>= 1) v = fmaxf(v, shx(v, o)); return v; }

DI int orig_col(int n) {
  if (n < 1536) return n;
  if (n < 3712) return n + 8;
  if (n < 3968) return n + 20;
  if (n < 3976) return 1536 + (n - 3968);
  if (n < 3988) return 3720 + (n - 3976);
  return -1;
}

DI bool head_is_paired(int hd);
DI void ph_prologue(const Params& p, int bid, int nblk, char* smem) {
  const long gtid = (long)bid * 256 + tid_opaque(), gsz = (long)nblk * 256;
  if (gtid < 64) p.CTR()[gtid] = 0;
  for (long idx = gtid; idx < 2L * 128 * NP; idx += gsz) {
    const int n = (int)(idx % NP), k8 = (int)((idx / NP) % 128), l = (int)(idx / (NP * 128));
    const int pp = n & 63, w_ = pp >> 5, rr = pp & 31, n_ = rr >> 4, fq_ = (rr >> 2) & 3, j_ = rr & 3;
    const int lc = head_is_paired(n >> 6) ? (32 * n_ + 16 * w_ + 4 * fq_ + j_) : (32 * w_ + 8 * fq_ + 4 * n_ + j_);
    const int oc = orig_col((n & ~63) + lc);
    unsigned w[4];
    for (int j = 0; j < 4; ++j) {
      float a = 0.f, b = 0.f;
      if (oc >= 0) { a = p.w_in[((size_t)l * 1024 + k8 * 8 + 2 * j) * 3988 + oc]; b = p.w_in[((size_t)l * 1024 + k8 * 8 + 2 * j + 1) * 3988 + oc]; }
      w[j] = (unsigned)f2bf(a) | ((unsigned)f2bf(b) << 16);
    }
    *(uint4*)(p.WT() + ((size_t)l * NP + n) * 1024 + k8 * 8) = make_uint4(w[0], w[1], w[2], w[3]);
  }
  for (long idx = gtid; idx < 2L * 128 * 1024; idx += gsz) {
    const int d = (int)(idx % 1024), m8 = (int)((idx / 1024) % 128), l = (int)(idx / (1024 * 128));
    unsigned w[4];
    for (int j = 0; j < 4; ++j) {
      float a = p.w_out[((size_t)l * 1024 + m8 * 8 + 2 * j) * 1024 + d], b = p.w_out[((size_t)l * 1024 + m8 * 8 + 2 * j + 1) * 1024 + d];
      w[j] = (unsigned)f2bf(a) | ((unsigned)f2bf(b) << 16);
    }
    *(uint4*)(p.WOT() + ((size_t)l * 1024 + d) * 1024 + m8 * 8) = make_uint4(w[0], w[1], w[2], w[3]);
  }
  for (long idx = gtid; idx < 4L * 256 * 64; idx += gsz) {
    const int j = (int)(idx % 64), i8 = (int)((idx / 64) % 256), lk = (int)(idx / (64 * 256));
    unsigned w[4];
    for (int e = 0; e < 4; ++e) {
      const float a = p.w1[((size_t)lk * 2048 + i8 * 8 + 2 * e) * 64 + j], b = p.w1[((size_t)lk * 2048 + i8 * 8 + 2 * e + 1) * 64 + j];
      w[e] = (unsigned)f2bf(a) | ((unsigned)f2bf(b) << 16);
    }
    *(uint4*)(p.W1T() + ((size_t)lk * 64 + j) * 2048 + i8 * 8) = make_uint4(w[0], w[1], w[2], w[3]);
  }
  for (long idx = gtid; idx < 4L * 64 * 64; idx += gsz) {
    const int jo = (int)(idx % 64), ji = (int)((idx / 64) % 64), lk = (int)(idx / 4096);
    p.W2T()[((size_t)lk * 64 + jo) * 64 + ji] = f2bf(p.w2[((size_t)lk * 64 + ji) * 64 + jo]);
  }
  if (bid < 64) {
    const int lk = bid >> 4, seg = bid & 15, j = tid_opaque() & 63, part = tid_opaque() >> 6;
    float a = 0.f;
    const int i0 = seg * 128 + part * 32;
#pragma unroll 8
    for (int i = i0; i < i0 + 32; ++i) a += p.pe[(size_t)lk * 2048 + i] * p.w1[((size_t)lk * 2048 + i) * 64 + j];
    float* red = (float*)smem;
    __syncthreads();
    red[part * 64 + j] = a;
    __syncthreads();
    if (part == 0) atomicAdd(p.CVEC() + lk * 64 + j, (red[j] + red[64 + j]) + (red[128 + j] + red[192 + j]));
    __syncthreads();
  }
  for (long idx = gtid; idx < 2L * NP; idx += gsz) {
    const int n = (int)(idx % NP), l = (int)(idx / NP); const int oc = orig_col(n);
    p.BIASP()[idx] = oc >= 0 ? p.b_in[l * 3988 + oc] : 0.f;
  }
  for (long idx = gtid; idx < (long)T * 32; idx += gsz) {
    const int t = (int)(idx / 32), i = (int)(idx % 32);
    const float inv = exp2f(-(float)i * (13.287712379549449f / 32.0f));
    const float ang = (float)t * inv;
    p.ROPEC()[idx] = cosf(ang); p.ROPES()[idx] = sinf(ang);
  }
  for (long idx = gtid; idx < 512; idx += gsz) {
    const int c = (int)(idx % 256), l = (int)(idx / 256);
    const float a = p.c_lb[c], b = p.c_lb[256 + c];
    const float m = fmaxf(a, b); const float ea = expf(a - m), eb = expf(b - m);
    p.LB()[idx] = l == 0 ? 0.f : eb / (ea + eb);
  }
}

DI void ln_rows(const Params& p, int mode, int layer, int bid, int nblk) {
  const int tid_ = tid_opaque(); const int lane = tid_ & 63, wid = tid_ >> 6, nw = 4;
  const float* g = mode == 0 ? p.ln0_g : p.ln_g + layer * 1024;
  const float* bb = mode == 0 ? p.ln0_b : p.ln_b + layer * 1024;
  const float* src = mode == 0 ? p.x : p.hf;
  for (int row = bid * nw + wid; row < NTOK; row += nblk * nw) {
    const float* s = src + (size_t)row * 1024;
    float4 v[4];
    float sum = 0.f;
#pragma unroll
    for (int i = 0; i < 4; ++i) { v[i] = *(const float4*)(s + i * 256 + lane * 4); sum += (v[i].x + v[i].y) + (v[i].z + v[i].w); }
    sum = wave_sum(sum);
    const float mu = sum * (1.f / 1024.f);
    float q = 0.f;
#pragma unroll
    for (int i = 0; i < 4; ++i) { float a = v[i].x - mu, b = v[i].y - mu, c = v[i].z - mu, d = v[i].w - mu; q += (a * a + b * b) + (c * c + d * d); }
    q = wave_sum(q);
    const float rs = rsqrtf(q * (1.f / 1024.f) + 1e-5f);
    if (mode == 0 && lane == 0) { p.LNS()[(size_t)row * 2] = mu; p.LNS()[(size_t)row * 2 + 1] = rs; }
#pragma unroll
    for (int i = 0; i < 4; ++i) {
      const int c0 = i * 256 + lane * 4;
      const float4 gg = *(const float4*)(g + c0), b4 = *(const float4*)(bb + c0);
      float4 o;
      o.x = (v[i].x - mu) * rs * gg.x + b4.x; o.y = (v[i].y - mu) * rs * gg.y + b4.y;
      o.z = (v[i].z - mu) * rs * gg.z + b4.z; o.w = (v[i].w - mu) * rs * gg.w + b4.w;
      if (mode != 0) *(float4*)(p.hf + (size_t)row * 1024 + c0) = o;
      uint2 pk; pk.x = (unsigned)f2bf(o.x) | ((unsigned)f2bf(o.y) << 16); pk.y = (unsigned)f2bf(o.z) | ((unsigned)f2bf(o.w) << 16);
      *(uint2*)(p.HB() + (size_t)row * 1024 + c0) = pk;
    }
  }
}

typedef float f32x2 __attribute__((ext_vector_type(2)));
typedef __bf16 bf16v2 __attribute__((ext_vector_type(2)));
typedef unsigned u32x2 __attribute__((ext_vector_type(2)));
DI unsigned pack2(float a, float b) { f32x2 v = {a, b}; return __builtin_bit_cast(unsigned, __builtin_convertvector(v, bf16v2)); }
DI f32x16 zero16() { f32x16 z;
#pragma unroll
  for (int i = 0; i < 16; ++i) z[i] = 0.f; return z; }
DI bf16x8 ld_frag8x2(const bf16_t* p) { const u32x2 lo = *(const u32x2*)p, hi = *(const u32x2*)(p + 8); u32x4 t = {lo.x, lo.y, hi.x, hi.y}; return __builtin_bit_cast(bf16x8, t); }
template <int BASE> DI bf16x8 pack8(const f32x16& s) {
  u32x4 t = {pack2(s[BASE + 0], s[BASE + 1]), pack2(s[BASE + 2], s[BASE + 3]), pack2(s[BASE + 4], s[BASE + 5]), pack2(s[BASE + 6], s[BASE + 7])};
  return __builtin_bit_cast(bf16x8, t);
}
DI int crow(int r, int h2) { return (r & 3) + 8 * (r >> 2) + 4 * h2; }
#define MFMA32(a, b, c) __builtin_amdgcn_mfma_f32_32x32x16_bf16((a), (b), (c), 0, 0, 0)
#define LAS __attribute__((address_space(3)))
enum { K_NONE = 0, K_ROPE, K_PLAIN, K_TR, K_GSILU, K_GSIG, K_SILUH, K_LOGF, K_SMALL };
namespace g8 {
constexpr int BK = 64, HALF = 128, HT = HALF * BK;
DI int lds_byte(int r, int c) { const int st = (r >> 4) * 2 + (c >> 5), rr = r & 15, cc = c & 31, ob = rr * 64 + cc * 2; return st * 1024 + (ob ^ (((ob >> 9) & 1) << 5)); }
DI void stage_rc(int b, int& R, int& C) { const int st = b / 1024, sb = b % 1024, swz = sb ^ (((sb >> 9) & 1) << 5); R = (st >> 1) * 16 + swz / 64; C = (st & 1) * 32 + (swz % 64) / 2; }
}
DI void gemm256_mainloop(const bf16_t* A, const bf16_t* Bt, bf16_t* shm, f32x4 (&acc)[2][2][4][2]) {
  using namespace g8;
  constexpr int K = 1024;
#define SA(b, h) (shm + ((b) * 2 + (h)) * HT)
#define SB(b, h) (shm + (4 + (b) * 2 + (h)) * HT)
#define STAGE(P, BASE, br, kt) do { const long g_ = (long)(br) * K + (long)(kt) * BK; \
    _Pragma("unroll") for (int i_ = 0; i_ < 2; ++i_) { const int b_ = tidf * 16 + i_ * 8192; int r_, c_; stage_rc(b_, r_, c_); \
      __builtin_amdgcn_global_load_lds((const unsigned*)((BASE) + g_ + (long)r_ * K + c_), (LAS unsigned*)((char*)(P) + b_), 16, 0, 0); } } while (0)
#define LDA(dst, b, h) _Pragma("unroll") for (int m = 0; m < 4; ++m) _Pragma("unroll") for (int k = 0; k < 2; ++k) \
    dst[m][k] = *reinterpret_cast<const bf16x8*>((const char*)SA(b, h) + lds_byte(wr * 64 + m * 16 + fr, k * 32 + fq * 8))
#define LDB(dst, b, h) _Pragma("unroll") for (int n = 0; n < 2; ++n) _Pragma("unroll") for (int k = 0; k < 2; ++k) \
    dst[n][k] = *reinterpret_cast<const bf16x8*>((const char*)SB(b, h) + lds_byte(wc * 32 + n * 16 + fr, k * 32 + fq * 8))
#define MMA(ai, bj, At_, Bt_) do { __builtin_amdgcn_s_setprio(1); \
    _Pragma("unroll") for (int m = 0; m < 4; ++m) _Pragma("unroll") for (int n = 0; n < 2; ++n) _Pragma("unroll") for (int k = 0; k < 2; ++k) \
      acc[ai][bj][m][n] = __builtin_amdgcn_mfma_f32_16x16x32_bf16(Bt_[n][k], At_[m][k], acc[ai][bj][m][n], 0, 0, 0); \
    __builtin_amdgcn_s_setprio(0); } while (0)
#define WAIT_V(n) asm volatile("s_waitcnt vmcnt(" #n ")" ::: "memory")
#define WAIT_L(n) asm volatile("s_waitcnt lgkmcnt(" #n ")" ::: "memory")
#define BAR __builtin_amdgcn_s_barrier()
#define SCHED __builtin_amdgcn_sched_barrier(0)
  int tidf = threadIdx.x; asm volatile("" : "+v"(tidf));
  const int wid = tidf >> 6, lane = tidf & 63, wr = wid >> 2, wc = wid & 3, fr = lane & 15, fq = lane >> 4;
#pragma unroll
  for (int a = 0; a < 2; ++a)
#pragma unroll
    for (int b = 0; b < 2; ++b)
#pragma unroll
      for (int m = 0; m < 4; ++m)
#pragma unroll
        for (int n = 0; n < 2; ++n) acc[a][b][m][n] = (f32x4){0.f, 0.f, 0.f, 0.f};
  bf16x8 At[4][2], B0[2][2], B1[2][2];
  constexpr int nt = K / BK;
  WAIT_V(0);
  STAGE(SB(0, 0), Bt, 0, 0); STAGE(SA(0, 0), A, 0, 0);
  STAGE(SB(0, 1), Bt, HALF, 0); STAGE(SA(0, 1), A, HALF, 0);
  if (wr == 1) BAR;
  WAIT_V(4); BAR;
  STAGE(SB(1, 0), Bt, 0, 1); STAGE(SA(1, 0), A, 0, 1); STAGE(SB(1, 1), Bt, HALF, 1);
  WAIT_V(6); BAR;
  for (int t = 0; t < nt - 2; t += 2) {
    LDB(B0, 0, 0); SCHED; LDA(At, 0, 0); STAGE(SA(1, 1), A, HALF, t + 1);
    WAIT_L(8); BAR; WAIT_L(0); MMA(0, 0, At, B0); BAR; SCHED;
    LDB(B1, 0, 1); STAGE(SB(0, 0), Bt, 0, t + 2);
    BAR; WAIT_L(0); MMA(0, 1, At, B1); BAR;
    LDA(At, 0, 1); STAGE(SA(0, 0), A, 0, t + 2);
    BAR; WAIT_L(0); MMA(1, 0, At, B0); BAR; SCHED;
    STAGE(SB(0, 1), Bt, HALF, t + 2);
    WAIT_V(6); BAR; MMA(1, 1, At, B1); BAR;
    LDB(B0, 1, 0); SCHED; LDA(At, 1, 0); STAGE(SA(0, 1), A, HALF, t + 2);
    WAIT_L(8); BAR; WAIT_L(0); MMA(0, 0, At, B0); BAR; SCHED;
    LDB(B1, 1, 1); STAGE(SB(1, 0), Bt, 0, t + 3);
    BAR; WAIT_L(0); MMA(0, 1, At, B1); BAR;
    LDA(At, 1, 1); STAGE(SA(1, 0), A, 0, t + 3);
    BAR; WAIT_L(0); MMA(1, 0, At, B0); BAR; SCHED;
    STAGE(SB(1, 1), Bt, HALF, t + 3);
    WAIT_V(6); BAR; MMA(1, 1, At, B1); BAR;
  }
  { LDB(B0, 0, 0); LDA(At, 0, 0); STAGE(SA(1, 1), A, HALF, nt - 1);
    BAR; WAIT_L(0); MMA(0, 0, At, B0); BAR;
    LDB(B1, 0, 1); BAR; WAIT_L(0); MMA(0, 1, At, B1); BAR;
    LDA(At, 0, 1); WAIT_V(4); BAR; WAIT_L(0); MMA(1, 0, At, B0); MMA(1, 1, At, B1); BAR; }
  { LDB(B0, 1, 0); LDA(At, 1, 0); WAIT_V(2); BAR; WAIT_L(0); MMA(0, 0, At, B0); BAR;
    LDB(B1, 1, 1); WAIT_V(0); BAR; WAIT_L(0); MMA(0, 1, At, B1); BAR;
    LDA(At, 1, 1); BAR; WAIT_L(0); MMA(1, 0, At, B0); MMA(1, 1, At, B1); BAR; }
  if (wr == 0) BAR;
#undef SA
#undef SB
#undef STAGE
#undef LDA
#undef LDB
#undef MMA
#undef WAIT_V
#undef WAIT_L
#undef BAR
#undef SCHED
}

DI void classify_head(const Params& p, int hd, int b, int& kind, bf16_t*& dst, float*& fdst, float& scale) {
  kind = K_NONE; dst = nullptr; fdst = nullptr; scale = 1.f;
  if (hd < 4) { kind = K_ROPE; dst = p.QA() + ((size_t)(b * 4 + hd) * T) * 64; scale = 0.125f; }
  else if (hd < 6) { kind = K_ROPE; dst = p.KA() + ((size_t)(b * 2 + hd - 4) * T) * 64; }
  else if (hd < 8) { kind = K_TR; dst = p.VAT() + (size_t)(b * 2 + hd - 6) * 64 * T; }
  else if (hd < 12) { kind = K_GSILU; dst = p.GZ() + (size_t)0 * NTOK * 256 + (hd - 8) * 64; }
  else if (hd < 20) { kind = K_PLAIN; dst = p.QKB() + ((size_t)(b * 8 + hd - 12) * T) * 64; }
  else if (hd < 24) { kind = K_TR; dst = p.VBT() + (size_t)(b * 4 + hd - 20) * 64 * T; }
  else if (hd < 28) { kind = K_GSIG; dst = p.GZ() + (size_t)1 * NTOK * 256 + (hd - 24) * 64; }
  else if (hd < 32) { kind = K_GSILU; dst = p.GZ() + (size_t)2 * NTOK * 256 + (hd - 28) * 64; }
  else if (hd < 36) { kind = K_SILUH; dst = p.QC() + ((size_t)(b * 4 + hd - 32) * T) * 64; }
  else if (hd < 40) { kind = K_LOGF; fdst = p.GC() + ((size_t)(b * 4 + hd - 36) * T) * 64; }
  else if (hd < 44) { kind = K_TR; dst = p.VCT() + (size_t)(b * 4 + hd - 40) * 64 * T; }
  else if (hd < 48) { kind = K_GSILU; dst = p.GZ() + (size_t)3 * NTOK * 256 + (hd - 44) * 64; }
  else if (hd < 52) { kind = K_ROPE; dst = p.QD() + ((size_t)(b * 4 + hd - 48) * T) * 64; scale = 0.125f; }
  else if (hd < 58) {
    const int j = hd - 52;
    dst = p.KV() + (size_t)(j * NB + b) * T * 64;
    kind = (j == 0 || j == 1) ? K_PLAIN : ((j == 2 || j == 4) ? K_ROPE : K_TR);
  }
  else if (hd < 62) { kind = K_GSILU; dst = p.GZ() + (size_t)4 * NTOK * 256 + (hd - 58) * 64; }
  else if (hd == 62) { kind = K_SMALL; }
}

DI bool head_is_paired(int hd) { return hd < 6 || (hd >= 48 && hd < 52) || hd == 54 || hd == 56; }
template <int KIND>
DI void epi_direct(const Params& p, const f32x4 (&a)[4][2], bf16_t* dst, float* fdst, float scale, int layer, int hd, int b, int tq, int wr, int w, int fr, int fq) {
  if (KIND == K_ROPE) {
    const int c = 16 * w + 4 * fq;
    const f32x4 b0 = *(const f32x4*)(p.BIASP() + layer * NP + hd * 64 + c), b1 = *(const f32x4*)(p.BIASP() + layer * NP + hd * 64 + 32 + c);
#pragma unroll
    for (int m = 0; m < 4; ++m) {
      const int t = tq + wr * 64 + m * 16 + fr;
      const f32x4 cs = *(const f32x4*)(p.ROPEC() + t * 32 + c), sn = *(const f32x4*)(p.ROPES() + t * 32 + c);
      const f32x4 v0 = a[m][0] + b0, v1 = a[m][1] + b1;
      const f32x4 o0 = (v0 * cs - v1 * sn) * scale, o1 = (v0 * sn + v1 * cs) * scale;
      u32x2 w0 = {pack2(o0[0], o0[1]), pack2(o0[2], o0[3])}, w1 = {pack2(o1[0], o1[1]), pack2(o1[2], o1[3])};
      *(u32x2*)(dst + (size_t)t * 64 + c) = w0; *(u32x2*)(dst + (size_t)t * 64 + 32 + c) = w1;
    }
    return;
  }
  const int c = 32 * w + 8 * fq;
  const f32x4 b0 = *(const f32x4*)(p.BIASP() + layer * NP + hd * 64 + c), b1 = *(const f32x4*)(p.BIASP() + layer * NP + hd * 64 + c + 4);
  if (KIND == K_SMALL) {
#pragma unroll
    for (int m = 0; m < 4; ++m) {
      const size_t tok = (size_t)b * T + tq + wr * 64 + m * 16 + fr;
#pragma unroll
      for (int n = 0; n < 2; ++n)
#pragma unroll
        for (int j = 0; j < 4; ++j) {
          const int cc = c + 4 * n + j;
          const float v = a[m][n][j] + (n ? b1[j] : b0[j]);
          if (cc < 8) p.IFG()[tok * 8 + cc] = v;
          else if (cc < 20) p.DG()[tok * 12 + (cc - 8)] = sigmoidf_(v);
        }
    }
    return;
  }
  f32x4 lb0 = {0.f, 0.f, 0.f, 0.f}, lb1 = {0.f, 0.f, 0.f, 0.f};
  if (KIND == K_LOGF) { lb0 = *(const f32x4*)(p.LB() + layer * 256 + (hd - 36) * 64 + c); lb1 = *(const f32x4*)(p.LB() + layer * 256 + (hd - 36) * 64 + c + 4); }
#pragma unroll
  for (int m = 0; m < 4; ++m) {
    const int t = tq + wr * 64 + m * 16 + fr;
    const f32x4 v0 = a[m][0] + b0, v1 = a[m][1] + b1;
    if (KIND == K_LOGF) {
      f32x4 o0, o1;
#pragma unroll
      for (int j = 0; j < 4; ++j) { o0[j] = __logf(lb0[j] + (1.f - lb0[j]) * sigmoidf_(v0[j])); o1[j] = __logf(lb1[j] + (1.f - lb1[j]) * sigmoidf_(v1[j])); }
      *(f32x4*)(fdst + (size_t)t * 64 + c) = o0; *(f32x4*)(fdst + (size_t)t * 64 + c + 4) = o1;
    } else {
      f32x4 o0, o1;
#pragma unroll
      for (int j = 0; j < 4; ++j) {
        if (KIND == K_PLAIN) { o0[j] = v0[j]; o1[j] = v1[j]; }
        else if (KIND == K_SILUH || KIND == K_GSILU) { o0[j] = siluf_(v0[j]); o1[j] = siluf_(v1[j]); }
        else { o0[j] = sigmoidf_(v0[j]); o1[j] = sigmoidf_(v1[j]); }
      }
      u32x4 wv = {pack2(o0[0], o0[1]), pack2(o0[2], o0[3]), pack2(o1[0], o1[1]), pack2(o1[2], o1[3])};
      if (KIND == K_GSILU || KIND == K_GSIG) *(u32x4*)(dst + ((size_t)b * T + t) * 256 + c) = wv;
      else *(u32x4*)(dst + (size_t)t * 64 + c) = wv;
    }
  }
}
DI void epi_tr_write(const Params& p, const f32x4 (&a)[4][2], char* img, int layer, int hd, int wr, int w, int fr, int fq) {
  const int c = 32 * w + 8 * fq;
  const f32x4 b0 = *(const f32x4*)(p.BIASP() + layer * NP + hd * 64 + c), b1 = *(const f32x4*)(p.BIASP() + layer * NP + hd * 64 + c + 4);
  bf16_t* timg = (bf16_t*)img;
#pragma unroll
  for (int m = 0; m < 4; ++m)
#pragma unroll
    for (int n = 0; n < 2; ++n)
#pragma unroll
      for (int j = 0; j < 4; ++j) timg[(c + 4 * n + j) * 128 + wr * 64 + m * 16 + fr] = f2bf(a[m][n][j] + (n ? b1[j] : b0[j]));
}
DI void gemm_in_quadrant(const Params& p, int layer, int panel, int pn, int ai, int bj, const f32x4 (&a)[4][2], char* shm,
                         int b, int hq, int tid2, int wr, int wc, int fr, int fq) {
  const int tq = (panel & 7) * 256 + ai * 128;
  const int hd0 = pn * 4 + bj * 2;
  const int hd = hd0 + (wc >> 1), w = wc & 1;
  int kind; bf16_t* dst; float* fdst; float scale;
  classify_head(p, hd, b, kind, dst, fdst, scale);
  switch (kind) {
    case K_ROPE: epi_direct<K_ROPE>(p, a, dst, fdst, scale, layer, hd, b, tq, wr, w, fr, fq); break;
    case K_PLAIN: epi_direct<K_PLAIN>(p, a, dst, fdst, scale, layer, hd, b, tq, wr, w, fr, fq); break;
    case K_GSILU: epi_direct<K_GSILU>(p, a, dst, fdst, scale, layer, hd, b, tq, wr, w, fr, fq); break;
    case K_GSIG: epi_direct<K_GSIG>(p, a, dst, fdst, scale, layer, hd, b, tq, wr, w, fr, fq); break;
    case K_SILUH: epi_direct<K_SILUH>(p, a, dst, fdst, scale, layer, hd, b, tq, wr, w, fr, fq); break;
    case K_LOGF: epi_direct<K_LOGF>(p, a, dst, fdst, scale, layer, hd, b, tq, wr, w, fr, fq); break;
    case K_SMALL: epi_direct<K_SMALL>(p, a, dst, fdst, scale, layer, hd, b, tq, wr, w, fr, fq); break;
    default: break;
  }
  int k0, k1; { bf16_t* d_; float* f_; float s_; classify_head(p, hd0, b, k0, d_, f_, s_); classify_head(p, hd0 + 1, b, k1, d_, f_, s_); }
  if (k0 == K_TR || k1 == K_TR) {
    if (kind == K_TR) epi_tr_write(p, a, shm + (wc >> 1) * 16384, layer, hd, wr, w, fr, fq);
    __syncthreads();
    int kq; bf16_t* dq; float* fq_; float sq; classify_head(p, hd0 + hq, b, kq, dq, fq_, sq);
    if (kq == K_TR) {
      const char* img = shm + hq * 16384;
#pragma unroll
      for (int i = 0; i < 4; ++i) { const int q = tid2 + 256 * i, cc = q >> 4, rc = q & 15; *(u32x4*)(dq + (size_t)cc * T + tq + rc * 8) = *(const u32x4*)(img + q * 16); }
    }
    __syncthreads();
  }
}
DI void gemm_in_epilogue(const Params& p, int layer, int panel, int pn, const f32x4 (&acc)[2][2][4][2], char* shm) {
  int tidf = threadIdx.x; asm volatile("" : "+v"(tidf));
  const int wid = tidf >> 6, lane = tidf & 63, wr = wid >> 2, wc = wid & 3, fr = lane & 15, fq = lane >> 4;
  const int b = panel >> 3;
  const int hq = __builtin_amdgcn_readfirstlane(tidf >> 8), tid2 = tidf & 255;
  __syncthreads();
  gemm_in_quadrant(p, layer, panel, pn, 0, 0, acc[0][0], shm, b, hq, tid2, wr, wc, fr, fq);
  gemm_in_quadrant(p, layer, panel, pn, 0, 1, acc[0][1], shm, b, hq, tid2, wr, wc, fr, fq);
  gemm_in_quadrant(p, layer, panel, pn, 1, 0, acc[1][0], shm, b, hq, tid2, wr, wc, fr, fq);
  gemm_in_quadrant(p, layer, panel, pn, 1, 1, acc[1][1], shm, b, hq, tid2, wr, wc, fr, fq);
}
template <int L0>
DI void gemm_out_epilogue(const Params& p, int panel, int pn, const f32x4 (&acc)[2][2][4][2], char* shm) {
  int tidf = threadIdx.x; asm volatile("" : "+v"(tidf));
  const int wid = tidf >> 6, lane = tidf & 63, wr = wid >> 2, wc = wid & 3, fr = lane & 15, fq = lane >> 4;
#pragma unroll
  for (int ai = 0; ai < 2; ++ai)
#pragma unroll
    for (int m = 0; m < 4; ++m) {
      const size_t row = (size_t)(panel * 256 + ai * 128 + wr * 64 + m * 16 + fr);
      float mu = 0.f, rs = 0.f;
      if (L0) { const f32x2 st = *(const f32x2*)(p.LNS() + row * 2); mu = st[0]; rs = st[1]; }
#pragma unroll
      for (int bj = 0; bj < 2; ++bj)
#pragma unroll
        for (int n = 0; n < 2; ++n) {
          const int col = pn * 256 + bj * 128 + wc * 32 + n * 16 + fq * 4;
          float* g = p.hf + row * 1024 + col;
          f32x4 h;
          if (L0) {
            const f32x4 xv = *(const f32x4*)(p.x + row * 1024 + col);
            const f32x4 gg = *(const f32x4*)(p.ln0_g + col), bb = *(const f32x4*)(p.ln0_b + col);
            h = (xv - mu) * rs * gg + bb;
          } else h = *(const f32x4*)g;
          *(f32x4*)g = DN_ALPHA * h + acc[ai][bj][m][n];
        }
    }
}
DI void ph_gemm_in(const Params& p, int layer, int bid, int nblk, char* shm) {
  asm volatile("" : "+s"(bid));
  for (int panel = bid; panel < 256; panel += nblk) {
    const bf16_t* A = p.HB() + (size_t)panel * 256 * 1024;
    for (int pn = 0; pn < 16; ++pn) {
      f32x4 acc[2][2][4][2];
      gemm256_mainloop(A, p.WT() + ((size_t)layer * NP + pn * 256) * 1024, (bf16_t*)shm, acc);
      if (PROBE == 6) { __syncthreads(); gemm256_mainloop(A, p.WT() + ((size_t)layer * NP + pn * 256) * 1024, (bf16_t*)shm, acc); }
      gemm_in_epilogue(p, layer, panel, pn, acc, shm);
      if (PROBE == 7) gemm_in_epilogue(p, layer, panel, pn, acc, shm);
    }
  }
}
DI void ph_gemm_out_ln(const Params& p, int layer, int bid, int nblk, char* shm) {
  asm volatile("" : "+s"(bid));
  for (int panel = bid; panel < 256; panel += nblk) {
    const bf16_t* A = p.YMIX() + (size_t)panel * 256 * 1024;
    for (int pn = 0; pn < 4; ++pn) {
      f32x4 acc[2][2][4][2];
      gemm256_mainloop(A, p.WOT() + ((size_t)layer * 1024 + pn * 256) * 1024, (bf16_t*)shm, acc);
      if (layer == 0) gemm_out_epilogue<1>(p, panel, pn, acc, shm); else gemm_out_epilogue<0>(p, panel, pn, acc, shm);
    }
    asm volatile("s_waitcnt vmcnt(0)" ::: "memory");
    __syncthreads();
    int tidf = threadIdx.x; asm volatile("" : "+v"(tidf));
    const int lane = tidf & 63, wid = tidf >> 6;
    const float* g = p.ln_g + layer * 1024; const float* bb = p.ln_b + layer * 1024;
    for (int rr = 0; rr < 32; ++rr) {
      const int row = panel * 256 + wid * 32 + rr;
      float* s = p.hf + (size_t)row * 1024;
      f32x4 v[4];
      float sum = 0.f;
#pragma unroll
      for (int i = 0; i < 4; ++i) { v[i] = *(const f32x4*)(s + i * 256 + lane * 4); sum += (v[i][0] + v[i][1]) + (v[i][2] + v[i][3]); }
      sum = wave_sum(sum);
      const float mu = sum * (1.f / 1024.f);
      float q = 0.f;
#pragma unroll
      for (int i = 0; i < 4; ++i) { const f32x4 d = v[i] - mu; q += (d[0] * d[0] + d[1] * d[1]) + (d[2] * d[2] + d[3] * d[3]); }
      q = wave_sum(q);
      const float rs = rsqrtf(q * (1.f / 1024.f) + 1e-5f);
#pragma unroll
      for (int i = 0; i < 4; ++i) {
        const int cc = i * 256 + lane * 4;
        const f32x4 gg = *(const f32x4*)(g + cc), b4 = *(const f32x4*)(bb + cc);
        const f32x4 o = (v[i] - mu) * rs * gg + b4;
        *(f32x4*)(s + cc) = o;
        if (layer == 0) { u32x2 pk = {pack2(o[0], o[1]), pack2(o[2], o[3])}; *(u32x2*)(p.HB() + (size_t)row * 1024 + cc) = pk; }
      }
    }
  }
}

DI f32x16 qk_tile(const bf16_t* Krow, const bf16x8 (&qf)[4], int l31, int h2) {
  f32x16 s = zero16();
  const bf16_t* kp = Krow + l31 * 64 + h2 * 8;
#pragma unroll
  for (int ks = 0; ks < 4; ++ks) { const bf16x8 a = *(const bf16x8*)(kp + ks * 16); s = MFMA32(a, qf[ks], s); }
  return s;
}
DI f32x16 qk_tile_s(const bf16_t* Krow, int stride, const bf16x8 (&qf)[4], int l31, int h2) {
  f32x16 s = zero16();
  const bf16_t* kp = Krow + l31 * stride + h2 * 8;
#pragma unroll
  for (int ks = 0; ks < 4; ++ks) { const bf16x8 a = *(const bf16x8*)(kp + ks * 16); s = MFMA32(a, qf[ks], s); }
  return s;
}
DI void softmax_pv(f32x16& s, const bf16_t* VTp, int vstride, f32x16 (&o)[2], float& m, float& l, int l31, int h2) {
  bf16x8 va[2][2];
#pragma unroll
  for (int dt = 0; dt < 2; ++dt)
#pragma unroll
    for (int sk = 0; sk < 2; ++sk) va[dt][sk] = ld_frag8x2(VTp + (size_t)(dt * 32 + l31) * vstride + sk * 16 + 4 * h2);
  float mx = s[0];
#pragma unroll
  for (int r = 1; r < 16; ++r) mx = fmaxf(mx, s[r]);
  mx = fmaxf(mx, shx(mx, 32));
  const float mn = fmaxf(m, mx);
  const float alpha = __expf(m - mn);
  float ps = 0.f;
#pragma unroll
  for (int r = 0; r < 16; ++r) { s[r] = __expf(s[r] - mn); ps += s[r]; }
  ps += shx(ps, 32);
  l = l * alpha + ps; m = mn;
#pragma unroll
  for (int dt = 0; dt < 2; ++dt)
#pragma unroll
    for (int r = 0; r < 16; ++r) o[dt][r] *= alpha;
  const bf16x8 p0 = pack8<0>(s), p1 = pack8<8>(s);
#pragma unroll
  for (int dt = 0; dt < 2; ++dt) { o[dt] = MFMA32(va[dt][0], p0, o[dt]); o[dt] = MFMA32(va[dt][1], p1, o[dt]); }
}

constexpr int AD_KSTR = 72, AD_VSTR = 68;
constexpr int AD_BUF = 64 * AD_KSTR * 2 + 64 * AD_VSTR * 2;
struct AdTile { u32x4 k, v; };
DI AdTile ad_load(const bf16_t* Kg, const bf16_t* Vg, int key0, int tidf) {
  AdTile r; const int row = tidf >> 3, ch = tidf & 7;
  r.k = *(const u32x4*)(Kg + (size_t)(key0 + row) * 64 + ch * 8);
  r.v = *(const u32x4*)(Vg + (size_t)row * T + key0 + ch * 8);
  return r;
}
DI void ad_store(const AdTile& r, char* buf, int tidf) {
  const int row = tidf >> 3, ch = tidf & 7;
  *(u32x4*)(buf + (row * AD_KSTR + ch * 8) * 2) = r.k;
  char* vp = buf + 64 * AD_KSTR * 2 + (row * AD_VSTR + ch * 8) * 2;
  *(u32x2*)vp = (u32x2){r.v[0], r.v[1]}; *(u32x2*)(vp + 8) = (u32x2){r.v[2], r.v[3]};
}
DI void ph_attnD(const Params& p, int layer, int* ctr, char* smem, int* s_pair) {
  float* imps = (float*)smem;
  float* impf = (float*)(smem + 32768);
  unsigned* smask = (unsigned*)(smem + 40960);
  unsigned* s_union = (unsigned*)(smem + 40960 + 256);
  char* kvbuf = smem + 49152;
  int tidf = threadIdx.x; asm volatile("" : "+v"(tidf));
  const int lane = tidf & 63, wid = tidf >> 6, h = wid & 3, qs = wid >> 2, l31 = lane & 31, h2 = lane >> 5;
  for (;;) {
    __syncthreads();
    if (tidf == 0) { *s_pair = atomicAdd(ctr, 1); *s_union = 0u; }
    __syncthreads();
    const int it = *s_pair;
    if (it >= 1024) break;
    const int b = it & 31, q0 = (31 - (it >> 5)) * 64;
    const int qw = q0 + 32 * qs;
    const int t = qw + l31, cur = q0 >> 6;
    const size_t tok = (size_t)b * T + t;
    bf16x8 qf[4];
    {
      const bf16_t* qp = p.QD() + ((size_t)(b * 4 + h) * T + t) * 64 + h2 * 8;
#pragma unroll
      for (int ks = 0; ks < 4; ++ks) qf[ks] = *(const bf16x8*)(qp + ks * 16);
    }
    const float g0 = p.DG()[tok * 12 + h * 3 + 0], g1 = p.DG()[tok * 12 + h * 3 + 1], g2 = p.DG()[tok * 12 + h * 3 + 2];
    f32x16 ofin[2];
    {
      const bf16_t* Kc = p.KCMP() + (size_t)b * 128 * 64;
      const bf16_t* Vc = p.VCMPT() + (size_t)b * 64 * 128;
      const int nkt = min(4, (qw >> 9) + 1);
      f32x16 o[2]; o[0] = zero16(); o[1] = zero16();
      float m = -1e30f, l = 0.f;
      for (int kt = 0; kt < nkt; ++kt) {
        f32x16 s = qk_tile(Kc + kt * 32 * 64, qf, l31, h2);
#pragma unroll
        for (int r = 0; r < 16; ++r) { const int n = kt * 32 + crow(r, h2); if (16 * n + 31 > t) s[r] = -INFINITY; }
        softmax_pv(s, Vc + kt * 32, 128, o, m, l, l31, h2);
      }
      const float il = l > 0.f ? 1.f / l : 0.f;
      const float gi = g0 * il;
#pragma unroll
      for (int dt = 0; dt < 2; ++dt)
#pragma unroll
        for (int r = 0; r < 16; ++r) ofin[dt][r] = gi * o[dt][r];
      float carry = 0.f;
#pragma unroll
      for (int kt = 0; kt < 4; ++kt) {
        f32x16 s;
        if (kt < nkt) {
          s = qk_tile(Kc + kt * 32 * 64, qf, l31, h2);
#pragma unroll
          for (int r = 0; r < 16; ++r) { const int n = kt * 32 + crow(r, h2); s[r] = (16 * n + 31 > t) ? 0.f : __expf(s[r] - m) * il; }
        } else s = zero16();
        float X[4];
#pragma unroll
        for (int g = 0; g < 4; ++g) X[g] = shx(s[4 * g + 3], 32);
#pragma unroll
        for (int g = 0; g < 4; ++g) {
          const float G = (s[4 * g] + s[4 * g + 1]) + (s[4 * g + 2] + s[4 * g + 3]);
          const float prev_other = g > 0 ? X[g - 1] : carry;
          imps[(wid * 32 + l31) * 32 + 8 * kt + 2 * g + h2] = G + (h2 ? X[g] : prev_other);
        }
        carry = X[3];
      }
    }
    __syncthreads();
    {
      const int tt = tidf >> 3, jg = tidf & 7, wq = (tt >> 5) * 4, tl = tt & 31;
#pragma unroll
      for (int i = 0; i < 4; ++i) {
        const int j = jg * 4 + i;
        impf[tt * 32 + j] = (imps[((wq + 0) * 32 + tl) * 32 + j] + imps[((wq + 1) * 32 + tl) * 32 + j]) + (imps[((wq + 2) * 32 + tl) * 32 + j] + imps[((wq + 3) * 32 + tl) * 32 + j]);
      }
    }
    __syncthreads();
    {
      const int tt = tidf >> 3, jg = tidf & 7;
      float v[32];
#pragma unroll
      for (int j = 0; j < 32; ++j) {
        float x = impf[tt * 32 + j];
        if (j > cur) x = -1e30f; else if (j == 0 || j == cur || j == cur - 1) x = 1e6f;
        v[j] = x;
      }
      unsigned bits = 0u;
#pragma unroll
      for (int i = 0; i < 4; ++i) {
        int rank = 0; float vj = 0.f;
#pragma unroll
        for (int j = 0; j < 32; ++j) if (j == jg * 4 + i) vj = v[j];
        const int jj = jg * 4 + i;
#pragma unroll
        for (int j = 0; j < 32; ++j) rank += (v[j] > vj || (v[j] == vj && j < jj)) ? 1 : 0;
        if (rank < 8 && jj <= cur) bits |= 1u << jj;
      }
      bits |= shx(bits, 1); bits |= shx(bits, 2); bits |= shx(bits, 4);
      if (jg == 0) { smask[tt] = bits; atomicOr(s_union, bits); }
    }
    __syncthreads();
    {
      const unsigned mymask = smask[32 * qs + l31];
      unsigned rem = *s_union;
      const bf16_t* Ks = p.KV() + (size_t)(2 * NB + b) * T * 64;
      const bf16_t* Vs = p.KV() + (size_t)(3 * NB + b) * 64 * T;
      f32x16 o[2]; o[0] = zero16(); o[1] = zero16();
      float m = -1e30f, l = 0.f;
      int j = __builtin_ctz(rem); rem &= rem - 1;
      { const AdTile r = ad_load(Ks, Vs, j * 64, tidf); ad_store(r, kvbuf, tidf); }
      __syncthreads();
      int pb = 0;
      for (;;) {
        const bool more = rem != 0u;
        const int jn = more ? __builtin_ctz(rem) : 0;
        AdTile nx;
        if (more) nx = ad_load(Ks, Vs, jn * 64, tidf);
        const char* buf = kvbuf + pb * AD_BUF;
        const bool sel = (mymask >> j) & 1u;
#pragma unroll
        for (int kh = 0; kh < 2; ++kh) {
          const int key0 = j * 64 + kh * 32;
          if (key0 <= qw + 31) {
            f32x16 s = qk_tile_s((const bf16_t*)buf + kh * 32 * AD_KSTR, AD_KSTR, qf, l31, h2);
#pragma unroll
            for (int r = 0; r < 16; ++r) { const int key = key0 + crow(r, h2); if (!sel || key > t) s[r] = -INFINITY; }
            softmax_pv(s, (const bf16_t*)(buf + 64 * AD_KSTR * 2) + kh * 32, AD_VSTR, o, m, l, l31, h2);
          }
        }
        if (more) ad_store(nx, kvbuf + (pb ^ 1) * AD_BUF, tidf);
        __syncthreads();
        if (!more) break;
        rem &= rem - 1; j = jn; pb ^= 1;
      }
      const float il = l > 0.f ? g1 / l : 0.f;
#pragma unroll
      for (int dt = 0; dt < 2; ++dt)
#pragma unroll
        for (int r = 0; r < 16; ++r) ofin[dt][r] += il * o[dt][r];
    }
    {
      const bf16_t* Kw = p.KV() + (size_t)(4 * NB + b) * T * 64;
      const bf16_t* Vw = p.KV() + (size_t)(5 * NB + b) * 64 * T;
      f32x16 o[2]; o[0] = zero16(); o[1] = zero16();
      float m = -1e30f, l = 0.f;
      int k0 = max(0, q0 - 512);
      { const AdTile r = ad_load(Kw, Vw, k0, tidf); ad_store(r, kvbuf, tidf); }
      __syncthreads();
      int pb = 0;
      for (;;) {
        const bool more = k0 + 64 <= q0;
        AdTile nx;
        if (more) nx = ad_load(Kw, Vw, k0 + 64, tidf);
        const char* buf = kvbuf + pb * AD_BUF;
#pragma unroll
        for (int kh = 0; kh < 2; ++kh) {
          const int key0 = k0 + kh * 32;
          if (key0 <= qw + 31 && key0 + 31 + 512 > qw) {
            f32x16 s = qk_tile_s((const bf16_t*)buf + kh * 32 * AD_KSTR, AD_KSTR, qf, l31, h2);
            if (key0 + 31 > qw || key0 + 512 <= qw + 31) {
#pragma unroll
              for (int r = 0; r < 16; ++r) { const int key = key0 + crow(r, h2); if (key > t || t - key >= 512) s[r] = -INFINITY; }
            }
            softmax_pv(s, (const bf16_t*)(buf + 64 * AD_KSTR * 2) + kh * 32, AD_VSTR, o, m, l, l31, h2);
          }
        }
        if (more) ad_store(nx, kvbuf + (pb ^ 1) * AD_BUF, tidf);
        __syncthreads();
        if (!more) break;
        k0 += 64; pb ^= 1;
      }
      const float il = l > 0.f ? g2 / l : 0.f;
#pragma unroll
      for (int dt = 0; dt < 2; ++dt)
#pragma unroll
        for (int r = 0; r < 16; ++r) ofin[dt][r] += il * o[dt][r];
    }
#pragma unroll
    for (int dt = 0; dt < 2; ++dt)
#pragma unroll
      for (int g = 0; g < 4; ++g) {
        const int d0 = dt * 32 + 8 * g + 4 * h2;
        const u32x2 gz = *(const u32x2*)(p.GZ() + (size_t)4 * NTOK * 256 + tok * 256 + h * 64 + d0);
        const float z0 = __uint_as_float(gz.x << 16), z1 = __uint_as_float(gz.x & 0xffff0000u), z2 = __uint_as_float(gz.y << 16), z3 = __uint_as_float(gz.y & 0xffff0000u);
        u32x2 o2 = {pack2(ofin[dt][4 * g] * z0, ofin[dt][4 * g + 1] * z1), pack2(ofin[dt][4 * g + 2] * z2, ofin[dt][4 * g + 3] * z3)};
        *(u32x2*)(p.YMIX() + tok * 1024 + 768 + h * 64 + d0) = o2;
      }
  }
}

DI float logsigmoidf_(float x) { return fminf(x, 0.f) - __logf(1.f + __expf(-fabsf(x))); }
DI void mlstm_gates(const Params& p, size_t tok0, int hh, float* bc, float* ig, int tid) {
  if (tid < 64) {
    const int s0 = 2 * tid;
    const float lf0 = logsigmoidf_(p.IFG()[(tok0 + s0) * 8 + 4 + hh]), lf1 = logsigmoidf_(p.IFG()[(tok0 + s0 + 1) * 8 + 4 + hh]);
    const float pair = lf0 + lf1;
    float x = pair;
#pragma unroll
    for (int off = 1; off < 64; off <<= 1) { const float y = shup(x, off); if (tid >= off) x += y; }
    const float excl = x - pair;
    bc[s0] = excl + lf0; bc[s0 + 1] = excl + pair;
    ig[s0] = p.IFG()[(tok0 + s0) * 8 + hh]; ig[s0 + 1] = p.IFG()[(tok0 + s0 + 1) * 8 + hh];
  }
}
DI void conv8(const bf16_t* raw, int t, int dg, const float (&cw)[4][8], const float (&cb)[8], float (&out)[8]) {
#pragma unroll
  for (int e = 0; e < 8; ++e) out[e] = cb[e];
#pragma unroll
  for (int j = 0; j < 4; ++j) {
    const int ts = t - 3 + j;
    if (ts >= 0) {
      const u32x4 row = *(const u32x4*)(raw + (size_t)ts * 64 + dg * 8);
#pragma unroll
      for (int e2 = 0; e2 < 4; ++e2) { out[2 * e2] += cw[j][2 * e2] * __uint_as_float(row[e2] << 16); out[2 * e2 + 1] += cw[j][2 * e2 + 1] * __uint_as_float(row[e2] & 0xffff0000u); }
    }
  }
#pragma unroll
  for (int e = 0; e < 8; ++e) out[e] = siluf_(out[e]);
}
DI void load_conv_w(const Params& p, int layer, int ch0, int dg, float (&cw)[4][8], float (&cb)[8]) {
#pragma unroll
  for (int j = 0; j < 4; ++j)
#pragma unroll
    for (int e = 0; e < 8; ++e) cw[j][e] = p.conv_w[layer * 2048 + j * 512 + ch0 + dg * 8 + e];
#pragma unroll
  for (int e = 0; e < 8; ++e) cb[e] = p.conv_b[layer * 512 + ch0 + dg * 8 + e];
}
DI void delta_state(const bf16_t* VT, const bf16_t* KT, float* out, int wid, int l31, int h2) {
  const int mt = wid >> 1, nt = wid & 1;
  f32x16 acc = zero16();
#pragma unroll
  for (int ks = 0; ks < 8; ++ks) {
    const bf16x8 a = *(const bf16x8*)(VT + (size_t)(mt * 32 + l31) * T + ks * 16 + h2 * 8);
    const bf16x8 bb = *(const bf16x8*)(KT + (nt * 32 + l31) * 136 + ks * 16 + h2 * 8);
    acc = MFMA32(a, bb, acc);
  }
#pragma unroll
  for (int r = 0; r < 16; ++r) out[(mt * 32 + crow(r, h2)) * 64 + nt * 32 + l31] = acc[r];
}
DI void ph_mlstm_local(const Params& p, int layer, int item, char* smem) {
  float* bc = (float*)smem; float* ig = bc + 128; float* wv = ig + 128;
  bf16_t* KwT = (bf16_t*)(smem + 2048);
  float* nred = (float*)(smem + 2048 + 64 * 136 * 2);
  const int tid = tid_opaque(), lane = tid & 63, wid = tid >> 6, l31 = lane & 31, h2 = lane >> 5;
  const int b = item >> 6, hh = (item >> 4) & 3, c = item & 15, t0 = c * 128;
  const size_t tok0 = (size_t)b * T + t0;
  __syncthreads();
  mlstm_gates(p, tok0, hh, bc, ig, tid);
  __syncthreads();
  if (tid < 128) wv[tid] = __expf(bc[127] - bc[tid] + ig[tid]);
  __syncthreads();
  {
    const int dg = tid & 7;
    float cw[4][8], cb[8];
    load_conv_w(p, layer, 256 + hh * 64, dg, cw, cb);
    const bf16_t* raw = p.QKB() + ((size_t)(b * 8 + 4 + hh) * T) * 64;
#pragma unroll
    for (int i = 0; i < 4; ++i) {
      const int s = (tid >> 3) + 32 * i;
      float v[8];
      conv8(raw, t0 + s, dg, cw, cb, v);
      const float w = wv[s];
#pragma unroll
      for (int e = 0; e < 8; ++e) KwT[(dg * 8 + e) * 136 + s] = f2bf(v[e] * w);
    }
  }
  __syncthreads();
  delta_state(p.VBT() + (size_t)(b * 4 + hh) * 64 * T + t0, KwT, p.BST() + (size_t)item * 4096, wid, l31, h2);
  {
    const int k = tid & 63, qd = tid >> 6;
    float a = 0.f;
#pragma unroll 8
    for (int s = 0; s < 32; ++s) a += bf2f(KwT[k * 136 + qd * 32 + s]);
    nred[qd * 64 + k] = a;
  }
  __syncthreads();
  if (tid < 64) p.BN()[(size_t)item * 64 + tid] = (nred[tid] + nred[64 + tid]) + (nred[128 + tid] + nred[192 + tid]);
  if (tid == 0) p.BG()[item] = bc[127];
}
DI void ph_mlstm_scan(const Params& p, int bh) {
  const int tid = tid_opaque();
  f32x4 C[4];
#pragma unroll
  for (int i = 0; i < 4; ++i) C[i] = (f32x4){0.f, 0.f, 0.f, 0.f};
  float n = 0.f;
  for (int c = 0; c < 16; ++c) {
    const int item = bh * 16 + c;
    const float g = __expf(p.BG()[item]);
    f32x4* ptr = (f32x4*)(p.BST() + (size_t)item * 4096 + tid * 16);
#pragma unroll
    for (int i = 0; i < 4; ++i) { const f32x4 tmp = ptr[i]; ptr[i] = C[i]; C[i] = g * C[i] + tmp; }
    if (tid < 64) { const float tmp = p.BN()[(size_t)item * 64 + tid]; p.BN()[(size_t)item * 64 + tid] = n; n = g * n + tmp; }
  }
}
DI void pv_only(const f32x16& s, const bf16_t* VTp, int vstride, f32x16 (&o)[2], int l31, int h2) {
  const bf16x8 p0 = pack8<0>(s), p1 = pack8<8>(s);
#pragma unroll
  for (int dt = 0; dt < 2; ++dt) {
    const bf16_t* vp = VTp + (size_t)(dt * 32 + l31) * vstride + 4 * h2;
    o[dt] = MFMA32(ld_frag8x2(vp), p0, o[dt]);
    o[dt] = MFMA32(ld_frag8x2(vp + 16), p1, o[dt]);
  }
}
DI bf16x8 frag_from_f32(const float* ptr) {
  const f32x4 a = *(const f32x4*)ptr, b = *(const f32x4*)(ptr + 4);
  u32x4 t = {pack2(a[0], a[1]), pack2(a[2], a[3]), pack2(b[0], b[1]), pack2(b[2], b[3])};
  return __builtin_bit_cast(bf16x8, t);
}
DI void ph_mlstm_out(const Params& p, int layer, int item, char* smem) {
  float* bc = (float*)smem; float* ig = bc + 128;
  bf16_t* qc = (bf16_t*)(smem + 2048);
  bf16_t* kc = qc + 128 * 72;
  const int tid = tid_opaque(), lane = tid & 63, wid = tid >> 6, l31 = lane & 31, h2 = lane >> 5;
  const int b = item >> 6, hh = (item >> 4) & 3, c = item & 15, t0 = c * 128;
  const size_t tok0 = (size_t)b * T + t0;
  __syncthreads();
  mlstm_gates(p, tok0, hh, bc, ig, tid);
  {
    const int dg = tid & 7;
#pragma unroll
    for (int which = 0; which < 2; ++which) {
      float cw[4][8], cb[8];
      load_conv_w(p, layer, which * 256 + hh * 64, dg, cw, cb);
      const bf16_t* raw = p.QKB() + ((size_t)(b * 8 + which * 4 + hh) * T) * 64;
      bf16_t* dst = which ? kc : qc;
      const float sc = which ? 1.f : 0.125f;
#pragma unroll
      for (int i = 0; i < 4; ++i) {
        const int s = (tid >> 3) + 32 * i;
        float v[8];
        conv8(raw, t0 + s, dg, cw, cb, v);
        u32x4 w = {pack2(v[0] * sc, v[1] * sc), pack2(v[2] * sc, v[3] * sc), pack2(v[4] * sc, v[5] * sc), pack2(v[6] * sc, v[7] * sc)};
        *(u32x4*)(dst + s * 72 + dg * 8) = w;
      }
    }
  }
  __syncthreads();
  if (tid < 128) ig[tid] = ig[tid] - bc[tid];
  __syncthreads();
  const int tq = 32 * wid + l31;
  bf16x8 qf[4];
#pragma unroll
  for (int ks = 0; ks < 4; ++ks) qf[ks] = *(const bf16x8*)(qc + tq * 72 + ks * 16 + h2 * 8);
  const float bt = bc[tq];
  f32x16 o[2]; o[0] = zero16(); o[1] = zero16();
  float dsum = 0.f;
  const bf16_t* VT = p.VBT() + (size_t)(b * 4 + hh) * 64 * T + t0;
  for (int kt = 0; kt <= wid; ++kt) {
    f32x16 s = qk_tile_s(kc + kt * 32 * 72, 72, qf, l31, h2);
#pragma unroll
    for (int r = 0; r < 16; ++r) {
      const int sidx = 32 * kt + crow(r, h2);
      float val = s[r] * __expf(bt + ig[sidx]);
      if (sidx > tq) val = 0.f;
      s[r] = val; dsum += val;
    }
    pv_only(s, VT + kt * 32, T, o, l31, h2);
  }
  dsum += shx(dsum, 32);
  const float* Cs = p.BST() + (size_t)item * 4096;
  const float* ns = p.BN() + (size_t)item * 64;
  f32x16 oi[2]; oi[0] = zero16(); oi[1] = zero16();
  float qn = 0.f;
#pragma unroll
  for (int ks = 0; ks < 4; ++ks) {
#pragma unroll
    for (int dt = 0; dt < 2; ++dt) oi[dt] = MFMA32(frag_from_f32(Cs + (dt * 32 + l31) * 64 + ks * 16 + h2 * 8), qf[ks], oi[dt]);
    const u32x4 qu = __builtin_bit_cast(u32x4, qf[ks]);
    const f32x4 n0 = *(const f32x4*)(ns + ks * 16 + h2 * 8), n1 = *(const f32x4*)(ns + ks * 16 + h2 * 8 + 4);
    qn += __uint_as_float(qu[0] << 16) * n0[0] + __uint_as_float(qu[0] & 0xffff0000u) * n0[1] + __uint_as_float(qu[1] << 16) * n0[2] + __uint_as_float(qu[1] & 0xffff0000u) * n0[3];
    qn += __uint_as_float(qu[2] << 16) * n1[0] + __uint_as_float(qu[2] & 0xffff0000u) * n1[1] + __uint_as_float(qu[3] << 16) * n1[2] + __uint_as_float(qu[3] & 0xffff0000u) * n1[3];
  }
  qn += shx(qn, 32);
  const float ebt = __expf(bt);
  const float den = dsum + ebt * qn;
  const float inv = 1.f / fmaxf(fabsf(den), 1.f);
  const size_t tok = tok0 + tq;
#pragma unroll
  for (int dt = 0; dt < 2; ++dt)
#pragma unroll
    for (int g = 0; g < 4; ++g) {
      const int d0 = dt * 32 + 8 * g + 4 * h2;
      const u32x2 g1 = *(const u32x2*)(p.GZ() + (size_t)1 * NTOK * 256 + tok * 256 + hh * 64 + d0);
      const u32x2 g2 = *(const u32x2*)(p.GZ() + (size_t)2 * NTOK * 256 + tok * 256 + hh * 64 + d0);
      float z[4] = {__uint_as_float(g1.x << 16) * __uint_as_float(g2.x << 16), __uint_as_float(g1.x & 0xffff0000u) * __uint_as_float(g2.x & 0xffff0000u),
                    __uint_as_float(g1.y << 16) * __uint_as_float(g2.y << 16), __uint_as_float(g1.y & 0xffff0000u) * __uint_as_float(g2.y & 0xffff0000u)};
      float hv[4];
#pragma unroll
      for (int i = 0; i < 4; ++i) hv[i] = (o[dt][4 * g + i] + ebt * oi[dt][4 * g + i]) * inv * z[i];
      u32x2 o2 = {pack2(hv[0], hv[1]), pack2(hv[2], hv[3])};
      *(u32x2*)(p.YMIX() + tok * 1024 + 256 + hh * 64 + d0) = o2;
    }
}


DI void ph_hgrn_local(const Params& p, int layer, int item, char* smem) {
  float* tot = (float*)smem;
  bf16_t* KdT = (bf16_t*)(smem + 1024);
  const int tid = tid_opaque(), lane = tid & 63, wid = tid >> 6, l31 = lane & 31, h2 = lane >> 5;
  const int b = item >> 6, hh = (item >> 4) & 3, c = item & 15, t0 = c * 128;
  const int k = tid & 63, qd = tid >> 6;
  float al[32], kk[32];
  {
    const float* gp = p.GC() + ((size_t)(b * 4 + hh) * T + t0 + 32 * qd) * 64 + k;
    float run = 0.f;
#pragma unroll
    for (int s = 0; s < 32; ++s) { const float g = gp[s * 64]; run += g; al[s] = run; kk[s] = 1.f - __expf(g); }
    __syncthreads();
    tot[qd * 64 + k] = run;
  }
  __syncthreads();
  float off = 0.f, aL = 0.f;
#pragma unroll
  for (int q = 0; q < 4; ++q) { const float v = tot[q * 64 + k]; aL += v; if (q < qd) off += v; }
#pragma unroll
  for (int s8 = 0; s8 < 4; ++s8) {
    float v[8];
#pragma unroll
    for (int e = 0; e < 8; ++e) v[e] = kk[s8 * 8 + e] * __expf(aL - (al[s8 * 8 + e] + off));
    u32x4 w = {pack2(v[0], v[1]), pack2(v[2], v[3]), pack2(v[4], v[5]), pack2(v[6], v[7])};
    *(u32x4*)(KdT + k * 136 + qd * 32 + s8 * 8) = w;
  }
  __syncthreads();
  delta_state(p.VCT() + (size_t)(b * 4 + hh) * 64 * T + t0, KdT, p.CST() + (size_t)item * 4096, wid, l31, h2);
  if (qd == 0) p.CAL()[(size_t)item * 64 + k] = aL;
}
DI void ph_hgrn_scan(const Params& p, int bh) {
  const int tid = tid_opaque();
  f32x4 S[4];
#pragma unroll
  for (int i = 0; i < 4; ++i) S[i] = (f32x4){0.f, 0.f, 0.f, 0.f};
  for (int c = 0; c < 16; ++c) {
    const int item = bh * 16 + c;
    const f32x4* dp = (const f32x4*)(p.CAL() + (size_t)item * 64 + (tid & 3) * 16);
    f32x4* ptr = (f32x4*)(p.CST() + (size_t)item * 4096 + tid * 16);
#pragma unroll
    for (int i = 0; i < 4; ++i) {
      const f32x4 a = dp[i];
      const f32x4 dec = {__expf(a[0]), __expf(a[1]), __expf(a[2]), __expf(a[3])};
      const f32x4 tmp = ptr[i]; ptr[i] = S[i]; S[i] = dec * S[i] + tmp;
    }
  }
}
DI void ph_hgrn_out(const Params& p, int layer, int item, char* smem) {
  float* a_lds = (float*)smem;
  float* tot = (float*)(smem + 128 * 68 * 4);
  const int tid = tid_opaque(), lane = tid & 63, wid = tid >> 6, l31 = lane & 31, h2 = lane >> 5;
  const int b = item >> 6, hh = (item >> 4) & 3, c = item & 15, t0 = c * 128;
  const size_t hbase = (size_t)(b * 4 + hh) * T + t0;
  {
    const int k = tid & 63, qd = tid >> 6;
    float al[32];
    const float* gp = p.GC() + (hbase + 32 * qd) * 64 + k;
    float run = 0.f;
#pragma unroll
    for (int s = 0; s < 32; ++s) { run += gp[s * 64]; al[s] = run; }
    __syncthreads();
    tot[qd * 64 + k] = run;
    __syncthreads();
    float off = 0.f;
#pragma unroll
    for (int q = 0; q < 4; ++q) { const float v = tot[q * 64 + k]; if (q < qd) off += v; }
#pragma unroll
    for (int s = 0; s < 32; ++s) a_lds[(32 * qd + s) * 68 + k] = al[s] + off;
  }
  __syncthreads();
  const int tq = 32 * wid + l31;
  bf16x8 qi[4], qh[4];
#pragma unroll
  for (int ks = 0; ks < 4; ++ks) {
    const int k0 = ks * 16 + h2 * 8;
    const u32x4 qu = *(const u32x4*)(p.QC() + (hbase + tq) * 64 + k0);
    float q8[8], e1[8], e2[8];
#pragma unroll
    for (int e2i = 0; e2i < 4; ++e2i) { q8[2 * e2i] = __uint_as_float(qu[e2i] << 16); q8[2 * e2i + 1] = __uint_as_float(qu[e2i] & 0xffff0000u); }
#pragma unroll
    for (int e = 0; e < 8; ++e) {
      const float a = a_lds[tq * 68 + k0 + e];
      const float r = wid > 0 ? a_lds[(32 * wid - 1) * 68 + k0 + e] : 0.f;
      e1[e] = q8[e] * __expf(a - r); e2[e] = q8[e] * __expf(a);
    }
    u32x4 w1 = {pack2(e1[0], e1[1]), pack2(e1[2], e1[3]), pack2(e1[4], e1[5]), pack2(e1[6], e1[7])};
    u32x4 w2 = {pack2(e2[0], e2[1]), pack2(e2[2], e2[3]), pack2(e2[4], e2[5]), pack2(e2[6], e2[7])};
    qi[ks] = __builtin_bit_cast(bf16x8, w1); qh[ks] = __builtin_bit_cast(bf16x8, w2);
  }
  f32x16 o[2]; o[0] = zero16(); o[1] = zero16();
  const bf16_t* VT = p.VCT() + (size_t)(b * 4 + hh) * 64 * T + t0;
  for (int kt = 0; kt <= wid; ++kt) {
    f32x16 s = zero16();
    const int srow = 32 * kt + l31;
#pragma unroll
    for (int ks = 0; ks < 4; ++ks) {
      const int k0 = ks * 16 + h2 * 8;
      const f32x4 g0 = *(const f32x4*)(p.GC() + (hbase + srow) * 64 + k0), g1 = *(const f32x4*)(p.GC() + (hbase + srow) * 64 + k0 + 4);
      float v[8];
#pragma unroll
      for (int e = 0; e < 8; ++e) {
        const float g = e < 4 ? g0[e] : g1[e - 4];
        const float a = a_lds[srow * 68 + k0 + e];
        const float r = wid > 0 ? a_lds[(32 * wid - 1) * 68 + k0 + e] : 0.f;
        v[e] = (1.f - __expf(g)) * __expf(fminf(r - a, 80.f));
      }
      u32x4 w = {pack2(v[0], v[1]), pack2(v[2], v[3]), pack2(v[4], v[5]), pack2(v[6], v[7])};
      s = MFMA32(__builtin_bit_cast(bf16x8, w), qi[ks], s);
    }
    if (kt == wid) {
#pragma unroll
      for (int r = 0; r < 16; ++r) if (32 * kt + crow(r, h2) > tq) s[r] = 0.f;
    }
    pv_only(s, VT + kt * 32, T, o, l31, h2);
  }
  {
    const float* Ss = p.CST() + (size_t)item * 4096;
#pragma unroll
    for (int ks = 0; ks < 4; ++ks)
#pragma unroll
      for (int dt = 0; dt < 2; ++dt) o[dt] = MFMA32(frag_from_f32(Ss + (dt * 32 + l31) * 64 + ks * 16 + h2 * 8), qh[ks], o[dt]);
  }
  float ss = 0.f;
#pragma unroll
  for (int dt = 0; dt < 2; ++dt)
#pragma unroll
    for (int r = 0; r < 16; ++r) ss += o[dt][r] * o[dt][r];
  ss += shx(ss, 32);
  const float rs = rsqrtf(ss * (1.f / 64.f) + 1e-6f);
  const size_t tok = (size_t)b * T + t0 + tq;
#pragma unroll
  for (int dt = 0; dt < 2; ++dt)
#pragma unroll
    for (int g = 0; g < 4; ++g) {
      const int d0 = dt * 32 + 8 * g + 4 * h2;
      const u32x2 gz = *(const u32x2*)(p.GZ() + (size_t)3 * NTOK * 256 + tok * 256 + hh * 64 + d0);
      const f32x4 gn = *(const f32x4*)(p.c_norm_g + layer * 256 + hh * 64 + d0);
      const float z0 = __uint_as_float(gz.x << 16), z1 = __uint_as_float(gz.x & 0xffff0000u), z2 = __uint_as_float(gz.y << 16), z3 = __uint_as_float(gz.y & 0xffff0000u);
      u32x2 o2 = {pack2(o[dt][4 * g] * rs * gn[0] * z0, o[dt][4 * g + 1] * rs * gn[1] * z1), pack2(o[dt][4 * g + 2] * rs * gn[2] * z2, o[dt][4 * g + 3] * rs * gn[3] * z3)};
      *(u32x2*)(p.YMIX() + tok * 1024 + 512 + hh * 64 + d0) = o2;
    }
}


DI void ph_attnA(const Params& p, int layer, int item, char* smem) {
  const int tid = tid_opaque(), lane = tid & 63, h = tid >> 6, l31 = lane & 31, h2 = lane >> 5;
  const int b = item >> 6, q0 = (item & 63) * 32, g = h >> 1;
  const int t = q0 + l31;
  const size_t tok = (size_t)b * T + t;
  bf16x8 qf[4];
  {
    const bf16_t* qp = p.QA() + ((size_t)(b * 4 + h) * T + t) * 64 + h2 * 8;
#pragma unroll
    for (int ks = 0; ks < 4; ++ks) qf[ks] = *(const bf16x8*)(qp + ks * 16);
  }
  const bf16_t* Kp = p.KA() + (size_t)(b * 2 + g) * T * 64;
  const bf16_t* Vp = p.VAT() + (size_t)(b * 2 + g) * 64 * T;
  f32x16 o[2]; o[0] = zero16(); o[1] = zero16();
  float m = -1e30f, l = 0.f;
  for (int key0 = max(0, q0 - 128); key0 <= q0; key0 += 32) {
    f32x16 s = qk_tile(Kp + (size_t)key0 * 64, qf, l31, h2);
    if (key0 == q0 - 128 || key0 == q0) {
#pragma unroll
      for (int r = 0; r < 16; ++r) { const int key = key0 + crow(r, h2); if (key > t || t - key >= 128) s[r] = -INFINITY; }
    }
    softmax_pv(s, Vp + key0, T, o, m, l, l31, h2);
  }
  const float sink = p.a_sinks[layer * 4 + h];
  const float M = fmaxf(m, sink);
  const float sc = __expf(m - M);
  const float inv = sc / (l * sc + __expf(sink - M));
#pragma unroll
  for (int dt = 0; dt < 2; ++dt)
#pragma unroll
    for (int gq = 0; gq < 4; ++gq) {
      const int d0 = dt * 32 + 8 * gq + 4 * h2;
      const u32x2 gz = *(const u32x2*)(p.GZ() + tok * 256 + h * 64 + d0);
      const float z0 = __uint_as_float(gz.x << 16), z1 = __uint_as_float(gz.x & 0xffff0000u), z2 = __uint_as_float(gz.y << 16), z3 = __uint_as_float(gz.y & 0xffff0000u);
      u32x2 o2 = {pack2(o[dt][4 * gq] * inv * z0, o[dt][4 * gq + 1] * inv * z1), pack2(o[dt][4 * gq + 2] * inv * z2, o[dt][4 * gq + 3] * inv * z3)};
      *(u32x2*)(p.YMIX() + tok * 1024 + h * 64 + d0) = o2;
    }
}

DI void ph_cmp(const Params& p, int layer, int item, char* smem) {
  float* red = (float*)smem;
  bf16_t* hid = (bf16_t*)(smem + 32768);
  const int tid = tid_opaque(), lane = tid & 63, wid = tid >> 6, l31 = lane & 31, h2 = lane >> 5;
  const int b = item >> 3, kvsel = (item >> 2) & 1, mt = item & 3;
  const int lk = layer * 2 + kvsel;
  const int n = min(mt * 32 + l31, 126);
  const bf16_t* src = p.KV() + ((size_t)(kvsel * NB + b) * T + 16 * n) * 64 + wid * 512 + h2 * 8;
  const bf16_t* w1t = p.W1T() + (size_t)lk * 64 * 2048 + wid * 512 + h2 * 8;
  f32x16 acc[2]; acc[0] = zero16(); acc[1] = zero16();
#pragma unroll 4
  for (int ks = 0; ks < 32; ++ks) {
    const bf16x8 a = *(const bf16x8*)(src + ks * 16);
    const bf16x8 b0 = *(const bf16x8*)(w1t + (size_t)l31 * 2048 + ks * 16);
    const bf16x8 b1 = *(const bf16x8*)(w1t + (size_t)(32 + l31) * 2048 + ks * 16);
    acc[0] = MFMA32(a, b0, acc[0]); acc[1] = MFMA32(a, b1, acc[1]);
  }
  __syncthreads();
#pragma unroll
  for (int nt = 0; nt < 2; ++nt)
#pragma unroll
    for (int r = 0; r < 16; ++r) red[(wid * 32 + crow(r, h2)) * 64 + nt * 32 + l31] = acc[nt][r];
  __syncthreads();
  {
    const int row = tid >> 3, c0 = (tid & 7) * 8;
    float v[8];
#pragma unroll
    for (int e = 0; e < 8; ++e) {
      const float x = (red[(0 * 32 + row) * 64 + c0 + e] + red[(1 * 32 + row) * 64 + c0 + e]) + (red[(2 * 32 + row) * 64 + c0 + e] + red[(3 * 32 + row) * 64 + c0 + e]) + p.CVEC()[lk * 64 + c0 + e];
      v[e] = siluf_(x);
    }
    u32x4 w = {pack2(v[0], v[1]), pack2(v[2], v[3]), pack2(v[4], v[5]), pack2(v[6], v[7])};
    *(u32x4*)(hid + row * 72 + c0) = w;
  }
  __syncthreads();
  if (wid == 0) {
    f32x16 o[2]; o[0] = zero16(); o[1] = zero16();
    const bf16_t* w2t = p.W2T() + (size_t)lk * 4096;
#pragma unroll
    for (int ks = 0; ks < 4; ++ks) {
      const bf16x8 a = *(const bf16x8*)(hid + l31 * 72 + ks * 16 + h2 * 8);
#pragma unroll
      for (int nt = 0; nt < 2; ++nt) o[nt] = MFMA32(a, *(const bf16x8*)(w2t + (nt * 32 + l31) * 64 + ks * 16 + h2 * 8), o[nt]);
    }
    if (kvsel == 0) {
#pragma unroll
      for (int r = 0; r < 16; ++r) {
        const int nn = mt * 32 + crow(r, h2);
        if (nn < 127) {
          const int pos = 16 * nn + 31;
          const float cs = p.ROPEC()[pos * 32 + l31], sn = p.ROPES()[pos * 32 + l31];
          p.KCMP()[((size_t)b * 128 + nn) * 64 + l31] = f2bf(o[0][r] * cs - o[1][r] * sn);
          p.KCMP()[((size_t)b * 128 + nn) * 64 + 32 + l31] = f2bf(o[0][r] * sn + o[1][r] * cs);
        }
      }
    } else {
#pragma unroll
      for (int nt = 0; nt < 2; ++nt)
#pragma unroll
        for (int r = 0; r < 16; ++r) {
          const int nn = mt * 32 + crow(r, h2);
          if (nn < 127) p.VCMPT()[((size_t)b * 64 + nt * 32 + l31) * 128 + nn] = f2bf(o[nt][r]);
        }
    }
  }
}


#define XB_TMO      128
#define XB_XCNT(j)  (256  + 64 * (j))
#define XB_XSUB(j)  (1280 + 64 * (j))
#define XB_XGEN(j)  (2304 + 64 * (j))
#define XB_TOP      3328
#define XB_TOPGEN   3392
#define XCD_BAR_WORDS 3456
#define XB_SPIN_CAP (1u << 22)
DI unsigned xb_ld(unsigned* p)              { return __hip_atomic_load(p, __ATOMIC_RELAXED, __HIP_MEMORY_SCOPE_AGENT); }
DI unsigned xb_add(unsigned* p, unsigned v) { return __hip_atomic_fetch_add(p, v, __ATOMIC_RELAXED, __HIP_MEMORY_SCOPE_AGENT); }
DI unsigned xb_xcc_id() { return (unsigned)__builtin_amdgcn_s_getreg((3 << 11) | 20) & 0xFu; }
#define XB_SPIN(cond, bar) do { unsigned _sp = 0; while (cond) { __builtin_amdgcn_s_sleep(1); \
    if ((++_sp & 255u) == 0u) { if (xb_ld(&(bar)[XB_TMO])) break; if (_sp > XB_SPIN_CAP) { atomicAdd(&(bar)[XB_TMO], 1u); break; } } } } while (0)
struct XcdBarrier { unsigned* bar; unsigned x; volatile LAS unsigned* st; };
DI XcdBarrier xcd_barrier_post(unsigned* bar, volatile LAS unsigned* st) {
  XcdBarrier b; b.bar = bar; b.x = xb_xcc_id(); b.st = st;
  if (threadIdx.x == 0) (void)xb_add(&bar[XB_XCNT(b.x)], 1u);
  return b;
}
DI void xcd_barrier_complete(unsigned* bar, unsigned x, unsigned& nloc, unsigned& nx) {
  const unsigned G = gridDim.x * gridDim.y * gridDim.z;
  unsigned sum, cnt, mine, sp = 0u;
  for (;;) {
    sum = 0u; cnt = 0u; mine = 0u;
#pragma unroll
    for (unsigned j = 0; j < 16; ++j) { const unsigned c = xb_ld(&bar[XB_XCNT(j)]); sum += c; cnt += (c > 0u) ? 1u : 0u; mine = (j == x) ? c : mine; }
    if (sum == G) break;
    __builtin_amdgcn_s_sleep(1);
    if ((++sp & 255u) == 0u) { if (xb_ld(&bar[XB_TMO])) break; if (sp > XB_SPIN_CAP) { atomicAdd(&bar[XB_TMO], 1u); break; } }
  }
  nloc = mine > 0u ? mine : 1u; nx = cnt > 0u ? cnt : 1u;
}
DI void xcd_barrier(const XcdBarrier& b) {
  asm volatile("s_waitcnt vmcnt(0)" ::: "memory");
  __syncthreads();
  int t0_ = threadIdx.x; asm volatile("" : "+v"(t0_));
  if (t0_ == 0) {
    unsigned* bar = b.bar;
    __builtin_amdgcn_s_waitcnt(0);
    unsigned nloc = b.st[0], nx = b.st[1];
    if (nloc == 0u) { xcd_barrier_complete(bar, b.x, nloc, nx); b.st[0] = nloc; b.st[1] = nx; }
    const unsigned old = xb_add(&bar[XB_XSUB(b.x)], 1u);
    const unsigned gen = old / nloc;
    if (old + 1u == (gen + 1u) * nloc) {
      __builtin_amdgcn_fence(__ATOMIC_RELEASE, "agent");
      asm volatile("s_waitcnt vmcnt(0)" ::: "memory");
      const unsigned og = xb_add(&bar[XB_TOP], 1u);
      const unsigned tg = og / nx;
      if (og + 1u == (tg + 1u) * nx) xb_add(&bar[XB_TOPGEN], 1u);
      else XB_SPIN(xb_ld(&bar[XB_TOPGEN]) == tg, bar);
      __builtin_amdgcn_fence(__ATOMIC_ACQUIRE, "agent");
      xb_add(&bar[XB_XGEN(b.x)], 1u);
      asm volatile("s_waitcnt vmcnt(0)" ::: "memory");
    } else {
      XB_SPIN(xb_ld(&bar[XB_XGEN(b.x)]) == gen, bar);
      __builtin_amdgcn_fence(__ATOMIC_ACQUIRE, "agent");
      asm volatile("s_waitcnt vmcnt(0)" ::: "memory");
    }
  }
  __syncthreads();
}

constexpr int HALF_LDS = 40960;
__global__ void __launch_bounds__(512) mega(Params p) {
  __shared__ __attribute__((aligned(16))) char smem_all[131072 + 32];
  cg::grid_group grid = cg::this_grid();
  const int half = half_id();
  const int bid = blockIdx.x, nblk = gridDim.x;
  const int vbid = 2 * bid + half, nvblk = 2 * nblk;
  char* smem = smem_all + half * HALF_LDS;
  unsigned* xbw = (unsigned*)(smem_all + 131072);
  int* s_pair = (int*)(smem_all + 131072 + 16);
  if (threadIdx.x == 0) { xbw[0] = 0u; xbw[1] = 0u; }
  __syncthreads();
  const XcdBarrier xb = xcd_barrier_post(p.XBAR(), (volatile LAS unsigned*)xbw);
  ph_prologue(p, vbid, nvblk, smem);
  ln_rows(p, 0, 0, vbid, nvblk);
  if (PROBE == 5) { ph_prologue(p, vbid, nvblk, smem); ln_rows(p, 0, 0, vbid, nvblk); }
  grid.sync();
  for (int l = 0; l < 2; ++l) {
    ph_gemm_in(p, l, bid, nblk, smem_all);
    if (PROBE == 1) ph_gemm_in(p, l, bid, nblk, smem_all);
    xcd_barrier(xb);
    for (int rep = 0; rep < (PROBE == 3 ? 2 : 1); ++rep) {
    for (int item = vbid; item < 2048; item += nvblk) ph_mlstm_local(p, l, item, smem);
    for (int item = vbid; item < 2048; item += nvblk) ph_hgrn_local(p, l, item, smem);
    __syncthreads();
    for (int item = vbid; item < 256; item += nvblk) ph_cmp(p, l, item, smem);
    for (int item = vbid; item < 2048; item += nvblk) ph_attnA(p, l, item, smem);
    }
    xcd_barrier(xb);
    if (vbid < 128) ph_mlstm_scan(p, vbid);
    else if (vbid < 256) ph_hgrn_scan(p, vbid - 128);
    __syncthreads();
    ph_attnD(p, l, p.CTR() + l, smem_all, s_pair);
    if (PROBE == 2) ph_attnD(p, l, p.CTR() + 2 + l, smem_all, s_pair);
    xcd_barrier(xb);
    for (int rep = 0; rep < (PROBE == 4 ? 2 : 1); ++rep) {
    for (int item = vbid; item < 2048; item += nvblk) ph_mlstm_out(p, l, item, smem);
    for (int item = vbid; item < 2048; item += nvblk) ph_hgrn_out(p, l, item, smem);
    }
    xcd_barrier(xb);
    ph_gemm_out_ln(p, l, bid, nblk, smem_all);
    if (l == 0) xcd_barrier(xb);
  }
}

static inline size_t align_up(size_t v) { return (v + 255) & ~(size_t)255; }

extern "C" void kernel_launch(void* const* d_in, const int* in_sizes, int n_in, void* d_out, int out_size, void* d_ws, size_t ws_size, hipStream_t stream) {
  Params p{};
  p.x = (const float*)d_in[0]; p.ln0_g = (const float*)d_in[1]; p.ln0_b = (const float*)d_in[2]; p.w_in = (const float*)d_in[3];
  p.b_in = (const float*)d_in[4]; p.a_sinks = (const float*)d_in[5]; p.conv_w = (const float*)d_in[6]; p.conv_b = (const float*)d_in[7];
  p.c_lb = (const float*)d_in[8]; p.c_norm_g = (const float*)d_in[9]; p.pe = (const float*)d_in[10]; p.w1 = (const float*)d_in[11];
  p.w2 = (const float*)d_in[12]; p.w_out = (const float*)d_in[13]; p.ln_g = (const float*)d_in[14]; p.ln_b = (const float*)d_in[15];
  p.hf = (float*)d_out;
  p.ws = (char*)d_ws;
  if (WS_TOTAL > ws_size) { fprintf(stderr, "workspace too small: need %zu have %zu\n", (size_t)WS_TOTAL, ws_size); return; }

  static int grid_blocks = 0;
  if (!grid_blocks) {
    int dev = 0, cus = 0, per_cu = 0;
    (void)hipGetDevice(&dev);
    (void)hipDeviceGetAttribute(&cus, hipDeviceAttributeMultiprocessorCount, dev);
    (void)hipOccupancyMaxActiveBlocksPerMultiprocessor(&per_cu, mega, 512, 0);
    if (per_cu > 1) per_cu = 1;
    grid_blocks = cus * per_cu;
  }
  (void)hipMemsetAsync((char*)d_ws + OFF_XBAR, 0, XCD_BAR_WORDS * 4, stream);
  (void)hipMemsetAsync((char*)d_ws + OFF_CVEC, 0, SZ_CVEC, stream);
  void* args[] = {&p};
  hipError_t e = hipLaunchCooperativeKernel((void*)mega, dim3(grid_blocks), dim3(512), args, 0, stream);
  if (e != hipSuccess) fprintf(stderr, "cooperative launch failed: %s (grid %d)\n", hipGetErrorString(e), grid_blocks);
}
```

```cpp
#include <hip/hip_runtime.h>
#include <hip/hip_cooperative_groups.h>
#include <stdio.h>
#include <stdint.h>
#include <stddef.h>

#ifndef PROBE
#define PROBE 0
#endif
#define DI __device__ __forceinline__
typedef unsigned short bf16_t;
typedef short bf16x8 __attribute__((ext_vector_type(8)));
typedef float f32x16 __attribute__((ext_vector_type(16)));
typedef unsigned u32x4 __attribute__((ext_vector_type(4)));
typedef float f32x4 __attribute__((ext_vector_type(4)));

constexpr int NB = 32, T = 2048, DM = 1024, NTOK = NB * T, NP = 4096;
constexpr float DN_ALPHA = 1.41421356237309515f;

constexpr size_t OFF_HB = 0;
constexpr size_t SZ_HB = (size_t)NTOK * 1024 * 2;
constexpr size_t OFF_YMIX = OFF_HB + ((SZ_HB + 255) & ~(size_t)255);
constexpr size_t SZ_YMIX = (size_t)NTOK * 1024 * 2;
constexpr size_t OFF_QA = OFF_YMIX + ((SZ_YMIX + 255) & ~(size_t)255);
constexpr size_t SZ_QA = (size_t)NTOK * 256 * 2;
constexpr size_t OFF_KA = OFF_QA + ((SZ_QA + 255) & ~(size_t)255);
constexpr size_t SZ_KA = (size_t)NTOK * 128 * 2;
constexpr size_t OFF_VAT = OFF_KA + ((SZ_KA + 255) & ~(size_t)255);
constexpr size_t SZ_VAT = (size_t)NTOK * 128 * 2;
constexpr size_t OFF_QKB = OFF_VAT + ((SZ_VAT + 255) & ~(size_t)255);
constexpr size_t SZ_QKB = (size_t)NTOK * 512 * 2;
constexpr size_t OFF_VBT = OFF_QKB + ((SZ_QKB + 255) & ~(size_t)255);
constexpr size_t SZ_VBT = (size_t)NTOK * 256 * 2;
constexpr size_t OFF_QC = OFF_VBT + ((SZ_VBT + 255) & ~(size_t)255);
constexpr size_t SZ_QC = (size_t)NTOK * 256 * 2;
constexpr size_t OFF_GC = OFF_QC + ((SZ_QC + 255) & ~(size_t)255);
constexpr size_t SZ_GC = (size_t)NTOK * 256 * 4;
constexpr size_t OFF_VCT = OFF_GC + ((SZ_GC + 255) & ~(size_t)255);
constexpr size_t SZ_VCT = (size_t)NTOK * 256 * 2;
constexpr size_t OFF_QD = OFF_VCT + ((SZ_VCT + 255) & ~(size_t)255);
constexpr size_t SZ_QD = (size_t)NTOK * 256 * 2;
constexpr size_t OFF_KV = OFF_QD + ((SZ_QD + 255) & ~(size_t)255);
constexpr size_t SZ_KV = (size_t)NTOK * 384 * 2;
constexpr size_t OFF_GZ = OFF_KV + ((SZ_KV + 255) & ~(size_t)255);
constexpr size_t SZ_GZ = (size_t)NTOK * 1280 * 2;
constexpr size_t OFF_IFG = OFF_GZ + ((SZ_GZ + 255) & ~(size_t)255);
constexpr size_t SZ_IFG = (size_t)NTOK * 8 * 4;
constexpr size_t OFF_DG = OFF_IFG + ((SZ_IFG + 255) & ~(size_t)255);
constexpr size_t SZ_DG = (size_t)NTOK * 12 * 4;
constexpr size_t OFF_WT = OFF_DG + ((SZ_DG + 255) & ~(size_t)255);
constexpr size_t SZ_WT = (size_t)2 * NP * 1024 * 2;
constexpr size_t OFF_WOT = OFF_WT + ((SZ_WT + 255) & ~(size_t)255);
constexpr size_t SZ_WOT = (size_t)2 * 1024 * 1024 * 2;
constexpr size_t OFF_KCMP = OFF_WOT + ((SZ_WOT + 255) & ~(size_t)255);
constexpr size_t SZ_KCMP = (size_t)NB * 128 * 64 * 2;
constexpr size_t OFF_VCMPT = OFF_KCMP + ((SZ_KCMP + 255) & ~(size_t)255);
constexpr size_t SZ_VCMPT = (size_t)NB * 64 * 128 * 2;
constexpr size_t OFF_BIASP = OFF_VCMPT + ((SZ_VCMPT + 255) & ~(size_t)255);
constexpr size_t SZ_BIASP = (size_t)2 * NP * 4;
constexpr size_t OFF_LB = OFF_BIASP + ((SZ_BIASP + 255) & ~(size_t)255);
constexpr size_t SZ_LB = (size_t)512 * 4;
constexpr size_t OFF_ROPEC = OFF_LB + ((SZ_LB + 255) & ~(size_t)255);
constexpr size_t SZ_ROPEC = (size_t)T * 32 * 4;
constexpr size_t OFF_ROPES = OFF_ROPEC + ((SZ_ROPEC + 255) & ~(size_t)255);
constexpr size_t SZ_ROPES = (size_t)T * 32 * 4;
constexpr size_t OFF_BST = OFF_ROPES + ((SZ_ROPES + 255) & ~(size_t)255);
constexpr size_t SZ_BST = (size_t)2048 * 4096 * 4;
constexpr size_t OFF_BN = OFF_BST + ((SZ_BST + 255) & ~(size_t)255);
constexpr size_t SZ_BN = (size_t)2048 * 64 * 4;
constexpr size_t OFF_BG = OFF_BN + ((SZ_BN + 255) & ~(size_t)255);
constexpr size_t SZ_BG = (size_t)2048 * 4;
constexpr size_t OFF_CST = OFF_BG + ((SZ_BG + 255) & ~(size_t)255);
constexpr size_t SZ_CST = (size_t)2048 * 4096 * 4;
constexpr size_t OFF_CAL = OFF_CST + ((SZ_CST + 255) & ~(size_t)255);
constexpr size_t SZ_CAL = (size_t)2048 * 64 * 4;
constexpr size_t OFF_W1T = OFF_CAL + ((SZ_CAL + 255) & ~(size_t)255);
constexpr size_t SZ_W1T = (size_t)4 * 64 * 2048 * 2;
constexpr size_t OFF_W2T = OFF_W1T + ((SZ_W1T + 255) & ~(size_t)255);
constexpr size_t SZ_W2T = (size_t)4 * 64 * 64 * 2;
constexpr size_t OFF_CVEC = OFF_W2T + ((SZ_W2T + 255) & ~(size_t)255);
constexpr size_t SZ_CVEC = (size_t)256 * 4;
constexpr size_t OFF_CTR = OFF_CVEC + ((SZ_CVEC + 255) & ~(size_t)255);
constexpr size_t SZ_CTR = (size_t)256;
constexpr size_t OFF_XBAR = OFF_CTR + ((SZ_CTR + 255) & ~(size_t)255);
constexpr size_t SZ_XBAR = (size_t)3456 * 4;
constexpr size_t OFF_LNS = OFF_XBAR + ((SZ_XBAR + 255) & ~(size_t)255);
constexpr size_t SZ_LNS = (size_t)NTOK * 2 * 4;
constexpr size_t WS_TOTAL = OFF_LNS + ((SZ_LNS + 255) & ~(size_t)255);
struct Params {
  const float *x, *ln0_g, *ln0_b, *w_in, *b_in, *a_sinks, *conv_w, *conv_b, *c_lb, *c_norm_g, *pe, *w1, *w2, *w_out, *ln_g, *ln_b;
  float* hf;
  char* ws;
  DI bf16_t* HB() const { return (bf16_t*)(ws + OFF_HB); }
  DI bf16_t* YMIX() const { return (bf16_t*)(ws + OFF_YMIX); }
  DI bf16_t* QA() const { return (bf16_t*)(ws + OFF_QA); }
  DI bf16_t* KA() const { return (bf16_t*)(ws + OFF_KA); }
  DI bf16_t* VAT() const { return (bf16_t*)(ws + OFF_VAT); }
  DI bf16_t* QKB() const { return (bf16_t*)(ws + OFF_QKB); }
  DI bf16_t* VBT() const { return (bf16_t*)(ws + OFF_VBT); }
  DI bf16_t* QC() const { return (bf16_t*)(ws + OFF_QC); }
  DI float* GC() const { return (float*)(ws + OFF_GC); }
  DI bf16_t* VCT() const { return (bf16_t*)(ws + OFF_VCT); }
  DI bf16_t* QD() const { return (bf16_t*)(ws + OFF_QD); }
  DI bf16_t* KV() const { return (bf16_t*)(ws + OFF_KV); }
  DI bf16_t* GZ() const { return (bf16_t*)(ws + OFF_GZ); }
  DI float* IFG() const { return (float*)(ws + OFF_IFG); }
  DI float* DG() const { return (float*)(ws + OFF_DG); }
  DI bf16_t* WT() const { return (bf16_t*)(ws + OFF_WT); }
  DI bf16_t* WOT() const { return (bf16_t*)(ws + OFF_WOT); }
  DI bf16_t* KCMP() const { return (bf16_t*)(ws + OFF_KCMP); }
  DI bf16_t* VCMPT() const { return (bf16_t*)(ws + OFF_VCMPT); }
  DI float* BIASP() const { return (float*)(ws + OFF_BIASP); }
  DI float* LB() const { return (float*)(ws + OFF_LB); }
  DI float* ROPEC() const { return (float*)(ws + OFF_ROPEC); }
  DI float* ROPES() const { return (float*)(ws + OFF_ROPES); }
  DI float* BST() const { return (float*)(ws + OFF_BST); }
  DI float* BN() const { return (float*)(ws + OFF_BN); }
  DI float* BG() const { return (float*)(ws + OFF_BG); }
  DI float* CST() const { return (float*)(ws + OFF_CST); }
  DI float* CAL() const { return (float*)(ws + OFF_CAL); }
  DI bf16_t* W1T() const { return (bf16_t*)(ws + OFF_W1T); }
  DI bf16_t* W2T() const { return (bf16_t*)(ws + OFF_W2T); }
  DI float* CVEC() const { return (float*)(ws + OFF_CVEC); }
  DI int* CTR() const { return (int*)(ws + OFF_CTR); }
  DI unsigned* XBAR() const { return (unsigned*)(ws + OFF_XBAR); }
  DI float* LNS() const { return (float*)(ws + OFF_LNS); }
};
namespace cg = cooperative_groups;

DI int tid_opaque() { int t = threadIdx.x; asm volatile("" : "+v"(t)); return t & 255; }
DI int half_id() { return __builtin_amdgcn_readfirstlane((int)(threadIdx.x >> 8)); }
DI float bf2f(bf16_t v) { return __uint_as_float(((unsigned)v) << 16); }
DI bf16_t f2bf(float x) { unsigned u = __float_as_uint(x); u += 0x7fffu + ((u >> 16) & 1u); return (bf16_t)(u >> 16); }
DI float sigmoidf_(float x) { return __builtin_amdgcn_rcpf(1.f + __builtin_amdgcn_exp2f(-1.4426950408889634f * x)); }
DI float siluf_(float x) { return x * __builtin_amdgcn_rcpf(1.f + __builtin_amdgcn_exp2f(-1.4426950408889634f * x)); }
DI int lane_op() { int l = threadIdx.x; asm volatile("" : "+v"(l)); return l & 63; }
DI float shx(float v, int m) { return __builtin_bit_cast(float, __builtin_amdgcn_ds_bpermute((lane_op() ^ m) << 2, __builtin_bit_cast(int, v))); }
DI unsigned shx(unsigned v, int m) { return (unsigned)__builtin_amdgcn_ds_bpermute((lane_op() ^ m) << 2, (int)v); }
DI float shup(float v, int d) { const int l = lane_op(); const int s = l - d; return __builtin_bit_cast(float, __builtin_amdgcn_ds_bpermute((s < 0 ? l : s) << 2, __builtin_bit_cast(int, v))); }
DI float wave_sum(float v) { for (int o = 32; o > 0; o >>= 1) v += shx(v, o); return v; }
DI float wave_max(float v) { for (int o = 32; o > 0; o >>= 1) v = fmaxf(v, shx(v, o)); return v; }

DI int orig_col(int n) {
  if (n < 1536) return n;
  if (n < 3712) return n + 8;
  if (n < 3968) return n + 20;
  if (n < 3976) return 1536 + (n - 3968);
  if (n < 3988) return 3720 + (n - 3976);
  return -1;
}

DI bool head_is_paired(int hd);
DI void ph_prologue(const Params& p, int bid, int nblk, char* smem) {
  const long gtid = (long)bid * 256 + tid_opaque(), gsz = (long)nblk * 256;
  if (gtid < 64) p.CTR()[gtid] = 0;
  for (long idx = gtid; idx < 2L * 128 * NP; idx += gsz) {
    const int n = (int)(idx % NP), k8 = (int)((idx / NP) % 128), l = (int)(idx / (NP * 128));
    const int pp = n & 63, w_ = pp >> 5, rr = pp & 31, n_ = rr >> 4, fq_ = (rr >> 2) & 3, j_ = rr & 3;
    const int lc = head_is_paired(n >> 6) ? (32 * n_ + 16 * w_ + 4 * fq_ + j_) : (32 * w_ + 8 * fq_ + 4 * n_ + j_);
    const int oc = orig_col((n & ~63) + lc);
    unsigned w[4];
    for (int j = 0; j < 4; ++j) {
      float a = 0.f, b = 0.f;
      if (oc >= 0) { a = p.w_in[((size_t)l * 1024 + k8 * 8 + 2 * j) * 3988 + oc]; b = p.w_in[((size_t)l * 1024 + k8 * 8 + 2 * j + 1) * 3988 + oc]; }
      w[j] = (unsigned)f2bf(a) | ((unsigned)f2bf(b) << 16);
    }
    *(uint4*)(p.WT() + ((size_t)l * NP + n) * 1024 + k8 * 8) = make_uint4(w[0], w[1], w[2], w[3]);
  }
  for (long idx = gtid; idx < 2L * 128 * 1024; idx += gsz) {
    const int d = (int)(idx % 1024), m8 = (int)((idx / 1024) % 128), l = (int)(idx / (1024 * 128));
    unsigned w[4];
    for (int j = 0; j < 4; ++j) {
      float a = p.w_out[((size_t)l * 1024 + m8 * 8 + 2 * j) * 1024 + d], b = p.w_out[((size_t)l * 1024 + m8 * 8 + 2 * j + 1) * 1024 + d];
      w[j] = (unsigned)f2bf(a) | ((unsigned)f2bf(b) << 16);
    }
    *(uint4*)(p.WOT() + ((size_t)l * 1024 + d) * 1024 + m8 * 8) = make_uint4(w[0], w[1], w[2], w[3]);
  }
  for (long idx = gtid; idx < 4L * 256 * 64; idx += gsz) {
    const int j = (int)(idx % 64), i8 = (int)((idx / 64) % 256), lk = (int)(idx / (64 * 256));
    unsigned w[4];
    for (int e = 0; e < 4; ++e) {
      const float a = p.w1[((size_t)lk * 2048 + i8 * 8 + 2 * e) * 64 + j], b = p.w1[((size_t)lk * 2048 + i8 * 8 + 2 * e + 1) * 64 + j];
      w[e] = (unsigned)f2bf(a) | ((unsigned)f2bf(b) << 16);
    }
    *(uint4*)(p.W1T() + ((size_t)lk * 64 + j) * 2048 + i8 * 8) = make_uint4(w[0], w[1], w[2], w[3]);
  }
  for (long idx = gtid; idx < 4L * 64 * 64; idx += gsz) {
    const int jo = (int)(idx % 64), ji = (int)((idx / 64) % 64), lk = (int)(idx / 4096);
    p.W2T()[((size_t)lk * 64 + jo) * 64 + ji] = f2bf(p.w2[((size_t)lk * 64 + ji) * 64 + jo]);
  }
  if (bid < 64) {
    const int lk = bid >> 4, seg = bid & 15, j = tid_opaque() & 63, part = tid_opaque() >> 6;
    float a = 0.f;
    const int i0 = seg * 128 + part * 32;
#pragma unroll 8
    for (int i = i0; i < i0 + 32; ++i) a += p.pe[(size_t)lk * 2048 + i] * p.w1[((size_t)lk * 2048 + i) * 64 + j];
    float* red = (float*)smem;
    __syncthreads();
    red[part * 64 + j] = a;
    __syncthreads();
    if (part == 0) atomicAdd(p.CVEC() + lk * 64 + j, (red[j] + red[64 + j]) + (red[128 + j] + red[192 + j]));
    __syncthreads();
  }
  for (long idx = gtid; idx < 2L * NP; idx += gsz) {
    const int n = (int)(idx % NP), l = (int)(idx / NP); const int oc = orig_col(n);
    p.BIASP()[idx] = oc >= 0 ? p.b_in[l * 3988 + oc] : 0.f;
  }
  for (long idx = gtid; idx < (long)T * 32; idx += gsz) {
    const int t = (int)(idx / 32), i = (int)(idx % 32);
    const float inv = exp2f(-(float)i * (13.287712379549449f / 32.0f));
    const float ang = (float)t * inv;
    p.ROPEC()[idx] = cosf(ang); p.ROPES()[idx] = sinf(ang);
  }
  for (long idx = gtid; idx < 512; idx += gsz) {
    const int c = (int)(idx % 256), l = (int)(idx / 256);
    const float a = p.c_lb[c], b = p.c_lb[256 + c];
    const float m = fmaxf(a, b); const float ea = expf(a - m), eb = expf(b - m);
    p.LB()[idx] = l == 0 ? 0.f : eb / (ea + eb);
  }
}

DI void ln_rows(const Params& p, int mode, int layer, int bid, int nblk) {
  const int tid_ = tid_opaque(); const int lane = tid_ & 63, wid = tid_ >> 6, nw = 4;
  const float* g = mode == 0 ? p.ln0_g : p.ln_g + layer * 1024;
  const float* bb = mode == 0 ? p.ln0_b : p.ln_b + layer * 1024;
  const float* src = mode == 0 ? p.x : p.hf;
  for (int row = bid * nw + wid; row < NTOK; row += nblk * nw) {
    const float* s = src + (size_t)row * 1024;
    float4 v[4];
    float sum = 0.f;
#pragma unroll
    for (int i = 0; i < 4; ++i) { v[i] = *(const float4*)(s + i * 256 + lane * 4); sum += (v[i].x + v[i].y) + (v[i].z + v[i].w); }
    sum = wave_sum(sum);
    const float mu = sum * (1.f / 1024.f);
    float q = 0.f;
#pragma unroll
    for (int i = 0; i < 4; ++i) { float a = v[i].x - mu, b = v[i].y - mu, c = v[i].z - mu, d = v[i].w - mu; q += (a * a + b * b) + (c * c + d * d); }
    q = wave_sum(q);
    const float rs = rsqrtf(q * (1.f / 1024.f) + 1e-5f);
    if (mode == 0 && lane == 0) { p.LNS()[(size_t)row * 2] = mu; p.LNS()[(size_t)row * 2 + 1] = rs; }
#pragma unroll
    for (int i = 0; i < 4; ++i) {
      const int c0 = i * 256 + lane * 4;
      const float4 gg = *(const float4*)(g + c0), b4 = *(const float4*)(bb + c0);
      float4 o;
      o.x = (v[i].x - mu) * rs * gg.x + b4.x; o.y = (v[i].y - mu) * rs * gg.y + b4.y;
      o.z = (v[i].z - mu) * rs * gg.z + b4.z; o.w = (v[i].w - mu) * rs * gg.w + b4.w;
      if (mode != 0) *(float4*)(p.hf + (size_t)row * 1024 + c0) = o;
      uint2 pk; pk.x = (unsigned)f2bf(o.x) | ((unsigned)f2bf(o.y) << 16); pk.y = (unsigned)f2bf(o.z) | ((unsigned)f2bf(o.w) << 16);
      *(uint2*)(p.HB() + (size_t)row * 1024 + c0) = pk;
    }
  }
}

typedef float f32x2 __attribute__((ext_vector_type(2)));
typedef __bf16 bf16v2 __attribute__((ext_vector_type(2)));
typedef unsigned u32x2 __attribute__((ext_vector_type(2)));
DI unsigned pack2(float a, float b) { f32x2 v = {a, b}; return __builtin_bit_cast(unsigned, __builtin_convertvector(v, bf16v2)); }
DI f32x16 zero16() { f32x16 z;
#pragma unroll
  for (int i = 0; i < 16; ++i) z[i] = 0.f; return z; }
DI bf16x8 ld_frag8x2(const bf16_t* p) { const u32x2 lo = *(const u32x2*)p, hi = *(const u32x2*)(p + 8); u32x4 t = {lo.x, lo.y, hi.x, hi.y}; return __builtin_bit_cast(bf16x8, t); }
template <int BASE> DI bf16x8 pack8(const f32x16& s) {
  u32x4 t = {pack2(s[BASE + 0], s[BASE + 1]), pack2(s[BASE + 2], s[BASE + 3]), pack2(s[BASE + 4], s[BASE + 5]), pack2(s[BASE + 6], s[BASE + 7])};
  return __builtin_bit_cast(bf16x8, t);
}
DI int crow(int r, int h2) { return (r & 3) + 8 * (r >> 2) + 4 * h2; }
#define MFMA32(a, b, c) __builtin_amdgcn_mfma_f32_32x32x16_bf16((a), (b), (c), 0, 0, 0)
#define LAS __attribute__((address_space(3)))
enum { K_NONE = 0, K_ROPE, K_PLAIN, K_TR, K_GSILU, K_GSIG, K_SILUH, K_LOGF, K_SMALL };
namespace g8 {
constexpr int BK = 64, HALF = 128, HT = HALF * BK;
DI int lds_byte(int r, int c) { const int st = (r >> 4) * 2 + (c >> 5), rr = r & 15, cc = c & 31, ob = rr * 64 + cc * 2; return st * 1024 + (ob ^ (((ob >> 9) & 1) << 5)); }
DI void stage_rc(int b, int& R, int& C) { const int st = b / 1024, sb = b % 1024, swz = sb ^ (((sb >> 9) & 1) << 5); R = (st >> 1) * 16 + swz / 64; C = (st & 1) * 32 + (swz % 64) / 2; }
}
DI void gemm256_mainloop(const bf16_t* A, const bf16_t* Bt, bf16_t* shm, f32x4 (&acc)[2][2][4][2]) {
  using namespace g8;
  constexpr int K = 1024;
#define SA(b, h) (shm + ((b) * 2 + (h)) * HT)
#define SB(b, h) (shm + (4 + (b) * 2 + (h)) * HT)
#define STAGE(P, BASE, br, kt) do { const long g_ = (long)(br) * K + (long)(kt) * BK; \
    _Pragma("unroll") for (int i_ = 0; i_ < 2; ++i_) { const int b_ = tidf * 16 + i_ * 8192; int r_, c_; stage_rc(b_, r_, c_); \
      __builtin_amdgcn_global_load_lds((const unsigned*)((BASE) + g_ + (long)r_ * K + c_), (LAS unsigned*)((char*)(P) + b_), 16, 0, 0); } } while (0)
#define LDA(dst, b, h) _Pragma("unroll") for (int m = 0; m < 4; ++m) _Pragma("unroll") for (int k = 0; k < 2; ++k) \
    dst[m][k] = *reinterpret_cast<const bf16x8*>((const char*)SA(b, h) + lds_byte(wr * 64 + m * 16 + fr, k * 32 + fq * 8))
#define LDB(dst, b, h) _Pragma("unroll") for (int n = 0; n < 2; ++n) _Pragma("unroll") for (int k = 0; k < 2; ++k) \
    dst[n][k] = *reinterpret_cast<const bf16x8*>((const char*)SB(b, h) + lds_byte(wc * 32 + n * 16 + fr, k * 32 + fq * 8))
#define MMA(ai, bj, At_, Bt_) do { __builtin_amdgcn_s_setprio(1); \
    _Pragma("unroll") for (int m = 0; m < 4; ++m) _Pragma("unroll") for (int n = 0; n < 2; ++n) _Pragma("unroll") for (int k = 0; k < 2; ++k) \
      acc[ai][bj][m][n] = __builtin_amdgcn_mfma_f32_16x16x32_bf16(Bt_[n][k], At_[m][k], acc[ai][bj][m][n], 0, 0, 0); \
    __builtin_amdgcn_s_setprio(0); } while (0)
#define WAIT_V(n) asm volatile("s_waitcnt vmcnt(" #n ")" ::: "memory")
#define WAIT_L(n) asm volatile("s_waitcnt lgkmcnt(" #n ")" ::: "memory")
#define BAR __builtin_amdgcn_s_barrier()
#define SCHED __builtin_amdgcn_sched_barrier(0)
  int tidf = threadIdx.x; asm volatile("" : "+v"(tidf));
  const int wid = tidf >> 6, lane = tidf & 63, wr = wid >> 2, wc = wid & 3, fr = lane & 15, fq = lane >> 4;
#pragma unroll
  for (int a = 0; a < 2; ++a)
#pragma unroll
    for (int b = 0; b < 2; ++b)
#pragma unroll
      for (int m = 0; m < 4; ++m)
#pragma unroll
        for (int n = 0; n < 2; ++n) acc[a][b][m][n] = (f32x4){0.f, 0.f, 0.f, 0.f};
  bf16x8 At[4][2], B0[2][2], B1[2][2];
  constexpr int nt = K / BK;
  WAIT_V(0);
  STAGE(SB(0, 0), Bt, 0, 0); STAGE(SA(0, 0), A, 0, 0);
  STAGE(SB(0, 1), Bt, HALF, 0); STAGE(SA(0, 1), A, HALF, 0);
  if (wr == 1) BAR;
  WAIT_V(4); BAR;
  STAGE(SB(1, 0), Bt, 0, 1); STAGE(SA(1, 0), A, 0, 1); STAGE(SB(1, 1), Bt, HALF, 1);
  WAIT_V(6); BAR;
  for (int t = 0; t < nt - 2; t += 2) {
    LDB(B0, 0, 0); SCHED; LDA(At, 0, 0); STAGE(SA(1, 1), A, HALF, t + 1);
    WAIT_L(8); BAR; WAIT_L(0); MMA(0, 0, At, B0); BAR; SCHED;
    LDB(B1, 0, 1); STAGE(SB(0, 0), Bt, 0, t + 2);
    BAR; WAIT_L(0); MMA(0, 1, At, B1); BAR;
    LDA(At, 0, 1); STAGE(SA(0, 0), A, 0, t + 2);
    BAR; WAIT_L(0); MMA(1, 0, At, B0); BAR; SCHED;
    STAGE(SB(0, 1), Bt, HALF, t + 2);
    WAIT_V(6); BAR; MMA(1, 1, At, B1); BAR;
    LDB(B0, 1, 0); SCHED; LDA(At, 1, 0); STAGE(SA(0, 1), A, HALF, t + 2);
    WAIT_L(8); BAR; WAIT_L(0); MMA(0, 0, At, B0); BAR; SCHED;
    LDB(B1, 1, 1); STAGE(SB(1, 0), Bt, 0, t + 3);
    BAR; WAIT_L(0); MMA(0, 1, At, B1); BAR;
    LDA(At, 1, 1); STAGE(SA(1, 0), A, 0, t + 3);
    BAR; WAIT_L(0); MMA(1, 0, At, B0); BAR; SCHED;
    STAGE(SB(1, 1), Bt, HALF, t + 3);
    WAIT_V(6); BAR; MMA(1, 1, At, B1); BAR;
  }
  { LDB(B0, 0, 0); LDA(At, 0, 0); STAGE(SA(1, 1), A, HALF, nt - 1);
    BAR; WAIT_L(0); MMA(0, 0, At, B0); BAR;
    LDB(B1, 0, 1); BAR; WAIT_L(0); MMA(0, 1, At, B1); BAR;
    LDA(At, 0, 1); WAIT_V(4); BAR; WAIT_L(0); MMA(1, 0, At, B0); MMA(1, 1, At, B1); BAR; }
  { LDB(B0, 1, 0); LDA(At, 1, 0); WAIT_V(2); BAR; WAIT_L(0); MMA(0, 0, At, B0); BAR;
    LDB(B1, 1, 1); WAIT_V(0); BAR; WAIT_L(0); MMA(0, 1, At, B1); BAR;
    LDA(At, 1, 1); BAR; WAIT_L(0); MMA(1, 0, At, B0); MMA(1, 1, At, B1); BAR; }
  if (wr == 0) BAR;
#undef SA
#undef SB
#undef STAGE
#undef LDA
#undef LDB
#undef MMA
#undef WAIT_V
#undef WAIT_L
#undef BAR
#undef SCHED
}

DI void classify_head(const Params& p, int hd, int b, int& kind, bf16_t*& dst, float*& fdst, float& scale) {
  kind = K_NONE; dst = nullptr; fdst = nullptr; scale = 1.f;
  if (hd < 4) { kind = K_ROPE; dst = p.QA() + ((size_t)(b * 4 + hd) * T) * 64; scale = 0.125f * 1.4426950408889634f; }
  else if (hd < 6) { kind = K_ROPE; dst = p.KA() + ((size_t)(b * 2 + hd - 4) * T) * 64; }
  else if (hd < 8) { kind = K_TR; dst = p.VAT() + (size_t)(b * 2 + hd - 6) * 64 * T; }
  else if (hd < 12) { kind = K_GSILU; dst = p.GZ() + (size_t)0 * NTOK * 256 + (hd - 8) * 64; }
  else if (hd < 20) { kind = K_PLAIN; dst = p.QKB() + ((size_t)(b * 8 + hd - 12) * T) * 64; }
  else if (hd < 24) { kind = K_TR; dst = p.VBT() + (size_t)(b * 4 + hd - 20) * 64 * T; }
  else if (hd < 28) { kind = K_GSIG; dst = p.GZ() + (size_t)1 * NTOK * 256 + (hd - 24) * 64; }
  else if (hd < 32) { kind = K_GSILU; dst = p.GZ() + (size_t)2 * NTOK * 256 + (hd - 28) * 64; }
  else if (hd < 36) { kind = K_SILUH; dst = p.QC() + ((size_t)(b * 4 + hd - 32) * T) * 64; }
  else if (hd < 40) { kind = K_LOGF; fdst = p.GC() + ((size_t)(b * 4 + hd - 36) * T) * 64; }
  else if (hd < 44) { kind = K_TR; dst = p.VCT() + (size_t)(b * 4 + hd - 40) * 64 * T; }
  else if (hd < 48) { kind = K_GSILU; dst = p.GZ() + (size_t)3 * NTOK * 256 + (hd - 44) * 64; }
  else if (hd < 52) { kind = K_ROPE; dst = p.QD() + ((size_t)(b * 4 + hd - 48) * T) * 64; scale = 0.125f * 1.4426950408889634f; }
  else if (hd < 58) {
    const int j = hd - 52;
    dst = p.KV() + (size_t)(j * NB + b) * T * 64;
    kind = (j == 0 || j == 1) ? K_PLAIN : ((j == 2 || j == 4) ? K_ROPE : K_TR);
  }
  else if (hd < 62) { kind = K_GSILU; dst = p.GZ() + (size_t)4 * NTOK * 256 + (hd - 58) * 64; }
  else if (hd == 62) { kind = K_SMALL; }
}

DI bool head_is_paired(int hd) { return hd < 6 || (hd >= 48 && hd < 52) || hd == 54 || hd == 56; }
template <int KIND>
DI void epi_direct(const Params& p, const f32x4 (&a)[4][2], bf16_t* dst, float* fdst, float scale, int layer, int hd, int b, int tq, int wr, int w, int fr, int fq) {
  if (KIND == K_ROPE) {
    const int c = 16 * w + 4 * fq;
    const f32x4 b0 = *(const f32x4*)(p.BIASP() + layer * NP + hd * 64 + c), b1 = *(const f32x4*)(p.BIASP() + layer * NP + hd * 64 + 32 + c);
#pragma unroll
    for (int m = 0; m < 4; ++m) {
      const int t = tq + wr * 64 + m * 16 + fr;
      const f32x4 cs = *(const f32x4*)(p.ROPEC() + t * 32 + c), sn = *(const f32x4*)(p.ROPES() + t * 32 + c);
      const f32x4 v0 = a[m][0] + b0, v1 = a[m][1] + b1;
      const f32x4 o0 = (v0 * cs - v1 * sn) * scale, o1 = (v0 * sn + v1 * cs) * scale;
      u32x2 w0 = {pack2(o0[0], o0[1]), pack2(o0[2], o0[3])}, w1 = {pack2(o1[0], o1[1]), pack2(o1[2], o1[3])};
      *(u32x2*)(dst + (size_t)t * 64 + c) = w0; *(u32x2*)(dst + (size_t)t * 64 + 32 + c) = w1;
    }
    return;
  }
  const int c = 32 * w + 8 * fq;
  const f32x4 b0 = *(const f32x4*)(p.BIASP() + layer * NP + hd * 64 + c), b1 = *(const f32x4*)(p.BIASP() + layer * NP + hd * 64 + c + 4);
  if (KIND == K_SMALL) {
#pragma unroll
    for (int m = 0; m < 4; ++m) {
      const size_t tok = (size_t)b * T + tq + wr * 64 + m * 16 + fr;
#pragma unroll
      for (int n = 0; n < 2; ++n)
#pragma unroll
        for (int j = 0; j < 4; ++j) {
          const int cc = c + 4 * n + j;
          const float v = a[m][n][j] + (n ? b1[j] : b0[j]);
          if (cc < 8) p.IFG()[tok * 8 + cc] = v;
          else if (cc < 20) p.DG()[tok * 12 + (cc - 8)] = sigmoidf_(v);
        }
    }
    return;
  }
  f32x4 lb0 = {0.f, 0.f, 0.f, 0.f}, lb1 = {0.f, 0.f, 0.f, 0.f};
  if (KIND == K_LOGF) { lb0 = *(const f32x4*)(p.LB() + layer * 256 + (hd - 36) * 64 + c); lb1 = *(const f32x4*)(p.LB() + layer * 256 + (hd - 36) * 64 + c + 4); }
#pragma unroll
  for (int m = 0; m < 4; ++m) {
    const int t = tq + wr * 64 + m * 16 + fr;
    const f32x4 v0 = a[m][0] + b0, v1 = a[m][1] + b1;
    if (KIND == K_LOGF) {
      f32x4 o0, o1;
#pragma unroll
      for (int j = 0; j < 4; ++j) { o0[j] = __logf(lb0[j] + (1.f - lb0[j]) * sigmoidf_(v0[j])); o1[j] = __logf(lb1[j] + (1.f - lb1[j]) * sigmoidf_(v1[j])); }
      *(f32x4*)(fdst + (size_t)t * 64 + c) = o0; *(f32x4*)(fdst + (size_t)t * 64 + c + 4) = o1;
    } else {
      f32x4 o0, o1;
#pragma unroll
      for (int j = 0; j < 4; ++j) {
        if (KIND == K_PLAIN) { o0[j] = v0[j]; o1[j] = v1[j]; }
        else if (KIND == K_SILUH || KIND == K_GSILU) { o0[j] = siluf_(v0[j]); o1[j] = siluf_(v1[j]); }
        else { o0[j] = sigmoidf_(v0[j]); o1[j] = sigmoidf_(v1[j]); }
      }
      u32x4 wv = {pack2(o0[0], o0[1]), pack2(o0[2], o0[3]), pack2(o1[0], o1[1]), pack2(o1[2], o1[3])};
      if (KIND == K_GSILU || KIND == K_GSIG) *(u32x4*)(dst + ((size_t)b * T + t) * 256 + c) = wv;
      else *(u32x4*)(dst + (size_t)t * 64 + c) = wv;
    }
  }
}
DI void epi_tr_write(const Params& p, const f32x4 (&a)[4][2], char* img, int layer, int hd, int wr, int w, int fr, int fq) {
  const int c = 32 * w + 8 * fq;
  const f32x4 b0 = *(const f32x4*)(p.BIASP() + layer * NP + hd * 64 + c), b1 = *(const f32x4*)(p.BIASP() + layer * NP + hd * 64 + c + 4);
  bf16_t* timg = (bf16_t*)img;
#pragma unroll
  for (int m = 0; m < 4; ++m)
#pragma unroll
    for (int n = 0; n < 2; ++n)
#pragma unroll
      for (int j = 0; j < 4; ++j) timg[(c + 4 * n + j) * 128 + wr * 64 + m * 16 + fr] = f2bf(a[m][n][j] + (n ? b1[j] : b0[j]));
}
DI void gemm_in_quadrant(const Params& p, int layer, int panel, int pn, int ai, int bj, const f32x4 (&a)[4][2], char* shm,
                         int b, int hq, int tid2, int wr, int wc, int fr, int fq) {
  const int tq = (panel & 7) * 256 + ai * 128;
  const int hd0 = pn * 4 + bj * 2;
  const int hd = hd0 + (wc >> 1), w = wc & 1;
  int kind; bf16_t* dst; float* fdst; float scale;
  classify_head(p, hd, b, kind, dst, fdst, scale);
  switch (kind) {
    case K_ROPE: epi_direct<K_ROPE>(p, a, dst, fdst, scale, layer, hd, b, tq, wr, w, fr, fq); break;
    case K_PLAIN: epi_direct<K_PLAIN>(p, a, dst, fdst, scale, layer, hd, b, tq, wr, w, fr, fq); break;
    case K_GSILU: epi_direct<K_GSILU>(p, a, dst, fdst, scale, layer, hd, b, tq, wr, w, fr, fq); break;
    case K_GSIG: epi_direct<K_GSIG>(p, a, dst, fdst, scale, layer, hd, b, tq, wr, w, fr, fq); break;
    case K_SILUH: epi_direct<K_SILUH>(p, a, dst, fdst, scale, layer, hd, b, tq, wr, w, fr, fq); break;
    case K_LOGF: epi_direct<K_LOGF>(p, a, dst, fdst, scale, layer, hd, b, tq, wr, w, fr, fq); break;
    case K_SMALL: epi_direct<K_SMALL>(p, a, dst, fdst, scale, layer, hd, b, tq, wr, w, fr, fq); break;
    default: break;
  }
  int k0, k1; { bf16_t* d_; float* f_; float s_; classify_head(p, hd0, b, k0, d_, f_, s_); classify_head(p, hd0 + 1, b, k1, d_, f_, s_); }
  if (k0 == K_TR || k1 == K_TR) {
    if (kind == K_TR) epi_tr_write(p, a, shm + (wc >> 1) * 16384, layer, hd, wr, w, fr, fq);
    __syncthreads();
    int kq; bf16_t* dq; float* fq_; float sq; classify_head(p, hd0 + hq, b, kq, dq, fq_, sq);
    if (kq == K_TR) {
      const char* img = shm + hq * 16384;
#pragma unroll
      for (int i = 0; i < 4; ++i) { const int q = tid2 + 256 * i, cc = q >> 4, rc = q & 15; *(u32x4*)(dq + (size_t)cc * T + tq + rc * 8) = *(const u32x4*)(img + q * 16); }
    }
    __syncthreads();
  }
}
DI void gemm_in_epilogue(const Params& p, int layer, int panel, int pn, const f32x4 (&acc)[2][2][4][2], char* shm) {
  int tidf = threadIdx.x; asm volatile("" : "+v"(tidf));
  const int wid = tidf >> 6, lane = tidf & 63, wr = wid >> 2, wc = wid & 3, fr = lane & 15, fq = lane >> 4;
  const int b = panel >> 3;
  const int hq = __builtin_amdgcn_readfirstlane(tidf >> 8), tid2 = tidf & 255;
  __syncthreads();
  gemm_in_quadrant(p, layer, panel, pn, 0, 0, acc[0][0], shm, b, hq, tid2, wr, wc, fr, fq);
  gemm_in_quadrant(p, layer, panel, pn, 0, 1, acc[0][1], shm, b, hq, tid2, wr, wc, fr, fq);
  gemm_in_quadrant(p, layer, panel, pn, 1, 0, acc[1][0], shm, b, hq, tid2, wr, wc, fr, fq);
  gemm_in_quadrant(p, layer, panel, pn, 1, 1, acc[1][1], shm, b, hq, tid2, wr, wc, fr, fq);
}
template <int L0>
DI void gemm_out_epilogue(const Params& p, int panel, int pn, const f32x4 (&acc)[2][2][4][2], char* shm) {
  int tidf = threadIdx.x; asm volatile("" : "+v"(tidf));
  const int wid = tidf >> 6, lane = tidf & 63, wr = wid >> 2, wc = wid & 3, fr = lane & 15, fq = lane >> 4;
#pragma unroll
  for (int ai = 0; ai < 2; ++ai)
#pragma unroll
    for (int m = 0; m < 4; ++m) {
      const size_t row = (size_t)(panel * 256 + ai * 128 + wr * 64 + m * 16 + fr);
      float mu = 0.f, rs = 0.f;
      if (L0) { const f32x2 st = *(const f32x2*)(p.LNS() + row * 2); mu = st[0]; rs = st[1]; }
#pragma unroll
      for (int bj = 0; bj < 2; ++bj)
#pragma unroll
        for (int n = 0; n < 2; ++n) {
          const int col = pn * 256 + bj * 128 + wc * 32 + n * 16 + fq * 4;
          float* g = p.hf + row * 1024 + col;
          f32x4 h;
          if (L0) {
            const f32x4 xv = *(const f32x4*)(p.x + row * 1024 + col);
            const f32x4 gg = *(const f32x4*)(p.ln0_g + col), bb = *(const f32x4*)(p.ln0_b + col);
            h = (xv - mu) * rs * gg + bb;
          } else h = *(const f32x4*)g;
          *(f32x4*)g = DN_ALPHA * h + acc[ai][bj][m][n];
        }
    }
}
DI void ph_gemm_in(const Params& p, int layer, int bid, int nblk, char* shm) {
  asm volatile("" : "+s"(bid));
  for (int panel = bid; panel < 256; panel += nblk) {
    const bf16_t* A = p.HB() + (size_t)panel * 256 * 1024;
    for (int pn = 0; pn < 16; ++pn) {
      f32x4 acc[2][2][4][2];
      gemm256_mainloop(A, p.WT() + ((size_t)layer * NP + pn * 256) * 1024, (bf16_t*)shm, acc);
      if (PROBE == 6) { __syncthreads(); gemm256_mainloop(A, p.WT() + ((size_t)layer * NP + pn * 256) * 1024, (bf16_t*)shm, acc); }
      gemm_in_epilogue(p, layer, panel, pn, acc, shm);
      if (PROBE == 7) gemm_in_epilogue(p, layer, panel, pn, acc, shm);
    }
  }
}
DI void ph_gemm_out_ln(const Params& p, int layer, int bid, int nblk, char* shm) {
  asm volatile("" : "+s"(bid));
  for (int panel = bid; panel < 256; panel += nblk) {
    const bf16_t* A = p.YMIX() + (size_t)panel * 256 * 1024;
    for (int pn = 0; pn < 4; ++pn) {
      f32x4 acc[2][2][4][2];
      gemm256_mainloop(A, p.WOT() + ((size_t)layer * 1024 + pn * 256) * 1024, (bf16_t*)shm, acc);
      if (layer == 0) gemm_out_epilogue<1>(p, panel, pn, acc, shm); else gemm_out_epilogue<0>(p, panel, pn, acc, shm);
    }
    asm volatile("s_waitcnt vmcnt(0)" ::: "memory");
    __syncthreads();
    int tidf = threadIdx.x; asm volatile("" : "+v"(tidf));
    const int lane = tidf & 63, wid = tidf >> 6;
    const float* g = p.ln_g + layer * 1024; const float* bb = p.ln_b + layer * 1024;
    for (int rr = 0; rr < 32; ++rr) {
      const int row = panel * 256 + wid * 32 + rr;
      float* s = p.hf + (size_t)row * 1024;
      f32x4 v[4];
      float sum = 0.f;
#pragma unroll
      for (int i = 0; i < 4; ++i) { v[i] = *(const f32x4*)(s + i * 256 + lane * 4); sum += (v[i][0] + v[i][1]) + (v[i][2] + v[i][3]); }
      sum = wave_sum(sum);
      const float mu = sum * (1.f / 1024.f);
      float q = 0.f;
#pragma unroll
      for (int i = 0; i < 4; ++i) { const f32x4 d = v[i] - mu; q += (d[0] * d[0] + d[1] * d[1]) + (d[2] * d[2] + d[3] * d[3]); }
      q = wave_sum(q);
      const float rs = rsqrtf(q * (1.f / 1024.f) + 1e-5f);
#pragma unroll
      for (int i = 0; i < 4; ++i) {
        const int cc = i * 256 + lane * 4;
        const f32x4 gg = *(const f32x4*)(g + cc), b4 = *(const f32x4*)(bb + cc);
        const f32x4 o = (v[i] - mu) * rs * gg + b4;
        *(f32x4*)(s + cc) = o;
        if (layer == 0) { u32x2 pk = {pack2(o[0], o[1]), pack2(o[2], o[3])}; *(u32x2*)(p.HB() + (size_t)row * 1024 + cc) = pk; }
      }
    }
  }
}

DI f32x16 qk_tile(const bf16_t* Krow, const bf16x8 (&qf)[4], int l31, int h2) {
  f32x16 s = zero16();
  const bf16_t* kp = Krow + l31 * 64 + h2 * 8;
#pragma unroll
  for (int ks = 0; ks < 4; ++ks) { const bf16x8 a = *(const bf16x8*)(kp + ks * 16); s = MFMA32(a, qf[ks], s); }
  return s;
}
DI f32x16 qk_tile_s(const bf16_t* Krow, int stride, const bf16x8 (&qf)[4], int l31, int h2) {
  f32x16 s = zero16();
  const bf16_t* kp = Krow + l31 * stride + h2 * 8;
#pragma unroll
  for (int ks = 0; ks < 4; ++ks) { const bf16x8 a = *(const bf16x8*)(kp + ks * 16); s = MFMA32(a, qf[ks], s); }
  return s;
}
DI void softmax_pv(f32x16& s, const bf16_t* VTp, int vstride, f32x16 (&o)[2], float& m, float& l, int l31, int h2) {
  bf16x8 va[2][2];
#pragma unroll
  for (int dt = 0; dt < 2; ++dt)
#pragma unroll
    for (int sk = 0; sk < 2; ++sk) va[dt][sk] = ld_frag8x2(VTp + (size_t)(dt * 32 + l31) * vstride + sk * 16 + 4 * h2);
  float mx = s[0];
#pragma unroll
  for (int r = 1; r < 16; ++r) mx = fmaxf(mx, s[r]);
  mx = fmaxf(mx, shx(mx, 32));
  const float mn = fmaxf(m, mx);
  const float alpha = __builtin_amdgcn_exp2f(m - mn);
  float ps = 0.f;
#pragma unroll
  for (int r = 0; r < 16; ++r) { s[r] = __builtin_amdgcn_exp2f(s[r] - mn); ps += s[r]; }
  ps += shx(ps, 32);
  l = l * alpha + ps; m = mn;
#pragma unroll
  for (int dt = 0; dt < 2; ++dt)
#pragma unroll
    for (int r = 0; r < 16; ++r) o[dt][r] *= alpha;
  const bf16x8 p0 = pack8<0>(s), p1 = pack8<8>(s);
#pragma unroll
  for (int dt = 0; dt < 2; ++dt) { o[dt] = MFMA32(va[dt][0], p0, o[dt]); o[dt] = MFMA32(va[dt][1], p1, o[dt]); }
}

constexpr int AD_KSTR = 72, AD_VSTR = 68;
constexpr int AD_BUF = 64 * AD_KSTR * 2 + 64 * AD_VSTR * 2;
struct AdTile { u32x4 k, v; };
DI AdTile ad_load(const bf16_t* Kg, const bf16_t* Vg, int key0, int tidf) {
  AdTile r; const int row = tidf >> 3, ch = tidf & 7;
  r.k = *(const u32x4*)(Kg + (size_t)(key0 + row) * 64 + ch * 8);
  r.v = *(const u32x4*)(Vg + (size_t)row * T + key0 + ch * 8);
  return r;
}
DI void ad_store(const AdTile& r, char* buf, int tidf) {
  const int row = tidf >> 3, ch = tidf & 7;
  *(u32x4*)(buf + (row * AD_KSTR + ch * 8) * 2) = r.k;
  char* vp = buf + 64 * AD_KSTR * 2 + (row * AD_VSTR + ch * 8) * 2;
  *(u32x2*)vp = (u32x2){r.v[0], r.v[1]}; *(u32x2*)(vp + 8) = (u32x2){r.v[2], r.v[3]};
}
DI void ph_attnD(const Params& p, int layer, int* ctr, char* smem, int* s_pair) {
  float* imps = (float*)smem;
  float* impf = (float*)(smem + 34816);
  unsigned* smask = (unsigned*)(smem + 43008);
  unsigned* s_union = (unsigned*)(smem + 43008 + 256);
  char* kvbuf = smem + 49152;
  int tidf = threadIdx.x; asm volatile("" : "+v"(tidf));
  const int lane = tidf & 63, wid = tidf >> 6, h = wid & 3, qs = wid >> 2, l31 = lane & 31, h2 = lane >> 5;
  for (;;) {
    __syncthreads();
    if (tidf == 0) { *s_pair = atomicAdd(ctr, 1); *s_union = 0u; }
    __syncthreads();
    const int it = *s_pair;
    if (it >= 1024) break;
    const int b = it & 31, q0 = (31 - (it >> 5)) * 64;
    const int qw = q0 + 32 * qs;
    const int t = qw + l31, cur = q0 >> 6;
    const size_t tok = (size_t)b * T + t;
    bf16x8 qf[4];
    {
      const bf16_t* qp = p.QD() + ((size_t)(b * 4 + h) * T + t) * 64 + h2 * 8;
#pragma unroll
      for (int ks = 0; ks < 4; ++ks) qf[ks] = *(const bf16x8*)(qp + ks * 16);
    }
    const float g0 = p.DG()[tok * 12 + h * 3 + 0], g1 = p.DG()[tok * 12 + h * 3 + 1], g2 = p.DG()[tok * 12 + h * 3 + 2];
    f32x16 ofin[2];
    {
      const bf16_t* Kc = p.KCMP() + (size_t)b * 128 * 64;
      const bf16_t* Vc = p.VCMPT() + (size_t)b * 64 * 128;
      const int nkt = min(4, (qw >> 9) + 1);
      f32x16 o[2]; o[0] = zero16(); o[1] = zero16();
      float m = -1e30f, l = 0.f;
      for (int kt = 0; kt < nkt; ++kt) {
        f32x16 s = qk_tile(Kc + kt * 32 * 64, qf, l31, h2);
#pragma unroll
        for (int r = 0; r < 16; ++r) { const int n = kt * 32 + crow(r, h2); if (16 * n + 31 > t) s[r] = -INFINITY; }
        softmax_pv(s, Vc + kt * 32, 128, o, m, l, l31, h2);
      }
      const float il = l > 0.f ? 1.f / l : 0.f;
      const float gi = g0 * il;
#pragma unroll
      for (int dt = 0; dt < 2; ++dt)
#pragma unroll
        for (int r = 0; r < 16; ++r) ofin[dt][r] = gi * o[dt][r];
      float carry = 0.f;
#pragma unroll
      for (int kt = 0; kt < 4; ++kt) {
        f32x16 s;
        if (kt < nkt) {
          s = qk_tile(Kc + kt * 32 * 64, qf, l31, h2);
#pragma unroll
          for (int r = 0; r < 16; ++r) { const int n = kt * 32 + crow(r, h2); s[r] = (16 * n + 31 > t) ? 0.f : __builtin_amdgcn_exp2f(s[r] - m) * il; }
        } else s = zero16();
        float X[4];
#pragma unroll
        for (int g = 0; g < 4; ++g) X[g] = shx(s[4 * g + 3], 32);
#pragma unroll
        for (int g = 0; g < 4; ++g) {
          const float G = (s[4 * g] + s[4 * g + 1]) + (s[4 * g + 2] + s[4 * g + 3]);
          const float prev_other = g > 0 ? X[g - 1] : carry;
          imps[(wid * 32 + l31) * 33 + 8 * kt + 2 * g + h2] = G + (h2 ? X[g] : prev_other);
        }
        carry = X[3];
      }
    }
    __syncthreads();
    {
      const int tt = tidf >> 3, jg = tidf & 7, wq = (tt >> 5) * 4, tl = tt & 31;
#pragma unroll
      for (int i = 0; i < 4; ++i) {
        const int j = jg * 4 + i;
        impf[tt * 32 + j] = (imps[((wq + 0) * 32 + tl) * 33 + j] + imps[((wq + 1) * 32 + tl) * 33 + j]) + (imps[((wq + 2) * 32 + tl) * 33 + j] + imps[((wq + 3) * 32 + tl) * 33 + j]);
      }
    }
    __syncthreads();
    {
      const int tt = tidf >> 3, jg = tidf & 7;
      float v[32];
#pragma unroll
      for (int j = 0; j < 32; ++j) {
        float x = impf[tt * 32 + j];
        if (j > cur) x = -1e30f; else if (j == 0 || j == cur || j == cur - 1) x = 1e6f;
        v[j] = x;
      }
      unsigned bits = 0u;
#pragma unroll
      for (int i = 0; i < 4; ++i) {
        int rank = 0; float vj = 0.f;
#pragma unroll
        for (int j = 0; j < 32; ++j) if (j == jg * 4 + i) vj = v[j];
        const int jj = jg * 4 + i;
#pragma unroll
        for (int j = 0; j < 32; ++j) rank += (v[j] > vj || (v[j] == vj && j < jj)) ? 1 : 0;
        if (rank < 8 && jj <= cur) bits |= 1u << jj;
      }
      bits |= shx(bits, 1); bits |= shx(bits, 2); bits |= shx(bits, 4);
      if (jg == 0) { smask[tt] = bits; atomicOr(s_union, bits); }
    }
    __syncthreads();
    {
      const unsigned mymask = smask[32 * qs + l31];
      unsigned rem = *s_union;
      const bf16_t* Ks = p.KV() + (size_t)(2 * NB + b) * T * 64;
      const bf16_t* Vs = p.KV() + (size_t)(3 * NB + b) * 64 * T;
      f32x16 o[2]; o[0] = zero16(); o[1] = zero16();
      float m = -1e30f, l = 0.f;
      int j = __builtin_ctz(rem); rem &= rem - 1;
      { const AdTile r = ad_load(Ks, Vs, j * 64, tidf); ad_store(r, kvbuf, tidf); }
      __syncthreads();
      int pb = 0;
      for (;;) {
        const bool more = rem != 0u;
        const int jn = more ? __builtin_ctz(rem) : 0;
        AdTile nx;
        if (more) nx = ad_load(Ks, Vs, jn * 64, tidf);
        const char* buf = kvbuf + pb * AD_BUF;
        const bool sel = (mymask >> j) & 1u;
#pragma unroll
        for (int kh = 0; kh < 2; ++kh) {
          const int key0 = j * 64 + kh * 32;
          if (key0 <= qw + 31) {
            f32x16 s = qk_tile_s((const bf16_t*)buf + kh * 32 * AD_KSTR, AD_KSTR, qf, l31, h2);
#pragma unroll
            for (int r = 0; r < 16; ++r) { const int key = key0 + crow(r, h2); if (!sel || key > t) s[r] = -INFINITY; }
            softmax_pv(s, (const bf16_t*)(buf + 64 * AD_KSTR * 2) + kh * 32, AD_VSTR, o, m, l, l31, h2);
          }
        }
        if (more) ad_store(nx, kvbuf + (pb ^ 1) * AD_BUF, tidf);
        __syncthreads();
        if (!more) break;
        rem &= rem - 1; j = jn; pb ^= 1;
      }
      const float il = l > 0.f ? g1 / l : 0.f;
#pragma unroll
      for (int dt = 0; dt < 2; ++dt)
#pragma unroll
        for (int r = 0; r < 16; ++r) ofin[dt][r] += il * o[dt][r];
    }
    {
      const bf16_t* Kw = p.KV() + (size_t)(4 * NB + b) * T * 64;
      const bf16_t* Vw = p.KV() + (size_t)(5 * NB + b) * 64 * T;
      f32x16 o[2]; o[0] = zero16(); o[1] = zero16();
      float m = -1e30f, l = 0.f;
      int k0 = max(0, q0 - 512);
      { const AdTile r = ad_load(Kw, Vw, k0, tidf); ad_store(r, kvbuf, tidf); }
      __syncthreads();
      int pb = 0;
      for (;;) {
        const bool more = k0 + 64 <= q0;
        AdTile nx;
        if (more) nx = ad_load(Kw, Vw, k0 + 64, tidf);
        const char* buf = kvbuf + pb * AD_BUF;
#pragma unroll
        for (int kh = 0; kh < 2; ++kh) {
          const int key0 = k0 + kh * 32;
          if (key0 <= qw + 31 && key0 + 31 + 512 > qw) {
            f32x16 s = qk_tile_s((const bf16_t*)buf + kh * 32 * AD_KSTR, AD_KSTR, qf, l31, h2);
            if (key0 + 31 > qw || key0 + 512 <= qw + 31) {
#pragma unroll
              for (int r = 0; r < 16; ++r) { const int key = key0 + crow(r, h2); if (key > t || t - key >= 512) s[r] = -INFINITY; }
            }
            softmax_pv(s, (const bf16_t*)(buf + 64 * AD_KSTR * 2) + kh * 32, AD_VSTR, o, m, l, l31, h2);
          }
        }
        if (more) ad_store(nx, kvbuf + (pb ^ 1) * AD_BUF, tidf);
        __syncthreads();
        if (!more) break;
        k0 += 64; pb ^= 1;
      }
      const float il = l > 0.f ? g2 / l : 0.f;
#pragma unroll
      for (int dt = 0; dt < 2; ++dt)
#pragma unroll
        for (int r = 0; r < 16; ++r) ofin[dt][r] += il * o[dt][r];
    }
#pragma unroll
    for (int dt = 0; dt < 2; ++dt)
#pragma unroll
      for (int g = 0; g < 4; ++g) {
        const int d0 = dt * 32 + 8 * g + 4 * h2;
        const u32x2 gz = *(const u32x2*)(p.GZ() + (size_t)4 * NTOK * 256 + tok * 256 + h * 64 + d0);
        const float z0 = __uint_as_float(gz.x << 16), z1 = __uint_as_float(gz.x & 0xffff0000u), z2 = __uint_as_float(gz.y << 16), z3 = __uint_as_float(gz.y & 0xffff0000u);
        u32x2 o2 = {pack2(ofin[dt][4 * g] * z0, ofin[dt][4 * g + 1] * z1), pack2(ofin[dt][4 * g + 2] * z2, ofin[dt][4 * g + 3] * z3)};
        *(u32x2*)(p.YMIX() + tok * 1024 + 768 + h * 64 + d0) = o2;
      }
  }
}


struct AaTile { u32x4 k0, v0, k1, v1; };
DI AaTile aa_load(const bf16_t* Kg, const bf16_t* Vg, int key0, int tidf) {
  AaTile r; const int row = tidf >> 3, ch = tidf & 7;
  r.k0 = *(const u32x4*)(Kg + (size_t)(key0 + row) * 64 + ch * 8);
  r.v0 = *(const u32x4*)(Vg + (size_t)row * T + key0 + ch * 8);
  r.k1 = *(const u32x4*)(Kg + (size_t)T * 64 + (size_t)(key0 + row) * 64 + ch * 8);
  r.v1 = *(const u32x4*)(Vg + (size_t)T * 64 + (size_t)row * T + key0 + ch * 8);
  return r;
}
DI void aa_store(const AaTile& r, char* buf, int tidf) {
  AdTile a; a.k = r.k0; a.v = r.v0; ad_store(a, buf, tidf);
  a.k = r.k1; a.v = r.v1; ad_store(a, buf + AD_BUF, tidf);
}
DI void ph_attnA_fb(const Params& p, int layer, int item, char* smem) {
  int tidf = threadIdx.x; asm volatile("" : "+v"(tidf));
  const int lane = tidf & 63, wid = tidf >> 6, h = wid & 3, qs = wid >> 2, l31 = lane & 31, h2 = lane >> 5, g = h >> 1;
  const int b = item >> 5, q0 = (item & 31) * 64;
  const int qw = q0 + 32 * qs, t = qw + l31;
  const size_t tok = (size_t)b * T + t;
  bf16x8 qf[4];
  {
    const bf16_t* qp = p.QA() + ((size_t)(b * 4 + h) * T + t) * 64 + h2 * 8;
#pragma unroll
    for (int ks = 0; ks < 4; ++ks) qf[ks] = *(const bf16x8*)(qp + ks * 16);
  }
  const bf16_t* Kg = p.KA() + (size_t)(b * 2) * T * 64;
  const bf16_t* Vg = p.VAT() + (size_t)(b * 2) * 64 * T;
  f32x16 o[2]; o[0] = zero16(); o[1] = zero16();
  float m = -1e30f, l = 0.f;
  int k0 = max(0, q0 - 128);
  __syncthreads();
  { const AaTile r = aa_load(Kg, Vg, k0, tidf); aa_store(r, smem, tidf); }
  __syncthreads();
  int pb = 0;
  for (;;) {
    const bool more = k0 + 64 <= q0;
    AaTile nx;
    if (more) nx = aa_load(Kg, Vg, k0 + 64, tidf);
    const char* buf = smem + pb * (2 * AD_BUF) + g * AD_BUF;
#pragma unroll
    for (int kh = 0; kh < 2; ++kh) {
      const int key0 = k0 + kh * 32;
      if (key0 <= qw + 31 && key0 + 31 + 128 > qw) {
        f32x16 s = qk_tile_s((const bf16_t*)buf + kh * 32 * AD_KSTR, AD_KSTR, qf, l31, h2);
        if (key0 + 31 > qw || key0 + 128 <= qw + 31) {
#pragma unroll
          for (int r = 0; r < 16; ++r) { const int key = key0 + crow(r, h2); if (key > t || t - key >= 128) s[r] = -INFINITY; }
        }
        softmax_pv(s, (const bf16_t*)(buf + 64 * AD_KSTR * 2) + kh * 32, AD_VSTR, o, m, l, l31, h2);
      }
    }
    if (more) aa_store(nx, smem + (pb ^ 1) * (2 * AD_BUF), tidf);
    __syncthreads();
    if (!more) break;
    k0 += 64; pb ^= 1;
  }
  const float sink = p.a_sinks[layer * 4 + h] * 1.4426950408889634f;
  const float M = fmaxf(m, sink);
  const float sc = __builtin_amdgcn_exp2f(m - M);
  const float inv = sc / (l * sc + __builtin_amdgcn_exp2f(sink - M));
#pragma unroll
  for (int dt = 0; dt < 2; ++dt)
#pragma unroll
    for (int gq = 0; gq < 4; ++gq) {
      const int d0 = dt * 32 + 8 * gq + 4 * h2;
      const u32x2 gz = *(const u32x2*)(p.GZ() + tok * 256 + h * 64 + d0);
      const float z0 = __uint_as_float(gz.x << 16), z1 = __uint_as_float(gz.x & 0xffff0000u), z2 = __uint_as_float(gz.y << 16), z3 = __uint_as_float(gz.y & 0xffff0000u);
      u32x2 o2 = {pack2(o[dt][4 * gq] * inv * z0, o[dt][4 * gq + 1] * inv * z1), pack2(o[dt][4 * gq + 2] * inv * z2, o[dt][4 * gq + 3] * inv * z3)};
      *(u32x2*)(p.YMIX() + tok * 1024 + h * 64 + d0) = o2;
    }
}

DI float logsigmoidf_(float x) { return fminf(x, 0.f) - __logf(1.f + __expf(-fabsf(x))); }
DI void mlstm_gates(const Params& p, size_t tok0, int hh, float* bc, float* ig, int tid) {
  if (tid < 64) {
    const int s0 = 2 * tid;
    const float lf0 = logsigmoidf_(p.IFG()[(tok0 + s0) * 8 + 4 + hh]), lf1 = logsigmoidf_(p.IFG()[(tok0 + s0 + 1) * 8 + 4 + hh]);
    const float pair = lf0 + lf1;
    float x = pair;
#pragma unroll
    for (int off = 1; off < 64; off <<= 1) { const float y = shup(x, off); if (tid >= off) x += y; }
    const float excl = x - pair;
    bc[s0] = excl + lf0; bc[s0 + 1] = excl + pair;
    ig[s0] = p.IFG()[(tok0 + s0) * 8 + hh]; ig[s0 + 1] = p.IFG()[(tok0 + s0 + 1) * 8 + hh];
  }
}
DI void conv8(const bf16_t* raw, int t, int dg, const float (&cw)[4][8], const float (&cb)[8], float (&out)[8]) {
#pragma unroll
  for (int e = 0; e < 8; ++e) out[e] = cb[e];
#pragma unroll
  for (int j = 0; j < 4; ++j) {
    const int ts = t - 3 + j;
    if (ts >= 0) {
      const u32x4 row = *(const u32x4*)(raw + (size_t)ts * 64 + dg * 8);
#pragma unroll
      for (int e2 = 0; e2 < 4; ++e2) { out[2 * e2] += cw[j][2 * e2] * __uint_as_float(row[e2] << 16); out[2 * e2 + 1] += cw[j][2 * e2 + 1] * __uint_as_float(row[e2] & 0xffff0000u); }
    }
  }
#pragma unroll
  for (int e = 0; e < 8; ++e) out[e] = siluf_(out[e]);
}
DI void conv_rows_load(const bf16_t* raw, int tfirst, int dg, u32x4 (&r)[7]) {
#pragma unroll
  for (int j = 0; j < 7; ++j) {
    const int ts = tfirst + j;
    const u32x4 v = *(const u32x4*)(raw + (size_t)max(ts, 0) * 64 + dg * 8);
    r[j] = ts >= 0 ? v : (u32x4){0u, 0u, 0u, 0u};
  }
}
template <int I>
DI void conv_rows_compute(const u32x4 (&r)[7], const float (&cw)[4][8], const float (&cb)[8], float (&out)[8]) {
#pragma unroll
  for (int e = 0; e < 8; ++e) out[e] = cb[e];
#pragma unroll
  for (int j = 0; j < 4; ++j) {
    const u32x4 row = r[I + j];
#pragma unroll
    for (int e2 = 0; e2 < 4; ++e2) { out[2 * e2] += cw[j][2 * e2] * __uint_as_float(row[e2] << 16); out[2 * e2 + 1] += cw[j][2 * e2 + 1] * __uint_as_float(row[e2] & 0xffff0000u); }
  }
#pragma unroll
  for (int e = 0; e < 8; ++e) out[e] = siluf_(out[e]);
}
DI void load_conv_w(const Params& p, int layer, int ch0, int dg, float (&cw)[4][8], float (&cb)[8]) {
#pragma unroll
  for (int j = 0; j < 4; ++j)
#pragma unroll
    for (int e = 0; e < 8; ++e) cw[j][e] = p.conv_w[layer * 2048 + j * 512 + ch0 + dg * 8 + e];
#pragma unroll
  for (int e = 0; e < 8; ++e) cb[e] = p.conv_b[layer * 512 + ch0 + dg * 8 + e];
}
DI void delta_state_loadA(const bf16_t* VT, bf16x8 (&a)[8], int wid, int l31, int h2) {
  const int mt = wid >> 1;
#pragma unroll
  for (int ks = 0; ks < 8; ++ks) a[ks] = *(const bf16x8*)(VT + (size_t)(mt * 32 + l31) * T + ks * 16 + h2 * 8);
}
DI void delta_state(const bf16x8 (&a)[8], const bf16_t* KT, float* out, int wid, int l31, int h2) {
  const int mt = wid >> 1, nt = wid & 1;
  f32x16 acc = zero16();
#pragma unroll
  for (int ks = 0; ks < 8; ++ks) {
    const bf16x8 bb = *(const bf16x8*)(KT + (nt * 32 + l31) * 136 + ks * 16 + h2 * 8);
    acc = MFMA32(a[ks], bb, acc);
  }
#pragma unroll
  for (int r = 0; r < 16; ++r) out[(mt * 32 + crow(r, h2)) * 64 + nt * 32 + l31] = acc[r];
}
DI void ph_mlstm_local(const Params& p, int layer, int item, char* smem) {
  float* bc = (float*)smem; float* ig = bc + 128; float* wv = ig + 128;
  bf16_t* KwT = (bf16_t*)(smem + 2048);
  float* nred = (float*)(smem + 2048 + 64 * 136 * 2);
  const int tid = tid_opaque(), lane = tid & 63, wid = tid >> 6, l31 = lane & 31, h2 = lane >> 5;
  const int b = item >> 6, hh = (item >> 4) & 3, c = item & 15, t0 = c * 128;
  const size_t tok0 = (size_t)b * T + t0;
  const int dg = tid & 7, sb = tid >> 3;
  u32x4 rows[7];
  conv_rows_load(p.QKB() + ((size_t)(b * 8 + 4 + hh) * T) * 64, t0 + 4 * sb - 3, dg, rows);
  bf16x8 af[8];
  delta_state_loadA(p.VBT() + (size_t)(b * 4 + hh) * 64 * T + t0, af, wid, l31, h2);
  float cw[4][8], cb[8];
  load_conv_w(p, layer, 256 + hh * 64, dg, cw, cb);
  __syncthreads();
  mlstm_gates(p, tok0, hh, bc, ig, tid);
  __syncthreads();
  if (tid < 128) wv[tid] = __expf(bc[127] - bc[tid] + ig[tid]);
  __syncthreads();
  {
    float v0[8], v1[8], v2[8], v3[8];
    conv_rows_compute<0>(rows, cw, cb, v0); conv_rows_compute<1>(rows, cw, cb, v1);
    conv_rows_compute<2>(rows, cw, cb, v2); conv_rows_compute<3>(rows, cw, cb, v3);
    const f32x4 w4 = *(const f32x4*)(wv + 4 * sb);
#pragma unroll
    for (int e = 0; e < 8; ++e) {
      u32x2 pk = {pack2(v0[e] * w4[0], v1[e] * w4[1]), pack2(v2[e] * w4[2], v3[e] * w4[3])};
      *(u32x2*)(KwT + (dg * 8 + e) * 136 + 4 * sb) = pk;
    }
  }
  __syncthreads();
  delta_state(af, KwT, p.BST() + (size_t)item * 4096, wid, l31, h2);
  {
    const int k = tid & 63, qd = tid >> 6;
    float a = 0.f;
#pragma unroll 8
    for (int s = 0; s < 32; ++s) a += bf2f(KwT[k * 136 + qd * 32 + s]);
    nred[qd * 64 + k] = a;
  }
  __syncthreads();
  if (tid < 64) p.BN()[(size_t)item * 64 + tid] = (nred[tid] + nred[64 + tid]) + (nred[128 + tid] + nred[192 + tid]);
  if (tid == 0) p.BG()[item] = bc[127];
}
DI void ph_mlstm_scan(const Params& p, int bh) {
  const int tid = tid_opaque();
  f32x4 C[4];
#pragma unroll
  for (int i = 0; i < 4; ++i) C[i] = (f32x4){0.f, 0.f, 0.f, 0.f};
  float n = 0.f;
  for (int c = 0; c < 16; ++c) {
    const int item = bh * 16 + c;
    const float g = __expf(p.BG()[item]);
    f32x4* ptr = (f32x4*)(p.BST() + (size_t)item * 4096 + tid * 16);
#pragma unroll
    for (int i = 0; i < 4; ++i) { const f32x4 tmp = ptr[i]; ptr[i] = C[i]; C[i] = g * C[i] + tmp; }
    if (tid < 64) { const float tmp = p.BN()[(size_t)item * 64 + tid]; p.BN()[(size_t)item * 64 + tid] = n; n = g * n + tmp; }
  }
}
DI void pv_only(const f32x16& s, const bf16_t* VTp, int vstride, f32x16 (&o)[2], int l31, int h2) {
  const bf16x8 p0 = pack8<0>(s), p1 = pack8<8>(s);
#pragma unroll
  for (int dt = 0; dt < 2; ++dt) {
    const bf16_t* vp = VTp + (size_t)(dt * 32 + l31) * vstride + 4 * h2;
    o[dt] = MFMA32(ld_frag8x2(vp), p0, o[dt]);
    o[dt] = MFMA32(ld_frag8x2(vp + 16), p1, o[dt]);
  }
}
DI bf16x8 frag_from_f32(const float* ptr) {
  const f32x4 a = *(const f32x4*)ptr, b = *(const f32x4*)(ptr + 4);
  u32x4 t = {pack2(a[0], a[1]), pack2(a[2], a[3]), pack2(b[0], b[1]), pack2(b[2], b[3])};
  return __builtin_bit_cast(bf16x8, t);
}
DI void ph_mlstm_out(const Params& p, int layer, int item, char* smem) {
  float* bc = (float*)smem; float* ig = bc + 128;
  bf16_t* qc = (bf16_t*)(smem + 2048);
  bf16_t* kc = qc + 128 * 72;
  const int tid = tid_opaque(), lane = tid & 63, wid = tid >> 6, l31 = lane & 31, h2 = lane >> 5;
  const int b = item >> 6, hh = (item >> 4) & 3, c = item & 15, t0 = c * 128;
  const size_t tok0 = (size_t)b * T + t0;
  const int dg = tid & 7, sb = tid >> 3;
  u32x4 rq[7], rk[7];
  conv_rows_load(p.QKB() + ((size_t)(b * 8 + hh) * T) * 64, t0 + 4 * sb - 3, dg, rq);
  conv_rows_load(p.QKB() + ((size_t)(b * 8 + 4 + hh) * T) * 64, t0 + 4 * sb - 3, dg, rk);
  __syncthreads();
  mlstm_gates(p, tok0, hh, bc, ig, tid);
  {
    float cw[4][8], cb[8];
    load_conv_w(p, layer, hh * 64, dg, cw, cb);
    float v[8];
#define CONV_ST(I, R, DST, SC) do { conv_rows_compute<I>(R, cw, cb, v); \
      u32x4 w_ = {pack2(v[0] * (SC), v[1] * (SC)), pack2(v[2] * (SC), v[3] * (SC)), pack2(v[4] * (SC), v[5] * (SC)), pack2(v[6] * (SC), v[7] * (SC))}; \
      *(u32x4*)((DST) + (4 * sb + (I)) * 72 + dg * 8) = w_; } while (0)
    CONV_ST(0, rq, qc, 0.125f); CONV_ST(1, rq, qc, 0.125f); CONV_ST(2, rq, qc, 0.125f); CONV_ST(3, rq, qc, 0.125f);
    load_conv_w(p, layer, 256 + hh * 64, dg, cw, cb);
    CONV_ST(0, rk, kc, 1.f); CONV_ST(1, rk, kc, 1.f); CONV_ST(2, rk, kc, 1.f); CONV_ST(3, rk, kc, 1.f);
#undef CONV_ST
  }
  const int tq = 32 * wid + l31;
  const float* Cs = p.BST() + (size_t)item * 4096;
  const float* ns = p.BN() + (size_t)item * 64;
  f32x4 cst[2][4][2], nst[4][2];
#pragma unroll
  for (int ks = 0; ks < 4; ++ks) {
#pragma unroll
    for (int dt = 0; dt < 2; ++dt) { cst[dt][ks][0] = *(const f32x4*)(Cs + (dt * 32 + l31) * 64 + ks * 16 + h2 * 8); cst[dt][ks][1] = *(const f32x4*)(Cs + (dt * 32 + l31) * 64 + ks * 16 + h2 * 8 + 4); }
    nst[ks][0] = *(const f32x4*)(ns + ks * 16 + h2 * 8); nst[ks][1] = *(const f32x4*)(ns + ks * 16 + h2 * 8 + 4);
  }
  u32x2 gz1[2][4], gz2[2][4];
#pragma unroll
  for (int dt = 0; dt < 2; ++dt)
#pragma unroll
    for (int g = 0; g < 4; ++g) {
      const int d0 = dt * 32 + 8 * g + 4 * h2;
      gz1[dt][g] = *(const u32x2*)(p.GZ() + (size_t)1 * NTOK * 256 + (tok0 + tq) * 256 + hh * 64 + d0);
      gz2[dt][g] = *(const u32x2*)(p.GZ() + (size_t)2 * NTOK * 256 + (tok0 + tq) * 256 + hh * 64 + d0);
    }
  __syncthreads();
  if (tid < 128) ig[tid] = ig[tid] - bc[tid];
  __syncthreads();
  bf16x8 qf[4];
#pragma unroll
  for (int ks = 0; ks < 4; ++ks) qf[ks] = *(const bf16x8*)(qc + tq * 72 + ks * 16 + h2 * 8);
  const float bt = bc[tq];
  f32x16 o[2]; o[0] = zero16(); o[1] = zero16();
  float dsum = 0.f;
  const bf16_t* VT = p.VBT() + (size_t)(b * 4 + hh) * 64 * T + t0;
  for (int kt = 0; kt <= wid; ++kt) {
    f32x16 s = qk_tile_s(kc + kt * 32 * 72, 72, qf, l31, h2);
#pragma unroll
    for (int r = 0; r < 16; ++r) {
      const int sidx = 32 * kt + crow(r, h2);
      float val = s[r] * __expf(bt + ig[sidx]);
      if (sidx > tq) val = 0.f;
      s[r] = val; dsum += val;
    }
    pv_only(s, VT + kt * 32, T, o, l31, h2);
  }
  dsum += shx(dsum, 32);
  f32x16 oi[2]; oi[0] = zero16(); oi[1] = zero16();
  float qn = 0.f;
#pragma unroll
  for (int ks = 0; ks < 4; ++ks) {
#pragma unroll
    for (int dt = 0; dt < 2; ++dt) {
      const f32x4 a_ = cst[dt][ks][0], b_ = cst[dt][ks][1];
      u32x4 t_ = {pack2(a_[0], a_[1]), pack2(a_[2], a_[3]), pack2(b_[0], b_[1]), pack2(b_[2], b_[3])};
      oi[dt] = MFMA32(__builtin_bit_cast(bf16x8, t_), qf[ks], oi[dt]);
    }
    const u32x4 qu = __builtin_bit_cast(u32x4, qf[ks]);
    const f32x4 n0 = nst[ks][0], n1 = nst[ks][1];
    qn += __uint_as_float(qu[0] << 16) * n0[0] + __uint_as_float(qu[0] & 0xffff0000u) * n0[1] + __uint_as_float(qu[1] << 16) * n0[2] + __uint_as_float(qu[1] & 0xffff0000u) * n0[3];
    qn += __uint_as_float(qu[2] << 16) * n1[0] + __uint_as_float(qu[2] & 0xffff0000u) * n1[1] + __uint_as_float(qu[3] << 16) * n1[2] + __uint_as_float(qu[3] & 0xffff0000u) * n1[3];
  }
  qn += shx(qn, 32);
  const float ebt = __expf(bt);
  const float den = dsum + ebt * qn;
  const float inv = 1.f / fmaxf(fabsf(den), 1.f);
  const size_t tok = tok0 + tq;
#pragma unroll
  for (int dt = 0; dt < 2; ++dt)
#pragma unroll
    for (int g = 0; g < 4; ++g) {
      const int d0 = dt * 32 + 8 * g + 4 * h2;
      const u32x2 g1 = gz1[dt][g], g2 = gz2[dt][g];
      float z[4] = {__uint_as_float(g1.x << 16) * __uint_as_float(g2.x << 16), __uint_as_float(g1.x & 0xffff0000u) * __uint_as_float(g2.x & 0xffff0000u),
                    __uint_as_float(g1.y << 16) * __uint_as_float(g2.y << 16), __uint_as_float(g1.y & 0xffff0000u) * __uint_as_float(g2.y & 0xffff0000u)};
      float hv[4];
#pragma unroll
      for (int i = 0; i < 4; ++i) hv[i] = (o[dt][4 * g + i] + ebt * oi[dt][4 * g + i]) * inv * z[i];
      u32x2 o2 = {pack2(hv[0], hv[1]), pack2(hv[2], hv[3])};
      *(u32x2*)(p.YMIX() + tok * 1024 + 256 + hh * 64 + d0) = o2;
    }
}


DI void ph_hgrn_local(const Params& p, int layer, int item, char* smem) {
  float* tot = (float*)smem;
  bf16_t* KdT = (bf16_t*)(smem + 1024);
  const int tid = tid_opaque(), lane = tid & 63, wid = tid >> 6, l31 = lane & 31, h2 = lane >> 5;
  const int b = item >> 6, hh = (item >> 4) & 3, c = item & 15, t0 = c * 128;
  const int k = tid & 63, qd = tid >> 6;
  float al[32], kk[32];
  bf16x8 af[8];
  delta_state_loadA(p.VCT() + (size_t)(b * 4 + hh) * 64 * T + t0, af, wid, l31, h2);
  {
    const float* gp = p.GC() + ((size_t)(b * 4 + hh) * T + t0 + 32 * qd) * 64 + k;
    float run = 0.f;
#pragma unroll
    for (int s = 0; s < 32; ++s) { const float g = gp[s * 64]; run += g; al[s] = run; kk[s] = 1.f - __expf(g); }
    __syncthreads();
    tot[qd * 64 + k] = run;
  }
  __syncthreads();
  float off = 0.f, aL = 0.f;
#pragma unroll
  for (int q = 0; q < 4; ++q) { const float v = tot[q * 64 + k]; aL += v; if (q < qd) off += v; }
#pragma unroll
  for (int s8 = 0; s8 < 4; ++s8) {
    float v[8];
#pragma unroll
    for (int e = 0; e < 8; ++e) v[e] = kk[s8 * 8 + e] * __expf(aL - (al[s8 * 8 + e] + off));
    u32x4 w = {pack2(v[0], v[1]), pack2(v[2], v[3]), pack2(v[4], v[5]), pack2(v[6], v[7])};
    *(u32x4*)(KdT + k * 136 + qd * 32 + s8 * 8) = w;
  }
  __syncthreads();
  delta_state(af, KdT, p.CST() + (size_t)item * 4096, wid, l31, h2);
  if (qd == 0) p.CAL()[(size_t)item * 64 + k] = aL;
}
DI void ph_hgrn_scan(const Params& p, int bh) {
  const int tid = tid_opaque();
  f32x4 S[4];
#pragma unroll
  for (int i = 0; i < 4; ++i) S[i] = (f32x4){0.f, 0.f, 0.f, 0.f};
  for (int c = 0; c < 16; ++c) {
    const int item = bh * 16 + c;
    const f32x4* dp = (const f32x4*)(p.CAL() + (size_t)item * 64 + (tid & 3) * 16);
    f32x4* ptr = (f32x4*)(p.CST() + (size_t)item * 4096 + tid * 16);
#pragma unroll
    for (int i = 0; i < 4; ++i) {
      const f32x4 a = dp[i];
      const f32x4 dec = {__expf(a[0]), __expf(a[1]), __expf(a[2]), __expf(a[3])};
      const f32x4 tmp = ptr[i]; ptr[i] = S[i]; S[i] = dec * S[i] + tmp;
    }
  }
}
DI void ph_hgrn_out(const Params& p, int layer, int item, char* smem) {
  float* a_lds = (float*)smem;
  float* tot = (float*)(smem + 128 * 68 * 4);
  bf16_t* kk_lds = (bf16_t*)(smem + 128 * 68 * 4 + 1024);
  const int tid = tid_opaque(), lane = tid & 63, wid = tid >> 6, l31 = lane & 31, h2 = lane >> 5;
  const int b = item >> 6, hh = (item >> 4) & 3, c = item & 15, t0 = c * 128;
  const size_t hbase = (size_t)(b * 4 + hh) * T + t0;
  const int tq = 32 * wid + l31;
  const size_t tok = (size_t)b * T + t0 + tq;
  u32x4 qu[4];
#pragma unroll
  for (int ks = 0; ks < 4; ++ks) qu[ks] = *(const u32x4*)(p.QC() + (hbase + tq) * 64 + ks * 16 + h2 * 8);
  u32x2 gzv[2][4];
#pragma unroll
  for (int dt = 0; dt < 2; ++dt)
#pragma unroll
    for (int g = 0; g < 4; ++g) gzv[dt][g] = *(const u32x2*)(p.GZ() + (size_t)3 * NTOK * 256 + tok * 256 + hh * 64 + dt * 32 + 8 * g + 4 * h2);
  {
    const int k = tid & 63, qd = tid >> 6;
    float al[32];
    const float* gp = p.GC() + (hbase + 32 * qd) * 64 + k;
    float run = 0.f;
    __syncthreads();
#pragma unroll
    for (int s = 0; s < 32; ++s) { const float g = gp[s * 64]; run += g; al[s] = run; kk_lds[(32 * qd + s) * 72 + k] = f2bf(1.f - __expf(g)); }
    tot[qd * 64 + k] = run;
    __syncthreads();
    float off = 0.f;
#pragma unroll
    for (int q = 0; q < 4; ++q) { const float v = tot[q * 64 + k]; if (q < qd) off += v; }
#pragma unroll
    for (int s = 0; s < 32; ++s) a_lds[(32 * qd + s) * 68 + k] = al[s] + off;
  }
  const float* Ss = p.CST() + (size_t)item * 4096;
  f32x4 cst[2][4][2];
#pragma unroll
  for (int ks = 0; ks < 4; ++ks)
#pragma unroll
    for (int dt = 0; dt < 2; ++dt) { cst[dt][ks][0] = *(const f32x4*)(Ss + (dt * 32 + l31) * 64 + ks * 16 + h2 * 8); cst[dt][ks][1] = *(const f32x4*)(Ss + (dt * 32 + l31) * 64 + ks * 16 + h2 * 8 + 4); }
  __syncthreads();
  bf16x8 qi[4], qh[4];
#pragma unroll
  for (int ks = 0; ks < 4; ++ks) {
    const int k0 = ks * 16 + h2 * 8;
    float q8[8], e1[8], e2[8];
#pragma unroll
    for (int e2i = 0; e2i < 4; ++e2i) { q8[2 * e2i] = __uint_as_float(qu[ks][e2i] << 16); q8[2 * e2i + 1] = __uint_as_float(qu[ks][e2i] & 0xffff0000u); }
#pragma unroll
    for (int e = 0; e < 8; ++e) {
      const float a = a_lds[tq * 68 + k0 + e];
      const float r = wid > 0 ? a_lds[(32 * wid - 1) * 68 + k0 + e] : 0.f;
      e1[e] = q8[e] * __expf(a - r); e2[e] = q8[e] * __expf(a);
    }
    u32x4 w1 = {pack2(e1[0], e1[1]), pack2(e1[2], e1[3]), pack2(e1[4], e1[5]), pack2(e1[6], e1[7])};
    u32x4 w2 = {pack2(e2[0], e2[1]), pack2(e2[2], e2[3]), pack2(e2[4], e2[5]), pack2(e2[6], e2[7])};
    qi[ks] = __builtin_bit_cast(bf16x8, w1); qh[ks] = __builtin_bit_cast(bf16x8, w2);
  }
  f32x16 o[2]; o[0] = zero16(); o[1] = zero16();
  const bf16_t* VT = p.VCT() + (size_t)(b * 4 + hh) * 64 * T + t0;
  for (int kt = 0; kt <= wid; ++kt) {
    f32x16 s = zero16();
    const int srow = 32 * kt + l31;
#pragma unroll
    for (int ks = 0; ks < 4; ++ks) {
      const int k0 = ks * 16 + h2 * 8;
      const u32x4 ku = *(const u32x4*)(kk_lds + srow * 72 + k0);
      float v[8];
#pragma unroll
      for (int e = 0; e < 8; ++e) {
        const float a = a_lds[srow * 68 + k0 + e];
        const float r = wid > 0 ? a_lds[(32 * wid - 1) * 68 + k0 + e] : 0.f;
        const float kkv = (e & 1) ? __uint_as_float(ku[e >> 1] & 0xffff0000u) : __uint_as_float(ku[e >> 1] << 16);
        v[e] = kkv * __expf(fminf(r - a, 80.f));
      }
      u32x4 w = {pack2(v[0], v[1]), pack2(v[2], v[3]), pack2(v[4], v[5]), pack2(v[6], v[7])};
      s = MFMA32(__builtin_bit_cast(bf16x8, w), qi[ks], s);
    }
    if (kt == wid) {
#pragma unroll
      for (int r = 0; r < 16; ++r) if (32 * kt + crow(r, h2) > tq) s[r] = 0.f;
    }
    pv_only(s, VT + kt * 32, T, o, l31, h2);
  }
#pragma unroll
  for (int ks = 0; ks < 4; ++ks)
#pragma unroll
    for (int dt = 0; dt < 2; ++dt) {
      const f32x4 a_ = cst[dt][ks][0], b_ = cst[dt][ks][1];
      u32x4 t_ = {pack2(a_[0], a_[1]), pack2(a_[2], a_[3]), pack2(b_[0], b_[1]), pack2(b_[2], b_[3])};
      o[dt] = MFMA32(__builtin_bit_cast(bf16x8, t_), qh[ks], o[dt]);
    }
  float ss = 0.f;
#pragma unroll
  for (int dt = 0; dt < 2; ++dt)
#pragma unroll
    for (int r = 0; r < 16; ++r) ss += o[dt][r] * o[dt][r];
  ss += shx(ss, 32);
  const float rs = rsqrtf(ss * (1.f / 64.f) + 1e-6f);
#pragma unroll
  for (int dt = 0; dt < 2; ++dt)
#pragma unroll
    for (int g = 0; g < 4; ++g) {
      const int d0 = dt * 32 + 8 * g + 4 * h2;
      const u32x2 gz = gzv[dt][g];
      const f32x4 gn = *(const f32x4*)(p.c_norm_g + layer * 256 + hh * 64 + d0);
      const float z0 = __uint_as_float(gz.x << 16), z1 = __uint_as_float(gz.x & 0xffff0000u), z2 = __uint_as_float(gz.y << 16), z3 = __uint_as_float(gz.y & 0xffff0000u);
      u32x2 o2 = {pack2(o[dt][4 * g] * rs * gn[0] * z0, o[dt][4 * g + 1] * rs * gn[1] * z1), pack2(o[dt][4 * g + 2] * rs * gn[2] * z2, o[dt][4 * g + 3] * rs * gn[3] * z3)};
      *(u32x2*)(p.YMIX() + tok * 1024 + 512 + hh * 64 + d0) = o2;
    }
}


DI void ph_attnA(const Params& p, int layer, int item, char* smem) {
  const int tid = tid_opaque(), lane = tid & 63, h = tid >> 6, l31 = lane & 31, h2 = lane >> 5;
  const int b = item >> 6, q0 = (item & 63) * 32, g = h >> 1;
  const int t = q0 + l31;
  const size_t tok = (size_t)b * T + t;
  bf16x8 qf[4];
  {
    const bf16_t* qp = p.QA() + ((size_t)(b * 4 + h) * T + t) * 64 + h2 * 8;
#pragma unroll
    for (int ks = 0; ks < 4; ++ks) qf[ks] = *(const bf16x8*)(qp + ks * 16);
  }
  const bf16_t* Kp = p.KA() + (size_t)(b * 2 + g) * T * 64;
  const bf16_t* Vp = p.VAT() + (size_t)(b * 2 + g) * 64 * T;
  f32x16 o[2]; o[0] = zero16(); o[1] = zero16();
  float m = -1e30f, l = 0.f;
  for (int key0 = max(0, q0 - 128); key0 <= q0; key0 += 32) {
    f32x16 s = qk_tile(Kp + (size_t)key0 * 64, qf, l31, h2);
    if (key0 == q0 - 128 || key0 == q0) {
#pragma unroll
      for (int r = 0; r < 16; ++r) { const int key = key0 + crow(r, h2); if (key > t || t - key >= 128) s[r] = -INFINITY; }
    }
    softmax_pv(s, Vp + key0, T, o, m, l, l31, h2);
  }
  const float sink = p.a_sinks[layer * 4 + h] * 1.4426950408889634f;
  const float M = fmaxf(m, sink);
  const float sc = __builtin_amdgcn_exp2f(m - M);
  const float inv = sc / (l * sc + __builtin_amdgcn_exp2f(sink - M));
#pragma unroll
  for (int dt = 0; dt < 2; ++dt)
#pragma unroll
    for (int gq = 0; gq < 4; ++gq) {
      const int d0 = dt * 32 + 8 * gq + 4 * h2;
      const u32x2 gz = *(const u32x2*)(p.GZ() + tok * 256 + h * 64 + d0);
      const float z0 = __uint_as_float(gz.x << 16), z1 = __uint_as_float(gz.x & 0xffff0000u), z2 = __uint_as_float(gz.y << 16), z3 = __uint_as_float(gz.y & 0xffff0000u);
      u32x2 o2 = {pack2(o[dt][4 * gq] * inv * z0, o[dt][4 * gq + 1] * inv * z1), pack2(o[dt][4 * gq + 2] * inv * z2, o[dt][4 * gq + 3] * inv * z3)};
      *(u32x2*)(p.YMIX() + tok * 1024 + h * 64 + d0) = o2;
    }
}

DI void ph_cmp(const Params& p, int layer, int item, char* smem) {
  float* red = (float*)smem;
  bf16_t* hid = (bf16_t*)(smem + 32768);
  const int tid = tid_opaque(), lane = tid & 63, wid = tid >> 6, l31 = lane & 31, h2 = lane >> 5;
  const int b = item >> 3, kvsel = (item >> 2) & 1, mt = item & 3;
  const int lk = layer * 2 + kvsel;
  const int n = min(mt * 32 + l31, 126);
  const bf16_t* src = p.KV() + ((size_t)(kvsel * NB + b) * T + 16 * n) * 64 + wid * 512 + h2 * 8;
  const bf16_t* w1t = p.W1T() + (size_t)lk * 64 * 2048 + wid * 512 + h2 * 8;
  f32x16 acc[2]; acc[0] = zero16(); acc[1] = zero16();
#pragma unroll 4
  for (int ks = 0; ks < 32; ++ks) {
    const bf16x8 a = *(const bf16x8*)(src + ks * 16);
    const bf16x8 b0 = *(const bf16x8*)(w1t + (size_t)l31 * 2048 + ks * 16);
    const bf16x8 b1 = *(const bf16x8*)(w1t + (size_t)(32 + l31) * 2048 + ks * 16);
    acc[0] = MFMA32(a, b0, acc[0]); acc[1] = MFMA32(a, b1, acc[1]);
  }
  __syncthreads();
#pragma unroll
  for (int nt = 0; nt < 2; ++nt)
#pragma unroll
    for (int r = 0; r < 16; ++r) red[(wid * 32 + crow(r, h2)) * 64 + nt * 32 + l31] = acc[nt][r];
  __syncthreads();
  {
    const int row = tid >> 3, c0 = (tid & 7) * 8;
    float v[8];
#pragma unroll
    for (int e = 0; e < 8; ++e) {
      const float x = (red[(0 * 32 + row) * 64 + c0 + e] + red[(1 * 32 + row) * 64 + c0 + e]) + (red[(2 * 32 + row) * 64 + c0 + e] + red[(3 * 32 + row) * 64 + c0 + e]) + p.CVEC()[lk * 64 + c0 + e];
      v[e] = siluf_(x);
    }
    u32x4 w = {pack2(v[0], v[1]), pack2(v[2], v[3]), pack2(v[4], v[5]), pack2(v[6], v[7])};
    *(u32x4*)(hid + row * 72 + c0) = w;
  }
  __syncthreads();
  if (wid == 0) {
    f32x16 o[2]; o[0] = zero16(); o[1] = zero16();
    const bf16_t* w2t = p.W2T() + (size_t)lk * 4096;
#pragma unroll
    for (int ks = 0; ks < 4; ++ks) {
      const bf16x8 a = *(const bf16x8*)(hid + l31 * 72 + ks * 16 + h2 * 8);
#pragma unroll
      for (int nt = 0; nt < 2; ++nt) o[nt] = MFMA32(a, *(const bf16x8*)(w2t + (nt * 32 + l31) * 64 + ks * 16 + h2 * 8), o[nt]);
    }
    if (kvsel == 0) {
#pragma unroll
      for (int r = 0; r < 16; ++r) {
        const int nn = mt * 32 + crow(r, h2);
        if (nn < 127) {
          const int pos = 16 * nn + 31;
          const float cs = p.ROPEC()[pos * 32 + l31], sn = p.ROPES()[pos * 32 + l31];
          p.KCMP()[((size_t)b * 128 + nn) * 64 + l31] = f2bf(o[0][r] * cs - o[1][r] * sn);
          p.KCMP()[((size_t)b * 128 + nn) * 64 + 32 + l31] = f2bf(o[0][r] * sn + o[1][r] * cs);
        }
      }
    } else {
#pragma unroll
      for (int nt = 0; nt < 2; ++nt)
#pragma unroll
        for (int r = 0; r < 16; ++r) {
          const int nn = mt * 32 + crow(r, h2);
          if (nn < 127) p.VCMPT()[((size_t)b * 64 + nt * 32 + l31) * 128 + nn] = f2bf(o[nt][r]);
        }
    }
  }
}


#define XB_TMO      128
#define XB_XCNT(j)  (256  + 64 * (j))
#define XB_XSUB(j)  (1280 + 64 * (j))
#define XB_XGEN(j)  (2304 + 64 * (j))
#define XB_TOP      3328
#define XB_TOPGEN   3392
#define XCD_BAR_WORDS 3456
#define XB_SPIN_CAP (1u << 22)
DI unsigned xb_ld(unsigned* p)              { return __hip_atomic_load(p, __ATOMIC_RELAXED, __HIP_MEMORY_SCOPE_AGENT); }
DI unsigned xb_add(unsigned* p, unsigned v) { return __hip_atomic_fetch_add(p, v, __ATOMIC_RELAXED, __HIP_MEMORY_SCOPE_AGENT); }
DI unsigned xb_xcc_id() { return (unsigned)__builtin_amdgcn_s_getreg((3 << 11) | 20) & 0xFu; }
#define XB_SPIN(cond, bar) do { unsigned _sp = 0; while (cond) { __builtin_amdgcn_s_sleep(1); \
    if ((++_sp & 255u) == 0u) { if (xb_ld(&(bar)[XB_TMO])) break; if (_sp > XB_SPIN_CAP) { atomicAdd(&(bar)[XB_TMO], 1u); break; } } } } while (0)
struct XcdBarrier { unsigned* bar; unsigned x; volatile LAS unsigned* st; };
DI XcdBarrier xcd_barrier_post(unsigned* bar, volatile LAS unsigned* st) {
  XcdBarrier b; b.bar = bar; b.x = xb_xcc_id(); b.st = st;
  if (threadIdx.x == 0) (void)xb_add(&bar[XB_XCNT(b.x)], 1u);
  return b;
}
DI void xcd_barrier_complete(unsigned* bar, unsigned x, unsigned& nloc, unsigned& nx) {
  const unsigned G = gridDim.x * gridDim.y * gridDim.z;
  unsigned sum, cnt, mine, sp = 0u;
  for (;;) {
    sum = 0u; cnt = 0u; mine = 0u;
#pragma unroll
    for (unsigned j = 0; j < 16; ++j) { const unsigned c = xb_ld(&bar[XB_XCNT(j)]); sum += c; cnt += (c > 0u) ? 1u : 0u; mine = (j == x) ? c : mine; }
    if (sum == G) break;
    __builtin_amdgcn_s_sleep(1);
    if ((++sp & 255u) == 0u) { if (xb_ld(&bar[XB_TMO])) break; if (sp > XB_SPIN_CAP) { atomicAdd(&bar[XB_TMO], 1u); break; } }
  }
  nloc = mine > 0u ? mine : 1u; nx = cnt > 0u ? cnt : 1u;
}
DI void xcd_barrier(const XcdBarrier& b) {
  asm volatile("s_waitcnt vmcnt(0)" ::: "memory");
  __syncthreads();
  int t0_ = threadIdx.x; asm volatile("" : "+v"(t0_));
  if (t0_ == 0) {
    unsigned* bar = b.bar;
    __builtin_amdgcn_s_waitcnt(0);
    unsigned nloc = b.st[0], nx = b.st[1];
    if (nloc == 0u) { xcd_barrier_complete(bar, b.x, nloc, nx); b.st[0] = nloc; b.st[1] = nx; }
    const unsigned old = xb_add(&bar[XB_XSUB(b.x)], 1u);
    const unsigned gen = old / nloc;
    if (old + 1u == (gen + 1u) * nloc) {
      __builtin_amdgcn_fence(__ATOMIC_RELEASE, "agent");
      asm volatile("s_waitcnt vmcnt(0)" ::: "memory");
      const unsigned og = xb_add(&bar[XB_TOP], 1u);
      const unsigned tg = og / nx;
      if (og + 1u == (tg + 1u) * nx) xb_add(&bar[XB_TOPGEN], 1u);
      else XB_SPIN(xb_ld(&bar[XB_TOPGEN]) == tg, bar);
      __builtin_amdgcn_fence(__ATOMIC_ACQUIRE, "agent");
      xb_add(&bar[XB_XGEN(b.x)], 1u);
      asm volatile("s_waitcnt vmcnt(0)" ::: "memory");
    } else {
      XB_SPIN(xb_ld(&bar[XB_XGEN(b.x)]) == gen, bar);
      __builtin_amdgcn_fence(__ATOMIC_ACQUIRE, "agent");
      asm volatile("s_waitcnt vmcnt(0)" ::: "memory");
    }
  }
  __syncthreads();
}

constexpr int HALF_LDS = 65536;
__global__ void __launch_bounds__(512) mega(Params p) {
  __shared__ __attribute__((aligned(16))) char smem_all[131072 + 32];
  cg::grid_group grid = cg::this_grid();
  const int half = half_id();
  const int bid = blockIdx.x, nblk = gridDim.x;
  const int vbid = 2 * bid + half, nvblk = 2 * nblk;
  char* smem = smem_all + half * HALF_LDS;
  unsigned* xbw = (unsigned*)(smem_all + 131072);
  int* s_pair = (int*)(smem_all + 131072 + 16);
  if (threadIdx.x == 0) { xbw[0] = 0u; xbw[1] = 0u; }
  __syncthreads();
  const XcdBarrier xb = xcd_barrier_post(p.XBAR(), (volatile LAS unsigned*)xbw);
  ph_prologue(p, vbid, nvblk, smem);
  ln_rows(p, 0, 0, vbid, nvblk);
  if (PROBE == 5) { ph_prologue(p, vbid, nvblk, smem); ln_rows(p, 0, 0, vbid, nvblk); }
  grid.sync();
  for (int l = 0; l < 2; ++l) {
    ph_gemm_in(p, l, bid, nblk, smem_all);
    if (PROBE == 1) ph_gemm_in(p, l, bid, nblk, smem_all);
    xcd_barrier(xb);
    for (int rep = 0; rep < (PROBE == 3 ? 2 : 1); ++rep) {
    for (int item = vbid; item < 2048; item += nvblk) ph_mlstm_local(p, l, item, smem);
    for (int item = vbid; item < 2048; item += nvblk) ph_hgrn_local(p, l, item, smem);
    __syncthreads();
    for (int item = vbid; item < 256; item += nvblk) ph_cmp(p, l, item, smem);
    __syncthreads();
    for (int item = bid; item < 1024; item += nblk) ph_attnA_fb(p, l, item, smem_all);
    }
    xcd_barrier(xb);
    if (vbid < 128) ph_mlstm_scan(p, vbid);
    else if (vbid < 256) ph_hgrn_scan(p, vbid - 128);
    __syncthreads();
    ph_attnD(p, l, p.CTR() + l, smem_all, s_pair);
    if (PROBE == 2) ph_attnD(p, l, p.CTR() + 2 + l, smem_all, s_pair);
    xcd_barrier(xb);
    for (int rep = 0; rep < (PROBE == 4 ? 2 : 1); ++rep) {
    for (int item = vbid; item < 2048; item += nvblk) ph_mlstm_out(p, l, item, smem);
    for (int item = vbid; item < 2048; item += nvblk) ph_hgrn_out(p, l, item, smem);
    }
    xcd_barrier(xb);
    ph_gemm_out_ln(p, l, bid, nblk, smem_all);
    if (l == 0) xcd_barrier(xb);
  }
}

static inline size_t align_up(size_t v) { return (v + 255) & ~(size_t)255; }

extern "C" void kernel_launch(void* const* d_in, const int* in_sizes, int n_in, void* d_out, int out_size, void* d_ws, size_t ws_size, hipStream_t stream) {
  Params p{};
  p.x = (const float*)d_in[0]; p.ln0_g = (const float*)d_in[1]; p.ln0_b = (const float*)d_in[2]; p.w_in = (const float*)d_in[3];
  p.b_in = (const float*)d_in[4]; p.a_sinks = (const float*)d_in[5]; p.conv_w = (const float*)d_in[6]; p.conv_b = (const float*)d_in[7];
  p.c_lb = (const float*)d_in[8]; p.c_norm_g = (const float*)d_in[9]; p.pe = (const float*)d_in[10]; p.w1 = (const float*)d_in[11];
  p.w2 = (const float*)d_in[12]; p.w_out = (const float*)d_in[13]; p.ln_g = (const float*)d_in[14]; p.ln_b = (const float*)d_in[15];
  p.hf = (float*)d_out;
  p.ws = (char*)d_ws;
  if (WS_TOTAL > ws_size) { fprintf(stderr, "workspace too small: need %zu have %zu\n", (size_t)WS_TOTAL, ws_size); return; }

  static int grid_blocks = 0;
  if (!grid_blocks) {
    int dev = 0, cus = 0, per_cu = 0;
    (void)hipGetDevice(&dev);
    (void)hipDeviceGetAttribute(&cus, hipDeviceAttributeMultiprocessorCount, dev);
    (void)hipOccupancyMaxActiveBlocksPerMultiprocessor(&per_cu, mega, 512, 0);
    if (per_cu > 1) per_cu = 1;
    grid_blocks = cus * per_cu;
  }
  (void)hipMemsetAsync((char*)d_ws + OFF_XBAR, 0, XCD_BAR_WORDS * 4, stream);
  (void)hipMemsetAsync((char*)d_ws + OFF_CVEC, 0, SZ_CVEC, stream);
  void* args[] = {&p};
  hipError_t e = hipLaunchCooperativeKernel((void*)mega, dim3(grid_blocks), dim3(512), args, 0, stream);
  if (e != hipSuccess) fprintf(stderr, "cooperative launch failed: %s (grid %d)\n", hipGetErrorString(e), grid_blocks);
}
```

```cpp
#include <hip/hip_runtime.h>
#include <hip/hip_cooperative_groups.h>
#include <stdio.h>
#include <stdint.h>
#include <stddef.h>

#ifndef PROBE
#define PROBE 0
#endif
#define DI __device__ __forceinline__
typedef unsigned short bf16_t;
typedef short bf16x8 __attribute__((ext_vector_type(8)));
typedef float f32x16 __attribute__((ext_vector_type(16)));
typedef unsigned u32x4 __attribute__((ext_vector_type(4)));
typedef float f32x4 __attribute__((ext_vector_type(4)));

constexpr int NB = 32, T = 2048, DM = 1024, NTOK = NB * T, NP = 4096;
constexpr float DN_ALPHA = 1.41421356237309515f;

constexpr size_t OFF_HB = 0;
constexpr size_t SZ_HB = (size_t)NTOK * 1024 * 2;
constexpr size_t OFF_YMIX = OFF_HB + ((SZ_HB + 255) & ~(size_t)255);
constexpr size_t SZ_YMIX = (size_t)NTOK * 1024 * 2;
constexpr size_t OFF_QA = OFF_YMIX + ((SZ_YMIX + 255) & ~(size_t)255);
constexpr size_t SZ_QA = (size_t)NTOK * 256 * 2;
constexpr size_t OFF_KA = OFF_QA + ((SZ_QA + 255) & ~(size_t)255);
constexpr size_t SZ_KA = (size_t)NTOK * 128 * 2;
constexpr size_t OFF_VAT = OFF_KA + ((SZ_KA + 255) & ~(size_t)255);
constexpr size_t SZ_VAT = (size_t)NTOK * 128 * 2;
constexpr size_t OFF_QKB = OFF_VAT + ((SZ_VAT + 255) & ~(size_t)255);
constexpr size_t SZ_QKB = (size_t)NTOK * 512 * 2;
constexpr size_t OFF_VBT = OFF_QKB + ((SZ_QKB + 255) & ~(size_t)255);
constexpr size_t SZ_VBT = (size_t)NTOK * 256 * 2;
constexpr size_t OFF_QC = OFF_VBT + ((SZ_VBT + 255) & ~(size_t)255);
constexpr size_t SZ_QC = (size_t)NTOK * 256 * 2;
constexpr size_t OFF_GC = OFF_QC + ((SZ_QC + 255) & ~(size_t)255);
constexpr size_t SZ_GC = (size_t)NTOK * 256 * 4;
constexpr size_t OFF_VCT = OFF_GC + ((SZ_GC + 255) & ~(size_t)255);
constexpr size_t SZ_VCT = (size_t)NTOK * 256 * 2;
constexpr size_t OFF_QD = OFF_VCT + ((SZ_VCT + 255) & ~(size_t)255);
constexpr size_t SZ_QD = (size_t)NTOK * 256 * 2;
constexpr size_t OFF_KV = OFF_QD + ((SZ_QD + 255) & ~(size_t)255);
constexpr size_t SZ_KV = (size_t)NTOK * 384 * 2;
constexpr size_t OFF_GZ = OFF_KV + ((SZ_KV + 255) & ~(size_t)255);
constexpr size_t SZ_GZ = (size_t)NTOK * 1280 * 2;
constexpr size_t OFF_IFG = OFF_GZ + ((SZ_GZ + 255) & ~(size_t)255);
constexpr size_t SZ_IFG = (size_t)NTOK * 8 * 4;
constexpr size_t OFF_DG = OFF_IFG + ((SZ_IFG + 255) & ~(size_t)255);
constexpr size_t SZ_DG = (size_t)NTOK * 12 * 4;
constexpr size_t OFF_WT = OFF_DG + ((SZ_DG + 255) & ~(size_t)255);
constexpr size_t SZ_WT = (size_t)2 * NP * 1024 * 2;
constexpr size_t OFF_WOT = OFF_WT + ((SZ_WT + 255) & ~(size_t)255);
constexpr size_t SZ_WOT = (size_t)2 * 1024 * 1024 * 2;
constexpr size_t OFF_KCMP = OFF_WOT + ((SZ_WOT + 255) & ~(size_t)255);
constexpr size_t SZ_KCMP = (size_t)NB * 128 * 64 * 2;
constexpr size_t OFF_VCMPT = OFF_KCMP + ((SZ_KCMP + 255) & ~(size_t)255);
constexpr size_t SZ_VCMPT = (size_t)NB * 64 * 128 * 2;
constexpr size_t OFF_BIASP = OFF_VCMPT + ((SZ_VCMPT + 255) & ~(size_t)255);
constexpr size_t SZ_BIASP = (size_t)2 * NP * 4;
constexpr size_t OFF_LB = OFF_BIASP + ((SZ_BIASP + 255) & ~(size_t)255);
constexpr size_t SZ_LB = (size_t)512 * 4;
constexpr size_t OFF_ROPEC = OFF_LB + ((SZ_LB + 255) & ~(size_t)255);
constexpr size_t SZ_ROPEC = (size_t)T * 32 * 4;
constexpr size_t OFF_ROPES = OFF_ROPEC + ((SZ_ROPEC + 255) & ~(size_t)255);
constexpr size_t SZ_ROPES = (size_t)T * 32 * 4;
constexpr size_t OFF_BST = OFF_ROPES + ((SZ_ROPES + 255) & ~(size_t)255);
constexpr size_t SZ_BST = (size_t)2048 * 4096 * 4;
constexpr size_t OFF_BN = OFF_BST + ((SZ_BST + 255) & ~(size_t)255);
constexpr size_t SZ_BN = (size_t)2048 * 64 * 4;
constexpr size_t OFF_BG = OFF_BN + ((SZ_BN + 255) & ~(size_t)255);
constexpr size_t SZ_BG = (size_t)2048 * 4;
constexpr size_t OFF_CST = OFF_BG + ((SZ_BG + 255) & ~(size_t)255);
constexpr size_t SZ_CST = (size_t)2048 * 4096 * 4;
constexpr size_t OFF_CAL = OFF_CST + ((SZ_CST + 255) & ~(size_t)255);
constexpr size_t SZ_CAL = (size_t)2048 * 64 * 4;
constexpr size_t OFF_W1T = OFF_CAL + ((SZ_CAL + 255) & ~(size_t)255);
constexpr size_t SZ_W1T = (size_t)4 * 64 * 2048 * 2;
constexpr size_t OFF_W2T = OFF_W1T + ((SZ_W1T + 255) & ~(size_t)255);
constexpr size_t SZ_W2T = (size_t)4 * 64 * 64 * 2;
constexpr size_t OFF_CVEC = OFF_W2T + ((SZ_W2T + 255) & ~(size_t)255);
constexpr size_t SZ_CVEC = (size_t)256 * 4;
constexpr size_t OFF_CTR = OFF_CVEC + ((SZ_CVEC + 255) & ~(size_t)255);
constexpr size_t SZ_CTR = (size_t)256;
constexpr size_t OFF_XBAR = OFF_CTR + ((SZ_CTR + 255) & ~(size_t)255);
constexpr size_t SZ_XBAR = (size_t)3456 * 4;
constexpr size_t OFF_LNS = OFF_XBAR + ((SZ_XBAR + 255) & ~(size_t)255);
constexpr size_t SZ_LNS = (size_t)NTOK * 2 * 4;
constexpr size_t WS_TOTAL = OFF_LNS + ((SZ_LNS + 255) & ~(size_t)255);
struct Params {
  const float *x, *ln0_g, *ln0_b, *w_in, *b_in, *a_sinks, *conv_w, *conv_b, *c_lb, *c_norm_g, *pe, *w1, *w2, *w_out, *ln_g, *ln_b;
  float* hf;
  char* ws;
  DI bf16_t* HB() const { return (bf16_t*)(ws + OFF_HB); }
  DI bf16_t* YMIX() const { return (bf16_t*)(ws + OFF_YMIX); }
  DI bf16_t* QA() const { return (bf16_t*)(ws + OFF_QA); }
  DI bf16_t* KA() const { return (bf16_t*)(ws + OFF_KA); }
  DI bf16_t* VAT() const { return (bf16_t*)(ws + OFF_VAT); }
  DI bf16_t* QKB() const { return (bf16_t*)(ws + OFF_QKB); }
  DI bf16_t* VBT() const { return (bf16_t*)(ws + OFF_VBT); }
  DI bf16_t* QC() const { return (bf16_t*)(ws + OFF_QC); }
  DI float* GC() const { return (float*)(ws + OFF_GC); }
  DI bf16_t* VCT() const { return (bf16_t*)(ws + OFF_VCT); }
  DI bf16_t* QD() const { return (bf16_t*)(ws + OFF_QD); }
  DI bf16_t* KV() const { return (bf16_t*)(ws + OFF_KV); }
  DI bf16_t* GZ() const { return (bf16_t*)(ws + OFF_GZ); }
  DI float* IFG() const { return (float*)(ws + OFF_IFG); }
  DI float* DG() const { return (float*)(ws + OFF_DG); }
  DI bf16_t* WT() const { return (bf16_t*)(ws + OFF_WT); }
  DI bf16_t* WOT() const { return (bf16_t*)(ws + OFF_WOT); }
  DI bf16_t* KCMP() const { return (bf16_t*)(ws + OFF_KCMP); }
  DI bf16_t* VCMPT() const { return (bf16_t*)(ws + OFF_VCMPT); }
  DI float* BIASP() const { return (float*)(ws + OFF_BIASP); }
  DI float* LB() const { return (float*)(ws + OFF_LB); }
  DI float* ROPEC() const { return (float*)(ws + OFF_ROPEC); }
  DI float* ROPES() const { return (float*)(ws + OFF_ROPES); }
  DI float* BST() const { return (float*)(ws + OFF_BST); }
  DI float* BN() const { return (float*)(ws + OFF_BN); }
  DI float* BG() const { return (float*)(ws + OFF_BG); }
  DI float* CST() const { return (float*)(ws + OFF_CST); }
  DI float* CAL() const { return (float*)(ws + OFF_CAL); }
  DI bf16_t* W1T() const { return (bf16_t*)(ws + OFF_W1T); }
  DI bf16_t* W2T() const { return (bf16_t*)(ws + OFF_W2T); }
  DI float* CVEC() const { return (float*)(ws + OFF_CVEC); }
  DI int* CTR() const { return (int*)(ws + OFF_CTR); }
  DI unsigned* XBAR() const { return (unsigned*)(ws + OFF_XBAR); }
  DI float* LNS() const { return (float*)(ws + OFF_LNS); }
};
namespace cg = cooperative_groups;

DI int tid_opaque() { int t = threadIdx.x; asm volatile("" : "+v"(t)); return t & 255; }
DI int half_id() { return __builtin_amdgcn_readfirstlane((int)(threadIdx.x >> 8)); }
DI float bf2f(bf16_t v) { return __uint_as_float(((unsigned)v) << 16); }
DI bf16_t f2bf(float x) { unsigned u = __float_as_uint(x); u += 0x7fffu + ((u >> 16) & 1u); return (bf16_t)(u >> 16); }
DI float sigmoidf_(float x) { return __builtin_amdgcn_rcpf(1.f + __builtin_amdgcn_exp2f(-1.4426950408889634f * x)); }
DI float siluf_(float x) { return x * __builtin_amdgcn_rcpf(1.f + __builtin_amdgcn_exp2f(-1.4426950408889634f * x)); }
DI int lane_op() { int l = threadIdx.x; asm volatile("" : "+v"(l)); return l & 63; }
DI float shx(float v, int m) { return __builtin_bit_cast(float, __builtin_amdgcn_ds_bpermute((lane_op() ^ m) << 2, __builtin_bit_cast(int, v))); }
DI unsigned shx(unsigned v, int m) { return (unsigned)__builtin_amdgcn_ds_bpermute((lane_op() ^ m) << 2, (int)v); }
DI float shup(float v, int d) { const int l = lane_op(); const int s = l - d; return __builtin_bit_cast(float, __builtin_amdgcn_ds_bpermute((s < 0 ? l : s) << 2, __builtin_bit_cast(int, v))); }
DI float xhalf_max(float x) { int a = __builtin_bit_cast(int, x), b = a; asm volatile("" : "+v"(b)); auto r = __builtin_amdgcn_permlane32_swap(a, b, false, false); return fmaxf(__builtin_bit_cast(float, (int)r[0]), __builtin_bit_cast(float, (int)r[1])); }
DI float xhalf_sum(float x) { int a = __builtin_bit_cast(int, x), b = a; asm volatile("" : "+v"(b)); auto r = __builtin_amdgcn_permlane32_swap(a, b, false, false); return __builtin_bit_cast(float, (int)r[0]) + __builtin_bit_cast(float, (int)r[1]); }
DI float wave_sum(float v) { for (int o = 32; o > 0; o >>= 1) v += shx(v, o); return v; }
DI float wave_max(float v) { for (int o = 32; o > 0; o >>= 1) v = fmaxf(v, shx(v, o)); return v; }

DI int orig_col(int n) {
  if (n < 1536) return n;
  if (n < 3712) return n + 8;
  if (n < 3968) return n + 20;
  if (n < 3976) return 1536 + (n - 3968);
  if (n < 3988) return 3720 + (n - 3976);
  return -1;
}

DI bool head_is_paired(int hd);
DI void ph_prologue(const Params& p, int bid, int nblk, char* smem) {
  const long gtid = (long)bid * 256 + tid_opaque(), gsz = (long)nblk * 256;
  if (gtid < 64) p.CTR()[gtid] = 0;
  for (long idx = gtid; idx < 2L * 128 * NP; idx += gsz) {
    const int n = (int)(idx % NP), k8 = (int)((idx / NP) % 128), l = (int)(idx / (NP * 128));
    const int pp = n & 63, w_ = pp >> 5, rr = pp & 31, n_ = rr >> 4, fq_ = (rr >> 2) & 3, j_ = rr & 3;
    const int lc = head_is_paired(n >> 6) ? (32 * n_ + 16 * w_ + 4 * fq_ + j_) : (32 * w_ + 8 * fq_ + 4 * n_ + j_);
    const int oc = orig_col((n & ~63) + lc);
    unsigned w[4];
    for (int j = 0; j < 4; ++j) {
      float a = 0.f, b = 0.f;
      if (oc >= 0) { a = p.w_in[((size_t)l * 1024 + k8 * 8 + 2 * j) * 3988 + oc]; b = p.w_in[((size_t)l * 1024 + k8 * 8 + 2 * j + 1) * 3988 + oc]; }
      w[j] = (unsigned)f2bf(a) | ((unsigned)f2bf(b) << 16);
    }
    *(uint4*)(p.WT() + ((size_t)l * NP + n) * 1024 + k8 * 8) = make_uint4(w[0], w[1], w[2], w[3]);
  }
  for (long idx = gtid; idx < 2L * 128 * 1024; idx += gsz) {
    const int d = (int)(idx % 1024), m8 = (int)((idx / 1024) % 128), l = (int)(idx / (1024 * 128));
    unsigned w[4];
    for (int j = 0; j < 4; ++j) {
      float a = p.w_out[((size_t)l * 1024 + m8 * 8 + 2 * j) * 1024 + d], b = p.w_out[((size_t)l * 1024 + m8 * 8 + 2 * j + 1) * 1024 + d];
      w[j] = (unsigned)f2bf(a) | ((unsigned)f2bf(b) << 16);
    }
    *(uint4*)(p.WOT() + ((size_t)l * 1024 + d) * 1024 + m8 * 8) = make_uint4(w[0], w[1], w[2], w[3]);
  }
  for (long idx = gtid; idx < 4L * 256 * 64; idx += gsz) {
    const int j = (int)(idx % 64), i8 = (int)((idx / 64) % 256), lk = (int)(idx / (64 * 256));
    unsigned w[4];
    for (int e = 0; e < 4; ++e) {
      const float a = p.w1[((size_t)lk * 2048 + i8 * 8 + 2 * e) * 64 + j], b = p.w1[((size_t)lk * 2048 + i8 * 8 + 2 * e + 1) * 64 + j];
      w[e] = (unsigned)f2bf(a) | ((unsigned)f2bf(b) << 16);
    }
    *(uint4*)(p.W1T() + ((size_t)lk * 64 + j) * 2048 + i8 * 8) = make_uint4(w[0], w[1], w[2], w[3]);
  }
  for (long idx = gtid; idx < 4L * 64 * 64; idx += gsz) {
    const int jo = (int)(idx % 64), ji = (int)((idx / 64) % 64), lk = (int)(idx / 4096);
    p.W2T()[((size_t)lk * 64 + jo) * 64 + ji] = f2bf(p.w2[((size_t)lk * 64 + ji) * 64 + jo]);
  }
  if (bid < 64) {
    const int lk = bid >> 4, seg = bid & 15, j = tid_opaque() & 63, part = tid_opaque() >> 6;
    float a = 0.f;
    const int i0 = seg * 128 + part * 32;
#pragma unroll 8
    for (int i = i0; i < i0 + 32; ++i) a += p.pe[(size_t)lk * 2048 + i] * p.w1[((size_t)lk * 2048 + i) * 64 + j];
    float* red = (float*)smem;
    __syncthreads();
    red[part * 64 + j] = a;
    __syncthreads();
    if (part == 0) atomicAdd(p.CVEC() + lk * 64 + j, (red[j] + red[64 + j]) + (red[128 + j] + red[192 + j]));
    __syncthreads();
  }
  for (long idx = gtid; idx < 2L * NP; idx += gsz) {
    const int n = (int)(idx % NP), l = (int)(idx / NP); const int oc = orig_col(n);
    p.BIASP()[idx] = oc >= 0 ? p.b_in[l * 3988 + oc] : 0.f;
  }
  for (long idx = gtid; idx < (long)T * 32; idx += gsz) {
    const int t = (int)(idx / 32), i = (int)(idx % 32);
    const float inv = exp2f(-(float)i * (13.287712379549449f / 32.0f));
    const float ang = (float)t * inv;
    p.ROPEC()[idx] = cosf(ang); p.ROPES()[idx] = sinf(ang);
  }
  for (long idx = gtid; idx < 512; idx += gsz) {
    const int c = (int)(idx % 256), l = (int)(idx / 256);
    const float a = p.c_lb[c], b = p.c_lb[256 + c];
    const float m = fmaxf(a, b); const float ea = expf(a - m), eb = expf(b - m);
    p.LB()[idx] = l == 0 ? 0.f : eb / (ea + eb);
  }
}

DI void ln_rows(const Params& p, int mode, int layer, int bid, int nblk) {
  const int tid_ = tid_opaque(); const int lane = tid_ & 63, wid = tid_ >> 6, nw = 4;
  const float* g = mode == 0 ? p.ln0_g : p.ln_g + layer * 1024;
  const float* bb = mode == 0 ? p.ln0_b : p.ln_b + layer * 1024;
  const float* src = mode == 0 ? p.x : p.hf;
  for (int row = bid * nw + wid; row < NTOK; row += nblk * nw) {
    const float* s = src + (size_t)row * 1024;
    float4 v[4];
    float sum = 0.f;
#pragma unroll
    for (int i = 0; i < 4; ++i) { v[i] = *(const float4*)(s + i * 256 + lane * 4); sum += (v[i].x + v[i].y) + (v[i].z + v[i].w); }
    sum = wave_sum(sum);
    const float mu = sum * (1.f / 1024.f);
    float q = 0.f;
#pragma unroll
    for (int i = 0; i < 4; ++i) { float a = v[i].x - mu, b = v[i].y - mu, c = v[i].z - mu, d = v[i].w - mu; q += (a * a + b * b) + (c * c + d * d); }
    q = wave_sum(q);
    const float rs = rsqrtf(q * (1.f / 1024.f) + 1e-5f);
    if (mode == 0 && lane == 0) { p.LNS()[(size_t)row * 2] = mu; p.LNS()[(size_t)row * 2 + 1] = rs; }
#pragma unroll
    for (int i = 0; i < 4; ++i) {
      const int c0 = i * 256 + lane * 4;
      const float4 gg = *(const float4*)(g + c0), b4 = *(const float4*)(bb + c0);
      float4 o;
      o.x = (v[i].x - mu) * rs * gg.x + b4.x; o.y = (v[i].y - mu) * rs * gg.y + b4.y;
      o.z = (v[i].z - mu) * rs * gg.z + b4.z; o.w = (v[i].w - mu) * rs * gg.w + b4.w;
      if (mode != 0) *(float4*)(p.hf + (size_t)row * 1024 + c0) = o;
      uint2 pk; pk.x = (unsigned)f2bf(o.x) | ((unsigned)f2bf(o.y) << 16); pk.y = (unsigned)f2bf(o.z) | ((unsigned)f2bf(o.w) << 16);
      *(uint2*)(p.HB() + (size_t)row * 1024 + c0) = pk;
    }
  }
}

typedef float f32x2 __attribute__((ext_vector_type(2)));
typedef __bf16 bf16v2 __attribute__((ext_vector_type(2)));
typedef unsigned u32x2 __attribute__((ext_vector_type(2)));
DI unsigned pack2(float a, float b) { f32x2 v = {a, b}; return __builtin_bit_cast(unsigned, __builtin_convertvector(v, bf16v2)); }
DI f32x16 zero16() { f32x16 z;
#pragma unroll
  for (int i = 0; i < 16; ++i) z[i] = 0.f; return z; }
DI bf16x8 ld_frag8x2(const bf16_t* p) { const u32x2 lo = *(const u32x2*)p, hi = *(const u32x2*)(p + 8); u32x4 t = {lo.x, lo.y, hi.x, hi.y}; return __builtin_bit_cast(bf16x8, t); }
template <int BASE> DI bf16x8 pack8(const f32x16& s) {
  u32x4 t = {pack2(s[BASE + 0], s[BASE + 1]), pack2(s[BASE + 2], s[BASE + 3]), pack2(s[BASE + 4], s[BASE + 5]), pack2(s[BASE + 6], s[BASE + 7])};
  return __builtin_bit_cast(bf16x8, t);
}
DI int crow(int r, int h2) { return (r & 3) + 8 * (r >> 2) + 4 * h2; }
#define MFMA32(a, b, c) __builtin_amdgcn_mfma_f32_32x32x16_bf16((a), (b), (c), 0, 0, 0)
#define LAS __attribute__((address_space(3)))
enum { K_NONE = 0, K_ROPE, K_PLAIN, K_TR, K_GSILU, K_GSIG, K_SILUH, K_LOGF, K_SMALL };
namespace g8 {
constexpr int BK = 64, HALF = 128, HT = HALF * BK;
DI int lds_byte(int r, int c) { const int st = (r >> 4) * 2 + (c >> 5), rr = r & 15, cc = c & 31, ob = rr * 64 + cc * 2; return st * 1024 + (ob ^ (((ob >> 9) & 1) << 5)); }
DI void stage_rc(int b, int& R, int& C) { const int st = b / 1024, sb = b % 1024, swz = sb ^ (((sb >> 9) & 1) << 5); R = (st >> 1) * 16 + swz / 64; C = (st & 1) * 32 + (swz % 64) / 2; }
}
DI void gemm256_mainloop(const bf16_t* A, const bf16_t* Bt, bf16_t* shm, f32x4 (&acc)[2][2][4][2]) {
  using namespace g8;
  constexpr int K = 1024;
#define SA(b, h) (shm + ((b) * 2 + (h)) * HT)
#define SB(b, h) (shm + (4 + (b) * 2 + (h)) * HT)
#define STAGE(P, BASE, br, kt) do { const long g_ = (long)(br) * K + (long)(kt) * BK; \
    _Pragma("unroll") for (int i_ = 0; i_ < 2; ++i_) { const int b_ = tidf * 16 + i_ * 8192; int r_, c_; stage_rc(b_, r_, c_); \
      __builtin_amdgcn_global_load_lds((const unsigned*)((BASE) + g_ + (long)r_ * K + c_), (LAS unsigned*)((char*)(P) + b_), 16, 0, 0); } } while (0)
#define LDA(dst, b, h) _Pragma("unroll") for (int m = 0; m < 4; ++m) _Pragma("unroll") for (int k = 0; k < 2; ++k) \
    dst[m][k] = *reinterpret_cast<const bf16x8*>((const char*)SA(b, h) + lds_byte(wr * 64 + m * 16 + fr, k * 32 + fq * 8))
#define LDB(dst, b, h) _Pragma("unroll") for (int n = 0; n < 2; ++n) _Pragma("unroll") for (int k = 0; k < 2; ++k) \
    dst[n][k] = *reinterpret_cast<const bf16x8*>((const char*)SB(b, h) + lds_byte(wc * 32 + n * 16 + fr, k * 32 + fq * 8))
#define MMA(ai, bj, At_, Bt_) do { __builtin_amdgcn_s_setprio(1); \
    _Pragma("unroll") for (int m = 0; m < 4; ++m) _Pragma("unroll") for (int n = 0; n < 2; ++n) _Pragma("unroll") for (int k = 0; k < 2; ++k) \
      acc[ai][bj][m][n] = __builtin_amdgcn_mfma_f32_16x16x32_bf16(Bt_[n][k], At_[m][k], acc[ai][bj][m][n], 0, 0, 0); \
    __builtin_amdgcn_s_setprio(0); } while (0)
#define WAIT_V(n) asm volatile("s_waitcnt vmcnt(" #n ")" ::: "memory")
#define WAIT_L(n) asm volatile("s_waitcnt lgkmcnt(" #n ")" ::: "memory")
#define BAR __builtin_amdgcn_s_barrier()
#define SCHED __builtin_amdgcn_sched_barrier(0)
  int tidf = threadIdx.x; asm volatile("" : "+v"(tidf));
  const int wid = tidf >> 6, lane = tidf & 63, wr = wid >> 2, wc = wid & 3, fr = lane & 15, fq = lane >> 4;
#pragma unroll
  for (int a = 0; a < 2; ++a)
#pragma unroll
    for (int b = 0; b < 2; ++b)
#pragma unroll
      for (int m = 0; m < 4; ++m)
#pragma unroll
        for (int n = 0; n < 2; ++n) acc[a][b][m][n] = (f32x4){0.f, 0.f, 0.f, 0.f};
  bf16x8 At[4][2], B0[2][2], B1[2][2];
  constexpr int nt = K / BK;
  WAIT_V(0);
  STAGE(SB(0, 0), Bt, 0, 0); STAGE(SA(0, 0), A, 0, 0);
  STAGE(SB(0, 1), Bt, HALF, 0); STAGE(SA(0, 1), A, HALF, 0);
  if (wr == 1) BAR;
  WAIT_V(4); BAR;
  STAGE(SB(1, 0), Bt, 0, 1); STAGE(SA(1, 0), A, 0, 1); STAGE(SB(1, 1), Bt, HALF, 1);
  WAIT_V(6); BAR;
  for (int t = 0; t < nt - 2; t += 2) {
    LDB(B0, 0, 0); SCHED; LDA(At, 0, 0); STAGE(SA(1, 1), A, HALF, t + 1);
    WAIT_L(8); BAR; WAIT_L(0); MMA(0, 0, At, B0); BAR; SCHED;
    LDB(B1, 0, 1); STAGE(SB(0, 0), Bt, 0, t + 2);
    BAR; WAIT_L(0); MMA(0, 1, At, B1); BAR;
    LDA(At, 0, 1); STAGE(SA(0, 0), A, 0, t + 2);
    BAR; WAIT_L(0); MMA(1, 0, At, B0); BAR; SCHED;
    STAGE(SB(0, 1), Bt, HALF, t + 2);
    WAIT_V(6); BAR; MMA(1, 1, At, B1); BAR;
    LDB(B0, 1, 0); SCHED; LDA(At, 1, 0); STAGE(SA(0, 1), A, HALF, t + 2);
    WAIT_L(8); BAR; WAIT_L(0); MMA(0, 0, At, B0); BAR; SCHED;
    LDB(B1, 1, 1); STAGE(SB(1, 0), Bt, 0, t + 3);
    BAR; WAIT_L(0); MMA(0, 1, At, B1); BAR;
    LDA(At, 1, 1); STAGE(SA(1, 0), A, 0, t + 3);
    BAR; WAIT_L(0); MMA(1, 0, At, B0); BAR; SCHED;
    STAGE(SB(1, 1), Bt, HALF, t + 3);
    WAIT_V(6); BAR; MMA(1, 1, At, B1); BAR;
  }
  { LDB(B0, 0, 0); LDA(At, 0, 0); STAGE(SA(1, 1), A, HALF, nt - 1);
    BAR; WAIT_L(0); MMA(0, 0, At, B0); BAR;
    LDB(B1, 0, 1); BAR; WAIT_L(0); MMA(0, 1, At, B1); BAR;
    LDA(At, 0, 1); WAIT_V(4); BAR; WAIT_L(0); MMA(1, 0, At, B0); MMA(1, 1, At, B1); BAR; }
  { LDB(B0, 1, 0); LDA(At, 1, 0); WAIT_V(2); BAR; WAIT_L(0); MMA(0, 0, At, B0); BAR;
    LDB(B1, 1, 1); WAIT_V(0); BAR; WAIT_L(0); MMA(0, 1, At, B1); BAR;
    LDA(At, 1, 1); BAR; WAIT_L(0); MMA(1, 0, At, B0); MMA(1, 1, At, B1); BAR; }
  if (wr == 0) BAR;
#undef SA
#undef SB
#undef STAGE
#undef LDA
#undef LDB
#undef MMA
#undef WAIT_V
#undef WAIT_L
#undef BAR
#undef SCHED
}

DI void classify_head(const Params& p, int hd, int b, int& kind, bf16_t*& dst, float*& fdst, float& scale) {
  kind = K_NONE; dst = nullptr; fdst = nullptr; scale = 1.f;
  if (hd < 4) { kind = K_ROPE; dst = p.QA() + ((size_t)(b * 4 + hd) * T) * 64; scale = 0.125f * 1.4426950408889634f; }
  else if (hd < 6) { kind = K_ROPE; dst = p.KA() + ((size_t)(b * 2 + hd - 4) * T) * 64; }
  else if (hd < 8) { kind = K_TR; dst = p.VAT() + (size_t)(b * 2 + hd - 6) * 64 * T; }
  else if (hd < 12) { kind = K_GSILU; dst = p.GZ() + (size_t)0 * NTOK * 256 + (hd - 8) * 64; }
  else if (hd < 20) { kind = K_PLAIN; dst = p.QKB() + ((size_t)(b * 8 + hd - 12) * T) * 64; }
  else if (hd < 24) { kind = K_TR; dst = p.VBT() + (size_t)(b * 4 + hd - 20) * 64 * T; }
  else if (hd < 28) { kind = K_GSIG; dst = p.GZ() + (size_t)1 * NTOK * 256 + (hd - 24) * 64; }
  else if (hd < 32) { kind = K_GSILU; dst = p.GZ() + (size_t)2 * NTOK * 256 + (hd - 28) * 64; }
  else if (hd < 36) { kind = K_SILUH; dst = p.QC() + ((size_t)(b * 4 + hd - 32) * T) * 64; }
  else if (hd < 40) { kind = K_LOGF; fdst = p.GC() + ((size_t)(b * 4 + hd - 36) * T) * 64; }
  else if (hd < 44) { kind = K_TR; dst = p.VCT() + (size_t)(b * 4 + hd - 40) * 64 * T; }
  else if (hd < 48) { kind = K_GSILU; dst = p.GZ() + (size_t)3 * NTOK * 256 + (hd - 44) * 64; }
  else if (hd < 52) { kind = K_ROPE; dst = p.QD() + ((size_t)(b * 4 + hd - 48) * T) * 64; scale = 0.125f * 1.4426950408889634f; }
  else if (hd < 58) {
    const int j = hd - 52;
    dst = p.KV() + (size_t)(j * NB + b) * T * 64;
    kind = (j == 0 || j == 1) ? K_PLAIN : ((j == 2 || j == 4) ? K_ROPE : K_TR);
  }
  else if (hd < 62) { kind = K_GSILU; dst = p.GZ() + (size_t)4 * NTOK * 256 + (hd - 58) * 64; }
  else if (hd == 62) { kind = K_SMALL; }
}

DI bool head_is_paired(int hd) { return hd < 6 || (hd >= 48 && hd < 52) || hd == 54 || hd == 56; }
template <int KIND>
DI void epi_direct(const Params& p, const f32x4 (&a)[4][2], bf16_t* dst, float* fdst, float scale, int layer, int hd, int b, int tq, int wr, int w, int fr, int fq) {
  if (KIND == K_ROPE) {
    const int c = 16 * w + 4 * fq;
    const f32x4 b0 = *(const f32x4*)(p.BIASP() + layer * NP + hd * 64 + c), b1 = *(const f32x4*)(p.BIASP() + layer * NP + hd * 64 + 32 + c);
#pragma unroll
    for (int m = 0; m < 4; ++m) {
      const int t = tq + wr * 64 + m * 16 + fr;
      const f32x4 cs = *(const f32x4*)(p.ROPEC() + t * 32 + c), sn = *(const f32x4*)(p.ROPES() + t * 32 + c);
      const f32x4 v0 = a[m][0] + b0, v1 = a[m][1] + b1;
      const f32x4 o0 = (v0 * cs - v1 * sn) * scale, o1 = (v0 * sn + v1 * cs) * scale;
      u32x2 w0 = {pack2(o0[0], o0[1]), pack2(o0[2], o0[3])}, w1 = {pack2(o1[0], o1[1]), pack2(o1[2], o1[3])};
      *(u32x2*)(dst + (size_t)t * 64 + c) = w0; *(u32x2*)(dst + (size_t)t * 64 + 32 + c) = w1;
    }
    return;
  }
  const int c = 32 * w + 8 * fq;
  const f32x4 b0 = *(const f32x4*)(p.BIASP() + layer * NP + hd * 64 + c), b1 = *(const f32x4*)(p.BIASP() + layer * NP + hd * 64 + c + 4);
  if (KIND == K_SMALL) {
#pragma unroll
    for (int m = 0; m < 4; ++m) {
      const size_t tok = (size_t)b * T + tq + wr * 64 + m * 16 + fr;
#pragma unroll
      for (int n = 0; n < 2; ++n)
#pragma unroll
        for (int j = 0; j < 4; ++j) {
          const int cc = c + 4 * n + j;
          const float v = a[m][n][j] + (n ? b1[j] : b0[j]);
          if (cc < 8) p.IFG()[tok * 8 + cc] = v;
          else if (cc < 20) p.DG()[tok * 12 + (cc - 8)] = sigmoidf_(v);
        }
    }
    return;
  }
  f32x4 lb0 = {0.f, 0.f, 0.f, 0.f}, lb1 = {0.f, 0.f, 0.f, 0.f};
  if (KIND == K_LOGF) { lb0 = *(const f32x4*)(p.LB() + layer * 256 + (hd - 36) * 64 + c); lb1 = *(const f32x4*)(p.LB() + layer * 256 + (hd - 36) * 64 + c + 4); }
#pragma unroll
  for (int m = 0; m < 4; ++m) {
    const int t = tq + wr * 64 + m * 16 + fr;
    const f32x4 v0 = a[m][0] + b0, v1 = a[m][1] + b1;
    if (KIND == K_LOGF) {
      f32x4 o0, o1;
#pragma unroll
      for (int j = 0; j < 4; ++j) { o0[j] = __logf(lb0[j] + (1.f - lb0[j]) * sigmoidf_(v0[j])); o1[j] = __logf(lb1[j] + (1.f - lb1[j]) * sigmoidf_(v1[j])); }
      *(f32x4*)(fdst + (size_t)t * 64 + c) = o0; *(f32x4*)(fdst + (size_t)t * 64 + c + 4) = o1;
    } else {
      f32x4 o0, o1;
#pragma unroll
      for (int j = 0; j < 4; ++j) {
        if (KIND == K_PLAIN) { o0[j] = v0[j]; o1[j] = v1[j]; }
        else if (KIND == K_SILUH || KIND == K_GSILU) { o0[j] = siluf_(v0[j]); o1[j] = siluf_(v1[j]); }
        else { o0[j] = sigmoidf_(v0[j]); o1[j] = sigmoidf_(v1[j]); }
      }
      u32x4 wv = {pack2(o0[0], o0[1]), pack2(o0[2], o0[3]), pack2(o1[0], o1[1]), pack2(o1[2], o1[3])};
      if (KIND == K_GSILU || KIND == K_GSIG) *(u32x4*)(dst + ((size_t)b * T + t) * 256 + c) = wv;
      else *(u32x4*)(dst + (size_t)t * 64 + c) = wv;
    }
  }
}
DI void epi_tr_write(const Params& p, const f32x4 (&a)[4][2], char* img, int layer, int hd, int wr, int w, int fr, int fq) {
  const int c = 32 * w + 8 * fq;
  const f32x4 b0 = *(const f32x4*)(p.BIASP() + layer * NP + hd * 64 + c), b1 = *(const f32x4*)(p.BIASP() + layer * NP + hd * 64 + c + 4);
  bf16_t* timg = (bf16_t*)img;
#pragma unroll
  for (int m = 0; m < 4; ++m)
#pragma unroll
    for (int n = 0; n < 2; ++n)
#pragma unroll
      for (int j = 0; j < 4; ++j) timg[(c + 4 * n + j) * 128 + wr * 64 + m * 16 + fr] = f2bf(a[m][n][j] + (n ? b1[j] : b0[j]));
}
DI void gemm_in_quadrant(const Params& p, int layer, int panel, int pn, int ai, int bj, const f32x4 (&a)[4][2], char* shm,
                         int b, int hq, int tid2, int wr, int wc, int fr, int fq) {
  const int tq = (panel & 7) * 256 + ai * 128;
  const int hd0 = pn * 4 + bj * 2;
  const int hd = hd0 + (wc >> 1), w = wc & 1;
  int kind; bf16_t* dst; float* fdst; float scale;
  classify_head(p, hd, b, kind, dst, fdst, scale);
  switch (kind) {
    case K_ROPE: epi_direct<K_ROPE>(p, a, dst, fdst, scale, layer, hd, b, tq, wr, w, fr, fq); break;
    case K_PLAIN: epi_direct<K_PLAIN>(p, a, dst, fdst, scale, layer, hd, b, tq, wr, w, fr, fq); break;
    case K_GSILU: epi_direct<K_GSILU>(p, a, dst, fdst, scale, layer, hd, b, tq, wr, w, fr, fq); break;
    case K_GSIG: epi_direct<K_GSIG>(p, a, dst, fdst, scale, layer, hd, b, tq, wr, w, fr, fq); break;
    case K_SILUH: epi_direct<K_SILUH>(p, a, dst, fdst, scale, layer, hd, b, tq, wr, w, fr, fq); break;
    case K_LOGF: epi_direct<K_LOGF>(p, a, dst, fdst, scale, layer, hd, b, tq, wr, w, fr, fq); break;
    case K_SMALL: epi_direct<K_SMALL>(p, a, dst, fdst, scale, layer, hd, b, tq, wr, w, fr, fq); break;
    default: break;
  }
  int k0, k1; { bf16_t* d_; float* f_; float s_; classify_head(p, hd0, b, k0, d_, f_, s_); classify_head(p, hd0 + 1, b, k1, d_, f_, s_); }
  if (k0 == K_TR || k1 == K_TR) {
    if (kind == K_TR) epi_tr_write(p, a, shm + (wc >> 1) * 16384, layer, hd, wr, w, fr, fq);
    __syncthreads();
    int kq; bf16_t* dq; float* fq_; float sq; classify_head(p, hd0 + hq, b, kq, dq, fq_, sq);
    if (kq == K_TR) {
      const char* img = shm + hq * 16384;
#pragma unroll
      for (int i = 0; i < 4; ++i) { const int q = tid2 + 256 * i, cc = q >> 4, rc = q & 15; *(u32x4*)(dq + (size_t)cc * T + tq + rc * 8) = *(const u32x4*)(img + q * 16); }
    }
    __syncthreads();
  }
}
DI void gemm_in_epilogue(const Params& p, int layer, int panel, int pn, const f32x4 (&acc)[2][2][4][2], char* shm) {
  int tidf = threadIdx.x; asm volatile("" : "+v"(tidf));
  const int wid = tidf >> 6, lane = tidf & 63, wr = wid >> 2, wc = wid & 3, fr = lane & 15, fq = lane >> 4;
  const int b = panel >> 3;
  const int hq = __builtin_amdgcn_readfirstlane(tidf >> 8), tid2 = tidf & 255;
  __syncthreads();
  gemm_in_quadrant(p, layer, panel, pn, 0, 0, acc[0][0], shm, b, hq, tid2, wr, wc, fr, fq);
  gemm_in_quadrant(p, layer, panel, pn, 0, 1, acc[0][1], shm, b, hq, tid2, wr, wc, fr, fq);
  gemm_in_quadrant(p, layer, panel, pn, 1, 0, acc[1][0], shm, b, hq, tid2, wr, wc, fr, fq);
  gemm_in_quadrant(p, layer, panel, pn, 1, 1, acc[1][1], shm, b, hq, tid2, wr, wc, fr, fq);
}
template <int L0>
DI void gemm_out_epilogue(const Params& p, int panel, int pn, const f32x4 (&acc)[2][2][4][2], char* shm) {
  int tidf = threadIdx.x; asm volatile("" : "+v"(tidf));
  const int wid = tidf >> 6, lane = tidf & 63, wr = wid >> 2, wc = wid & 3, fr = lane & 15, fq = lane >> 4;
#pragma unroll
  for (int ai = 0; ai < 2; ++ai)
#pragma unroll
    for (int m = 0; m < 4; ++m) {
      const size_t row = (size_t)(panel * 256 + ai * 128 + wr * 64 + m * 16 + fr);
      float mu = 0.f, rs = 0.f;
      if (L0) { const f32x2 st = *(const f32x2*)(p.LNS() + row * 2); mu = st[0]; rs = st[1]; }
#pragma unroll
      for (int bj = 0; bj < 2; ++bj)
#pragma unroll
        for (int n = 0; n < 2; ++n) {
          const int col = pn * 256 + bj * 128 + wc * 32 + n * 16 + fq * 4;
          float* g = p.hf + row * 1024 + col;
          f32x4 h;
          if (L0) {
            const f32x4 xv = *(const f32x4*)(p.x + row * 1024 + col);
            const f32x4 gg = *(const f32x4*)(p.ln0_g + col), bb = *(const f32x4*)(p.ln0_b + col);
            h = (xv - mu) * rs * gg + bb;
          } else h = *(const f32x4*)g;
          *(f32x4*)g = DN_ALPHA * h + acc[ai][bj][m][n];
        }
    }
}
DI void ph_gemm_in(const Params& p, int layer, int bid, int nblk, char* shm) {
  asm volatile("" : "+s"(bid));
  if (nblk == 256) {
    const int x = bid & 7, c = bid >> 3;
    for (int g = 0; g < 4; ++g) {
      const int panel = 32 * x + 8 * g + (c & 7);
      const bf16_t* A = p.HB() + (size_t)panel * 256 * 1024;
      for (int s = 0; s < 4; ++s) {
        const int pn = (c >> 3) + 4 * s;
        f32x4 acc[2][2][4][2];
        gemm256_mainloop(A, p.WT() + ((size_t)layer * NP + pn * 256) * 1024, (bf16_t*)shm, acc);
        if (PROBE == 6) { __syncthreads(); gemm256_mainloop(A, p.WT() + ((size_t)layer * NP + pn * 256) * 1024, (bf16_t*)shm, acc); }
        gemm_in_epilogue(p, layer, panel, pn, acc, shm);
        if (PROBE == 7) gemm_in_epilogue(p, layer, panel, pn, acc, shm);
      }
    }
    return;
  }
  for (int panel = bid; panel < 256; panel += nblk) {
    const bf16_t* A = p.HB() + (size_t)panel * 256 * 1024;
    for (int pn = 0; pn < 16; ++pn) {
      f32x4 acc[2][2][4][2];
      gemm256_mainloop(A, p.WT() + ((size_t)layer * NP + pn * 256) * 1024, (bf16_t*)shm, acc);
      gemm_in_epilogue(p, layer, panel, pn, acc, shm);
    }
  }
}
DI void ph_gemm_out_ln(const Params& p, int layer, int bid, int nblk, char* shm) {
  asm volatile("" : "+s"(bid));
  for (int panel = bid; panel < 256; panel += nblk) {
    const bf16_t* A = p.YMIX() + (size_t)panel * 256 * 1024;
    for (int pn = 0; pn < 4; ++pn) {
      f32x4 acc[2][2][4][2];
      gemm256_mainloop(A, p.WOT() + ((size_t)layer * 1024 + pn * 256) * 1024, (bf16_t*)shm, acc);
      if (layer == 0) gemm_out_epilogue<1>(p, panel, pn, acc, shm); else gemm_out_epilogue<0>(p, panel, pn, acc, shm);
    }
    asm volatile("s_waitcnt vmcnt(0)" ::: "memory");
    __syncthreads();
    int tidf = threadIdx.x; asm volatile("" : "+v"(tidf));
    const int lane = tidf & 63, wid = tidf >> 6;
    const float* g = p.ln_g + layer * 1024; const float* bb = p.ln_b + layer * 1024;
    for (int rr = 0; rr < 32; ++rr) {
      const int row = panel * 256 + wid * 32 + rr;
      float* s = p.hf + (size_t)row * 1024;
      f32x4 v[4];
      float sum = 0.f;
#pragma unroll
      for (int i = 0; i < 4; ++i) { v[i] = *(const f32x4*)(s + i * 256 + lane * 4); sum += (v[i][0] + v[i][1]) + (v[i][2] + v[i][3]); }
      sum = wave_sum(sum);
      const float mu = sum * (1.f / 1024.f);
      float q = 0.f;
#pragma unroll
      for (int i = 0; i < 4; ++i) { const f32x4 d = v[i] - mu; q += (d[0] * d[0] + d[1] * d[1]) + (d[2] * d[2] + d[3] * d[3]); }
      q = wave_sum(q);
      const float rs = rsqrtf(q * (1.f / 1024.f) + 1e-5f);
#pragma unroll
      for (int i = 0; i < 4; ++i) {
        const int cc = i * 256 + lane * 4;
        const f32x4 gg = *(const f32x4*)(g + cc), b4 = *(const f32x4*)(bb + cc);
        const f32x4 o = (v[i] - mu) * rs * gg + b4;
        *(f32x4*)(s + cc) = o;
        if (layer == 0) { u32x2 pk = {pack2(o[0], o[1]), pack2(o[2], o[3])}; *(u32x2*)(p.HB() + (size_t)row * 1024 + cc) = pk; }
      }
    }
  }
}

DI f32x16 qk_tile(const bf16_t* Krow, const bf16x8 (&qf)[4], int l31, int h2) {
  f32x16 s = zero16();
  const bf16_t* kp = Krow + l31 * 64 + h2 * 8;
#pragma unroll
  for (int ks = 0; ks < 4; ++ks) { const bf16x8 a = *(const bf16x8*)(kp + ks * 16); s = MFMA32(a, qf[ks], s); }
  return s;
}
DI f32x16 qk_tile_s(const bf16_t* Krow, int stride, const bf16x8 (&qf)[4], int l31, int h2) {
  f32x16 s = zero16();
  const bf16_t* kp = Krow + l31 * stride + h2 * 8;
#pragma unroll
  for (int ks = 0; ks < 4; ++ks) { const bf16x8 a = *(const bf16x8*)(kp + ks * 16); s = MFMA32(a, qf[ks], s); }
  return s;
}
template <bool HAS_SEL>
DI void softmax_pv_t(f32x16& s, const bf16_t* VTp, int vstride, f32x16 (&o)[2], float& m, float& l, int l31, int h2, bool sel) {
  bf16x8 va[2][2];
#pragma unroll
  for (int dt = 0; dt < 2; ++dt)
#pragma unroll
    for (int sk = 0; sk < 2; ++sk) va[dt][sk] = ld_frag8x2(VTp + (size_t)(dt * 32 + l31) * vstride + sk * 16 + 4 * h2);
  float mx = s[0];
#pragma unroll
  for (int r = 1; r < 16; ++r) mx = fmaxf(mx, s[r]);
  if (HAS_SEL) mx = sel ? mx : -INFINITY;
  mx = xhalf_max(mx);
  const float mn = fmaxf(m, mx);
  const float alpha = __builtin_amdgcn_exp2f(m - mn);
  const float mref = (HAS_SEL && !sel) ? INFINITY : mn;
  float ps = 0.f;
#pragma unroll
  for (int r = 0; r < 16; ++r) { s[r] = __builtin_amdgcn_exp2f(s[r] - mref); ps += s[r]; }
  l = l * alpha + ps; m = mn;
#pragma unroll
  for (int dt = 0; dt < 2; ++dt)
#pragma unroll
    for (int r = 0; r < 16; ++r) o[dt][r] *= alpha;
  const bf16x8 p0 = pack8<0>(s), p1 = pack8<8>(s);
#pragma unroll
  for (int dt = 0; dt < 2; ++dt) { o[dt] = MFMA32(va[dt][0], p0, o[dt]); o[dt] = MFMA32(va[dt][1], p1, o[dt]); }
}
DI void softmax_pv(f32x16& s, const bf16_t* VTp, int vstride, f32x16 (&o)[2], float& m, float& l, int l31, int h2) { softmax_pv_t<false>(s, VTp, vstride, o, m, l, l31, h2, true); }

constexpr int AD_KSTR = 72, AD_VSTR = 68;
constexpr int AD_BUF = 64 * AD_KSTR * 2 + 64 * AD_VSTR * 2;
struct AdTile { u32x4 k, v; };
DI AdTile ad_load(const bf16_t* Kg, const bf16_t* Vg, int key0, int tidf) {
  AdTile r; const int row = tidf >> 3, ch = tidf & 7;
  r.k = *(const u32x4*)(Kg + (size_t)(key0 + row) * 64 + ch * 8);
  r.v = *(const u32x4*)(Vg + (size_t)row * T + key0 + ch * 8);
  return r;
}
DI void ad_store(const AdTile& r, char* buf, int tidf) {
  const int row = tidf >> 3, ch = tidf & 7;
  *(u32x4*)(buf + (row * AD_KSTR + ch * 8) * 2) = r.k;
  char* vp = buf + 64 * AD_KSTR * 2 + (row * AD_VSTR + ch * 8) * 2;
  *(u32x2*)vp = (u32x2){r.v[0], r.v[1]}; *(u32x2*)(vp + 8) = (u32x2){r.v[2], r.v[3]};
}
DI void ph_attnD(const Params& p, int layer, int* ctr, char* smem, int* s_pair) {
  float* imps = (float*)smem;
  float* impf = (float*)(smem + 34816);
  unsigned* smask = (unsigned*)(smem + 43008);
  unsigned* s_union = (unsigned*)(smem + 43008 + 256);
  char* kvbuf = smem + 49152;
  int tidf = threadIdx.x; asm volatile("" : "+v"(tidf));
  const int lane = tidf & 63, wid = tidf >> 6, h = wid & 3, qs = wid >> 2, l31 = lane & 31, h2 = lane >> 5;
  for (;;) {
    __syncthreads();
    if (tidf == 0) { *s_pair = atomicAdd(ctr, 1); *s_union = 0u; }
    __syncthreads();
    const int it = *s_pair;
    if (it >= 1024) break;
    const int b = it & 31, q0 = (31 - (it >> 5)) * 64;
    const int qw = q0 + 32 * qs;
    const int t = qw + l31, cur = q0 >> 6;
    const size_t tok = (size_t)b * T + t;
    bf16x8 qf[4];
    {
      const bf16_t* qp = p.QD() + ((size_t)(b * 4 + h) * T + t) * 64 + h2 * 8;
#pragma unroll
      for (int ks = 0; ks < 4; ++ks) qf[ks] = *(const bf16x8*)(qp + ks * 16);
    }
    const float g0 = p.DG()[tok * 12 + h * 3 + 0], g1 = p.DG()[tok * 12 + h * 3 + 1], g2 = p.DG()[tok * 12 + h * 3 + 2];
    f32x16 ofin[2];
    {
      const bf16_t* Kc = p.KCMP() + (size_t)b * 128 * 64;
      const bf16_t* Vc = p.VCMPT() + (size_t)b * 64 * 128;
      const int nkt = min(4, (qw >> 9) + 1);
      f32x16 o[2]; o[0] = zero16(); o[1] = zero16();
      float m = -1e30f, l = 0.f;
      for (int kt = 0; kt < nkt; ++kt) {
        f32x16 s = qk_tile(Kc + kt * 32 * 64, qf, l31, h2);
#pragma unroll
        for (int r = 0; r < 16; ++r) { const int n = kt * 32 + crow(r, h2); if (16 * n + 31 > t) s[r] = -INFINITY; }
        softmax_pv(s, Vc + kt * 32, 128, o, m, l, l31, h2);
      }
      l = xhalf_sum(l);
      const float il = l > 0.f ? 1.f / l : 0.f;
      const float gi = g0 * il;
#pragma unroll
      for (int dt = 0; dt < 2; ++dt)
#pragma unroll
        for (int r = 0; r < 16; ++r) ofin[dt][r] = gi * o[dt][r];
      float carry = 0.f;
#pragma unroll
      for (int kt = 0; kt < 4; ++kt) {
        f32x16 s;
        if (kt < nkt) {
          s = qk_tile(Kc + kt * 32 * 64, qf, l31, h2);
#pragma unroll
          for (int r = 0; r < 16; ++r) { const int n = kt * 32 + crow(r, h2); s[r] = (16 * n + 31 > t) ? 0.f : __builtin_amdgcn_exp2f(s[r] - m) * il; }
        } else s = zero16();
        float X[4];
#pragma unroll
        for (int g = 0; g < 4; ++g) X[g] = shx(s[4 * g + 3], 32);
#pragma unroll
        for (int g = 0; g < 4; ++g) {
          const float G = (s[4 * g] + s[4 * g + 1]) + (s[4 * g + 2] + s[4 * g + 3]);
          const float prev_other = g > 0 ? X[g - 1] : carry;
          imps[(wid * 32 + l31) * 33 + 8 * kt + 2 * g + h2] = G + (h2 ? X[g] : prev_other);
        }
        carry = X[3];
      }
    }
    __syncthreads();
    {
      const int tt = tidf >> 3, jg = tidf & 7, wq = (tt >> 5) * 4, tl = tt & 31;
#pragma unroll
      for (int i = 0; i < 4; ++i) {
        const int j = jg * 4 + i;
        impf[tt * 32 + j] = (imps[((wq + 0) * 32 + tl) * 33 + j] + imps[((wq + 1) * 32 + tl) * 33 + j]) + (imps[((wq + 2) * 32 + tl) * 33 + j] + imps[((wq + 3) * 32 + tl) * 33 + j]);
      }
    }
    __syncthreads();
    {
      const int tt = tidf >> 3, jg = tidf & 7;
      float v[32];
#pragma unroll
      for (int j = 0; j < 32; ++j) {
        float x = impf[tt * 32 + j];
        if (j > cur) x = -1e30f; else if (j == 0 || j == cur || j == cur - 1) x = 1e6f;
        v[j] = x;
      }
      unsigned bits = 0u;
#pragma unroll
      for (int i = 0; i < 4; ++i) {
        int rank = 0; float vj = 0.f;
#pragma unroll
        for (int j = 0; j < 32; ++j) if (j == jg * 4 + i) vj = v[j];
        const int jj = jg * 4 + i;
#pragma unroll
        for (int j = 0; j < 32; ++j) rank += (v[j] > vj || (v[j] == vj && j < jj)) ? 1 : 0;
        if (rank < 8 && jj <= cur) bits |= 1u << jj;
      }
      bits |= shx(bits, 1); bits |= shx(bits, 2); bits |= shx(bits, 4);
      if (jg == 0) { smask[tt] = bits; atomicOr(s_union, bits); }
    }
    __syncthreads();
    {
      const unsigned mymask = smask[32 * qs + l31];
      unsigned rem = *s_union;
      const bf16_t* Ks = p.KV() + (size_t)(2 * NB + b) * T * 64;
      const bf16_t* Vs = p.KV() + (size_t)(3 * NB + b) * 64 * T;
      f32x16 o[2]; o[0] = zero16(); o[1] = zero16();
      float m = -1e30f, l = 0.f;
      int j = __builtin_ctz(rem); rem &= rem - 1;
      { const AdTile r = ad_load(Ks, Vs, j * 64, tidf); ad_store(r, kvbuf, tidf); }
      __syncthreads();
      int pb = 0;
      for (;;) {
        const bool more = rem != 0u;
        const int jn = more ? __builtin_ctz(rem) : 0;
        AdTile nx;
        if (more) nx = ad_load(Ks, Vs, jn * 64, tidf);
        const char* buf = kvbuf + pb * AD_BUF;
        const bool sel = (mymask >> j) & 1u;
#pragma unroll
        for (int kh = 0; kh < 2; ++kh) {
          const int key0 = j * 64 + kh * 32;
          if (key0 <= qw + 31) {
            f32x16 s = qk_tile_s((const bf16_t*)buf + kh * 32 * AD_KSTR, AD_KSTR, qf, l31, h2);
            if (j == cur) {
#pragma unroll
              for (int r = 0; r < 16; ++r) { const int key = key0 + crow(r, h2); if (key > t) s[r] = -INFINITY; }
            }
            softmax_pv_t<true>(s, (const bf16_t*)(buf + 64 * AD_KSTR * 2) + kh * 32, AD_VSTR, o, m, l, l31, h2, sel);
          }
        }
        if (more) ad_store(nx, kvbuf + (pb ^ 1) * AD_BUF, tidf);
        __syncthreads();
        if (!more) break;
        rem &= rem - 1; j = jn; pb ^= 1;
      }
      l = xhalf_sum(l);
      const float il = l > 0.f ? g1 / l : 0.f;
#pragma unroll
      for (int dt = 0; dt < 2; ++dt)
#pragma unroll
        for (int r = 0; r < 16; ++r) ofin[dt][r] += il * o[dt][r];
    }
    {
      const bf16_t* Kw = p.KV() + (size_t)(4 * NB + b) * T * 64;
      const bf16_t* Vw = p.KV() + (size_t)(5 * NB + b) * 64 * T;
      f32x16 o[2]; o[0] = zero16(); o[1] = zero16();
      float m = -1e30f, l = 0.f;
      int k0 = max(0, q0 - 512);
      { const AdTile r = ad_load(Kw, Vw, k0, tidf); ad_store(r, kvbuf, tidf); }
      __syncthreads();
      int pb = 0;
      for (;;) {
        const bool more = k0 + 64 <= q0;
        AdTile nx;
        if (more) nx = ad_load(Kw, Vw, k0 + 64, tidf);
        const char* buf = kvbuf + pb * AD_BUF;
#pragma unroll
        for (int kh = 0; kh < 2; ++kh) {
          const int key0 = k0 + kh * 32;
          if (key0 <= qw + 31 && key0 + 31 + 512 > qw) {
            f32x16 s = qk_tile_s((const bf16_t*)buf + kh * 32 * AD_KSTR, AD_KSTR, qf, l31, h2);
            if (key0 + 31 > qw || key0 + 512 <= qw + 31) {
#pragma unroll
              for (int r = 0; r < 16; ++r) { const int key = key0 + crow(r, h2); if (key > t || t - key >= 512) s[r] = -INFINITY; }
            }
            softmax_pv(s, (const bf16_t*)(buf + 64 * AD_KSTR * 2) + kh * 32, AD_VSTR, o, m, l, l31, h2);
          }
        }
        if (more) ad_store(nx, kvbuf + (pb ^ 1) * AD_BUF, tidf);
        __syncthreads();
        if (!more) break;
        k0 += 64; pb ^= 1;
      }
      l = xhalf_sum(l);
      const float il = l > 0.f ? g2 / l : 0.f;
#pragma unroll
      for (int dt = 0; dt < 2; ++dt)
#pragma unroll
        for (int r = 0; r < 16; ++r) ofin[dt][r] += il * o[dt][r];
    }
#pragma unroll
    for (int dt = 0; dt < 2; ++dt)
#pragma unroll
      for (int g = 0; g < 4; ++g) {
        const int d0 = dt * 32 + 8 * g + 4 * h2;
        const u32x2 gz = *(const u32x2*)(p.GZ() + (size_t)4 * NTOK * 256 + tok * 256 + h * 64 + d0);
        const float z0 = __uint_as_float(gz.x << 16), z1 = __uint_as_float(gz.x & 0xffff0000u), z2 = __uint_as_float(gz.y << 16), z3 = __uint_as_float(gz.y & 0xffff0000u);
        u32x2 o2 = {pack2(ofin[dt][4 * g] * z0, ofin[dt][4 * g + 1] * z1), pack2(ofin[dt][4 * g + 2] * z2, ofin[dt][4 * g + 3] * z3)};
        *(u32x2*)(p.YMIX() + tok * 1024 + 768 + h * 64 + d0) = o2;
      }
  }
}


struct AaTile { u32x4 k0, v0, k1, v1; };
DI AaTile aa_load(const bf16_t* Kg, const bf16_t* Vg, int key0, int tidf) {
  AaTile r; const int row = tidf >> 3, ch = tidf & 7;
  r.k0 = *(const u32x4*)(Kg + (size_t)(key0 + row) * 64 + ch * 8);
  r.v0 = *(const u32x4*)(Vg + (size_t)row * T + key0 + ch * 8);
  r.k1 = *(const u32x4*)(Kg + (size_t)T * 64 + (size_t)(key0 + row) * 64 + ch * 8);
  r.v1 = *(const u32x4*)(Vg + (size_t)T * 64 + (size_t)row * T + key0 + ch * 8);
  return r;
}
DI void aa_store(const AaTile& r, char* buf, int tidf) {
  AdTile a; a.k = r.k0; a.v = r.v0; ad_store(a, buf, tidf);
  a.k = r.k1; a.v = r.v1; ad_store(a, buf + AD_BUF, tidf);
}
DI void ph_attnA_fb(const Params& p, int layer, int item, char* smem) {
  int tidf = threadIdx.x; asm volatile("" : "+v"(tidf));
  const int lane = tidf & 63, wid = tidf >> 6, h = wid & 3, qs = wid >> 2, l31 = lane & 31, h2 = lane >> 5, g = h >> 1;
  const int b = item >> 5, q0 = (item & 31) * 64;
  const int qw = q0 + 32 * qs, t = qw + l31;
  const size_t tok = (size_t)b * T + t;
  bf16x8 qf[4];
  {
    const bf16_t* qp = p.QA() + ((size_t)(b * 4 + h) * T + t) * 64 + h2 * 8;
#pragma unroll
    for (int ks = 0; ks < 4; ++ks) qf[ks] = *(const bf16x8*)(qp + ks * 16);
  }
  const bf16_t* Kg = p.KA() + (size_t)(b * 2) * T * 64;
  const bf16_t* Vg = p.VAT() + (size_t)(b * 2) * 64 * T;
  f32x16 o[2]; o[0] = zero16(); o[1] = zero16();
  float m = -1e30f, l = 0.f;
  int k0 = max(0, q0 - 128);
  __syncthreads();
  { const AaTile r = aa_load(Kg, Vg, k0, tidf); aa_store(r, smem, tidf); }
  __syncthreads();
  int pb = 0;
  for (;;) {
    const bool more = k0 + 64 <= q0;
    AaTile nx;
    if (more) nx = aa_load(Kg, Vg, k0 + 64, tidf);
    const char* buf = smem + pb * (2 * AD_BUF) + g * AD_BUF;
#pragma unroll
    for (int kh = 0; kh < 2; ++kh) {
      const int key0 = k0 + kh * 32;
      if (key0 <= qw + 31 && key0 + 31 + 128 > qw) {
        f32x16 s = qk_tile_s((const bf16_t*)buf + kh * 32 * AD_KSTR, AD_KSTR, qf, l31, h2);
        if (key0 + 31 > qw || key0 + 128 <= qw + 31) {
#pragma unroll
          for (int r = 0; r < 16; ++r) { const int key = key0 + crow(r, h2); if (key > t || t - key >= 128) s[r] = -INFINITY; }
        }
        softmax_pv(s, (const bf16_t*)(buf + 64 * AD_KSTR * 2) + kh * 32, AD_VSTR, o, m, l, l31, h2);
      }
    }
    if (more) aa_store(nx, smem + (pb ^ 1) * (2 * AD_BUF), tidf);
    __syncthreads();
    if (!more) break;
    k0 += 64; pb ^= 1;
  }
  l = xhalf_sum(l);
  const float sink = p.a_sinks[layer * 4 + h] * 1.4426950408889634f;
  const float M = fmaxf(m, sink);
  const float sc = __builtin_amdgcn_exp2f(m - M);
  const float inv = sc / (l * sc + __builtin_amdgcn_exp2f(sink - M));
#pragma unroll
  for (int dt = 0; dt < 2; ++dt)
#pragma unroll
    for (int gq = 0; gq < 4; ++gq) {
      const int d0 = dt * 32 + 8 * gq + 4 * h2;
      const u32x2 gz = *(const u32x2*)(p.GZ() + tok * 256 + h * 64 + d0);
      const float z0 = __uint_as_float(gz.x << 16), z1 = __uint_as_float(gz.x & 0xffff0000u), z2 = __uint_as_float(gz.y << 16), z3 = __uint_as_float(gz.y & 0xffff0000u);
      u32x2 o2 = {pack2(o[dt][4 * gq] * inv * z0, o[dt][4 * gq + 1] * inv * z1), pack2(o[dt][4 * gq + 2] * inv * z2, o[dt][4 * gq + 3] * inv * z3)};
      *(u32x2*)(p.YMIX() + tok * 1024 + h * 64 + d0) = o2;
    }
}

DI float logsigmoidf_(float x) { return fminf(x, 0.f) - __logf(1.f + __expf(-fabsf(x))); }
DI void mlstm_gates(const Params& p, size_t tok0, int hh, float* bc, float* ig, int tid) {
  if (tid < 64) {
    const int s0 = 2 * tid;
    const float lf0 = logsigmoidf_(p.IFG()[(tok0 + s0) * 8 + 4 + hh]), lf1 = logsigmoidf_(p.IFG()[(tok0 + s0 + 1) * 8 + 4 + hh]);
    const float pair = lf0 + lf1;
    float x = pair;
#pragma unroll
    for (int off = 1; off < 64; off <<= 1) { const float y = shup(x, off); if (tid >= off) x += y; }
    const float excl = x - pair;
    bc[s0] = excl + lf0; bc[s0 + 1] = excl + pair;
    ig[s0] = p.IFG()[(tok0 + s0) * 8 + hh]; ig[s0 + 1] = p.IFG()[(tok0 + s0 + 1) * 8 + hh];
  }
}
DI void conv8(const bf16_t* raw, int t, int dg, const float (&cw)[4][8], const float (&cb)[8], float (&out)[8]) {
#pragma unroll
  for (int e = 0; e < 8; ++e) out[e] = cb[e];
#pragma unroll
  for (int j = 0; j < 4; ++j) {
    const int ts = t - 3 + j;
    if (ts >= 0) {
      const u32x4 row = *(const u32x4*)(raw + (size_t)ts * 64 + dg * 8);
#pragma unroll
      for (int e2 = 0; e2 < 4; ++e2) { out[2 * e2] += cw[j][2 * e2] * __uint_as_float(row[e2] << 16); out[2 * e2 + 1] += cw[j][2 * e2 + 1] * __uint_as_float(row[e2] & 0xffff0000u); }
    }
  }
#pragma unroll
  for (int e = 0; e < 8; ++e) out[e] = siluf_(out[e]);
}
DI void conv_rows_load(const bf16_t* raw, int tfirst, int dg, u32x4 (&r)[7]) {
#pragma unroll
  for (int j = 0; j < 7; ++j) {
    const int ts = tfirst + j;
    const u32x4 v = *(const u32x4*)(raw + (size_t)max(ts, 0) * 64 + dg * 8);
    r[j] = ts >= 0 ? v : (u32x4){0u, 0u, 0u, 0u};
  }
}
template <int I>
DI void conv_rows_compute(const u32x4 (&r)[7], const float (&cw)[4][8], const float (&cb)[8], float (&out)[8]) {
#pragma unroll
  for (int e = 0; e < 8; ++e) out[e] = cb[e];
#pragma unroll
  for (int j = 0; j < 4; ++j) {
    const u32x4 row = r[I + j];
#pragma unroll
    for (int e2 = 0; e2 < 4; ++e2) { out[2 * e2] += cw[j][2 * e2] * __uint_as_float(row[e2] << 16); out[2 * e2 + 1] += cw[j][2 * e2 + 1] * __uint_as_float(row[e2] & 0xffff0000u); }
  }
#pragma unroll
  for (int e = 0; e < 8; ++e) out[e] = siluf_(out[e]);
}
DI void load_conv_w(const Params& p, int layer, int ch0, int dg, float (&cw)[4][8], float (&cb)[8]) {
#pragma unroll
  for (int j = 0; j < 4; ++j)
#pragma unroll
    for (int e = 0; e < 8; ++e) cw[j][e] = p.conv_w[layer * 2048 + j * 512 + ch0 + dg * 8 + e];
#pragma unroll
  for (int e = 0; e < 8; ++e) cb[e] = p.conv_b[layer * 512 + ch0 + dg * 8 + e];
}
DI void delta_state_loadA(const bf16_t* VT, bf16x8 (&a)[8], int wid, int l31, int h2) {
  const int mt = wid >> 1;
#pragma unroll
  for (int ks = 0; ks < 8; ++ks) a[ks] = *(const bf16x8*)(VT + (size_t)(mt * 32 + l31) * T + ks * 16 + h2 * 8);
}
DI void delta_state(const bf16x8 (&a)[8], const bf16_t* KT, float* out, int wid, int l31, int h2) {
  const int mt = wid >> 1, nt = wid & 1;
  f32x16 acc = zero16();
#pragma unroll
  for (int ks = 0; ks < 8; ++ks) {
    const bf16x8 bb = *(const bf16x8*)(KT + (nt * 32 + l31) * 136 + ks * 16 + h2 * 8);
    acc = MFMA32(a[ks], bb, acc);
  }
#pragma unroll
  for (int r = 0; r < 16; ++r) out[(mt * 32 + crow(r, h2)) * 64 + nt * 32 + l31] = acc[r];
}
DI void ph_mlstm_local(const Params& p, int layer, int item, char* smem) {
  float* bc = (float*)smem; float* ig = bc + 128; float* wv = ig + 128;
  bf16_t* KwT = (bf16_t*)(smem + 2048);
  float* nred = (float*)(smem + 2048 + 64 * 136 * 2);
  const int tid = tid_opaque(), lane = tid & 63, wid = tid >> 6, l31 = lane & 31, h2 = lane >> 5;
  const int b = item >> 6, hh = (item >> 4) & 3, c = item & 15, t0 = c * 128;
  const size_t tok0 = (size_t)b * T + t0;
  const int dg = tid & 7, sb = tid >> 3;
  u32x4 rows[7];
  conv_rows_load(p.QKB() + ((size_t)(b * 8 + 4 + hh) * T) * 64, t0 + 4 * sb - 3, dg, rows);
  bf16x8 af[8];
  delta_state_loadA(p.VBT() + (size_t)(b * 4 + hh) * 64 * T + t0, af, wid, l31, h2);
  float cw[4][8], cb[8];
  load_conv_w(p, layer, 256 + hh * 64, dg, cw, cb);
  __syncthreads();
  mlstm_gates(p, tok0, hh, bc, ig, tid);
  __syncthreads();
  if (tid < 128) wv[tid] = __expf(bc[127] - bc[tid] + ig[tid]);
  __syncthreads();
  {
    float v0[8], v1[8], v2[8], v3[8];
    conv_rows_compute<0>(rows, cw, cb, v0); conv_rows_compute<1>(rows, cw, cb, v1);
    conv_rows_compute<2>(rows, cw, cb, v2); conv_rows_compute<3>(rows, cw, cb, v3);
    const f32x4 w4 = *(const f32x4*)(wv + 4 * sb);
#pragma unroll
    for (int e = 0; e < 8; ++e) {
      u32x2 pk = {pack2(v0[e] * w4[0], v1[e] * w4[1]), pack2(v2[e] * w4[2], v3[e] * w4[3])};
      *(u32x2*)(KwT + (dg * 8 + e) * 136 + 4 * sb) = pk;
    }
  }
  __syncthreads();
  delta_state(af, KwT, p.BST() + (size_t)item * 4096, wid, l31, h2);
  {
    const int k = tid & 63, qd = tid >> 6;
    float a = 0.f;
#pragma unroll 8
    for (int s = 0; s < 32; ++s) a += bf2f(KwT[k * 136 + qd * 32 + s]);
    nred[qd * 64 + k] = a;
  }
  __syncthreads();
  if (tid < 64) p.BN()[(size_t)item * 64 + tid] = (nred[tid] + nred[64 + tid]) + (nred[128 + tid] + nred[192 + tid]);
  if (tid == 0) p.BG()[item] = bc[127];
}
DI void ph_mlstm_scan(const Params& p, int bh) {
  const int tid = tid_opaque();
  f32x4 C[4];
#pragma unroll
  for (int i = 0; i < 4; ++i) C[i] = (f32x4){0.f, 0.f, 0.f, 0.f};
  float n = 0.f;
  for (int c = 0; c < 16; ++c) {
    const int item = bh * 16 + c;
    const float g = __expf(p.BG()[item]);
    f32x4* ptr = (f32x4*)(p.BST() + (size_t)item * 4096 + tid * 16);
#pragma unroll
    for (int i = 0; i < 4; ++i) { const f32x4 tmp = ptr[i]; ptr[i] = C[i]; C[i] = g * C[i] + tmp; }
    if (tid < 64) { const float tmp = p.BN()[(size_t)item * 64 + tid]; p.BN()[(size_t)item * 64 + tid] = n; n = g * n + tmp; }
  }
}
DI void pv_only(const f32x16& s, const bf16_t* VTp, int vstride, f32x16 (&o)[2], int l31, int h2) {
  const bf16x8 p0 = pack8<0>(s), p1 = pack8<8>(s);
#pragma unroll
  for (int dt = 0; dt < 2; ++dt) {
    const bf16_t* vp = VTp + (size_t)(dt * 32 + l31) * vstride + 4 * h2;
    o[dt] = MFMA32(ld_frag8x2(vp), p0, o[dt]);
    o[dt] = MFMA32(ld_frag8x2(vp + 16), p1, o[dt]);
  }
}
DI bf16x8 frag_from_f32(const float* ptr) {
  const f32x4 a = *(const f32x4*)ptr, b = *(const f32x4*)(ptr + 4);
  u32x4 t = {pack2(a[0], a[1]), pack2(a[2], a[3]), pack2(b[0], b[1]), pack2(b[2], b[3])};
  return __builtin_bit_cast(bf16x8, t);
}
constexpr int VT_LSTR = 132;
DI void vt_chunk_load(const bf16_t* VT, int tid, u32x4 (&r)[4]) {
  const int d = tid >> 2, part = tid & 3;
#pragma unroll
  for (int j = 0; j < 4; ++j) r[j] = *(const u32x4*)(VT + (size_t)d * T + part * 32 + j * 8);
}
DI void vt_chunk_store(const u32x4 (&r)[4], bf16_t* lds, int tid) {
  const int d = tid >> 2, part = tid & 3;
#pragma unroll
  for (int j = 0; j < 4; ++j) {
    bf16_t* q = lds + d * VT_LSTR + part * 32 + j * 8;
    *(u32x2*)q = (u32x2){r[j][0], r[j][1]}; *(u32x2*)(q + 4) = (u32x2){r[j][2], r[j][3]};
  }
}
DI void ph_mlstm_out(const Params& p, int layer, int item, char* smem) {
  float* bc = (float*)smem; float* ig = bc + 128;
  bf16_t* qc = (bf16_t*)(smem + 2048);
  bf16_t* kc = qc + 128 * 72;
  bf16_t* vt = kc + 128 * 72;
  const int tid = tid_opaque(), lane = tid & 63, wid = tid >> 6, l31 = lane & 31, h2 = lane >> 5;
  const int b = item >> 6, hh = (item >> 4) & 3, c = item & 15, t0 = c * 128;
  const size_t tok0 = (size_t)b * T + t0;
  const int dg = tid & 7, sb = tid >> 3;
  u32x4 rq[7], rk[7];
  conv_rows_load(p.QKB() + ((size_t)(b * 8 + hh) * T) * 64, t0 + 4 * sb - 3, dg, rq);
  conv_rows_load(p.QKB() + ((size_t)(b * 8 + 4 + hh) * T) * 64, t0 + 4 * sb - 3, dg, rk);
  u32x4 rv[4];
  vt_chunk_load(p.VBT() + (size_t)(b * 4 + hh) * 64 * T + t0, tid, rv);
  __syncthreads();
  mlstm_gates(p, tok0, hh, bc, ig, tid);
  {
    float cw[4][8], cb[8];
    load_conv_w(p, layer, hh * 64, dg, cw, cb);
    float v[8];
#define CONV_ST(I, R, DST, SC) do { conv_rows_compute<I>(R, cw, cb, v); \
      u32x4 w_ = {pack2(v[0] * (SC), v[1] * (SC)), pack2(v[2] * (SC), v[3] * (SC)), pack2(v[4] * (SC), v[5] * (SC)), pack2(v[6] * (SC), v[7] * (SC))}; \
      *(u32x4*)((DST) + (4 * sb + (I)) * 72 + dg * 8) = w_; } while (0)
    CONV_ST(0, rq, qc, 0.125f); CONV_ST(1, rq, qc, 0.125f); CONV_ST(2, rq, qc, 0.125f); CONV_ST(3, rq, qc, 0.125f);
    load_conv_w(p, layer, 256 + hh * 64, dg, cw, cb);
    CONV_ST(0, rk, kc, 1.f); CONV_ST(1, rk, kc, 1.f); CONV_ST(2, rk, kc, 1.f); CONV_ST(3, rk, kc, 1.f);
#undef CONV_ST
  }
  vt_chunk_store(rv, vt, tid);
  const int tq = 32 * wid + l31;
  const float* Cs = p.BST() + (size_t)item * 4096;
  const float* ns = p.BN() + (size_t)item * 64;
  f32x4 cst[2][4][2], nst[4][2];
#pragma unroll
  for (int ks = 0; ks < 4; ++ks) {
#pragma unroll
    for (int dt = 0; dt < 2; ++dt) { cst[dt][ks][0] = *(const f32x4*)(Cs + (dt * 32 + l31) * 64 + ks * 16 + h2 * 8); cst[dt][ks][1] = *(const f32x4*)(Cs + (dt * 32 + l31) * 64 + ks * 16 + h2 * 8 + 4); }
    nst[ks][0] = *(const f32x4*)(ns + ks * 16 + h2 * 8); nst[ks][1] = *(const f32x4*)(ns + ks * 16 + h2 * 8 + 4);
  }
  u32x2 gz1[2][4], gz2[2][4];
#pragma unroll
  for (int dt = 0; dt < 2; ++dt)
#pragma unroll
    for (int g = 0; g < 4; ++g) {
      const int d0 = dt * 32 + 8 * g + 4 * h2;
      gz1[dt][g] = *(const u32x2*)(p.GZ() + (size_t)1 * NTOK * 256 + (tok0 + tq) * 256 + hh * 64 + d0);
      gz2[dt][g] = *(const u32x2*)(p.GZ() + (size_t)2 * NTOK * 256 + (tok0 + tq) * 256 + hh * 64 + d0);
    }
  __syncthreads();
  if (tid < 128) ig[tid] = ig[tid] - bc[tid];
  __syncthreads();
  bf16x8 qf[4];
#pragma unroll
  for (int ks = 0; ks < 4; ++ks) qf[ks] = *(const bf16x8*)(qc + tq * 72 + ks * 16 + h2 * 8);
  const float bt = bc[tq];
  f32x16 o[2]; o[0] = zero16(); o[1] = zero16();
  float dsum = 0.f;
  for (int kt = 0; kt <= wid; ++kt) {
    f32x16 s = qk_tile_s(kc + kt * 32 * 72, 72, qf, l31, h2);
#pragma unroll
    for (int r = 0; r < 16; ++r) {
      const int sidx = 32 * kt + crow(r, h2);
      float val = s[r] * __expf(bt + ig[sidx]);
      if (sidx > tq) val = 0.f;
      s[r] = val; dsum += val;
    }
    pv_only(s, vt + kt * 32, VT_LSTR, o, l31, h2);
  }
  dsum += shx(dsum, 32);
  f32x16 oi[2]; oi[0] = zero16(); oi[1] = zero16();
  float qn = 0.f;
#pragma unroll
  for (int ks = 0; ks < 4; ++ks) {
#pragma unroll
    for (int dt = 0; dt < 2; ++dt) {
      const f32x4 a_ = cst[dt][ks][0], b_ = cst[dt][ks][1];
      u32x4 t_ = {pack2(a_[0], a_[1]), pack2(a_[2], a_[3]), pack2(b_[0], b_[1]), pack2(b_[2], b_[3])};
      oi[dt] = MFMA32(__builtin_bit_cast(bf16x8, t_), qf[ks], oi[dt]);
    }
    const u32x4 qu = __builtin_bit_cast(u32x4, qf[ks]);
    const f32x4 n0 = nst[ks][0], n1 = nst[ks][1];
    qn += __uint_as_float(qu[0] << 16) * n0[0] + __uint_as_float(qu[0] & 0xffff0000u) * n0[1] + __uint_as_float(qu[1] << 16) * n0[2] + __uint_as_float(qu[1] & 0xffff0000u) * n0[3];
    qn += __uint_as_float(qu[2] << 16) * n1[0] + __uint_as_float(qu[2] & 0xffff0000u) * n1[1] + __uint_as_float(qu[3] << 16) * n1[2] + __uint_as_float(qu[3] & 0xffff0000u) * n1[3];
  }
  qn += shx(qn, 32);
  const float ebt = __expf(bt);
  const float den = dsum + ebt * qn;
  const float inv = 1.f / fmaxf(fabsf(den), 1.f);
  const size_t tok = tok0 + tq;
#pragma unroll
  for (int dt = 0; dt < 2; ++dt)
#pragma unroll
    for (int g = 0; g < 4; ++g) {
      const int d0 = dt * 32 + 8 * g + 4 * h2;
      const u32x2 g1 = gz1[dt][g], g2 = gz2[dt][g];
      float z[4] = {__uint_as_float(g1.x << 16) * __uint_as_float(g2.x << 16), __uint_as_float(g1.x & 0xffff0000u) * __uint_as_float(g2.x & 0xffff0000u),
                    __uint_as_float(g1.y << 16) * __uint_as_float(g2.y << 16), __uint_as_float(g1.y & 0xffff0000u) * __uint_as_float(g2.y & 0xffff0000u)};
      float hv[4];
#pragma unroll
      for (int i = 0; i < 4; ++i) hv[i] = (o[dt][4 * g + i] + ebt * oi[dt][4 * g + i]) * inv * z[i];
      u32x2 o2 = {pack2(hv[0], hv[1]), pack2(hv[2], hv[3])};
      *(u32x2*)(p.YMIX() + tok * 1024 + 256 + hh * 64 + d0) = o2;
    }
}


DI void ph_hgrn_local(const Params& p, int layer, int item, char* smem) {
  float* tot = (float*)smem;
  bf16_t* KdT = (bf16_t*)(smem + 1024);
  const int tid = tid_opaque(), lane = tid & 63, wid = tid >> 6, l31 = lane & 31, h2 = lane >> 5;
  const int b = item >> 6, hh = (item >> 4) & 3, c = item & 15, t0 = c * 128;
  const int k = tid & 63, qd = tid >> 6;
  float al[32], kk[32];
  bf16x8 af[8];
  delta_state_loadA(p.VCT() + (size_t)(b * 4 + hh) * 64 * T + t0, af, wid, l31, h2);
  {
    const float* gp = p.GC() + ((size_t)(b * 4 + hh) * T + t0 + 32 * qd) * 64 + k;
    float run = 0.f;
#pragma unroll
    for (int s = 0; s < 32; ++s) { const float g = gp[s * 64]; run += g; al[s] = run; kk[s] = 1.f - __expf(g); }
    __syncthreads();
    tot[qd * 64 + k] = run;
  }
  __syncthreads();
  float off = 0.f, aL = 0.f;
#pragma unroll
  for (int q = 0; q < 4; ++q) { const float v = tot[q * 64 + k]; aL += v; if (q < qd) off += v; }
#pragma unroll
  for (int s8 = 0; s8 < 4; ++s8) {
    float v[8];
#pragma unroll
    for (int e = 0; e < 8; ++e) v[e] = kk[s8 * 8 + e] * __expf(aL - (al[s8 * 8 + e] + off));
    u32x4 w = {pack2(v[0], v[1]), pack2(v[2], v[3]), pack2(v[4], v[5]), pack2(v[6], v[7])};
    *(u32x4*)(KdT + k * 136 + qd * 32 + s8 * 8) = w;
  }
  __syncthreads();
  delta_state(af, KdT, p.CST() + (size_t)item * 4096, wid, l31, h2);
  if (qd == 0) p.CAL()[(size_t)item * 64 + k] = aL;
}
DI void ph_hgrn_scan(const Params& p, int bh) {
  const int tid = tid_opaque();
  f32x4 S[4];
#pragma unroll
  for (int i = 0; i < 4; ++i) S[i] = (f32x4){0.f, 0.f, 0.f, 0.f};
  for (int c = 0; c < 16; ++c) {
    const int item = bh * 16 + c;
    const f32x4* dp = (const f32x4*)(p.CAL() + (size_t)item * 64 + (tid & 3) * 16);
    f32x4* ptr = (f32x4*)(p.CST() + (size_t)item * 4096 + tid * 16);
#pragma unroll
    for (int i = 0; i < 4; ++i) {
      const f32x4 a = dp[i];
      const f32x4 dec = {__expf(a[0]), __expf(a[1]), __expf(a[2]), __expf(a[3])};
      const f32x4 tmp = ptr[i]; ptr[i] = S[i]; S[i] = dec * S[i] + tmp;
    }
  }
}
DI void ph_hgrn_out(const Params& p, int layer, int item, char* smem) {
  float* a_lds = (float*)smem;
  float* tot = (float*)(smem + 128 * 68 * 4);
  bf16_t* kk_lds = (bf16_t*)(smem + 128 * 68 * 4 + 1024);
  bf16_t* vt = kk_lds + 128 * 72;
  const int tid = tid_opaque(), lane = tid & 63, wid = tid >> 6, l31 = lane & 31, h2 = lane >> 5;
  const int b = item >> 6, hh = (item >> 4) & 3, c = item & 15, t0 = c * 128;
  const size_t hbase = (size_t)(b * 4 + hh) * T + t0;
  const int tq = 32 * wid + l31;
  const size_t tok = (size_t)b * T + t0 + tq;
  u32x4 qu[4];
#pragma unroll
  for (int ks = 0; ks < 4; ++ks) qu[ks] = *(const u32x4*)(p.QC() + (hbase + tq) * 64 + ks * 16 + h2 * 8);
  u32x4 rv[4];
  vt_chunk_load(p.VCT() + (size_t)(b * 4 + hh) * 64 * T + t0, tid, rv);
  u32x2 gzv[2][4];
#pragma unroll
  for (int dt = 0; dt < 2; ++dt)
#pragma unroll
    for (int g = 0; g < 4; ++g) gzv[dt][g] = *(const u32x2*)(p.GZ() + (size_t)3 * NTOK * 256 + tok * 256 + hh * 64 + dt * 32 + 8 * g + 4 * h2);
  {
    const int k = tid & 63, qd = tid >> 6;
    float al[32];
    const float* gp = p.GC() + (hbase + 32 * qd) * 64 + k;
    float run = 0.f;
    __syncthreads();
#pragma unroll
    for (int s = 0; s < 32; ++s) { const float g = gp[s * 64]; run += g; al[s] = run; kk_lds[(32 * qd + s) * 72 + k] = f2bf(1.f - __expf(g)); }
    tot[qd * 64 + k] = run;
    vt_chunk_store(rv, vt, tid);
    __syncthreads();
    float off = 0.f;
#pragma unroll
    for (int q = 0; q < 4; ++q) { const float v = tot[q * 64 + k]; if (q < qd) off += v; }
#pragma unroll
    for (int s = 0; s < 32; ++s) a_lds[(32 * qd + s) * 68 + k] = al[s] + off;
  }
  const float* Ss = p.CST() + (size_t)item * 4096;
  f32x4 cst[2][4][2];
#pragma unroll
  for (int ks = 0; ks < 4; ++ks)
#pragma unroll
    for (int dt = 0; dt < 2; ++dt) { cst[dt][ks][0] = *(const f32x4*)(Ss + (dt * 32 + l31) * 64 + ks * 16 + h2 * 8); cst[dt][ks][1] = *(const f32x4*)(Ss + (dt * 32 + l31) * 64 + ks * 16 + h2 * 8 + 4); }
  __syncthreads();
  bf16x8 qi[4], qh[4];
#pragma unroll
  for (int ks = 0; ks < 4; ++ks) {
    const int k0 = ks * 16 + h2 * 8;
    float q8[8], e1[8], e2[8];
#pragma unroll
    for (int e2i = 0; e2i < 4; ++e2i) { q8[2 * e2i] = __uint_as_float(qu[ks][e2i] << 16); q8[2 * e2i + 1] = __uint_as_float(qu[ks][e2i] & 0xffff0000u); }
#pragma unroll
    for (int e = 0; e < 8; ++e) {
      const float a = a_lds[tq * 68 + k0 + e];
      const float r = wid > 0 ? a_lds[(32 * wid - 1) * 68 + k0 + e] : 0.f;
      e1[e] = q8[e] * __expf(a - r); e2[e] = q8[e] * __expf(a);
    }
    u32x4 w1 = {pack2(e1[0], e1[1]), pack2(e1[2], e1[3]), pack2(e1[4], e1[5]), pack2(e1[6], e1[7])};
    u32x4 w2 = {pack2(e2[0], e2[1]), pack2(e2[2], e2[3]), pack2(e2[4], e2[5]), pack2(e2[6], e2[7])};
    qi[ks] = __builtin_bit_cast(bf16x8, w1); qh[ks] = __builtin_bit_cast(bf16x8, w2);
  }
  f32x16 o[2]; o[0] = zero16(); o[1] = zero16();
  for (int kt = 0; kt <= wid; ++kt) {
    f32x16 s = zero16();
    const int srow = 32 * kt + l31;
#pragma unroll
    for (int ks = 0; ks < 4; ++ks) {
      const int k0 = ks * 16 + h2 * 8;
      const u32x4 ku = *(const u32x4*)(kk_lds + srow * 72 + k0);
      float v[8];
#pragma unroll
      for (int e = 0; e < 8; ++e) {
        const float a = a_lds[srow * 68 + k0 + e];
        const float r = wid > 0 ? a_lds[(32 * wid - 1) * 68 + k0 + e] : 0.f;
        const float kkv = (e & 1) ? __uint_as_float(ku[e >> 1] & 0xffff0000u) : __uint_as_float(ku[e >> 1] << 16);
        v[e] = kkv * __expf(fminf(r - a, 80.f));
      }
      u32x4 w = {pack2(v[0], v[1]), pack2(v[2], v[3]), pack2(v[4], v[5]), pack2(v[6], v[7])};
      s = MFMA32(__builtin_bit_cast(bf16x8, w), qi[ks], s);
    }
    if (kt == wid) {
#pragma unroll
      for (int r = 0; r < 16; ++r) if (32 * kt + crow(r, h2) > tq) s[r] = 0.f;
    }
    pv_only(s, vt + kt * 32, VT_LSTR, o, l31, h2);
  }
#pragma unroll
  for (int ks = 0; ks < 4; ++ks)
#pragma unroll
    for (int dt = 0; dt < 2; ++dt) {
      const f32x4 a_ = cst[dt][ks][0], b_ = cst[dt][ks][1];
      u32x4 t_ = {pack2(a_[0], a_[1]), pack2(a_[2], a_[3]), pack2(b_[0], b_[1]), pack2(b_[2], b_[3])};
      o[dt] = MFMA32(__builtin_bit_cast(bf16x8, t_), qh[ks], o[dt]);
    }
  float ss = 0.f;
#pragma unroll
  for (int dt = 0; dt < 2; ++dt)
#pragma unroll
    for (int r = 0; r < 16; ++r) ss += o[dt][r] * o[dt][r];
  ss += shx(ss, 32);
  const float rs = rsqrtf(ss * (1.f / 64.f) + 1e-6f);
#pragma unroll
  for (int dt = 0; dt < 2; ++dt)
#pragma unroll
    for (int g = 0; g < 4; ++g) {
      const int d0 = dt * 32 + 8 * g + 4 * h2;
      const u32x2 gz = gzv[dt][g];
      const f32x4 gn = *(const f32x4*)(p.c_norm_g + layer * 256 + hh * 64 + d0);
      const float z0 = __uint_as_float(gz.x << 16), z1 = __uint_as_float(gz.x & 0xffff0000u), z2 = __uint_as_float(gz.y << 16), z3 = __uint_as_float(gz.y & 0xffff0000u);
      u32x2 o2 = {pack2(o[dt][4 * g] * rs * gn[0] * z0, o[dt][4 * g + 1] * rs * gn[1] * z1), pack2(o[dt][4 * g + 2] * rs * gn[2] * z2, o[dt][4 * g + 3] * rs * gn[3] * z3)};
      *(u32x2*)(p.YMIX() + tok * 1024 + 512 + hh * 64 + d0) = o2;
    }
}


DI void ph_attnA(const Params& p, int layer, int item, char* smem) {
  const int tid = tid_opaque(), lane = tid & 63, h = tid >> 6, l31 = lane & 31, h2 = lane >> 5;
  const int b = item >> 6, q0 = (item & 63) * 32, g = h >> 1;
  const int t = q0 + l31;
  const size_t tok = (size_t)b * T + t;
  bf16x8 qf[4];
  {
    const bf16_t* qp = p.QA() + ((size_t)(b * 4 + h) * T + t) * 64 + h2 * 8;
#pragma unroll
    for (int ks = 0; ks < 4; ++ks) qf[ks] = *(const bf16x8*)(qp + ks * 16);
  }
  const bf16_t* Kp = p.KA() + (size_t)(b * 2 + g) * T * 64;
  const bf16_t* Vp = p.VAT() + (size_t)(b * 2 + g) * 64 * T;
  f32x16 o[2]; o[0] = zero16(); o[1] = zero16();
  float m = -1e30f, l = 0.f;
  for (int key0 = max(0, q0 - 128); key0 <= q0; key0 += 32) {
    f32x16 s = qk_tile(Kp + (size_t)key0 * 64, qf, l31, h2);
    if (key0 == q0 - 128 || key0 == q0) {
#pragma unroll
      for (int r = 0; r < 16; ++r) { const int key = key0 + crow(r, h2); if (key > t || t - key >= 128) s[r] = -INFINITY; }
    }
    softmax_pv(s, Vp + key0, T, o, m, l, l31, h2);
  }
  l = xhalf_sum(l);
  const float sink = p.a_sinks[layer * 4 + h] * 1.4426950408889634f;
  const float M = fmaxf(m, sink);
  const float sc = __builtin_amdgcn_exp2f(m - M);
  const float inv = sc / (l * sc + __builtin_amdgcn_exp2f(sink - M));
#pragma unroll
  for (int dt = 0; dt < 2; ++dt)
#pragma unroll
    for (int gq = 0; gq < 4; ++gq) {
      const int d0 = dt * 32 + 8 * gq + 4 * h2;
      const u32x2 gz = *(const u32x2*)(p.GZ() + tok * 256 + h * 64 + d0);
      const float z0 = __uint_as_float(gz.x << 16), z1 = __uint_as_float(gz.x & 0xffff0000u), z2 = __uint_as_float(gz.y << 16), z3 = __uint_as_float(gz.y & 0xffff0000u);
      u32x2 o2 = {pack2(o[dt][4 * gq] * inv * z0, o[dt][4 * gq + 1] * inv * z1), pack2(o[dt][4 * gq + 2] * inv * z2, o[dt][4 * gq + 3] * inv * z3)};
      *(u32x2*)(p.YMIX() + tok * 1024 + h * 64 + d0) = o2;
    }
}

DI void ph_cmp(const Params& p, int layer, int item, char* smem) {
  float* red = (float*)smem;
  bf16_t* hid = (bf16_t*)(smem + 32768);
  const int tid = tid_opaque(), lane = tid & 63, wid = tid >> 6, l31 = lane & 31, h2 = lane >> 5;
  const int b = item >> 3, kvsel = (item >> 2) & 1, mt = item & 3;
  const int lk = layer * 2 + kvsel;
  const int n = min(mt * 32 + l31, 126);
  const bf16_t* src = p.KV() + ((size_t)(kvsel * NB + b) * T + 16 * n) * 64 + wid * 512 + h2 * 8;
  const bf16_t* w1t = p.W1T() + (size_t)lk * 64 * 2048 + wid * 512 + h2 * 8;
  f32x16 acc[2]; acc[0] = zero16(); acc[1] = zero16();
#pragma unroll 4
  for (int ks = 0; ks < 32; ++ks) {
    const bf16x8 a = *(const bf16x8*)(src + ks * 16);
    const bf16x8 b0 = *(const bf16x8*)(w1t + (size_t)l31 * 2048 + ks * 16);
    const bf16x8 b1 = *(const bf16x8*)(w1t + (size_t)(32 + l31) * 2048 + ks * 16);
    acc[0] = MFMA32(a, b0, acc[0]); acc[1] = MFMA32(a, b1, acc[1]);
  }
  __syncthreads();
#pragma unroll
  for (int nt = 0; nt < 2; ++nt)
#pragma unroll
    for (int r = 0; r < 16; ++r) red[(wid * 32 + crow(r, h2)) * 64 + nt * 32 + l31] = acc[nt][r];
  __syncthreads();
  {
    const int row = tid >> 3, c0 = (tid & 7) * 8;
    float v[8];
#pragma unroll
    for (int e = 0; e < 8; ++e) {
      const float x = (red[(0 * 32 + row) * 64 + c0 + e] + red[(1 * 32 + row) * 64 + c0 + e]) + (red[(2 * 32 + row) * 64 + c0 + e] + red[(3 * 32 + row) * 64 + c0 + e]) + p.CVEC()[lk * 64 + c0 + e];
      v[e] = siluf_(x);
    }
    u32x4 w = {pack2(v[0], v[1]), pack2(v[2], v[3]), pack2(v[4], v[5]), pack2(v[6], v[7])};
    *(u32x4*)(hid + row * 72 + c0) = w;
  }
  __syncthreads();
  if (wid == 0) {
    f32x16 o[2]; o[0] = zero16(); o[1] = zero16();
    const bf16_t* w2t = p.W2T() + (size_t)lk * 4096;
#pragma unroll
    for (int ks = 0; ks < 4; ++ks) {
      const bf16x8 a = *(const bf16x8*)(hid + l31 * 72 + ks * 16 + h2 * 8);
#pragma unroll
      for (int nt = 0; nt < 2; ++nt) o[nt] = MFMA32(a, *(const bf16x8*)(w2t + (nt * 32 + l31) * 64 + ks * 16 + h2 * 8), o[nt]);
    }
    if (kvsel == 0) {
#pragma unroll
      for (int r = 0; r < 16; ++r) {
        const int nn = mt * 32 + crow(r, h2);
        if (nn < 127) {
          const int pos = 16 * nn + 31;
          const float cs = p.ROPEC()[pos * 32 + l31], sn = p.ROPES()[pos * 32 + l31];
          p.KCMP()[((size_t)b * 128 + nn) * 64 + l31] = f2bf(o[0][r] * cs - o[1][r] * sn);
          p.KCMP()[((size_t)b * 128 + nn) * 64 + 32 + l31] = f2bf(o[0][r] * sn + o[1][r] * cs);
        }
      }
    } else {
#pragma unroll
      for (int nt = 0; nt < 2; ++nt)
#pragma unroll
        for (int r = 0; r < 16; ++r) {
          const int nn = mt * 32 + crow(r, h2);
          if (nn < 127) p.VCMPT()[((size_t)b * 64 + nt * 32 + l31) * 128 + nn] = f2bf(o[nt][r]);
        }
    }
  }
}


#define XB_TMO      128
#define XB_XCNT(j)  (256  + 64 * (j))
#define XB_XSUB(j)  (1280 + 64 * (j))
#define XB_XGEN(j)  (2304 + 64 * (j))
#define XB_TOP      3328
#define XB_TOPGEN   3392
#define XCD_BAR_WORDS 3456
#define XB_SPIN_CAP (1u << 22)
DI unsigned xb_ld(unsigned* p)              { return __hip_atomic_load(p, __ATOMIC_RELAXED, __HIP_MEMORY_SCOPE_AGENT); }
DI unsigned xb_add(unsigned* p, unsigned v) { return __hip_atomic_fetch_add(p, v, __ATOMIC_RELAXED, __HIP_MEMORY_SCOPE_AGENT); }
DI unsigned xb_xcc_id() { return (unsigned)__builtin_amdgcn_s_getreg((3 << 11) | 20) & 0xFu; }
#define XB_SPIN(cond, bar) do { unsigned _sp = 0; while (cond) { __builtin_amdgcn_s_sleep(1); \
    if ((++_sp & 255u) == 0u) { if (xb_ld(&(bar)[XB_TMO])) break; if (_sp > XB_SPIN_CAP) { atomicAdd(&(bar)[XB_TMO], 1u); break; } } } } while (0)
struct XcdBarrier { unsigned* bar; unsigned x; volatile LAS unsigned* st; };
DI XcdBarrier xcd_barrier_post(unsigned* bar, volatile LAS unsigned* st) {
  XcdBarrier b; b.bar = bar; b.x = xb_xcc_id(); b.st = st;
  if (threadIdx.x == 0) (void)xb_add(&bar[XB_XCNT(b.x)], 1u);
  return b;
}
DI void xcd_barrier_complete(unsigned* bar, unsigned x, unsigned& nloc, unsigned& nx) {
  const unsigned G = gridDim.x * gridDim.y * gridDim.z;
  unsigned sum, cnt, mine, sp = 0u;
  for (;;) {
    sum = 0u; cnt = 0u; mine = 0u;
#pragma unroll
    for (unsigned j = 0; j < 16; ++j) { const unsigned c = xb_ld(&bar[XB_XCNT(j)]); sum += c; cnt += (c > 0u) ? 1u : 0u; mine = (j == x) ? c : mine; }
    if (sum == G) break;
    __builtin_amdgcn_s_sleep(1);
    if ((++sp & 255u) == 0u) { if (xb_ld(&bar[XB_TMO])) break; if (sp > XB_SPIN_CAP) { atomicAdd(&bar[XB_TMO], 1u); break; } }
  }
  nloc = mine > 0u ? mine : 1u; nx = cnt > 0u ? cnt : 1u;
}
DI void xcd_barrier(const XcdBarrier& b) {
  asm volatile("s_waitcnt vmcnt(0)" ::: "memory");
  __syncthreads();
  int t0_ = threadIdx.x; asm volatile("" : "+v"(t0_));
  if (t0_ == 0) {
    unsigned* bar = b.bar;
    __builtin_amdgcn_s_waitcnt(0);
    unsigned nloc = b.st[0], nx = b.st[1];
    if (nloc == 0u) { xcd_barrier_complete(bar, b.x, nloc, nx); b.st[0] = nloc; b.st[1] = nx; }
    const unsigned old = xb_add(&bar[XB_XSUB(b.x)], 1u);
    const unsigned gen = old / nloc;
    if (old + 1u == (gen + 1u) * nloc) {
      __builtin_amdgcn_fence(__ATOMIC_RELEASE, "agent");
      asm volatile("s_waitcnt vmcnt(0)" ::: "memory");
      const unsigned og = xb_add(&bar[XB_TOP], 1u);
      const unsigned tg = og / nx;
      if (og + 1u == (tg + 1u) * nx) xb_add(&bar[XB_TOPGEN], 1u);
      else XB_SPIN(xb_ld(&bar[XB_TOPGEN]) == tg, bar);
      __builtin_amdgcn_fence(__ATOMIC_ACQUIRE, "agent");
      xb_add(&bar[XB_XGEN(b.x)], 1u);
      asm volatile("s_waitcnt vmcnt(0)" ::: "memory");
    } else {
      XB_SPIN(xb_ld(&bar[XB_XGEN(b.x)]) == gen, bar);
      __builtin_amdgcn_fence(__ATOMIC_ACQUIRE, "agent");
      asm volatile("s_waitcnt vmcnt(0)" ::: "memory");
    }
  }
  __syncthreads();
}

constexpr int HALF_LDS = 80000;
__global__ void __launch_bounds__(512) mega(Params p) {
  __shared__ __attribute__((aligned(16))) char smem_all[2 * HALF_LDS + 32];
  cg::grid_group grid = cg::this_grid();
  const int half = half_id();
  const int bid = blockIdx.x, nblk = gridDim.x;
  const int vbid = 2 * bid + half, nvblk = 2 * nblk;
  char* smem = smem_all + half * HALF_LDS;
  unsigned* xbw = (unsigned*)(smem_all + 2 * HALF_LDS);
  int* s_pair = (int*)(smem_all + 2 * HALF_LDS + 16);
  if (threadIdx.x == 0) { xbw[0] = 0u; xbw[1] = 0u; }
  __syncthreads();
  const XcdBarrier xb = xcd_barrier_post(p.XBAR(), (volatile LAS unsigned*)xbw);
  ph_prologue(p, vbid, nvblk, smem);
  ln_rows(p, 0, 0, vbid, nvblk);
  if (PROBE == 5) { ph_prologue(p, vbid, nvblk, smem); ln_rows(p, 0, 0, vbid, nvblk); }
  grid.sync();
  for (int l = 0; l < 2; ++l) {
    ph_gemm_in(p, l, bid, nblk, smem_all);
    if (PROBE == 1) ph_gemm_in(p, l, bid, nblk, smem_all);
    xcd_barrier(xb);
    for (int rep = 0; rep < (PROBE == 3 ? 2 : 1); ++rep) {
    for (int item = vbid; item < 2048; item += nvblk) ph_mlstm_local(p, l, item, smem);
    for (int item = vbid; item < 2048; item += nvblk) ph_hgrn_local(p, l, item, smem);
    __syncthreads();
    for (int item = vbid; item < 256; item += nvblk) ph_cmp(p, l, item, smem);
    __syncthreads();
    for (int item = bid; item < 1024; item += nblk) ph_attnA_fb(p, l, item, smem_all);
    }
    xcd_barrier(xb);
    if (vbid < 128) ph_mlstm_scan(p, vbid);
    else if (vbid < 256) ph_hgrn_scan(p, vbid - 128);
    __syncthreads();
    ph_attnD(p, l, p.CTR() + l, smem_all, s_pair);
    if (PROBE == 2) ph_attnD(p, l, p.CTR() + 2 + l, smem_all, s_pair);
    xcd_barrier(xb);
    for (int rep = 0; rep < (PROBE == 4 ? 2 : 1); ++rep) {
    for (int item = vbid; item < 2048; item += nvblk) ph_mlstm_out(p, l, item, smem);
    for (int item = vbid; item < 2048; item += nvblk) ph_hgrn_out(p, l, item, smem);
    }
    xcd_barrier(xb);
    ph_gemm_out_ln(p, l, bid, nblk, smem_all);
    if (l == 0) xcd_barrier(xb);
  }
}

static inline size_t align_up(size_t v) { return (v + 255) & ~(size_t)255; }

extern "C" void kernel_launch(void* const* d_in, const int* in_sizes, int n_in, void* d_out, int out_size, void* d_ws, size_t ws_size, hipStream_t stream) {
  Params p{};
  p.x = (const float*)d_in[0]; p.ln0_g = (const float*)d_in[1]; p.ln0_b = (const float*)d_in[2]; p.w_in = (const float*)d_in[3];
  p.b_in = (const float*)d_in[4]; p.a_sinks = (const float*)d_in[5]; p.conv_w = (const float*)d_in[6]; p.conv_b = (const float*)d_in[7];
  p.c_lb = (const float*)d_in[8]; p.c_norm_g = (const float*)d_in[9]; p.pe = (const float*)d_in[10]; p.w1 = (const float*)d_in[11];
  p.w2 = (const float*)d_in[12]; p.w_out = (const float*)d_in[13]; p.ln_g = (const float*)d_in[14]; p.ln_b = (const float*)d_in[15];
  p.hf = (float*)d_out;
  p.ws = (char*)d_ws;
  if (WS_TOTAL > ws_size) { fprintf(stderr, "workspace too small: need %zu have %zu\n", (size_t)WS_TOTAL, ws_size); return; }

  static int grid_blocks = 0;
  if (!grid_blocks) {
    int dev = 0, cus = 0, per_cu = 0;
    (void)hipGetDevice(&dev);
    (void)hipDeviceGetAttribute(&cus, hipDeviceAttributeMultiprocessorCount, dev);
    (void)hipOccupancyMaxActiveBlocksPerMultiprocessor(&per_cu, mega, 512, 0);
    if (per_cu > 1) per_cu = 1;
    grid_blocks = cus * per_cu;
  }
  (void)hipMemsetAsync((char*)d_ws + OFF_XBAR, 0, XCD_BAR_WORDS * 4, stream);
  (void)hipMemsetAsync((char*)d_ws + OFF_CVEC, 0, SZ_CVEC, stream);
  void* args[] = {&p};
  hipError_t e = hipLaunchCooperativeKernel((void*)mega, dim3(grid_blocks), dim3(512), args, 0, stream);
  if (e != hipSuccess) fprintf(stderr, "cooperative launch failed: %s (grid %d)\n", hipGetErrorString(e), grid_blocks);
}
```

```cpp
#include <hip/hip_runtime.h>
#include <hip/hip_cooperative_groups.h>
#include <stdio.h>
#include <stdint.h>
#include <stddef.h>

#ifndef PROBE
#define PROBE 0
#endif
#define DI __device__ __forceinline__
typedef unsigned short bf16_t;
typedef short bf16x8 __attribute__((ext_vector_type(8)));
typedef float f32x16 __attribute__((ext_vector_type(16)));
typedef unsigned u32x4 __attribute__((ext_vector_type(4)));
typedef float f32x4 __attribute__((ext_vector_type(4)));

constexpr int NB = 32, T = 2048, DM = 1024, NTOK = NB * T, NP = 4096;
constexpr float DN_ALPHA = 1.41421356237309515f;

constexpr size_t OFF_HB = 0;
constexpr size_t SZ_HB = (size_t)NTOK * 1024 * 2;
constexpr size_t OFF_YMIX = OFF_HB + ((SZ_HB + 255) & ~(size_t)255);
constexpr size_t SZ_YMIX = (size_t)NTOK * 1024 * 2;
constexpr size_t OFF_QA = OFF_YMIX + ((SZ_YMIX + 255) & ~(size_t)255);
constexpr size_t SZ_QA = (size_t)NTOK * 256 * 2;
constexpr size_t OFF_KA = OFF_QA + ((SZ_QA + 255) & ~(size_t)255);
constexpr size_t SZ_KA = (size_t)NTOK * 128 * 2;
constexpr size_t OFF_VAT = OFF_KA + ((SZ_KA + 255) & ~(size_t)255);
constexpr size_t SZ_VAT = (size_t)NTOK * 128 * 2;
constexpr size_t OFF_QKB = OFF_VAT + ((SZ_VAT + 255) & ~(size_t)255);
constexpr size_t SZ_QKB = (size_t)NTOK * 512 * 2;
constexpr size_t OFF_VBT = OFF_QKB + ((SZ_QKB + 255) & ~(size_t)255);
constexpr size_t SZ_VBT = (size_t)NTOK * 256 * 2;
constexpr size_t OFF_QC = OFF_VBT + ((SZ_VBT + 255) & ~(size_t)255);
constexpr size_t SZ_QC = (size_t)NTOK * 256 * 2;
constexpr size_t OFF_GC = OFF_QC + ((SZ_QC + 255) & ~(size_t)255);
constexpr size_t SZ_GC = (size_t)NTOK * 256 * 4;
constexpr size_t OFF_VCT = OFF_GC + ((SZ_GC + 255) & ~(size_t)255);
constexpr size_t SZ_VCT = (size_t)NTOK * 256 * 2;
constexpr size_t OFF_QD = OFF_VCT + ((SZ_VCT + 255) & ~(size_t)255);
constexpr size_t SZ_QD = (size_t)NTOK * 256 * 2;
constexpr size_t OFF_KV = OFF_QD + ((SZ_QD + 255) & ~(size_t)255);
constexpr size_t SZ_KV = (size_t)NTOK * 384 * 2;
constexpr size_t OFF_GZ = OFF_KV + ((SZ_KV + 255) & ~(size_t)255);
constexpr size_t SZ_GZ = (size_t)NTOK * 1280 * 2;
constexpr size_t OFF_IFG = OFF_GZ + ((SZ_GZ + 255) & ~(size_t)255);
constexpr size_t SZ_IFG = (size_t)NTOK * 8 * 4;
constexpr size_t OFF_DG = OFF_IFG + ((SZ_IFG + 255) & ~(size_t)255);
constexpr size_t SZ_DG = (size_t)NTOK * 12 * 4;
constexpr size_t OFF_WT = OFF_DG + ((SZ_DG + 255) & ~(size_t)255);
constexpr size_t SZ_WT = (size_t)2 * NP * 1024 * 2;
constexpr size_t OFF_WOT = OFF_WT + ((SZ_WT + 255) & ~(size_t)255);
constexpr size_t SZ_WOT = (size_t)2 * 1024 * 1024 * 2;
constexpr size_t OFF_KCMP = OFF_WOT + ((SZ_WOT + 255) & ~(size_t)255);
constexpr size_t SZ_KCMP = (size_t)NB * 128 * 64 * 2;
constexpr size_t OFF_VCMPT = OFF_KCMP + ((SZ_KCMP + 255) & ~(size_t)255);
constexpr size_t SZ_VCMPT = (size_t)NB * 64 * 128 * 2;
constexpr size_t OFF_BIASP = OFF_VCMPT + ((SZ_VCMPT + 255) & ~(size_t)255);
constexpr size_t SZ_BIASP = (size_t)2 * NP * 4;
constexpr size_t OFF_LB = OFF_BIASP + ((SZ_BIASP + 255) & ~(size_t)255);
constexpr size_t SZ_LB = (size_t)512 * 4;
constexpr size_t OFF_ROPEC = OFF_LB + ((SZ_LB + 255) & ~(size_t)255);
constexpr size_t SZ_ROPEC = (size_t)T * 32 * 4;
constexpr size_t OFF_ROPES = OFF_ROPEC + ((SZ_ROPEC + 255) & ~(size_t)255);
constexpr size_t SZ_ROPES = (size_t)T * 32 * 4;
constexpr size_t OFF_BST = OFF_ROPES + ((SZ_ROPES + 255) & ~(size_t)255);
constexpr size_t SZ_BST = (size_t)2048 * 4096 * 4;
constexpr size_t OFF_BN = OFF_BST + ((SZ_BST + 255) & ~(size_t)255);
constexpr size_t SZ_BN = (size_t)2048 * 64 * 4;
constexpr size_t OFF_BG = OFF_BN + ((SZ_BN + 255) & ~(size_t)255);
constexpr size_t SZ_BG = (size_t)2048 * 4;
constexpr size_t OFF_CST = OFF_BG + ((SZ_BG + 255) & ~(size_t)255);
constexpr size_t SZ_CST = (size_t)2048 * 4096 * 4;
constexpr size_t OFF_CAL = OFF_CST + ((SZ_CST + 255) & ~(size_t)255);
constexpr size_t SZ_CAL = (size_t)2048 * 64 * 4;
constexpr size_t OFF_W1T = OFF_CAL + ((SZ_CAL + 255) & ~(size_t)255);
constexpr size_t SZ_W1T = (size_t)4 * 64 * 2048 * 2;
constexpr size_t OFF_W2T = OFF_W1T + ((SZ_W1T + 255) & ~(size_t)255);
constexpr size_t SZ_W2T = (size_t)4 * 64 * 64 * 2;
constexpr size_t OFF_CVEC = OFF_W2T + ((SZ_W2T + 255) & ~(size_t)255);
constexpr size_t SZ_CVEC = (size_t)256 * 4;
constexpr size_t OFF_CTR = OFF_CVEC + ((SZ_CVEC + 255) & ~(size_t)255);
constexpr size_t SZ_CTR = (size_t)256;
constexpr size_t OFF_XBAR = OFF_CTR + ((SZ_CTR + 255) & ~(size_t)255);
constexpr size_t SZ_XBAR = (size_t)3456 * 4;
constexpr size_t OFF_LNS = OFF_XBAR + ((SZ_XBAR + 255) & ~(size_t)255);
constexpr size_t SZ_LNS = (size_t)NTOK * 2 * 4;
constexpr size_t WS_TOTAL = OFF_LNS + ((SZ_LNS + 255) & ~(size_t)255);
struct Params {
  const float *x, *ln0_g, *ln0_b, *w_in, *b_in, *a_sinks, *conv_w, *conv_b, *c_lb, *c_norm_g, *pe, *w1, *w2, *w_out, *ln_g, *ln_b;
  float* hf;
  char* ws;
  DI bf16_t* HB() const { return (bf16_t*)(ws + OFF_HB); }
  DI bf16_t* YMIX() const { return (bf16_t*)(ws + OFF_YMIX); }
  DI bf16_t* QA() const { return (bf16_t*)(ws + OFF_QA); }
  DI bf16_t* KA() const { return (bf16_t*)(ws + OFF_KA); }
  DI bf16_t* VAT() const { return (bf16_t*)(ws + OFF_VAT); }
  DI bf16_t* QKB() const { return (bf16_t*)(ws + OFF_QKB); }
  DI bf16_t* VBT() const { return (bf16_t*)(ws + OFF_VBT); }
  DI bf16_t* QC() const { return (bf16_t*)(ws + OFF_QC); }
  DI float* GC() const { return (float*)(ws + OFF_GC); }
  DI bf16_t* VCT() const { return (bf16_t*)(ws + OFF_VCT); }
  DI bf16_t* QD() const { return (bf16_t*)(ws + OFF_QD); }
  DI bf16_t* KV() const { return (bf16_t*)(ws + OFF_KV); }
  DI bf16_t* GZ() const { return (bf16_t*)(ws + OFF_GZ); }
  DI float* IFG() const { return (float*)(ws + OFF_IFG); }
  DI float* DG() const { return (float*)(ws + OFF_DG); }
  DI bf16_t* WT() const { return (bf16_t*)(ws + OFF_WT); }
  DI bf16_t* WOT() const { return (bf16_t*)(ws + OFF_WOT); }
  DI bf16_t* KCMP() const { return (bf16_t*)(ws + OFF_KCMP); }
  DI bf16_t* VCMPT() const { return (bf16_t*)(ws + OFF_VCMPT); }
  DI float* BIASP() const { return (float*)(ws + OFF_BIASP); }
  DI float* LB() const { return (float*)(ws + OFF_LB); }
  DI float* ROPEC() const { return (float*)(ws + OFF_ROPEC); }
  DI float* ROPES() const { return (float*)(ws + OFF_ROPES); }
  DI float* BST() const { return (float*)(ws + OFF_BST); }
  DI float* BN() const { return (float*)(ws + OFF_BN); }
  DI float* BG() const { return (float*)(ws + OFF_BG); }
  DI float* CST() const { return (float*)(ws + OFF_CST); }
  DI float* CAL() const { return (float*)(ws + OFF_CAL); }
  DI bf16_t* W1T() const { return (bf16_t*)(ws + OFF_W1T); }
  DI bf16_t* W2T() const { return (bf16_t*)(ws + OFF_W2T); }
  DI float* CVEC() const { return (float*)(ws + OFF_CVEC); }
  DI int* CTR() const { return (int*)(ws + OFF_CTR); }
  DI unsigned* XBAR() const { return (unsigned*)(ws + OFF_XBAR); }
  DI float* LNS() const { return (float*)(ws + OFF_LNS); }
};
namespace cg = cooperative_groups;

DI int tid_opaque() { int t = threadIdx.x; asm volatile("" : "+v"(t)); return t & 255; }
DI int half_id() { return __builtin_amdgcn_readfirstlane((int)(threadIdx.x >> 8)); }
DI float bf2f(bf16_t v) { return __uint_as_float(((unsigned)v) << 16); }
DI bf16_t f2bf(float x) { unsigned u = __float_as_uint(x); u += 0x7fffu + ((u >> 16) & 1u); return (bf16_t)(u >> 16); }
DI float sigmoidf_(float x) { return __builtin_amdgcn_rcpf(1.f + __builtin_amdgcn_exp2f(-1.4426950408889634f * x)); }
DI float siluf_(float x) { return x * __builtin_amdgcn_rcpf(1.f + __builtin_amdgcn_exp2f(-1.4426950408889634f * x)); }
DI int lane_op() { int l = threadIdx.x; asm volatile("" : "+v"(l)); return l & 63; }
DI float shx(float v, int m) { return __builtin_bit_cast(float, __builtin_amdgcn_ds_bpermute((lane_op() ^ m) << 2, __builtin_bit_cast(int, v))); }
DI unsigned shx(unsigned v, int m) { return (unsigned)__builtin_amdgcn_ds_bpermute((lane_op() ^ m) << 2, (int)v); }
DI float shup(float v, int d) { const int l = lane_op(); const int s = l - d; return __builtin_bit_cast(float, __builtin_amdgcn_ds_bpermute((s < 0 ? l : s) << 2, __builtin_bit_cast(int, v))); }
DI float xhalf_max(float x) { int a = __builtin_bit_cast(int, x), b = a; asm volatile("" : "+v"(b)); auto r = __builtin_amdgcn_permlane32_swap(a, b, false, false); return fmaxf(__builtin_bit_cast(float, (int)r[0]), __builtin_bit_cast(float, (int)r[1])); }
DI float xhalf_sum(float x) { int a = __builtin_bit_cast(int, x), b = a; asm volatile("" : "+v"(b)); auto r = __builtin_amdgcn_permlane32_swap(a, b, false, false); return __builtin_bit_cast(float, (int)r[0]) + __builtin_bit_cast(float, (int)r[1]); }
DI float wave_sum(float v) { for (int o = 32; o > 0; o >>= 1) v += shx(v, o); return v; }
DI float wave_max(float v) { for (int o = 32; o > 0; o >>= 1) v = fmaxf(v, shx(v, o)); return v; }

DI int orig_col(int n) {
  if (n < 1536) return n;
  if (n < 3712) return n + 8;
  if (n < 3968) return n + 20;
  if (n < 3976) return 1536 + (n - 3968);
  if (n < 3988) return 3720 + (n - 3976);
  return -1;
}

DI bool head_is_paired(int hd);
DI void ph_prologue(const Params& p, int bid, int nblk, char* smem) {
  const long gtid = (long)bid * 256 + tid_opaque(), gsz = (long)nblk * 256;
  if (gtid < 64) p.CTR()[gtid] = 0;
  for (long idx = gtid; idx < 2L * 128 * NP; idx += gsz) {
    const int n = (int)(idx % NP), k8 = (int)((idx / NP) % 128), l = (int)(idx / (NP * 128));
    const int pp = n & 63, w_ = pp >> 5, rr = pp & 31, n_ = rr >> 4, fq_ = (rr >> 2) & 3, j_ = rr & 3;
    const int lc = head_is_paired(n >> 6) ? (32 * n_ + 16 * w_ + 4 * fq_ + j_) : (32 * w_ + 8 * fq_ + 4 * n_ + j_);
    const int oc = orig_col((n & ~63) + lc);
    unsigned w[4];
    for (int j = 0; j < 4; ++j) {
      float a = 0.f, b = 0.f;
      if (oc >= 0) { a = p.w_in[((size_t)l * 1024 + k8 * 8 + 2 * j) * 3988 + oc]; b = p.w_in[((size_t)l * 1024 + k8 * 8 + 2 * j + 1) * 3988 + oc]; }
      w[j] = (unsigned)f2bf(a) | ((unsigned)f2bf(b) << 16);
    }
    *(uint4*)(p.WT() + ((size_t)l * NP + n) * 1024 + k8 * 8) = make_uint4(w[0], w[1], w[2], w[3]);
  }
  for (long idx = gtid; idx < 2L * 128 * 1024; idx += gsz) {
    const int d = (int)(idx % 1024), m8 = (int)((idx / 1024) % 128), l = (int)(idx / (1024 * 128));
    unsigned w[4];
    for (int j = 0; j < 4; ++j) {
      float a = p.w_out[((size_t)l * 1024 + m8 * 8 + 2 * j) * 1024 + d], b = p.w_out[((size_t)l * 1024 + m8 * 8 + 2 * j + 1) * 1024 + d];
      w[j] = (unsigned)f2bf(a) | ((unsigned)f2bf(b) << 16);
    }
    *(uint4*)(p.WOT() + ((size_t)l * 1024 + d) * 1024 + m8 * 8) = make_uint4(w[0], w[1], w[2], w[3]);
  }
  for (long idx = gtid; idx < 4L * 256 * 64; idx += gsz) {
    const int j = (int)(idx % 64), i8 = (int)((idx / 64) % 256), lk = (int)(idx / (64 * 256));
    unsigned w[4];
    for (int e = 0; e < 4; ++e) {
      const float a = p.w1[((size_t)lk * 2048 + i8 * 8 + 2 * e) * 64 + j], b = p.w1[((size_t)lk * 2048 + i8 * 8 + 2 * e + 1) * 64 + j];
      w[e] = (unsigned)f2bf(a) | ((unsigned)f2bf(b) << 16);
    }
    *(uint4*)(p.W1T() + ((size_t)lk * 64 + j) * 2048 + i8 * 8) = make_uint4(w[0], w[1], w[2], w[3]);
  }
  for (long idx = gtid; idx < 4L * 64 * 64; idx += gsz) {
    const int jo = (int)(idx % 64), ji = (int)((idx / 64) % 64), lk = (int)(idx / 4096);
    p.W2T()[((size_t)lk * 64 + jo) * 64 + ji] = f2bf(p.w2[((size_t)lk * 64 + ji) * 64 + jo]);
  }
  if (bid < 64) {
    const int lk = bid >> 4, seg = bid & 15, j = tid_opaque() & 63, part = tid_opaque() >> 6;
    float a = 0.f;
    const int i0 = seg * 128 + part * 32;
#pragma unroll 8
    for (int i = i0; i < i0 + 32; ++i) a += p.pe[(size_t)lk * 2048 + i] * p.w1[((size_t)lk * 2048 + i) * 64 + j];
    float* red = (float*)smem;
    __syncthreads();
    red[part * 64 + j] = a;
    __syncthreads();
    if (part == 0) atomicAdd(p.CVEC() + lk * 64 + j, (red[j] + red[64 + j]) + (red[128 + j] + red[192 + j]));
    __syncthreads();
  }
  for (long idx = gtid; idx < 2L * NP; idx += gsz) {
    const int n = (int)(idx % NP), l = (int)(idx / NP); const int oc = orig_col(n);
    p.BIASP()[idx] = oc >= 0 ? p.b_in[l * 3988 + oc] : 0.f;
  }
  for (long idx = gtid; idx < (long)T * 32; idx += gsz) {
    const int t = (int)(idx / 32), i = (int)(idx % 32);
    const float inv = exp2f(-(float)i * (13.287712379549449f / 32.0f));
    const float ang = (float)t * inv;
    p.ROPEC()[idx] = cosf(ang); p.ROPES()[idx] = sinf(ang);
  }
  for (long idx = gtid; idx < 512; idx += gsz) {
    const int c = (int)(idx % 256), l = (int)(idx / 256);
    const float a = p.c_lb[c], b = p.c_lb[256 + c];
    const float m = fmaxf(a, b); const float ea = expf(a - m), eb = expf(b - m);
    p.LB()[idx] = l == 0 ? 0.f : eb / (ea + eb);
  }
}

DI void ln_rows(const Params& p, int mode, int layer, int bid, int nblk) {
  const int tid_ = tid_opaque(); const int lane = tid_ & 63, wid = tid_ >> 6, nw = 4;
  const float* g = mode == 0 ? p.ln0_g : p.ln_g + layer * 1024;
  const float* bb = mode == 0 ? p.ln0_b : p.ln_b + layer * 1024;
  const float* src = mode == 0 ? p.x : p.hf;
  for (int row = bid * nw + wid; row < NTOK; row += nblk * nw) {
    const float* s = src + (size_t)row * 1024;
    float4 v[4];
    float sum = 0.f;
#pragma unroll
    for (int i = 0; i < 4; ++i) { v[i] = *(const float4*)(s + i * 256 + lane * 4); sum += (v[i].x + v[i].y) + (v[i].z + v[i].w); }
    sum = wave_sum(sum);
    const float mu = sum * (1.f / 1024.f);
    float q = 0.f;
#pragma unroll
    for (int i = 0; i < 4; ++i) { float a = v[i].x - mu, b = v[i].y - mu, c = v[i].z - mu, d = v[i].w - mu; q += (a * a + b * b) + (c * c + d * d); }
    q = wave_sum(q);
    const float rs = rsqrtf(q * (1.f / 1024.f) + 1e-5f);
    if (mode == 0 && lane == 0) { p.LNS()[(size_t)row * 2] = mu; p.LNS()[(size_t)row * 2 + 1] = rs; }
#pragma unroll
    for (int i = 0; i < 4; ++i) {
      const int c0 = i * 256 + lane * 4;
      const float4 gg = *(const float4*)(g + c0), b4 = *(const float4*)(bb + c0);
      float4 o;
      o.x = (v[i].x - mu) * rs * gg.x + b4.x; o.y = (v[i].y - mu) * rs * gg.y + b4.y;
      o.z = (v[i].z - mu) * rs * gg.z + b4.z; o.w = (v[i].w - mu) * rs * gg.w + b4.w;
      if (mode != 0) *(float4*)(p.hf + (size_t)row * 1024 + c0) = o;
      uint2 pk; pk.x = (unsigned)f2bf(o.x) | ((unsigned)f2bf(o.y) << 16); pk.y = (unsigned)f2bf(o.z) | ((unsigned)f2bf(o.w) << 16);
      *(uint2*)(p.HB() + (size_t)row * 1024 + c0) = pk;
    }
  }
}

typedef float f32x2 __attribute__((ext_vector_type(2)));
typedef __bf16 bf16v2 __attribute__((ext_vector_type(2)));
typedef unsigned u32x2 __attribute__((ext_vector_type(2)));
DI unsigned pack2(float a, float b) { f32x2 v = {a, b}; return __builtin_bit_cast(unsigned, __builtin_convertvector(v, bf16v2)); }
DI f32x16 zero16() { f32x16 z;
#pragma unroll
  for (int i = 0; i < 16; ++i) z[i] = 0.f; return z; }
DI bf16x8 ld_frag8x2(const bf16_t* p) { const u32x2 lo = *(const u32x2*)p, hi = *(const u32x2*)(p + 8); u32x4 t = {lo.x, lo.y, hi.x, hi.y}; return __builtin_bit_cast(bf16x8, t); }
template <int BASE> DI bf16x8 pack8(const f32x16& s) {
  u32x4 t = {pack2(s[BASE + 0], s[BASE + 1]), pack2(s[BASE + 2], s[BASE + 3]), pack2(s[BASE + 4], s[BASE + 5]), pack2(s[BASE + 6], s[BASE + 7])};
  return __builtin_bit_cast(bf16x8, t);
}
DI int crow(int r, int h2) { return (r & 3) + 8 * (r >> 2) + 4 * h2; }
#define MFMA32(a, b, c) __builtin_amdgcn_mfma_f32_32x32x16_bf16((a), (b), (c), 0, 0, 0)
#define LAS __attribute__((address_space(3)))
enum { K_NONE = 0, K_ROPE, K_PLAIN, K_TR, K_GSILU, K_GSIG, K_SILUH, K_LOGF, K_SMALL };
namespace g8 {
constexpr int BK = 64, HALF = 128, HT = HALF * BK;
DI int lds_byte(int r, int c) { const int st = (r >> 4) * 2 + (c >> 5), rr = r & 15, cc = c & 31, ob = rr * 64 + cc * 2; return st * 1024 + (ob ^ (((ob >> 9) & 1) << 5)); }
DI void stage_rc(int b, int& R, int& C) { const int st = b / 1024, sb = b % 1024, swz = sb ^ (((sb >> 9) & 1) << 5); R = (st >> 1) * 16 + swz / 64; C = (st & 1) * 32 + (swz % 64) / 2; }
}
DI void gemm256_mainloop(const bf16_t* A, const bf16_t* Bt, bf16_t* shm, f32x4 (&acc)[2][2][4][2]) {
  using namespace g8;
  constexpr int K = 1024;
#define SA(b, h) (shm + ((b) * 2 + (h)) * HT)
#define SB(b, h) (shm + (4 + (b) * 2 + (h)) * HT)
#define STAGE(P, BASE, br, kt) do { const long g_ = (long)(br) * K + (long)(kt) * BK; \
    _Pragma("unroll") for (int i_ = 0; i_ < 2; ++i_) { const int b_ = tidf * 16 + i_ * 8192; int r_, c_; stage_rc(b_, r_, c_); \
      __builtin_amdgcn_global_load_lds((const unsigned*)((BASE) + g_ + (long)r_ * K + c_), (LAS unsigned*)((char*)(P) + b_), 16, 0, 0); } } while (0)
#define LDA(dst, b, h) _Pragma("unroll") for (int m = 0; m < 4; ++m) _Pragma("unroll") for (int k = 0; k < 2; ++k) \
    dst[m][k] = *reinterpret_cast<const bf16x8*>((const char*)SA(b, h) + lds_byte(wr * 64 + m * 16 + fr, k * 32 + fq * 8))
#define LDB(dst, b, h) _Pragma("unroll") for (int n = 0; n < 2; ++n) _Pragma("unroll") for (int k = 0; k < 2; ++k) \
    dst[n][k] = *reinterpret_cast<const bf16x8*>((const char*)SB(b, h) + lds_byte(wc * 32 + n * 16 + fr, k * 32 + fq * 8))
#define MMA(ai, bj, At_, Bt_) do { __builtin_amdgcn_s_setprio(1); \
    _Pragma("unroll") for (int m = 0; m < 4; ++m) _Pragma("unroll") for (int n = 0; n < 2; ++n) _Pragma("unroll") for (int k = 0; k < 2; ++k) \
      acc[ai][bj][m][n] = __builtin_amdgcn_mfma_f32_16x16x32_bf16(Bt_[n][k], At_[m][k], acc[ai][bj][m][n], 0, 0, 0); \
    __builtin_amdgcn_s_setprio(0); } while (0)
#define WAIT_V(n) asm volatile("s_waitcnt vmcnt(" #n ")" ::: "memory")
#define WAIT_L(n) asm volatile("s_waitcnt lgkmcnt(" #n ")" ::: "memory")
#define BAR __builtin_amdgcn_s_barrier()
#define SCHED __builtin_amdgcn_sched_barrier(0)
  int tidf = threadIdx.x; asm volatile("" : "+v"(tidf));
  const int wid = tidf >> 6, lane = tidf & 63, wr = wid >> 2, wc = wid & 3, fr = lane & 15, fq = lane >> 4;
#pragma unroll
  for (int a = 0; a < 2; ++a)
#pragma unroll
    for (int b = 0; b < 2; ++b)
#pragma unroll
      for (int m = 0; m < 4; ++m)
#pragma unroll
        for (int n = 0; n < 2; ++n) acc[a][b][m][n] = (f32x4){0.f, 0.f, 0.f, 0.f};
  bf16x8 At[4][2], B0[2][2], B1[2][2];
  constexpr int nt = K / BK;
  WAIT_V(0);
  STAGE(SB(0, 0), Bt, 0, 0); STAGE(SA(0, 0), A, 0, 0);
  STAGE(SB(0, 1), Bt, HALF, 0); STAGE(SA(0, 1), A, HALF, 0);
  if (wr == 1) BAR;
  WAIT_V(4); BAR;
  STAGE(SB(1, 0), Bt, 0, 1); STAGE(SA(1, 0), A, 0, 1); STAGE(SB(1, 1), Bt, HALF, 1);
  WAIT_V(6); BAR;
  for (int t = 0; t < nt - 2; t += 2) {
    LDB(B0, 0, 0); SCHED; LDA(At, 0, 0); STAGE(SA(1, 1), A, HALF, t + 1);
    WAIT_L(8); BAR; WAIT_L(0); MMA(0, 0, At, B0); BAR; SCHED;
    LDB(B1, 0, 1); STAGE(SB(0, 0), Bt, 0, t + 2);
    BAR; WAIT_L(0); MMA(0, 1, At, B1); BAR;
    LDA(At, 0, 1); STAGE(SA(0, 0), A, 0, t + 2);
    BAR; WAIT_L(0); MMA(1, 0, At, B0); BAR; SCHED;
    STAGE(SB(0, 1), Bt, HALF, t + 2);
    WAIT_V(6); BAR; MMA(1, 1, At, B1); BAR;
    LDB(B0, 1, 0); SCHED; LDA(At, 1, 0); STAGE(SA(0, 1), A, HALF, t + 2);
    WAIT_L(8); BAR; WAIT_L(0); MMA(0, 0, At, B0); BAR; SCHED;
    LDB(B1, 1, 1); STAGE(SB(1, 0), Bt, 0, t + 3);
    BAR; WAIT_L(0); MMA(0, 1, At, B1); BAR;
    LDA(At, 1, 1); STAGE(SA(1, 0), A, 0, t + 3);
    BAR; WAIT_L(0); MMA(1, 0, At, B0); BAR; SCHED;
    STAGE(SB(1, 1), Bt, HALF, t + 3);
    WAIT_V(6); BAR; MMA(1, 1, At, B1); BAR;
  }
  { LDB(B0, 0, 0); LDA(At, 0, 0); STAGE(SA(1, 1), A, HALF, nt - 1);
    BAR; WAIT_L(0); MMA(0, 0, At, B0); BAR;
    LDB(B1, 0, 1); BAR; WAIT_L(0); MMA(0, 1, At, B1); BAR;
    LDA(At, 0, 1); WAIT_V(4); BAR; WAIT_L(0); MMA(1, 0, At, B0); MMA(1, 1, At, B1); BAR; }
  { LDB(B0, 1, 0); LDA(At, 1, 0); WAIT_V(2); BAR; WAIT_L(0); MMA(0, 0, At, B0); BAR;
    LDB(B1, 1, 1); WAIT_V(0); BAR; WAIT_L(0); MMA(0, 1, At, B1); BAR;
    LDA(At, 1, 1); BAR; WAIT_L(0); MMA(1, 0, At, B0); MMA(1, 1, At, B1); BAR; }
  if (wr == 0) BAR;
#undef SA
#undef SB
#undef STAGE
#undef LDA
#undef LDB
#undef MMA
#undef WAIT_V
#undef WAIT_L
#undef BAR
#undef SCHED
}

DI void classify_head(const Params& p, int hd, int b, int& kind, bf16_t*& dst, float*& fdst, float& scale) {
  kind = K_NONE; dst = nullptr; fdst = nullptr; scale = 1.f;
  if (hd < 4) { kind = K_ROPE; dst = p.QA() + ((size_t)(b * 4 + hd) * T) * 64; scale = 0.125f * 1.4426950408889634f; }
  else if (hd < 6) { kind = K_ROPE; dst = p.KA() + ((size_t)(b * 2 + hd - 4) * T) * 64; }
  else if (hd < 8) { kind = K_TR; dst = p.VAT() + (size_t)(b * 2 + hd - 6) * 64 * T; }
  else if (hd < 12) { kind = K_GSILU; dst = p.GZ() + (size_t)0 * NTOK * 256 + (hd - 8) * 64; }
  else if (hd < 20) { kind = K_PLAIN; dst = p.QKB() + ((size_t)(b * 8 + hd - 12) * T) * 64; }
  else if (hd < 24) { kind = K_TR; dst = p.VBT() + (size_t)(b * 4 + hd - 20) * 64 * T; }
  else if (hd < 28) { kind = K_GSIG; dst = p.GZ() + (size_t)1 * NTOK * 256 + (hd - 24) * 64; }
  else if (hd < 32) { kind = K_GSILU; dst = p.GZ() + (size_t)2 * NTOK * 256 + (hd - 28) * 64; }
  else if (hd < 36) { kind = K_SILUH; dst = p.QC() + ((size_t)(b * 4 + hd - 32) * T) * 64; }
  else if (hd < 40) { kind = K_LOGF; fdst = p.GC() + ((size_t)(b * 4 + hd - 36) * T) * 64; }
  else if (hd < 44) { kind = K_TR; dst = p.VCT() + (size_t)(b * 4 + hd - 40) * 64 * T; }
  else if (hd < 48) { kind = K_GSILU; dst = p.GZ() + (size_t)3 * NTOK * 256 + (hd - 44) * 64; }
  else if (hd < 52) { kind = K_ROPE; dst = p.QD() + ((size_t)(b * 4 + hd - 48) * T) * 64; scale = 0.125f * 1.4426950408889634f; }
  else if (hd < 58) {
    const int j = hd - 52;
    dst = p.KV() + (size_t)(j * NB + b) * T * 64;
    kind = (j == 0 || j == 1) ? K_PLAIN : ((j == 2 || j == 4) ? K_ROPE : K_TR);
  }
  else if (hd < 62) { kind = K_GSILU; dst = p.GZ() + (size_t)4 * NTOK * 256 + (hd - 58) * 64; }
  else if (hd == 62) { kind = K_SMALL; }
}

DI bool head_is_paired(int hd) { return hd < 6 || (hd >= 48 && hd < 52) || hd == 54 || hd == 56; }
template <int KIND>
DI void epi_direct(const Params& p, const f32x4 (&a)[4][2], bf16_t* dst, float* fdst, float scale, int layer, int hd, int b, int tq, int wr, int w, int fr, int fq) {
  if (KIND == K_ROPE) {
    const int c = 16 * w + 4 * fq;
    const f32x4 b0 = *(const f32x4*)(p.BIASP() + layer * NP + hd * 64 + c), b1 = *(const f32x4*)(p.BIASP() + layer * NP + hd * 64 + 32 + c);
#pragma unroll
    for (int m = 0; m < 4; ++m) {
      const int t = tq + wr * 64 + m * 16 + fr;
      const f32x4 cs = *(const f32x4*)(p.ROPEC() + t * 32 + c), sn = *(const f32x4*)(p.ROPES() + t * 32 + c);
      const f32x4 v0 = a[m][0] + b0, v1 = a[m][1] + b1;
      const f32x4 o0 = (v0 * cs - v1 * sn) * scale, o1 = (v0 * sn + v1 * cs) * scale;
      u32x2 w0 = {pack2(o0[0], o0[1]), pack2(o0[2], o0[3])}, w1 = {pack2(o1[0], o1[1]), pack2(o1[2], o1[3])};
      *(u32x2*)(dst + (size_t)t * 64 + c) = w0; *(u32x2*)(dst + (size_t)t * 64 + 32 + c) = w1;
    }
    return;
  }
  const int c = 32 * w + 8 * fq;
  const f32x4 b0 = *(const f32x4*)(p.BIASP() + layer * NP + hd * 64 + c), b1 = *(const f32x4*)(p.BIASP() + layer * NP + hd * 64 + c + 4);
  if (KIND == K_SMALL) {
#pragma unroll
    for (int m = 0; m < 4; ++m) {
      const size_t tok = (size_t)b * T + tq + wr * 64 + m * 16 + fr;
#pragma unroll
      for (int n = 0; n < 2; ++n)
#pragma unroll
        for (int j = 0; j < 4; ++j) {
          const int cc = c + 4 * n + j;
          const float v = a[m][n][j] + (n ? b1[j] : b0[j]);
          if (cc < 8) p.IFG()[tok * 8 + cc] = v;
          else if (cc < 20) p.DG()[tok * 12 + (cc - 8)] = sigmoidf_(v);
        }
    }
    return;
  }
  f32x4 lb0 = {0.f, 0.f, 0.f, 0.f}, lb1 = {0.f, 0.f, 0.f, 0.f};
  if (KIND == K_LOGF) { lb0 = *(const f32x4*)(p.LB() + layer * 256 + (hd - 36) * 64 + c); lb1 = *(const f32x4*)(p.LB() + layer * 256 + (hd - 36) * 64 + c + 4); }
#pragma unroll
  for (int m = 0; m < 4; ++m) {
    const int t = tq + wr * 64 + m * 16 + fr;
    const f32x4 v0 = a[m][0] + b0, v1 = a[m][1] + b1;
    if (KIND == K_LOGF) {
      f32x4 o0, o1;
#pragma unroll
      for (int j = 0; j < 4; ++j) { o0[j] = __logf(lb0[j] + (1.f - lb0[j]) * sigmoidf_(v0[j])); o1[j] = __logf(lb1[j] + (1.f - lb1[j]) * sigmoidf_(v1[j])); }
      *(f32x4*)(fdst + (size_t)t * 64 + c) = o0; *(f32x4*)(fdst + (size_t)t * 64 + c + 4) = o1;
    } else {
      f32x4 o0, o1;
#pragma unroll
      for (int j = 0; j < 4; ++j) {
        if (KIND == K_PLAIN) { o0[j] = v0[j]; o1[j] = v1[j]; }
        else if (KIND == K_SILUH || KIND == K_GSILU) { o0[j] = siluf_(v0[j]); o1[j] = siluf_(v1[j]); }
        else { o0[j] = sigmoidf_(v0[j]); o1[j] = sigmoidf_(v1[j]); }
      }
      u32x4 wv = {pack2(o0[0], o0[1]), pack2(o0[2], o0[3]), pack2(o1[0], o1[1]), pack2(o1[2], o1[3])};
      if (KIND == K_GSILU || KIND == K_GSIG) *(u32x4*)(dst + ((size_t)b * T + t) * 256 + c) = wv;
      else *(u32x4*)(dst + (size_t)t * 64 + c) = wv;
    }
  }
}
DI void epi_tr_write(const Params& p, const f32x4 (&a)[4][2], char* img, int layer, int hd, int wr, int w, int fr, int fq) {
  const int c = 32 * w + 8 * fq;
  const f32x4 b0 = *(const f32x4*)(p.BIASP() + layer * NP + hd * 64 + c), b1 = *(const f32x4*)(p.BIASP() + layer * NP + hd * 64 + c + 4);
  bf16_t* timg = (bf16_t*)img;
#pragma unroll
  for (int m = 0; m < 4; ++m)
#pragma unroll
    for (int n = 0; n < 2; ++n)
#pragma unroll
      for (int j = 0; j < 4; ++j) timg[(c + 4 * n + j) * 128 + wr * 64 + m * 16 + fr] = f2bf(a[m][n][j] + (n ? b1[j] : b0[j]));
}
DI void gemm_in_quadrant(const Params& p, int layer, int panel, int pn, int ai, int bj, const f32x4 (&a)[4][2], char* shm,
                         int b, int hq, int tid2, int wr, int wc, int fr, int fq) {
  const int tq = (panel & 7) * 256 + ai * 128;
  const int hd0 = pn * 4 + bj * 2;
  const int hd = hd0 + (wc >> 1), w = wc & 1;
  int kind; bf16_t* dst; float* fdst; float scale;
  classify_head(p, hd, b, kind, dst, fdst, scale);
  switch (kind) {
    case K_ROPE: epi_direct<K_ROPE>(p, a, dst, fdst, scale, layer, hd, b, tq, wr, w, fr, fq); break;
    case K_PLAIN: epi_direct<K_PLAIN>(p, a, dst, fdst, scale, layer, hd, b, tq, wr, w, fr, fq); break;
    case K_GSILU: epi_direct<K_GSILU>(p, a, dst, fdst, scale, layer, hd, b, tq, wr, w, fr, fq); break;
    case K_GSIG: epi_direct<K_GSIG>(p, a, dst, fdst, scale, layer, hd, b, tq, wr, w, fr, fq); break;
    case K_SILUH: epi_direct<K_SILUH>(p, a, dst, fdst, scale, layer, hd, b, tq, wr, w, fr, fq); break;
    case K_LOGF: epi_direct<K_LOGF>(p, a, dst, fdst, scale, layer, hd, b, tq, wr, w, fr, fq); break;
    case K_SMALL: epi_direct<K_SMALL>(p, a, dst, fdst, scale, layer, hd, b, tq, wr, w, fr, fq); break;
    default: break;
  }
  int k0, k1; { bf16_t* d_; float* f_; float s_; classify_head(p, hd0, b, k0, d_, f_, s_); classify_head(p, hd0 + 1, b, k1, d_, f_, s_); }
  if (k0 == K_TR || k1 == K_TR) {
    if (kind == K_TR) epi_tr_write(p, a, shm + (wc >> 1) * 16384, layer, hd, wr, w, fr, fq);
    __syncthreads();
    int kq; bf16_t* dq; float* fq_; float sq; classify_head(p, hd0 + hq, b, kq, dq, fq_, sq);
    if (kq == K_TR) {
      const char* img = shm + hq * 16384;
#pragma unroll
      for (int i = 0; i < 4; ++i) { const int q = tid2 + 256 * i, cc = q >> 4, rc = q & 15; *(u32x4*)(dq + (size_t)cc * T + tq + rc * 8) = *(const u32x4*)(img + q * 16); }
    }
    __syncthreads();
  }
}
DI void gemm_in_epilogue(const Params& p, int layer, int panel, int pn, const f32x4 (&acc)[2][2][4][2], char* shm) {
  int tidf = threadIdx.x; asm volatile("" : "+v"(tidf));
  const int wid = tidf >> 6, lane = tidf & 63, wr = wid >> 2, wc = wid & 3, fr = lane & 15, fq = lane >> 4;
  const int b = panel >> 3;
  const int hq = __builtin_amdgcn_readfirstlane(tidf >> 8), tid2 = tidf & 255;
  __syncthreads();
  gemm_in_quadrant(p, layer, panel, pn, 0, 0, acc[0][0], shm, b, hq, tid2, wr, wc, fr, fq);
  gemm_in_quadrant(p, layer, panel, pn, 0, 1, acc[0][1], shm, b, hq, tid2, wr, wc, fr, fq);
  gemm_in_quadrant(p, layer, panel, pn, 1, 0, acc[1][0], shm, b, hq, tid2, wr, wc, fr, fq);
  gemm_in_quadrant(p, layer, panel, pn, 1, 1, acc[1][1], shm, b, hq, tid2, wr, wc, fr, fq);
}
DI void gemm_out_epilogue(const Params& p, int panel, int pn, const f32x4 (&acc)[2][2][4][2], char* shm) {
  int tidf = threadIdx.x; asm volatile("" : "+v"(tidf));
  const int wid = tidf >> 6, lane = tidf & 63, wr = wid >> 2, wc = wid & 3, fr = lane & 15, fq = lane >> 4;
#pragma unroll
  for (int ai = 0; ai < 2; ++ai)
#pragma unroll
    for (int m = 0; m < 4; ++m) {
      const size_t row = (size_t)(panel * 256 + ai * 128 + wr * 64 + m * 16 + fr);
#pragma unroll
      for (int bj = 0; bj < 2; ++bj)
#pragma unroll
        for (int n = 0; n < 2; ++n) {
          const int col = pn * 256 + bj * 128 + wc * 32 + n * 16 + fq * 4;
          const u32x2 hb = *(const u32x2*)(p.HB() + row * 1024 + col);
          const f32x4 h = {__uint_as_float(hb[0] << 16), __uint_as_float(hb[0] & 0xffff0000u), __uint_as_float(hb[1] << 16), __uint_as_float(hb[1] & 0xffff0000u)};
          *(f32x4*)(p.hf + row * 1024 + col) = DN_ALPHA * h + acc[ai][bj][m][n];
        }
    }
}
DI void ph_gemm_in(const Params& p, int layer, int bid, int nblk, char* shm) {
  asm volatile("" : "+s"(bid));
  if (nblk == 256) {
    const int x = bid & 7, c = bid >> 3;
    for (int g = 0; g < 4; ++g) {
      const int panel = 32 * x + 8 * g + (c & 7);
      const bf16_t* A = p.HB() + (size_t)panel * 256 * 1024;
      for (int s = 0; s < 4; ++s) {
        const int pn = (c >> 3) + 4 * s;
        f32x4 acc[2][2][4][2];
        gemm256_mainloop(A, p.WT() + ((size_t)layer * NP + pn * 256) * 1024, (bf16_t*)shm, acc);
        if (PROBE == 6) { __syncthreads(); gemm256_mainloop(A, p.WT() + ((size_t)layer * NP + pn * 256) * 1024, (bf16_t*)shm, acc); }
        gemm_in_epilogue(p, layer, panel, pn, acc, shm);
        if (PROBE == 7) gemm_in_epilogue(p, layer, panel, pn, acc, shm);
      }
    }
    return;
  }
  for (int panel = bid; panel < 256; panel += nblk) {
    const bf16_t* A = p.HB() + (size_t)panel * 256 * 1024;
    for (int pn = 0; pn < 16; ++pn) {
      f32x4 acc[2][2][4][2];
      gemm256_mainloop(A, p.WT() + ((size_t)layer * NP + pn * 256) * 1024, (bf16_t*)shm, acc);
      gemm_in_epilogue(p, layer, panel, pn, acc, shm);
    }
  }
}
DI void ph_gemm_out_ln(const Params& p, int layer, int bid, int nblk, char* shm) {
  asm volatile("" : "+s"(bid));
  for (int panel = bid; panel < 256; panel += nblk) {
    const bf16_t* A = p.YMIX() + (size_t)panel * 256 * 1024;
    for (int pn = 0; pn < 4; ++pn) {
      f32x4 acc[2][2][4][2];
      gemm256_mainloop(A, p.WOT() + ((size_t)layer * 1024 + pn * 256) * 1024, (bf16_t*)shm, acc);
      gemm_out_epilogue(p, panel, pn, acc, shm);
    }
    asm volatile("s_waitcnt vmcnt(0)" ::: "memory");
    __syncthreads();
    int tidf = threadIdx.x; asm volatile("" : "+v"(tidf));
    const int lane = tidf & 63, wid = tidf >> 6;
    const float* g = p.ln_g + layer * 1024; const float* bb = p.ln_b + layer * 1024;
    for (int rr = 0; rr < 32; ++rr) {
      const int row = panel * 256 + wid * 32 + rr;
      float* s = p.hf + (size_t)row * 1024;
      f32x4 v[4];
      float sum = 0.f;
#pragma unroll
      for (int i = 0; i < 4; ++i) { v[i] = *(const f32x4*)(s + i * 256 + lane * 4); sum += (v[i][0] + v[i][1]) + (v[i][2] + v[i][3]); }
      sum = wave_sum(sum);
      const float mu = sum * (1.f / 1024.f);
      float q = 0.f;
#pragma unroll
      for (int i = 0; i < 4; ++i) { const f32x4 d = v[i] - mu; q += (d[0] * d[0] + d[1] * d[1]) + (d[2] * d[2] + d[3] * d[3]); }
      q = wave_sum(q);
      const float rs = rsqrtf(q * (1.f / 1024.f) + 1e-5f);
#pragma unroll
      for (int i = 0; i < 4; ++i) {
        const int cc = i * 256 + lane * 4;
        const f32x4 gg = *(const f32x4*)(g + cc), b4 = *(const f32x4*)(bb + cc);
        const f32x4 o = (v[i] - mu) * rs * gg + b4;
        if (layer == 0) { u32x2 pk = {pack2(o[0], o[1]), pack2(o[2], o[3])}; *(u32x2*)(p.HB() + (size_t)row * 1024 + cc) = pk; }
        else *(f32x4*)(s + cc) = o;
      }
    }
  }
}

DI f32x16 qk_tile(const bf16_t* Krow, const bf16x8 (&qf)[4], int l31, int h2) {
  f32x16 s = zero16();
  const bf16_t* kp = Krow + l31 * 64 + h2 * 8;
#pragma unroll
  for (int ks = 0; ks < 4; ++ks) { const bf16x8 a = *(const bf16x8*)(kp + ks * 16); s = MFMA32(a, qf[ks], s); }
  return s;
}
DI f32x16 qk_tile_s(const bf16_t* Krow, int stride, const bf16x8 (&qf)[4], int l31, int h2) {
  f32x16 s = zero16();
  const bf16_t* kp = Krow + l31 * stride + h2 * 8;
#pragma unroll
  for (int ks = 0; ks < 4; ++ks) { const bf16x8 a = *(const bf16x8*)(kp + ks * 16); s = MFMA32(a, qf[ks], s); }
  return s;
}
template <bool HAS_SEL>
DI void softmax_pv_t(f32x16& s, const bf16_t* VTp, int vstride, f32x16 (&o)[2], float& m, float& l, int l31, int h2, bool sel) {
  bf16x8 va[2][2];
#pragma unroll
  for (int dt = 0; dt < 2; ++dt)
#pragma unroll
    for (int sk = 0; sk < 2; ++sk) va[dt][sk] = ld_frag8x2(VTp + (size_t)(dt * 32 + l31) * vstride + sk * 16 + 4 * h2);
  float mx = s[0];
#pragma unroll
  for (int r = 1; r < 16; ++r) mx = fmaxf(mx, s[r]);
  if (HAS_SEL) mx = sel ? mx : -INFINITY;
  mx = xhalf_max(mx);
  const float mn = fmaxf(m, mx);
  const float alpha = __builtin_amdgcn_exp2f(m - mn);
  const float mref = (HAS_SEL && !sel) ? INFINITY : mn;
  float ps = 0.f;
#pragma unroll
  for (int r = 0; r < 16; ++r) { s[r] = __builtin_amdgcn_exp2f(s[r] - mref); ps += s[r]; }
  l = l * alpha + ps; m = mn;
#pragma unroll
  for (int dt = 0; dt < 2; ++dt)
#pragma unroll
    for (int r = 0; r < 16; ++r) o[dt][r] *= alpha;
  const bf16x8 p0 = pack8<0>(s), p1 = pack8<8>(s);
#pragma unroll
  for (int dt = 0; dt < 2; ++dt) { o[dt] = MFMA32(va[dt][0], p0, o[dt]); o[dt] = MFMA32(va[dt][1], p1, o[dt]); }
}
DI void softmax_pv(f32x16& s, const bf16_t* VTp, int vstride, f32x16 (&o)[2], float& m, float& l, int l31, int h2) { softmax_pv_t<false>(s, VTp, vstride, o, m, l, l31, h2, true); }

constexpr int AD_KSTR = 72, AD_VSTR = 68;
constexpr int AD_BUF = 64 * AD_KSTR * 2 + 64 * AD_VSTR * 2;
struct AdTile { u32x4 k, v; };
DI AdTile ad_load(const bf16_t* Kg, const bf16_t* Vg, int key0, int tidf) {
  AdTile r; const int row = tidf >> 3, ch = tidf & 7;
  r.k = *(const u32x4*)(Kg + (size_t)(key0 + row) * 64 + ch * 8);
  r.v = *(const u32x4*)(Vg + (size_t)row * T + key0 + ch * 8);
  return r;
}
DI void ad_store(const AdTile& r, char* buf, int tidf) {
  const int row = tidf >> 3, ch = tidf & 7;
  *(u32x4*)(buf + (row * AD_KSTR + ch * 8) * 2) = r.k;
  char* vp = buf + 64 * AD_KSTR * 2 + (row * AD_VSTR + ch * 8) * 2;
  *(u32x2*)vp = (u32x2){r.v[0], r.v[1]}; *(u32x2*)(vp + 8) = (u32x2){r.v[2], r.v[3]};
}
DI void ph_attnD(const Params& p, int layer, int* ctr, char* smem, int* s_pair) {
  float* imps = (float*)smem;
  float* impf = (float*)(smem + 34816);
  unsigned* smask = (unsigned*)(smem + 43008);
  unsigned* s_union = (unsigned*)(smem + 43008 + 256);
  char* kvbuf = smem + 49152;
  int tidf = threadIdx.x; asm volatile("" : "+v"(tidf));
  const int lane = tidf & 63, wid = tidf >> 6, h = wid & 3, qs = wid >> 2, l31 = lane & 31, h2 = lane >> 5;
  for (;;) {
    __syncthreads();
    if (tidf == 0) { *s_pair = atomicAdd(ctr, 1); *s_union = 0u; }
    __syncthreads();
    const int it = *s_pair;
    if (it >= 1024) break;
    const int b = it & 31, q0 = (31 - (it >> 5)) * 64;
    const int qw = q0 + 32 * qs;
    const int t = qw + l31, cur = q0 >> 6;
    const size_t tok = (size_t)b * T + t;
    bf16x8 qf[4];
    {
      const bf16_t* qp = p.QD() + ((size_t)(b * 4 + h) * T + t) * 64 + h2 * 8;
#pragma unroll
      for (int ks = 0; ks < 4; ++ks) qf[ks] = *(const bf16x8*)(qp + ks * 16);
    }
    const float g0 = p.DG()[tok * 12 + h * 3 + 0], g1 = p.DG()[tok * 12 + h * 3 + 1], g2 = p.DG()[tok * 12 + h * 3 + 2];
    f32x16 ofin[2];
    {
      const bf16_t* Kc = p.KCMP() + (size_t)b * 128 * 64;
      const bf16_t* Vc = p.VCMPT() + (size_t)b * 64 * 128;
      const int nkt = min(4, (qw >> 9) + 1);
      f32x16 o[2]; o[0] = zero16(); o[1] = zero16();
      float m = -1e30f, l = 0.f;
      for (int kt = 0; kt < nkt; ++kt) {
        f32x16 s = qk_tile(Kc + kt * 32 * 64, qf, l31, h2);
#pragma unroll
        for (int r = 0; r < 16; ++r) { const int n = kt * 32 + crow(r, h2); if (16 * n + 31 > t) s[r] = -INFINITY; }
        softmax_pv(s, Vc + kt * 32, 128, o, m, l, l31, h2);
      }
      l = xhalf_sum(l);
      const float il = l > 0.f ? 1.f / l : 0.f;
      const float gi = g0 * il;
#pragma unroll
      for (int dt = 0; dt < 2; ++dt)
#pragma unroll
        for (int r = 0; r < 16; ++r) ofin[dt][r] = gi * o[dt][r];
      float carry = 0.f;
#pragma unroll
      for (int kt = 0; kt < 4; ++kt) {
        f32x16 s;
        if (kt < nkt) {
          s = qk_tile(Kc + kt * 32 * 64, qf, l31, h2);
#pragma unroll
          for (int r = 0; r < 16; ++r) { const int n = kt * 32 + crow(r, h2); s[r] = (16 * n + 31 > t) ? 0.f : __builtin_amdgcn_exp2f(s[r] - m) * il; }
        } else s = zero16();
        float X[4];
#pragma unroll
        for (int g = 0; g < 4; ++g) X[g] = shx(s[4 * g + 3], 32);
#pragma unroll
        for (int g = 0; g < 4; ++g) {
          const float G = (s[4 * g] + s[4 * g + 1]) + (s[4 * g + 2] + s[4 * g + 3]);
          const float prev_other = g > 0 ? X[g - 1] : carry;
          imps[(wid * 32 + l31) * 33 + 8 * kt + 2 * g + h2] = G + (h2 ? X[g] : prev_other);
        }
        carry = X[3];
      }
    }
    __syncthreads();
    {
      const int tt = tidf >> 3, jg = tidf & 7, wq = (tt >> 5) * 4, tl = tt & 31;
#pragma unroll
      for (int i = 0; i < 4; ++i) {
        const int j = jg * 4 + i;
        impf[tt * 32 + j] = (imps[((wq + 0) * 32 + tl) * 33 + j] + imps[((wq + 1) * 32 + tl) * 33 + j]) + (imps[((wq + 2) * 32 + tl) * 33 + j] + imps[((wq + 3) * 32 + tl) * 33 + j]);
      }
    }
    __syncthreads();
    {
      const int tt = tidf >> 3, jg = tidf & 7;
      float v[32];
#pragma unroll
      for (int j = 0; j < 32; ++j) {
        float x = impf[tt * 32 + j];
        if (j > cur) x = -1e30f; else if (j == 0 || j == cur || j == cur - 1) x = 1e6f;
        v[j] = x;
      }
      unsigned bits = 0u;
#pragma unroll
      for (int i = 0; i < 4; ++i) {
        int rank = 0; float vj = 0.f;
#pragma unroll
        for (int j = 0; j < 32; ++j) if (j == jg * 4 + i) vj = v[j];
        const int jj = jg * 4 + i;
#pragma unroll
        for (int j = 0; j < 32; ++j) rank += (v[j] > vj || (v[j] == vj && j < jj)) ? 1 : 0;
        if (rank < 8 && jj <= cur) bits |= 1u << jj;
      }
      bits |= shx(bits, 1); bits |= shx(bits, 2); bits |= shx(bits, 4);
      if (jg == 0) { smask[tt] = bits; atomicOr(s_union, bits); }
    }
    __syncthreads();
    {
      const unsigned mymask = smask[32 * qs + l31];
      unsigned rem = *s_union;
      const bf16_t* Ks = p.KV() + (size_t)(2 * NB + b) * T * 64;
      const bf16_t* Vs = p.KV() + (size_t)(3 * NB + b) * 64 * T;
      f32x16 o[2]; o[0] = zero16(); o[1] = zero16();
      float m = -1e30f, l = 0.f;
      int j = __builtin_ctz(rem); rem &= rem - 1;
      { const AdTile r = ad_load(Ks, Vs, j * 64, tidf); ad_store(r, kvbuf, tidf); }
      __syncthreads();
      int pb = 0;
      for (;;) {
        const bool more = rem != 0u;
        const int jn = more ? __builtin_ctz(rem) : 0;
        AdTile nx;
        if (more) nx = ad_load(Ks, Vs, jn * 64, tidf);
        const char* buf = kvbuf + pb * AD_BUF;
        const bool sel = (mymask >> j) & 1u;
#pragma unroll
        for (int kh = 0; kh < 2; ++kh) {
          const int key0 = j * 64 + kh * 32;
          if (key0 <= qw + 31) {
            f32x16 s = qk_tile_s((const bf16_t*)buf + kh * 32 * AD_KSTR, AD_KSTR, qf, l31, h2);
            if (j == cur) {
#pragma unroll
              for (int r = 0; r < 16; ++r) { const int key = key0 + crow(r, h2); if (key > t) s[r] = -INFINITY; }
            }
            softmax_pv_t<true>(s, (const bf16_t*)(buf + 64 * AD_KSTR * 2) + kh * 32, AD_VSTR, o, m, l, l31, h2, sel);
          }
        }
        if (more) ad_store(nx, kvbuf + (pb ^ 1) * AD_BUF, tidf);
        __syncthreads();
        if (!more) break;
        rem &= rem - 1; j = jn; pb ^= 1;
      }
      l = xhalf_sum(l);
      const float il = l > 0.f ? g1 / l : 0.f;
#pragma unroll
      for (int dt = 0; dt < 2; ++dt)
#pragma unroll
        for (int r = 0; r < 16; ++r) ofin[dt][r] += il * o[dt][r];
    }
    {
      const bf16_t* Kw = p.KV() + (size_t)(4 * NB + b) * T * 64;
      const bf16_t* Vw = p.KV() + (size_t)(5 * NB + b) * 64 * T;
      f32x16 o[2]; o[0] = zero16(); o[1] = zero16();
      float m = -1e30f, l = 0.f;
      int k0 = max(0, q0 - 512);
      { const AdTile r = ad_load(Kw, Vw, k0, tidf); ad_store(r, kvbuf, tidf); }
      __syncthreads();
      int pb = 0;
      for (;;) {
        const bool more = k0 + 64 <= q0;
        AdTile nx;
        if (more) nx = ad_load(Kw, Vw, k0 + 64, tidf);
        const char* buf = kvbuf + pb * AD_BUF;
#pragma unroll
        for (int kh = 0; kh < 2; ++kh) {
          const int key0 = k0 + kh * 32;
          if (key0 <= qw + 31 && key0 + 31 + 512 > qw) {
            f32x16 s = qk_tile_s((const bf16_t*)buf + kh * 32 * AD_KSTR, AD_KSTR, qf, l31, h2);
            if (key0 + 31 > qw || key0 + 512 <= qw + 31) {
#pragma unroll
              for (int r = 0; r < 16; ++r) { const int key = key0 + crow(r, h2); if (key > t || t - key >= 512) s[r] = -INFINITY; }
            }
            softmax_pv(s, (const bf16_t*)(buf + 64 * AD_KSTR * 2) + kh * 32, AD_VSTR, o, m, l, l31, h2);
          }
        }
        if (more) ad_store(nx, kvbuf + (pb ^ 1) * AD_BUF, tidf);
        __syncthreads();
        if (!more) break;
        k0 += 64; pb ^= 1;
      }
      l = xhalf_sum(l);
      const float il = l > 0.f ? g2 / l : 0.f;
#pragma unroll
      for (int dt = 0; dt < 2; ++dt)
#pragma unroll
        for (int r = 0; r < 16; ++r) ofin[dt][r] += il * o[dt][r];
    }
#pragma unroll
    for (int dt = 0; dt < 2; ++dt)
#pragma unroll
      for (int g = 0; g < 4; ++g) {
        const int d0 = dt * 32 + 8 * g + 4 * h2;
        const u32x2 gz = *(const u32x2*)(p.GZ() + (size_t)4 * NTOK * 256 + tok * 256 + h * 64 + d0);
        const float z0 = __uint_as_float(gz.x << 16), z1 = __uint_as_float(gz.x & 0xffff0000u), z2 = __uint_as_float(gz.y << 16), z3 = __uint_as_float(gz.y & 0xffff0000u);
        u32x2 o2 = {pack2(ofin[dt][4 * g] * z0, ofin[dt][4 * g + 1] * z1), pack2(ofin[dt][4 * g + 2] * z2, ofin[dt][4 * g + 3] * z3)};
        *(u32x2*)(p.YMIX() + tok * 1024 + 768 + h * 64 + d0) = o2;
      }
  }
}


struct AaTile { u32x4 k0, v0, k1, v1; };
DI AaTile aa_load(const bf16_t* Kg, const bf16_t* Vg, int key0, int tidf) {
  AaTile r; const int row = tidf >> 3, ch = tidf & 7;
  r.k0 = *(const u32x4*)(Kg + (size_t)(key0 + row) * 64 + ch * 8);
  r.v0 = *(const u32x4*)(Vg + (size_t)row * T + key0 + ch * 8);
  r.k1 = *(const u32x4*)(Kg + (size_t)T * 64 + (size_t)(key0 + row) * 64 + ch * 8);
  r.v1 = *(const u32x4*)(Vg + (size_t)T * 64 + (size_t)row * T + key0 + ch * 8);
  return r;
}
DI void aa_store(const AaTile& r, char* buf, int tidf) {
  AdTile a; a.k = r.k0; a.v = r.v0; ad_store(a, buf, tidf);
  a.k = r.k1; a.v = r.v1; ad_store(a, buf + AD_BUF, tidf);
}
DI void ph_attnA_fb(const Params& p, int layer, int item, char* smem) {
  int tidf = threadIdx.x; asm volatile("" : "+v"(tidf));
  const int lane = tidf & 63, wid = tidf >> 6, h = wid & 3, qs = wid >> 2, l31 = lane & 31, h2 = lane >> 5, g = h >> 1;
  const int b = item >> 5, q0 = (item & 31) * 64;
  const int qw = q0 + 32 * qs, t = qw + l31;
  const size_t tok = (size_t)b * T + t;
  bf16x8 qf[4];
  {
    const bf16_t* qp = p.QA() + ((size_t)(b * 4 + h) * T + t) * 64 + h2 * 8;
#pragma unroll
    for (int ks = 0; ks < 4; ++ks) qf[ks] = *(const bf16x8*)(qp + ks * 16);
  }
  const bf16_t* Kg = p.KA() + (size_t)(b * 2) * T * 64;
  const bf16_t* Vg = p.VAT() + (size_t)(b * 2) * 64 * T;
  f32x16 o[2]; o[0] = zero16(); o[1] = zero16();
  float m = -1e30f, l = 0.f;
  int k0 = max(0, q0 - 128);
  __syncthreads();
  { const AaTile r = aa_load(Kg, Vg, k0, tidf); aa_store(r, smem, tidf); }
  __syncthreads();
  int pb = 0;
  for (;;) {
    const bool more = k0 + 64 <= q0;
    AaTile nx;
    if (more) nx = aa_load(Kg, Vg, k0 + 64, tidf);
    const char* buf = smem + pb * (2 * AD_BUF) + g * AD_BUF;
#pragma unroll
    for (int kh = 0; kh < 2; ++kh) {
      const int key0 = k0 + kh * 32;
      if (key0 <= qw + 31 && key0 + 31 + 128 > qw) {
        f32x16 s = qk_tile_s((const bf16_t*)buf + kh * 32 * AD_KSTR, AD_KSTR, qf, l31, h2);
        if (key0 + 31 > qw || key0 + 128 <= qw + 31) {
#pragma unroll
          for (int r = 0; r < 16; ++r) { const int key = key0 + crow(r, h2); if (key > t || t - key >= 128) s[r] = -INFINITY; }
        }
        softmax_pv(s, (const bf16_t*)(buf + 64 * AD_KSTR * 2) + kh * 32, AD_VSTR, o, m, l, l31, h2);
      }
    }
    if (more) aa_store(nx, smem + (pb ^ 1) * (2 * AD_BUF), tidf);
    __syncthreads();
    if (!more) break;
    k0 += 64; pb ^= 1;
  }
  l = xhalf_sum(l);
  const float sink = p.a_sinks[layer * 4 + h] * 1.4426950408889634f;
  const float M = fmaxf(m, sink);
  const float sc = __builtin_amdgcn_exp2f(m - M);
  const float inv = sc / (l * sc + __builtin_amdgcn_exp2f(sink - M));
#pragma unroll
  for (int dt = 0; dt < 2; ++dt)
#pragma unroll
    for (int gq = 0; gq < 4; ++gq) {
      const int d0 = dt * 32 + 8 * gq + 4 * h2;
      const u32x2 gz = *(const u32x2*)(p.GZ() + tok * 256 + h * 64 + d0);
      const float z0 = __uint_as_float(gz.x << 16), z1 = __uint_as_float(gz.x & 0xffff0000u), z2 = __uint_as_float(gz.y << 16), z3 = __uint_as_float(gz.y & 0xffff0000u);
      u32x2 o2 = {pack2(o[dt][4 * gq] * inv * z0, o[dt][4 * gq + 1] * inv * z1), pack2(o[dt][4 * gq + 2] * inv * z2, o[dt][4 * gq + 3] * inv * z3)};
      *(u32x2*)(p.YMIX() + tok * 1024 + h * 64 + d0) = o2;
    }
}

DI float logsigmoidf_(float x) { return fminf(x, 0.f) - __logf(1.f + __expf(-fabsf(x))); }
DI void mlstm_gates(const Params& p, size_t tok0, int hh, float* bc, float* ig, int tid) {
  if (tid < 64) {
    const int s0 = 2 * tid;
    const float lf0 = logsigmoidf_(p.IFG()[(tok0 + s0) * 8 + 4 + hh]), lf1 = logsigmoidf_(p.IFG()[(tok0 + s0 + 1) * 8 + 4 + hh]);
    const float pair = lf0 + lf1;
    float x = pair;
#pragma unroll
    for (int off = 1; off < 64; off <<= 1) { const float y = shup(x, off); if (tid >= off) x += y; }
    const float excl = x - pair;
    bc[s0] = excl + lf0; bc[s0 + 1] = excl + pair;
    ig[s0] = p.IFG()[(tok0 + s0) * 8 + hh]; ig[s0 + 1] = p.IFG()[(tok0 + s0 + 1) * 8 + hh];
  }
}
DI void conv8(const bf16_t* raw, int t, int dg, const float (&cw)[4][8], const float (&cb)[8], float (&out)[8]) {
#pragma unroll
  for (int e = 0; e < 8; ++e) out[e] = cb[e];
#pragma unroll
  for (int j = 0; j < 4; ++j) {
    const int ts = t - 3 + j;
    if (ts >= 0) {
      const u32x4 row = *(const u32x4*)(raw + (size_t)ts * 64 + dg * 8);
#pragma unroll
      for (int e2 = 0; e2 < 4; ++e2) { out[2 * e2] += cw[j][2 * e2] * __uint_as_float(row[e2] << 16); out[2 * e2 + 1] += cw[j][2 * e2 + 1] * __uint_as_float(row[e2] & 0xffff0000u); }
    }
  }
#pragma unroll
  for (int e = 0; e < 8; ++e) out[e] = siluf_(out[e]);
}
DI void conv_rows_load(const bf16_t* raw, int tfirst, int dg, u32x4 (&r)[7]) {
#pragma unroll
  for (int j = 0; j < 7; ++j) {
    const int ts = tfirst + j;
    const u32x4 v = *(const u32x4*)(raw + (size_t)max(ts, 0) * 64 + dg * 8);
    r[j] = ts >= 0 ? v : (u32x4){0u, 0u, 0u, 0u};
  }
}
template <int I>
DI void conv_rows_compute(const u32x4 (&r)[7], const float (&cw)[4][8], const float (&cb)[8], float (&out)[8]) {
#pragma unroll
  for (int e = 0; e < 8; ++e) out[e] = cb[e];
#pragma unroll
  for (int j = 0; j < 4; ++j) {
    const u32x4 row = r[I + j];
#pragma unroll
    for (int e2 = 0; e2 < 4; ++e2) { out[2 * e2] += cw[j][2 * e2] * __uint_as_float(row[e2] << 16); out[2 * e2 + 1] += cw[j][2 * e2 + 1] * __uint_as_float(row[e2] & 0xffff0000u); }
  }
#pragma unroll
  for (int e = 0; e < 8; ++e) out[e] = siluf_(out[e]);
}
DI void load_conv_w(const Params& p, int layer, int ch0, int dg, float (&cw)[4][8], float (&cb)[8]) {
#pragma unroll
  for (int j = 0; j < 4; ++j)
#pragma unroll
    for (int e = 0; e < 8; ++e) cw[j][e] = p.conv_w[layer * 2048 + j * 512 + ch0 + dg * 8 + e];
#pragma unroll
  for (int e = 0; e < 8; ++e) cb[e] = p.conv_b[layer * 512 + ch0 + dg * 8 + e];
}
DI void delta_state_loadA(const bf16_t* VT, bf16x8 (&a)[8], int wid, int l31, int h2) {
  const int mt = wid >> 1;
#pragma unroll
  for (int ks = 0; ks < 8; ++ks) a[ks] = *(const bf16x8*)(VT + (size_t)(mt * 32 + l31) * T + ks * 16 + h2 * 8);
}
DI void delta_state(const bf16x8 (&a)[8], const bf16_t* KT, float* out, int wid, int l31, int h2) {
  const int mt = wid >> 1, nt = wid & 1;
  f32x16 acc = zero16();
#pragma unroll
  for (int ks = 0; ks < 8; ++ks) {
    const bf16x8 bb = *(const bf16x8*)(KT + (nt * 32 + l31) * 136 + ks * 16 + h2 * 8);
    acc = MFMA32(a[ks], bb, acc);
  }
#pragma unroll
  for (int r = 0; r < 16; ++r) out[(mt * 32 + crow(r, h2)) * 64 + nt * 32 + l31] = acc[r];
}
DI void ph_mlstm_local(const Params& p, int layer, int item, char* smem) {
  float* bc = (float*)smem; float* ig = bc + 128; float* wv = ig + 128;
  bf16_t* KwT = (bf16_t*)(smem + 2048);
  float* nred = (float*)(smem + 2048 + 64 * 136 * 2);
  const int tid = tid_opaque(), lane = tid & 63, wid = tid >> 6, l31 = lane & 31, h2 = lane >> 5;
  const int b = item >> 6, hh = (item >> 4) & 3, c = item & 15, t0 = c * 128;
  const size_t tok0 = (size_t)b * T + t0;
  const int dg = tid & 7, sb = tid >> 3;
  u32x4 rows[7];
  conv_rows_load(p.QKB() + ((size_t)(b * 8 + 4 + hh) * T) * 64, t0 + 4 * sb - 3, dg, rows);
  bf16x8 af[8];
  delta_state_loadA(p.VBT() + (size_t)(b * 4 + hh) * 64 * T + t0, af, wid, l31, h2);
  float cw[4][8], cb[8];
  load_conv_w(p, layer, 256 + hh * 64, dg, cw, cb);
  __syncthreads();
  mlstm_gates(p, tok0, hh, bc, ig, tid);
  __syncthreads();
  if (tid < 128) wv[tid] = __expf(bc[127] - bc[tid] + ig[tid]);
  __syncthreads();
  {
    float v0[8], v1[8], v2[8], v3[8];
    conv_rows_compute<0>(rows, cw, cb, v0); conv_rows_compute<1>(rows, cw, cb, v1);
    conv_rows_compute<2>(rows, cw, cb, v2); conv_rows_compute<3>(rows, cw, cb, v3);
    const f32x4 w4 = *(const f32x4*)(wv + 4 * sb);
#pragma unroll
    for (int e = 0; e < 8; ++e) {
      u32x2 pk = {pack2(v0[e] * w4[0], v1[e] * w4[1]), pack2(v2[e] * w4[2], v3[e] * w4[3])};
      *(u32x2*)(KwT + (dg * 8 + e) * 136 + 4 * sb) = pk;
    }
  }
  __syncthreads();
  delta_state(af, KwT, p.BST() + (size_t)item * 4096, wid, l31, h2);
  {
    const int k = tid & 63, qd = tid >> 6;
    float a = 0.f;
#pragma unroll 8
    for (int s = 0; s < 32; ++s) a += bf2f(KwT[k * 136 + qd * 32 + s]);
    nred[qd * 64 + k] = a;
  }
  __syncthreads();
  if (tid < 64) p.BN()[(size_t)item * 64 + tid] = (nred[tid] + nred[64 + tid]) + (nred[128 + tid] + nred[192 + tid]);
  if (tid == 0) p.BG()[item] = bc[127];
}
DI void ph_mlstm_scan(const Params& p, int bh) {
  const int tid = tid_opaque();
  f32x4 C[4];
#pragma unroll
  for (int i = 0; i < 4; ++i) C[i] = (f32x4){0.f, 0.f, 0.f, 0.f};
  float n = 0.f;
  for (int c = 0; c < 16; ++c) {
    const int item = bh * 16 + c;
    const float g = __expf(p.BG()[item]);
    f32x4* ptr = (f32x4*)(p.BST() + (size_t)item * 4096 + tid * 16);
#pragma unroll
    for (int i = 0; i < 4; ++i) { const f32x4 tmp = ptr[i]; ptr[i] = C[i]; C[i] = g * C[i] + tmp; }
    if (tid < 64) { const float tmp = p.BN()[(size_t)item * 64 + tid]; p.BN()[(size_t)item * 64 + tid] = n; n = g * n + tmp; }
  }
}
DI void pv_only(const f32x16& s, const bf16_t* VTp, int vstride, f32x16 (&o)[2], int l31, int h2) {
  const bf16x8 p0 = pack8<0>(s), p1 = pack8<8>(s);
#pragma unroll
  for (int dt = 0; dt < 2; ++dt) {
    const bf16_t* vp = VTp + (size_t)(dt * 32 + l31) * vstride + 4 * h2;
    o[dt] = MFMA32(ld_frag8x2(vp), p0, o[dt]);
    o[dt] = MFMA32(ld_frag8x2(vp + 16), p1, o[dt]);
  }
}
DI bf16x8 frag_from_f32(const float* ptr) {
  const f32x4 a = *(const f32x4*)ptr, b = *(const f32x4*)(ptr + 4);
  u32x4 t = {pack2(a[0], a[1]), pack2(a[2], a[3]), pack2(b[0], b[1]), pack2(b[2], b[3])};
  return __builtin_bit_cast(bf16x8, t);
}
constexpr int VT_LSTR = 132;
DI void vt_chunk_load(const bf16_t* VT, int tid, u32x4 (&r)[4]) {
  const int d = tid >> 2, part = tid & 3;
#pragma unroll
  for (int j = 0; j < 4; ++j) r[j] = *(const u32x4*)(VT + (size_t)d * T + part * 32 + j * 8);
}
DI void vt_chunk_store(const u32x4 (&r)[4], bf16_t* lds, int tid) {
  const int d = tid >> 2, part = tid & 3;
#pragma unroll
  for (int j = 0; j < 4; ++j) {
    bf16_t* q = lds + d * VT_LSTR + part * 32 + j * 8;
    *(u32x2*)q = (u32x2){r[j][0], r[j][1]}; *(u32x2*)(q + 4) = (u32x2){r[j][2], r[j][3]};
  }
}
DI void ph_mlstm_out(const Params& p, int layer, int item, char* smem) {
  float* bc = (float*)smem; float* ig = bc + 128;
  bf16_t* qc = (bf16_t*)(smem + 2048);
  bf16_t* kc = qc + 128 * 72;
  bf16_t* vt = kc + 128 * 72;
  const int tid = tid_opaque(), lane = tid & 63, wid = tid >> 6, l31 = lane & 31, h2 = lane >> 5;
  const int b = item >> 6, hh = (item >> 4) & 3, c = item & 15, t0 = c * 128;
  const size_t tok0 = (size_t)b * T + t0;
  const int dg = tid & 7, sb = tid >> 3;
  u32x4 rq[7], rk[7];
  conv_rows_load(p.QKB() + ((size_t)(b * 8 + hh) * T) * 64, t0 + 4 * sb - 3, dg, rq);
  conv_rows_load(p.QKB() + ((size_t)(b * 8 + 4 + hh) * T) * 64, t0 + 4 * sb - 3, dg, rk);
  u32x4 rv[4];
  vt_chunk_load(p.VBT() + (size_t)(b * 4 + hh) * 64 * T + t0, tid, rv);
  __syncthreads();
  mlstm_gates(p, tok0, hh, bc, ig, tid);
  {
    float cw[4][8], cb[8];
    load_conv_w(p, layer, hh * 64, dg, cw, cb);
    float v[8];
#define CONV_ST(I, R, DST, SC) do { conv_rows_compute<I>(R, cw, cb, v); \
      u32x4 w_ = {pack2(v[0] * (SC), v[1] * (SC)), pack2(v[2] * (SC), v[3] * (SC)), pack2(v[4] * (SC), v[5] * (SC)), pack2(v[6] * (SC), v[7] * (SC))}; \
      *(u32x4*)((DST) + (4 * sb + (I)) * 72 + dg * 8) = w_; } while (0)
    CONV_ST(0, rq, qc, 0.125f); CONV_ST(1, rq, qc, 0.125f); CONV_ST(2, rq, qc, 0.125f); CONV_ST(3, rq, qc, 0.125f);
    load_conv_w(p, layer, 256 + hh * 64, dg, cw, cb);
    CONV_ST(0, rk, kc, 1.f); CONV_ST(1, rk, kc, 1.f); CONV_ST(2, rk, kc, 1.f); CONV_ST(3, rk, kc, 1.f);
#undef CONV_ST
  }
  vt_chunk_store(rv, vt, tid);
  const int tq = 32 * wid + l31;
  const float* Cs = p.BST() + (size_t)item * 4096;
  const float* ns = p.BN() + (size_t)item * 64;
  f32x4 cst[2][4][2], nst[4][2];
#pragma unroll
  for (int ks = 0; ks < 4; ++ks) {
#pragma unroll
    for (int dt = 0; dt < 2; ++dt) { cst[dt][ks][0] = *(const f32x4*)(Cs + (dt * 32 + l31) * 64 + ks * 16 + h2 * 8); cst[dt][ks][1] = *(const f32x4*)(Cs + (dt * 32 + l31) * 64 + ks * 16 + h2 * 8 + 4); }
    nst[ks][0] = *(const f32x4*)(ns + ks * 16 + h2 * 8); nst[ks][1] = *(const f32x4*)(ns + ks * 16 + h2 * 8 + 4);
  }
  u32x2 gz1[2][4], gz2[2][4];
#pragma unroll
  for (int dt = 0; dt < 2; ++dt)
#pragma unroll
    for (int g = 0; g < 4; ++g) {
      const int d0 = dt * 32 + 8 * g + 4 * h2;
      gz1[dt][g] = *(const u32x2*)(p.GZ() + (size_t)1 * NTOK * 256 + (tok0 + tq) * 256 + hh * 64 + d0);
      gz2[dt][g] = *(const u32x2*)(p.GZ() + (size_t)2 * NTOK * 256 + (tok0 + tq) * 256 + hh * 64 + d0);
    }
  __syncthreads();
  if (tid < 128) ig[tid] = ig[tid] - bc[tid];
  __syncthreads();
  bf16x8 qf[4];
#pragma unroll
  for (int ks = 0; ks < 4; ++ks) qf[ks] = *(const bf16x8*)(qc + tq * 72 + ks * 16 + h2 * 8);
  const float bt = bc[tq];
  f32x16 o[2]; o[0] = zero16(); o[1] = zero16();
  float dsum = 0.f;
  for (int kt = 0; kt <= wid; ++kt) {
    f32x16 s = qk_tile_s(kc + kt * 32 * 72, 72, qf, l31, h2);
#pragma unroll
    for (int r = 0; r < 16; ++r) {
      const int sidx = 32 * kt + crow(r, h2);
      float val = s[r] * __expf(bt + ig[sidx]);
      if (sidx > tq) val = 0.f;
      s[r] = val; dsum += val;
    }
    pv_only(s, vt + kt * 32, VT_LSTR, o, l31, h2);
  }
  dsum += shx(dsum, 32);
  f32x16 oi[2]; oi[0] = zero16(); oi[1] = zero16();
  float qn = 0.f;
#pragma unroll
  for (int ks = 0; ks < 4; ++ks) {
#pragma unroll
    for (int dt = 0; dt < 2; ++dt) {
      const f32x4 a_ = cst[dt][ks][0], b_ = cst[dt][ks][1];
      u32x4 t_ = {pack2(a_[0], a_[1]), pack2(a_[2], a_[3]), pack2(b_[0], b_[1]), pack2(b_[2], b_[3])};
      oi[dt] = MFMA32(__builtin_bit_cast(bf16x8, t_), qf[ks], oi[dt]);
    }
    const u32x4 qu = __builtin_bit_cast(u32x4, qf[ks]);
    const f32x4 n0 = nst[ks][0], n1 = nst[ks][1];
    qn += __uint_as_float(qu[0] << 16) * n0[0] + __uint_as_float(qu[0] & 0xffff0000u) * n0[1] + __uint_as_float(qu[1] << 16) * n0[2] + __uint_as_float(qu[1] & 0xffff0000u) * n0[3];
    qn += __uint_as_float(qu[2] << 16) * n1[0] + __uint_as_float(qu[2] & 0xffff0000u) * n1[1] + __uint_as_float(qu[3] << 16) * n1[2] + __uint_as_float(qu[3] & 0xffff0000u) * n1[3];
  }
  qn += shx(qn, 32);
  const float ebt = __expf(bt);
  const float den = dsum + ebt * qn;
  const float inv = 1.f / fmaxf(fabsf(den), 1.f);
  const size_t tok = tok0 + tq;
#pragma unroll
  for (int dt = 0; dt < 2; ++dt)
#pragma unroll
    for (int g = 0; g < 4; ++g) {
      const int d0 = dt * 32 + 8 * g + 4 * h2;
      const u32x2 g1 = gz1[dt][g], g2 = gz2[dt][g];
      float z[4] = {__uint_as_float(g1.x << 16) * __uint_as_float(g2.x << 16), __uint_as_float(g1.x & 0xffff0000u) * __uint_as_float(g2.x & 0xffff0000u),
                    __uint_as_float(g1.y << 16) * __uint_as_float(g2.y << 16), __uint_as_float(g1.y & 0xffff0000u) * __uint_as_float(g2.y & 0xffff0000u)};
      float hv[4];
#pragma unroll
      for (int i = 0; i < 4; ++i) hv[i] = (o[dt][4 * g + i] + ebt * oi[dt][4 * g + i]) * inv * z[i];
      u32x2 o2 = {pack2(hv[0], hv[1]), pack2(hv[2], hv[3])};
      *(u32x2*)(p.YMIX() + tok * 1024 + 256 + hh * 64 + d0) = o2;
    }
}


DI void ph_hgrn_local(const Params& p, int layer, int item, char* smem) {
  float* tot = (float*)smem;
  bf16_t* KdT = (bf16_t*)(smem + 1024);
  const int tid = tid_opaque(), lane = tid & 63, wid = tid >> 6, l31 = lane & 31, h2 = lane >> 5;
  const int b = item >> 6, hh = (item >> 4) & 3, c = item & 15, t0 = c * 128;
  const int k = tid & 63, qd = tid >> 6;
  float al[32], kk[32];
  bf16x8 af[8];
  delta_state_loadA(p.VCT() + (size_t)(b * 4 + hh) * 64 * T + t0, af, wid, l31, h2);
  {
    const float* gp = p.GC() + ((size_t)(b * 4 + hh) * T + t0 + 32 * qd) * 64 + k;
    float run = 0.f;
#pragma unroll
    for (int s = 0; s < 32; ++s) { const float g = gp[s * 64]; run += g; al[s] = run; kk[s] = 1.f - __expf(g); }
    __syncthreads();
    tot[qd * 64 + k] = run;
  }
  __syncthreads();
  float off = 0.f, aL = 0.f;
#pragma unroll
  for (int q = 0; q < 4; ++q) { const float v = tot[q * 64 + k]; aL += v; if (q < qd) off += v; }
#pragma unroll
  for (int s8 = 0; s8 < 4; ++s8) {
    float v[8];
#pragma unroll
    for (int e = 0; e < 8; ++e) v[e] = kk[s8 * 8 + e] * __expf(aL - (al[s8 * 8 + e] + off));
    u32x4 w = {pack2(v[0], v[1]), pack2(v[2], v[3]), pack2(v[4], v[5]), pack2(v[6], v[7])};
    *(u32x4*)(KdT + k * 136 + qd * 32 + s8 * 8) = w;
  }
  __syncthreads();
  delta_state(af, KdT, p.CST() + (size_t)item * 4096, wid, l31, h2);
  if (qd == 0) p.CAL()[(size_t)item * 64 + k] = aL;
}
DI void ph_hgrn_scan(const Params& p, int bh) {
  const int tid = tid_opaque();
  f32x4 S[4];
#pragma unroll
  for (int i = 0; i < 4; ++i) S[i] = (f32x4){0.f, 0.f, 0.f, 0.f};
  for (int c = 0; c < 16; ++c) {
    const int item = bh * 16 + c;
    const f32x4* dp = (const f32x4*)(p.CAL() + (size_t)item * 64 + (tid & 3) * 16);
    f32x4* ptr = (f32x4*)(p.CST() + (size_t)item * 4096 + tid * 16);
#pragma unroll
    for (int i = 0; i < 4; ++i) {
      const f32x4 a = dp[i];
      const f32x4 dec = {__expf(a[0]), __expf(a[1]), __expf(a[2]), __expf(a[3])};
      const f32x4 tmp = ptr[i]; ptr[i] = S[i]; S[i] = dec * S[i] + tmp;
    }
  }
}
DI void ph_hgrn_out(const Params& p, int layer, int item, char* smem) {
  float* a_lds = (float*)smem;
  float* tot = (float*)(smem + 128 * 68 * 4);
  bf16_t* kk_lds = (bf16_t*)(smem + 128 * 68 * 4 + 1024);
  bf16_t* vt = kk_lds + 128 * 72;
  const int tid = tid_opaque(), lane = tid & 63, wid = tid >> 6, l31 = lane & 31, h2 = lane >> 5;
  const int b = item >> 6, hh = (item >> 4) & 3, c = item & 15, t0 = c * 128;
  const size_t hbase = (size_t)(b * 4 + hh) * T + t0;
  const int tq = 32 * wid + l31;
  const size_t tok = (size_t)b * T + t0 + tq;
  u32x4 qu[4];
#pragma unroll
  for (int ks = 0; ks < 4; ++ks) qu[ks] = *(const u32x4*)(p.QC() + (hbase + tq) * 64 + ks * 16 + h2 * 8);
  u32x4 rv[4];
  vt_chunk_load(p.VCT() + (size_t)(b * 4 + hh) * 64 * T + t0, tid, rv);
  u32x2 gzv[2][4];
#pragma unroll
  for (int dt = 0; dt < 2; ++dt)
#pragma unroll
    for (int g = 0; g < 4; ++g) gzv[dt][g] = *(const u32x2*)(p.GZ() + (size_t)3 * NTOK * 256 + tok * 256 + hh * 64 + dt * 32 + 8 * g + 4 * h2);
  {
    const int k = tid & 63, qd = tid >> 6;
    float al[32];
    const float* gp = p.GC() + (hbase + 32 * qd) * 64 + k;
    float run = 0.f;
    __syncthreads();
#pragma unroll
    for (int s = 0; s < 32; ++s) { const float g = gp[s * 64]; run += g; al[s] = run; kk_lds[(32 * qd + s) * 72 + k] = f2bf(1.f - __expf(g)); }
    tot[qd * 64 + k] = run;
    vt_chunk_store(rv, vt, tid);
    __syncthreads();
    float off = 0.f;
#pragma unroll
    for (int q = 0; q < 4; ++q) { const float v = tot[q * 64 + k]; if (q < qd) off += v; }
#pragma unroll
    for (int s = 0; s < 32; ++s) a_lds[(32 * qd + s) * 68 + k] = al[s] + off;
  }
  const float* Ss = p.CST() + (size_t)item * 4096;
  f32x4 cst[2][4][2];
#pragma unroll
  for (int ks = 0; ks < 4; ++ks)
#pragma unroll
    for (int dt = 0; dt < 2; ++dt) { cst[dt][ks][0] = *(const f32x4*)(Ss + (dt * 32 + l31) * 64 + ks * 16 + h2 * 8); cst[dt][ks][1] = *(const f32x4*)(Ss + (dt * 32 + l31) * 64 + ks * 16 + h2 * 8 + 4); }
  __syncthreads();
  bf16x8 qi[4], qh[4];
#pragma unroll
  for (int ks = 0; ks < 4; ++ks) {
    const int k0 = ks * 16 + h2 * 8;
    float q8[8], e1[8], e2[8];
#pragma unroll
    for (int e2i = 0; e2i < 4; ++e2i) { q8[2 * e2i] = __uint_as_float(qu[ks][e2i] << 16); q8[2 * e2i + 1] = __uint_as_float(qu[ks][e2i] & 0xffff0000u); }
#pragma unroll
    for (int e = 0; e < 8; ++e) {
      const float a = a_lds[tq * 68 + k0 + e];
      const float r = wid > 0 ? a_lds[(32 * wid - 1) * 68 + k0 + e] : 0.f;
      e1[e] = q8[e] * __expf(a - r); e2[e] = q8[e] * __expf(a);
    }
    u32x4 w1 = {pack2(e1[0], e1[1]), pack2(e1[2], e1[3]), pack2(e1[4], e1[5]), pack2(e1[6], e1[7])};
    u32x4 w2 = {pack2(e2[0], e2[1]), pack2(e2[2], e2[3]), pack2(e2[4], e2[5]), pack2(e2[6], e2[7])};
    qi[ks] = __builtin_bit_cast(bf16x8, w1); qh[ks] = __builtin_bit_cast(bf16x8, w2);
  }
  f32x16 o[2]; o[0] = zero16(); o[1] = zero16();
  for (int kt = 0; kt <= wid; ++kt) {
    f32x16 s = zero16();
    const int srow = 32 * kt + l31;
#pragma unroll
    for (int ks = 0; ks < 4; ++ks) {
      const int k0 = ks * 16 + h2 * 8;
      const u32x4 ku = *(const u32x4*)(kk_lds + srow * 72 + k0);
      float v[8];
#pragma unroll
      for (int e = 0; e < 8; ++e) {
        const float a = a_lds[srow * 68 + k0 + e];
        const float r = wid > 0 ? a_lds[(32 * wid - 1) * 68 + k0 + e] : 0.f;
        const float kkv = (e & 1) ? __uint_as_float(ku[e >> 1] & 0xffff0000u) : __uint_as_float(ku[e >> 1] << 16);
        v[e] = kkv * __expf(fminf(r - a, 80.f));
      }
      u32x4 w = {pack2(v[0], v[1]), pack2(v[2], v[3]), pack2(v[4], v[5]), pack2(v[6], v[7])};
      s = MFMA32(__builtin_bit_cast(bf16x8, w), qi[ks], s);
    }
    if (kt == wid) {
#pragma unroll
      for (int r = 0; r < 16; ++r) if (32 * kt + crow(r, h2) > tq) s[r] = 0.f;
    }
    pv_only(s, vt + kt * 32, VT_LSTR, o, l31, h2);
  }
#pragma unroll
  for (int ks = 0; ks < 4; ++ks)
#pragma unroll
    for (int dt = 0; dt < 2; ++dt) {
      const f32x4 a_ = cst[dt][ks][0], b_ = cst[dt][ks][1];
      u32x4 t_ = {pack2(a_[0], a_[1]), pack2(a_[2], a_[3]), pack2(b_[0], b_[1]), pack2(b_[2], b_[3])};
      o[dt] = MFMA32(__builtin_bit_cast(bf16x8, t_), qh[ks], o[dt]);
    }
  float ss = 0.f;
#pragma unroll
  for (int dt = 0; dt < 2; ++dt)
#pragma unroll
    for (int r = 0; r < 16; ++r) ss += o[dt][r] * o[dt][r];
  ss += shx(ss, 32);
  const float rs = rsqrtf(ss * (1.f / 64.f) + 1e-6f);
#pragma unroll
  for (int dt = 0; dt < 2; ++dt)
#pragma unroll
    for (int g = 0; g < 4; ++g) {
      const int d0 = dt * 32 + 8 * g + 4 * h2;
      const u32x2 gz = gzv[dt][g];
      const f32x4 gn = *(const f32x4*)(p.c_norm_g + layer * 256 + hh * 64 + d0);
      const float z0 = __uint_as_float(gz.x << 16), z1 = __uint_as_float(gz.x & 0xffff0000u), z2 = __uint_as_float(gz.y << 16), z3 = __uint_as_float(gz.y & 0xffff0000u);
      u32x2 o2 = {pack2(o[dt][4 * g] * rs * gn[0] * z0, o[dt][4 * g + 1] * rs * gn[1] * z1), pack2(o[dt][4 * g + 2] * rs * gn[2] * z2, o[dt][4 * g + 3] * rs * gn[3] * z3)};
      *(u32x2*)(p.YMIX() + tok * 1024 + 512 + hh * 64 + d0) = o2;
    }
}


DI void ph_attnA(const Params& p, int layer, int item, char* smem) {
  const int tid = tid_opaque(), lane = tid & 63, h = tid >> 6, l31 = lane & 31, h2 = lane >> 5;
  const int b = item >> 6, q0 = (item & 63) * 32, g = h >> 1;
  const int t = q0 + l31;
  const size_t tok = (size_t)b * T + t;
  bf16x8 qf[4];
  {
    const bf16_t* qp = p.QA() + ((size_t)(b * 4 + h) * T + t) * 64 + h2 * 8;
#pragma unroll
    for (int ks = 0; ks < 4; ++ks) qf[ks] = *(const bf16x8*)(qp + ks * 16);
  }
  const bf16_t* Kp = p.KA() + (size_t)(b * 2 + g) * T * 64;
  const bf16_t* Vp = p.VAT() + (size_t)(b * 2 + g) * 64 * T;
  f32x16 o[2]; o[0] = zero16(); o[1] = zero16();
  float m = -1e30f, l = 0.f;
  for (int key0 = max(0, q0 - 128); key0 <= q0; key0 += 32) {
    f32x16 s = qk_tile(Kp + (size_t)key0 * 64, qf, l31, h2);
    if (key0 == q0 - 128 || key0 == q0) {
#pragma unroll
      for (int r = 0; r < 16; ++r) { const int key = key0 + crow(r, h2); if (key > t || t - key >= 128) s[r] = -INFINITY; }
    }
    softmax_pv(s, Vp + key0, T, o, m, l, l31, h2);
  }
  l = xhalf_sum(l);
  const float sink = p.a_sinks[layer * 4 + h] * 1.4426950408889634f;
  const float M = fmaxf(m, sink);
  const float sc = __builtin_amdgcn_exp2f(m - M);
  const float inv = sc / (l * sc + __builtin_amdgcn_exp2f(sink - M));
#pragma unroll
  for (int dt = 0; dt < 2; ++dt)
#pragma unroll
    for (int gq = 0; gq < 4; ++gq) {
      const int d0 = dt * 32 + 8 * gq + 4 * h2;
      const u32x2 gz = *(const u32x2*)(p.GZ() + tok * 256 + h * 64 + d0);
      const float z0 = __uint_as_float(gz.x << 16), z1 = __uint_as_float(gz.x & 0xffff0000u), z2 = __uint_as_float(gz.y << 16), z3 = __uint_as_float(gz.y & 0xffff0000u);
      u32x2 o2 = {pack2(o[dt][4 * gq] * inv * z0, o[dt][4 * gq + 1] * inv * z1), pack2(o[dt][4 * gq + 2] * inv * z2, o[dt][4 * gq + 3] * inv * z3)};
      *(u32x2*)(p.YMIX() + tok * 1024 + h * 64 + d0) = o2;
    }
}

DI void ph_cmp(const Params& p, int layer, int item, char* smem) {
  float* red = (float*)smem;
  bf16_t* hid = (bf16_t*)(smem + 32768);
  const int tid = tid_opaque(), lane = tid & 63, wid = tid >> 6, l31 = lane & 31, h2 = lane >> 5;
  const int b = item >> 3, kvsel = (item >> 2) & 1, mt = item & 3;
  const int lk = layer * 2 + kvsel;
  const int n = min(mt * 32 + l31, 126);
  const bf16_t* src = p.KV() + ((size_t)(kvsel * NB + b) * T + 16 * n) * 64 + wid * 512 + h2 * 8;
  const bf16_t* w1t = p.W1T() + (size_t)lk * 64 * 2048 + wid * 512 + h2 * 8;
  f32x16 acc[2]; acc[0] = zero16(); acc[1] = zero16();
#pragma unroll 4
  for (int ks = 0; ks < 32; ++ks) {
    const bf16x8 a = *(const bf16x8*)(src + ks * 16);
    const bf16x8 b0 = *(const bf16x8*)(w1t + (size_t)l31 * 2048 + ks * 16);
    const bf16x8 b1 = *(const bf16x8*)(w1t + (size_t)(32 + l31) * 2048 + ks * 16);
    acc[0] = MFMA32(a, b0, acc[0]); acc[1] = MFMA32(a, b1, acc[1]);
  }
  __syncthreads();
#pragma unroll
  for (int nt = 0; nt < 2; ++nt)
#pragma unroll
    for (int r = 0; r < 16; ++r) red[(wid * 32 + crow(r, h2)) * 64 + nt * 32 + l31] = acc[nt][r];
  __syncthreads();
  {
    const int row = tid >> 3, c0 = (tid & 7) * 8;
    float v[8];
#pragma unroll
    for (int e = 0; e < 8; ++e) {
      const float x = (red[(0 * 32 + row) * 64 + c0 + e] + red[(1 * 32 + row) * 64 + c0 + e]) + (red[(2 * 32 + row) * 64 + c0 + e] + red[(3 * 32 + row) * 64 + c0 + e]) + p.CVEC()[lk * 64 + c0 + e];
      v[e] = siluf_(x);
    }
    u32x4 w = {pack2(v[0], v[1]), pack2(v[2], v[3]), pack2(v[4], v[5]), pack2(v[6], v[7])};
    *(u32x4*)(hid + row * 72 + c0) = w;
  }
  __syncthreads();
  if (wid == 0) {
    f32x16 o[2]; o[0] = zero16(); o[1] = zero16();
    const bf16_t* w2t = p.W2T() + (size_t)lk * 4096;
#pragma unroll
    for (int ks = 0; ks < 4; ++ks) {
      const bf16x8 a = *(const bf16x8*)(hid + l31 * 72 + ks * 16 + h2 * 8);
#pragma unroll
      for (int nt = 0; nt < 2; ++nt) o[nt] = MFMA32(a, *(const bf16x8*)(w2t + (nt * 32 + l31) * 64 + ks * 16 + h2 * 8), o[nt]);
    }
    if (kvsel == 0) {
#pragma unroll
      for (int r = 0; r < 16; ++r) {
        const int nn = mt * 32 + crow(r, h2);
        if (nn < 127) {
          const int pos = 16 * nn + 31;
          const float cs = p.ROPEC()[pos * 32 + l31], sn = p.ROPES()[pos * 32 + l31];
          p.KCMP()[((size_t)b * 128 + nn) * 64 + l31] = f2bf(o[0][r] * cs - o[1][r] * sn);
          p.KCMP()[((size_t)b * 128 + nn) * 64 + 32 + l31] = f2bf(o[0][r] * sn + o[1][r] * cs);
        }
      }
    } else {
#pragma unroll
      for (int nt = 0; nt < 2; ++nt)
#pragma unroll
        for (int r = 0; r < 16; ++r) {
          const int nn = mt * 32 + crow(r, h2);
          if (nn < 127) p.VCMPT()[((size_t)b * 64 + nt * 32 + l31) * 128 + nn] = f2bf(o[nt][r]);
        }
    }
  }
}


#define XB_TMO      128
#define XB_XCNT(j)  (256  + 64 * (j))
#define XB_XSUB(j)  (1280 + 64 * (j))
#define XB_XGEN(j)  (2304 + 64 * (j))
#define XB_TOP      3328
#define XB_TOPGEN   3392
#define XCD_BAR_WORDS 3456
#define XB_SPIN_CAP (1u << 22)
DI unsigned xb_ld(unsigned* p)              { return __hip_atomic_load(p, __ATOMIC_RELAXED, __HIP_MEMORY_SCOPE_AGENT); }
DI unsigned xb_add(unsigned* p, unsigned v) { return __hip_atomic_fetch_add(p, v, __ATOMIC_RELAXED, __HIP_MEMORY_SCOPE_AGENT); }
DI unsigned xb_xcc_id() { return (unsigned)__builtin_amdgcn_s_getreg((3 << 11) | 20) & 0xFu; }
#define XB_SPIN(cond, bar) do { unsigned _sp = 0; while (cond) { __builtin_amdgcn_s_sleep(1); \
    if ((++_sp & 255u) == 0u) { if (xb_ld(&(bar)[XB_TMO])) break; if (_sp > XB_SPIN_CAP) { atomicAdd(&(bar)[XB_TMO], 1u); break; } } } } while (0)
struct XcdBarrier { unsigned* bar; unsigned x; volatile LAS unsigned* st; };
DI XcdBarrier xcd_barrier_post(unsigned* bar, volatile LAS unsigned* st) {
  XcdBarrier b; b.bar = bar; b.x = xb_xcc_id(); b.st = st;
  if (threadIdx.x == 0) (void)xb_add(&bar[XB_XCNT(b.x)], 1u);
  return b;
}
DI void xcd_barrier_complete(unsigned* bar, unsigned x, unsigned& nloc, unsigned& nx) {
  const unsigned G = gridDim.x * gridDim.y * gridDim.z;
  unsigned sum, cnt, mine, sp = 0u;
  for (;;) {
    sum = 0u; cnt = 0u; mine = 0u;
#pragma unroll
    for (unsigned j = 0; j < 16; ++j) { const unsigned c = xb_ld(&bar[XB_XCNT(j)]); sum += c; cnt += (c > 0u) ? 1u : 0u; mine = (j == x) ? c : mine; }
    if (sum == G) break;
    __builtin_amdgcn_s_sleep(1);
    if ((++sp & 255u) == 0u) { if (xb_ld(&bar[XB_TMO])) break; if (sp > XB_SPIN_CAP) { atomicAdd(&bar[XB_TMO], 1u); break; } }
  }
  nloc = mine > 0u ? mine : 1u; nx = cnt > 0u ? cnt : 1u;
}
DI void xcd_barrier(const XcdBarrier& b) {
  asm volatile("s_waitcnt vmcnt(0)" ::: "memory");
  __syncthreads();
  int t0_ = threadIdx.x; asm volatile("" : "+v"(t0_));
  if (t0_ == 0) {
    unsigned* bar = b.bar;
    __builtin_amdgcn_s_waitcnt(0);
    unsigned nloc = b.st[0], nx = b.st[1];
    if (nloc == 0u) { xcd_barrier_complete(bar, b.x, nloc, nx); b.st[0] = nloc; b.st[1] = nx; }
    const unsigned old = xb_add(&bar[XB_XSUB(b.x)], 1u);
    const unsigned gen = old / nloc;
    if (old + 1u == (gen + 1u) * nloc) {
      __builtin_amdgcn_fence(__ATOMIC_RELEASE, "agent");
      asm volatile("s_waitcnt vmcnt(0)" ::: "memory");
      const unsigned og = xb_add(&bar[XB_TOP], 1u);
      const unsigned tg = og / nx;
      if (og + 1u == (tg + 1u) * nx) xb_add(&bar[XB_TOPGEN], 1u);
      else XB_SPIN(xb_ld(&bar[XB_TOPGEN]) == tg, bar);
      __builtin_amdgcn_fence(__ATOMIC_ACQUIRE, "agent");
      xb_add(&bar[XB_XGEN(b.x)], 1u);
      asm volatile("s_waitcnt vmcnt(0)" ::: "memory");
    } else {
      XB_SPIN(xb_ld(&bar[XB_XGEN(b.x)]) == gen, bar);
      __builtin_amdgcn_fence(__ATOMIC_ACQUIRE, "agent");
      asm volatile("s_waitcnt vmcnt(0)" ::: "memory");
    }
  }
  __syncthreads();
}

constexpr int HALF_LDS = 80000;
__global__ void __launch_bounds__(512) mega(Params p) {
  __shared__ __attribute__((aligned(16))) char smem_all[2 * HALF_LDS + 32];
  cg::grid_group grid = cg::this_grid();
  const int half = half_id();
  const int bid = blockIdx.x, nblk = gridDim.x;
  const int vbid = 2 * bid + half, nvblk = 2 * nblk;
  char* smem = smem_all + half * HALF_LDS;
  unsigned* xbw = (unsigned*)(smem_all + 2 * HALF_LDS);
  int* s_pair = (int*)(smem_all + 2 * HALF_LDS + 16);
  if (threadIdx.x == 0) { xbw[0] = 0u; xbw[1] = 0u; }
  __syncthreads();
  const XcdBarrier xb = xcd_barrier_post(p.XBAR(), (volatile LAS unsigned*)xbw);
  ph_prologue(p, vbid, nvblk, smem);
  ln_rows(p, 0, 0, vbid, nvblk);
  if (PROBE == 5) { ph_prologue(p, vbid, nvblk, smem); ln_rows(p, 0, 0, vbid, nvblk); }
  grid.sync();
  for (int l = 0; l < 2; ++l) {
    ph_gemm_in(p, l, bid, nblk, smem_all);
    if (PROBE == 1) ph_gemm_in(p, l, bid, nblk, smem_all);
    xcd_barrier(xb);
    for (int rep = 0; rep < (PROBE == 3 ? 2 : 1); ++rep) {
    for (int item = vbid; item < 2048; item += nvblk) ph_mlstm_local(p, l, item, smem);
    for (int item = vbid; item < 2048; item += nvblk) ph_hgrn_local(p, l, item, smem);
    __syncthreads();
    for (int item = vbid; item < 256; item += nvblk) ph_cmp(p, l, item, smem);
    __syncthreads();
    for (int item = bid; item < 1024; item += nblk) ph_attnA_fb(p, l, item, smem_all);
    }
    xcd_barrier(xb);
    if (vbid < 128) ph_mlstm_scan(p, vbid);
    else if (vbid < 256) ph_hgrn_scan(p, vbid - 128);
    __syncthreads();
    ph_attnD(p, l, p.CTR() + l, smem_all, s_pair);
    if (PROBE == 2) ph_attnD(p, l, p.CTR() + 2 + l, smem_all, s_pair);
    xcd_barrier(xb);
    for (int rep = 0; rep < (PROBE == 4 ? 2 : 1); ++rep) {
    for (int item = vbid; item < 2048; item += nvblk) ph_mlstm_out(p, l, item, smem);
    for (int item = vbid; item < 2048; item += nvblk) ph_hgrn_out(p, l, item, smem);
    }
    xcd_barrier(xb);
    ph_gemm_out_ln(p, l, bid, nblk, smem_all);
    if (l == 0) xcd_barrier(xb);
  }
}

static inline size_t align_up(size_t v) { return (v + 255) & ~(size_t)255; }

extern "C" void kernel_launch(void* const* d_in, const int* in_sizes, int n_in, void* d_out, int out_size, void* d_ws, size_t ws_size, hipStream_t stream) {
  Params p{};
  p.x = (const float*)d_in[0]; p.ln0_g = (const float*)d_in[1]; p.ln0_b = (const float*)d_in[2]; p.w_in = (const float*)d_in[3];
  p.b_in = (const float*)d_in[4]; p.a_sinks = (const float*)d_in[5]; p.conv_w = (const float*)d_in[6]; p.conv_b = (const float*)d_in[7];
  p.c_lb = (const float*)d_in[8]; p.c_norm_g = (const float*)d_in[9]; p.pe = (const float*)d_in[10]; p.w1 = (const float*)d_in[11];
  p.w2 = (const float*)d_in[12]; p.w_out = (const float*)d_in[13]; p.ln_g = (const float*)d_in[14]; p.ln_b = (const float*)d_in[15];
  p.hf = (float*)d_out;
  p.ws = (char*)d_ws;
  if (WS_TOTAL > ws_size) { fprintf(stderr, "workspace too small: need %zu have %zu\n", (size_t)WS_TOTAL, ws_size); return; }

  static int grid_blocks = 0;
  if (!grid_blocks) {
    int dev = 0, cus = 0, per_cu = 0;
    (void)hipGetDevice(&dev);
    (void)hipDeviceGetAttribute(&cus, hipDeviceAttributeMultiprocessorCount, dev);
    (void)hipOccupancyMaxActiveBlocksPerMultiprocessor(&per_cu, mega, 512, 0);
    if (per_cu > 1) per_cu = 1;
    grid_blocks = cus * per_cu;
  }
  (void)hipMemsetAsync((char*)d_ws + OFF_XBAR, 0, XCD_BAR_WORDS * 4, stream);
  (void)hipMemsetAsync((char*)d_ws + OFF_CVEC, 0, SZ_CVEC, stream);
  void* args[] = {&p};
  hipError_t e = hipLaunchCooperativeKernel((void*)mega, dim3(grid_blocks), dim3(512), args, 0, stream);
  if (e != hipSuccess) fprintf(stderr, "cooperative launch failed: %s (grid %d)\n", hipGetErrorString(e), grid_blocks);
}
```

```cpp
#include <hip/hip_runtime.h>
#include <hip/hip_cooperative_groups.h>
#include <stdio.h>
#include <stdint.h>
#include <stddef.h>

#ifndef PROBE
#define PROBE 0
#endif
#define DI __device__ __forceinline__
typedef unsigned short bf16_t;
typedef short bf16x8 __attribute__((ext_vector_type(8)));
typedef float f32x16 __attribute__((ext_vector_type(16)));
typedef unsigned u32x4 __attribute__((ext_vector_type(4)));
typedef float f32x4 __attribute__((ext_vector_type(4)));

constexpr int NB = 32, T = 2048, DM = 1024, NTOK = NB * T, NP = 4096;
constexpr float DN_ALPHA = 1.41421356237309515f;

constexpr size_t OFF_HB = 0;
constexpr size_t SZ_HB = (size_t)NTOK * 1024 * 2;
constexpr size_t OFF_YMIX = OFF_HB + ((SZ_HB + 255) & ~(size_t)255);
constexpr size_t SZ_YMIX = (size_t)NTOK * 1024 * 2;
constexpr size_t OFF_QA = OFF_YMIX + ((SZ_YMIX + 255) & ~(size_t)255);
constexpr size_t SZ_QA = (size_t)NTOK * 256 * 2;
constexpr size_t OFF_KA = OFF_QA + ((SZ_QA + 255) & ~(size_t)255);
constexpr size_t SZ_KA = (size_t)NTOK * 128 * 2;
constexpr size_t OFF_VAT = OFF_KA + ((SZ_KA + 255) & ~(size_t)255);
constexpr size_t SZ_VAT = (size_t)NTOK * 128 * 2;
constexpr size_t OFF_QKB = OFF_VAT + ((SZ_VAT + 255) & ~(size_t)255);
constexpr size_t SZ_QKB = (size_t)NTOK * 512 * 2;
constexpr size_t OFF_VBT = OFF_QKB + ((SZ_QKB + 255) & ~(size_t)255);
constexpr size_t SZ_VBT = (size_t)NTOK * 256 * 2;
constexpr size_t OFF_QC = OFF_VBT + ((SZ_VBT + 255) & ~(size_t)255);
constexpr size_t SZ_QC = (size_t)NTOK * 256 * 2;
constexpr size_t OFF_GC = OFF_QC + ((SZ_QC + 255) & ~(size_t)255);
constexpr size_t SZ_GC = (size_t)NTOK * 256 * 4;
constexpr size_t OFF_VCT = OFF_GC + ((SZ_GC + 255) & ~(size_t)255);
constexpr size_t SZ_VCT = (size_t)NTOK * 256 * 2;
constexpr size_t OFF_QD = OFF_VCT + ((SZ_VCT + 255) & ~(size_t)255);
constexpr size_t SZ_QD = (size_t)NTOK * 256 * 2;
constexpr size_t OFF_KV = OFF_QD + ((SZ_QD + 255) & ~(size_t)255);
constexpr size_t SZ_KV = (size_t)NTOK * 384 * 2;
constexpr size_t OFF_GZ = OFF_KV + ((SZ_KV + 255) & ~(size_t)255);
constexpr size_t SZ_GZ = (size_t)NTOK * 1280 * 2;
constexpr size_t OFF_IFG = OFF_GZ + ((SZ_GZ + 255) & ~(size_t)255);
constexpr size_t SZ_IFG = (size_t)NTOK * 8 * 4;
constexpr size_t OFF_DG = OFF_IFG + ((SZ_IFG + 255) & ~(size_t)255);
constexpr size_t SZ_DG = (size_t)NTOK * 12 * 4;
constexpr size_t OFF_WT = OFF_DG + ((SZ_DG + 255) & ~(size_t)255);
constexpr size_t SZ_WT = (size_t)2 * NP * 1024 * 2;
constexpr size_t OFF_WOT = OFF_WT + ((SZ_WT + 255) & ~(size_t)255);
constexpr size_t SZ_WOT = (size_t)2 * 1024 * 1024 * 2;
constexpr size_t OFF_KCMP = OFF_WOT + ((SZ_WOT + 255) & ~(size_t)255);
constexpr size_t SZ_KCMP = (size_t)NB * 128 * 64 * 2;
constexpr size_t OFF_VCMPT = OFF_KCMP + ((SZ_KCMP + 255) & ~(size_t)255);
constexpr size_t SZ_VCMPT = (size_t)NB * 64 * 128 * 2;
constexpr size_t OFF_BIASP = OFF_VCMPT + ((SZ_VCMPT + 255) & ~(size_t)255);
constexpr size_t SZ_BIASP = (size_t)2 * NP * 4;
constexpr size_t OFF_LB = OFF_BIASP + ((SZ_BIASP + 255) & ~(size_t)255);
constexpr size_t SZ_LB = (size_t)512 * 4;
constexpr size_t OFF_ROPEC = OFF_LB + ((SZ_LB + 255) & ~(size_t)255);
constexpr size_t SZ_ROPEC = (size_t)T * 32 * 4;
constexpr size_t OFF_ROPES = OFF_ROPEC + ((SZ_ROPEC + 255) & ~(size_t)255);
constexpr size_t SZ_ROPES = (size_t)T * 32 * 4;
constexpr size_t OFF_BST = OFF_ROPES + ((SZ_ROPES + 255) & ~(size_t)255);
constexpr size_t SZ_BST = (size_t)2048 * 4096 * 4;
constexpr size_t OFF_BN = OFF_BST + ((SZ_BST + 255) & ~(size_t)255);
constexpr size_t SZ_BN = (size_t)2048 * 64 * 4;
constexpr size_t OFF_BG = OFF_BN + ((SZ_BN + 255) & ~(size_t)255);
constexpr size_t SZ_BG = (size_t)2048 * 4;
constexpr size_t OFF_CST = OFF_BG + ((SZ_BG + 255) & ~(size_t)255);
constexpr size_t SZ_CST = (size_t)2048 * 4096 * 4;
constexpr size_t OFF_CAL = OFF_CST + ((SZ_CST + 255) & ~(size_t)255);
constexpr size_t SZ_CAL = (size_t)2048 * 64 * 4;
constexpr size_t OFF_W1T = OFF_CAL + ((SZ_CAL + 255) & ~(size_t)255);
constexpr size_t SZ_W1T = (size_t)4 * 64 * 2048 * 2;
constexpr size_t OFF_W2T = OFF_W1T + ((SZ_W1T + 255) & ~(size_t)255);
constexpr size_t SZ_W2T = (size_t)4 * 64 * 64 * 2;
constexpr size_t OFF_CVEC = OFF_W2T + ((SZ_W2T + 255) & ~(size_t)255);
constexpr size_t SZ_CVEC = (size_t)256 * 4;
constexpr size_t OFF_CTR = OFF_CVEC + ((SZ_CVEC + 255) & ~(size_t)255);
constexpr size_t SZ_CTR = (size_t)256;
constexpr size_t OFF_XBAR = OFF_CTR + ((SZ_CTR + 255) & ~(size_t)255);
constexpr size_t SZ_XBAR = (size_t)3456 * 4;
constexpr size_t OFF_LNS = OFF_XBAR + ((SZ_XBAR + 255) & ~(size_t)255);
constexpr size_t SZ_LNS = (size_t)NTOK * 2 * 4;
constexpr size_t WS_TOTAL = OFF_LNS + ((SZ_LNS + 255) & ~(size_t)255);
struct Params {
  const float *x, *ln0_g, *ln0_b, *w_in, *b_in, *a_sinks, *conv_w, *conv_b, *c_lb, *c_norm_g, *pe, *w1, *w2, *w_out, *ln_g, *ln_b;
  float* hf;
  char* ws;
  DI bf16_t* HB() const { return (bf16_t*)(ws + OFF_HB); }
  DI bf16_t* YMIX() const { return (bf16_t*)(ws + OFF_YMIX); }
  DI bf16_t* QA() const { return (bf16_t*)(ws + OFF_QA); }
  DI bf16_t* KA() const { return (bf16_t*)(ws + OFF_KA); }
  DI bf16_t* VAT() const { return (bf16_t*)(ws + OFF_VAT); }
  DI bf16_t* QKB() const { return (bf16_t*)(ws + OFF_QKB); }
  DI bf16_t* VBT() const { return (bf16_t*)(ws + OFF_VBT); }
  DI bf16_t* QC() const { return (bf16_t*)(ws + OFF_QC); }
  DI float* GC() const { return (float*)(ws + OFF_GC); }
  DI bf16_t* VCT() const { return (bf16_t*)(ws + OFF_VCT); }
  DI bf16_t* QD() const { return (bf16_t*)(ws + OFF_QD); }
  DI bf16_t* KV() const { return (bf16_t*)(ws + OFF_KV); }
  DI bf16_t* GZ() const { return (bf16_t*)(ws + OFF_GZ); }
  DI float* IFG() const { return (float*)(ws + OFF_IFG); }
  DI float* DG() const { return (float*)(ws + OFF_DG); }
  DI bf16_t* WT() const { return (bf16_t*)(ws + OFF_WT); }
  DI bf16_t* WOT() const { return (bf16_t*)(ws + OFF_WOT); }
  DI bf16_t* KCMP() const { return (bf16_t*)(ws + OFF_KCMP); }
  DI bf16_t* VCMPT() const { return (bf16_t*)(ws + OFF_VCMPT); }
  DI float* BIASP() const { return (float*)(ws + OFF_BIASP); }
  DI float* LB() const { return (float*)(ws + OFF_LB); }
  DI float* ROPEC() const { return (float*)(ws + OFF_ROPEC); }
  DI float* ROPES() const { return (float*)(ws + OFF_ROPES); }
  DI float* BST() const { return (float*)(ws + OFF_BST); }
  DI float* BN() const { return (float*)(ws + OFF_BN); }
  DI float* BG() const { return (float*)(ws + OFF_BG); }
  DI float* CST() const { return (float*)(ws + OFF_CST); }
  DI float* CAL() const { return (float*)(ws + OFF_CAL); }
  DI bf16_t* W1T() const { return (bf16_t*)(ws + OFF_W1T); }
  DI bf16_t* W2T() const { return (bf16_t*)(ws + OFF_W2T); }
  DI float* CVEC() const { return (float*)(ws + OFF_CVEC); }
  DI int* CTR() const { return (int*)(ws + OFF_CTR); }
  DI unsigned* XBAR() const { return (unsigned*)(ws + OFF_XBAR); }
  DI float* LNS() const { return (float*)(ws + OFF_LNS); }
};
namespace cg = cooperative_groups;

DI int tid_opaque() { int t = threadIdx.x; asm volatile("" : "+v"(t)); return t & 255; }
DI int half_id() { return __builtin_amdgcn_readfirstlane((int)(threadIdx.x >> 8)); }
DI float bf2f(bf16_t v) { return __uint_as_float(((unsigned)v) << 16); }
DI bf16_t f2bf(float x) { unsigned u = __float_as_uint(x); u += 0x7fffu + ((u >> 16) & 1u); return (bf16_t)(u >> 16); }
DI float sigmoidf_(float x) { return __builtin_amdgcn_rcpf(1.f + __builtin_amdgcn_exp2f(-1.4426950408889634f * x)); }
DI float siluf_(float x) { return x * __builtin_amdgcn_rcpf(1.f + __builtin_amdgcn_exp2f(-1.4426950408889634f * x)); }
DI int lane_op() { int l = threadIdx.x; asm volatile("" : "+v"(l)); return l & 63; }
DI float shx(float v, int m) { return __builtin_bit_cast(float, __builtin_amdgcn_ds_bpermute((lane_op() ^ m) << 2, __builtin_bit_cast(int, v))); }
DI unsigned shx(unsigned v, int m) { return (unsigned)__builtin_amdgcn_ds_bpermute((lane_op() ^ m) << 2, (int)v); }
DI float shup(float v, int d) { const int l = lane_op(); const int s = l - d; return __builtin_bit_cast(float, __builtin_amdgcn_ds_bpermute((s < 0 ? l : s) << 2, __builtin_bit_cast(int, v))); }
DI float xhalf_max(float x) { int a = __builtin_bit_cast(int, x), b = a; asm volatile("" : "+v"(b)); auto r = __builtin_amdgcn_permlane32_swap(a, b, false, false); return fmaxf(__builtin_bit_cast(float, (int)r[0]), __builtin_bit_cast(float, (int)r[1])); }
DI float xhalf_sum(float x) { int a = __builtin_bit_cast(int, x), b = a; asm volatile("" : "+v"(b)); auto r = __builtin_amdgcn_permlane32_swap(a, b, false, false); return __builtin_bit_cast(float, (int)r[0]) + __builtin_bit_cast(float, (int)r[1]); }
DI float wave_sum(float v) { for (int o = 32; o > 0; o >>= 1) v += shx(v, o); return v; }
DI float wave_max(float v) { for (int o = 32; o > 0; o >>= 1) v = fmaxf(v, shx(v, o)); return v; }

DI int orig_col(int n) {
  if (n < 1536) return n;
  if (n < 3712) return n + 8;
  if (n < 3968) return n + 20;
  if (n < 3976) return 1536 + (n - 3968);
  if (n < 3988) return 3720 + (n - 3976);
  return -1;
}

DI bool head_is_paired(int hd);
DI void ph_prologue(const Params& p, int bid, int nblk, char* smem) {
  const long gtid = (long)bid * 256 + tid_opaque(), gsz = (long)nblk * 256;
  if (gtid < 64) p.CTR()[gtid] = 0;
  for (long idx = gtid; idx < 2L * 128 * NP; idx += gsz) {
    const int n = (int)(idx % NP), k8 = (int)((idx / NP) % 128), l = (int)(idx / (NP * 128));
    const int pp = n & 63, w_ = pp >> 5, rr = pp & 31, n_ = rr >> 4, fq_ = (rr >> 2) & 3, j_ = rr & 3;
    const int lc = head_is_paired(n >> 6) ? (32 * n_ + 16 * w_ + 4 * fq_ + j_) : (32 * w_ + 8 * fq_ + 4 * n_ + j_);
    const int oc = orig_col((n & ~63) + lc);
    unsigned w[4];
    for (int j = 0; j < 4; ++j) {
      float a = 0.f, b = 0.f;
      if (oc >= 0) { a = p.w_in[((size_t)l * 1024 + k8 * 8 + 2 * j) * 3988 + oc]; b = p.w_in[((size_t)l * 1024 + k8 * 8 + 2 * j + 1) * 3988 + oc]; }
      w[j] = (unsigned)f2bf(a) | ((unsigned)f2bf(b) << 16);
    }
    *(uint4*)(p.WT() + ((size_t)l * NP + n) * 1024 + k8 * 8) = make_uint4(w[0], w[1], w[2], w[3]);
  }
  for (long idx = gtid; idx < 2L * 128 * 1024; idx += gsz) {
    const int d = (int)(idx % 1024), m8 = (int)((idx / 1024) % 128), l = (int)(idx / (1024 * 128));
    unsigned w[4];
    for (int j = 0; j < 4; ++j) {
      float a = p.w_out[((size_t)l * 1024 + m8 * 8 + 2 * j) * 1024 + d], b = p.w_out[((size_t)l * 1024 + m8 * 8 + 2 * j + 1) * 1024 + d];
      w[j] = (unsigned)f2bf(a) | ((unsigned)f2bf(b) << 16);
    }
    *(uint4*)(p.WOT() + ((size_t)l * 1024 + d) * 1024 + m8 * 8) = make_uint4(w[0], w[1], w[2], w[3]);
  }
  for (long idx = gtid; idx < 4L * 256 * 64; idx += gsz) {
    const int j = (int)(idx % 64), i8 = (int)((idx / 64) % 256), lk = (int)(idx / (64 * 256));
    unsigned w[4];
    for (int e = 0; e < 4; ++e) {
      const float a = p.w1[((size_t)lk * 2048 + i8 * 8 + 2 * e) * 64 + j], b = p.w1[((size_t)lk * 2048 + i8 * 8 + 2 * e + 1) * 64 + j];
      w[e] = (unsigned)f2bf(a) | ((unsigned)f2bf(b) << 16);
    }
    *(uint4*)(p.W1T() + ((size_t)lk * 64 + j) * 2048 + i8 * 8) = make_uint4(w[0], w[1], w[2], w[3]);
  }
  for (long idx = gtid; idx < 4L * 64 * 64; idx += gsz) {
    const int jo = (int)(idx % 64), ji = (int)((idx / 64) % 64), lk = (int)(idx / 4096);
    p.W2T()[((size_t)lk * 64 + jo) * 64 + ji] = f2bf(p.w2[((size_t)lk * 64 + ji) * 64 + jo]);
  }
  if (bid < 64) {
    const int lk = bid >> 4, seg = bid & 15, j = tid_opaque() & 63, part = tid_opaque() >> 6;
    float a = 0.f;
    const int i0 = seg * 128 + part * 32;
#pragma unroll 8
    for (int i = i0; i < i0 + 32; ++i) a += p.pe[(size_t)lk * 2048 + i] * p.w1[((size_t)lk * 2048 + i) * 64 + j];
    float* red = (float*)smem;
    __syncthreads();
    red[part * 64 + j] = a;
    __syncthreads();
    if (part == 0) atomicAdd(p.CVEC() + lk * 64 + j, (red[j] + red[64 + j]) + (red[128 + j] + red[192 + j]));
    __syncthreads();
  }
  for (long idx = gtid; idx < 2L * NP; idx += gsz) {
    const int n = (int)(idx % NP), l = (int)(idx / NP); const int oc = orig_col(n);
    p.BIASP()[idx] = oc >= 0 ? p.b_in[l * 3988 + oc] : 0.f;
  }
  for (long idx = gtid; idx < (long)T * 32; idx += gsz) {
    const int t = (int)(idx / 32), i = (int)(idx % 32);
    const float inv = exp2f(-(float)i * (13.287712379549449f / 32.0f));
    const float ang = (float)t * inv;
    p.ROPEC()[idx] = cosf(ang); p.ROPES()[idx] = sinf(ang);
  }
  for (long idx = gtid; idx < 512; idx += gsz) {
    const int c = (int)(idx % 256), l = (int)(idx / 256);
    const float a = p.c_lb[c], b = p.c_lb[256 + c];
    const float m = fmaxf(a, b); const float ea = expf(a - m), eb = expf(b - m);
    p.LB()[idx] = l == 0 ? 0.f : eb / (ea + eb);
  }
}

DI void ln_rows(const Params& p, int mode, int layer, int bid, int nblk) {
  const int tid_ = tid_opaque(); const int lane = tid_ & 63, wid = tid_ >> 6, nw = 4;
  const float* g = mode == 0 ? p.ln0_g : p.ln_g + layer * 1024;
  const float* bb = mode == 0 ? p.ln0_b : p.ln_b + layer * 1024;
  const float* src = mode == 0 ? p.x : p.hf;
  const int stride = nblk * nw;
  int row = bid * nw + wid;
  f32x4 nx[4];
  if (row < NTOK) {
#pragma unroll
    for (int i = 0; i < 4; ++i) nx[i] = *(const f32x4*)(src + (size_t)row * 1024 + i * 256 + lane * 4);
  }
  for (; row < NTOK; row += stride) {
    f32x4 v[4];
#pragma unroll
    for (int i = 0; i < 4; ++i) v[i] = nx[i];
    if (row + stride < NTOK) {
#pragma unroll
      for (int i = 0; i < 4; ++i) nx[i] = *(const f32x4*)(src + (size_t)(row + stride) * 1024 + i * 256 + lane * 4);
    }
    float sum = 0.f;
#pragma unroll
    for (int i = 0; i < 4; ++i) sum += (v[i][0] + v[i][1]) + (v[i][2] + v[i][3]);
    sum = wave_sum(sum);
    const float mu = sum * (1.f / 1024.f);
    float q = 0.f;
#pragma unroll
    for (int i = 0; i < 4; ++i) { const f32x4 d = v[i] - mu; q += (d[0] * d[0] + d[1] * d[1]) + (d[2] * d[2] + d[3] * d[3]); }
    q = wave_sum(q);
    const float rs = rsqrtf(q * (1.f / 1024.f) + 1e-5f);
    if (mode == 0 && lane == 0) { p.LNS()[(size_t)row * 2] = mu; p.LNS()[(size_t)row * 2 + 1] = rs; }
#pragma unroll
    for (int i = 0; i < 4; ++i) {
      const int c0 = i * 256 + lane * 4;
      const f32x4 gg = *(const f32x4*)(g + c0), b4 = *(const f32x4*)(bb + c0);
      const f32x4 o = (v[i] - mu) * rs * gg + b4;
      if (mode != 0) *(f32x4*)(p.hf + (size_t)row * 1024 + c0) = o;
      uint2 pk; pk.x = (unsigned)f2bf(o[0]) | ((unsigned)f2bf(o[1]) << 16); pk.y = (unsigned)f2bf(o[2]) | ((unsigned)f2bf(o[3]) << 16);
      *(uint2*)(p.HB() + (size_t)row * 1024 + c0) = pk;
    }
  }
}

typedef float f32x2 __attribute__((ext_vector_type(2)));
typedef __bf16 bf16v2 __attribute__((ext_vector_type(2)));
typedef unsigned u32x2 __attribute__((ext_vector_type(2)));
DI unsigned pack2(float a, float b) { f32x2 v = {a, b}; return __builtin_bit_cast(unsigned, __builtin_convertvector(v, bf16v2)); }
DI f32x16 zero16() { f32x16 z;
#pragma unroll
  for (int i = 0; i < 16; ++i) z[i] = 0.f; return z; }
DI bf16x8 ld_frag8x2(const bf16_t* p) { const u32x2 lo = *(const u32x2*)p, hi = *(const u32x2*)(p + 8); u32x4 t = {lo.x, lo.y, hi.x, hi.y}; return __builtin_bit_cast(bf16x8, t); }
template <int BASE> DI bf16x8 pack8(const f32x16& s) {
  u32x4 t = {pack2(s[BASE + 0], s[BASE + 1]), pack2(s[BASE + 2], s[BASE + 3]), pack2(s[BASE + 4], s[BASE + 5]), pack2(s[BASE + 6], s[BASE + 7])};
  return __builtin_bit_cast(bf16x8, t);
}
DI int crow(int r, int h2) { return (r & 3) + 8 * (r >> 2) + 4 * h2; }
#define MFMA32(a, b, c) __builtin_amdgcn_mfma_f32_32x32x16_bf16((a), (b), (c), 0, 0, 0)
#define LAS __attribute__((address_space(3)))
enum { K_NONE = 0, K_ROPE, K_PLAIN, K_TR, K_GSILU, K_GSIG, K_SILUH, K_LOGF, K_SMALL };
namespace g8 {
constexpr int BK = 64, HALF = 128, HT = HALF * BK;
DI int lds_byte(int r, int c) { const int st = (r >> 4) * 2 + (c >> 5), rr = r & 15, cc = c & 31, ob = rr * 64 + cc * 2; return st * 1024 + (ob ^ (((ob >> 9) & 1) << 5)); }
DI void stage_rc(int b, int& R, int& C) { const int st = b / 1024, sb = b % 1024, swz = sb ^ (((sb >> 9) & 1) << 5); R = (st >> 1) * 16 + swz / 64; C = (st & 1) * 32 + (swz % 64) / 2; }
}
DI void gemm256_mainloop(const bf16_t* A, const bf16_t* Bt, bf16_t* shm, f32x4 (&acc)[2][2][4][2]) {
  using namespace g8;
  constexpr int K = 1024;
#define SA(b, h) (shm + ((b) * 2 + (h)) * HT)
#define SB(b, h) (shm + (4 + (b) * 2 + (h)) * HT)
#define STAGE(P, BASE, br, kt) do { const long g_ = (long)(br) * K + (long)(kt) * BK; \
    _Pragma("unroll") for (int i_ = 0; i_ < 2; ++i_) { const int b_ = tidf * 16 + i_ * 8192; int r_, c_; stage_rc(b_, r_, c_); \
      __builtin_amdgcn_global_load_lds((const unsigned*)((BASE) + g_ + (long)r_ * K + c_), (LAS unsigned*)((char*)(P) + b_), 16, 0, 0); } } while (0)
#define LDA(dst, b, h) _Pragma("unroll") for (int m = 0; m < 4; ++m) _Pragma("unroll") for (int k = 0; k < 2; ++k) \
    dst[m][k] = *reinterpret_cast<const bf16x8*>((const char*)SA(b, h) + lds_byte(wr * 64 + m * 16 + fr, k * 32 + fq * 8))
#define LDB(dst, b, h) _Pragma("unroll") for (int n = 0; n < 2; ++n) _Pragma("unroll") for (int k = 0; k < 2; ++k) \
    dst[n][k] = *reinterpret_cast<const bf16x8*>((const char*)SB(b, h) + lds_byte(wc * 32 + n * 16 + fr, k * 32 + fq * 8))
#define MMA(ai, bj, At_, Bt_) do { __builtin_amdgcn_s_setprio(1); \
    _Pragma("unroll") for (int m = 0; m < 4; ++m) _Pragma("unroll") for (int n = 0; n < 2; ++n) _Pragma("unroll") for (int k = 0; k < 2; ++k) \
      acc[ai][bj][m][n] = __builtin_amdgcn_mfma_f32_16x16x32_bf16(Bt_[n][k], At_[m][k], acc[ai][bj][m][n], 0, 0, 0); \
    __builtin_amdgcn_s_setprio(0); } while (0)
#define WAIT_V(n) asm volatile("s_waitcnt vmcnt(" #n ")" ::: "memory")
#define WAIT_L(n) asm volatile("s_waitcnt lgkmcnt(" #n ")" ::: "memory")
#define BAR __builtin_amdgcn_s_barrier()
#define SCHED __builtin_amdgcn_sched_barrier(0)
  int tidf = threadIdx.x; asm volatile("" : "+v"(tidf));
  const int wid = tidf >> 6, lane = tidf & 63, wr = wid >> 2, wc = wid & 3, fr = lane & 15, fq = lane >> 4;
#pragma unroll
  for (int a = 0; a < 2; ++a)
#pragma unroll
    for (int b = 0; b < 2; ++b)
#pragma unroll
      for (int m = 0; m < 4; ++m)
#pragma unroll
        for (int n = 0; n < 2; ++n) acc[a][b][m][n] = (f32x4){0.f, 0.f, 0.f, 0.f};
  bf16x8 At[4][2], B0[2][2], B1[2][2];
  constexpr int nt = K / BK;
  WAIT_V(0);
  STAGE(SB(0, 0), Bt, 0, 0); STAGE(SA(0, 0), A, 0, 0);
  STAGE(SB(0, 1), Bt, HALF, 0); STAGE(SA(0, 1), A, HALF, 0);
  if (wr == 1) BAR;
  WAIT_V(4); BAR;
  STAGE(SB(1, 0), Bt, 0, 1); STAGE(SA(1, 0), A, 0, 1); STAGE(SB(1, 1), Bt, HALF, 1);
  WAIT_V(6); BAR;
  for (int t = 0; t < nt - 2; t += 2) {
    LDB(B0, 0, 0); SCHED; LDA(At, 0, 0); STAGE(SA(1, 1), A, HALF, t + 1);
    WAIT_L(8); BAR; WAIT_L(0); MMA(0, 0, At, B0); BAR; SCHED;
    LDB(B1, 0, 1); STAGE(SB(0, 0), Bt, 0, t + 2);
    BAR; WAIT_L(0); MMA(0, 1, At, B1); BAR;
    LDA(At, 0, 1); STAGE(SA(0, 0), A, 0, t + 2);
    BAR; WAIT_L(0); MMA(1, 0, At, B0); BAR; SCHED;
    STAGE(SB(0, 1), Bt, HALF, t + 2);
    WAIT_V(6); BAR; MMA(1, 1, At, B1); BAR;
    LDB(B0, 1, 0); SCHED; LDA(At, 1, 0); STAGE(SA(0, 1), A, HALF, t + 2);
    WAIT_L(8); BAR; WAIT_L(0); MMA(0, 0, At, B0); BAR; SCHED;
    LDB(B1, 1, 1); STAGE(SB(1, 0), Bt, 0, t + 3);
    BAR; WAIT_L(0); MMA(0, 1, At, B1); BAR;
    LDA(At, 1, 1); STAGE(SA(1, 0), A, 0, t + 3);
    BAR; WAIT_L(0); MMA(1, 0, At, B0); BAR; SCHED;
    STAGE(SB(1, 1), Bt, HALF, t + 3);
    WAIT_V(6); BAR; MMA(1, 1, At, B1); BAR;
  }
  { LDB(B0, 0, 0); LDA(At, 0, 0); STAGE(SA(1, 1), A, HALF, nt - 1);
    BAR; WAIT_L(0); MMA(0, 0, At, B0); BAR;
    LDB(B1, 0, 1); BAR; WAIT_L(0); MMA(0, 1, At, B1); BAR;
    LDA(At, 0, 1); WAIT_V(4); BAR; WAIT_L(0); MMA(1, 0, At, B0); MMA(1, 1, At, B1); BAR; }
  { LDB(B0, 1, 0); LDA(At, 1, 0); WAIT_V(2); BAR; WAIT_L(0); MMA(0, 0, At, B0); BAR;
    LDB(B1, 1, 1); WAIT_V(0); BAR; WAIT_L(0); MMA(0, 1, At, B1); BAR;
    LDA(At, 1, 1); BAR; WAIT_L(0); MMA(1, 0, At, B0); MMA(1, 1, At, B1); BAR; }
  if (wr == 0) BAR;
#undef SA
#undef SB
#undef STAGE
#undef LDA
#undef LDB
#undef MMA
#undef WAIT_V
#undef WAIT_L
#undef BAR
#undef SCHED
}

DI void classify_head(const Params& p, int hd, int b, int& kind, bf16_t*& dst, float*& fdst, float& scale) {
  kind = K_NONE; dst = nullptr; fdst = nullptr; scale = 1.f;
  if (hd < 4) { kind = K_ROPE; dst = p.QA() + ((size_t)(b * 4 + hd) * T) * 64; scale = 0.125f * 1.4426950408889634f; }
  else if (hd < 6) { kind = K_ROPE; dst = p.KA() + ((size_t)(b * 2 + hd - 4) * T) * 64; }
  else if (hd < 8) { kind = K_TR; dst = p.VAT() + (size_t)(b * 2 + hd - 6) * 64 * T; }
  else if (hd < 12) { kind = K_GSILU; dst = p.GZ() + (size_t)0 * NTOK * 256 + (hd - 8) * 64; }
  else if (hd < 20) { kind = K_PLAIN; dst = p.QKB() + ((size_t)(b * 8 + hd - 12) * T) * 64; }
  else if (hd < 24) { kind = K_TR; dst = p.VBT() + (size_t)(b * 4 + hd - 20) * 64 * T; }
  else if (hd < 28) { kind = K_GSIG; dst = p.GZ() + (size_t)1 * NTOK * 256 + (hd - 24) * 64; }
  else if (hd < 32) { kind = K_GSILU; dst = p.GZ() + (size_t)2 * NTOK * 256 + (hd - 28) * 64; }
  else if (hd < 36) { kind = K_SILUH; dst = p.QC() + ((size_t)(b * 4 + hd - 32) * T) * 64; }
  else if (hd < 40) { kind = K_LOGF; fdst = p.GC() + ((size_t)(b * 4 + hd - 36) * T) * 64; }
  else if (hd < 44) { kind = K_TR; dst = p.VCT() + (size_t)(b * 4 + hd - 40) * 64 * T; }
  else if (hd < 48) { kind = K_GSILU; dst = p.GZ() + (size_t)3 * NTOK * 256 + (hd - 44) * 64; }
  else if (hd < 52) { kind = K_ROPE; dst = p.QD() + ((size_t)(b * 4 + hd - 48) * T) * 64; scale = 0.125f * 1.4426950408889634f; }
  else if (hd < 58) {
    const int j = hd - 52;
    dst = p.KV() + (size_t)(j * NB + b) * T * 64;
    kind = (j == 0 || j == 1) ? K_PLAIN : ((j == 2 || j == 4) ? K_ROPE : K_TR);
  }
  else if (hd < 62) { kind = K_GSILU; dst = p.GZ() + (size_t)4 * NTOK * 256 + (hd - 58) * 64; }
  else if (hd == 62) { kind = K_SMALL; }
}

DI bool head_is_paired(int hd) { return hd < 6 || (hd >= 48 && hd < 52) || hd == 54 || hd == 56; }
template <int KIND>
DI void epi_direct(const Params& p, const f32x4 (&a)[4][2], bf16_t* dst, float* fdst, float scale, int layer, int hd, int b, int tq, int wr, int w, int fr, int fq) {
  if (KIND == K_ROPE) {
    const int c = 16 * w + 4 * fq;
    const f32x4 b0 = *(const f32x4*)(p.BIASP() + layer * NP + hd * 64 + c), b1 = *(const f32x4*)(p.BIASP() + layer * NP + hd * 64 + 32 + c);
#pragma unroll
    for (int m = 0; m < 4; ++m) {
      const int t = tq + wr * 64 + m * 16 + fr;
      const f32x4 cs = *(const f32x4*)(p.ROPEC() + t * 32 + c), sn = *(const f32x4*)(p.ROPES() + t * 32 + c);
      const f32x4 v0 = a[m][0] + b0, v1 = a[m][1] + b1;
      const f32x4 o0 = (v0 * cs - v1 * sn) * scale, o1 = (v0 * sn + v1 * cs) * scale;
      u32x2 w0 = {pack2(o0[0], o0[1]), pack2(o0[2], o0[3])}, w1 = {pack2(o1[0], o1[1]), pack2(o1[2], o1[3])};
      *(u32x2*)(dst + (size_t)t * 64 + c) = w0; *(u32x2*)(dst + (size_t)t * 64 + 32 + c) = w1;
    }
    return;
  }
  const int c = 32 * w + 8 * fq;
  const f32x4 b0 = *(const f32x4*)(p.BIASP() + layer * NP + hd * 64 + c), b1 = *(const f32x4*)(p.BIASP() + layer * NP + hd * 64 + c + 4);
  if (KIND == K_SMALL) {
#pragma unroll
    for (int m = 0; m < 4; ++m) {
      const size_t tok = (size_t)b * T + tq + wr * 64 + m * 16 + fr;
#pragma unroll
      for (int n = 0; n < 2; ++n)
#pragma unroll
        for (int j = 0; j < 4; ++j) {
          const int cc = c + 4 * n + j;
          const float v = a[m][n][j] + (n ? b1[j] : b0[j]);
          if (cc < 8) p.IFG()[tok * 8 + cc] = v;
          else if (cc < 20) p.DG()[tok * 12 + (cc - 8)] = sigmoidf_(v);
        }
    }
    return;
  }
  f32x4 lb0 = {0.f, 0.f, 0.f, 0.f}, lb1 = {0.f, 0.f, 0.f, 0.f};
  if (KIND == K_LOGF) { lb0 = *(const f32x4*)(p.LB() + layer * 256 + (hd - 36) * 64 + c); lb1 = *(const f32x4*)(p.LB() + layer * 256 + (hd - 36) * 64 + c + 4); }
#pragma unroll
  for (int m = 0; m < 4; ++m) {
    const int t = tq + wr * 64 + m * 16 + fr;
    const f32x4 v0 = a[m][0] + b0, v1 = a[m][1] + b1;
    if (KIND == K_LOGF) {
      f32x4 o0, o1;
#pragma unroll
      for (int j = 0; j < 4; ++j) { o0[j] = __logf(lb0[j] + (1.f - lb0[j]) * sigmoidf_(v0[j])); o1[j] = __logf(lb1[j] + (1.f - lb1[j]) * sigmoidf_(v1[j])); }
      *(f32x4*)(fdst + (size_t)t * 64 + c) = o0; *(f32x4*)(fdst + (size_t)t * 64 + c + 4) = o1;
    } else {
      f32x4 o0, o1;
#pragma unroll
      for (int j = 0; j < 4; ++j) {
        if (KIND == K_PLAIN) { o0[j] = v0[j]; o1[j] = v1[j]; }
        else if (KIND == K_SILUH || KIND == K_GSILU) { o0[j] = siluf_(v0[j]); o1[j] = siluf_(v1[j]); }
        else { o0[j] = sigmoidf_(v0[j]); o1[j] = sigmoidf_(v1[j]); }
      }
      u32x4 wv = {pack2(o0[0], o0[1]), pack2(o0[2], o0[3]), pack2(o1[0], o1[1]), pack2(o1[2], o1[3])};
      if (KIND == K_GSILU || KIND == K_GSIG) *(u32x4*)(dst + ((size_t)b * T + t) * 256 + c) = wv;
      else *(u32x4*)(dst + (size_t)t * 64 + c) = wv;
    }
  }
}
DI void epi_tr_write(const Params& p, const f32x4 (&a)[4][2], char* img, int layer, int hd, int wr, int w, int fr, int fq) {
  const int c = 32 * w + 8 * fq;
  const f32x4 b0 = *(const f32x4*)(p.BIASP() + layer * NP + hd * 64 + c), b1 = *(const f32x4*)(p.BIASP() + layer * NP + hd * 64 + c + 4);
  bf16_t* timg = (bf16_t*)img;
#pragma unroll
  for (int m = 0; m < 4; ++m)
#pragma unroll
    for (int n = 0; n < 2; ++n)
#pragma unroll
      for (int j = 0; j < 4; ++j) timg[(c + 4 * n + j) * 128 + wr * 64 + m * 16 + fr] = f2bf(a[m][n][j] + (n ? b1[j] : b0[j]));
}
DI void gemm_in_quadrant(const Params& p, int layer, int panel, int pn, int ai, int bj, const f32x4 (&a)[4][2], char* shm,
                         int b, int hq, int tid2, int wr, int wc, int fr, int fq) {
  const int tq = (panel & 7) * 256 + ai * 128;
  const int hd0 = pn * 4 + bj * 2;
  const int hd = hd0 + (wc >> 1), w = wc & 1;
  int kind; bf16_t* dst; float* fdst; float scale;
  classify_head(p, hd, b, kind, dst, fdst, scale);
  switch (kind) {
    case K_ROPE: epi_direct<K_ROPE>(p, a, dst, fdst, scale, layer, hd, b, tq, wr, w, fr, fq); break;
    case K_PLAIN: epi_direct<K_PLAIN>(p, a, dst, fdst, scale, layer, hd, b, tq, wr, w, fr, fq); break;
    case K_GSILU: epi_direct<K_GSILU>(p, a, dst, fdst, scale, layer, hd, b, tq, wr, w, fr, fq); break;
    case K_GSIG: epi_direct<K_GSIG>(p, a, dst, fdst, scale, layer, hd, b, tq, wr, w, fr, fq); break;
    case K_SILUH: epi_direct<K_SILUH>(p, a, dst, fdst, scale, layer, hd, b, tq, wr, w, fr, fq); break;
    case K_LOGF: epi_direct<K_LOGF>(p, a, dst, fdst, scale, layer, hd, b, tq, wr, w, fr, fq); break;
    case K_SMALL: epi_direct<K_SMALL>(p, a, dst, fdst, scale, layer, hd, b, tq, wr, w, fr, fq); break;
    default: break;
  }
  int k0, k1; { bf16_t* d_; float* f_; float s_; classify_head(p, hd0, b, k0, d_, f_, s_); classify_head(p, hd0 + 1, b, k1, d_, f_, s_); }
  if (k0 == K_TR || k1 == K_TR) {
    if (kind == K_TR) epi_tr_write(p, a, shm + (wc >> 1) * 16384, layer, hd, wr, w, fr, fq);
    __syncthreads();
    int kq; bf16_t* dq; float* fq_; float sq; classify_head(p, hd0 + hq, b, kq, dq, fq_, sq);
    if (kq == K_TR) {
      const char* img = shm + hq * 16384;
#pragma unroll
      for (int i = 0; i < 4; ++i) { const int q = tid2 + 256 * i, cc = q >> 4, rc = q & 15; *(u32x4*)(dq + (size_t)cc * T + tq + rc * 8) = *(const u32x4*)(img + q * 16); }
    }
    __syncthreads();
  }
}
template <int KIND, int BJ, int PASS>
DI void epi2_write(const Params& p, const f32x4 (&acc)[2][2][4][2], char* img, float scale, int layer, int hd, int tbase, int wr, int w, int fr, int fq) {
  if (KIND == K_ROPE) {
    const int c = 16 * w + 4 * fq;
    const f32x4 b0 = *(const f32x4*)(p.BIASP() + layer * NP + hd * 64 + c), b1 = *(const f32x4*)(p.BIASP() + layer * NP + hd * 64 + 32 + c);
    const int ch0 = 2 * w + (fq >> 1), sub = (fq & 1) * 8;
#pragma unroll
    for (int ai = 0; ai < 2; ++ai)
#pragma unroll
      for (int m = 0; m < 4; ++m) {
        const int row = ai * 128 + wr * 64 + m * 16 + fr, t = tbase + row;
        const f32x4 cs = *(const f32x4*)(p.ROPEC() + t * 32 + c), sn = *(const f32x4*)(p.ROPES() + t * 32 + c);
        const f32x4 v0 = acc[ai][BJ][m][0] + b0, v1 = acc[ai][BJ][m][1] + b1;
        const f32x4 o0 = (v0 * cs - v1 * sn) * scale, o1 = (v0 * sn + v1 * cs) * scale;
        u32x2 w0 = {pack2(o0[0], o0[1]), pack2(o0[2], o0[3])}, w1 = {pack2(o1[0], o1[1]), pack2(o1[2], o1[3])};
        *(u32x2*)(img + row * 128 + ((ch0 ^ (fr & 7)) * 16) + sub) = w0;
        *(u32x2*)(img + row * 128 + (((ch0 + 4) ^ (fr & 7)) * 16) + sub) = w1;
      }
    return;
  }
  const int c = 32 * w + 8 * fq;
  const f32x4 b0 = *(const f32x4*)(p.BIASP() + layer * NP + hd * 64 + c), b1 = *(const f32x4*)(p.BIASP() + layer * NP + hd * 64 + c + 4);
  if (KIND == K_TR) {
    bf16_t* timg = (bf16_t*)img;
#pragma unroll
    for (int ai = 0; ai < 2; ++ai)
#pragma unroll
      for (int m = 0; m < 4; ++m)
#pragma unroll
        for (int n = 0; n < 2; ++n)
#pragma unroll
          for (int j = 0; j < 4; ++j) timg[(c + 4 * n + j) * 256 + ai * 128 + wr * 64 + m * 16 + fr] = f2bf(acc[ai][BJ][m][n][j] + (n ? b1[j] : b0[j]));
    return;
  }
  if (KIND == K_LOGF) {
    const f32x4 lb0 = *(const f32x4*)(p.LB() + layer * 256 + (hd - 36) * 64 + c), lb1 = *(const f32x4*)(p.LB() + layer * 256 + (hd - 36) * 64 + c + 4);
    float* fimg = (float*)img;
#pragma unroll
    for (int m = 0; m < 4; ++m) {
      const f32x4 v0 = acc[PASS][BJ][m][0] + b0, v1 = acc[PASS][BJ][m][1] + b1;
      f32x4 o0, o1;
#pragma unroll
      for (int j = 0; j < 4; ++j) { o0[j] = __logf(lb0[j] + (1.f - lb0[j]) * sigmoidf_(v0[j])); o1[j] = __logf(lb1[j] + (1.f - lb1[j]) * sigmoidf_(v1[j])); }
      const int row = wr * 64 + m * 16 + fr;
      *(f32x4*)(fimg + row * 64 + c) = o0; *(f32x4*)(fimg + row * 64 + c + 4) = o1;
    }
    return;
  }
  const int ch = 4 * w + fq;
#pragma unroll
  for (int ai = 0; ai < 2; ++ai)
#pragma unroll
    for (int m = 0; m < 4; ++m) {
      const int row = ai * 128 + wr * 64 + m * 16 + fr;
      const f32x4 v0 = acc[ai][BJ][m][0] + b0, v1 = acc[ai][BJ][m][1] + b1;
      f32x4 o0, o1;
#pragma unroll
      for (int j = 0; j < 4; ++j) {
        if (KIND == K_PLAIN) { o0[j] = v0[j]; o1[j] = v1[j]; }
        else if (KIND == K_SILUH || KIND == K_GSILU) { o0[j] = siluf_(v0[j]); o1[j] = siluf_(v1[j]); }
        else { o0[j] = sigmoidf_(v0[j]); o1[j] = sigmoidf_(v1[j]); }
      }
      u32x4 wv = {pack2(o0[0], o0[1]), pack2(o0[2], o0[3]), pack2(o1[0], o1[1]), pack2(o1[2], o1[3])};
      *(u32x4*)(img + row * 128 + ((ch ^ (fr & 7)) * 16)) = wv;
    }
}
template <int BJ, int PASS>
DI void epi2_write_head(const Params& p, int layer, int pn, const f32x4 (&acc)[2][2][4][2], char* shm, int b, int tbase, int wr, int wc, int fr, int fq) {
  const int w = wc & 1, hq = BJ * 2 + (wc >> 1), hd = pn * 4 + hq;
  int kind; bf16_t* dst; float* fdst; float scale;
  classify_head(p, hd, b, kind, dst, fdst, scale);
  char* img = shm + hq * 32768;
  switch (kind) {
    case K_ROPE: epi2_write<K_ROPE, BJ, PASS>(p, acc, img, scale, layer, hd, tbase, wr, w, fr, fq); break;
    case K_PLAIN: epi2_write<K_PLAIN, BJ, PASS>(p, acc, img, scale, layer, hd, tbase, wr, w, fr, fq); break;
    case K_TR: epi2_write<K_TR, BJ, PASS>(p, acc, img, scale, layer, hd, tbase, wr, w, fr, fq); break;
    case K_GSILU: epi2_write<K_GSILU, BJ, PASS>(p, acc, img, scale, layer, hd, tbase, wr, w, fr, fq); break;
    case K_GSIG: epi2_write<K_GSIG, BJ, PASS>(p, acc, img, scale, layer, hd, tbase, wr, w, fr, fq); break;
    case K_SILUH: epi2_write<K_SILUH, BJ, PASS>(p, acc, img, scale, layer, hd, tbase, wr, w, fr, fq); break;
    case K_LOGF: epi2_write<K_LOGF, BJ, PASS>(p, acc, img, scale, layer, hd, tbase, wr, w, fr, fq); break;
    case K_SMALL: {
      const int c = 32 * w + 8 * fq;
      const f32x4 b0 = *(const f32x4*)(p.BIASP() + layer * NP + hd * 64 + c), b1 = *(const f32x4*)(p.BIASP() + layer * NP + hd * 64 + c + 4);
#pragma unroll
      for (int ai = 0; ai < 2; ++ai)
#pragma unroll
        for (int m = 0; m < 4; ++m) {
          const size_t tok = (size_t)b * T + tbase + ai * 128 + wr * 64 + m * 16 + fr;
#pragma unroll
          for (int n = 0; n < 2; ++n)
#pragma unroll
            for (int j = 0; j < 4; ++j) {
              const int cc = c + 4 * n + j;
              const float v = acc[ai][BJ][m][n][j] + (n ? b1[j] : b0[j]);
              if (cc < 8) p.IFG()[tok * 8 + cc] = v;
              else if (cc < 20) p.DG()[tok * 12 + (cc - 8)] = sigmoidf_(v);
            }
        }
    } break;
    default: break;
  }
}
template <int PASS>
DI void epi2_pass(const Params& p, int layer, int panel, int pn, const f32x4 (&acc)[2][2][4][2], char* shm, int tidf) {
  const int wid = tidf >> 6, lane = tidf & 63, wr = wid >> 2, wc = wid & 3, fr = lane & 15, fq = lane >> 4;
  const int b = panel >> 3, tbase = (panel & 7) * 256;
  epi2_write_head<0, PASS>(p, layer, pn, acc, shm, b, tbase, wr, wc, fr, fq);
  epi2_write_head<1, PASS>(p, layer, pn, acc, shm, b, tbase, wr, wc, fr, fq);
  __syncthreads();
  {
    const int hq = wid >> 1, hd = pn * 4 + hq, half = wid & 1;
    int kind; bf16_t* dst; float* fdst; float scale;
    classify_head(p, hd, b, kind, dst, fdst, scale);
    const char* img = shm + hq * 32768;
    if (kind == K_LOGF) {
#pragma unroll 4
      for (int i = 0; i < 16; ++i) {
        const int pi = half * 16 + i;
        const u32x4 v = *(const u32x4*)(img + pi * 1024 + lane * 16);
        const int row = 4 * pi + (lane >> 4), ch = lane & 15;
        *(u32x4*)(fdst + (size_t)(tbase + PASS * 128 + row) * 64 + ch * 4) = v;
      }
    } else if (kind == K_TR) {
#pragma unroll 4
      for (int i = 0; i < 16; ++i) {
        const int pi = half * 16 + i;
        const u32x4 v = *(const u32x4*)(img + pi * 1024 + lane * 16);
        const int d = 2 * pi + (lane >> 5), tc = lane & 31;
        *(u32x4*)(dst + (size_t)d * T + tbase + tc * 8) = v;
      }
    } else if (kind == K_ROPE || kind == K_PLAIN || kind == K_SILUH || kind == K_GSILU || kind == K_GSIG) {
      const bool gate = (kind == K_GSILU || kind == K_GSIG);
#pragma unroll 4
      for (int i = 0; i < 16; ++i) {
        const int pi = half * 16 + i;
        const int rl = lane >> 3, chl = lane & 7, row = 8 * pi + rl;
        const u32x4 v = *(const u32x4*)(img + row * 128 + ((chl ^ rl) * 16));
        if (gate) *(u32x4*)(dst + ((size_t)b * T + tbase + row) * 256 + chl * 8) = v;
        else *(u32x4*)(dst + (size_t)(tbase + row) * 64 + chl * 8) = v;
      }
    }
  }
  __syncthreads();
}
DI void gemm_in_epilogue(const Params& p, int layer, int panel, int pn, const f32x4 (&acc)[2][2][4][2], char* shm) {
  int tidf = threadIdx.x; asm volatile("" : "+v"(tidf));
  __syncthreads();
  epi2_pass<0>(p, layer, panel, pn, acc, shm, tidf);
  if (pn == 9) epi2_pass<1>(p, layer, panel, pn, acc, shm, tidf);
}
DI void gemm_out_epilogue(const Params& p, int panel, int pn, const f32x4 (&acc)[2][2][4][2], char* shm) {
  int tidf = threadIdx.x; asm volatile("" : "+v"(tidf));
  const int wid = tidf >> 6, lane = tidf & 63, wr = wid >> 2, wc = wid & 3, fr = lane & 15, fq = lane >> 4;
#pragma unroll
  for (int ai = 0; ai < 2; ++ai)
#pragma unroll
    for (int m = 0; m < 4; ++m) {
      const size_t row = (size_t)(panel * 256 + ai * 128 + wr * 64 + m * 16 + fr);
#pragma unroll
      for (int bj = 0; bj < 2; ++bj)
#pragma unroll
        for (int n = 0; n < 2; ++n) {
          const int col = pn * 256 + bj * 128 + wc * 32 + n * 16 + fq * 4;
          const u32x2 hb = *(const u32x2*)(p.HB() + row * 1024 + col);
          const f32x4 h = {__uint_as_float(hb[0] << 16), __uint_as_float(hb[0] & 0xffff0000u), __uint_as_float(hb[1] << 16), __uint_as_float(hb[1] & 0xffff0000u)};
          *(f32x4*)(p.hf + row * 1024 + col) = DN_ALPHA * h + acc[ai][bj][m][n];
        }
    }
}
DI void ph_gemm_in(const Params& p, int layer, int bid, int nblk, char* shm) {
  asm volatile("" : "+s"(bid));
  if (nblk == 256) {
    const int x = bid & 7, c = bid >> 3;
    for (int g = 0; g < 4; ++g) {
      const int panel = 32 * x + 8 * g + (c & 7);
      const bf16_t* A = p.HB() + (size_t)panel * 256 * 1024;
      for (int s = 0; s < 4; ++s) {
        const int pn = (c >> 3) + 4 * s;
        f32x4 acc[2][2][4][2];
        gemm256_mainloop(A, p.WT() + ((size_t)layer * NP + pn * 256) * 1024, (bf16_t*)shm, acc);
        if (PROBE == 6) { __syncthreads(); gemm256_mainloop(A, p.WT() + ((size_t)layer * NP + pn * 256) * 1024, (bf16_t*)shm, acc); }
        gemm_in_epilogue(p, layer, panel, pn, acc, shm);
        if (PROBE == 7) gemm_in_epilogue(p, layer, panel, pn, acc, shm);
      }
    }
    return;
  }
  for (int panel = bid; panel < 256; panel += nblk) {
    const bf16_t* A = p.HB() + (size_t)panel * 256 * 1024;
    for (int pn = 0; pn < 16; ++pn) {
      f32x4 acc[2][2][4][2];
      gemm256_mainloop(A, p.WT() + ((size_t)layer * NP + pn * 256) * 1024, (bf16_t*)shm, acc);
      gemm_in_epilogue(p, layer, panel, pn, acc, shm);
    }
  }
}
DI void ph_gemm_out_ln(const Params& p, int layer, int bid, int nblk, char* shm) {
  asm volatile("" : "+s"(bid));
  for (int panel = bid; panel < 256; panel += nblk) {
    const bf16_t* A = p.YMIX() + (size_t)panel * 256 * 1024;
    for (int pn = 0; pn < 4; ++pn) {
      f32x4 acc[2][2][4][2];
      gemm256_mainloop(A, p.WOT() + ((size_t)layer * 1024 + pn * 256) * 1024, (bf16_t*)shm, acc);
      gemm_out_epilogue(p, panel, pn, acc, shm);
    }
    asm volatile("s_waitcnt vmcnt(0)" ::: "memory");
    __syncthreads();
    int tidf = threadIdx.x; asm volatile("" : "+v"(tidf));
    const int lane = tidf & 63, wid = tidf >> 6;
    const float* g = p.ln_g + layer * 1024; const float* bb = p.ln_b + layer * 1024;
    f32x4 nx[4];
    {
      const float* s0 = p.hf + (size_t)(panel * 256 + wid * 32) * 1024;
#pragma unroll
      for (int i = 0; i < 4; ++i) nx[i] = *(const f32x4*)(s0 + i * 256 + lane * 4);
    }
    for (int rr = 0; rr < 32; ++rr) {
      const int row = panel * 256 + wid * 32 + rr;
      float* s = p.hf + (size_t)row * 1024;
      f32x4 v[4];
#pragma unroll
      for (int i = 0; i < 4; ++i) v[i] = nx[i];
      if (rr + 1 < 32) {
#pragma unroll
        for (int i = 0; i < 4; ++i) nx[i] = *(const f32x4*)(s + 1024 + i * 256 + lane * 4);
      }
      float sum = 0.f;
#pragma unroll
      for (int i = 0; i < 4; ++i) sum += (v[i][0] + v[i][1]) + (v[i][2] + v[i][3]);
      sum = wave_sum(sum);
      const float mu = sum * (1.f / 1024.f);
      float q = 0.f;
#pragma unroll
      for (int i = 0; i < 4; ++i) { const f32x4 d = v[i] - mu; q += (d[0] * d[0] + d[1] * d[1]) + (d[2] * d[2] + d[3] * d[3]); }
      q = wave_sum(q);
      const float rs = rsqrtf(q * (1.f / 1024.f) + 1e-5f);
#pragma unroll
      for (int i = 0; i < 4; ++i) {
        const int cc = i * 256 + lane * 4;
        const f32x4 gg = *(const f32x4*)(g + cc), b4 = *(const f32x4*)(bb + cc);
        const f32x4 o = (v[i] - mu) * rs * gg + b4;
        if (layer == 0) { u32x2 pk = {pack2(o[0], o[1]), pack2(o[2], o[3])}; *(u32x2*)(p.HB() + (size_t)row * 1024 + cc) = pk; }
        else *(f32x4*)(s + cc) = o;
      }
    }
  }
}

DI f32x16 qk_tile(const bf16_t* Krow, const bf16x8 (&qf)[4], int l31, int h2) {
  f32x16 s = zero16();
  const bf16_t* kp = Krow + l31 * 64 + h2 * 8;
#pragma unroll
  for (int ks = 0; ks < 4; ++ks) { const bf16x8 a = *(const bf16x8*)(kp + ks * 16); s = MFMA32(a, qf[ks], s); }
  return s;
}
DI f32x16 qk_tile_s(const bf16_t* Krow, int stride, const bf16x8 (&qf)[4], int l31, int h2) {
  f32x16 s = zero16();
  const bf16_t* kp = Krow + l31 * stride + h2 * 8;
#pragma unroll
  for (int ks = 0; ks < 4; ++ks) { const bf16x8 a = *(const bf16x8*)(kp + ks * 16); s = MFMA32(a, qf[ks], s); }
  return s;
}
template <bool HAS_SEL>
DI void softmax_pv_t(f32x16& s, const bf16_t* VTp, int vstride, f32x16 (&o)[2], float& m, float& l, int l31, int h2, bool sel) {
  bf16x8 va[2][2];
#pragma unroll
  for (int dt = 0; dt < 2; ++dt)
#pragma unroll
    for (int sk = 0; sk < 2; ++sk) va[dt][sk] = ld_frag8x2(VTp + (size_t)(dt * 32 + l31) * vstride + sk * 16 + 4 * h2);
  float mx = s[0];
#pragma unroll
  for (int r = 1; r < 16; ++r) mx = fmaxf(mx, s[r]);
  if (HAS_SEL) mx = sel ? mx : -INFINITY;
  mx = xhalf_max(mx);
  const float mn = fmaxf(m, mx);
  const float alpha = __builtin_amdgcn_exp2f(m - mn);
  const float mref = (HAS_SEL && !sel) ? INFINITY : mn;
  float ps = 0.f;
#pragma unroll
  for (int r = 0; r < 16; ++r) { s[r] = __builtin_amdgcn_exp2f(s[r] - mref); ps += s[r]; }
  l = l * alpha + ps; m = mn;
#pragma unroll
  for (int dt = 0; dt < 2; ++dt)
#pragma unroll
    for (int r = 0; r < 16; ++r) o[dt][r] *= alpha;
  const bf16x8 p0 = pack8<0>(s), p1 = pack8<8>(s);
#pragma unroll
  for (int dt = 0; dt < 2; ++dt) { o[dt] = MFMA32(va[dt][0], p0, o[dt]); o[dt] = MFMA32(va[dt][1], p1, o[dt]); }
}
DI void softmax_pv(f32x16& s, const bf16_t* VTp, int vstride, f32x16 (&o)[2], float& m, float& l, int l31, int h2) { softmax_pv_t<false>(s, VTp, vstride, o, m, l, l31, h2, true); }

constexpr int AD_KSTR = 72, AD_VSTR = 68;
constexpr int AD_BUF = 64 * AD_KSTR * 2 + 64 * AD_VSTR * 2;
struct AdTile { u32x4 k, v; };
DI AdTile ad_load(const bf16_t* Kg, const bf16_t* Vg, int key0, int tidf) {
  AdTile r; const int row = tidf >> 3, ch = tidf & 7;
  r.k = *(const u32x4*)(Kg + (size_t)(key0 + row) * 64 + ch * 8);
  r.v = *(const u32x4*)(Vg + (size_t)row * T + key0 + ch * 8);
  return r;
}
DI void ad_store(const AdTile& r, char* buf, int tidf) {
  const int row = tidf >> 3, ch = tidf & 7;
  *(u32x4*)(buf + (row * AD_KSTR + ch * 8) * 2) = r.k;
  char* vp = buf + 64 * AD_KSTR * 2 + (row * AD_VSTR + ch * 8) * 2;
  *(u32x2*)vp = (u32x2){r.v[0], r.v[1]}; *(u32x2*)(vp + 8) = (u32x2){r.v[2], r.v[3]};
}
template <bool HAS_SEL>
DI void softmax_pv64(const bf16_t* Kb, const bf16_t* Vb, const bf16x8 (&qf)[4], f32x16 (&o)[2], float& m, float& l, int l31, int h2, bool sel) {
  f32x16 s0 = qk_tile_s(Kb, AD_KSTR, qf, l31, h2);
  f32x16 s1 = qk_tile_s(Kb + 32 * AD_KSTR, AD_KSTR, qf, l31, h2);
  float mx = fmaxf(s0[0], s1[0]);
#pragma unroll
  for (int r = 1; r < 16; ++r) mx = fmaxf(mx, fmaxf(s0[r], s1[r]));
  if (HAS_SEL) mx = sel ? mx : -INFINITY;
  mx = xhalf_max(mx);
  const float mn = fmaxf(m, mx);
  const float alpha = __builtin_amdgcn_exp2f(m - mn);
  const float mref = (HAS_SEL && !sel) ? INFINITY : mn;
  float ps = 0.f;
#pragma unroll
  for (int r = 0; r < 16; ++r) { s0[r] = __builtin_amdgcn_exp2f(s0[r] - mref); s1[r] = __builtin_amdgcn_exp2f(s1[r] - mref); ps += s0[r] + s1[r]; }
  l = l * alpha + ps; m = mn;
#pragma unroll
  for (int dt = 0; dt < 2; ++dt)
#pragma unroll
    for (int r = 0; r < 16; ++r) o[dt][r] *= alpha;
  const bf16x8 p0 = pack8<0>(s0), p1 = pack8<8>(s0), p2 = pack8<0>(s1), p3 = pack8<8>(s1);
#pragma unroll
  for (int dt = 0; dt < 2; ++dt) {
    const bf16_t* vp = Vb + (size_t)(dt * 32 + l31) * AD_VSTR + 4 * h2;
    o[dt] = MFMA32(ld_frag8x2(vp), p0, o[dt]);
    o[dt] = MFMA32(ld_frag8x2(vp + 16), p1, o[dt]);
    o[dt] = MFMA32(ld_frag8x2(vp + 32), p2, o[dt]);
    o[dt] = MFMA32(ld_frag8x2(vp + 48), p3, o[dt]);
  }
}
DI void ph_attnD(const Params& p, int layer, int* ctr, char* smem, int* s_pair) {
  float* imps = (float*)smem;
  float* impf = (float*)(smem + 34816);
  unsigned* smask = (unsigned*)(smem + 43008);
  unsigned* s_union = (unsigned*)(smem + 43008 + 256);
  char* kvbuf = smem + 49152;
  for (;;) {
    int tidf = threadIdx.x; asm volatile("" : "+v"(tidf));
    const int lane = tidf & 63, wid = tidf >> 6, h = wid & 3, qs = wid >> 2, l31 = lane & 31, h2 = lane >> 5;
    __syncthreads();
    if (tidf == 0) { *s_pair = atomicAdd(ctr, 1); *s_union = 0u; }
    __syncthreads();
    const int it = *s_pair;
    if (it >= 1024) break;
    const int b = it & 31, q0 = (31 - (it >> 5)) * 64;
    const int qw = q0 + 32 * qs;
    const int t = qw + l31, cur = q0 >> 6;
    const size_t tok = (size_t)b * T + t;
    bf16x8 qf[4];
    {
      const bf16_t* qp = p.QD() + ((size_t)(b * 4 + h) * T + t) * 64 + h2 * 8;
#pragma unroll
      for (int ks = 0; ks < 4; ++ks) qf[ks] = *(const bf16x8*)(qp + ks * 16);
    }
    const float g0 = p.DG()[tok * 12 + h * 3 + 0], g1 = p.DG()[tok * 12 + h * 3 + 1], g2 = p.DG()[tok * 12 + h * 3 + 2];
    f32x16 ofin[2];
    {
      const bf16_t* Kc = p.KCMP() + (size_t)b * 128 * 64;
      const bf16_t* Vc = p.VCMPT() + (size_t)b * 64 * 128;
      const int nkt = min(4, (qw >> 9) + 1);
      f32x16 o[2]; o[0] = zero16(); o[1] = zero16();
      float m = -1e30f, l = 0.f;
      for (int kt = 0; kt < nkt; ++kt) {
        f32x16 s = qk_tile(Kc + kt * 32 * 64, qf, l31, h2);
#pragma unroll
        for (int r = 0; r < 16; ++r) { const int n = kt * 32 + crow(r, h2); if (16 * n + 31 > t) s[r] = -INFINITY; }
        softmax_pv(s, Vc + kt * 32, 128, o, m, l, l31, h2);
      }
      l = xhalf_sum(l);
      const float il = l > 0.f ? 1.f / l : 0.f;
      const float gi = g0 * il;
#pragma unroll
      for (int dt = 0; dt < 2; ++dt)
#pragma unroll
        for (int r = 0; r < 16; ++r) ofin[dt][r] = gi * o[dt][r];
      float carry = 0.f;
#pragma unroll
      for (int kt = 0; kt < 4; ++kt) {
        f32x16 s;
        if (kt < nkt) {
          s = qk_tile(Kc + kt * 32 * 64, qf, l31, h2);
#pragma unroll
          for (int r = 0; r < 16; ++r) { const int n = kt * 32 + crow(r, h2); s[r] = (16 * n + 31 > t) ? 0.f : __builtin_amdgcn_exp2f(s[r] - m) * il; }
        } else s = zero16();
        float X[4];
#pragma unroll
        for (int g = 0; g < 4; ++g) X[g] = shx(s[4 * g + 3], 32);
#pragma unroll
        for (int g = 0; g < 4; ++g) {
          const float G = (s[4 * g] + s[4 * g + 1]) + (s[4 * g + 2] + s[4 * g + 3]);
          const float prev_other = g > 0 ? X[g - 1] : carry;
          imps[(wid * 32 + l31) * 33 + 8 * kt + 2 * g + h2] = G + (h2 ? X[g] : prev_other);
        }
        carry = X[3];
      }
    }
    __syncthreads();
    {
      const int tt = tidf >> 3, jg = tidf & 7, wq = (tt >> 5) * 4, tl = tt & 31;
#pragma unroll
      for (int i = 0; i < 4; ++i) {
        const int j = jg * 4 + i;
        impf[tt * 32 + j] = (imps[((wq + 0) * 32 + tl) * 33 + j] + imps[((wq + 1) * 32 + tl) * 33 + j]) + (imps[((wq + 2) * 32 + tl) * 33 + j] + imps[((wq + 3) * 32 + tl) * 33 + j]);
      }
    }
    __syncthreads();
    {
      const int tt = tidf >> 3, jg = tidf & 7;
      float v[32];
#pragma unroll
      for (int j = 0; j < 32; ++j) {
        float x = impf[tt * 32 + j];
        if (j > cur) x = -1e30f; else if (j == 0 || j == cur || j == cur - 1) x = 1e6f;
        v[j] = x;
      }
      unsigned bits = 0u;
#pragma unroll
      for (int i = 0; i < 4; ++i) {
        int rank = 0; float vj = 0.f;
#pragma unroll
        for (int j = 0; j < 32; ++j) if (j == jg * 4 + i) vj = v[j];
        const int jj = jg * 4 + i;
#pragma unroll
        for (int j = 0; j < 32; ++j) rank += (v[j] > vj || (v[j] == vj && j < jj)) ? 1 : 0;
        if (rank < 8 && jj <= cur) bits |= 1u << jj;
      }
      bits |= shx(bits, 1); bits |= shx(bits, 2); bits |= shx(bits, 4);
      if (jg == 0) { smask[tt] = bits; atomicOr(s_union, bits); }
    }
    __syncthreads();
    {
      const unsigned mymask = smask[32 * qs + l31];
      unsigned rem = *s_union;
      const bf16_t* Ks = p.KV() + (size_t)(2 * NB + b) * T * 64;
      const bf16_t* Vs = p.KV() + (size_t)(3 * NB + b) * 64 * T;
      f32x16 o[2]; o[0] = zero16(); o[1] = zero16();
      float m = -1e30f, l = 0.f;
      int j = __builtin_ctz(rem); rem &= rem - 1;
      { const AdTile r = ad_load(Ks, Vs, j * 64, tidf); ad_store(r, kvbuf, tidf); }
      __syncthreads();
      int pb = 0;
      for (;;) {
        const bool more = rem != 0u;
        const int jn = more ? __builtin_ctz(rem) : 0;
        AdTile nx;
        if (more) nx = ad_load(Ks, Vs, jn * 64, tidf);
        const char* buf = kvbuf + pb * AD_BUF;
        const bool sel = (mymask >> j) & 1u;
        if (j < cur) softmax_pv64<true>((const bf16_t*)buf, (const bf16_t*)(buf + 64 * AD_KSTR * 2), qf, o, m, l, l31, h2, sel);
        else
#pragma unroll
        for (int kh = 0; kh < 2; ++kh) {
          const int key0 = j * 64 + kh * 32;
          if (key0 <= qw + 31) {
            f32x16 s = qk_tile_s((const bf16_t*)buf + kh * 32 * AD_KSTR, AD_KSTR, qf, l31, h2);
            if (j == cur) {
#pragma unroll
              for (int r = 0; r < 16; ++r) { const int key = key0 + crow(r, h2); if (key > t) s[r] = -INFINITY; }
            }
            softmax_pv_t<true>(s, (const bf16_t*)(buf + 64 * AD_KSTR * 2) + kh * 32, AD_VSTR, o, m, l, l31, h2, sel);
          }
        }
        if (more) ad_store(nx, kvbuf + (pb ^ 1) * AD_BUF, tidf);
        __syncthreads();
        if (!more) break;
        rem &= rem - 1; j = jn; pb ^= 1;
      }
      l = xhalf_sum(l);
      const float il = l > 0.f ? g1 / l : 0.f;
#pragma unroll
      for (int dt = 0; dt < 2; ++dt)
#pragma unroll
        for (int r = 0; r < 16; ++r) ofin[dt][r] += il * o[dt][r];
    }
    {
      const bf16_t* Kw = p.KV() + (size_t)(4 * NB + b) * T * 64;
      const bf16_t* Vw = p.KV() + (size_t)(5 * NB + b) * 64 * T;
      f32x16 o[2]; o[0] = zero16(); o[1] = zero16();
      float m = -1e30f, l = 0.f;
      int k0 = max(0, q0 - 512);
      { const AdTile r = ad_load(Kw, Vw, k0, tidf); ad_store(r, kvbuf, tidf); }
      __syncthreads();
      int pb = 0;
      for (;;) {
        const bool more = k0 + 64 <= q0;
        AdTile nx;
        if (more) nx = ad_load(Kw, Vw, k0 + 64, tidf);
        const char* buf = kvbuf + pb * AD_BUF;
        if (k0 + 63 <= qw && k0 + 512 > qw + 31) softmax_pv64<false>((const bf16_t*)buf, (const bf16_t*)(buf + 64 * AD_KSTR * 2), qf, o, m, l, l31, h2, true);
        else
#pragma unroll
        for (int kh = 0; kh < 2; ++kh) {
          const int key0 = k0 + kh * 32;
          if (key0 <= qw + 31 && key0 + 31 + 512 > qw) {
            f32x16 s = qk_tile_s((const bf16_t*)buf + kh * 32 * AD_KSTR, AD_KSTR, qf, l31, h2);
            if (key0 + 31 > qw || key0 + 512 <= qw + 31) {
#pragma unroll
              for (int r = 0; r < 16; ++r) { const int key = key0 + crow(r, h2); if (key > t || t - key >= 512) s[r] = -INFINITY; }
            }
            softmax_pv(s, (const bf16_t*)(buf + 64 * AD_KSTR * 2) + kh * 32, AD_VSTR, o, m, l, l31, h2);
          }
        }
        if (more) ad_store(nx, kvbuf + (pb ^ 1) * AD_BUF, tidf);
        __syncthreads();
        if (!more) break;
        k0 += 64; pb ^= 1;
      }
      l = xhalf_sum(l);
      const float il = l > 0.f ? g2 / l : 0.f;
#pragma unroll
      for (int dt = 0; dt < 2; ++dt)
#pragma unroll
        for (int r = 0; r < 16; ++r) ofin[dt][r] += il * o[dt][r];
    }
#pragma unroll
    for (int dt = 0; dt < 2; ++dt)
#pragma unroll
      for (int g = 0; g < 4; ++g) {
        const int d0 = dt * 32 + 8 * g + 4 * h2;
        const u32x2 gz = *(const u32x2*)(p.GZ() + (size_t)4 * NTOK * 256 + tok * 256 + h * 64 + d0);
        const float z0 = __uint_as_float(gz.x << 16), z1 = __uint_as_float(gz.x & 0xffff0000u), z2 = __uint_as_float(gz.y << 16), z3 = __uint_as_float(gz.y & 0xffff0000u);
        u32x2 o2 = {pack2(ofin[dt][4 * g] * z0, ofin[dt][4 * g + 1] * z1), pack2(ofin[dt][4 * g + 2] * z2, ofin[dt][4 * g + 3] * z3)};
        *(u32x2*)(p.YMIX() + tok * 1024 + 768 + h * 64 + d0) = o2;
      }
  }
}


struct AaTile { u32x4 k0, v0, k1, v1; };
DI AaTile aa_load(const bf16_t* Kg, const bf16_t* Vg, int key0, int tidf) {
  AaTile r; const int row = tidf >> 3, ch = tidf & 7;
  r.k0 = *(const u32x4*)(Kg + (size_t)(key0 + row) * 64 + ch * 8);
  r.v0 = *(const u32x4*)(Vg + (size_t)row * T + key0 + ch * 8);
  r.k1 = *(const u32x4*)(Kg + (size_t)T * 64 + (size_t)(key0 + row) * 64 + ch * 8);
  r.v1 = *(const u32x4*)(Vg + (size_t)T * 64 + (size_t)row * T + key0 + ch * 8);
  return r;
}
DI void aa_store(const AaTile& r, char* buf, int tidf) {
  AdTile a; a.k = r.k0; a.v = r.v0; ad_store(a, buf, tidf);
  a.k = r.k1; a.v = r.v1; ad_store(a, buf + AD_BUF, tidf);
}
DI void ph_attnA_fb(const Params& p, int layer, int item, char* smem) {
  int tidf = threadIdx.x; asm volatile("" : "+v"(tidf));
  const int lane = tidf & 63, wid = tidf >> 6, h = wid & 3, qs = wid >> 2, l31 = lane & 31, h2 = lane >> 5, g = h >> 1;
  const int b = item >> 5, q0 = (item & 31) * 64;
  const int qw = q0 + 32 * qs, t = qw + l31;
  const size_t tok = (size_t)b * T + t;
  bf16x8 qf[4];
  {
    const bf16_t* qp = p.QA() + ((size_t)(b * 4 + h) * T + t) * 64 + h2 * 8;
#pragma unroll
    for (int ks = 0; ks < 4; ++ks) qf[ks] = *(const bf16x8*)(qp + ks * 16);
  }
  const bf16_t* Kg = p.KA() + (size_t)(b * 2) * T * 64;
  const bf16_t* Vg = p.VAT() + (size_t)(b * 2) * 64 * T;
  f32x16 o[2]; o[0] = zero16(); o[1] = zero16();
  float m = -1e30f, l = 0.f;
  int k0 = max(0, q0 - 128);
  __syncthreads();
  { const AaTile r = aa_load(Kg, Vg, k0, tidf); aa_store(r, smem, tidf); }
  __syncthreads();
  int pb = 0;
  for (;;) {
    const bool more = k0 + 64 <= q0;
    AaTile nx;
    if (more) nx = aa_load(Kg, Vg, k0 + 64, tidf);
    const char* buf = smem + pb * (2 * AD_BUF) + g * AD_BUF;
#pragma unroll
    for (int kh = 0; kh < 2; ++kh) {
      const int key0 = k0 + kh * 32;
      if (key0 <= qw + 31 && key0 + 31 + 128 > qw) {
        f32x16 s = qk_tile_s((const bf16_t*)buf + kh * 32 * AD_KSTR, AD_KSTR, qf, l31, h2);
        if (key0 + 31 > qw || key0 + 128 <= qw + 31) {
#pragma unroll
          for (int r = 0; r < 16; ++r) { const int key = key0 + crow(r, h2); if (key > t || t - key >= 128) s[r] = -INFINITY; }
        }
        softmax_pv(s, (const bf16_t*)(buf + 64 * AD_KSTR * 2) + kh * 32, AD_VSTR, o, m, l, l31, h2);
      }
    }
    if (more) aa_store(nx, smem + (pb ^ 1) * (2 * AD_BUF), tidf);
    __syncthreads();
    if (!more) break;
    k0 += 64; pb ^= 1;
  }
  l = xhalf_sum(l);
  const float sink = p.a_sinks[layer * 4 + h] * 1.4426950408889634f;
  const float M = fmaxf(m, sink);
  const float sc = __builtin_amdgcn_exp2f(m - M);
  const float inv = sc / (l * sc + __builtin_amdgcn_exp2f(sink - M));
#pragma unroll
  for (int dt = 0; dt < 2; ++dt)
#pragma unroll
    for (int gq = 0; gq < 4; ++gq) {
      const int d0 = dt * 32 + 8 * gq + 4 * h2;
      const u32x2 gz = *(const u32x2*)(p.GZ() + tok * 256 + h * 64 + d0);
      const float z0 = __uint_as_float(gz.x << 16), z1 = __uint_as_float(gz.x & 0xffff0000u), z2 = __uint_as_float(gz.y << 16), z3 = __uint_as_float(gz.y & 0xffff0000u);
      u32x2 o2 = {pack2(o[dt][4 * gq] * inv * z0, o[dt][4 * gq + 1] * inv * z1), pack2(o[dt][4 * gq + 2] * inv * z2, o[dt][4 * gq + 3] * inv * z3)};
      *(u32x2*)(p.YMIX() + tok * 1024 + h * 64 + d0) = o2;
    }
}

DI float logsigmoidf_(float x) { return fminf(x, 0.f) - __logf(1.f + __expf(-fabsf(x))); }
DI void mlstm_gates(const Params& p, size_t tok0, int hh, float* bc, float* ig, int tid) {
  if (tid < 64) {
    const int s0 = 2 * tid;
    const float lf0 = logsigmoidf_(p.IFG()[(tok0 + s0) * 8 + 4 + hh]), lf1 = logsigmoidf_(p.IFG()[(tok0 + s0 + 1) * 8 + 4 + hh]);
    const float pair = lf0 + lf1;
    float x = pair;
#pragma unroll
    for (int off = 1; off < 64; off <<= 1) { const float y = shup(x, off); if (tid >= off) x += y; }
    const float excl = x - pair;
    bc[s0] = excl + lf0; bc[s0 + 1] = excl + pair;
    ig[s0] = p.IFG()[(tok0 + s0) * 8 + hh]; ig[s0 + 1] = p.IFG()[(tok0 + s0 + 1) * 8 + hh];
  }
}
DI void conv8(const bf16_t* raw, int t, int dg, const float (&cw)[4][8], const float (&cb)[8], float (&out)[8]) {
#pragma unroll
  for (int e = 0; e < 8; ++e) out[e] = cb[e];
#pragma unroll
  for (int j = 0; j < 4; ++j) {
    const int ts = t - 3 + j;
    if (ts >= 0) {
      const u32x4 row = *(const u32x4*)(raw + (size_t)ts * 64 + dg * 8);
#pragma unroll
      for (int e2 = 0; e2 < 4; ++e2) { out[2 * e2] += cw[j][2 * e2] * __uint_as_float(row[e2] << 16); out[2 * e2 + 1] += cw[j][2 * e2 + 1] * __uint_as_float(row[e2] & 0xffff0000u); }
    }
  }
#pragma unroll
  for (int e = 0; e < 8; ++e) out[e] = siluf_(out[e]);
}
DI void conv_rows_load(const bf16_t* raw, int tfirst, int dg, u32x4 (&r)[7]) {
#pragma unroll
  for (int j = 0; j < 7; ++j) {
    const int ts = tfirst + j;
    const u32x4 v = *(const u32x4*)(raw + (size_t)max(ts, 0) * 64 + dg * 8);
    r[j] = ts >= 0 ? v : (u32x4){0u, 0u, 0u, 0u};
  }
}
template <int I>
DI void conv_rows_compute(const u32x4 (&r)[7], const float (&cw)[4][8], const float (&cb)[8], float (&out)[8]) {
#pragma unroll
  for (int e = 0; e < 8; ++e) out[e] = cb[e];
#pragma unroll
  for (int j = 0; j < 4; ++j) {
    const u32x4 row = r[I + j];
#pragma unroll
    for (int e2 = 0; e2 < 4; ++e2) { out[2 * e2] += cw[j][2 * e2] * __uint_as_float(row[e2] << 16); out[2 * e2 + 1] += cw[j][2 * e2 + 1] * __uint_as_float(row[e2] & 0xffff0000u); }
  }
#pragma unroll
  for (int e = 0; e < 8; ++e) out[e] = siluf_(out[e]);
}
DI void load_conv_w(const Params& p, int layer, int ch0, int dg, float (&cw)[4][8], float (&cb)[8]) {
#pragma unroll
  for (int j = 0; j < 4; ++j)
#pragma unroll
    for (int e = 0; e < 8; ++e) cw[j][e] = p.conv_w[layer * 2048 + j * 512 + ch0 + dg * 8 + e];
#pragma unroll
  for (int e = 0; e < 8; ++e) cb[e] = p.conv_b[layer * 512 + ch0 + dg * 8 + e];
}
DI void delta_state_loadA(const bf16_t* VT, bf16x8 (&a)[8], int wid, int l31, int h2) {
  const int mt = wid >> 1;
#pragma unroll
  for (int ks = 0; ks < 8; ++ks) a[ks] = *(const bf16x8*)(VT + (size_t)(mt * 32 + l31) * T + ks * 16 + h2 * 8);
}
DI void delta_state(const bf16x8 (&a)[8], const bf16_t* KT, float* out, int wid, int l31, int h2) {
  const int mt = wid >> 1, nt = wid & 1;
  f32x16 acc = zero16();
#pragma unroll
  for (int ks = 0; ks < 8; ++ks) {
    const bf16x8 bb = *(const bf16x8*)(KT + (nt * 32 + l31) * 136 + ks * 16 + h2 * 8);
    acc = MFMA32(a[ks], bb, acc);
  }
#pragma unroll
  for (int r = 0; r < 16; ++r) out[(mt * 32 + crow(r, h2)) * 64 + nt * 32 + l31] = acc[r];
}
DI void ph_mlstm_local(const Params& p, int layer, int item, char* smem) {
  float* bc = (float*)smem; float* ig = bc + 128; float* wv = ig + 128;
  bf16_t* KwT = (bf16_t*)(smem + 2048);
  float* nred = (float*)(smem + 2048 + 64 * 136 * 2);
  const int tid = tid_opaque(), lane = tid & 63, wid = tid >> 6, l31 = lane & 31, h2 = lane >> 5;
  const int b = item >> 6, hh = (item >> 4) & 3, c = item & 15, t0 = c * 128;
  const size_t tok0 = (size_t)b * T + t0;
  const int dg = tid & 7, sb = tid >> 3;
  u32x4 rows[7];
  conv_rows_load(p.QKB() + ((size_t)(b * 8 + 4 + hh) * T) * 64, t0 + 4 * sb - 3, dg, rows);
  bf16x8 af[8];
  delta_state_loadA(p.VBT() + (size_t)(b * 4 + hh) * 64 * T + t0, af, wid, l31, h2);
  float cw[4][8], cb[8];
  load_conv_w(p, layer, 256 + hh * 64, dg, cw, cb);
  __syncthreads();
  mlstm_gates(p, tok0, hh, bc, ig, tid);
  __syncthreads();
  if (tid < 128) wv[tid] = __expf(bc[127] - bc[tid] + ig[tid]);
  __syncthreads();
  {
    float v0[8], v1[8], v2[8], v3[8];
    conv_rows_compute<0>(rows, cw, cb, v0); conv_rows_compute<1>(rows, cw, cb, v1);
    conv_rows_compute<2>(rows, cw, cb, v2); conv_rows_compute<3>(rows, cw, cb, v3);
    const f32x4 w4 = *(const f32x4*)(wv + 4 * sb);
#pragma unroll
    for (int e = 0; e < 8; ++e) {
      u32x2 pk = {pack2(v0[e] * w4[0], v1[e] * w4[1]), pack2(v2[e] * w4[2], v3[e] * w4[3])};
      *(u32x2*)(KwT + (dg * 8 + e) * 136 + 4 * sb) = pk;
    }
  }
  __syncthreads();
  delta_state(af, KwT, p.BST() + (size_t)item * 4096, wid, l31, h2);
  {
    const int k = tid & 63, qd = tid >> 6;
    float a = 0.f;
#pragma unroll 8
    for (int s = 0; s < 32; ++s) a += bf2f(KwT[k * 136 + qd * 32 + s]);
    nred[qd * 64 + k] = a;
  }
  __syncthreads();
  if (tid < 64) p.BN()[(size_t)item * 64 + tid] = (nred[tid] + nred[64 + tid]) + (nred[128 + tid] + nred[192 + tid]);
  if (tid == 0) p.BG()[item] = bc[127];
}
DI void ph_mlstm_scan(const Params& p, int bh) {
  const int tid = tid_opaque();
  f32x4 C[4];
#pragma unroll
  for (int i = 0; i < 4; ++i) C[i] = (f32x4){0.f, 0.f, 0.f, 0.f};
  float n = 0.f;
  for (int c = 0; c < 16; ++c) {
    const int item = bh * 16 + c;
    const float g = __expf(p.BG()[item]);
    f32x4* ptr = (f32x4*)(p.BST() + (size_t)item * 4096 + tid * 16);
#pragma unroll
    for (int i = 0; i < 4; ++i) { const f32x4 tmp = ptr[i]; ptr[i] = C[i]; C[i] = g * C[i] + tmp; }
    if (tid < 64) { const float tmp = p.BN()[(size_t)item * 64 + tid]; p.BN()[(size_t)item * 64 + tid] = n; n = g * n + tmp; }
  }
}
DI void pv_only(const f32x16& s, const bf16_t* VTp, int vstride, f32x16 (&o)[2], int l31, int h2) {
  const bf16x8 p0 = pack8<0>(s), p1 = pack8<8>(s);
#pragma unroll
  for (int dt = 0; dt < 2; ++dt) {
    const bf16_t* vp = VTp + (size_t)(dt * 32 + l31) * vstride + 4 * h2;
    o[dt] = MFMA32(ld_frag8x2(vp), p0, o[dt]);
    o[dt] = MFMA32(ld_frag8x2(vp + 16), p1, o[dt]);
  }
}
DI bf16x8 frag_from_f32(const float* ptr) {
  const f32x4 a = *(const f32x4*)ptr, b = *(const f32x4*)(ptr + 4);
  u32x4 t = {pack2(a[0], a[1]), pack2(a[2], a[3]), pack2(b[0], b[1]), pack2(b[2], b[3])};
  return __builtin_bit_cast(bf16x8, t);
}
constexpr int VT_LSTR = 132;
DI void vt_chunk_load(const bf16_t* VT, int tid, u32x4 (&r)[4]) {
  const int d = tid >> 2, part = tid & 3;
#pragma unroll
  for (int j = 0; j < 4; ++j) r[j] = *(const u32x4*)(VT + (size_t)d * T + part * 32 + j * 8);
}
DI void vt_chunk_store(const u32x4 (&r)[4], bf16_t* lds, int tid) {
  const int d = tid >> 2, part = tid & 3;
#pragma unroll
  for (int j = 0; j < 4; ++j) {
    bf16_t* q = lds + d * VT_LSTR + part * 32 + j * 8;
    *(u32x2*)q = (u32x2){r[j][0], r[j][1]}; *(u32x2*)(q + 4) = (u32x2){r[j][2], r[j][3]};
  }
}
DI void ph_mlstm_out(const Params& p, int layer, int item, char* smem) {
  float* bc = (float*)smem; float* ig = bc + 128;
  bf16_t* qc = (bf16_t*)(smem + 2048);
  bf16_t* kc = qc + 128 * 72;
  bf16_t* vt = kc + 128 * 72;
  const int tid = tid_opaque(), lane = tid & 63, wid = tid >> 6, l31 = lane & 31, h2 = lane >> 5;
  const int b = item >> 6, hh = (item >> 4) & 3, c = item & 15, t0 = c * 128;
  const size_t tok0 = (size_t)b * T + t0;
  const int dg = tid & 7, sb = tid >> 3;
  u32x4 rq[7], rk[7];
  conv_rows_load(p.QKB() + ((size_t)(b * 8 + hh) * T) * 64, t0 + 4 * sb - 3, dg, rq);
  conv_rows_load(p.QKB() + ((size_t)(b * 8 + 4 + hh) * T) * 64, t0 + 4 * sb - 3, dg, rk);
  u32x4 rv[4];
  vt_chunk_load(p.VBT() + (size_t)(b * 4 + hh) * 64 * T + t0, tid, rv);
  __syncthreads();
  mlstm_gates(p, tok0, hh, bc, ig, tid);
  {
    float cw[4][8], cb[8];
    load_conv_w(p, layer, hh * 64, dg, cw, cb);
    float v[8];
#define CONV_ST(I, R, DST, SC) do { conv_rows_compute<I>(R, cw, cb, v); \
      u32x4 w_ = {pack2(v[0] * (SC), v[1] * (SC)), pack2(v[2] * (SC), v[3] * (SC)), pack2(v[4] * (SC), v[5] * (SC)), pack2(v[6] * (SC), v[7] * (SC))}; \
      *(u32x4*)((DST) + (4 * sb + (I)) * 72 + dg * 8) = w_; } while (0)
    CONV_ST(0, rq, qc, 0.125f); CONV_ST(1, rq, qc, 0.125f); CONV_ST(2, rq, qc, 0.125f); CONV_ST(3, rq, qc, 0.125f);
    load_conv_w(p, layer, 256 + hh * 64, dg, cw, cb);
    CONV_ST(0, rk, kc, 1.f); CONV_ST(1, rk, kc, 1.f); CONV_ST(2, rk, kc, 1.f); CONV_ST(3, rk, kc, 1.f);
#undef CONV_ST
  }
  vt_chunk_store(rv, vt, tid);
  const int tq = 32 * wid + l31;
  const float* Cs = p.BST() + (size_t)item * 4096;
  const float* ns = p.BN() + (size_t)item * 64;
  f32x4 cst[2][4][2], nst[4][2];
#pragma unroll
  for (int ks = 0; ks < 4; ++ks) {
#pragma unroll
    for (int dt = 0; dt < 2; ++dt) { cst[dt][ks][0] = *(const f32x4*)(Cs + (dt * 32 + l31) * 64 + ks * 16 + h2 * 8); cst[dt][ks][1] = *(const f32x4*)(Cs + (dt * 32 + l31) * 64 + ks * 16 + h2 * 8 + 4); }
    nst[ks][0] = *(const f32x4*)(ns + ks * 16 + h2 * 8); nst[ks][1] = *(const f32x4*)(ns + ks * 16 + h2 * 8 + 4);
  }
  u32x2 gz1[2][4], gz2[2][4];
#pragma unroll
  for (int dt = 0; dt < 2; ++dt)
#pragma unroll
    for (int g = 0; g < 4; ++g) {
      const int d0 = dt * 32 + 8 * g + 4 * h2;
      gz1[dt][g] = *(const u32x2*)(p.GZ() + (size_t)1 * NTOK * 256 + (tok0 + tq) * 256 + hh * 64 + d0);
      gz2[dt][g] = *(const u32x2*)(p.GZ() + (size_t)2 * NTOK * 256 + (tok0 + tq) * 256 + hh * 64 + d0);
    }
  __syncthreads();
  if (tid < 128) ig[tid] = ig[tid] - bc[tid];
  __syncthreads();
  bf16x8 qf[4];
#pragma unroll
  for (int ks = 0; ks < 4; ++ks) qf[ks] = *(const bf16x8*)(qc + tq * 72 + ks * 16 + h2 * 8);
  const float bt = bc[tq];
  f32x16 o[2]; o[0] = zero16(); o[1] = zero16();
  float dsum = 0.f;
  for (int kt = 0; kt <= wid; ++kt) {
    f32x16 s = qk_tile_s(kc + kt * 32 * 72, 72, qf, l31, h2);
#pragma unroll
    for (int r = 0; r < 16; ++r) {
      const int sidx = 32 * kt + crow(r, h2);
      float val = s[r] * __expf(bt + ig[sidx]);
      if (sidx > tq) val = 0.f;
      s[r] = val; dsum += val;
    }
    pv_only(s, vt + kt * 32, VT_LSTR, o, l31, h2);
  }
  dsum += shx(dsum, 32);
  f32x16 oi[2]; oi[0] = zero16(); oi[1] = zero16();
  float qn = 0.f;
#pragma unroll
  for (int ks = 0; ks < 4; ++ks) {
#pragma unroll
    for (int dt = 0; dt < 2; ++dt) {
      const f32x4 a_ = cst[dt][ks][0], b_ = cst[dt][ks][1];
      u32x4 t_ = {pack2(a_[0], a_[1]), pack2(a_[2], a_[3]), pack2(b_[0], b_[1]), pack2(b_[2], b_[3])};
      oi[dt] = MFMA32(__builtin_bit_cast(bf16x8, t_), qf[ks], oi[dt]);
    }
    const u32x4 qu = __builtin_bit_cast(u32x4, qf[ks]);
    const f32x4 n0 = nst[ks][0], n1 = nst[ks][1];
    qn += __uint_as_float(qu[0] << 16) * n0[0] + __uint_as_float(qu[0] & 0xffff0000u) * n0[1] + __uint_as_float(qu[1] << 16) * n0[2] + __uint_as_float(qu[1] & 0xffff0000u) * n0[3];
    qn += __uint_as_float(qu[2] << 16) * n1[0] + __uint_as_float(qu[2] & 0xffff0000u) * n1[1] + __uint_as_float(qu[3] << 16) * n1[2] + __uint_as_float(qu[3] & 0xffff0000u) * n1[3];
  }
  qn += shx(qn, 32);
  const float ebt = __expf(bt);
  const float den = dsum + ebt * qn;
  const float inv = 1.f / fmaxf(fabsf(den), 1.f);
  const size_t tok = tok0 + tq;
#pragma unroll
  for (int dt = 0; dt < 2; ++dt)
#pragma unroll
    for (int g = 0; g < 4; ++g) {
      const int d0 = dt * 32 + 8 * g + 4 * h2;
      const u32x2 g1 = gz1[dt][g], g2 = gz2[dt][g];
      float z[4] = {__uint_as_float(g1.x << 16) * __uint_as_float(g2.x << 16), __uint_as_float(g1.x & 0xffff0000u) * __uint_as_float(g2.x & 0xffff0000u),
                    __uint_as_float(g1.y << 16) * __uint_as_float(g2.y << 16), __uint_as_float(g1.y & 0xffff0000u) * __uint_as_float(g2.y & 0xffff0000u)};
      float hv[4];
#pragma unroll
      for (int i = 0; i < 4; ++i) hv[i] = (o[dt][4 * g + i] + ebt * oi[dt][4 * g + i]) * inv * z[i];
      u32x2 o2 = {pack2(hv[0], hv[1]), pack2(hv[2], hv[3])};
      *(u32x2*)(p.YMIX() + tok * 1024 + 256 + hh * 64 + d0) = o2;
    }
}


DI void ph_hgrn_local(const Params& p, int layer, int item, char* smem) {
  float* tot = (float*)smem;
  bf16_t* KdT = (bf16_t*)(smem + 1024);
  const int tid = tid_opaque(), lane = tid & 63, wid = tid >> 6, l31 = lane & 31, h2 = lane >> 5;
  const int b = item >> 6, hh = (item >> 4) & 3, c = item & 15, t0 = c * 128;
  const int k = tid & 63, qd = tid >> 6;
  float al[32], kk[32];
  bf16x8 af[8];
  delta_state_loadA(p.VCT() + (size_t)(b * 4 + hh) * 64 * T + t0, af, wid, l31, h2);
  {
    const float* gp = p.GC() + ((size_t)(b * 4 + hh) * T + t0 + 32 * qd) * 64 + k;
    float run = 0.f;
#pragma unroll
    for (int s = 0; s < 32; ++s) { const float g = gp[s * 64]; run += g; al[s] = run; kk[s] = 1.f - __expf(g); }
    __syncthreads();
    tot[qd * 64 + k] = run;
  }
  __syncthreads();
  float off = 0.f, aL = 0.f;
#pragma unroll
  for (int q = 0; q < 4; ++q) { const float v = tot[q * 64 + k]; aL += v; if (q < qd) off += v; }
#pragma unroll
  for (int s8 = 0; s8 < 4; ++s8) {
    float v[8];
#pragma unroll
    for (int e = 0; e < 8; ++e) v[e] = kk[s8 * 8 + e] * __expf(aL - (al[s8 * 8 + e] + off));
    u32x4 w = {pack2(v[0], v[1]), pack2(v[2], v[3]), pack2(v[4], v[5]), pack2(v[6], v[7])};
    *(u32x4*)(KdT + k * 136 + qd * 32 + s8 * 8) = w;
  }
  __syncthreads();
  delta_state(af, KdT, p.CST() + (size_t)item * 4096, wid, l31, h2);
  if (qd == 0) p.CAL()[(size_t)item * 64 + k] = aL;
}
DI void ph_hgrn_scan(const Params& p, int bh) {
  const int tid = tid_opaque();
  f32x4 S[4];
#pragma unroll
  for (int i = 0; i < 4; ++i) S[i] = (f32x4){0.f, 0.f, 0.f, 0.f};
  for (int c = 0; c < 16; ++c) {
    const int item = bh * 16 + c;
    const f32x4* dp = (const f32x4*)(p.CAL() + (size_t)item * 64 + (tid & 3) * 16);
    f32x4* ptr = (f32x4*)(p.CST() + (size_t)item * 4096 + tid * 16);
#pragma unroll
    for (int i = 0; i < 4; ++i) {
      const f32x4 a = dp[i];
      const f32x4 dec = {__expf(a[0]), __expf(a[1]), __expf(a[2]), __expf(a[3])};
      const f32x4 tmp = ptr[i]; ptr[i] = S[i]; S[i] = dec * S[i] + tmp;
    }
  }
}
DI void ph_hgrn_out(const Params& p, int layer, int item, char* smem) {
  float* a_lds = (float*)smem;
  float* tot = (float*)(smem + 128 * 68 * 4);
  bf16_t* kk_lds = (bf16_t*)(smem + 128 * 68 * 4 + 1024);
  bf16_t* vt = kk_lds + 128 * 72;
  const int tid = tid_opaque(), lane = tid & 63, wid = tid >> 6, l31 = lane & 31, h2 = lane >> 5;
  const int b = item >> 6, hh = (item >> 4) & 3, c = item & 15, t0 = c * 128;
  const size_t hbase = (size_t)(b * 4 + hh) * T + t0;
  const int tq = 32 * wid + l31;
  const size_t tok = (size_t)b * T + t0 + tq;
  u32x4 qu[4];
#pragma unroll
  for (int ks = 0; ks < 4; ++ks) qu[ks] = *(const u32x4*)(p.QC() + (hbase + tq) * 64 + ks * 16 + h2 * 8);
  u32x4 rv[4];
  vt_chunk_load(p.VCT() + (size_t)(b * 4 + hh) * 64 * T + t0, tid, rv);
  u32x2 gzv[2][4];
#pragma unroll
  for (int dt = 0; dt < 2; ++dt)
#pragma unroll
    for (int g = 0; g < 4; ++g) gzv[dt][g] = *(const u32x2*)(p.GZ() + (size_t)3 * NTOK * 256 + tok * 256 + hh * 64 + dt * 32 + 8 * g + 4 * h2);
  {
    const int k = tid & 63, qd = tid >> 6;
    float al[32];
    const float* gp = p.GC() + (hbase + 32 * qd) * 64 + k;
    float run = 0.f;
    __syncthreads();
#pragma unroll
    for (int s = 0; s < 32; ++s) { const float g = gp[s * 64]; run += g; al[s] = run; kk_lds[(32 * qd + s) * 72 + k] = f2bf(1.f - __expf(g)); }
    tot[qd * 64 + k] = run;
    vt_chunk_store(rv, vt, tid);
    __syncthreads();
    float off = 0.f;
#pragma unroll
    for (int q = 0; q < 4; ++q) { const float v = tot[q * 64 + k]; if (q < qd) off += v; }
#pragma unroll
    for (int s = 0; s < 32; ++s) a_lds[(32 * qd + s) * 68 + k] = al[s] + off;
  }
  const float* Ss = p.CST() + (size_t)item * 4096;
  f32x4 cst[2][4][2];
#pragma unroll
  for (int ks = 0; ks < 4; ++ks)
#pragma unroll
    for (int dt = 0; dt < 2; ++dt) { cst[dt][ks][0] = *(const f32x4*)(Ss + (dt * 32 + l31) * 64 + ks * 16 + h2 * 8); cst[dt][ks][1] = *(const f32x4*)(Ss + (dt * 32 + l31) * 64 + ks * 16 + h2 * 8 + 4); }
  __syncthreads();
  bf16x8 qi[4], qh[4];
#pragma unroll
  for (int ks = 0; ks < 4; ++ks) {
    const int k0 = ks * 16 + h2 * 8;
    float q8[8], e1[8], e2[8];
#pragma unroll
    for (int e2i = 0; e2i < 4; ++e2i) { q8[2 * e2i] = __uint_as_float(qu[ks][e2i] << 16); q8[2 * e2i + 1] = __uint_as_float(qu[ks][e2i] & 0xffff0000u); }
#pragma unroll
    for (int e = 0; e < 8; ++e) {
      const float a = a_lds[tq * 68 + k0 + e];
      const float r = wid > 0 ? a_lds[(32 * wid - 1) * 68 + k0 + e] : 0.f;
      e1[e] = q8[e] * __expf(a - r); e2[e] = q8[e] * __expf(a);
    }
    u32x4 w1 = {pack2(e1[0], e1[1]), pack2(e1[2], e1[3]), pack2(e1[4], e1[5]), pack2(e1[6], e1[7])};
    u32x4 w2 = {pack2(e2[0], e2[1]), pack2(e2[2], e2[3]), pack2(e2[4], e2[5]), pack2(e2[6], e2[7])};
    qi[ks] = __builtin_bit_cast(bf16x8, w1); qh[ks] = __builtin_bit_cast(bf16x8, w2);
  }
  f32x16 o[2]; o[0] = zero16(); o[1] = zero16();
  for (int kt = 0; kt <= wid; ++kt) {
    f32x16 s = zero16();
    const int srow = 32 * kt + l31;
#pragma unroll
    for (int ks = 0; ks < 4; ++ks) {
      const int k0 = ks * 16 + h2 * 8;
      const u32x4 ku = *(const u32x4*)(kk_lds + srow * 72 + k0);
      float v[8];
#pragma unroll
      for (int e = 0; e < 8; ++e) {
        const float a = a_lds[srow * 68 + k0 + e];
        const float r = wid > 0 ? a_lds[(32 * wid - 1) * 68 + k0 + e] : 0.f;
        const float kkv = (e & 1) ? __uint_as_float(ku[e >> 1] & 0xffff0000u) : __uint_as_float(ku[e >> 1] << 16);
        v[e] = kkv * __expf(fminf(r - a, 80.f));
      }
      u32x4 w = {pack2(v[0], v[1]), pack2(v[2], v[3]), pack2(v[4], v[5]), pack2(v[6], v[7])};
      s = MFMA32(__builtin_bit_cast(bf16x8, w), qi[ks], s);
    }
    if (kt == wid) {
#pragma unroll
      for (int r = 0; r < 16; ++r) if (32 * kt + crow(r, h2) > tq) s[r] = 0.f;
    }
    pv_only(s, vt + kt * 32, VT_LSTR, o, l31, h2);
  }
#pragma unroll
  for (int ks = 0; ks < 4; ++ks)
#pragma unroll
    for (int dt = 0; dt < 2; ++dt) {
      const f32x4 a_ = cst[dt][ks][0], b_ = cst[dt][ks][1];
      u32x4 t_ = {pack2(a_[0], a_[1]), pack2(a_[2], a_[3]), pack2(b_[0], b_[1]), pack2(b_[2], b_[3])};
      o[dt] = MFMA32(__builtin_bit_cast(bf16x8, t_), qh[ks], o[dt]);
    }
  float ss = 0.f;
#pragma unroll
  for (int dt = 0; dt < 2; ++dt)
#pragma unroll
    for (int r = 0; r < 16; ++r) ss += o[dt][r] * o[dt][r];
  ss += shx(ss, 32);
  const float rs = rsqrtf(ss * (1.f / 64.f) + 1e-6f);
#pragma unroll
  for (int dt = 0; dt < 2; ++dt)
#pragma unroll
    for (int g = 0; g < 4; ++g) {
      const int d0 = dt * 32 + 8 * g + 4 * h2;
      const u32x2 gz = gzv[dt][g];
      const f32x4 gn = *(const f32x4*)(p.c_norm_g + layer * 256 + hh * 64 + d0);
      const float z0 = __uint_as_float(gz.x << 16), z1 = __uint_as_float(gz.x & 0xffff0000u), z2 = __uint_as_float(gz.y << 16), z3 = __uint_as_float(gz.y & 0xffff0000u);
      u32x2 o2 = {pack2(o[dt][4 * g] * rs * gn[0] * z0, o[dt][4 * g + 1] * rs * gn[1] * z1), pack2(o[dt][4 * g + 2] * rs * gn[2] * z2, o[dt][4 * g + 3] * rs * gn[3] * z3)};
      *(u32x2*)(p.YMIX() + tok * 1024 + 512 + hh * 64 + d0) = o2;
    }
}


DI void ph_attnA(const Params& p, int layer, int item, char* smem) {
  const int tid = tid_opaque(), lane = tid & 63, h = tid >> 6, l31 = lane & 31, h2 = lane >> 5;
  const int b = item >> 6, q0 = (item & 63) * 32, g = h >> 1;
  const int t = q0 + l31;
  const size_t tok = (size_t)b * T + t;
  bf16x8 qf[4];
  {
    const bf16_t* qp = p.QA() + ((size_t)(b * 4 + h) * T + t) * 64 + h2 * 8;
#pragma unroll
    for (int ks = 0; ks < 4; ++ks) qf[ks] = *(const bf16x8*)(qp + ks * 16);
  }
  const bf16_t* Kp = p.KA() + (size_t)(b * 2 + g) * T * 64;
  const bf16_t* Vp = p.VAT() + (size_t)(b * 2 + g) * 64 * T;
  f32x16 o[2]; o[0] = zero16(); o[1] = zero16();
  float m = -1e30f, l = 0.f;
  for (int key0 = max(0, q0 - 128); key0 <= q0; key0 += 32) {
    f32x16 s = qk_tile(Kp + (size_t)key0 * 64, qf, l31, h2);
    if (key0 == q0 - 128 || key0 == q0) {
#pragma unroll
      for (int r = 0; r < 16; ++r) { const int key = key0 + crow(r, h2); if (key > t || t - key >= 128) s[r] = -INFINITY; }
    }
    softmax_pv(s, Vp + key0, T, o, m, l, l31, h2);
  }
  l = xhalf_sum(l);
  const float sink = p.a_sinks[layer * 4 + h] * 1.4426950408889634f;
  const float M = fmaxf(m, sink);
  const float sc = __builtin_amdgcn_exp2f(m - M);
  const float inv = sc / (l * sc + __builtin_amdgcn_exp2f(sink - M));
#pragma unroll
  for (int dt = 0; dt < 2; ++dt)
#pragma unroll
    for (int gq = 0; gq < 4; ++gq) {
      const int d0 = dt * 32 + 8 * gq + 4 * h2;
      const u32x2 gz = *(const u32x2*)(p.GZ() + tok * 256 + h * 64 + d0);
      const float z0 = __uint_as_float(gz.x << 16), z1 = __uint_as_float(gz.x & 0xffff0000u), z2 = __uint_as_float(gz.y << 16), z3 = __uint_as_float(gz.y & 0xffff0000u);
      u32x2 o2 = {pack2(o[dt][4 * gq] * inv * z0, o[dt][4 * gq + 1] * inv * z1), pack2(o[dt][4 * gq + 2] * inv * z2, o[dt][4 * gq + 3] * inv * z3)};
      *(u32x2*)(p.YMIX() + tok * 1024 + h * 64 + d0) = o2;
    }
}

DI void ph_cmp(const Params& p, int layer, int item, char* smem) {
  float* red = (float*)smem;
  bf16_t* hid = (bf16_t*)(smem + 32768);
  const int tid = tid_opaque(), lane = tid & 63, wid = tid >> 6, l31 = lane & 31, h2 = lane >> 5;
  const int b = item >> 3, kvsel = (item >> 2) & 1, mt = item & 3;
  const int lk = layer * 2 + kvsel;
  const int n = min(mt * 32 + l31, 126);
  const bf16_t* src = p.KV() + ((size_t)(kvsel * NB + b) * T + 16 * n) * 64 + wid * 512 + h2 * 8;
  const bf16_t* w1t = p.W1T() + (size_t)lk * 64 * 2048 + wid * 512 + h2 * 8;
  f32x16 acc[2]; acc[0] = zero16(); acc[1] = zero16();
#pragma unroll 4
  for (int ks = 0; ks < 32; ++ks) {
    const bf16x8 a = *(const bf16x8*)(src + ks * 16);
    const bf16x8 b0 = *(const bf16x8*)(w1t + (size_t)l31 * 2048 + ks * 16);
    const bf16x8 b1 = *(const bf16x8*)(w1t + (size_t)(32 + l31) * 2048 + ks * 16);
    acc[0] = MFMA32(a, b0, acc[0]); acc[1] = MFMA32(a, b1, acc[1]);
  }
  __syncthreads();
#pragma unroll
  for (int nt = 0; nt < 2; ++nt)
#pragma unroll
    for (int r = 0; r < 16; ++r) red[(wid * 32 + crow(r, h2)) * 64 + nt * 32 + l31] = acc[nt][r];
  __syncthreads();
  {
    const int row = tid >> 3, c0 = (tid & 7) * 8;
    float v[8];
#pragma unroll
    for (int e = 0; e < 8; ++e) {
      const float x = (red[(0 * 32 + row) * 64 + c0 + e] + red[(1 * 32 + row) * 64 + c0 + e]) + (red[(2 * 32 + row) * 64 + c0 + e] + red[(3 * 32 + row) * 64 + c0 + e]) + p.CVEC()[lk * 64 + c0 + e];
      v[e] = siluf_(x);
    }
    u32x4 w = {pack2(v[0], v[1]), pack2(v[2], v[3]), pack2(v[4], v[5]), pack2(v[6], v[7])};
    *(u32x4*)(hid + row * 72 + c0) = w;
  }
  __syncthreads();
  if (wid == 0) {
    f32x16 o[2]; o[0] = zero16(); o[1] = zero16();
    const bf16_t* w2t = p.W2T() + (size_t)lk * 4096;
#pragma unroll
    for (int ks = 0; ks < 4; ++ks) {
      const bf16x8 a = *(const bf16x8*)(hid + l31 * 72 + ks * 16 + h2 * 8);
#pragma unroll
      for (int nt = 0; nt < 2; ++nt) o[nt] = MFMA32(a, *(const bf16x8*)(w2t + (nt * 32 + l31) * 64 + ks * 16 + h2 * 8), o[nt]);
    }
    if (kvsel == 0) {
#pragma unroll
      for (int r = 0; r < 16; ++r) {
        const int nn = mt * 32 + crow(r, h2);
        if (nn < 127) {
          const int pos = 16 * nn + 31;
          const float cs = p.ROPEC()[pos * 32 + l31], sn = p.ROPES()[pos * 32 + l31];
          p.KCMP()[((size_t)b * 128 + nn) * 64 + l31] = f2bf(o[0][r] * cs - o[1][r] * sn);
          p.KCMP()[((size_t)b * 128 + nn) * 64 + 32 + l31] = f2bf(o[0][r] * sn + o[1][r] * cs);
        }
      }
    } else {
#pragma unroll
      for (int nt = 0; nt < 2; ++nt)
#pragma unroll
        for (int r = 0; r < 16; ++r) {
          const int nn = mt * 32 + crow(r, h2);
          if (nn < 127) p.VCMPT()[((size_t)b * 64 + nt * 32 + l31) * 128 + nn] = f2bf(o[nt][r]);
        }
    }
  }
}


#define XB_TMO      128
#define XB_XCNT(j)  (256  + 64 * (j))
#define XB_XSUB(j)  (1280 + 64 * (j))
#define XB_XGEN(j)  (2304 + 64 * (j))
#define XB_TOP      3328
#define XB_TOPGEN   3392
#define XCD_BAR_WORDS 3456
#define XB_SPIN_CAP (1u << 22)
DI unsigned xb_ld(unsigned* p)              { return __hip_atomic_load(p, __ATOMIC_RELAXED, __HIP_MEMORY_SCOPE_AGENT); }
DI unsigned xb_add(unsigned* p, unsigned v) { return __hip_atomic_fetch_add(p, v, __ATOMIC_RELAXED, __HIP_MEMORY_SCOPE_AGENT); }
DI unsigned xb_xcc_id() { return (unsigned)__builtin_amdgcn_s_getreg((3 << 11) | 20) & 0xFu; }
#define XB_SPIN(cond, bar) do { unsigned _sp = 0; while (cond) { __builtin_amdgcn_s_sleep(1); \
    if ((++_sp & 255u) == 0u) { if (xb_ld(&(bar)[XB_TMO])) break; if (_sp > XB_SPIN_CAP) { atomicAdd(&(bar)[XB_TMO], 1u); break; } } } } while (0)
struct XcdBarrier { unsigned* bar; unsigned x; volatile LAS unsigned* st; };
DI XcdBarrier xcd_barrier_post(unsigned* bar, volatile LAS unsigned* st) {
  XcdBarrier b; b.bar = bar; b.x = xb_xcc_id(); b.st = st;
  if (threadIdx.x == 0) (void)xb_add(&bar[XB_XCNT(b.x)], 1u);
  return b;
}
DI void xcd_barrier_complete(unsigned* bar, unsigned x, unsigned& nloc, unsigned& nx) {
  const unsigned G = gridDim.x * gridDim.y * gridDim.z;
  unsigned sum, cnt, mine, sp = 0u;
  for (;;) {
    sum = 0u; cnt = 0u; mine = 0u;
#pragma unroll
    for (unsigned j = 0; j < 16; ++j) { const unsigned c = xb_ld(&bar[XB_XCNT(j)]); sum += c; cnt += (c > 0u) ? 1u : 0u; mine = (j == x) ? c : mine; }
    if (sum == G) break;
    __builtin_amdgcn_s_sleep(1);
    if ((++sp & 255u) == 0u) { if (xb_ld(&bar[XB_TMO])) break; if (sp > XB_SPIN_CAP) { atomicAdd(&bar[XB_TMO], 1u); break; } }
  }
  nloc = mine > 0u ? mine : 1u; nx = cnt > 0u ? cnt : 1u;
}
DI void xcd_barrier(const XcdBarrier& b) {
  asm volatile("s_waitcnt vmcnt(0)" ::: "memory");
  __syncthreads();
  int t0_ = threadIdx.x; asm volatile("" : "+v"(t0_));
  if (t0_ == 0) {
    unsigned* bar = b.bar;
    __builtin_amdgcn_s_waitcnt(0);
    unsigned nloc = b.st[0], nx = b.st[1];
    if (nloc == 0u) { xcd_barrier_complete(bar, b.x, nloc, nx); b.st[0] = nloc; b.st[1] = nx; }
    const unsigned old = xb_add(&bar[XB_XSUB(b.x)], 1u);
    const unsigned gen = old / nloc;
    if (old + 1u == (gen + 1u) * nloc) {
      __builtin_amdgcn_fence(__ATOMIC_RELEASE, "agent");
      asm volatile("s_waitcnt vmcnt(0)" ::: "memory");
      const unsigned og = xb_add(&bar[XB_TOP], 1u);
      const unsigned tg = og / nx;
      if (og + 1u == (tg + 1u) * nx) xb_add(&bar[XB_TOPGEN], 1u);
      else XB_SPIN(xb_ld(&bar[XB_TOPGEN]) == tg, bar);
      __builtin_amdgcn_fence(__ATOMIC_ACQUIRE, "agent");
      xb_add(&bar[XB_XGEN(b.x)], 1u);
      asm volatile("s_waitcnt vmcnt(0)" ::: "memory");
    } else {
      XB_SPIN(xb_ld(&bar[XB_XGEN(b.x)]) == gen, bar);
      __builtin_amdgcn_fence(__ATOMIC_ACQUIRE, "agent");
      asm volatile("s_waitcnt vmcnt(0)" ::: "memory");
    }
  }
  __syncthreads();
}

constexpr int HALF_LDS = 80000;
__global__ void __launch_bounds__(512) mega(Params p) {
  __shared__ __attribute__((aligned(16))) char smem_all[2 * HALF_LDS + 32];
  cg::grid_group grid = cg::this_grid();
  const int half = half_id();
  const int bid = blockIdx.x, nblk = gridDim.x;
  const int vbid = 2 * bid + half, nvblk = 2 * nblk;
  char* smem = smem_all + half * HALF_LDS;
  unsigned* xbw = (unsigned*)(smem_all + 2 * HALF_LDS);
  int* s_pair = (int*)(smem_all + 2 * HALF_LDS + 16);
  if (threadIdx.x == 0) { xbw[0] = 0u; xbw[1] = 0u; }
  __syncthreads();
  const XcdBarrier xb = xcd_barrier_post(p.XBAR(), (volatile LAS unsigned*)xbw);
  ph_prologue(p, vbid, nvblk, smem);
  ln_rows(p, 0, 0, vbid, nvblk);
  if (PROBE == 5) { ph_prologue(p, vbid, nvblk, smem); ln_rows(p, 0, 0, vbid, nvblk); }
  grid.sync();
  for (int l = 0; l < 2; ++l) {
    ph_gemm_in(p, l, bid, nblk, smem_all);
    if (PROBE == 1) ph_gemm_in(p, l, bid, nblk, smem_all);
    xcd_barrier(xb);
    for (int rep = 0; rep < (PROBE == 3 ? 2 : 1); ++rep) {
    for (int item = vbid; item < 2048; item += nvblk) ph_mlstm_local(p, l, item, smem);
    for (int item = vbid; item < 2048; item += nvblk) ph_hgrn_local(p, l, item, smem);
    __syncthreads();
    for (int item = vbid; item < 256; item += nvblk) ph_cmp(p, l, item, smem);
    __syncthreads();
    for (int item = bid; item < 1024; item += nblk) ph_attnA_fb(p, l, item, smem_all);
    }
    xcd_barrier(xb);
    if (vbid < 128) ph_mlstm_scan(p, vbid);
    else if (vbid < 256) ph_hgrn_scan(p, vbid - 128);
    __syncthreads();
    ph_attnD(p, l, p.CTR() + l, smem_all, s_pair);
    if (PROBE == 2) ph_attnD(p, l, p.CTR() + 2 + l, smem_all, s_pair);
    xcd_barrier(xb);
    for (int rep = 0; rep < (PROBE == 4 ? 2 : 1); ++rep) {
    for (int item = vbid; item < 2048; item += nvblk) ph_mlstm_out(p, l, item, smem);
    for (int item = vbid; item < 2048; item += nvblk) ph_hgrn_out(p, l, item, smem);
    }
    xcd_barrier(xb);
    ph_gemm_out_ln(p, l, bid, nblk, smem_all);
    if (l == 0) xcd_barrier(xb);
  }
}

static inline size_t align_up(size_t v) { return (v + 255) & ~(size_t)255; }

extern "C" void kernel_launch(void* const* d_in, const int* in_sizes, int n_in, void* d_out, int out_size, void* d_ws, size_t ws_size, hipStream_t stream) {
  Params p{};
  p.x = (const float*)d_in[0]; p.ln0_g = (const float*)d_in[1]; p.ln0_b = (const float*)d_in[2]; p.w_in = (const float*)d_in[3];
  p.b_in = (const float*)d_in[4]; p.a_sinks = (const float*)d_in[5]; p.conv_w = (const float*)d_in[6]; p.conv_b = (const float*)d_in[7];
  p.c_lb = (const float*)d_in[8]; p.c_norm_g = (const float*)d_in[9]; p.pe = (const float*)d_in[10]; p.w1 = (const float*)d_in[11];
  p.w2 = (const float*)d_in[12]; p.w_out = (const float*)d_in[13]; p.ln_g = (const float*)d_in[14]; p.ln_b = (const float*)d_in[15];
  p.hf = (float*)d_out;
  p.ws = (char*)d_ws;
  if (WS_TOTAL > ws_size) { fprintf(stderr, "workspace too small: need %zu have %zu\n", (size_t)WS_TOTAL, ws_size); return; }

  static int grid_blocks = 0;
  if (!grid_blocks) {
    int dev = 0, cus = 0, per_cu = 0;
    (void)hipGetDevice(&dev);
    (void)hipDeviceGetAttribute(&cus, hipDeviceAttributeMultiprocessorCount, dev);
    (void)hipOccupancyMaxActiveBlocksPerMultiprocessor(&per_cu, mega, 512, 0);
    if (per_cu > 1) per_cu = 1;
    grid_blocks = cus * per_cu;
  }
  (void)hipMemsetAsync((char*)d_ws + OFF_XBAR, 0, XCD_BAR_WORDS * 4, stream);
  (void)hipMemsetAsync((char*)d_ws + OFF_CVEC, 0, SZ_CVEC, stream);
  void* args[] = {&p};
  hipError_t e = hipLaunchCooperativeKernel((void*)mega, dim3(grid_blocks), dim3(512), args, 0, stream);
  if (e != hipSuccess) fprintf(stderr, "cooperative launch failed: %s (grid %d)\n", hipGetErrorString(e), grid_blocks);
}
```

```cpp
#include <hip/hip_runtime.h>
#include <hip/hip_cooperative_groups.h>
#include <stdio.h>
#include <stdint.h>
#include <stddef.h>

#ifndef PROBE
#define PROBE 0
#endif
#define DI __device__ __forceinline__
typedef unsigned short bf16_t;
typedef short bf16x8 __attribute__((ext_vector_type(8)));
typedef float f32x16 __attribute__((ext_vector_type(16)));
typedef unsigned u32x4 __attribute__((ext_vector_type(4)));
typedef float f32x4 __attribute__((ext_vector_type(4)));

constexpr int NB = 32, T = 2048, DM = 1024, NTOK = NB * T, NP = 4096;
constexpr float DN_ALPHA = 1.41421356237309515f;

constexpr size_t OFF_HB = 0;
constexpr size_t SZ_HB = (size_t)NTOK * 1024 * 2;
constexpr size_t OFF_YMIX = OFF_HB + ((SZ_HB + 255) & ~(size_t)255);
constexpr size_t SZ_YMIX = (size_t)NTOK * 1024 * 2;
constexpr size_t OFF_QA = OFF_YMIX + ((SZ_YMIX + 255) & ~(size_t)255);
constexpr size_t SZ_QA = (size_t)NTOK * 256 * 2;
constexpr size_t OFF_KA = OFF_QA + ((SZ_QA + 255) & ~(size_t)255);
constexpr size_t SZ_KA = (size_t)NTOK * 128 * 2;
constexpr size_t OFF_VAT = OFF_KA + ((SZ_KA + 255) & ~(size_t)255);
constexpr size_t SZ_VAT = (size_t)NTOK * 128 * 2;
constexpr size_t OFF_QKB = OFF_VAT + ((SZ_VAT + 255) & ~(size_t)255);
constexpr size_t SZ_QKB = (size_t)NTOK * 512 * 2;
constexpr size_t OFF_VBT = OFF_QKB + ((SZ_QKB + 255) & ~(size_t)255);
constexpr size_t SZ_VBT = (size_t)NTOK * 256 * 2;
constexpr size_t OFF_QC = OFF_VBT + ((SZ_VBT + 255) & ~(size_t)255);
constexpr size_t SZ_QC = (size_t)NTOK * 256 * 2;
constexpr size_t OFF_GC = OFF_QC + ((SZ_QC + 255) & ~(size_t)255);
constexpr size_t SZ_GC = (size_t)NTOK * 256 * 4;
constexpr size_t OFF_VCT = OFF_GC + ((SZ_GC + 255) & ~(size_t)255);
constexpr size_t SZ_VCT = (size_t)NTOK * 256 * 2;
constexpr size_t OFF_QD = OFF_VCT + ((SZ_VCT + 255) & ~(size_t)255);
constexpr size_t SZ_QD = (size_t)NTOK * 256 * 2;
constexpr size_t OFF_KV = OFF_QD + ((SZ_QD + 255) & ~(size_t)255);
constexpr size_t SZ_KV = (size_t)NTOK * 384 * 2;
constexpr size_t OFF_GZ = OFF_KV + ((SZ_KV + 255) & ~(size_t)255);
constexpr size_t SZ_GZ = (size_t)NTOK * 1280 * 2;
constexpr size_t OFF_IFG = OFF_GZ + ((SZ_GZ + 255) & ~(size_t)255);
constexpr size_t SZ_IFG = (size_t)NTOK * 8 * 4;
constexpr size_t OFF_DG = OFF_IFG + ((SZ_IFG + 255) & ~(size_t)255);
constexpr size_t SZ_DG = (size_t)NTOK * 12 * 4;
constexpr size_t OFF_WT = OFF_DG + ((SZ_DG + 255) & ~(size_t)255);
constexpr size_t SZ_WT = (size_t)2 * NP * 1024 * 2;
constexpr size_t OFF_WOT = OFF_WT + ((SZ_WT + 255) & ~(size_t)255);
constexpr size_t SZ_WOT = (size_t)2 * 1024 * 1024 * 2;
constexpr size_t OFF_KCMP = OFF_WOT + ((SZ_WOT + 255) & ~(size_t)255);
constexpr size_t SZ_KCMP = (size_t)NB * 128 * 64 * 2;
constexpr size_t OFF_VCMPT = OFF_KCMP + ((SZ_KCMP + 255) & ~(size_t)255);
constexpr size_t SZ_VCMPT = (size_t)NB * 64 * 128 * 2;
constexpr size_t OFF_BIASP = OFF_VCMPT + ((SZ_VCMPT + 255) & ~(size_t)255);
constexpr size_t SZ_BIASP = (size_t)2 * NP * 4;
constexpr size_t OFF_LB = OFF_BIASP + ((SZ_BIASP + 255) & ~(size_t)255);
constexpr size_t SZ_LB = (size_t)512 * 4;
constexpr size_t OFF_ROPEC = OFF_LB + ((SZ_LB + 255) & ~(size_t)255);
constexpr size_t SZ_ROPEC = (size_t)T * 32 * 4;
constexpr size_t OFF_ROPES = OFF_ROPEC + ((SZ_ROPEC + 255) & ~(size_t)255);
constexpr size_t SZ_ROPES = (size_t)T * 32 * 4;
constexpr size_t OFF_BST = OFF_ROPES + ((SZ_ROPES + 255) & ~(size_t)255);
constexpr size_t SZ_BST = (size_t)2048 * 4096 * 4;
constexpr size_t OFF_BN = OFF_BST + ((SZ_BST + 255) & ~(size_t)255);
constexpr size_t SZ_BN = (size_t)2048 * 64 * 4;
constexpr size_t OFF_BG = OFF_BN + ((SZ_BN + 255) & ~(size_t)255);
constexpr size_t SZ_BG = (size_t)2048 * 4;
constexpr size_t OFF_CST = OFF_BG + ((SZ_BG + 255) & ~(size_t)255);
constexpr size_t SZ_CST = (size_t)2048 * 4096 * 4;
constexpr size_t OFF_CAL = OFF_CST + ((SZ_CST + 255) & ~(size_t)255);
constexpr size_t SZ_CAL = (size_t)2048 * 64 * 4;
constexpr size_t OFF_W1T = OFF_CAL + ((SZ_CAL + 255) & ~(size_t)255);
constexpr size_t SZ_W1T = (size_t)4 * 64 * 2048 * 2;
constexpr size_t OFF_W2T = OFF_W1T + ((SZ_W1T + 255) & ~(size_t)255);
constexpr size_t SZ_W2T = (size_t)4 * 64 * 64 * 2;
constexpr size_t OFF_CVEC = OFF_W2T + ((SZ_W2T + 255) & ~(size_t)255);
constexpr size_t SZ_CVEC = (size_t)256 * 4;
constexpr size_t OFF_CTR = OFF_CVEC + ((SZ_CVEC + 255) & ~(size_t)255);
constexpr size_t SZ_CTR = (size_t)256;
constexpr size_t OFF_XBAR = OFF_CTR + ((SZ_CTR + 255) & ~(size_t)255);
constexpr size_t SZ_XBAR = (size_t)3456 * 4;
constexpr size_t OFF_LNS = OFF_XBAR + ((SZ_XBAR + 255) & ~(size_t)255);
constexpr size_t SZ_LNS = (size_t)NTOK * 2 * 4;
constexpr size_t WS_TOTAL = OFF_LNS + ((SZ_LNS + 255) & ~(size_t)255);
struct Params {
  const float *x, *ln0_g, *ln0_b, *w_in, *b_in, *a_sinks, *conv_w, *conv_b, *c_lb, *c_norm_g, *pe, *w1, *w2, *w_out, *ln_g, *ln_b;
  float* hf;
  char* ws;
  DI bf16_t* HB() const { return (bf16_t*)(ws + OFF_HB); }
  DI bf16_t* YMIX() const { return (bf16_t*)(ws + OFF_YMIX); }
  DI bf16_t* QA() const { return (bf16_t*)(ws + OFF_QA); }
  DI bf16_t* KA() const { return (bf16_t*)(ws + OFF_KA); }
  DI bf16_t* VAT() const { return (bf16_t*)(ws + OFF_VAT); }
  DI bf16_t* QKB() const { return (bf16_t*)(ws + OFF_QKB); }
  DI bf16_t* VBT() const { return (bf16_t*)(ws + OFF_VBT); }
  DI bf16_t* QC() const { return (bf16_t*)(ws + OFF_QC); }
  DI float* GC() const { return (float*)(ws + OFF_GC); }
  DI bf16_t* VCT() const { return (bf16_t*)(ws + OFF_VCT); }
  DI bf16_t* QD() const { return (bf16_t*)(ws + OFF_QD); }
  DI bf16_t* KV() const { return (bf16_t*)(ws + OFF_KV); }
  DI bf16_t* GZ() const { return (bf16_t*)(ws + OFF_GZ); }
  DI float* IFG() const { return (float*)(ws + OFF_IFG); }
  DI float* DG() const { return (float*)(ws + OFF_DG); }
  DI bf16_t* WT() const { return (bf16_t*)(ws + OFF_WT); }
  DI bf16_t* WOT() const { return (bf16_t*)(ws + OFF_WOT); }
  DI bf16_t* KCMP() const { return (bf16_t*)(ws + OFF_KCMP); }
  DI bf16_t* VCMPT() const { return (bf16_t*)(ws + OFF_VCMPT); }
  DI float* BIASP() const { return (float*)(ws + OFF_BIASP); }
  DI float* LB() const { return (float*)(ws + OFF_LB); }
  DI float* ROPEC() const { return (float*)(ws + OFF_ROPEC); }
  DI float* ROPES() const { return (float*)(ws + OFF_ROPES); }
  DI float* BST() const { return (float*)(ws + OFF_BST); }
  DI float* BN() const { return (float*)(ws + OFF_BN); }
  DI float* BG() const { return (float*)(ws + OFF_BG); }
  DI float* CST() const { return (float*)(ws + OFF_CST); }
  DI float* CAL() const { return (float*)(ws + OFF_CAL); }
  DI bf16_t* W1T() const { return (bf16_t*)(ws + OFF_W1T); }
  DI bf16_t* W2T() const { return (bf16_t*)(ws + OFF_W2T); }
  DI float* CVEC() const { return (float*)(ws + OFF_CVEC); }
  DI int* CTR() const { return (int*)(ws + OFF_CTR); }
  DI unsigned* XBAR() const { return (unsigned*)(ws + OFF_XBAR); }
  DI float* LNS() const { return (float*)(ws + OFF_LNS); }
};
namespace cg = cooperative_groups;

DI int tid_opaque() { int t = threadIdx.x; asm volatile("" : "+v"(t)); return t & 255; }
DI int half_id() { return __builtin_amdgcn_readfirstlane((int)(threadIdx.x >> 8)); }
DI float bf2f(bf16_t v) { return __uint_as_float(((unsigned)v) << 16); }
DI bf16_t f2bf(float x) { unsigned u = __float_as_uint(x); u += 0x7fffu + ((u >> 16) & 1u); return (bf16_t)(u >> 16); }
DI float sigmoidf_(float x) { return __builtin_amdgcn_rcpf(1.f + __builtin_amdgcn_exp2f(-1.4426950408889634f * x)); }
DI float siluf_(float x) { return x * __builtin_amdgcn_rcpf(1.f + __builtin_amdgcn_exp2f(-1.4426950408889634f * x)); }
DI int lane_op() { int l = threadIdx.x; asm volatile("" : "+v"(l)); return l & 63; }
DI float shx(float v, int m) { return __builtin_bit_cast(float, __builtin_amdgcn_ds_bpermute((lane_op() ^ m) << 2, __builtin_bit_cast(int, v))); }
DI unsigned shx(unsigned v, int m) { return (unsigned)__builtin_amdgcn_ds_bpermute((lane_op() ^ m) << 2, (int)v); }
DI float shup(float v, int d) { const int l = lane_op(); const int s = l - d; return __builtin_bit_cast(float, __builtin_amdgcn_ds_bpermute((s < 0 ? l : s) << 2, __builtin_bit_cast(int, v))); }
DI float xhalf_max(float x) { int a = __builtin_bit_cast(int, x), b = a; asm volatile("" : "+v"(b)); auto r = __builtin_amdgcn_permlane32_swap(a, b, false, false); return fmaxf(__builtin_bit_cast(float, (int)r[0]), __builtin_bit_cast(float, (int)r[1])); }
DI float xhalf_sum(float x) { int a = __builtin_bit_cast(int, x), b = a; asm volatile("" : "+v"(b)); auto r = __builtin_amdgcn_permlane32_swap(a, b, false, false); return __builtin_bit_cast(float, (int)r[0]) + __builtin_bit_cast(float, (int)r[1]); }
DI float wave_sum(float v) { for (int o = 32; o > 0; o >>= 1) v += shx(v, o); return v; }
DI float wave_max(float v) { for (int o = 32; o > 0; o >>= 1) v = fmaxf(v, shx(v, o)); return v; }

DI int orig_col(int n) {
  if (n < 1536) return n;
  if (n < 3712) return n + 8;
  if (n < 3968) return n + 20;
  if (n < 3976) return 1536 + (n - 3968);
  if (n < 3988) return 3720 + (n - 3976);
  return -1;
}

DI bool head_is_paired(int hd);
DI void ph_prologue(const Params& p, int bid, int nblk, char* smem) {
  const long gtid = (long)bid * 256 + tid_opaque(), gsz = (long)nblk * 256;
  if (gtid < 64) p.CTR()[gtid] = 0;
  for (long idx = gtid; idx < 2L * 128 * NP; idx += gsz) {
    const int n = (int)(idx % NP), k8 = (int)((idx / NP) % 128), l = (int)(idx / (NP * 128));
    const int pp = n & 63, w_ = pp >> 5, rr = pp & 31, n_ = rr >> 4, fq_ = (rr >> 2) & 3, j_ = rr & 3;
    const int lc = head_is_paired(n >> 6) ? (32 * n_ + 16 * w_ + 4 * fq_ + j_) : (32 * w_ + 8 * fq_ + 4 * n_ + j_);
    const int oc = orig_col((n & ~63) + lc);
    unsigned w[4];
    for (int j = 0; j < 4; ++j) {
      float a = 0.f, b = 0.f;
      if (oc >= 0) { a = p.w_in[((size_t)l * 1024 + k8 * 8 + 2 * j) * 3988 + oc]; b = p.w_in[((size_t)l * 1024 + k8 * 8 + 2 * j + 1) * 3988 + oc]; }
      w[j] = (unsigned)f2bf(a) | ((unsigned)f2bf(b) << 16);
    }
    *(uint4*)(p.WT() + ((size_t)l * NP + n) * 1024 + k8 * 8) = make_uint4(w[0], w[1], w[2], w[3]);
  }
  for (long idx = gtid; idx < 2L * 128 * 1024; idx += gsz) {
    const int d = (int)(idx % 1024), m8 = (int)((idx / 1024) % 128), l = (int)(idx / (1024 * 128));
    unsigned w[4];
    for (int j = 0; j < 4; ++j) {
      float a = p.w_out[((size_t)l * 1024 + m8 * 8 + 2 * j) * 1024 + d], b = p.w_out[((size_t)l * 1024 + m8 * 8 + 2 * j + 1) * 1024 + d];
      w[j] = (unsigned)f2bf(a) | ((unsigned)f2bf(b) << 16);
    }
    *(uint4*)(p.WOT() + ((size_t)l * 1024 + d) * 1024 + m8 * 8) = make_uint4(w[0], w[1], w[2], w[3]);
  }
  for (long idx = gtid; idx < 4L * 256 * 64; idx += gsz) {
    const int j = (int)(idx % 64), i8 = (int)((idx / 64) % 256), lk = (int)(idx / (64 * 256));
    unsigned w[4];
    for (int e = 0; e < 4; ++e) {
      const float a = p.w1[((size_t)lk * 2048 + i8 * 8 + 2 * e) * 64 + j], b = p.w1[((size_t)lk * 2048 + i8 * 8 + 2 * e + 1) * 64 + j];
      w[e] = (unsigned)f2bf(a) | ((unsigned)f2bf(b) << 16);
    }
    *(uint4*)(p.W1T() + ((size_t)lk * 64 + j) * 2048 + i8 * 8) = make_uint4(w[0], w[1], w[2], w[3]);
  }
  for (long idx = gtid; idx < 4L * 64 * 64; idx += gsz) {
    const int jo = (int)(idx % 64), ji = (int)((idx / 64) % 64), lk = (int)(idx / 4096);
    p.W2T()[((size_t)lk * 64 + jo) * 64 + ji] = f2bf(p.w2[((size_t)lk * 64 + ji) * 64 + jo]);
  }
  if (bid < 64) {
    const int lk = bid >> 4, seg = bid & 15, j = tid_opaque() & 63, part = tid_opaque() >> 6;
    float a = 0.f;
    const int i0 = seg * 128 + part * 32;
#pragma unroll 8
    for (int i = i0; i < i0 + 32; ++i) a += p.pe[(size_t)lk * 2048 + i] * p.w1[((size_t)lk * 2048 + i) * 64 + j];
    float* red = (float*)smem;
    __syncthreads();
    red[part * 64 + j] = a;
    __syncthreads();
    if (part == 0) atomicAdd(p.CVEC() + lk * 64 + j, (red[j] + red[64 + j]) + (red[128 + j] + red[192 + j]));
    __syncthreads();
  }
  for (long idx = gtid; idx < 2L * NP; idx += gsz) {
    const int n = (int)(idx % NP), l = (int)(idx / NP); const int oc = orig_col(n);
    p.BIASP()[idx] = oc >= 0 ? p.b_in[l * 3988 + oc] : 0.f;
  }
  for (long idx = gtid; idx < (long)T * 32; idx += gsz) {
    const int t = (int)(idx / 32), i = (int)(idx % 32);
    const float inv = exp2f(-(float)i * (13.287712379549449f / 32.0f));
    const float ang = (float)t * inv;
    p.ROPEC()[idx] = cosf(ang); p.ROPES()[idx] = sinf(ang);
  }
  for (long idx = gtid; idx < 512; idx += gsz) {
    const int c = (int)(idx % 256), l = (int)(idx / 256);
    const float a = p.c_lb[c], b = p.c_lb[256 + c];
    const float m = fmaxf(a, b); const float ea = expf(a - m), eb = expf(b - m);
    p.LB()[idx] = l == 0 ? 0.f : eb / (ea + eb);
  }
}

DI void ln_rows(const Params& p, int mode, int layer, int bid, int nblk) {
  const int tid_ = tid_opaque(); const int lane = tid_ & 63, wid = tid_ >> 6, nw = 4;
  const float* g = mode == 0 ? p.ln0_g : p.ln_g + layer * 1024;
  const float* bb = mode == 0 ? p.ln0_b : p.ln_b + layer * 1024;
  const float* src = mode == 0 ? p.x : p.hf;
  const int stride = nblk * nw;
  int row = bid * nw + wid;
  f32x4 nx[4];
  if (row < NTOK) {
#pragma unroll
    for (int i = 0; i < 4; ++i) nx[i] = *(const f32x4*)(src + (size_t)row * 1024 + i * 256 + lane * 4);
  }
  for (; row < NTOK; row += stride) {
    f32x4 v[4];
#pragma unroll
    for (int i = 0; i < 4; ++i) v[i] = nx[i];
    if (row + stride < NTOK) {
#pragma unroll
      for (int i = 0; i < 4; ++i) nx[i] = *(const f32x4*)(src + (size_t)(row + stride) * 1024 + i * 256 + lane * 4);
    }
    float sum = 0.f;
#pragma unroll
    for (int i = 0; i < 4; ++i) sum += (v[i][0] + v[i][1]) + (v[i][2] + v[i][3]);
    sum = wave_sum(sum);
    const float mu = sum * (1.f / 1024.f);
    float q = 0.f;
#pragma unroll
    for (int i = 0; i < 4; ++i) { const f32x4 d = v[i] - mu; q += (d[0] * d[0] + d[1] * d[1]) + (d[2] * d[2] + d[3] * d[3]); }
    q = wave_sum(q);
    const float rs = rsqrtf(q * (1.f / 1024.f) + 1e-5f);
    if (mode == 0 && lane == 0) { p.LNS()[(size_t)row * 2] = mu; p.LNS()[(size_t)row * 2 + 1] = rs; }
#pragma unroll
    for (int i = 0; i < 4; ++i) {
      const int c0 = i * 256 + lane * 4;
      const f32x4 gg = *(const f32x4*)(g + c0), b4 = *(const f32x4*)(bb + c0);
      const f32x4 o = (v[i] - mu) * rs * gg + b4;
      if (mode != 0) *(f32x4*)(p.hf + (size_t)row * 1024 + c0) = o;
      uint2 pk; pk.x = (unsigned)f2bf(o[0]) | ((unsigned)f2bf(o[1]) << 16); pk.y = (unsigned)f2bf(o[2]) | ((unsigned)f2bf(o[3]) << 16);
      *(uint2*)(p.HB() + (size_t)row * 1024 + c0) = pk;
    }
  }
}

typedef float f32x2 __attribute__((ext_vector_type(2)));
typedef __bf16 bf16v2 __attribute__((ext_vector_type(2)));
typedef unsigned u32x2 __attribute__((ext_vector_type(2)));
DI unsigned pack2(float a, float b) { f32x2 v = {a, b}; return __builtin_bit_cast(unsigned, __builtin_convertvector(v, bf16v2)); }
DI f32x16 zero16() { f32x16 z;
#pragma unroll
  for (int i = 0; i < 16; ++i) z[i] = 0.f; return z; }
DI bf16x8 ld_frag8x2(const bf16_t* p) { const u32x2 lo = *(const u32x2*)p, hi = *(const u32x2*)(p + 8); u32x4 t = {lo.x, lo.y, hi.x, hi.y}; return __builtin_bit_cast(bf16x8, t); }
template <int BASE> DI bf16x8 pack8(const f32x16& s) {
  u32x4 t = {pack2(s[BASE + 0], s[BASE + 1]), pack2(s[BASE + 2], s[BASE + 3]), pack2(s[BASE + 4], s[BASE + 5]), pack2(s[BASE + 6], s[BASE + 7])};
  return __builtin_bit_cast(bf16x8, t);
}
DI int crow(int r, int h2) { return (r & 3) + 8 * (r >> 2) + 4 * h2; }
#define MFMA32(a, b, c) __builtin_amdgcn_mfma_f32_32x32x16_bf16((a), (b), (c), 0, 0, 0)
#define LAS __attribute__((address_space(3)))
enum { K_NONE = 0, K_ROPE, K_PLAIN, K_TR, K_GSILU, K_GSIG, K_SILUH, K_LOGF, K_SMALL };
namespace g8 {
constexpr int BK = 64, HALF = 128, HT = HALF * BK;
DI int lds_byte(int r, int c) { const int st = (r >> 4) * 2 + (c >> 5), rr = r & 15, cc = c & 31, ob = rr * 64 + cc * 2; return st * 1024 + (ob ^ (((ob >> 9) & 1) << 5)); }
DI void stage_rc(int b, int& R, int& C) { const int st = b / 1024, sb = b % 1024, swz = sb ^ (((sb >> 9) & 1) << 5); R = (st >> 1) * 16 + swz / 64; C = (st & 1) * 32 + (swz % 64) / 2; }
}
DI void gemm256_mainloop(const bf16_t* A, const bf16_t* Bt, bf16_t* shm, f32x4 (&acc)[2][2][4][2]) {
  using namespace g8;
  constexpr int K = 1024;
#define SA(b, h) (shm + ((b) * 2 + (h)) * HT)
#define SB(b, h) (shm + (4 + (b) * 2 + (h)) * HT)
#define STAGE(P, BASE, br, kt) do { const long g_ = (long)(br) * K + (long)(kt) * BK; \
    _Pragma("unroll") for (int i_ = 0; i_ < 2; ++i_) { const int b_ = tidf * 16 + i_ * 8192; int r_, c_; stage_rc(b_, r_, c_); \
      __builtin_amdgcn_global_load_lds((const unsigned*)((BASE) + g_ + (long)r_ * K + c_), (LAS unsigned*)((char*)(P) + b_), 16, 0, 0); } } while (0)
#define LDA(dst, b, h) _Pragma("unroll") for (int m = 0; m < 4; ++m) _Pragma("unroll") for (int k = 0; k < 2; ++k) \
    dst[m][k] = *reinterpret_cast<const bf16x8*>((const char*)SA(b, h) + lds_byte(wr * 64 + m * 16 + fr, k * 32 + fq * 8))
#define LDB(dst, b, h) _Pragma("unroll") for (int n = 0; n < 2; ++n) _Pragma("unroll") for (int k = 0; k < 2; ++k) \
    dst[n][k] = *reinterpret_cast<const bf16x8*>((const char*)SB(b, h) + lds_byte(wc * 32 + n * 16 + fr, k * 32 + fq * 8))
#define MMA(ai, bj, At_, Bt_) do { __builtin_amdgcn_s_setprio(1); \
    _Pragma("unroll") for (int m = 0; m < 4; ++m) _Pragma("unroll") for (int n = 0; n < 2; ++n) _Pragma("unroll") for (int k = 0; k < 2; ++k) \
      acc[ai][bj][m][n] = __builtin_amdgcn_mfma_f32_16x16x32_bf16(Bt_[n][k], At_[m][k], acc[ai][bj][m][n], 0, 0, 0); \
    __builtin_amdgcn_s_setprio(0); } while (0)
#define WAIT_V(n) asm volatile("s_waitcnt vmcnt(" #n ")" ::: "memory")
#define WAIT_L(n) asm volatile("s_waitcnt lgkmcnt(" #n ")" ::: "memory")
#define BAR __builtin_amdgcn_s_barrier()
#define SCHED __builtin_amdgcn_sched_barrier(0)
  int tidf = threadIdx.x; asm volatile("" : "+v"(tidf));
  const int wid = tidf >> 6, lane = tidf & 63, wr = wid >> 2, wc = wid & 3, fr = lane & 15, fq = lane >> 4;
#pragma unroll
  for (int a = 0; a < 2; ++a)
#pragma unroll
    for (int b = 0; b < 2; ++b)
#pragma unroll
      for (int m = 0; m < 4; ++m)
#pragma unroll
        for (int n = 0; n < 2; ++n) acc[a][b][m][n] = (f32x4){0.f, 0.f, 0.f, 0.f};
  bf16x8 At[4][2], B0[2][2], B1[2][2];
  constexpr int nt = K / BK;
  WAIT_V(0);
  STAGE(SB(0, 0), Bt, 0, 0); STAGE(SA(0, 0), A, 0, 0);
  STAGE(SB(0, 1), Bt, HALF, 0); STAGE(SA(0, 1), A, HALF, 0);
  if (wr == 1) BAR;
  WAIT_V(4); BAR;
  STAGE(SB(1, 0), Bt, 0, 1); STAGE(SA(1, 0), A, 0, 1); STAGE(SB(1, 1), Bt, HALF, 1);
  WAIT_V(6); BAR;
  for (int t = 0; t < nt - 2; t += 2) {
    LDB(B0, 0, 0); SCHED; LDA(At, 0, 0); STAGE(SA(1, 1), A, HALF, t + 1);
    WAIT_L(8); BAR; WAIT_L(0); MMA(0, 0, At, B0); BAR; SCHED;
    LDB(B1, 0, 1); STAGE(SB(0, 0), Bt, 0, t + 2);
    BAR; WAIT_L(0); MMA(0, 1, At, B1); BAR;
    LDA(At, 0, 1); STAGE(SA(0, 0), A, 0, t + 2);
    BAR; WAIT_L(0); MMA(1, 0, At, B0); BAR; SCHED;
    STAGE(SB(0, 1), Bt, HALF, t + 2);
    WAIT_V(6); BAR; MMA(1, 1, At, B1); BAR;
    LDB(B0, 1, 0); SCHED; LDA(At, 1, 0); STAGE(SA(0, 1), A, HALF, t + 2);
    WAIT_L(8); BAR; WAIT_L(0); MMA(0, 0, At, B0); BAR; SCHED;
    LDB(B1, 1, 1); STAGE(SB(1, 0), Bt, 0, t + 3);
    BAR; WAIT_L(0); MMA(0, 1, At, B1); BAR;
    LDA(At, 1, 1); STAGE(SA(1, 0), A, 0, t + 3);
    BAR; WAIT_L(0); MMA(1, 0, At, B0); BAR; SCHED;
    STAGE(SB(1, 1), Bt, HALF, t + 3);
    WAIT_V(6); BAR; MMA(1, 1, At, B1); BAR;
  }
  { LDB(B0, 0, 0); LDA(At, 0, 0); STAGE(SA(1, 1), A, HALF, nt - 1);
    BAR; WAIT_L(0); MMA(0, 0, At, B0); BAR;
    LDB(B1, 0, 1); BAR; WAIT_L(0); MMA(0, 1, At, B1); BAR;
    LDA(At, 0, 1); WAIT_V(4); BAR; WAIT_L(0); MMA(1, 0, At, B0); MMA(1, 1, At, B1); BAR; }
  { LDB(B0, 1, 0); LDA(At, 1, 0); WAIT_V(2); BAR; WAIT_L(0); MMA(0, 0, At, B0); BAR;
    LDB(B1, 1, 1); WAIT_V(0); BAR; WAIT_L(0); MMA(0, 1, At, B1); BAR;
    LDA(At, 1, 1); BAR; WAIT_L(0); MMA(1, 0, At, B0); MMA(1, 1, At, B1); BAR; }
  if (wr == 0) BAR;
#undef SA
#undef SB
#undef STAGE
#undef LDA
#undef LDB
#undef MMA
#undef WAIT_V
#undef WAIT_L
#undef BAR
#undef SCHED
}

DI void classify_head(const Params& p, int hd, int b, int& kind, bf16_t*& dst, float*& fdst, float& scale) {
  kind = K_NONE; dst = nullptr; fdst = nullptr; scale = 1.f;
  if (hd < 4) { kind = K_ROPE; dst = p.QA() + ((size_t)(b * 4 + hd) * T) * 64; scale = 0.125f * 1.4426950408889634f; }
  else if (hd < 6) { kind = K_ROPE; dst = p.KA() + ((size_t)(b * 2 + hd - 4) * T) * 64; }
  else if (hd < 8) { kind = K_TR; dst = p.VAT() + (size_t)(b * 2 + hd - 6) * 64 * T; }
  else if (hd < 12) { kind = K_GSILU; dst = p.GZ() + (size_t)0 * NTOK * 256 + (hd - 8) * 64; }
  else if (hd < 20) { kind = K_PLAIN; dst = p.QKB() + ((size_t)(b * 8 + hd - 12) * T) * 64; }
  else if (hd < 24) { kind = K_TR; dst = p.VBT() + (size_t)(b * 4 + hd - 20) * 64 * T; }
  else if (hd < 28) { kind = K_GSIG; dst = p.GZ() + (size_t)1 * NTOK * 256 + (hd - 24) * 64; }
  else if (hd < 32) { kind = K_GSILU; dst = p.GZ() + (size_t)2 * NTOK * 256 + (hd - 28) * 64; }
  else if (hd < 36) { kind = K_SILUH; dst = p.QC() + ((size_t)(b * 4 + hd - 32) * T) * 64; }
  else if (hd < 40) { kind = K_LOGF; fdst = p.GC() + ((size_t)(b * 4 + hd - 36) * T) * 64; }
  else if (hd < 44) { kind = K_TR; dst = p.VCT() + (size_t)(b * 4 + hd - 40) * 64 * T; }
  else if (hd < 48) { kind = K_GSILU; dst = p.GZ() + (size_t)3 * NTOK * 256 + (hd - 44) * 64; }
  else if (hd < 52) { kind = K_ROPE; dst = p.QD() + ((size_t)(b * 4 + hd - 48) * T) * 64; scale = 0.125f * 1.4426950408889634f; }
  else if (hd < 58) {
    const int j = hd - 52;
    dst = p.KV() + (size_t)(j * NB + b) * T * 64;
    kind = (j == 0 || j == 1) ? K_PLAIN : ((j == 2 || j == 4) ? K_ROPE : K_TR);
  }
  else if (hd < 62) { kind = K_GSILU; dst = p.GZ() + (size_t)4 * NTOK * 256 + (hd - 58) * 64; }
  else if (hd == 62) { kind = K_SMALL; }
}

DI bool head_is_paired(int hd) { return hd < 6 || (hd >= 48 && hd < 52) || hd == 54 || hd == 56; }
template <int KIND>
DI void epi_direct(const Params& p, const f32x4 (&a)[4][2], bf16_t* dst, float* fdst, float scale, int layer, int hd, int b, int tq, int wr, int w, int fr, int fq) {
  if (KIND == K_ROPE) {
    const int c = 16 * w + 4 * fq;
    const f32x4 b0 = *(const f32x4*)(p.BIASP() + layer * NP + hd * 64 + c), b1 = *(const f32x4*)(p.BIASP() + layer * NP + hd * 64 + 32 + c);
#pragma unroll
    for (int m = 0; m < 4; ++m) {
      const int t = tq + wr * 64 + m * 16 + fr;
      const f32x4 cs = *(const f32x4*)(p.ROPEC() + t * 32 + c), sn = *(const f32x4*)(p.ROPES() + t * 32 + c);
      const f32x4 v0 = a[m][0] + b0, v1 = a[m][1] + b1;
      const f32x4 o0 = (v0 * cs - v1 * sn) * scale, o1 = (v0 * sn + v1 * cs) * scale;
      u32x2 w0 = {pack2(o0[0], o0[1]), pack2(o0[2], o0[3])}, w1 = {pack2(o1[0], o1[1]), pack2(o1[2], o1[3])};
      *(u32x2*)(dst + (size_t)t * 64 + c) = w0; *(u32x2*)(dst + (size_t)t * 64 + 32 + c) = w1;
    }
    return;
  }
  const int c = 32 * w + 8 * fq;
  const f32x4 b0 = *(const f32x4*)(p.BIASP() + layer * NP + hd * 64 + c), b1 = *(const f32x4*)(p.BIASP() + layer * NP + hd * 64 + c + 4);
  if (KIND == K_SMALL) {
#pragma unroll
    for (int m = 0; m < 4; ++m) {
      const size_t tok = (size_t)b * T + tq + wr * 64 + m * 16 + fr;
#pragma unroll
      for (int n = 0; n < 2; ++n)
#pragma unroll
        for (int j = 0; j < 4; ++j) {
          const int cc = c + 4 * n + j;
          const float v = a[m][n][j] + (n ? b1[j] : b0[j]);
          if (cc < 8) p.IFG()[tok * 8 + cc] = v;
          else if (cc < 20) p.DG()[tok * 12 + (cc - 8)] = sigmoidf_(v);
        }
    }
    return;
  }
  f32x4 lb0 = {0.f, 0.f, 0.f, 0.f}, lb1 = {0.f, 0.f, 0.f, 0.f};
  if (KIND == K_LOGF) { lb0 = *(const f32x4*)(p.LB() + layer * 256 + (hd - 36) * 64 + c); lb1 = *(const f32x4*)(p.LB() + layer * 256 + (hd - 36) * 64 + c + 4); }
#pragma unroll
  for (int m = 0; m < 4; ++m) {
    const int t = tq + wr * 64 + m * 16 + fr;
    const f32x4 v0 = a[m][0] + b0, v1 = a[m][1] + b1;
    if (KIND == K_LOGF) {
      f32x4 o0, o1;
#pragma unroll
      for (int j = 0; j < 4; ++j) { o0[j] = __logf(lb0[j] + (1.f - lb0[j]) * sigmoidf_(v0[j])); o1[j] = __logf(lb1[j] + (1.f - lb1[j]) * sigmoidf_(v1[j])); }
      *(f32x4*)(fdst + (size_t)t * 64 + c) = o0; *(f32x4*)(fdst + (size_t)t * 64 + c + 4) = o1;
    } else {
      f32x4 o0, o1;
#pragma unroll
      for (int j = 0; j < 4; ++j) {
        if (KIND == K_PLAIN) { o0[j] = v0[j]; o1[j] = v1[j]; }
        else if (KIND == K_SILUH || KIND == K_GSILU) { o0[j] = siluf_(v0[j]); o1[j] = siluf_(v1[j]); }
        else { o0[j] = sigmoidf_(v0[j]); o1[j] = sigmoidf_(v1[j]); }
      }
      u32x4 wv = {pack2(o0[0], o0[1]), pack2(o0[2], o0[3]), pack2(o1[0], o1[1]), pack2(o1[2], o1[3])};
      if (KIND == K_GSILU || KIND == K_GSIG) *(u32x4*)(dst + ((size_t)b * T + t) * 256 + c) = wv;
      else *(u32x4*)(dst + (size_t)t * 64 + c) = wv;
    }
  }
}
DI void epi_tr_write(const Params& p, const f32x4 (&a)[4][2], char* img, int layer, int hd, int wr, int w, int fr, int fq) {
  const int c = 32 * w + 8 * fq;
  const f32x4 b0 = *(const f32x4*)(p.BIASP() + layer * NP + hd * 64 + c), b1 = *(const f32x4*)(p.BIASP() + layer * NP + hd * 64 + c + 4);
  bf16_t* timg = (bf16_t*)img;
#pragma unroll
  for (int m = 0; m < 4; ++m)
#pragma unroll
    for (int n = 0; n < 2; ++n)
#pragma unroll
      for (int j = 0; j < 4; ++j) timg[(c + 4 * n + j) * 128 + wr * 64 + m * 16 + fr] = f2bf(a[m][n][j] + (n ? b1[j] : b0[j]));
}
DI void gemm_in_quadrant(const Params& p, int layer, int panel, int pn, int ai, int bj, const f32x4 (&a)[4][2], char* shm,
                         int b, int hq, int tid2, int wr, int wc, int fr, int fq) {
  const int tq = (panel & 7) * 256 + ai * 128;
  const int hd0 = pn * 4 + bj * 2;
  const int hd = hd0 + (wc >> 1), w = wc & 1;
  int kind; bf16_t* dst; float* fdst; float scale;
  classify_head(p, hd, b, kind, dst, fdst, scale);
  switch (kind) {
    case K_ROPE: epi_direct<K_ROPE>(p, a, dst, fdst, scale, layer, hd, b, tq, wr, w, fr, fq); break;
    case K_PLAIN: epi_direct<K_PLAIN>(p, a, dst, fdst, scale, layer, hd, b, tq, wr, w, fr, fq); break;
    case K_GSILU: epi_direct<K_GSILU>(p, a, dst, fdst, scale, layer, hd, b, tq, wr, w, fr, fq); break;
    case K_GSIG: epi_direct<K_GSIG>(p, a, dst, fdst, scale, layer, hd, b, tq, wr, w, fr, fq); break;
    case K_SILUH: epi_direct<K_SILUH>(p, a, dst, fdst, scale, layer, hd, b, tq, wr, w, fr, fq); break;
    case K_LOGF: epi_direct<K_LOGF>(p, a, dst, fdst, scale, layer, hd, b, tq, wr, w, fr, fq); break;
    case K_SMALL: epi_direct<K_SMALL>(p, a, dst, fdst, scale, layer, hd, b, tq, wr, w, fr, fq); break;
    default: break;
  }
  int k0, k1; { bf16_t* d_; float* f_; float s_; classify_head(p, hd0, b, k0, d_, f_, s_); classify_head(p, hd0 + 1, b, k1, d_, f_, s_); }
  if (k0 == K_TR || k1 == K_TR) {
    if (kind == K_TR) epi_tr_write(p, a, shm + (wc >> 1) * 16384, layer, hd, wr, w, fr, fq);
    __syncthreads();
    int kq; bf16_t* dq; float* fq_; float sq; classify_head(p, hd0 + hq, b, kq, dq, fq_, sq);
    if (kq == K_TR) {
      const char* img = shm + hq * 16384;
#pragma unroll
      for (int i = 0; i < 4; ++i) { const int q = tid2 + 256 * i, cc = q >> 4, rc = q & 15; *(u32x4*)(dq + (size_t)cc * T + tq + rc * 8) = *(const u32x4*)(img + q * 16); }
    }
    __syncthreads();
  }
}
template <int KIND, int BJ, int PASS>
DI void epi2_write(const Params& p, const f32x4 (&acc)[2][2][4][2], char* img, float scale, int layer, int hd, int tbase, int wr, int w, int fr, int fq) {
  if (KIND == K_ROPE) {
    const int c = 16 * w + 4 * fq;
    const f32x4 b0 = *(const f32x4*)(p.BIASP() + layer * NP + hd * 64 + c), b1 = *(const f32x4*)(p.BIASP() + layer * NP + hd * 64 + 32 + c);
    const int ch0 = 2 * w + (fq >> 1), sub = (fq & 1) * 8;
#pragma unroll
    for (int ai = 0; ai < 2; ++ai)
#pragma unroll
      for (int m = 0; m < 4; ++m) {
        const int row = ai * 128 + wr * 64 + m * 16 + fr, t = tbase + row;
        const f32x4 cs = *(const f32x4*)(p.ROPEC() + t * 32 + c), sn = *(const f32x4*)(p.ROPES() + t * 32 + c);
        const f32x4 v0 = acc[ai][BJ][m][0] + b0, v1 = acc[ai][BJ][m][1] + b1;
        const f32x4 o0 = (v0 * cs - v1 * sn) * scale, o1 = (v0 * sn + v1 * cs) * scale;
        u32x2 w0 = {pack2(o0[0], o0[1]), pack2(o0[2], o0[3])}, w1 = {pack2(o1[0], o1[1]), pack2(o1[2], o1[3])};
        *(u32x2*)(img + row * 128 + ((ch0 ^ (fr & 7)) * 16) + sub) = w0;
        *(u32x2*)(img + row * 128 + (((ch0 + 4) ^ (fr & 7)) * 16) + sub) = w1;
      }
    return;
  }
  const int c = 32 * w + 8 * fq;
  const f32x4 b0 = *(const f32x4*)(p.BIASP() + layer * NP + hd * 64 + c), b1 = *(const f32x4*)(p.BIASP() + layer * NP + hd * 64 + c + 4);
  if (KIND == K_TR) {
    bf16_t* timg = (bf16_t*)img;
#pragma unroll
    for (int ai = 0; ai < 2; ++ai)
#pragma unroll
      for (int m = 0; m < 4; ++m)
#pragma unroll
        for (int n = 0; n < 2; ++n)
#pragma unroll
          for (int j = 0; j < 4; ++j) timg[(c + 4 * n + j) * 256 + ai * 128 + wr * 64 + m * 16 + fr] = f2bf(acc[ai][BJ][m][n][j] + (n ? b1[j] : b0[j]));
    return;
  }
  if (KIND == K_LOGF) {
    const f32x4 lb0 = *(const f32x4*)(p.LB() + layer * 256 + (hd - 36) * 64 + c), lb1 = *(const f32x4*)(p.LB() + layer * 256 + (hd - 36) * 64 + c + 4);
    float* fimg = (float*)img;
#pragma unroll
    for (int m = 0; m < 4; ++m) {
      const f32x4 v0 = acc[PASS][BJ][m][0] + b0, v1 = acc[PASS][BJ][m][1] + b1;
      f32x4 o0, o1;
#pragma unroll
      for (int j = 0; j < 4; ++j) { o0[j] = __logf(lb0[j] + (1.f - lb0[j]) * sigmoidf_(v0[j])); o1[j] = __logf(lb1[j] + (1.f - lb1[j]) * sigmoidf_(v1[j])); }
      const int row = wr * 64 + m * 16 + fr;
      *(f32x4*)(fimg + row * 64 + c) = o0; *(f32x4*)(fimg + row * 64 + c + 4) = o1;
    }
    return;
  }
  const int ch = 4 * w + fq;
#pragma unroll
  for (int ai = 0; ai < 2; ++ai)
#pragma unroll
    for (int m = 0; m < 4; ++m) {
      const int row = ai * 128 + wr * 64 + m * 16 + fr;
      const f32x4 v0 = acc[ai][BJ][m][0] + b0, v1 = acc[ai][BJ][m][1] + b1;
      f32x4 o0, o1;
#pragma unroll
      for (int j = 0; j < 4; ++j) {
        if (KIND == K_PLAIN) { o0[j] = v0[j]; o1[j] = v1[j]; }
        else if (KIND == K_SILUH || KIND == K_GSILU) { o0[j] = siluf_(v0[j]); o1[j] = siluf_(v1[j]); }
        else { o0[j] = sigmoidf_(v0[j]); o1[j] = sigmoidf_(v1[j]); }
      }
      u32x4 wv = {pack2(o0[0], o0[1]), pack2(o0[2], o0[3]), pack2(o1[0], o1[1]), pack2(o1[2], o1[3])};
      *(u32x4*)(img + row * 128 + ((ch ^ (fr & 7)) * 16)) = wv;
    }
}
template <int BJ, int PASS>
DI void epi2_write_head(const Params& p, int layer, int pn, const f32x4 (&acc)[2][2][4][2], char* shm, int b, int tbase, int wr, int wc, int fr, int fq) {
  const int w = wc & 1, hq = BJ * 2 + (wc >> 1), hd = pn * 4 + hq;
  int kind; bf16_t* dst; float* fdst; float scale;
  classify_head(p, hd, b, kind, dst, fdst, scale);
  char* img = shm + hq * 32768;
  switch (kind) {
    case K_ROPE: epi2_write<K_ROPE, BJ, PASS>(p, acc, img, scale, layer, hd, tbase, wr, w, fr, fq); break;
    case K_PLAIN: epi2_write<K_PLAIN, BJ, PASS>(p, acc, img, scale, layer, hd, tbase, wr, w, fr, fq); break;
    case K_TR: epi2_write<K_TR, BJ, PASS>(p, acc, img, scale, layer, hd, tbase, wr, w, fr, fq); break;
    case K_GSILU: epi2_write<K_GSILU, BJ, PASS>(p, acc, img, scale, layer, hd, tbase, wr, w, fr, fq); break;
    case K_GSIG: epi2_write<K_GSIG, BJ, PASS>(p, acc, img, scale, layer, hd, tbase, wr, w, fr, fq); break;
    case K_SILUH: epi2_write<K_SILUH, BJ, PASS>(p, acc, img, scale, layer, hd, tbase, wr, w, fr, fq); break;
    case K_LOGF: epi2_write<K_LOGF, BJ, PASS>(p, acc, img, scale, layer, hd, tbase, wr, w, fr, fq); break;
    case K_SMALL: {
      const int c = 32 * w + 8 * fq;
      const f32x4 b0 = *(const f32x4*)(p.BIASP() + layer * NP + hd * 64 + c), b1 = *(const f32x4*)(p.BIASP() + layer * NP + hd * 64 + c + 4);
#pragma unroll
      for (int ai = 0; ai < 2; ++ai)
#pragma unroll
        for (int m = 0; m < 4; ++m) {
          const size_t tok = (size_t)b * T + tbase + ai * 128 + wr * 64 + m * 16 + fr;
#pragma unroll
          for (int n = 0; n < 2; ++n)
#pragma unroll
            for (int j = 0; j < 4; ++j) {
              const int cc = c + 4 * n + j;
              const float v = acc[ai][BJ][m][n][j] + (n ? b1[j] : b0[j]);
              if (cc < 8) p.IFG()[tok * 8 + cc] = v;
              else if (cc < 20) p.DG()[tok * 12 + (cc - 8)] = sigmoidf_(v);
            }
        }
    } break;
    default: break;
  }
}
template <int PASS>
DI void epi2_pass(const Params& p, int layer, int panel, int pn, const f32x4 (&acc)[2][2][4][2], char* shm, int tidf) {
  const int wid = tidf >> 6, lane = tidf & 63, wr = wid >> 2, wc = wid & 3, fr = lane & 15, fq = lane >> 4;
  const int b = panel >> 3, tbase = (panel & 7) * 256;
  epi2_write_head<0, PASS>(p, layer, pn, acc, shm, b, tbase, wr, wc, fr, fq);
  epi2_write_head<1, PASS>(p, layer, pn, acc, shm, b, tbase, wr, wc, fr, fq);
  __syncthreads();
  {
    const int hq = wid >> 1, hd = pn * 4 + hq, half = wid & 1;
    int kind; bf16_t* dst; float* fdst; float scale;
    classify_head(p, hd, b, kind, dst, fdst, scale);
    const char* img = shm + hq * 32768;
    if (kind == K_LOGF) {
#pragma unroll 4
      for (int i = 0; i < 16; ++i) {
        const int pi = half * 16 + i;
        const u32x4 v = *(const u32x4*)(img + pi * 1024 + lane * 16);
        const int row = 4 * pi + (lane >> 4), ch = lane & 15;
        *(u32x4*)(fdst + (size_t)(tbase + PASS * 128 + row) * 64 + ch * 4) = v;
      }
    } else if (kind == K_TR) {
#pragma unroll 4
      for (int i = 0; i < 16; ++i) {
        const int pi = half * 16 + i;
        const u32x4 v = *(const u32x4*)(img + pi * 1024 + lane * 16);
        const int d = 2 * pi + (lane >> 5), tc = lane & 31;
        *(u32x4*)(dst + (size_t)d * T + tbase + tc * 8) = v;
      }
    } else if (kind == K_ROPE || kind == K_PLAIN || kind == K_SILUH || kind == K_GSILU || kind == K_GSIG) {
      const bool gate = (kind == K_GSILU || kind == K_GSIG);
#pragma unroll 4
      for (int i = 0; i < 16; ++i) {
        const int pi = half * 16 + i;
        const int rl = lane >> 3, chl = lane & 7, row = 8 * pi + rl;
        const u32x4 v = *(const u32x4*)(img + row * 128 + ((chl ^ rl) * 16));
        if (gate) *(u32x4*)(dst + ((size_t)b * T + tbase + row) * 256 + chl * 8) = v;
        else *(u32x4*)(dst + (size_t)(tbase + row) * 64 + chl * 8) = v;
      }
    }
  }
  __syncthreads();
}
DI void gemm_in_epilogue(const Params& p, int layer, int panel, int pn, const f32x4 (&acc)[2][2][4][2], char* shm) {
  int tidf = threadIdx.x; asm volatile("" : "+v"(tidf));
  __syncthreads();
  epi2_pass<0>(p, layer, panel, pn, acc, shm, tidf);
  if (pn == 9) epi2_pass<1>(p, layer, panel, pn, acc, shm, tidf);
}
DI void gemm_out_epilogue(const Params& p, int panel, int pn, const f32x4 (&acc)[2][2][4][2], char* shm) {
  int tidf = threadIdx.x; asm volatile("" : "+v"(tidf));
  const int wid = tidf >> 6, lane = tidf & 63, wr = wid >> 2, wc = wid & 3, fr = lane & 15, fq = lane >> 4;
#pragma unroll
  for (int ai = 0; ai < 2; ++ai)
#pragma unroll
    for (int m = 0; m < 4; ++m) {
      const size_t row = (size_t)(panel * 256 + ai * 128 + wr * 64 + m * 16 + fr);
#pragma unroll
      for (int bj = 0; bj < 2; ++bj)
#pragma unroll
        for (int n = 0; n < 2; ++n) {
          const int col = pn * 256 + bj * 128 + wc * 32 + n * 16 + fq * 4;
          const u32x2 hb = *(const u32x2*)(p.HB() + row * 1024 + col);
          const f32x4 h = {__uint_as_float(hb[0] << 16), __uint_as_float(hb[0] & 0xffff0000u), __uint_as_float(hb[1] << 16), __uint_as_float(hb[1] & 0xffff0000u)};
          *(f32x4*)(p.hf + row * 1024 + col) = DN_ALPHA * h + acc[ai][bj][m][n];
        }
    }
}
DI void ph_gemm_in(const Params& p, int layer, int bid, int nblk, char* shm) {
  asm volatile("" : "+s"(bid));
  if (nblk == 256) {
    const int x = bid & 7, c = bid >> 3;
    for (int g = 0; g < 4; ++g) {
      const int panel = 32 * x + 8 * g + (c & 7);
      const bf16_t* A = p.HB() + (size_t)panel * 256 * 1024;
      for (int s = 0; s < 4; ++s) {
        const int pn = (c >> 3) + 4 * s;
        f32x4 acc[2][2][4][2];
        gemm256_mainloop(A, p.WT() + ((size_t)layer * NP + pn * 256) * 1024, (bf16_t*)shm, acc);
        if (PROBE == 6) { __syncthreads(); gemm256_mainloop(A, p.WT() + ((size_t)layer * NP + pn * 256) * 1024, (bf16_t*)shm, acc); }
        gemm_in_epilogue(p, layer, panel, pn, acc, shm);
        if (PROBE == 7) gemm_in_epilogue(p, layer, panel, pn, acc, shm);
      }
    }
    return;
  }
  for (int panel = bid; panel < 256; panel += nblk) {
    const bf16_t* A = p.HB() + (size_t)panel * 256 * 1024;
    for (int pn = 0; pn < 16; ++pn) {
      f32x4 acc[2][2][4][2];
      gemm256_mainloop(A, p.WT() + ((size_t)layer * NP + pn * 256) * 1024, (bf16_t*)shm, acc);
      gemm_in_epilogue(p, layer, panel, pn, acc, shm);
    }
  }
}
DI void ph_gemm_out_ln(const Params& p, int layer, int bid, int nblk, char* shm) {
  asm volatile("" : "+s"(bid));
  for (int panel = bid; panel < 256; panel += nblk) {
    const bf16_t* A = p.YMIX() + (size_t)panel * 256 * 1024;
    for (int pn = 0; pn < 4; ++pn) {
      f32x4 acc[2][2][4][2];
      gemm256_mainloop(A, p.WOT() + ((size_t)layer * 1024 + pn * 256) * 1024, (bf16_t*)shm, acc);
      gemm_out_epilogue(p, panel, pn, acc, shm);
    }
    asm volatile("s_waitcnt vmcnt(0)" ::: "memory");
    __syncthreads();
    int tidf = threadIdx.x; asm volatile("" : "+v"(tidf));
    const int lane = tidf & 63, wid = tidf >> 6;
    const float* g = p.ln_g + layer * 1024; const float* bb = p.ln_b + layer * 1024;
    f32x4 nx[4];
    {
      const float* s0 = p.hf + (size_t)(panel * 256 + wid * 32) * 1024;
#pragma unroll
      for (int i = 0; i < 4; ++i) nx[i] = *(const f32x4*)(s0 + i * 256 + lane * 4);
    }
    for (int rr = 0; rr < 32; ++rr) {
      const int row = panel * 256 + wid * 32 + rr;
      float* s = p.hf + (size_t)row * 1024;
      f32x4 v[4];
#pragma unroll
      for (int i = 0; i < 4; ++i) v[i] = nx[i];
      if (rr + 1 < 32) {
#pragma unroll
        for (int i = 0; i < 4; ++i) nx[i] = *(const f32x4*)(s + 1024 + i * 256 + lane * 4);
      }
      float sum = 0.f;
#pragma unroll
      for (int i = 0; i < 4; ++i) sum += (v[i][0] + v[i][1]) + (v[i][2] + v[i][3]);
      sum = wave_sum(sum);
      const float mu = sum * (1.f / 1024.f);
      float q = 0.f;
#pragma unroll
      for (int i = 0; i < 4; ++i) { const f32x4 d = v[i] - mu; q += (d[0] * d[0] + d[1] * d[1]) + (d[2] * d[2] + d[3] * d[3]); }
      q = wave_sum(q);
      const float rs = rsqrtf(q * (1.f / 1024.f) + 1e-5f);
#pragma unroll
      for (int i = 0; i < 4; ++i) {
        const int cc = i * 256 + lane * 4;
        const f32x4 gg = *(const f32x4*)(g + cc), b4 = *(const f32x4*)(bb + cc);
        const f32x4 o = (v[i] - mu) * rs * gg + b4;
        if (layer == 0) { u32x2 pk = {pack2(o[0], o[1]), pack2(o[2], o[3])}; *(u32x2*)(p.HB() + (size_t)row * 1024 + cc) = pk; }
        else *(f32x4*)(s + cc) = o;
      }
    }
  }
}

DI f32x16 qk_tile(const bf16_t* Krow, const bf16x8 (&qf)[4], int l31, int h2) {
  f32x16 s = zero16();
  const bf16_t* kp = Krow + l31 * 64 + h2 * 8;
#pragma unroll
  for (int ks = 0; ks < 4; ++ks) { const bf16x8 a = *(const bf16x8*)(kp + ks * 16); s = MFMA32(a, qf[ks], s); }
  return s;
}
DI f32x16 qk_tile_s(const bf16_t* Krow, int stride, const bf16x8 (&qf)[4], int l31, int h2) {
  f32x16 s = zero16();
  const bf16_t* kp = Krow + l31 * stride + h2 * 8;
#pragma unroll
  for (int ks = 0; ks < 4; ++ks) { const bf16x8 a = *(const bf16x8*)(kp + ks * 16); s = MFMA32(a, qf[ks], s); }
  return s;
}
template <bool HAS_SEL>
DI void softmax_pv_t(f32x16& s, const bf16_t* VTp, int vstride, f32x16 (&o)[2], float& m, float& l, int l31, int h2, bool sel) {
  bf16x8 va[2][2];
#pragma unroll
  for (int dt = 0; dt < 2; ++dt)
#pragma unroll
    for (int sk = 0; sk < 2; ++sk) va[dt][sk] = ld_frag8x2(VTp + (size_t)(dt * 32 + l31) * vstride + sk * 16 + 4 * h2);
  float mx = s[0];
#pragma unroll
  for (int r = 1; r < 16; ++r) mx = fmaxf(mx, s[r]);
  if (HAS_SEL) mx = sel ? mx : -INFINITY;
  mx = xhalf_max(mx);
  const float mn = fmaxf(m, mx);
  const float alpha = __builtin_amdgcn_exp2f(m - mn);
  const float mref = (HAS_SEL && !sel) ? INFINITY : mn;
  float ps = 0.f;
#pragma unroll
  for (int r = 0; r < 16; ++r) { s[r] = __builtin_amdgcn_exp2f(s[r] - mref); ps += s[r]; }
  l = l * alpha + ps; m = mn;
#pragma unroll
  for (int dt = 0; dt < 2; ++dt)
#pragma unroll
    for (int r = 0; r < 16; ++r) o[dt][r] *= alpha;
  const bf16x8 p0 = pack8<0>(s), p1 = pack8<8>(s);
#pragma unroll
  for (int dt = 0; dt < 2; ++dt) { o[dt] = MFMA32(va[dt][0], p0, o[dt]); o[dt] = MFMA32(va[dt][1], p1, o[dt]); }
}
DI void softmax_pv(f32x16& s, const bf16_t* VTp, int vstride, f32x16 (&o)[2], float& m, float& l, int l31, int h2) { softmax_pv_t<false>(s, VTp, vstride, o, m, l, l31, h2, true); }

constexpr int AD_KSTR = 72, AD_VSTR = 68;
constexpr int AD_BUF = 64 * AD_KSTR * 2 + 64 * AD_VSTR * 2;
struct AdTile { u32x4 k, v; };
DI AdTile ad_load(const bf16_t* Kg, const bf16_t* Vg, int key0, int tidf) {
  AdTile r; const int row = tidf >> 3, ch = tidf & 7;
  r.k = *(const u32x4*)(Kg + (size_t)(key0 + row) * 64 + ch * 8);
  r.v = *(const u32x4*)(Vg + (size_t)row * T + key0 + ch * 8);
  return r;
}
DI void ad_store(const AdTile& r, char* buf, int tidf) {
  const int row = tidf >> 3, ch = tidf & 7;
  *(u32x4*)(buf + (row * AD_KSTR + ch * 8) * 2) = r.k;
  char* vp = buf + 64 * AD_KSTR * 2 + (row * AD_VSTR + ch * 8) * 2;
  *(u32x2*)vp = (u32x2){r.v[0], r.v[1]}; *(u32x2*)(vp + 8) = (u32x2){r.v[2], r.v[3]};
}
template <bool HAS_SEL>
DI void softmax_pv64(const bf16_t* Kb, const bf16_t* Vb, const bf16x8 (&qf)[4], f32x16 (&o)[2], float& m, float& l, int l31, int h2, bool sel) {
  f32x16 s0 = qk_tile_s(Kb, AD_KSTR, qf, l31, h2);
  f32x16 s1 = qk_tile_s(Kb + 32 * AD_KSTR, AD_KSTR, qf, l31, h2);
  float mx = fmaxf(s0[0], s1[0]);
#pragma unroll
  for (int r = 1; r < 16; ++r) mx = fmaxf(mx, fmaxf(s0[r], s1[r]));
  if (HAS_SEL) mx = sel ? mx : -INFINITY;
  mx = xhalf_max(mx);
  const float mn = fmaxf(m, mx);
  const float alpha = __builtin_amdgcn_exp2f(m - mn);
  const float mref = (HAS_SEL && !sel) ? INFINITY : mn;
  float ps = 0.f;
#pragma unroll
  for (int r = 0; r < 16; ++r) { s0[r] = __builtin_amdgcn_exp2f(s0[r] - mref); s1[r] = __builtin_amdgcn_exp2f(s1[r] - mref); ps += s0[r] + s1[r]; }
  l = l * alpha + ps; m = mn;
#pragma unroll
  for (int dt = 0; dt < 2; ++dt)
#pragma unroll
    for (int r = 0; r < 16; ++r) o[dt][r] *= alpha;
  const bf16x8 p0 = pack8<0>(s0), p1 = pack8<8>(s0), p2 = pack8<0>(s1), p3 = pack8<8>(s1);
#pragma unroll
  for (int dt = 0; dt < 2; ++dt) {
    const bf16_t* vp = Vb + (size_t)(dt * 32 + l31) * AD_VSTR + 4 * h2;
    o[dt] = MFMA32(ld_frag8x2(vp), p0, o[dt]);
    o[dt] = MFMA32(ld_frag8x2(vp + 16), p1, o[dt]);
    o[dt] = MFMA32(ld_frag8x2(vp + 32), p2, o[dt]);
    o[dt] = MFMA32(ld_frag8x2(vp + 48), p3, o[dt]);
  }
}
DI void ph_attnD(const Params& p, int layer, int* ctr, char* smem, int* s_pair) {
  float* imps = (float*)smem;
  float* impf = (float*)(smem + 34816);
  unsigned* smask = (unsigned*)(smem + 43008);
  unsigned* s_union = (unsigned*)(smem + 43008 + 256);
  char* kvbuf = smem + 49152;
  for (;;) {
    int tidf = threadIdx.x; asm volatile("" : "+v"(tidf));
    const int lane = tidf & 63, wid = tidf >> 6, h = wid & 3, qs = wid >> 2, l31 = lane & 31, h2 = lane >> 5;
    __syncthreads();
    if (tidf == 0) { *s_pair = atomicAdd(ctr, 1); *s_union = 0u; }
    __syncthreads();
    const int it = *s_pair;
    if (it >= 1024) break;
    const int b = it & 31, q0 = (31 - (it >> 5)) * 64;
    const int qw = q0 + 32 * qs;
    const int t = qw + l31, cur = q0 >> 6;
    const size_t tok = (size_t)b * T + t;
    bf16x8 qf[4];
    {
      const bf16_t* qp = p.QD() + ((size_t)(b * 4 + h) * T + t) * 64 + h2 * 8;
#pragma unroll
      for (int ks = 0; ks < 4; ++ks) qf[ks] = *(const bf16x8*)(qp + ks * 16);
    }
    const float g0 = p.DG()[tok * 12 + h * 3 + 0], g1 = p.DG()[tok * 12 + h * 3 + 1], g2 = p.DG()[tok * 12 + h * 3 + 2];
    f32x16 ofin[2];
    bf16_t* Kc_l = (bf16_t*)kvbuf;
    bf16_t* Vc_l = (bf16_t*)(kvbuf + 128 * 72 * 2);
    {
      const bf16_t* Kc = p.KCMP() + (size_t)b * 128 * 64;
      const bf16_t* Vc = p.VCMPT() + (size_t)b * 64 * 128;
      u32x4 ck[2], cv[2];
#pragma unroll
      for (int i = 0; i < 2; ++i) { const int q = tidf + 512 * i; ck[i] = *(const u32x4*)(Kc + q * 8); cv[i] = *(const u32x4*)(Vc + q * 8); }
#pragma unroll
      for (int i = 0; i < 2; ++i) {
        const int q = tidf + 512 * i;
        *(u32x4*)(Kc_l + (q >> 3) * 72 + (q & 7) * 8) = ck[i];
        bf16_t* vq = Vc_l + (q >> 4) * 136 + (q & 15) * 8;
        *(u32x2*)vq = (u32x2){cv[i][0], cv[i][1]}; *(u32x2*)(vq + 4) = (u32x2){cv[i][2], cv[i][3]};
      }
    }
    __syncthreads();
    {
      const int nkt = min(4, (qw >> 9) + 1);
      f32x16 o[2]; o[0] = zero16(); o[1] = zero16();
      float m = -1e30f, l = 0.f;
      for (int kt = 0; kt < nkt; ++kt) {
        f32x16 s = qk_tile_s(Kc_l + kt * 32 * 72, 72, qf, l31, h2);
#pragma unroll
        for (int r = 0; r < 16; ++r) { const int n = kt * 32 + crow(r, h2); if (16 * n + 31 > t) s[r] = -INFINITY; }
        softmax_pv(s, Vc_l + kt * 32, 136, o, m, l, l31, h2);
      }
      l = xhalf_sum(l);
      const float il = l > 0.f ? 1.f / l : 0.f;
      const float gi = g0 * il;
#pragma unroll
      for (int dt = 0; dt < 2; ++dt)
#pragma unroll
        for (int r = 0; r < 16; ++r) ofin[dt][r] = gi * o[dt][r];
      float carry = 0.f;
#pragma unroll
      for (int kt = 0; kt < 4; ++kt) {
        f32x16 s;
        if (kt < nkt) {
          s = qk_tile_s(Kc_l + kt * 32 * 72, 72, qf, l31, h2);
#pragma unroll
          for (int r = 0; r < 16; ++r) { const int n = kt * 32 + crow(r, h2); s[r] = (16 * n + 31 > t) ? 0.f : __builtin_amdgcn_exp2f(s[r] - m) * il; }
        } else s = zero16();
        float X[4];
#pragma unroll
        for (int g = 0; g < 4; ++g) X[g] = shx(s[4 * g + 3], 32);
#pragma unroll
        for (int g = 0; g < 4; ++g) {
          const float G = (s[4 * g] + s[4 * g + 1]) + (s[4 * g + 2] + s[4 * g + 3]);
          const float prev_other = g > 0 ? X[g - 1] : carry;
          imps[(wid * 32 + l31) * 33 + 8 * kt + 2 * g + h2] = G + (h2 ? X[g] : prev_other);
        }
        carry = X[3];
      }
    }
    __syncthreads();
    {
      const int tt = tidf >> 3, jg = tidf & 7, wq = (tt >> 5) * 4, tl = tt & 31;
#pragma unroll
      for (int i = 0; i < 4; ++i) {
        const int j = jg * 4 + i;
        impf[tt * 32 + j] = (imps[((wq + 0) * 32 + tl) * 33 + j] + imps[((wq + 1) * 32 + tl) * 33 + j]) + (imps[((wq + 2) * 32 + tl) * 33 + j] + imps[((wq + 3) * 32 + tl) * 33 + j]);
      }
    }
    __syncthreads();
    {
      const int tt = tidf >> 3, jg = tidf & 7;
      float v[32];
#pragma unroll
      for (int j = 0; j < 32; ++j) {
        float x = impf[tt * 32 + j];
        if (j > cur) x = -1e30f; else if (j == 0 || j == cur || j == cur - 1) x = 1e6f;
        v[j] = x;
      }
      unsigned bits = 0u;
#pragma unroll
      for (int i = 0; i < 4; ++i) {
        int rank = 0; float vj = 0.f;
#pragma unroll
        for (int j = 0; j < 32; ++j) if (j == jg * 4 + i) vj = v[j];
        const int jj = jg * 4 + i;
#pragma unroll
        for (int j = 0; j < 32; ++j) rank += (v[j] > vj || (v[j] == vj && j < jj)) ? 1 : 0;
        if (rank < 8 && jj <= cur) bits |= 1u << jj;
      }
      bits |= shx(bits, 1); bits |= shx(bits, 2); bits |= shx(bits, 4);
      if (jg == 0) { smask[tt] = bits; atomicOr(s_union, bits); }
    }
    __syncthreads();
    {
      const unsigned mymask = smask[32 * qs + l31];
      unsigned rem = *s_union;
      const bf16_t* Ks = p.KV() + (size_t)(2 * NB + b) * T * 64;
      const bf16_t* Vs = p.KV() + (size_t)(3 * NB + b) * 64 * T;
      f32x16 o[2]; o[0] = zero16(); o[1] = zero16();
      float m = -1e30f, l = 0.f;
      int j = __builtin_ctz(rem); rem &= rem - 1;
      { const AdTile r = ad_load(Ks, Vs, j * 64, tidf); ad_store(r, kvbuf, tidf); }
      __syncthreads();
      int pb = 0;
      for (;;) {
        const bool more = rem != 0u;
        const int jn = more ? __builtin_ctz(rem) : 0;
        AdTile nx;
        if (more) nx = ad_load(Ks, Vs, jn * 64, tidf);
        const char* buf = kvbuf + pb * AD_BUF;
        const bool sel = (mymask >> j) & 1u;
        if (j < cur) softmax_pv64<true>((const bf16_t*)buf, (const bf16_t*)(buf + 64 * AD_KSTR * 2), qf, o, m, l, l31, h2, sel);
        else
#pragma unroll
        for (int kh = 0; kh < 2; ++kh) {
          const int key0 = j * 64 + kh * 32;
          if (key0 <= qw + 31) {
            f32x16 s = qk_tile_s((const bf16_t*)buf + kh * 32 * AD_KSTR, AD_KSTR, qf, l31, h2);
            if (j == cur) {
#pragma unroll
              for (int r = 0; r < 16; ++r) { const int key = key0 + crow(r, h2); if (key > t) s[r] = -INFINITY; }
            }
            softmax_pv_t<true>(s, (const bf16_t*)(buf + 64 * AD_KSTR * 2) + kh * 32, AD_VSTR, o, m, l, l31, h2, sel);
          }
        }
        if (more) ad_store(nx, kvbuf + (pb ^ 1) * AD_BUF, tidf);
        __syncthreads();
        if (!more) break;
        rem &= rem - 1; j = jn; pb ^= 1;
      }
      l = xhalf_sum(l);
      const float il = l > 0.f ? g1 / l : 0.f;
#pragma unroll
      for (int dt = 0; dt < 2; ++dt)
#pragma unroll
        for (int r = 0; r < 16; ++r) ofin[dt][r] += il * o[dt][r];
    }
    {
      const bf16_t* Kw = p.KV() + (size_t)(4 * NB + b) * T * 64;
      const bf16_t* Vw = p.KV() + (size_t)(5 * NB + b) * 64 * T;
      f32x16 o[2]; o[0] = zero16(); o[1] = zero16();
      float m = -1e30f, l = 0.f;
      int k0 = max(0, q0 - 512);
      { const AdTile r = ad_load(Kw, Vw, k0, tidf); ad_store(r, kvbuf, tidf); }
      __syncthreads();
      int pb = 0;
      for (;;) {
        const bool more = k0 + 64 <= q0;
        AdTile nx;
        if (more) nx = ad_load(Kw, Vw, k0 + 64, tidf);
        const char* buf = kvbuf + pb * AD_BUF;
        if (k0 + 63 <= qw && k0 + 512 > qw + 31) softmax_pv64<false>((const bf16_t*)buf, (const bf16_t*)(buf + 64 * AD_KSTR * 2), qf, o, m, l, l31, h2, true);
        else
#pragma unroll
        for (int kh = 0; kh < 2; ++kh) {
          const int key0 = k0 + kh * 32;
          if (key0 <= qw + 31 && key0 + 31 + 512 > qw) {
            f32x16 s = qk_tile_s((const bf16_t*)buf + kh * 32 * AD_KSTR, AD_KSTR, qf, l31, h2);
            if (key0 + 31 > qw || key0 + 512 <= qw + 31) {
#pragma unroll
              for (int r = 0; r < 16; ++r) { const int key = key0 + crow(r, h2); if (key > t || t - key >= 512) s[r] = -INFINITY; }
            }
            softmax_pv(s, (const bf16_t*)(buf + 64 * AD_KSTR * 2) + kh * 32, AD_VSTR, o, m, l, l31, h2);
          }
        }
        if (more) ad_store(nx, kvbuf + (pb ^ 1) * AD_BUF, tidf);
        __syncthreads();
        if (!more) break;
        k0 += 64; pb ^= 1;
      }
      l = xhalf_sum(l);
      const float il = l > 0.f ? g2 / l : 0.f;
#pragma unroll
      for (int dt = 0; dt < 2; ++dt)
#pragma unroll
        for (int r = 0; r < 16; ++r) ofin[dt][r] += il * o[dt][r];
    }
#pragma unroll
    for (int dt = 0; dt < 2; ++dt)
#pragma unroll
      for (int g = 0; g < 4; ++g) {
        const int d0 = dt * 32 + 8 * g + 4 * h2;
        const u32x2 gz = *(const u32x2*)(p.GZ() + (size_t)4 * NTOK * 256 + tok * 256 + h * 64 + d0);
        const float z0 = __uint_as_float(gz.x << 16), z1 = __uint_as_float(gz.x & 0xffff0000u), z2 = __uint_as_float(gz.y << 16), z3 = __uint_as_float(gz.y & 0xffff0000u);
        u32x2 o2 = {pack2(ofin[dt][4 * g] * z0, ofin[dt][4 * g + 1] * z1), pack2(ofin[dt][4 * g + 2] * z2, ofin[dt][4 * g + 3] * z3)};
        *(u32x2*)(p.YMIX() + tok * 1024 + 768 + h * 64 + d0) = o2;
      }
  }
}


struct AaTile { u32x4 k0, v0, k1, v1; };
DI AaTile aa_load(const bf16_t* Kg, const bf16_t* Vg, int key0, int tidf) {
  AaTile r; const int row = tidf >> 3, ch = tidf & 7;
  r.k0 = *(const u32x4*)(Kg + (size_t)(key0 + row) * 64 + ch * 8);
  r.v0 = *(const u32x4*)(Vg + (size_t)row * T + key0 + ch * 8);
  r.k1 = *(const u32x4*)(Kg + (size_t)T * 64 + (size_t)(key0 + row) * 64 + ch * 8);
  r.v1 = *(const u32x4*)(Vg + (size_t)T * 64 + (size_t)row * T + key0 + ch * 8);
  return r;
}
DI void aa_store(const AaTile& r, char* buf, int tidf) {
  AdTile a; a.k = r.k0; a.v = r.v0; ad_store(a, buf, tidf);
  a.k = r.k1; a.v = r.v1; ad_store(a, buf + AD_BUF, tidf);
}
DI void ph_attnA_fb(const Params& p, int layer, int item, char* smem) {
  int tidf = threadIdx.x; asm volatile("" : "+v"(tidf));
  const int lane = tidf & 63, wid = tidf >> 6, h = wid & 3, qs = wid >> 2, l31 = lane & 31, h2 = lane >> 5, g = h >> 1;
  const int b = item >> 5, q0 = (item & 31) * 64;
  const int qw = q0 + 32 * qs, t = qw + l31;
  const size_t tok = (size_t)b * T + t;
  bf16x8 qf[4];
  {
    const bf16_t* qp = p.QA() + ((size_t)(b * 4 + h) * T + t) * 64 + h2 * 8;
#pragma unroll
    for (int ks = 0; ks < 4; ++ks) qf[ks] = *(const bf16x8*)(qp + ks * 16);
  }
  const bf16_t* Kg = p.KA() + (size_t)(b * 2) * T * 64;
  const bf16_t* Vg = p.VAT() + (size_t)(b * 2) * 64 * T;
  f32x16 o[2]; o[0] = zero16(); o[1] = zero16();
  float m = -1e30f, l = 0.f;
  int k0 = max(0, q0 - 128);
  __syncthreads();
  { const AaTile r = aa_load(Kg, Vg, k0, tidf); aa_store(r, smem, tidf); }
  __syncthreads();
  int pb = 0;
  for (;;) {
    const bool more = k0 + 64 <= q0;
    AaTile nx;
    if (more) nx = aa_load(Kg, Vg, k0 + 64, tidf);
    const char* buf = smem + pb * (2 * AD_BUF) + g * AD_BUF;
#pragma unroll
    for (int kh = 0; kh < 2; ++kh) {
      const int key0 = k0 + kh * 32;
      if (key0 <= qw + 31 && key0 + 31 + 128 > qw) {
        f32x16 s = qk_tile_s((const bf16_t*)buf + kh * 32 * AD_KSTR, AD_KSTR, qf, l31, h2);
        if (key0 + 31 > qw || key0 + 128 <= qw + 31) {
#pragma unroll
          for (int r = 0; r < 16; ++r) { const int key = key0 + crow(r, h2); if (key > t || t - key >= 128) s[r] = -INFINITY; }
        }
        softmax_pv(s, (const bf16_t*)(buf + 64 * AD_KSTR * 2) + kh * 32, AD_VSTR, o, m, l, l31, h2);
      }
    }
    if (more) aa_store(nx, smem + (pb ^ 1) * (2 * AD_BUF), tidf);
    __syncthreads();
    if (!more) break;
    k0 += 64; pb ^= 1;
  }
  l = xhalf_sum(l);
  const float sink = p.a_sinks[layer * 4 + h] * 1.4426950408889634f;
  const float M = fmaxf(m, sink);
  const float sc = __builtin_amdgcn_exp2f(m - M);
  const float inv = sc / (l * sc + __builtin_amdgcn_exp2f(sink - M));
#pragma unroll
  for (int dt = 0; dt < 2; ++dt)
#pragma unroll
    for (int gq = 0; gq < 4; ++gq) {
      const int d0 = dt * 32 + 8 * gq + 4 * h2;
      const u32x2 gz = *(const u32x2*)(p.GZ() + tok * 256 + h * 64 + d0);
      const float z0 = __uint_as_float(gz.x << 16), z1 = __uint_as_float(gz.x & 0xffff0000u), z2 = __uint_as_float(gz.y << 16), z3 = __uint_as_float(gz.y & 0xffff0000u);
      u32x2 o2 = {pack2(o[dt][4 * gq] * inv * z0, o[dt][4 * gq + 1] * inv * z1), pack2(o[dt][4 * gq + 2] * inv * z2, o[dt][4 * gq + 3] * inv * z3)};
      *(u32x2*)(p.YMIX() + tok * 1024 + h * 64 + d0) = o2;
    }
}

DI float logsigmoidf_(float x) { return fminf(x, 0.f) - __logf(1.f + __expf(-fabsf(x))); }
DI void mlstm_gates(const Params& p, size_t tok0, int hh, float* bc, float* ig, int tid) {
  if (tid < 64) {
    const int s0 = 2 * tid;
    const float lf0 = logsigmoidf_(p.IFG()[(tok0 + s0) * 8 + 4 + hh]), lf1 = logsigmoidf_(p.IFG()[(tok0 + s0 + 1) * 8 + 4 + hh]);
    const float pair = lf0 + lf1;
    float x = pair;
#pragma unroll
    for (int off = 1; off < 64; off <<= 1) { const float y = shup(x, off); if (tid >= off) x += y; }
    const float excl = x - pair;
    bc[s0] = excl + lf0; bc[s0 + 1] = excl + pair;
    ig[s0] = p.IFG()[(tok0 + s0) * 8 + hh]; ig[s0 + 1] = p.IFG()[(tok0 + s0 + 1) * 8 + hh];
  }
}
DI void conv8(const bf16_t* raw, int t, int dg, const float (&cw)[4][8], const float (&cb)[8], float (&out)[8]) {
#pragma unroll
  for (int e = 0; e < 8; ++e) out[e] = cb[e];
#pragma unroll
  for (int j = 0; j < 4; ++j) {
    const int ts = t - 3 + j;
    if (ts >= 0) {
      const u32x4 row = *(const u32x4*)(raw + (size_t)ts * 64 + dg * 8);
#pragma unroll
      for (int e2 = 0; e2 < 4; ++e2) { out[2 * e2] += cw[j][2 * e2] * __uint_as_float(row[e2] << 16); out[2 * e2 + 1] += cw[j][2 * e2 + 1] * __uint_as_float(row[e2] & 0xffff0000u); }
    }
  }
#pragma unroll
  for (int e = 0; e < 8; ++e) out[e] = siluf_(out[e]);
}
DI void conv_rows_load(const bf16_t* raw, int tfirst, int dg, u32x4 (&r)[7]) {
#pragma unroll
  for (int j = 0; j < 7; ++j) {
    const int ts = tfirst + j;
    const u32x4 v = *(const u32x4*)(raw + (size_t)max(ts, 0) * 64 + dg * 8);
    r[j] = ts >= 0 ? v : (u32x4){0u, 0u, 0u, 0u};
  }
}
template <int I>
DI void conv_rows_compute(const u32x4 (&r)[7], const float (&cw)[4][8], const float (&cb)[8], float (&out)[8]) {
#pragma unroll
  for (int e = 0; e < 8; ++e) out[e] = cb[e];
#pragma unroll
  for (int j = 0; j < 4; ++j) {
    const u32x4 row = r[I + j];
#pragma unroll
    for (int e2 = 0; e2 < 4; ++e2) { out[2 * e2] += cw[j][2 * e2] * __uint_as_float(row[e2] << 16); out[2 * e2 + 1] += cw[j][2 * e2 + 1] * __uint_as_float(row[e2] & 0xffff0000u); }
  }
#pragma unroll
  for (int e = 0; e < 8; ++e) out[e] = siluf_(out[e]);
}
DI void load_conv_w(const Params& p, int layer, int ch0, int dg, float (&cw)[4][8], float (&cb)[8]) {
#pragma unroll
  for (int j = 0; j < 4; ++j)
#pragma unroll
    for (int e = 0; e < 8; ++e) cw[j][e] = p.conv_w[layer * 2048 + j * 512 + ch0 + dg * 8 + e];
#pragma unroll
  for (int e = 0; e < 8; ++e) cb[e] = p.conv_b[layer * 512 + ch0 + dg * 8 + e];
}
DI void delta_state_loadA(const bf16_t* VT, bf16x8 (&a)[8], int wid, int l31, int h2) {
  const int mt = wid >> 1;
#pragma unroll
  for (int ks = 0; ks < 8; ++ks) a[ks] = *(const bf16x8*)(VT + (size_t)(mt * 32 + l31) * T + ks * 16 + h2 * 8);
}
DI void delta_state(const bf16x8 (&a)[8], const bf16_t* KT, float* out, int wid, int l31, int h2) {
  const int mt = wid >> 1, nt = wid & 1;
  f32x16 acc = zero16();
#pragma unroll
  for (int ks = 0; ks < 8; ++ks) {
    const bf16x8 bb = *(const bf16x8*)(KT + (nt * 32 + l31) * 136 + ks * 16 + h2 * 8);
    acc = MFMA32(a[ks], bb, acc);
  }
#pragma unroll
  for (int r = 0; r < 16; ++r) out[(mt * 32 + crow(r, h2)) * 64 + nt * 32 + l31] = acc[r];
}
DI void ph_mlstm_local(const Params& p, int layer, int item, char* smem) {
  float* bc = (float*)smem; float* ig = bc + 128; float* wv = ig + 128;
  bf16_t* KwT = (bf16_t*)(smem + 2048);
  float* nred = (float*)(smem + 2048 + 64 * 136 * 2);
  const int tid = tid_opaque(), lane = tid & 63, wid = tid >> 6, l31 = lane & 31, h2 = lane >> 5;
  const int b = item >> 6, hh = (item >> 4) & 3, c = item & 15, t0 = c * 128;
  const size_t tok0 = (size_t)b * T + t0;
  const int dg = tid & 7, sb = tid >> 3;
  u32x4 rows[7];
  conv_rows_load(p.QKB() + ((size_t)(b * 8 + 4 + hh) * T) * 64, t0 + 4 * sb - 3, dg, rows);
  bf16x8 af[8];
  delta_state_loadA(p.VBT() + (size_t)(b * 4 + hh) * 64 * T + t0, af, wid, l31, h2);
  float cw[4][8], cb[8];
  load_conv_w(p, layer, 256 + hh * 64, dg, cw, cb);
  __syncthreads();
  mlstm_gates(p, tok0, hh, bc, ig, tid);
  __syncthreads();
  if (tid < 128) wv[tid] = __expf(bc[127] - bc[tid] + ig[tid]);
  __syncthreads();
  {
    float v0[8], v1[8], v2[8], v3[8];
    conv_rows_compute<0>(rows, cw, cb, v0); conv_rows_compute<1>(rows, cw, cb, v1);
    conv_rows_compute<2>(rows, cw, cb, v2); conv_rows_compute<3>(rows, cw, cb, v3);
    const f32x4 w4 = *(const f32x4*)(wv + 4 * sb);
#pragma unroll
    for (int e = 0; e < 8; ++e) {
      u32x2 pk = {pack2(v0[e] * w4[0], v1[e] * w4[1]), pack2(v2[e] * w4[2], v3[e] * w4[3])};
      *(u32x2*)(KwT + (dg * 8 + e) * 136 + 4 * sb) = pk;
    }
  }
  __syncthreads();
  delta_state(af, KwT, p.BST() + (size_t)item * 4096, wid, l31, h2);
  {
    const int k = tid & 63, qd = tid >> 6;
    float a = 0.f;
#pragma unroll 8
    for (int s = 0; s < 32; ++s) a += bf2f(KwT[k * 136 + qd * 32 + s]);
    nred[qd * 64 + k] = a;
  }
  __syncthreads();
  if (tid < 64) p.BN()[(size_t)item * 64 + tid] = (nred[tid] + nred[64 + tid]) + (nred[128 + tid] + nred[192 + tid]);
  if (tid == 0) p.BG()[item] = bc[127];
}
DI void ph_mlstm_scan(const Params& p, int bh) {
  const int tid = tid_opaque();
  f32x4 C[4];
#pragma unroll
  for (int i = 0; i < 4; ++i) C[i] = (f32x4){0.f, 0.f, 0.f, 0.f};
  float n = 0.f;
  for (int c = 0; c < 16; ++c) {
    const int item = bh * 16 + c;
    const float g = __expf(p.BG()[item]);
    f32x4* ptr = (f32x4*)(p.BST() + (size_t)item * 4096 + tid * 16);
#pragma unroll
    for (int i = 0; i < 4; ++i) { const f32x4 tmp = ptr[i]; ptr[i] = C[i]; C[i] = g * C[i] + tmp; }
    if (tid < 64) { const float tmp = p.BN()[(size_t)item * 64 + tid]; p.BN()[(size_t)item * 64 + tid] = n; n = g * n + tmp; }
  }
}
DI void pv_only(const f32x16& s, const bf16_t* VTp, int vstride, f32x16 (&o)[2], int l31, int h2) {
  const bf16x8 p0 = pack8<0>(s), p1 = pack8<8>(s);
#pragma unroll
  for (int dt = 0; dt < 2; ++dt) {
    const bf16_t* vp = VTp + (size_t)(dt * 32 + l31) * vstride + 4 * h2;
    o[dt] = MFMA32(ld_frag8x2(vp), p0, o[dt]);
    o[dt] = MFMA32(ld_frag8x2(vp + 16), p1, o[dt]);
  }
}
DI bf16x8 frag_from_f32(const float* ptr) {
  const f32x4 a = *(const f32x4*)ptr, b = *(const f32x4*)(ptr + 4);
  u32x4 t = {pack2(a[0], a[1]), pack2(a[2], a[3]), pack2(b[0], b[1]), pack2(b[2], b[3])};
  return __builtin_bit_cast(bf16x8, t);
}
constexpr int VT_LSTR = 132;
DI void vt_chunk_load(const bf16_t* VT, int tid, u32x4 (&r)[4]) {
  const int d = tid >> 2, part = tid & 3;
#pragma unroll
  for (int j = 0; j < 4; ++j) r[j] = *(const u32x4*)(VT + (size_t)d * T + part * 32 + j * 8);
}
DI void vt_chunk_store(const u32x4 (&r)[4], bf16_t* lds, int tid) {
  const int d = tid >> 2, part = tid & 3;
#pragma unroll
  for (int j = 0; j < 4; ++j) {
    bf16_t* q = lds + d * VT_LSTR + part * 32 + j * 8;
    *(u32x2*)q = (u32x2){r[j][0], r[j][1]}; *(u32x2*)(q + 4) = (u32x2){r[j][2], r[j][3]};
  }
}
DI void ph_mlstm_out(const Params& p, int layer, int item, char* smem) {
  float* bc = (float*)smem; float* ig = bc + 128;
  bf16_t* qc = (bf16_t*)(smem + 2048);
  bf16_t* kc = qc + 128 * 72;
  bf16_t* vt = kc + 128 * 72;
  const int tid = tid_opaque(), lane = tid & 63, wid = tid >> 6, l31 = lane & 31, h2 = lane >> 5;
  const int b = item >> 6, hh = (item >> 4) & 3, c = item & 15, t0 = c * 128;
  const size_t tok0 = (size_t)b * T + t0;
  const int dg = tid & 7, sb = tid >> 3;
  u32x4 rq[7], rk[7];
  conv_rows_load(p.QKB() + ((size_t)(b * 8 + hh) * T) * 64, t0 + 4 * sb - 3, dg, rq);
  conv_rows_load(p.QKB() + ((size_t)(b * 8 + 4 + hh) * T) * 64, t0 + 4 * sb - 3, dg, rk);
  u32x4 rv[4];
  vt_chunk_load(p.VBT() + (size_t)(b * 4 + hh) * 64 * T + t0, tid, rv);
  __syncthreads();
  mlstm_gates(p, tok0, hh, bc, ig, tid);
  {
    float cw[4][8], cb[8];
    load_conv_w(p, layer, hh * 64, dg, cw, cb);
    float v[8];
#define CONV_ST(I, R, DST, SC) do { conv_rows_compute<I>(R, cw, cb, v); \
      u32x4 w_ = {pack2(v[0] * (SC), v[1] * (SC)), pack2(v[2] * (SC), v[3] * (SC)), pack2(v[4] * (SC), v[5] * (SC)), pack2(v[6] * (SC), v[7] * (SC))}; \
      *(u32x4*)((DST) + (4 * sb + (I)) * 72 + dg * 8) = w_; } while (0)
    CONV_ST(0, rq, qc, 0.125f); CONV_ST(1, rq, qc, 0.125f); CONV_ST(2, rq, qc, 0.125f); CONV_ST(3, rq, qc, 0.125f);
    load_conv_w(p, layer, 256 + hh * 64, dg, cw, cb);
    CONV_ST(0, rk, kc, 1.f); CONV_ST(1, rk, kc, 1.f); CONV_ST(2, rk, kc, 1.f); CONV_ST(3, rk, kc, 1.f);
#undef CONV_ST
  }
  vt_chunk_store(rv, vt, tid);
  const int tq = 32 * wid + l31;
  const float* Cs = p.BST() + (size_t)item * 4096;
  const float* ns = p.BN() + (size_t)item * 64;
  f32x4 cst[2][4][2], nst[4][2];
#pragma unroll
  for (int ks = 0; ks < 4; ++ks) {
#pragma unroll
    for (int dt = 0; dt < 2; ++dt) { cst[dt][ks][0] = *(const f32x4*)(Cs + (dt * 32 + l31) * 64 + ks * 16 + h2 * 8); cst[dt][ks][1] = *(const f32x4*)(Cs + (dt * 32 + l31) * 64 + ks * 16 + h2 * 8 + 4); }
    nst[ks][0] = *(const f32x4*)(ns + ks * 16 + h2 * 8); nst[ks][1] = *(const f32x4*)(ns + ks * 16 + h2 * 8 + 4);
  }
  u32x2 gz1[2][4], gz2[2][4];
#pragma unroll
  for (int dt = 0; dt < 2; ++dt)
#pragma unroll
    for (int g = 0; g < 4; ++g) {
      const int d0 = dt * 32 + 8 * g + 4 * h2;
      gz1[dt][g] = *(const u32x2*)(p.GZ() + (size_t)1 * NTOK * 256 + (tok0 + tq) * 256 + hh * 64 + d0);
      gz2[dt][g] = *(const u32x2*)(p.GZ() + (size_t)2 * NTOK * 256 + (tok0 + tq) * 256 + hh * 64 + d0);
    }
  __syncthreads();
  if (tid < 128) ig[tid] = ig[tid] - bc[tid];
  __syncthreads();
  bf16x8 qf[4];
#pragma unroll
  for (int ks = 0; ks < 4; ++ks) qf[ks] = *(const bf16x8*)(qc + tq * 72 + ks * 16 + h2 * 8);
  const float bt = bc[tq];
  f32x16 o[2]; o[0] = zero16(); o[1] = zero16();
  float dsum = 0.f;
  for (int kt = 0; kt <= wid; ++kt) {
    f32x16 s = qk_tile_s(kc + kt * 32 * 72, 72, qf, l31, h2);
#pragma unroll
    for (int r = 0; r < 16; ++r) {
      const int sidx = 32 * kt + crow(r, h2);
      float val = s[r] * __expf(bt + ig[sidx]);
      if (sidx > tq) val = 0.f;
      s[r] = val; dsum += val;
    }
    pv_only(s, vt + kt * 32, VT_LSTR, o, l31, h2);
  }
  dsum += shx(dsum, 32);
  f32x16 oi[2]; oi[0] = zero16(); oi[1] = zero16();
  float qn = 0.f;
#pragma unroll
  for (int ks = 0; ks < 4; ++ks) {
#pragma unroll
    for (int dt = 0; dt < 2; ++dt) {
      const f32x4 a_ = cst[dt][ks][0], b_ = cst[dt][ks][1];
      u32x4 t_ = {pack2(a_[0], a_[1]), pack2(a_[2], a_[3]), pack2(b_[0], b_[1]), pack2(b_[2], b_[3])};
      oi[dt] = MFMA32(__builtin_bit_cast(bf16x8, t_), qf[ks], oi[dt]);
    }
    const u32x4 qu = __builtin_bit_cast(u32x4, qf[ks]);
    const f32x4 n0 = nst[ks][0], n1 = nst[ks][1];
    qn += __uint_as_float(qu[0] << 16) * n0[0] + __uint_as_float(qu[0] & 0xffff0000u) * n0[1] + __uint_as_float(qu[1] << 16) * n0[2] + __uint_as_float(qu[1] & 0xffff0000u) * n0[3];
    qn += __uint_as_float(qu[2] << 16) * n1[0] + __uint_as_float(qu[2] & 0xffff0000u) * n1[1] + __uint_as_float(qu[3] << 16) * n1[2] + __uint_as_float(qu[3] & 0xffff0000u) * n1[3];
  }
  qn += shx(qn, 32);
  const float ebt = __expf(bt);
  const float den = dsum + ebt * qn;
  const float inv = 1.f / fmaxf(fabsf(den), 1.f);
  const size_t tok = tok0 + tq;
#pragma unroll
  for (int dt = 0; dt < 2; ++dt)
#pragma unroll
    for (int g = 0; g < 4; ++g) {
      const int d0 = dt * 32 + 8 * g + 4 * h2;
      const u32x2 g1 = gz1[dt][g], g2 = gz2[dt][g];
      float z[4] = {__uint_as_float(g1.x << 16) * __uint_as_float(g2.x << 16), __uint_as_float(g1.x & 0xffff0000u) * __uint_as_float(g2.x & 0xffff0000u),
                    __uint_as_float(g1.y << 16) * __uint_as_float(g2.y << 16), __uint_as_float(g1.y & 0xffff0000u) * __uint_as_float(g2.y & 0xffff0000u)};
      float hv[4];
#pragma unroll
      for (int i = 0; i < 4; ++i) hv[i] = (o[dt][4 * g + i] + ebt * oi[dt][4 * g + i]) * inv * z[i];
      u32x2 o2 = {pack2(hv[0], hv[1]), pack2(hv[2], hv[3])};
      *(u32x2*)(p.YMIX() + tok * 1024 + 256 + hh * 64 + d0) = o2;
    }
}


DI void ph_hgrn_local(const Params& p, int layer, int item, char* smem) {
  float* tot = (float*)smem;
  bf16_t* KdT = (bf16_t*)(smem + 1024);
  const int tid = tid_opaque(), lane = tid & 63, wid = tid >> 6, l31 = lane & 31, h2 = lane >> 5;
  const int b = item >> 6, hh = (item >> 4) & 3, c = item & 15, t0 = c * 128;
  const int k = tid & 63, qd = tid >> 6;
  float al[32], kk[32];
  bf16x8 af[8];
  delta_state_loadA(p.VCT() + (size_t)(b * 4 + hh) * 64 * T + t0, af, wid, l31, h2);
  {
    const float* gp = p.GC() + ((size_t)(b * 4 + hh) * T + t0 + 32 * qd) * 64 + k;
    float run = 0.f;
#pragma unroll
    for (int s = 0; s < 32; ++s) { const float g = gp[s * 64]; run += g; al[s] = run; kk[s] = 1.f - __expf(g); }
    __syncthreads();
    tot[qd * 64 + k] = run;
  }
  __syncthreads();
  float off = 0.f, aL = 0.f;
#pragma unroll
  for (int q = 0; q < 4; ++q) { const float v = tot[q * 64 + k]; aL += v; if (q < qd) off += v; }
#pragma unroll
  for (int s8 = 0; s8 < 4; ++s8) {
    float v[8];
#pragma unroll
    for (int e = 0; e < 8; ++e) v[e] = kk[s8 * 8 + e] * __expf(aL - (al[s8 * 8 + e] + off));
    u32x4 w = {pack2(v[0], v[1]), pack2(v[2], v[3]), pack2(v[4], v[5]), pack2(v[6], v[7])};
    *(u32x4*)(KdT + k * 136 + qd * 32 + s8 * 8) = w;
  }
  __syncthreads();
  delta_state(af, KdT, p.CST() + (size_t)item * 4096, wid, l31, h2);
  if (qd == 0) p.CAL()[(size_t)item * 64 + k] = aL;
}
DI void ph_hgrn_scan(const Params& p, int bh) {
  const int tid = tid_opaque();
  f32x4 S[4];
#pragma unroll
  for (int i = 0; i < 4; ++i) S[i] = (f32x4){0.f, 0.f, 0.f, 0.f};
  for (int c = 0; c < 16; ++c) {
    const int item = bh * 16 + c;
    const f32x4* dp = (const f32x4*)(p.CAL() + (size_t)item * 64 + (tid & 3) * 16);
    f32x4* ptr = (f32x4*)(p.CST() + (size_t)item * 4096 + tid * 16);
#pragma unroll
    for (int i = 0; i < 4; ++i) {
      const f32x4 a = dp[i];
      const f32x4 dec = {__expf(a[0]), __expf(a[1]), __expf(a[2]), __expf(a[3])};
      const f32x4 tmp = ptr[i]; ptr[i] = S[i]; S[i] = dec * S[i] + tmp;
    }
  }
}
DI void ph_hgrn_out(const Params& p, int layer, int item, char* smem) {
  float* a_lds = (float*)smem;
  float* tot = (float*)(smem + 128 * 68 * 4);
  bf16_t* kk_lds = (bf16_t*)(smem + 128 * 68 * 4 + 1024);
  bf16_t* vt = kk_lds + 128 * 72;
  const int tid = tid_opaque(), lane = tid & 63, wid = tid >> 6, l31 = lane & 31, h2 = lane >> 5;
  const int b = item >> 6, hh = (item >> 4) & 3, c = item & 15, t0 = c * 128;
  const size_t hbase = (size_t)(b * 4 + hh) * T + t0;
  const int tq = 32 * wid + l31;
  const size_t tok = (size_t)b * T + t0 + tq;
  u32x4 qu[4];
#pragma unroll
  for (int ks = 0; ks < 4; ++ks) qu[ks] = *(const u32x4*)(p.QC() + (hbase + tq) * 64 + ks * 16 + h2 * 8);
  u32x4 rv[4];
  vt_chunk_load(p.VCT() + (size_t)(b * 4 + hh) * 64 * T + t0, tid, rv);
  u32x2 gzv[2][4];
#pragma unroll
  for (int dt = 0; dt < 2; ++dt)
#pragma unroll
    for (int g = 0; g < 4; ++g) gzv[dt][g] = *(const u32x2*)(p.GZ() + (size_t)3 * NTOK * 256 + tok * 256 + hh * 64 + dt * 32 + 8 * g + 4 * h2);
  {
    const int k = tid & 63, qd = tid >> 6;
    float al[32];
    const float* gp = p.GC() + (hbase + 32 * qd) * 64 + k;
    float run = 0.f;
    __syncthreads();
#pragma unroll
    for (int s = 0; s < 32; ++s) { const float g = gp[s * 64]; run += g; al[s] = run; kk_lds[(32 * qd + s) * 72 + k] = f2bf(1.f - __expf(g)); }
    tot[qd * 64 + k] = run;
    vt_chunk_store(rv, vt, tid);
    __syncthreads();
    float off = 0.f;
#pragma unroll
    for (int q = 0; q < 4; ++q) { const float v = tot[q * 64 + k]; if (q < qd) off += v; }
#pragma unroll
    for (int s = 0; s < 32; ++s) a_lds[(32 * qd + s) * 68 + k] = al[s] + off;
  }
  const float* Ss = p.CST() + (size_t)item * 4096;
  f32x4 cst[2][4][2];
#pragma unroll
  for (int ks = 0; ks < 4; ++ks)
#pragma unroll
    for (int dt = 0; dt < 2; ++dt) { cst[dt][ks][0] = *(const f32x4*)(Ss + (dt * 32 + l31) * 64 + ks * 16 + h2 * 8); cst[dt][ks][1] = *(const f32x4*)(Ss + (dt * 32 + l31) * 64 + ks * 16 + h2 * 8 + 4); }
  __syncthreads();
  bf16x8 qi[4], qh[4];
#pragma unroll
  for (int ks = 0; ks < 4; ++ks) {
    const int k0 = ks * 16 + h2 * 8;
    float q8[8], e1[8], e2[8];
#pragma unroll
    for (int e2i = 0; e2i < 4; ++e2i) { q8[2 * e2i] = __uint_as_float(qu[ks][e2i] << 16); q8[2 * e2i + 1] = __uint_as_float(qu[ks][e2i] & 0xffff0000u); }
#pragma unroll
    for (int e = 0; e < 8; ++e) {
      const float a = a_lds[tq * 68 + k0 + e];
      const float r = wid > 0 ? a_lds[(32 * wid - 1) * 68 + k0 + e] : 0.f;
      e1[e] = q8[e] * __expf(a - r); e2[e] = q8[e] * __expf(a);
    }
    u32x4 w1 = {pack2(e1[0], e1[1]), pack2(e1[2], e1[3]), pack2(e1[4], e1[5]), pack2(e1[6], e1[7])};
    u32x4 w2 = {pack2(e2[0], e2[1]), pack2(e2[2], e2[3]), pack2(e2[4], e2[5]), pack2(e2[6], e2[7])};
    qi[ks] = __builtin_bit_cast(bf16x8, w1); qh[ks] = __builtin_bit_cast(bf16x8, w2);
  }
  f32x16 o[2]; o[0] = zero16(); o[1] = zero16();
  for (int kt = 0; kt <= wid; ++kt) {
    f32x16 s = zero16();
    const int srow = 32 * kt + l31;
#pragma unroll
    for (int ks = 0; ks < 4; ++ks) {
      const int k0 = ks * 16 + h2 * 8;
      const u32x4 ku = *(const u32x4*)(kk_lds + srow * 72 + k0);
      float v[8];
#pragma unroll
      for (int e = 0; e < 8; ++e) {
        const float a = a_lds[srow * 68 + k0 + e];
        const float r = wid > 0 ? a_lds[(32 * wid - 1) * 68 + k0 + e] : 0.f;
        const float kkv = (e & 1) ? __uint_as_float(ku[e >> 1] & 0xffff0000u) : __uint_as_float(ku[e >> 1] << 16);
        v[e] = kkv * __expf(fminf(r - a, 80.f));
      }
      u32x4 w = {pack2(v[0], v[1]), pack2(v[2], v[3]), pack2(v[4], v[5]), pack2(v[6], v[7])};
      s = MFMA32(__builtin_bit_cast(bf16x8, w), qi[ks], s);
    }
    if (kt == wid) {
#pragma unroll
      for (int r = 0; r < 16; ++r) if (32 * kt + crow(r, h2) > tq) s[r] = 0.f;
    }
    pv_only(s, vt + kt * 32, VT_LSTR, o, l31, h2);
  }
#pragma unroll
  for (int ks = 0; ks < 4; ++ks)
#pragma unroll
    for (int dt = 0; dt < 2; ++dt) {
      const f32x4 a_ = cst[dt][ks][0], b_ = cst[dt][ks][1];
      u32x4 t_ = {pack2(a_[0], a_[1]), pack2(a_[2], a_[3]), pack2(b_[0], b_[1]), pack2(b_[2], b_[3])};
      o[dt] = MFMA32(__builtin_bit_cast(bf16x8, t_), qh[ks], o[dt]);
    }
  float ss = 0.f;
#pragma unroll
  for (int dt = 0; dt < 2; ++dt)
#pragma unroll
    for (int r = 0; r < 16; ++r) ss += o[dt][r] * o[dt][r];
  ss += shx(ss, 32);
  const float rs = rsqrtf(ss * (1.f / 64.f) + 1e-6f);
#pragma unroll
  for (int dt = 0; dt < 2; ++dt)
#pragma unroll
    for (int g = 0; g < 4; ++g) {
      const int d0 = dt * 32 + 8 * g + 4 * h2;
      const u32x2 gz = gzv[dt][g];
      const f32x4 gn = *(const f32x4*)(p.c_norm_g + layer * 256 + hh * 64 + d0);
      const float z0 = __uint_as_float(gz.x << 16), z1 = __uint_as_float(gz.x & 0xffff0000u), z2 = __uint_as_float(gz.y << 16), z3 = __uint_as_float(gz.y & 0xffff0000u);
      u32x2 o2 = {pack2(o[dt][4 * g] * rs * gn[0] * z0, o[dt][4 * g + 1] * rs * gn[1] * z1), pack2(o[dt][4 * g + 2] * rs * gn[2] * z2, o[dt][4 * g + 3] * rs * gn[3] * z3)};
      *(u32x2*)(p.YMIX() + tok * 1024 + 512 + hh * 64 + d0) = o2;
    }
}


DI void ph_attnA(const Params& p, int layer, int item, char* smem) {
  const int tid = tid_opaque(), lane = tid & 63, h = tid >> 6, l31 = lane & 31, h2 = lane >> 5;
  const int b = item >> 6, q0 = (item & 63) * 32, g = h >> 1;
  const int t = q0 + l31;
  const size_t tok = (size_t)b * T + t;
  bf16x8 qf[4];
  {
    const bf16_t* qp = p.QA() + ((size_t)(b * 4 + h) * T + t) * 64 + h2 * 8;
#pragma unroll
    for (int ks = 0; ks < 4; ++ks) qf[ks] = *(const bf16x8*)(qp + ks * 16);
  }
  const bf16_t* Kp = p.KA() + (size_t)(b * 2 + g) * T * 64;
  const bf16_t* Vp = p.VAT() + (size_t)(b * 2 + g) * 64 * T;
  f32x16 o[2]; o[0] = zero16(); o[1] = zero16();
  float m = -1e30f, l = 0.f;
  for (int key0 = max(0, q0 - 128); key0 <= q0; key0 += 32) {
    f32x16 s = qk_tile(Kp + (size_t)key0 * 64, qf, l31, h2);
    if (key0 == q0 - 128 || key0 == q0) {
#pragma unroll
      for (int r = 0; r < 16; ++r) { const int key = key0 + crow(r, h2); if (key > t || t - key >= 128) s[r] = -INFINITY; }
    }
    softmax_pv(s, Vp + key0, T, o, m, l, l31, h2);
  }
  l = xhalf_sum(l);
  const float sink = p.a_sinks[layer * 4 + h] * 1.4426950408889634f;
  const float M = fmaxf(m, sink);
  const float sc = __builtin_amdgcn_exp2f(m - M);
  const float inv = sc / (l * sc + __builtin_amdgcn_exp2f(sink - M));
#pragma unroll
  for (int dt = 0; dt < 2; ++dt)
#pragma unroll
    for (int gq = 0; gq < 4; ++gq) {
      const int d0 = dt * 32 + 8 * gq + 4 * h2;
      const u32x2 gz = *(const u32x2*)(p.GZ() + tok * 256 + h * 64 + d0);
      const float z0 = __uint_as_float(gz.x << 16), z1 = __uint_as_float(gz.x & 0xffff0000u), z2 = __uint_as_float(gz.y << 16), z3 = __uint_as_float(gz.y & 0xffff0000u);
      u32x2 o2 = {pack2(o[dt][4 * gq] * inv * z0, o[dt][4 * gq + 1] * inv * z1), pack2(o[dt][4 * gq + 2] * inv * z2, o[dt][4 * gq + 3] * inv * z3)};
      *(u32x2*)(p.YMIX() + tok * 1024 + h * 64 + d0) = o2;
    }
}

DI void ph_cmp(const Params& p, int layer, int item, char* smem) {
  float* red = (float*)smem;
  bf16_t* hid = (bf16_t*)(smem + 32768);
  const int tid = tid_opaque(), lane = tid & 63, wid = tid >> 6, l31 = lane & 31, h2 = lane >> 5;
  const int b = item >> 3, kvsel = (item >> 2) & 1, mt = item & 3;
  const int lk = layer * 2 + kvsel;
  const int n = min(mt * 32 + l31, 126);
  const bf16_t* src = p.KV() + ((size_t)(kvsel * NB + b) * T + 16 * n) * 64 + wid * 512 + h2 * 8;
  const bf16_t* w1t = p.W1T() + (size_t)lk * 64 * 2048 + wid * 512 + h2 * 8;
  f32x16 acc[2]; acc[0] = zero16(); acc[1] = zero16();
#pragma unroll 4
  for (int ks = 0; ks < 32; ++ks) {
    const bf16x8 a = *(const bf16x8*)(src + ks * 16);
    const bf16x8 b0 = *(const bf16x8*)(w1t + (size_t)l31 * 2048 + ks * 16);
    const bf16x8 b1 = *(const bf16x8*)(w1t + (size_t)(32 + l31) * 2048 + ks * 16);
    acc[0] = MFMA32(a, b0, acc[0]); acc[1] = MFMA32(a, b1, acc[1]);
  }
  __syncthreads();
#pragma unroll
  for (int nt = 0; nt < 2; ++nt)
#pragma unroll
    for (int r = 0; r < 16; ++r) red[(wid * 32 + crow(r, h2)) * 64 + nt * 32 + l31] = acc[nt][r];
  __syncthreads();
  {
    const int row = tid >> 3, c0 = (tid & 7) * 8;
    float v[8];
#pragma unroll
    for (int e = 0; e < 8; ++e) {
      const float x = (red[(0 * 32 + row) * 64 + c0 + e] + red[(1 * 32 + row) * 64 + c0 + e]) + (red[(2 * 32 + row) * 64 + c0 + e] + red[(3 * 32 + row) * 64 + c0 + e]) + p.CVEC()[lk * 64 + c0 + e];
      v[e] = siluf_(x);
    }
    u32x4 w = {pack2(v[0], v[1]), pack2(v[2], v[3]), pack2(v[4], v[5]), pack2(v[6], v[7])};
    *(u32x4*)(hid + row * 72 + c0) = w;
  }
  __syncthreads();
  if (wid == 0) {
    f32x16 o[2]; o[0] = zero16(); o[1] = zero16();
    const bf16_t* w2t = p.W2T() + (size_t)lk * 4096;
#pragma unroll
    for (int ks = 0; ks < 4; ++ks) {
      const bf16x8 a = *(const bf16x8*)(hid + l31 * 72 + ks * 16 + h2 * 8);
#pragma unroll
      for (int nt = 0; nt < 2; ++nt) o[nt] = MFMA32(a, *(const bf16x8*)(w2t + (nt * 32 + l31) * 64 + ks * 16 + h2 * 8), o[nt]);
    }
    if (kvsel == 0) {
#pragma unroll
      for (int r = 0; r < 16; ++r) {
        const int nn = mt * 32 + crow(r, h2);
        if (nn < 127) {
          const int pos = 16 * nn + 31;
          const float cs = p.ROPEC()[pos * 32 + l31], sn = p.ROPES()[pos * 32 + l31];
          p.KCMP()[((size_t)b * 128 + nn) * 64 + l31] = f2bf(o[0][r] * cs - o[1][r] * sn);
          p.KCMP()[((size_t)b * 128 + nn) * 64 + 32 + l31] = f2bf(o[0][r] * sn + o[1][r] * cs);
        }
      }
    } else {
#pragma unroll
      for (int nt = 0; nt < 2; ++nt)
#pragma unroll
        for (int r = 0; r < 16; ++r) {
          const int nn = mt * 32 + crow(r, h2);
          if (nn < 127) p.VCMPT()[((size_t)b * 64 + nt * 32 + l31) * 128 + nn] = f2bf(o[nt][r]);
        }
    }
  }
}


#define XB_TMO      128
#define XB_XCNT(j)  (256  + 64 * (j))
#define XB_XSUB(j)  (1280 + 64 * (j))
#define XB_XGEN(j)  (2304 + 64 * (j))
#define XB_TOP      3328
#define XB_TOPGEN   3392
#define XCD_BAR_WORDS 3456
#define XB_SPIN_CAP (1u << 22)
DI unsigned xb_ld(unsigned* p)              { return __hip_atomic_load(p, __ATOMIC_RELAXED, __HIP_MEMORY_SCOPE_AGENT); }
DI unsigned xb_add(unsigned* p, unsigned v) { return __hip_atomic_fetch_add(p, v, __ATOMIC_RELAXED, __HIP_MEMORY_SCOPE_AGENT); }
DI unsigned xb_xcc_id() { return (unsigned)__builtin_amdgcn_s_getreg((3 << 11) | 20) & 0xFu; }
#define XB_SPIN(cond, bar) do { unsigned _sp = 0; while (cond) { __builtin_amdgcn_s_sleep(1); \
    if ((++_sp & 255u) == 0u) { if (xb_ld(&(bar)[XB_TMO])) break; if (_sp > XB_SPIN_CAP) { atomicAdd(&(bar)[XB_TMO], 1u); break; } } } } while (0)
struct XcdBarrier { unsigned* bar; unsigned x; volatile LAS unsigned* st; };
DI XcdBarrier xcd_barrier_post(unsigned* bar, volatile LAS unsigned* st) {
  XcdBarrier b; b.bar = bar; b.x = xb_xcc_id(); b.st = st;
  if (threadIdx.x == 0) (void)xb_add(&bar[XB_XCNT(b.x)], 1u);
  return b;
}
DI void xcd_barrier_complete(unsigned* bar, unsigned x, unsigned& nloc, unsigned& nx) {
  const unsigned G = gridDim.x * gridDim.y * gridDim.z;
  unsigned sum, cnt, mine, sp = 0u;
  for (;;) {
    sum = 0u; cnt = 0u; mine = 0u;
#pragma unroll
    for (unsigned j = 0; j < 16; ++j) { const unsigned c = xb_ld(&bar[XB_XCNT(j)]); sum += c; cnt += (c > 0u) ? 1u : 0u; mine = (j == x) ? c : mine; }
    if (sum == G) break;
    __builtin_amdgcn_s_sleep(1);
    if ((++sp & 255u) == 0u) { if (xb_ld(&bar[XB_TMO])) break; if (sp > XB_SPIN_CAP) { atomicAdd(&bar[XB_TMO], 1u); break; } }
  }
  nloc = mine > 0u ? mine : 1u; nx = cnt > 0u ? cnt : 1u;
}
DI void xcd_barrier(const XcdBarrier& b) {
  asm volatile("s_waitcnt vmcnt(0)" ::: "memory");
  __syncthreads();
  int t0_ = threadIdx.x; asm volatile("" : "+v"(t0_));
  if (t0_ == 0) {
    unsigned* bar = b.bar;
    __builtin_amdgcn_s_waitcnt(0);
    unsigned nloc = b.st[0], nx = b.st[1];
    if (nloc == 0u) { xcd_barrier_complete(bar, b.x, nloc, nx); b.st[0] = nloc; b.st[1] = nx; }
    const unsigned old = xb_add(&bar[XB_XSUB(b.x)], 1u);
    const unsigned gen = old / nloc;
    if (old + 1u == (gen + 1u) * nloc) {
      __builtin_amdgcn_fence(__ATOMIC_RELEASE, "agent");
      asm volatile("s_waitcnt vmcnt(0)" ::: "memory");
      const unsigned og = xb_add(&bar[XB_TOP], 1u);
      const unsigned tg = og / nx;
      if (og + 1u == (tg + 1u) * nx) xb_add(&bar[XB_TOPGEN], 1u);
      else XB_SPIN(xb_ld(&bar[XB_TOPGEN]) == tg, bar);
      __builtin_amdgcn_fence(__ATOMIC_ACQUIRE, "agent");
      xb_add(&bar[XB_XGEN(b.x)], 1u);
      asm volatile("s_waitcnt vmcnt(0)" ::: "memory");
    } else {
      XB_SPIN(xb_ld(&bar[XB_XGEN(b.x)]) == gen, bar);
      __builtin_amdgcn_fence(__ATOMIC_ACQUIRE, "agent");
      asm volatile("s_waitcnt vmcnt(0)" ::: "memory");
    }
  }
  __syncthreads();
}

constexpr int HALF_LDS = 80000;
__global__ void __launch_bounds__(512) mega(Params p) {
  __shared__ __attribute__((aligned(16))) char smem_all[2 * HALF_LDS + 32];
  cg::grid_group grid = cg::this_grid();
  const int half = half_id();
  const int bid = blockIdx.x, nblk = gridDim.x;
  const int vbid = 2 * bid + half, nvblk = 2 * nblk;
  char* smem = smem_all + half * HALF_LDS;
  unsigned* xbw = (unsigned*)(smem_all + 2 * HALF_LDS);
  int* s_pair = (int*)(smem_all + 2 * HALF_LDS + 16);
  if (threadIdx.x == 0) { xbw[0] = 0u; xbw[1] = 0u; }
  __syncthreads();
  const XcdBarrier xb = xcd_barrier_post(p.XBAR(), (volatile LAS unsigned*)xbw);
  ph_prologue(p, vbid, nvblk, smem);
  ln_rows(p, 0, 0, vbid, nvblk);
  if (PROBE == 5) { ph_prologue(p, vbid, nvblk, smem); ln_rows(p, 0, 0, vbid, nvblk); }
  grid.sync();
  for (int l = 0; l < 2; ++l) {
    ph_gemm_in(p, l, bid, nblk, smem_all);
    if (PROBE == 1) ph_gemm_in(p, l, bid, nblk, smem_all);
    xcd_barrier(xb);
    for (int rep = 0; rep < (PROBE == 3 ? 2 : 1); ++rep) {
    for (int item = vbid; item < 2048; item += nvblk) ph_mlstm_local(p, l, item, smem);
    for (int item = vbid; item < 2048; item += nvblk) ph_hgrn_local(p, l, item, smem);
    __syncthreads();
    for (int item = vbid; item < 256; item += nvblk) ph_cmp(p, l, item, smem);
    __syncthreads();
    for (int item = bid; item < 1024; item += nblk) ph_attnA_fb(p, l, item, smem_all);
    }
    xcd_barrier(xb);
    if (vbid < 128) ph_mlstm_scan(p, vbid);
    else if (vbid < 256) ph_hgrn_scan(p, vbid - 128);
    __syncthreads();
    ph_attnD(p, l, p.CTR() + l, smem_all, s_pair);
    if (PROBE == 2) ph_attnD(p, l, p.CTR() + 2 + l, smem_all, s_pair);
    xcd_barrier(xb);
    for (int rep = 0; rep < (PROBE == 4 ? 2 : 1); ++rep) {
    for (int item = vbid; item < 2048; item += nvblk) ph_mlstm_out(p, l, item, smem);
    for (int item = vbid; item < 2048; item += nvblk) ph_hgrn_out(p, l, item, smem);
    }
    xcd_barrier(xb);
    ph_gemm_out_ln(p, l, bid, nblk, smem_all);
    if (l == 0) xcd_barrier(xb);
  }
}

static inline size_t align_up(size_t v) { return (v + 255) & ~(size_t)255; }

extern "C" void kernel_launch(void* const* d_in, const int* in_sizes, int n_in, void* d_out, int out_size, void* d_ws, size_t ws_size, hipStream_t stream) {
  Params p{};
  p.x = (const float*)d_in[0]; p.ln0_g = (const float*)d_in[1]; p.ln0_b = (const float*)d_in[2]; p.w_in = (const float*)d_in[3];
  p.b_in = (const float*)d_in[4]; p.a_sinks = (const float*)d_in[5]; p.conv_w = (const float*)d_in[6]; p.conv_b = (const float*)d_in[7];
  p.c_lb = (const float*)d_in[8]; p.c_norm_g = (const float*)d_in[9]; p.pe = (const float*)d_in[10]; p.w1 = (const float*)d_in[11];
  p.w2 = (const float*)d_in[12]; p.w_out = (const float*)d_in[13]; p.ln_g = (const float*)d_in[14]; p.ln_b = (const float*)d_in[15];
  p.hf = (float*)d_out;
  p.ws = (char*)d_ws;
  if (WS_TOTAL > ws_size) { fprintf(stderr, "workspace too small: need %zu have %zu\n", (size_t)WS_TOTAL, ws_size); return; }

  static int grid_blocks = 0;
  if (!grid_blocks) {
    int dev = 0, cus = 0, per_cu = 0;
    (void)hipGetDevice(&dev);
    (void)hipDeviceGetAttribute(&cus, hipDeviceAttributeMultiprocessorCount, dev);
    (void)hipOccupancyMaxActiveBlocksPerMultiprocessor(&per_cu, mega, 512, 0);
    if (per_cu > 1) per_cu = 1;
    grid_blocks = cus * per_cu;
  }
  (void)hipMemsetAsync((char*)d_ws + OFF_XBAR, 0, XCD_BAR_WORDS * 4, stream);
  (void)hipMemsetAsync((char*)d_ws + OFF_CVEC, 0, SZ_CVEC, stream);
  void* args[] = {&p};
  hipError_t e = hipLaunchCooperativeKernel((void*)mega, dim3(grid_blocks), dim3(512), args, 0, stream);
  if (e != hipSuccess) fprintf(stderr, "cooperative launch failed: %s (grid %d)\n", hipGetErrorString(e), grid_blocks);
}
```

```cpp
#include <hip/hip_runtime.h>
#include <hip/hip_cooperative_groups.h>
#include <stdio.h>
#include <stdint.h>
#include <stddef.h>

#ifndef PROBE
#define PROBE 0
#endif
#define PREP(n) for (int prep_ = 0; prep_ < (PROBE == (n) ? 2 : 1); ++prep_)
#define PREP_LAST(n) (prep_ == (PROBE == (n) ? 1 : 0))
#define DI __device__ __forceinline__
typedef unsigned short bf16_t;
typedef short bf16x8 __attribute__((ext_vector_type(8)));
typedef float f32x16 __attribute__((ext_vector_type(16)));
typedef unsigned u32x4 __attribute__((ext_vector_type(4)));
typedef float f32x4 __attribute__((ext_vector_type(4)));

constexpr int NB = 32, T = 2048, DM = 1024, NTOK = NB * T, NP = 4096;
constexpr float DN_ALPHA = 1.41421356237309515f;

constexpr size_t OFF_HB = 0;
constexpr size_t SZ_HB = (size_t)NTOK * 1024 * 2;
constexpr size_t OFF_YMIX = OFF_HB + ((SZ_HB + 255) & ~(size_t)255);
constexpr size_t SZ_YMIX = (size_t)NTOK * 1024 * 2;
constexpr size_t OFF_QA = OFF_YMIX + ((SZ_YMIX + 255) & ~(size_t)255);
constexpr size_t SZ_QA = (size_t)NTOK * 256 * 2;
constexpr size_t OFF_KA = OFF_QA + ((SZ_QA + 255) & ~(size_t)255);
constexpr size_t SZ_KA = (size_t)NTOK * 128 * 2;
constexpr size_t OFF_VAT = OFF_KA + ((SZ_KA + 255) & ~(size_t)255);
constexpr size_t SZ_VAT = (size_t)NTOK * 128 * 2;
constexpr size_t OFF_QKB = OFF_VAT + ((SZ_VAT + 255) & ~(size_t)255);
constexpr size_t SZ_QKB = (size_t)NTOK * 512 * 2;
constexpr size_t OFF_VBT = OFF_QKB + ((SZ_QKB + 255) & ~(size_t)255);
constexpr size_t SZ_VBT = (size_t)NTOK * 256 * 2;
constexpr size_t OFF_QC = OFF_VBT + ((SZ_VBT + 255) & ~(size_t)255);
constexpr size_t SZ_QC = (size_t)NTOK * 256 * 2;
constexpr size_t OFF_GC = OFF_QC + ((SZ_QC + 255) & ~(size_t)255);
constexpr size_t SZ_GC = (size_t)NTOK * 256 * 4;
constexpr size_t OFF_VCT = OFF_GC + ((SZ_GC + 255) & ~(size_t)255);
constexpr size_t SZ_VCT = (size_t)NTOK * 256 * 2;
constexpr size_t OFF_QD = OFF_VCT + ((SZ_VCT + 255) & ~(size_t)255);
constexpr size_t SZ_QD = (size_t)NTOK * 256 * 2;
constexpr size_t OFF_KV = OFF_QD + ((SZ_QD + 255) & ~(size_t)255);
constexpr size_t SZ_KV = (size_t)NTOK * 384 * 2;
constexpr size_t OFF_GZ = OFF_KV + ((SZ_KV + 255) & ~(size_t)255);
constexpr size_t SZ_GZ = (size_t)NTOK * 1280 * 2;
constexpr size_t OFF_IFG = OFF_GZ + ((SZ_GZ + 255) & ~(size_t)255);
constexpr size_t SZ_IFG = (size_t)NTOK * 8 * 4;
constexpr size_t OFF_DG = OFF_IFG + ((SZ_IFG + 255) & ~(size_t)255);
constexpr size_t SZ_DG = (size_t)NTOK * 12 * 4;
constexpr size_t OFF_WT = OFF_DG + ((SZ_DG + 255) & ~(size_t)255);
constexpr size_t SZ_WT = (size_t)2 * NP * 1024 * 2;
constexpr size_t OFF_WOT = OFF_WT + ((SZ_WT + 255) & ~(size_t)255);
constexpr size_t SZ_WOT = (size_t)2 * 1024 * 1024 * 2;
constexpr size_t OFF_KCMP = OFF_WOT + ((SZ_WOT + 255) & ~(size_t)255);
constexpr size_t SZ_KCMP = (size_t)NB * 128 * 64 * 2;
constexpr size_t OFF_VCMPT = OFF_KCMP + ((SZ_KCMP + 255) & ~(size_t)255);
constexpr size_t SZ_VCMPT = (size_t)NB * 64 * 128 * 2;
constexpr size_t OFF_BIASP = OFF_VCMPT + ((SZ_VCMPT + 255) & ~(size_t)255);
constexpr size_t SZ_BIASP = (size_t)2 * NP * 4;
constexpr size_t OFF_LB = OFF_BIASP + ((SZ_BIASP + 255) & ~(size_t)255);
constexpr size_t SZ_LB = (size_t)512 * 4;
constexpr size_t OFF_ROPEC = OFF_LB + ((SZ_LB + 255) & ~(size_t)255);
constexpr size_t SZ_ROPEC = (size_t)T * 32 * 4;
constexpr size_t OFF_ROPES = OFF_ROPEC + ((SZ_ROPEC + 255) & ~(size_t)255);
constexpr size_t SZ_ROPES = (size_t)T * 32 * 4;
constexpr size_t OFF_BST = OFF_ROPES + ((SZ_ROPES + 255) & ~(size_t)255);
constexpr size_t SZ_BST = (size_t)2048 * 4096 * 4;
constexpr size_t OFF_BN = OFF_BST + ((SZ_BST + 255) & ~(size_t)255);
constexpr size_t SZ_BN = (size_t)2048 * 64 * 4;
constexpr size_t OFF_BG = OFF_BN + ((SZ_BN + 255) & ~(size_t)255);
constexpr size_t SZ_BG = (size_t)2048 * 4;
constexpr size_t OFF_CST = OFF_BG + ((SZ_BG + 255) & ~(size_t)255);
constexpr size_t SZ_CST = (size_t)2048 * 4096 * 4;
constexpr size_t OFF_CAL = OFF_CST + ((SZ_CST + 255) & ~(size_t)255);
constexpr size_t SZ_CAL = (size_t)2048 * 64 * 4;
constexpr size_t OFF_W1T = OFF_CAL + ((SZ_CAL + 255) & ~(size_t)255);
constexpr size_t SZ_W1T = (size_t)4 * 64 * 2048 * 2;
constexpr size_t OFF_W2T = OFF_W1T + ((SZ_W1T + 255) & ~(size_t)255);
constexpr size_t SZ_W2T = (size_t)4 * 64 * 64 * 2;
constexpr size_t OFF_CVEC = OFF_W2T + ((SZ_W2T + 255) & ~(size_t)255);
constexpr size_t SZ_CVEC = (size_t)256 * 4;
constexpr size_t OFF_CTR = OFF_CVEC + ((SZ_CVEC + 255) & ~(size_t)255);
constexpr size_t SZ_CTR = (size_t)256;
constexpr size_t OFF_XBAR = OFF_CTR + ((SZ_CTR + 255) & ~(size_t)255);
constexpr size_t SZ_XBAR = (size_t)3456 * 4;
constexpr size_t OFF_XCNT = OFF_XBAR + ((SZ_XBAR + 255) & ~(size_t)255);
constexpr size_t SZ_XCNT = (size_t)3 * 256 * 64 * 4;
constexpr size_t OFF_XST = OFF_XCNT + ((SZ_XCNT + 255) & ~(size_t)255);
constexpr size_t SZ_XST = (size_t)3 * 256 * 4 * 256 * 2 * 4;
constexpr size_t OFF_LNS = OFF_XST + ((SZ_XST + 255) & ~(size_t)255);
constexpr size_t SZ_LNS = (size_t)NTOK * 2 * 4;
constexpr size_t WS_TOTAL = OFF_LNS + ((SZ_LNS + 255) & ~(size_t)255);
struct Params {
  const float *x, *ln0_g, *ln0_b, *w_in, *b_in, *a_sinks, *conv_w, *conv_b, *c_lb, *c_norm_g, *pe, *w1, *w2, *w_out, *ln_g, *ln_b;
  float* hf;
  char* ws;
  DI bf16_t* HB() const { return (bf16_t*)(ws + OFF_HB); }
  DI bf16_t* YMIX() const { return (bf16_t*)(ws + OFF_YMIX); }
  DI bf16_t* QA() const { return (bf16_t*)(ws + OFF_QA); }
  DI bf16_t* KA() const { return (bf16_t*)(ws + OFF_KA); }
  DI bf16_t* VAT() const { return (bf16_t*)(ws + OFF_VAT); }
  DI bf16_t* QKB() const { return (bf16_t*)(ws + OFF_QKB); }
  DI bf16_t* VBT() const { return (bf16_t*)(ws + OFF_VBT); }
  DI bf16_t* QC() const { return (bf16_t*)(ws + OFF_QC); }
  DI float* GC() const { return (float*)(ws + OFF_GC); }
  DI bf16_t* VCT() const { return (bf16_t*)(ws + OFF_VCT); }
  DI bf16_t* QD() const { return (bf16_t*)(ws + OFF_QD); }
  DI bf16_t* KV() const { return (bf16_t*)(ws + OFF_KV); }
  DI bf16_t* GZ() const { return (bf16_t*)(ws + OFF_GZ); }
  DI float* IFG() const { return (float*)(ws + OFF_IFG); }
  DI float* DG() const { return (float*)(ws + OFF_DG); }
  DI bf16_t* WT() const { return (bf16_t*)(ws + OFF_WT); }
  DI bf16_t* WOT() const { return (bf16_t*)(ws + OFF_WOT); }
  DI bf16_t* KCMP() const { return (bf16_t*)(ws + OFF_KCMP); }
  DI bf16_t* VCMPT() const { return (bf16_t*)(ws + OFF_VCMPT); }
  DI float* BIASP() const { return (float*)(ws + OFF_BIASP); }
  DI float* LB() const { return (float*)(ws + OFF_LB); }
  DI float* ROPEC() const { return (float*)(ws + OFF_ROPEC); }
  DI float* ROPES() const { return (float*)(ws + OFF_ROPES); }
  DI float* BST() const { return (float*)(ws + OFF_BST); }
  DI float* BN() const { return (float*)(ws + OFF_BN); }
  DI float* BG() const { return (float*)(ws + OFF_BG); }
  DI float* CST() const { return (float*)(ws + OFF_CST); }
  DI float* CAL() const { return (float*)(ws + OFF_CAL); }
  DI bf16_t* W1T() const { return (bf16_t*)(ws + OFF_W1T); }
  DI bf16_t* W2T() const { return (bf16_t*)(ws + OFF_W2T); }
  DI float* CVEC() const { return (float*)(ws + OFF_CVEC); }
  DI int* CTR() const { return (int*)(ws + OFF_CTR); }
  DI unsigned* XBAR() const { return (unsigned*)(ws + OFF_XBAR); }
  DI float* LNS() const { return (float*)(ws + OFF_LNS); }
  DI unsigned* XCNT() const { return (unsigned*)(ws + OFF_XCNT); }
  DI float* XST() const { return (float*)(ws + OFF_XST); }
};
namespace cg = cooperative_groups;

DI int tid_opaque() { int t = threadIdx.x; asm volatile("" : "+v"(t)); return t & 255; }
DI int half_id() { return __builtin_amdgcn_readfirstlane((int)(threadIdx.x >> 8)); }
DI float bf2f(bf16_t v) { return __uint_as_float(((unsigned)v) << 16); }
DI unsigned short f2h(float x) { return __builtin_bit_cast(unsigned short, (_Float16)x); }
DI bf16_t f2bf(float x) { unsigned u = __float_as_uint(x); u += 0x7fffu + ((u >> 16) & 1u); return (bf16_t)(u >> 16); }
DI float sigmoidf_(float x) { return __builtin_amdgcn_rcpf(1.f + __builtin_amdgcn_exp2f(-1.4426950408889634f * x)); }
DI float siluf_(float x) { return x * __builtin_amdgcn_rcpf(1.f + __builtin_amdgcn_exp2f(-1.4426950408889634f * x)); }
DI int lane_op() { int l = threadIdx.x; asm volatile("" : "+v"(l)); return l & 63; }
DI float shx(float v, int m) { return __builtin_bit_cast(float, __builtin_amdgcn_ds_bpermute((lane_op() ^ m) << 2, __builtin_bit_cast(int, v))); }
DI unsigned shx(unsigned v, int m) { return (unsigned)__builtin_amdgcn_ds_bpermute((lane_op() ^ m) << 2, (int)v); }
DI float shup(float v, int d) { const int l = lane_op(); const int s = l - d; return __builtin_bit_cast(float, __builtin_amdgcn_ds_bpermute((s < 0 ? l : s) << 2, __builtin_bit_cast(int, v))); }
DI float xhalf_max(float x) { int a = __builtin_bit_cast(int, x), b = a; asm volatile("" : "+v"(b)); auto r = __builtin_amdgcn_permlane32_swap(a, b, false, false); return fmaxf(__builtin_bit_cast(float, (int)r[0]), __builtin_bit_cast(float, (int)r[1])); }
DI float xhalf_sum(float x) { int a = __builtin_bit_cast(int, x), b = a; asm volatile("" : "+v"(b)); auto r = __builtin_amdgcn_permlane32_swap(a, b, false, false); return __builtin_bit_cast(float, (int)r[0]) + __builtin_bit_cast(float, (int)r[1]); }
DI float wave_sum(float v) { for (int o = 32; o > 0; o >>= 1) v += shx(v, o); return v; }
DI float wave_max(float v) { for (int o = 32; o > 0; o >>= 1) v = fmaxf(v, shx(v, o)); return v; }

DI int orig_col(int n) {
  if (n < 1536) return n;
  if (n < 3712) return n + 8;
  if (n < 3968) return n + 20;
  if (n < 3976) return 1536 + (n - 3968);
  if (n < 3988) return 3720 + (n - 3976);
  return -1;
}

DI bool head_is_paired(int hd);
DI void ph_prologue(const Params& p, int bid, int nblk, char* smem) {
  const long gtid = (long)bid * 256 + tid_opaque(), gsz = (long)nblk * 256;
  if (gtid < 64) p.CTR()[gtid] = 0;
  for (long idx = gtid; idx < 2L * 128 * NP; idx += gsz) {
    const int n = (int)(idx % NP), k8 = (int)((idx / NP) % 128), l = (int)(idx / (NP * 128));
    const int pp = n & 63, w_ = pp >> 5, rr = pp & 31, n_ = rr >> 4, fq_ = (rr >> 2) & 3, j_ = rr & 3;
    const int lc = head_is_paired(n >> 6) ? (32 * n_ + 16 * w_ + 4 * fq_ + j_) : (32 * w_ + 8 * fq_ + 4 * n_ + j_);
    const int oc = orig_col((n & ~63) + lc);
    unsigned w[4];
    for (int j = 0; j < 4; ++j) {
      float a = 0.f, b = 0.f;
      if (oc >= 0) { a = p.w_in[((size_t)l * 1024 + k8 * 8 + 2 * j) * 3988 + oc]; b = p.w_in[((size_t)l * 1024 + k8 * 8 + 2 * j + 1) * 3988 + oc]; }
      w[j] = (unsigned)f2h(a) | ((unsigned)f2h(b) << 16);
    }
    *(uint4*)(p.WT() + ((size_t)l * NP + n) * 1024 + k8 * 8) = make_uint4(w[0], w[1], w[2], w[3]);
  }
  for (long idx = gtid; idx < 2L * 128 * 1024; idx += gsz) {
    const int d = (int)(idx % 1024), m8 = (int)((idx / 1024) % 128), l = (int)(idx / (1024 * 128));
    unsigned w[4];
    for (int j = 0; j < 4; ++j) {
      float a = p.w_out[((size_t)l * 1024 + m8 * 8 + 2 * j) * 1024 + d], b = p.w_out[((size_t)l * 1024 + m8 * 8 + 2 * j + 1) * 1024 + d];
      w[j] = (unsigned)f2bf(a) | ((unsigned)f2bf(b) << 16);
    }
    *(uint4*)(p.WOT() + ((size_t)l * 1024 + d) * 1024 + m8 * 8) = make_uint4(w[0], w[1], w[2], w[3]);
  }
  for (long idx = gtid; idx < 4L * 256 * 64; idx += gsz) {
    const int j = (int)(idx % 64), i8 = (int)((idx / 64) % 256), lk = (int)(idx / (64 * 256));
    unsigned w[4];
    for (int e = 0; e < 4; ++e) {
      const float a = p.w1[((size_t)lk * 2048 + i8 * 8 + 2 * e) * 64 + j], b = p.w1[((size_t)lk * 2048 + i8 * 8 + 2 * e + 1) * 64 + j];
      w[e] = (unsigned)f2bf(a) | ((unsigned)f2bf(b) << 16);
    }
    *(uint4*)(p.W1T() + ((size_t)lk * 64 + j) * 2048 + i8 * 8) = make_uint4(w[0], w[1], w[2], w[3]);
  }
  for (long idx = gtid; idx < 4L * 64 * 64; idx += gsz) {
    const int jo = (int)(idx % 64), ji = (int)((idx / 64) % 64), lk = (int)(idx / 4096);
    p.W2T()[((size_t)lk * 64 + jo) * 64 + ji] = f2bf(p.w2[((size_t)lk * 64 + ji) * 64 + jo]);
  }
  if (bid < 64) {
    const int lk = bid >> 4, seg = bid & 15, j = tid_opaque() & 63, part = tid_opaque() >> 6;
    float a = 0.f;
    const int i0 = seg * 128 + part * 32;
#pragma unroll 8
    for (int i = i0; i < i0 + 32; ++i) a += p.pe[(size_t)lk * 2048 + i] * p.w1[((size_t)lk * 2048 + i) * 64 + j];
    float* red = (float*)smem;
    __syncthreads();
    red[part * 64 + j] = a;
    __syncthreads();
    if (part == 0) atomicAdd(p.CVEC() + lk * 64 + j, (red[j] + red[64 + j]) + (red[128 + j] + red[192 + j]));
    __syncthreads();
  }
  for (long idx = gtid; idx < 2L * NP; idx += gsz) {
    const int n = (int)(idx % NP), l = (int)(idx / NP); const int oc = orig_col(n);
    p.BIASP()[idx] = oc >= 0 ? p.b_in[l * 3988 + oc] : 0.f;
  }
  for (long idx = gtid; idx < (long)T * 32; idx += gsz) {
    const int t = (int)(idx / 32), i = (int)(idx % 32);
    const float inv = exp2f(-(float)i * (13.287712379549449f / 32.0f));
    const float ang = (float)t * inv;
    p.ROPEC()[idx] = cosf(ang); p.ROPES()[idx] = sinf(ang);
  }
  for (long idx = gtid; idx < 512; idx += gsz) {
    const int c = (int)(idx % 256), l = (int)(idx / 256);
    const float a = p.c_lb[c], b = p.c_lb[256 + c];
    const float m = fmaxf(a, b); const float ea = expf(a - m), eb = expf(b - m);
    p.LB()[idx] = l == 0 ? 0.f : eb / (ea + eb);
  }
}

DI void ln_rows(const Params& p, int mode, int layer, int bid, int nblk) {
  const int tid_ = tid_opaque(); const int lane = tid_ & 63, wid = tid_ >> 6, nw = 4;
  const float* g = mode == 0 ? p.ln0_g : p.ln_g + layer * 1024;
  const float* bb = mode == 0 ? p.ln0_b : p.ln_b + layer * 1024;
  const float* src = mode == 0 ? p.x : p.hf;
  const int stride = nblk * nw;
  f32x4 gg[4], b4[4];
#pragma unroll
  for (int i = 0; i < 4; ++i) { gg[i] = *(const f32x4*)(g + i * 256 + lane * 4); b4[i] = *(const f32x4*)(bb + i * 256 + lane * 4); }
  int row = bid * nw + wid;
  f32x4 nx[2][4];
#pragma unroll
  for (int u = 0; u < 2; ++u)
    if (row + u * stride < NTOK) {
#pragma unroll
      for (int i = 0; i < 4; ++i) nx[u][i] = *(const f32x4*)(src + (size_t)(row + u * stride) * 1024 + i * 256 + lane * 4);
    }
  for (; row < NTOK; row += 2 * stride) {
    f32x4 v[2][4];
#pragma unroll
    for (int u = 0; u < 2; ++u)
#pragma unroll
      for (int i = 0; i < 4; ++i) v[u][i] = nx[u][i];
#pragma unroll
    for (int u = 0; u < 2; ++u)
      if (row + (2 + u) * stride < NTOK) {
#pragma unroll
        for (int i = 0; i < 4; ++i) nx[u][i] = *(const f32x4*)(src + (size_t)(row + (2 + u) * stride) * 1024 + i * 256 + lane * 4);
      }
#pragma unroll
    for (int u = 0; u < 2; ++u) {
      const int r = row + u * stride;
      if (r < NTOK) {
        float sum = 0.f;
#pragma unroll
        for (int i = 0; i < 4; ++i) sum += (v[u][i][0] + v[u][i][1]) + (v[u][i][2] + v[u][i][3]);
        sum = wave_sum(sum);
        const float mu = sum * (1.f / 1024.f);
        float q = 0.f;
#pragma unroll
        for (int i = 0; i < 4; ++i) { const f32x4 d = v[u][i] - mu; q += (d[0] * d[0] + d[1] * d[1]) + (d[2] * d[2] + d[3] * d[3]); }
        q = wave_sum(q);
        const float rs = rsqrtf(q * (1.f / 1024.f) + 1e-5f);
#pragma unroll
        for (int i = 0; i < 4; ++i) {
          const int c0 = i * 256 + lane * 4;
          const f32x4 o = (v[u][i] - mu) * rs * gg[i] + b4[i];
          uint2 pk; pk.x = (unsigned)f2h(o[0]) | ((unsigned)f2h(o[1]) << 16); pk.y = (unsigned)f2h(o[2]) | ((unsigned)f2h(o[3]) << 16);
          *(uint2*)(p.HB() + (size_t)r * 1024 + c0) = pk;
        }
      }
    }
  }
}

typedef float f32x2 __attribute__((ext_vector_type(2)));
typedef __bf16 bf16v2 __attribute__((ext_vector_type(2)));
typedef unsigned u32x2 __attribute__((ext_vector_type(2)));
typedef _Float16 f16v2 __attribute__((ext_vector_type(2)));
DI unsigned pack2h(float a, float b) { f32x2 v = {a, b}; return __builtin_bit_cast(unsigned, __builtin_convertvector(v, f16v2)); }
DI unsigned pack2(float a, float b) { f32x2 v = {a, b}; return __builtin_bit_cast(unsigned, __builtin_convertvector(v, bf16v2)); }
DI f32x16 zero16() { f32x16 z;
#pragma unroll
  for (int i = 0; i < 16; ++i) z[i] = 0.f; return z; }
DI bf16x8 ld_frag8x2(const bf16_t* p) { const u32x2 lo = *(const u32x2*)p, hi = *(const u32x2*)(p + 8); u32x4 t = {lo.x, lo.y, hi.x, hi.y}; return __builtin_bit_cast(bf16x8, t); }
template <int BASE> DI bf16x8 pack8(const f32x16& s) {
  u32x4 t = {pack2(s[BASE + 0], s[BASE + 1]), pack2(s[BASE + 2], s[BASE + 3]), pack2(s[BASE + 4], s[BASE + 5]), pack2(s[BASE + 6], s[BASE + 7])};
  return __builtin_bit_cast(bf16x8, t);
}
DI int crow(int r, int h2) { return (r & 3) + 8 * (r >> 2) + 4 * h2; }
DI float max3f(float a, float b, float c) { float r; asm("v_max3_f32 %0, %1, %2, %3" : "=v"(r) : "v"(a), "v"(b), "v"(c)); return r; }
DI float max16(const f32x16& s) {
  float m = max3f(s[0], s[1], s[2]);
#pragma unroll
  for (int r = 3; r < 15; r += 2) m = max3f(m, s[r], s[r + 1]);
  return max3f(m, s[15], s[15]);
}
#define MFMA32(a, b, c) __builtin_amdgcn_mfma_f32_32x32x16_bf16((a), (b), (c), 0, 0, 0)
typedef _Float16 f16x8 __attribute__((ext_vector_type(8)));
typedef _Float16 f16x4 __attribute__((ext_vector_type(4)));
#define LAS __attribute__((address_space(3)))
enum { K_NONE = 0, K_ROPE, K_PLAIN, K_TR, K_GSILU, K_GSIG, K_SILUH, K_LOGF, K_SMALL };
namespace g8 {
constexpr int BK = 64, HALF = 128, HT = HALF * BK;
DI int lds_byte(int r, int c) { const int st = (r >> 4) * 2 + (c >> 5), rr = r & 15, cc = c & 31, ob = rr * 64 + cc * 2; return st * 1024 + (ob ^ (((ob >> 9) & 1) << 5)); }
DI void stage_rc(int b, int& R, int& C) { const int st = b / 1024, sb = b % 1024, swz = sb ^ (((sb >> 9) & 1) << 5); R = (st >> 1) * 16 + swz / 64; C = (st & 1) * 32 + (swz % 64) / 2; }
}
template <bool F16>
DI void gemm256_mainloop(const bf16_t* A, const bf16_t* Bt, bf16_t* shm, f32x4 (&acc)[2][2][4][2]) {
  using namespace g8;
  constexpr int K = 1024;
#define SA(b, h) (shm + ((b) * 2 + (h)) * HT)
#define SB(b, h) (shm + (4 + (b) * 2 + (h)) * HT)
#define STAGE(P, BASE, br, kt) do { const long g_ = (long)(br) * K + (long)(kt) * BK; \
    _Pragma("unroll") for (int i_ = 0; i_ < 2; ++i_) { const int b_ = tidf * 16 + i_ * 8192; int r_, c_; stage_rc(b_, r_, c_); \
      __builtin_amdgcn_global_load_lds((const unsigned*)((BASE) + g_ + (long)r_ * K + c_), (LAS unsigned*)((char*)(P) + b_), 16, 0, 0); } } while (0)
#define LDA(dst, b, h) _Pragma("unroll") for (int m = 0; m < 4; ++m) _Pragma("unroll") for (int k = 0; k < 2; ++k) \
    dst[m][k] = *reinterpret_cast<const bf16x8*>((const char*)SA(b, h) + lds_byte(wr * 64 + m * 16 + fr, k * 32 + fq * 8))
#define LDB(dst, b, h) _Pragma("unroll") for (int n = 0; n < 2; ++n) _Pragma("unroll") for (int k = 0; k < 2; ++k) \
    dst[n][k] = *reinterpret_cast<const bf16x8*>((const char*)SB(b, h) + lds_byte(wc * 32 + n * 16 + fr, k * 32 + fq * 8))
#define MMA(ai, bj, At_, Bt_) do { __builtin_amdgcn_s_setprio(1); \
    _Pragma("unroll") for (int m = 0; m < 4; ++m) _Pragma("unroll") for (int n = 0; n < 2; ++n) _Pragma("unroll") for (int k = 0; k < 2; ++k) \
      acc[ai][bj][m][n] = F16 ? __builtin_amdgcn_mfma_f32_16x16x32_f16(__builtin_bit_cast(f16x8, Bt_[n][k]), __builtin_bit_cast(f16x8, At_[m][k]), acc[ai][bj][m][n], 0, 0, 0) \
                              : __builtin_amdgcn_mfma_f32_16x16x32_bf16(Bt_[n][k], At_[m][k], acc[ai][bj][m][n], 0, 0, 0); \
    __builtin_amdgcn_s_setprio(0); } while (0)
#define WAIT_V(n) asm volatile("s_waitcnt vmcnt(" #n ")" ::: "memory")
#define WAIT_L(n) asm volatile("s_waitcnt lgkmcnt(" #n ")" ::: "memory")
#define BAR __builtin_amdgcn_s_barrier()
#define SCHED __builtin_amdgcn_sched_barrier(0)
  int tidf = threadIdx.x; asm volatile("" : "+v"(tidf));
  const int wid = tidf >> 6, lane = tidf & 63, wr = wid >> 2, wc = wid & 3, fr = lane & 15, fq = lane >> 4;
#pragma unroll
  for (int a = 0; a < 2; ++a)
#pragma unroll
    for (int b = 0; b < 2; ++b)
#pragma unroll
      for (int m = 0; m < 4; ++m)
#pragma unroll
        for (int n = 0; n < 2; ++n) acc[a][b][m][n] = (f32x4){0.f, 0.f, 0.f, 0.f};
  bf16x8 At[4][2], B0[2][2], B1[2][2];
  constexpr int nt = K / BK;
  WAIT_V(0);
  STAGE(SB(0, 0), Bt, 0, 0); STAGE(SA(0, 0), A, 0, 0);
  STAGE(SB(0, 1), Bt, HALF, 0); STAGE(SA(0, 1), A, HALF, 0);
  if (wr == 1) BAR;
  WAIT_V(4); BAR;
  STAGE(SB(1, 0), Bt, 0, 1); STAGE(SA(1, 0), A, 0, 1); STAGE(SB(1, 1), Bt, HALF, 1);
  WAIT_V(6); BAR;
  for (int t = 0; t < nt - 2; t += 2) {
    LDB(B0, 0, 0); SCHED; LDA(At, 0, 0); STAGE(SA(1, 1), A, HALF, t + 1);
    WAIT_L(8); BAR; WAIT_L(0); MMA(0, 0, At, B0); BAR; SCHED;
    LDB(B1, 0, 1); STAGE(SB(0, 0), Bt, 0, t + 2);
    BAR; WAIT_L(0); MMA(0, 1, At, B1); BAR;
    LDA(At, 0, 1); STAGE(SA(0, 0), A, 0, t + 2);
    BAR; WAIT_L(0); MMA(1, 0, At, B0); BAR; SCHED;
    STAGE(SB(0, 1), Bt, HALF, t + 2);
    WAIT_V(6); BAR; MMA(1, 1, At, B1); BAR;
    LDB(B0, 1, 0); SCHED; LDA(At, 1, 0); STAGE(SA(0, 1), A, HALF, t + 2);
    WAIT_L(8); BAR; WAIT_L(0); MMA(0, 0, At, B0); BAR; SCHED;
    LDB(B1, 1, 1); STAGE(SB(1, 0), Bt, 0, t + 3);
    BAR; WAIT_L(0); MMA(0, 1, At, B1); BAR;
    LDA(At, 1, 1); STAGE(SA(1, 0), A, 0, t + 3);
    BAR; WAIT_L(0); MMA(1, 0, At, B0); BAR; SCHED;
    STAGE(SB(1, 1), Bt, HALF, t + 3);
    WAIT_V(6); BAR; MMA(1, 1, At, B1); BAR;
  }
  { LDB(B0, 0, 0); LDA(At, 0, 0); STAGE(SA(1, 1), A, HALF, nt - 1);
    BAR; WAIT_L(0); MMA(0, 0, At, B0); BAR;
    LDB(B1, 0, 1); BAR; WAIT_L(0); MMA(0, 1, At, B1); BAR;
    LDA(At, 0, 1); WAIT_V(4); BAR; WAIT_L(0); MMA(1, 0, At, B0); MMA(1, 1, At, B1); BAR; }
  { LDB(B0, 1, 0); LDA(At, 1, 0); WAIT_V(2); BAR; WAIT_L(0); MMA(0, 0, At, B0); BAR;
    LDB(B1, 1, 1); WAIT_V(0); BAR; WAIT_L(0); MMA(0, 1, At, B1); BAR;
    LDA(At, 1, 1); BAR; WAIT_L(0); MMA(1, 0, At, B0); MMA(1, 1, At, B1); BAR; }
  if (wr == 0) BAR;
#undef SA
#undef SB
#undef STAGE
#undef LDA
#undef LDB
#undef MMA
#undef WAIT_V
#undef WAIT_L
#undef BAR
#undef SCHED
}

DI void classify_head(const Params& p, int hd, int b, int& kind, bf16_t*& dst, float*& fdst, float& scale) {
  kind = K_NONE; dst = nullptr; fdst = nullptr; scale = 1.f;
  if (hd < 4) { kind = K_ROPE; dst = p.QA() + ((size_t)(b * 4 + hd) * T) * 64; scale = 0.125f * 1.4426950408889634f; }
  else if (hd < 6) { kind = K_ROPE; dst = p.KA() + ((size_t)(b * 2 + hd - 4) * T) * 64; }
  else if (hd < 8) { kind = K_TR; dst = p.VAT() + (size_t)(b * 2 + hd - 6) * 64 * T; }
  else if (hd < 12) { kind = K_GSILU; dst = p.GZ() + (size_t)0 * NTOK * 256 + (hd - 8) * 64; }
  else if (hd < 20) { kind = K_PLAIN; dst = p.QKB() + ((size_t)(b * 8 + hd - 12) * T) * 64; }
  else if (hd < 24) { kind = K_TR; dst = p.VBT() + (size_t)(b * 4 + hd - 20) * 64 * T; }
  else if (hd < 28) { kind = K_GSIG; dst = p.GZ() + (size_t)1 * NTOK * 256 + (hd - 24) * 64; }
  else if (hd < 32) { kind = K_GSILU; dst = p.GZ() + (size_t)2 * NTOK * 256 + (hd - 28) * 64; }
  else if (hd < 36) { kind = K_SILUH; dst = p.QC() + ((size_t)(b * 4 + hd - 32) * T) * 64; }
  else if (hd < 40) { kind = K_LOGF; fdst = p.GC() + ((size_t)(b * 4 + hd - 36) * T) * 64; }
  else if (hd < 44) { kind = K_TR; dst = p.VCT() + (size_t)(b * 4 + hd - 40) * 64 * T; }
  else if (hd < 48) { kind = K_GSILU; dst = p.GZ() + (size_t)3 * NTOK * 256 + (hd - 44) * 64; }
  else if (hd < 52) { kind = K_ROPE; dst = p.QD() + ((size_t)(b * 4 + hd - 48) * T) * 64; scale = 0.125f * 1.4426950408889634f; }
  else if (hd < 58) {
    const int j = hd - 52;
    dst = p.KV() + (size_t)(j * NB + b) * T * 64;
    kind = (j == 0 || j == 1) ? K_PLAIN : ((j == 2 || j == 4) ? K_ROPE : K_TR);
  }
  else if (hd < 62) { kind = K_GSILU; dst = p.GZ() + (size_t)4 * NTOK * 256 + (hd - 58) * 64; }
  else if (hd == 62) { kind = K_SMALL; }
}

DI bool head_is_paired(int hd) { return hd < 6 || (hd >= 48 && hd < 52) || hd == 54 || hd == 56; }
template <int KIND>
DI void epi_direct(const Params& p, const f32x4 (&a)[4][2], bf16_t* dst, float* fdst, float scale, int layer, int hd, int b, int tq, int wr, int w, int fr, int fq) {
  if (KIND == K_ROPE) {
    const int c = 16 * w + 4 * fq;
    const f32x4 b0 = *(const f32x4*)(p.BIASP() + layer * NP + hd * 64 + c), b1 = *(const f32x4*)(p.BIASP() + layer * NP + hd * 64 + 32 + c);
#pragma unroll
    for (int m = 0; m < 4; ++m) {
      const int t = tq + wr * 64 + m * 16 + fr;
      const f32x4 cs = *(const f32x4*)(p.ROPEC() + t * 32 + c), sn = *(const f32x4*)(p.ROPES() + t * 32 + c);
      const f32x4 v0 = a[m][0] + b0, v1 = a[m][1] + b1;
      const f32x4 o0 = (v0 * cs - v1 * sn) * scale, o1 = (v0 * sn + v1 * cs) * scale;
      u32x2 w0 = {pack2(o0[0], o0[1]), pack2(o0[2], o0[3])}, w1 = {pack2(o1[0], o1[1]), pack2(o1[2], o1[3])};
      *(u32x2*)(dst + (size_t)t * 64 + c) = w0; *(u32x2*)(dst + (size_t)t * 64 + 32 + c) = w1;
    }
    return;
  }
  const int c = 32 * w + 8 * fq;
  const f32x4 b0 = *(const f32x4*)(p.BIASP() + layer * NP + hd * 64 + c), b1 = *(const f32x4*)(p.BIASP() + layer * NP + hd * 64 + c + 4);
  if (KIND == K_SMALL) {
#pragma unroll
    for (int m = 0; m < 4; ++m) {
      const size_t tok = (size_t)b * T + tq + wr * 64 + m * 16 + fr;
#pragma unroll
      for (int n = 0; n < 2; ++n)
#pragma unroll
        for (int j = 0; j < 4; ++j) {
          const int cc = c + 4 * n + j;
          const float v = a[m][n][j] + (n ? b1[j] : b0[j]);
          if (cc < 8) p.IFG()[tok * 8 + cc] = v;
          else if (cc < 20) p.DG()[tok * 12 + (cc - 8)] = sigmoidf_(v);
        }
    }
    return;
  }
  f32x4 lb0 = {0.f, 0.f, 0.f, 0.f}, lb1 = {0.f, 0.f, 0.f, 0.f};
  if (KIND == K_LOGF) { lb0 = *(const f32x4*)(p.LB() + layer * 256 + (hd - 36) * 64 + c); lb1 = *(const f32x4*)(p.LB() + layer * 256 + (hd - 36) * 64 + c + 4); }
#pragma unroll
  for (int m = 0; m < 4; ++m) {
    const int t = tq + wr * 64 + m * 16 + fr;
    const f32x4 v0 = a[m][0] + b0, v1 = a[m][1] + b1;
    if (KIND == K_LOGF) {
      f32x4 o0, o1;
#pragma unroll
      for (int j = 0; j < 4; ++j) { o0[j] = __logf(lb0[j] + (1.f - lb0[j]) * sigmoidf_(v0[j])); o1[j] = __logf(lb1[j] + (1.f - lb1[j]) * sigmoidf_(v1[j])); }
      *(f32x4*)(fdst + (size_t)t * 64 + c) = o0; *(f32x4*)(fdst + (size_t)t * 64 + c + 4) = o1;
    } else {
      f32x4 o0, o1;
#pragma unroll
      for (int j = 0; j < 4; ++j) {
        if (KIND == K_PLAIN) { o0[j] = v0[j]; o1[j] = v1[j]; }
        else if (KIND == K_SILUH || KIND == K_GSILU) { o0[j] = siluf_(v0[j]); o1[j] = siluf_(v1[j]); }
        else { o0[j] = sigmoidf_(v0[j]); o1[j] = sigmoidf_(v1[j]); }
      }
      u32x4 wv = {pack2(o0[0], o0[1]), pack2(o0[2], o0[3]), pack2(o1[0], o1[1]), pack2(o1[2], o1[3])};
      if (KIND == K_GSILU || KIND == K_GSIG) *(u32x4*)(dst + ((size_t)b * T + t) * 256 + c) = wv;
      else *(u32x4*)(dst + (size_t)t * 64 + c) = wv;
    }
  }
}
DI void epi_tr_write(const Params& p, const f32x4 (&a)[4][2], char* img, int layer, int hd, int wr, int w, int fr, int fq) {
  const int c = 32 * w + 8 * fq;
  const f32x4 b0 = *(const f32x4*)(p.BIASP() + layer * NP + hd * 64 + c), b1 = *(const f32x4*)(p.BIASP() + layer * NP + hd * 64 + c + 4);
  bf16_t* timg = (bf16_t*)img;
#pragma unroll
  for (int m = 0; m < 4; ++m)
#pragma unroll
    for (int n = 0; n < 2; ++n)
#pragma unroll
      for (int j = 0; j < 4; ++j) timg[(c + 4 * n + j) * 128 + wr * 64 + m * 16 + fr] = f2bf(a[m][n][j] + (n ? b1[j] : b0[j]));
}
DI void gemm_in_quadrant(const Params& p, int layer, int panel, int pn, int ai, int bj, const f32x4 (&a)[4][2], char* shm,
                         int b, int hq, int tid2, int wr, int wc, int fr, int fq) {
  const int tq = (panel & 7) * 256 + ai * 128;
  const int hd0 = pn * 4 + bj * 2;
  const int hd = hd0 + (wc >> 1), w = wc & 1;
  int kind; bf16_t* dst; float* fdst; float scale;
  classify_head(p, hd, b, kind, dst, fdst, scale);
  switch (kind) {
    case K_ROPE: epi_direct<K_ROPE>(p, a, dst, fdst, scale, layer, hd, b, tq, wr, w, fr, fq); break;
    case K_PLAIN: epi_direct<K_PLAIN>(p, a, dst, fdst, scale, layer, hd, b, tq, wr, w, fr, fq); break;
    case K_GSILU: epi_direct<K_GSILU>(p, a, dst, fdst, scale, layer, hd, b, tq, wr, w, fr, fq); break;
    case K_GSIG: epi_direct<K_GSIG>(p, a, dst, fdst, scale, layer, hd, b, tq, wr, w, fr, fq); break;
    case K_SILUH: epi_direct<K_SILUH>(p, a, dst, fdst, scale, layer, hd, b, tq, wr, w, fr, fq); break;
    case K_LOGF: epi_direct<K_LOGF>(p, a, dst, fdst, scale, layer, hd, b, tq, wr, w, fr, fq); break;
    case K_SMALL: epi_direct<K_SMALL>(p, a, dst, fdst, scale, layer, hd, b, tq, wr, w, fr, fq); break;
    default: break;
  }
  int k0, k1; { bf16_t* d_; float* f_; float s_; classify_head(p, hd0, b, k0, d_, f_, s_); classify_head(p, hd0 + 1, b, k1, d_, f_, s_); }
  if (k0 == K_TR || k1 == K_TR) {
    if (kind == K_TR) epi_tr_write(p, a, shm + (wc >> 1) * 16384, layer, hd, wr, w, fr, fq);
    __syncthreads();
    int kq; bf16_t* dq; float* fq_; float sq; classify_head(p, hd0 + hq, b, kq, dq, fq_, sq);
    if (kq == K_TR) {
      const char* img = shm + hq * 16384;
#pragma unroll
      for (int i = 0; i < 4; ++i) { const int q = tid2 + 256 * i, cc = q >> 4, rc = q & 15; *(u32x4*)(dq + (size_t)cc * T + tq + rc * 8) = *(const u32x4*)(img + q * 16); }
    }
    __syncthreads();
  }
}
template <int KIND, int BJ, int PASS>
DI void epi2_write(const Params& p, const f32x4 (&acc)[2][2][4][2], char* img, float scale, int layer, int hd, int tbase, int wr, int w, int fr, int fq) {
  if (KIND == K_ROPE) {
    const int c = 16 * w + 4 * fq;
    const f32x4 b0 = *(const f32x4*)(p.BIASP() + layer * NP + hd * 64 + c), b1 = *(const f32x4*)(p.BIASP() + layer * NP + hd * 64 + 32 + c);
    const int ch0 = 2 * w + (fq >> 1), sub = (fq & 1) * 8;
#pragma unroll
    for (int ai = 0; ai < 2; ++ai)
#pragma unroll
      for (int m = 0; m < 4; ++m) {
        const int row = ai * 128 + wr * 64 + m * 16 + fr, t = tbase + row;
        const f32x4 cs = *(const f32x4*)(p.ROPEC() + t * 32 + c), sn = *(const f32x4*)(p.ROPES() + t * 32 + c);
        const f32x4 v0 = acc[ai][BJ][m][0] + b0, v1 = acc[ai][BJ][m][1] + b1;
        const f32x4 o0 = (v0 * cs - v1 * sn) * scale, o1 = (v0 * sn + v1 * cs) * scale;
        u32x2 w0 = {pack2(o0[0], o0[1]), pack2(o0[2], o0[3])}, w1 = {pack2(o1[0], o1[1]), pack2(o1[2], o1[3])};
        *(u32x2*)(img + row * 128 + ((ch0 ^ (fr & 7)) * 16) + sub) = w0;
        *(u32x2*)(img + row * 128 + (((ch0 + 4) ^ (fr & 7)) * 16) + sub) = w1;
      }
    return;
  }
  const int c = 32 * w + 8 * fq;
  const f32x4 b0 = *(const f32x4*)(p.BIASP() + layer * NP + hd * 64 + c), b1 = *(const f32x4*)(p.BIASP() + layer * NP + hd * 64 + c + 4);
  if (KIND == K_TR) {
    bf16_t* timg = (bf16_t*)img;
#pragma unroll
    for (int ai = 0; ai < 2; ++ai)
#pragma unroll
      for (int m = 0; m < 4; ++m)
#pragma unroll
        for (int n = 0; n < 2; ++n)
#pragma unroll
          for (int j = 0; j < 4; ++j) timg[(c + 4 * n + j) * 256 + ai * 128 + wr * 64 + m * 16 + fr] = f2bf(acc[ai][BJ][m][n][j] + (n ? b1[j] : b0[j]));
    return;
  }
  if (KIND == K_LOGF) {
    const f32x4 lb0 = *(const f32x4*)(p.LB() + layer * 256 + (hd - 36) * 64 + c), lb1 = *(const f32x4*)(p.LB() + layer * 256 + (hd - 36) * 64 + c + 4);
    float* fimg = (float*)img;
#pragma unroll
    for (int m = 0; m < 4; ++m) {
      const f32x4 v0 = acc[PASS][BJ][m][0] + b0, v1 = acc[PASS][BJ][m][1] + b1;
      f32x4 o0, o1;
#pragma unroll
      for (int j = 0; j < 4; ++j) { o0[j] = __logf(lb0[j] + (1.f - lb0[j]) * sigmoidf_(v0[j])); o1[j] = __logf(lb1[j] + (1.f - lb1[j]) * sigmoidf_(v1[j])); }
      const int row = wr * 64 + m * 16 + fr;
      *(f32x4*)(fimg + row * 64 + c) = o0; *(f32x4*)(fimg + row * 64 + c + 4) = o1;
    }
    return;
  }
  const int ch = 4 * w + fq;
#pragma unroll
  for (int ai = 0; ai < 2; ++ai)
#pragma unroll
    for (int m = 0; m < 4; ++m) {
      const int row = ai * 128 + wr * 64 + m * 16 + fr;
      const f32x4 v0 = acc[ai][BJ][m][0] + b0, v1 = acc[ai][BJ][m][1] + b1;
      f32x4 o0, o1;
#pragma unroll
      for (int j = 0; j < 4; ++j) {
        if (KIND == K_PLAIN) { o0[j] = v0[j]; o1[j] = v1[j]; }
        else if (KIND == K_SILUH || KIND == K_GSILU) { o0[j] = siluf_(v0[j]); o1[j] = siluf_(v1[j]); }
        else { o0[j] = sigmoidf_(v0[j]); o1[j] = sigmoidf_(v1[j]); }
      }
      u32x4 wv = {pack2(o0[0], o0[1]), pack2(o0[2], o0[3]), pack2(o1[0], o1[1]), pack2(o1[2], o1[3])};
      *(u32x4*)(img + row * 128 + ((ch ^ (fr & 7)) * 16)) = wv;
    }
}
template <int BJ, int PASS>
DI void epi2_write_head(const Params& p, int layer, int pn, const f32x4 (&acc)[2][2][4][2], char* shm, int b, int tbase, int wr, int wc, int fr, int fq) {
  const int w = wc & 1, hq = BJ * 2 + (wc >> 1), hd = pn * 4 + hq;
  int kind; bf16_t* dst; float* fdst; float scale;
  classify_head(p, hd, b, kind, dst, fdst, scale);
  char* img = shm + hq * 32768;
  switch (kind) {
    case K_ROPE: epi2_write<K_ROPE, BJ, PASS>(p, acc, img, scale, layer, hd, tbase, wr, w, fr, fq); break;
    case K_PLAIN: epi2_write<K_PLAIN, BJ, PASS>(p, acc, img, scale, layer, hd, tbase, wr, w, fr, fq); break;
    case K_TR: epi2_write<K_TR, BJ, PASS>(p, acc, img, scale, layer, hd, tbase, wr, w, fr, fq); break;
    case K_GSILU: epi2_write<K_GSILU, BJ, PASS>(p, acc, img, scale, layer, hd, tbase, wr, w, fr, fq); break;
    case K_GSIG: epi2_write<K_GSIG, BJ, PASS>(p, acc, img, scale, layer, hd, tbase, wr, w, fr, fq); break;
    case K_SILUH: epi2_write<K_SILUH, BJ, PASS>(p, acc, img, scale, layer, hd, tbase, wr, w, fr, fq); break;
    case K_LOGF: epi2_write<K_LOGF, BJ, PASS>(p, acc, img, scale, layer, hd, tbase, wr, w, fr, fq); break;
    case K_SMALL: {
      const int c = 32 * w + 8 * fq;
      const f32x4 b0 = *(const f32x4*)(p.BIASP() + layer * NP + hd * 64 + c), b1 = *(const f32x4*)(p.BIASP() + layer * NP + hd * 64 + c + 4);
#pragma unroll
      for (int ai = 0; ai < 2; ++ai)
#pragma unroll
        for (int m = 0; m < 4; ++m) {
          const size_t tok = (size_t)b * T + tbase + ai * 128 + wr * 64 + m * 16 + fr;
#pragma unroll
          for (int n = 0; n < 2; ++n)
#pragma unroll
            for (int j = 0; j < 4; ++j) {
              const int cc = c + 4 * n + j;
              const float v = acc[ai][BJ][m][n][j] + (n ? b1[j] : b0[j]);
              if (cc < 8) p.IFG()[tok * 8 + cc] = v;
              else if (cc < 20) p.DG()[tok * 12 + (cc - 8)] = sigmoidf_(v);
            }
        }
    } break;
    default: break;
  }
}
template <int PASS>
DI void epi2_pass(const Params& p, int layer, int panel, int pn, const f32x4 (&acc)[2][2][4][2], char* shm, int tidf) {
  const int wid = tidf >> 6, lane = tidf & 63, wr = wid >> 2, wc = wid & 3, fr = lane & 15, fq = lane >> 4;
  const int b = panel >> 3, tbase = (panel & 7) * 256;
  epi2_write_head<0, PASS>(p, layer, pn, acc, shm, b, tbase, wr, wc, fr, fq);
  epi2_write_head<1, PASS>(p, layer, pn, acc, shm, b, tbase, wr, wc, fr, fq);
  __syncthreads();
  {
    const int hq = wid >> 1, hd = pn * 4 + hq, half = wid & 1;
    int kind; bf16_t* dst; float* fdst; float scale;
    classify_head(p, hd, b, kind, dst, fdst, scale);
    const char* img = shm + hq * 32768;
    if (kind == K_LOGF) {
#pragma unroll 4
      for (int i = 0; i < 16; ++i) {
        const int pi = half * 16 + i;
        const u32x4 v = *(const u32x4*)(img + pi * 1024 + lane * 16);
        const int row = 4 * pi + (lane >> 4), ch = lane & 15;
        *(u32x4*)(fdst + (size_t)(tbase + PASS * 128 + row) * 64 + ch * 4) = v;
      }
    } else if (kind == K_TR) {
#pragma unroll 4
      for (int i = 0; i < 16; ++i) {
        const int pi = half * 16 + i;
        const u32x4 v = *(const u32x4*)(img + pi * 1024 + lane * 16);
        const int d = 2 * pi + (lane >> 5), tc = lane & 31;
        *(u32x4*)(dst + (size_t)d * T + tbase + tc * 8) = v;
      }
    } else if (kind == K_ROPE || kind == K_PLAIN || kind == K_SILUH || kind == K_GSILU || kind == K_GSIG) {
      const bool gate = (kind == K_GSILU || kind == K_GSIG);
#pragma unroll 4
      for (int i = 0; i < 16; ++i) {
        const int pi = half * 16 + i;
        const int rl = lane >> 3, chl = lane & 7, row = 8 * pi + rl;
        const u32x4 v = *(const u32x4*)(img + row * 128 + ((chl ^ rl) * 16));
        if (gate) *(u32x4*)(dst + ((size_t)b * T + tbase + row) * 256 + chl * 8) = v;
        else *(u32x4*)(dst + (size_t)(tbase + row) * 64 + chl * 8) = v;
      }
    }
  }
  __syncthreads();
}
DI void gemm_in_epilogue(const Params& p, int layer, int panel, int pn, const f32x4 (&acc)[2][2][4][2], char* shm) {
  int tidf = threadIdx.x; asm volatile("" : "+v"(tidf));
  __syncthreads();
  epi2_pass<0>(p, layer, panel, pn, acc, shm, tidf);
  if (pn == 9) epi2_pass<1>(p, layer, panel, pn, acc, shm, tidf);
}
DI void ph_gemm_in(const Params& p, int layer, int bid, int nblk, char* shm) {
  asm volatile("" : "+s"(bid));
  if (nblk == 256) {
    const int x = bid & 7, c = bid >> 3;
    for (int g = 0; g < 4; ++g) {
      const int panel = 32 * x + 8 * g + (c & 7);
      const bf16_t* A = p.HB() + (size_t)panel * 256 * 1024;
      for (int s = 0; s < 4; ++s) {
        const int pn = (c >> 3) + 4 * s;
        f32x4 acc[2][2][4][2];
        gemm256_mainloop<true>(A, p.WT() + ((size_t)layer * NP + pn * 256) * 1024, (bf16_t*)shm, acc);
        if (PROBE == 6) { __syncthreads(); gemm256_mainloop<true>(A, p.WT() + ((size_t)layer * NP + pn * 256) * 1024, (bf16_t*)shm, acc); }
        gemm_in_epilogue(p, layer, panel, pn, acc, shm);
        if (PROBE == 7) gemm_in_epilogue(p, layer, panel, pn, acc, shm);
      }
    }
    return;
  }
  for (int panel = bid; panel < 256; panel += nblk) {
    const bf16_t* A = p.HB() + (size_t)panel * 256 * 1024;
    for (int pn = 0; pn < 16; ++pn) {
      f32x4 acc[2][2][4][2];
      gemm256_mainloop<true>(A, p.WT() + ((size_t)layer * NP + pn * 256) * 1024, (bf16_t*)shm, acc);
      gemm_in_epilogue(p, layer, panel, pn, acc, shm);
    }
  }
}
DI void gemm_out_epilogue_ln(const Params& p, int layer, int cset, int panel, int pn, f32x4 (&acc)[2][2][4][2], char* shm) {
  int tidf = threadIdx.x; asm volatile("" : "+v"(tidf));
  const int wid = tidf >> 6, lane = tidf & 63, wr = wid >> 2, wc = wid & 3, fr = lane & 15, fq = lane >> 4;
  float* rpart = (float*)shm;
  float* rmu = rpart + 2048;
  {
    u32x2 hres[2][4][2][2];
#pragma unroll
    for (int ai = 0; ai < 2; ++ai)
#pragma unroll
      for (int m = 0; m < 4; ++m) {
        const size_t row = (size_t)panel * 256 + ai * 128 + wr * 64 + m * 16 + fr;
#pragma unroll
        for (int bj = 0; bj < 2; ++bj)
#pragma unroll
          for (int n = 0; n < 2; ++n)
            hres[ai][m][bj][n] = *(const u32x2*)(p.HB() + row * 1024 + pn * 256 + bj * 128 + wc * 32 + n * 16 + fq * 4);
      }
#pragma unroll
    for (int ai = 0; ai < 2; ++ai)
#pragma unroll
      for (int m = 0; m < 4; ++m) {
        const int rl = ai * 128 + wr * 64 + m * 16 + fr;
        float s1 = 0.f, s2 = 0.f;
#pragma unroll
        for (int bj = 0; bj < 2; ++bj)
#pragma unroll
          for (int n = 0; n < 2; ++n) {
            const f32x4 h = __builtin_convertvector(__builtin_bit_cast(f16x4, hres[ai][m][bj][n]), f32x4);
            const f32x4 z = DN_ALPHA * h + acc[ai][bj][m][n];
            acc[ai][bj][m][n] = z;
            s1 += (z[0] + z[1]) + (z[2] + z[3]);
            s2 += (z[0] * z[0] + z[1] * z[1]) + (z[2] * z[2] + z[3] * z[3]);
          }
        s1 += shx(s1, 16); s2 += shx(s2, 16);
        s1 = xhalf_sum(s1); s2 = xhalf_sum(s2);
        if (fq == 0) { rpart[(rl * 4 + wc) * 2] = s1; rpart[(rl * 4 + wc) * 2 + 1] = s2; }
      }
  }
  f32x4 gg[2][2], bb[2][2];
#pragma unroll
  for (int bj = 0; bj < 2; ++bj)
#pragma unroll
    for (int n = 0; n < 2; ++n) {
      const int col = pn * 256 + bj * 128 + wc * 32 + n * 16 + fq * 4;
      gg[bj][n] = *(const f32x4*)(p.ln_g + layer * 1024 + col); bb[bj][n] = *(const f32x4*)(p.ln_b + layer * 1024 + col);
    }
  __syncthreads();
  float* xst = p.XST() + ((size_t)(cset * 256 + panel) * 4) * 512;
  if (tidf < 256) {
    const f32x4 a0 = *(const f32x4*)(rpart + tidf * 8), a1 = *(const f32x4*)(rpart + tidf * 8 + 4);
    f32x2 v = {(a0[0] + a0[2]) + (a1[0] + a1[2]), (a0[1] + a0[3]) + (a1[1] + a1[3])};
    __hip_atomic_store((unsigned long long*)(xst + (size_t)pn * 512 + tidf * 2), __builtin_bit_cast(unsigned long long, v), __ATOMIC_RELAXED, __HIP_MEMORY_SCOPE_AGENT);
  }
  asm volatile("s_waitcnt vmcnt(0)" ::: "memory");
  __syncthreads();
  if (tidf == 0) {
    unsigned* cnt = p.XCNT() + (size_t)(cset * 256 + panel) * 64;
    (void)__hip_atomic_fetch_add(cnt, 1u, __ATOMIC_RELAXED, __HIP_MEMORY_SCOPE_AGENT);
    unsigned sp = 0;
    while (__hip_atomic_load(cnt, __ATOMIC_RELAXED, __HIP_MEMORY_SCOPE_AGENT) < 4u) { __builtin_amdgcn_s_sleep(1); if (++sp > (1u << 24)) break; }
    asm volatile("s_waitcnt vmcnt(0)" ::: "memory");
  }
  __syncthreads();
  if (tidf < 256) {
    float S1 = 0.f, S2 = 0.f;
#pragma unroll
    for (int q = 0; q < 4; ++q) {
      const f32x2 v = __builtin_bit_cast(f32x2, __hip_atomic_load((unsigned long long*)(xst + (size_t)q * 512 + tidf * 2), __ATOMIC_RELAXED, __HIP_MEMORY_SCOPE_AGENT));
      S1 += v[0]; S2 += v[1];
    }
    const float mu = S1 * (1.f / 1024.f);
    const float var = fmaxf(S2 * (1.f / 1024.f) - mu * mu, 0.f);
    rmu[tidf * 2] = mu; rmu[tidf * 2 + 1] = rsqrtf(var + 1e-5f);
  }
  __syncthreads();
#pragma unroll
  for (int ai = 0; ai < 2; ++ai)
#pragma unroll
    for (int m = 0; m < 4; ++m) {
      const int rl = ai * 128 + wr * 64 + m * 16 + fr;
      const size_t row = (size_t)panel * 256 + rl;
      const f32x2 ms = *(const f32x2*)(rmu + rl * 2);
#pragma unroll
      for (int bj = 0; bj < 2; ++bj)
#pragma unroll
        for (int n = 0; n < 2; ++n) {
          const int col = pn * 256 + bj * 128 + wc * 32 + n * 16 + fq * 4;
          const f32x4 o = (acc[ai][bj][m][n] - ms[0]) * ms[1] * gg[bj][n] + bb[bj][n];
          if (layer == 0) { u32x2 pk = {pack2h(o[0], o[1]), pack2h(o[2], o[3])}; *(u32x2*)(p.HB() + row * 1024 + col) = pk; }
          else *(f32x4*)(p.hf + row * 1024 + col) = o;
        }
    }
  __syncthreads();
}
DI void ph_gemm_out_ln_x4(const Params& p, int layer, int cset, int bid, char* shm) {
  asm volatile("" : "+s"(bid));
  const int x = bid & 7, c = bid >> 3, pn = c & 3;
  for (int r = 0; r < 4; ++r) {
    const int panel = 64 * r + 8 * x + (c >> 2);
    f32x4 acc[2][2][4][2];
    gemm256_mainloop<false>(p.YMIX() + (size_t)panel * 256 * 1024, p.WOT() + ((size_t)layer * 1024 + pn * 256) * 1024, (bf16_t*)shm, acc);
    if (PROBE == 14) { __syncthreads(); gemm256_mainloop<false>(p.YMIX() + (size_t)panel * 256 * 1024, p.WOT() + ((size_t)layer * 1024 + pn * 256) * 1024, (bf16_t*)shm, acc); }
    gemm_out_epilogue_ln(p, layer, cset, panel, pn, acc, shm);
  }
}
DI f32x16 qk_tile(const bf16_t* Krow, const bf16x8 (&qf)[4], int l31, int h2) {
  f32x16 s = zero16();
  const bf16_t* kp = Krow + l31 * 64 + h2 * 8;
#pragma unroll
  for (int ks = 0; ks < 4; ++ks) { const bf16x8 a = *(const bf16x8*)(kp + ks * 16); s = MFMA32(a, qf[ks], s); }
  return s;
}
DI f32x16 qk_tile_s(const bf16_t* Krow, int stride, const bf16x8 (&qf)[4], int l31, int h2) {
  f32x16 s = zero16();
  const bf16_t* kp = Krow + l31 * stride + h2 * 8;
#pragma unroll
  for (int ks = 0; ks < 4; ++ks) { const bf16x8 a = *(const bf16x8*)(kp + ks * 16); s = MFMA32(a, qf[ks], s); }
  return s;
}
template <bool HAS_SEL>
DI void softmax_pv_t(f32x16& s, const bf16_t* VTp, int vstride, f32x16 (&o)[2], float& m, float& l, int l31, int h2, bool sel) {
  bf16x8 va[2][2];
#pragma unroll
  for (int dt = 0; dt < 2; ++dt)
#pragma unroll
    for (int sk = 0; sk < 2; ++sk) va[dt][sk] = ld_frag8x2(VTp + (size_t)(dt * 32 + l31) * vstride + sk * 16 + 4 * h2);
  float mx = max16(s);
  if (HAS_SEL) mx = sel ? mx : -INFINITY;
  mx = xhalf_max(mx);
  const float mn = fmaxf(m, mx);
  const float alpha = __builtin_amdgcn_exp2f(m - mn);
  const float mref = (HAS_SEL && !sel) ? INFINITY : mn;
  float ps = 0.f;
#pragma unroll
  for (int r = 0; r < 16; ++r) { s[r] = __builtin_amdgcn_exp2f(s[r] - mref); ps += s[r]; }
  l = l * alpha + ps; m = mn;
#pragma unroll
  for (int dt = 0; dt < 2; ++dt)
#pragma unroll
    for (int r = 0; r < 16; ++r) o[dt][r] *= alpha;
  const bf16x8 p0 = pack8<0>(s), p1 = pack8<8>(s);
#pragma unroll
  for (int dt = 0; dt < 2; ++dt) { o[dt] = MFMA32(va[dt][0], p0, o[dt]); o[dt] = MFMA32(va[dt][1], p1, o[dt]); }
}
DI void softmax_pv(f32x16& s, const bf16_t* VTp, int vstride, f32x16 (&o)[2], float& m, float& l, int l31, int h2) { softmax_pv_t<false>(s, VTp, vstride, o, m, l, l31, h2, true); }

constexpr int AD_KSTR = 72, AD_VSTR = 68;
constexpr int AD_BUF = 64 * AD_KSTR * 2 + 64 * AD_VSTR * 2;
struct AdTile { u32x4 k, v; };
DI AdTile ad_load(const bf16_t* Kg, const bf16_t* Vg, int key0, int tidf) {
  AdTile r; const int row = tidf >> 3, ch = tidf & 7;
  r.k = *(const u32x4*)(Kg + (size_t)(key0 + row) * 64 + ch * 8);
  r.v = *(const u32x4*)(Vg + (size_t)row * T + key0 + ch * 8);
  return r;
}
DI void ad_store(const AdTile& r, char* buf, int tidf) {
  const int row = tidf >> 3, ch = tidf & 7;
  *(u32x4*)(buf + (row * AD_KSTR + ch * 8) * 2) = r.k;
  char* vp = buf + 64 * AD_KSTR * 2 + (row * AD_VSTR + ch * 8) * 2;
  *(u32x2*)vp = (u32x2){r.v[0], r.v[1]}; *(u32x2*)(vp + 8) = (u32x2){r.v[2], r.v[3]};
}
template <bool HAS_SEL>
DI void softmax_pv64(const bf16_t* Kb, const bf16_t* Vb, const bf16x8 (&qf)[4], f32x16 (&o)[2], float& m, float& l, int l31, int h2, bool sel) {
  bf16x8 ka[2][4];
  {
    const bf16_t* kp = Kb + l31 * AD_KSTR + h2 * 8;
#pragma unroll
    for (int ks = 0; ks < 4; ++ks) { ka[0][ks] = *(const bf16x8*)(kp + ks * 16); ka[1][ks] = *(const bf16x8*)(kp + 32 * AD_KSTR + ks * 16); }
  }
  __builtin_amdgcn_sched_barrier(0);
  f32x16 s0 = zero16(), s1 = zero16();
#pragma unroll
  for (int ks = 0; ks < 4; ++ks) { s0 = MFMA32(ka[0][ks], qf[ks], s0); s1 = MFMA32(ka[1][ks], qf[ks], s1); }
  bf16x8 va[2][4];
#pragma unroll
  for (int dt = 0; dt < 2; ++dt) {
    const bf16_t* vp = Vb + (size_t)(dt * 32 + l31) * AD_VSTR + 4 * h2;
#pragma unroll
    for (int q = 0; q < 4; ++q) va[dt][q] = ld_frag8x2(vp + 16 * q);
  }
  __builtin_amdgcn_sched_barrier(0);
  float mx; { const float ma = max16(s0), mb = max16(s1); mx = max3f(ma, mb, mb); }
  if (HAS_SEL) mx = sel ? mx : -INFINITY;
  mx = xhalf_max(mx);
  const float mn = fmaxf(m, mx);
  const float alpha = __builtin_amdgcn_exp2f(m - mn);
  const float mref = (HAS_SEL && !sel) ? INFINITY : mn;
  float ps = 0.f;
#pragma unroll
  for (int r = 0; r < 16; ++r) { s0[r] = __builtin_amdgcn_exp2f(s0[r] - mref); s1[r] = __builtin_amdgcn_exp2f(s1[r] - mref); ps += s0[r] + s1[r]; }
  l = l * alpha + ps; m = mn;
  if (__builtin_amdgcn_ballot_w64(alpha != 1.f) != 0ull) {
#pragma unroll
    for (int dt = 0; dt < 2; ++dt)
#pragma unroll
      for (int r = 0; r < 16; ++r) o[dt][r] *= alpha;
  }
  const bf16x8 p0 = pack8<0>(s0), p1 = pack8<8>(s0), p2 = pack8<0>(s1), p3 = pack8<8>(s1);
#pragma unroll
  for (int dt = 0; dt < 2; ++dt) {
    o[dt] = MFMA32(va[dt][0], p0, o[dt]);
    o[dt] = MFMA32(va[dt][1], p1, o[dt]);
    o[dt] = MFMA32(va[dt][2], p2, o[dt]);
    o[dt] = MFMA32(va[dt][3], p3, o[dt]);
  }
}
DI void qk64(const bf16_t* Kb, const bf16x8 (&qf)[4], f32x16& s0, f32x16& s1, int l31, int h2) {
  bf16x8 ka[2][4];
  const bf16_t* kp = Kb + l31 * AD_KSTR + h2 * 8;
#pragma unroll
  for (int ks = 0; ks < 4; ++ks) { ka[0][ks] = *(const bf16x8*)(kp + ks * 16); ka[1][ks] = *(const bf16x8*)(kp + 32 * AD_KSTR + ks * 16); }
  s0 = zero16(); s1 = zero16();
#pragma unroll
  for (int ks = 0; ks < 4; ++ks) { s0 = MFMA32(ka[0][ks], qf[ks], s0); s1 = MFMA32(ka[1][ks], qf[ks], s1); }
}
template <bool HAS_SEL>
DI void sm_pv64(f32x16& s0, f32x16& s1, const bf16_t* Vb, f32x16 (&o)[2], float& m, float& l, int l31, int h2, bool sel) {
  bf16x8 va[2][4];
#pragma unroll
  for (int dt = 0; dt < 2; ++dt) {
    const bf16_t* vp = Vb + (size_t)(dt * 32 + l31) * AD_VSTR + 4 * h2;
#pragma unroll
    for (int q = 0; q < 4; ++q) va[dt][q] = ld_frag8x2(vp + 16 * q);
  }
  float mx; { const float ma = max16(s0), mb = max16(s1); mx = max3f(ma, mb, mb); }
  if (HAS_SEL) mx = sel ? mx : -INFINITY;
  mx = xhalf_max(mx);
  const float mn = fmaxf(m, mx);
  const float alpha = __builtin_amdgcn_exp2f(m - mn);
  const float mref = (HAS_SEL && !sel) ? INFINITY : mn;
  float ps = 0.f;
#pragma unroll
  for (int r = 0; r < 16; ++r) { s0[r] = __builtin_amdgcn_exp2f(s0[r] - mref); s1[r] = __builtin_amdgcn_exp2f(s1[r] - mref); ps += s0[r] + s1[r]; }
  l = l * alpha + ps; m = mn;
  if (__builtin_amdgcn_ballot_w64(alpha != 1.f) != 0ull) {
#pragma unroll
    for (int dt = 0; dt < 2; ++dt)
#pragma unroll
      for (int r = 0; r < 16; ++r) o[dt][r] *= alpha;
  }
  const bf16x8 p0 = pack8<0>(s0), p1 = pack8<8>(s0), p2 = pack8<0>(s1), p3 = pack8<8>(s1);
#pragma unroll
  for (int dt = 0; dt < 2; ++dt) {
    o[dt] = MFMA32(va[dt][0], p0, o[dt]);
    o[dt] = MFMA32(va[dt][1], p1, o[dt]);
    o[dt] = MFMA32(va[dt][2], p2, o[dt]);
    o[dt] = MFMA32(va[dt][3], p3, o[dt]);
  }
}
template <bool HAS_SEL>
DI void sm_pv64_qk(f32x16& s0, f32x16& s1, const bf16_t* Vb, f32x16 (&o)[2], float& m, float& l, int l31, int h2, bool sel,
                   const bf16_t* Knext, const bf16x8 (&qf)[4], f32x16& n0, f32x16& n1) {
  float mx; { const float ma = max16(s0), mb = max16(s1); mx = max3f(ma, mb, mb); }
  if (HAS_SEL) mx = sel ? mx : -INFINITY;
  mx = xhalf_max(mx);
  const float mn = fmaxf(m, mx);
  const float alpha = __builtin_amdgcn_exp2f(m - mn);
  const float mref = (HAS_SEL && !sel) ? INFINITY : mn;
  if (__builtin_amdgcn_ballot_w64(alpha != 1.f) != 0ull) {
#pragma unroll
    for (int dt = 0; dt < 2; ++dt)
#pragma unroll
      for (int r = 0; r < 16; ++r) o[dt][r] *= alpha;
  }
  bf16x8 ka[2][4];
  {
    const bf16_t* kp = Knext + l31 * AD_KSTR + h2 * 8;
#pragma unroll
    for (int ks = 0; ks < 4; ++ks) { ka[0][ks] = *(const bf16x8*)(kp + ks * 16); ka[1][ks] = *(const bf16x8*)(kp + 32 * AD_KSTR + ks * 16); }
  }
  bf16x8 va[2][4];
#pragma unroll
  for (int dt = 0; dt < 2; ++dt) {
    const bf16_t* vp = Vb + (size_t)(dt * 32 + l31) * AD_VSTR + 4 * h2;
#pragma unroll
    for (int q = 0; q < 4; ++q) va[dt][q] = ld_frag8x2(vp + 16 * q);
  }
  n0 = zero16(); n1 = zero16();
  float ps = 0.f;
#define SBAR __builtin_amdgcn_sched_barrier(0)
#define EX4(S, R0) _Pragma("unroll") for (int r = (R0); r < (R0) + 4; ++r) { S[r] = __builtin_amdgcn_exp2f(S[r] - mref); ps += S[r]; }
  SBAR; n0 = MFMA32(ka[0][0], qf[0], n0); SBAR; EX4(s0, 0);
  SBAR; n1 = MFMA32(ka[1][0], qf[0], n1); SBAR; EX4(s0, 4);
  const bf16x8 p0 = pack8<0>(s0);
  SBAR; n0 = MFMA32(ka[0][1], qf[1], n0); SBAR; EX4(s0, 8);
  SBAR; o[0] = MFMA32(va[0][0], p0, o[0]); SBAR; EX4(s0, 12);
  const bf16x8 p1 = pack8<8>(s0);
  SBAR; n1 = MFMA32(ka[1][1], qf[1], n1); o[1] = MFMA32(va[1][0], p0, o[1]); SBAR; EX4(s1, 0);
  SBAR; n0 = MFMA32(ka[0][2], qf[2], n0); o[0] = MFMA32(va[0][1], p1, o[0]); SBAR; EX4(s1, 4);
  const bf16x8 p2 = pack8<0>(s1);
  SBAR; n1 = MFMA32(ka[1][2], qf[2], n1); o[1] = MFMA32(va[1][1], p1, o[1]); SBAR; EX4(s1, 8);
  SBAR; n0 = MFMA32(ka[0][3], qf[3], n0); o[0] = MFMA32(va[0][2], p2, o[0]); SBAR; EX4(s1, 12);
  const bf16x8 p3 = pack8<8>(s1);
  SBAR; n1 = MFMA32(ka[1][3], qf[3], n1); o[1] = MFMA32(va[1][2], p2, o[1]); SBAR;
  o[0] = MFMA32(va[0][3], p3, o[0]); o[1] = MFMA32(va[1][3], p3, o[1]);
#undef SBAR
#undef EX4
  l = l * alpha + ps; m = mn;
}
DI void ph_attnD(const Params& p, int layer, int* ctr, char* smem, int* s_pair) {
  float* imps = (float*)smem;
  float* impf = (float*)(smem + 34816);
  unsigned* smask = (unsigned*)(smem + 43008);
  unsigned* s_union = (unsigned*)(smem + 43008 + 256);
  char* kvbuf = smem + 49152;
  int nxt_item = 0;
  if (threadIdx.x == 0) nxt_item = atomicAdd(ctr, 1);
  for (;;) {
    int tidf = threadIdx.x; asm volatile("" : "+v"(tidf));
    const int lane = tidf & 63, wid = tidf >> 6, h = wid & 3, qs = wid >> 2, l31 = lane & 31, h2 = lane >> 5;
    float* ofl = (float*)(smem + (wid < 6 ? wid * 8192 : 49152 + 3 * AD_BUF + (wid - 6) * 8192));
    __syncthreads();
    if (tidf == 0) { *s_pair = nxt_item; *s_union = 0u; nxt_item = atomicAdd(ctr, 1); }
    __syncthreads();
    const int it = *s_pair;
    if (it >= 1024) break;
    const int b = it & 31, q0 = (31 - (it >> 5)) * 64;
    const int qw = q0 + 32 * qs;
    const int t = qw + l31, cur = q0 >> 6;
    const size_t tok = (size_t)b * T + t;
    bf16x8 qf[4];
    {
      const bf16_t* qp = p.QD() + ((size_t)(b * 4 + h) * T + t) * 64 + h2 * 8;
#pragma unroll
      for (int ks = 0; ks < 4; ++ks) qf[ks] = *(const bf16x8*)(qp + ks * 16);
    }
    const float g0 = p.DG()[tok * 12 + h * 3 + 0], g1 = p.DG()[tok * 12 + h * 3 + 1], g2 = p.DG()[tok * 12 + h * 3 + 2];
    f32x16 ofin[2];
    bf16_t* Kc_l = (bf16_t*)kvbuf;
    bf16_t* Vc_l = (bf16_t*)(kvbuf + 128 * 72 * 2);
    {
      const bf16_t* Kc = p.KCMP() + (size_t)b * 128 * 64;
      const bf16_t* Vc = p.VCMPT() + (size_t)b * 64 * 128;
      u32x4 ck[2], cv[2];
#pragma unroll
      for (int i = 0; i < 2; ++i) { const int q = tidf + 512 * i; ck[i] = *(const u32x4*)(Kc + q * 8); cv[i] = *(const u32x4*)(Vc + q * 8); }
#pragma unroll
      for (int i = 0; i < 2; ++i) {
        const int q = tidf + 512 * i;
        *(u32x4*)(Kc_l + (q >> 3) * 72 + (q & 7) * 8) = ck[i];
        bf16_t* vq = Vc_l + (q >> 4) * 136 + (q & 15) * 8;
        *(u32x2*)vq = (u32x2){cv[i][0], cv[i][1]}; *(u32x2*)(vq + 4) = (u32x2){cv[i][2], cv[i][3]};
      }
    }
    __syncthreads();
    PREP(18) { {
      const int nkt = min(4, (qw >> 9) + 1);
      f32x16 o[2]; o[0] = zero16(); o[1] = zero16();
      float m = -1e30f, l = 0.f;
      for (int kt = 0; kt < nkt; ++kt) {
        f32x16 s = qk_tile_s(Kc_l + kt * 32 * 72, 72, qf, l31, h2);
#pragma unroll
        for (int r = 0; r < 16; ++r) { const int n = kt * 32 + crow(r, h2); if (16 * n + 31 > t) s[r] = -INFINITY; }
        softmax_pv(s, Vc_l + kt * 32, 136, o, m, l, l31, h2);
      }
      l = xhalf_sum(l);
      const float il = l > 0.f ? 1.f / l : 0.f;
      const float gi = g0 * il;
#pragma unroll
      for (int dt = 0; dt < 2; ++dt)
#pragma unroll
        for (int r = 0; r < 16; ++r) ofin[dt][r] = gi * o[dt][r];
      float carry = 0.f;
#pragma unroll
      for (int kt = 0; kt < 4; ++kt) {
        f32x16 s;
        if (kt < nkt) {
          s = qk_tile_s(Kc_l + kt * 32 * 72, 72, qf, l31, h2);
#pragma unroll
          for (int r = 0; r < 16; ++r) { const int n = kt * 32 + crow(r, h2); s[r] = (16 * n + 31 > t) ? 0.f : __builtin_amdgcn_exp2f(s[r] - m) * il; }
        } else s = zero16();
        float X[4];
#pragma unroll
        for (int g = 0; g < 4; ++g) X[g] = shx(s[4 * g + 3], 32);
#pragma unroll
        for (int g = 0; g < 4; ++g) {
          const float G = (s[4 * g] + s[4 * g + 1]) + (s[4 * g + 2] + s[4 * g + 3]);
          const float prev_other = g > 0 ? X[g - 1] : carry;
          imps[(wid * 32 + l31) * 33 + 8 * kt + 2 * g + h2] = G + (h2 ? X[g] : prev_other);
        }
        carry = X[3];
      }
    }
    __syncthreads();
    {
      const int tt = tidf >> 3, jg = tidf & 7, wq = (tt >> 5) * 4, tl = tt & 31;
#pragma unroll
      for (int i = 0; i < 4; ++i) {
        const int j = jg * 4 + i;
        impf[tt * 32 + j] = (imps[((wq + 0) * 32 + tl) * 33 + j] + imps[((wq + 1) * 32 + tl) * 33 + j]) + (imps[((wq + 2) * 32 + tl) * 33 + j] + imps[((wq + 3) * 32 + tl) * 33 + j]);
      }
    }
    __syncthreads();
    {
      const int tt = tidf >> 3, jg = tidf & 7;
      float v[32];
#pragma unroll
      for (int j = 0; j < 32; ++j) {
        float x = impf[tt * 32 + j];
        if (j > cur) x = -1e30f; else if (j == 0 || j == cur || j == cur - 1) x = 1e6f;
        v[j] = x;
      }
      unsigned bits = 0u;
#pragma unroll
      for (int i = 0; i < 4; ++i) {
        int rank = 0; float vj = 0.f;
#pragma unroll
        for (int j = 0; j < 32; ++j) if (j == jg * 4 + i) vj = v[j];
        const int jj = jg * 4 + i;
#pragma unroll
        for (int j = 0; j < 32; ++j) rank += (v[j] > vj || (v[j] == vj && j < jj)) ? 1 : 0;
        if (rank < 8 && jj <= cur) bits |= 1u << jj;
      }
      bits |= shx(bits, 1); bits |= shx(bits, 2); bits |= shx(bits, 4);
      if (jg == 0) { smask[tt] = bits; atomicOr(s_union, bits); }
    }
    __syncthreads();
    }
    {
      const unsigned mymask = smask[32 * qs + l31];
      unsigned rem = *s_union;
      const bf16_t* Ks = p.KV() + (size_t)(2 * NB + b) * T * 64;
      const bf16_t* Vs = p.KV() + (size_t)(3 * NB + b) * 64 * T;
      f32x16 o[2]; o[0] = zero16(); o[1] = zero16();
      float m = -1e30f, l = 0.f;
      int j = __builtin_ctz(rem); rem &= rem - 1;
      int jn = -1, j2 = -1, j3 = -1;
      if (rem != 0u) { jn = __builtin_ctz(rem); rem &= rem - 1; }
      {
        const AdTile r0 = ad_load(Ks, Vs, j * 64, tidf);
        AdTile r1; r1.k = r1.v = (u32x4){0u, 0u, 0u, 0u};
        if (jn >= 0) r1 = ad_load(Ks, Vs, jn * 64, tidf);
        ad_store(r0, kvbuf, tidf);
        if (jn >= 0) ad_store(r1, kvbuf + AD_BUF, tidf);
      }
      AdTile ra, rb;
      ra.k = ra.v = rb.k = rb.v = (u32x4){0u, 0u, 0u, 0u};
      if (rem != 0u) { j2 = __builtin_ctz(rem); rem &= rem - 1; ra = ad_load(Ks, Vs, j2 * 64, tidf); }
      if (rem != 0u) { j3 = __builtin_ctz(rem); rem &= rem - 1; rb = ad_load(Ks, Vs, j3 * 64, tidf); }
      __syncthreads();
#pragma unroll
      for (int dt = 0; dt < 2; ++dt)
#pragma unroll
        for (int g4 = 0; g4 < 4; ++g4) *(f32x4*)(ofl + ((dt * 4 + g4) * 64 + lane) * 4) = (f32x4){ofin[dt][4 * g4], ofin[dt][4 * g4 + 1], ofin[dt][4 * g4 + 2], ofin[dt][4 * g4 + 3]};
      int pb0 = 0, pb1 = 1, pb2 = 2;
      f32x16 c0, c1;
      qk64((const bf16_t*)kvbuf, qf, c0, c1, l31, h2);
      f32x16 n0, n1;
      auto step = [&](AdTile& tset, f32x16& c0, f32x16& c1, f32x16& n0, f32x16& n1) __attribute__((always_inline)) -> bool {
        const bool sel = (mymask >> j) & 1u;
        if (j == cur) {
#pragma unroll
          for (int r = 0; r < 16; ++r) { const int key = j * 64 + crow(r, h2); if (key > t) c0[r] = -INFINITY; if (key + 32 > t) c1[r] = -INFINITY; }
        }
        sm_pv64_qk<true>(c0, c1, (const bf16_t*)(kvbuf + pb0 * AD_BUF + 64 * AD_KSTR * 2), o, m, l, l31, h2, sel, (const bf16_t*)(kvbuf + pb1 * AD_BUF), qf, n0, n1);
        int j4 = -1;
        if (j2 >= 0) {
          ad_store(tset, kvbuf + pb2 * AD_BUF, tidf);
          if (rem != 0u) { j4 = __builtin_ctz(rem); rem &= rem - 1; tset = ad_load(Ks, Vs, j4 * 64, tidf); }
        }
        __syncthreads();
        if (jn < 0) return false;
        j = jn; jn = j2; j2 = j3; j3 = j4;
        const int tp = pb0; pb0 = pb1; pb1 = pb2; pb2 = tp;
        return true;
      };
      for (;;) { if (!step(ra, c0, c1, n0, n1)) break; if (!step(rb, n0, n1, c0, c1)) break; }
      l = xhalf_sum(l);
      const float il = l > 0.f ? g1 / l : 0.f;
#pragma unroll
      for (int dt = 0; dt < 2; ++dt)
#pragma unroll
        for (int g4 = 0; g4 < 4; ++g4) {
          f32x4* q = (f32x4*)(ofl + ((dt * 4 + g4) * 64 + lane) * 4);
          const f32x4 add = {o[dt][4 * g4], o[dt][4 * g4 + 1], o[dt][4 * g4 + 2], o[dt][4 * g4 + 3]};
          *q = *q + il * add;
        }
    }
    u32x2 gzv[2][4];
#pragma unroll
    for (int dt = 0; dt < 2; ++dt)
#pragma unroll
      for (int g = 0; g < 4; ++g) gzv[dt][g] = *(const u32x2*)(p.GZ() + (size_t)4 * NTOK * 256 + tok * 256 + h * 64 + dt * 32 + 8 * g + 4 * h2);
    {
      const bf16_t* Kw = p.KV() + (size_t)(4 * NB + b) * T * 64;
      const bf16_t* Vw = p.KV() + (size_t)(5 * NB + b) * 64 * T;
      f32x16 o[2]; o[0] = zero16(); o[1] = zero16();
      float m = -1e30f, l = 0.f;
      int k0 = max(0, q0 - 512);
      {
        const AdTile r0 = ad_load(Kw, Vw, k0, tidf);
        AdTile r1; r1.k = r1.v = (u32x4){0u, 0u, 0u, 0u};
        if (k0 + 64 <= q0) r1 = ad_load(Kw, Vw, k0 + 64, tidf);
        ad_store(r0, kvbuf, tidf);
        if (k0 + 64 <= q0) ad_store(r1, kvbuf + AD_BUF, tidf);
      }
      AdTile ra, rb;
      ra.k = ra.v = rb.k = rb.v = (u32x4){0u, 0u, 0u, 0u};
      if (k0 + 128 <= q0) ra = ad_load(Kw, Vw, k0 + 128, tidf);
      if (k0 + 192 <= q0) rb = ad_load(Kw, Vw, k0 + 192, tidf);
      __syncthreads();
      int pb0 = 0, pb1 = 1, pb2 = 2;
      f32x16 c0, c1;
      qk64((const bf16_t*)kvbuf, qf, c0, c1, l31, h2);
      f32x16 n0, n1;
      auto step = [&](AdTile& tset, f32x16& c0, f32x16& c1, f32x16& n0, f32x16& n1) __attribute__((always_inline)) -> bool {
        const bool more = k0 + 64 <= q0;
        if (!(k0 + 63 <= qw && k0 + 512 > qw + 31)) {
#pragma unroll
          for (int r = 0; r < 16; ++r) {
            const int key = k0 + crow(r, h2);
            if (key > t || t - key >= 512) c0[r] = -INFINITY;
            if (key + 32 > t || t - key - 32 >= 512) c1[r] = -INFINITY;
          }
        }
        sm_pv64_qk<false>(c0, c1, (const bf16_t*)(kvbuf + pb0 * AD_BUF + 64 * AD_KSTR * 2), o, m, l, l31, h2, true, (const bf16_t*)(kvbuf + pb1 * AD_BUF), qf, n0, n1);
        if (k0 + 128 <= q0) {
          ad_store(tset, kvbuf + pb2 * AD_BUF, tidf);
          if (k0 + 256 <= q0) tset = ad_load(Kw, Vw, k0 + 256, tidf);
        }
        __syncthreads();
        if (!more) return false;
        k0 += 64;
        const int tp = pb0; pb0 = pb1; pb1 = pb2; pb2 = tp;
        return true;
      };
      for (;;) { if (!step(ra, c0, c1, n0, n1)) break; if (!step(rb, n0, n1, c0, c1)) break; }
      l = xhalf_sum(l);
      const float il = l > 0.f ? g2 / l : 0.f;
#pragma unroll
      for (int dt = 0; dt < 2; ++dt)
#pragma unroll
        for (int g4 = 0; g4 < 4; ++g4) {
          const f32x4 q = *(const f32x4*)(ofl + ((dt * 4 + g4) * 64 + lane) * 4);
#pragma unroll
          for (int e = 0; e < 4; ++e) ofin[dt][4 * g4 + e] = q[e] + il * o[dt][4 * g4 + e];
        }
    }
#pragma unroll
    for (int dt = 0; dt < 2; ++dt)
#pragma unroll
      for (int g = 0; g < 4; ++g) {
        const int d0 = dt * 32 + 8 * g + 4 * h2;
        const u32x2 gz = gzv[dt][g];
        const float z0 = __uint_as_float(gz.x << 16), z1 = __uint_as_float(gz.x & 0xffff0000u), z2 = __uint_as_float(gz.y << 16), z3 = __uint_as_float(gz.y & 0xffff0000u);
        u32x2 o2 = {pack2(ofin[dt][4 * g] * z0, ofin[dt][4 * g + 1] * z1), pack2(ofin[dt][4 * g + 2] * z2, ofin[dt][4 * g + 3] * z3)};
        *(u32x2*)(p.YMIX() + tok * 1024 + 768 + h * 64 + d0) = o2;
      }
  }
}


struct AaTile { u32x4 k0, v0, k1, v1; };
DI AaTile aa_load(const bf16_t* Kg, const bf16_t* Vg, int key0, int tidf) {
  AaTile r; const int row = tidf >> 3, ch = tidf & 7;
  r.k0 = *(const u32x4*)(Kg + (size_t)(key0 + row) * 64 + ch * 8);
  r.v0 = *(const u32x4*)(Vg + (size_t)row * T + key0 + ch * 8);
  r.k1 = *(const u32x4*)(Kg + (size_t)T * 64 + (size_t)(key0 + row) * 64 + ch * 8);
  r.v1 = *(const u32x4*)(Vg + (size_t)T * 64 + (size_t)row * T + key0 + ch * 8);
  return r;
}
DI void aa_store(const AaTile& r, char* buf, int tidf) {
  AdTile a; a.k = r.k0; a.v = r.v0; ad_store(a, buf, tidf);
  a.k = r.k1; a.v = r.v1; ad_store(a, buf + AD_BUF, tidf);
}
DI void ph_attnA_fb(const Params& p, int layer, int item, char* smem) {
  int tidf = threadIdx.x; asm volatile("" : "+v"(tidf));
  const int lane = tidf & 63, wid = tidf >> 6, h = wid & 3, qs = wid >> 2, l31 = lane & 31, h2 = lane >> 5, g = h >> 1;
  const int b = item >> 5, q0 = (item & 31) * 64;
  const int qw = q0 + 32 * qs, t = qw + l31;
  const size_t tok = (size_t)b * T + t;
  bf16x8 qf[4];
  {
    const bf16_t* qp = p.QA() + ((size_t)(b * 4 + h) * T + t) * 64 + h2 * 8;
#pragma unroll
    for (int ks = 0; ks < 4; ++ks) qf[ks] = *(const bf16x8*)(qp + ks * 16);
  }
  const bf16_t* Kg = p.KA() + (size_t)(b * 2) * T * 64;
  const bf16_t* Vg = p.VAT() + (size_t)(b * 2) * 64 * T;
  f32x16 o[2]; o[0] = zero16(); o[1] = zero16();
  float m = -1e30f, l = 0.f;
  int k0 = max(0, q0 - 128);
  __syncthreads();
  { const AaTile r = aa_load(Kg, Vg, k0, tidf); aa_store(r, smem, tidf); }
  __syncthreads();
  int pb = 0;
  for (;;) {
    const bool more = k0 + 64 <= q0;
    AaTile nx;
    if (more) nx = aa_load(Kg, Vg, k0 + 64, tidf);
    const char* buf = smem + pb * (2 * AD_BUF) + g * AD_BUF;
#pragma unroll
    for (int kh = 0; kh < 2; ++kh) {
      const int key0 = k0 + kh * 32;
      if (key0 <= qw + 31 && key0 + 31 + 128 > qw) {
        f32x16 s = qk_tile_s((const bf16_t*)buf + kh * 32 * AD_KSTR, AD_KSTR, qf, l31, h2);
        if (key0 + 31 > qw || key0 + 128 <= qw + 31) {
#pragma unroll
          for (int r = 0; r < 16; ++r) { const int key = key0 + crow(r, h2); if (key > t || t - key >= 128) s[r] = -INFINITY; }
        }
        softmax_pv(s, (const bf16_t*)(buf + 64 * AD_KSTR * 2) + kh * 32, AD_VSTR, o, m, l, l31, h2);
      }
    }
    if (more) aa_store(nx, smem + (pb ^ 1) * (2 * AD_BUF), tidf);
    __syncthreads();
    if (!more) break;
    k0 += 64; pb ^= 1;
  }
  l = xhalf_sum(l);
  const float sink = p.a_sinks[layer * 4 + h] * 1.4426950408889634f;
  const float M = fmaxf(m, sink);
  const float sc = __builtin_amdgcn_exp2f(m - M);
  const float inv = sc / (l * sc + __builtin_amdgcn_exp2f(sink - M));
#pragma unroll
  for (int dt = 0; dt < 2; ++dt)
#pragma unroll
    for (int gq = 0; gq < 4; ++gq) {
      const int d0 = dt * 32 + 8 * gq + 4 * h2;
      const u32x2 gz = *(const u32x2*)(p.GZ() + tok * 256 + h * 64 + d0);
      const float z0 = __uint_as_float(gz.x << 16), z1 = __uint_as_float(gz.x & 0xffff0000u), z2 = __uint_as_float(gz.y << 16), z3 = __uint_as_float(gz.y & 0xffff0000u);
      u32x2 o2 = {pack2(o[dt][4 * gq] * inv * z0, o[dt][4 * gq + 1] * inv * z1), pack2(o[dt][4 * gq + 2] * inv * z2, o[dt][4 * gq + 3] * inv * z3)};
      *(u32x2*)(p.YMIX() + tok * 1024 + h * 64 + d0) = o2;
    }
}

DI float logsigmoidf_(float x) { return fminf(x, 0.f) - __logf(1.f + __expf(-fabsf(x))); }
DI void mlstm_gates(const Params& p, size_t tok0, int hh, float* bc, float* ig, int tid) {
  if (tid < 64) {
    const int s0 = 2 * tid;
    const float lf0 = logsigmoidf_(p.IFG()[(tok0 + s0) * 8 + 4 + hh]), lf1 = logsigmoidf_(p.IFG()[(tok0 + s0 + 1) * 8 + 4 + hh]);
    const float pair = lf0 + lf1;
    float x = pair;
#pragma unroll
    for (int off = 1; off < 64; off <<= 1) { const float y = shup(x, off); if (tid >= off) x += y; }
    const float excl = x - pair;
    bc[s0] = excl + lf0; bc[s0 + 1] = excl + pair;
    ig[s0] = p.IFG()[(tok0 + s0) * 8 + hh]; ig[s0 + 1] = p.IFG()[(tok0 + s0 + 1) * 8 + hh];
  }
}
DI void conv8(const bf16_t* raw, int t, int dg, const float (&cw)[4][8], const float (&cb)[8], float (&out)[8]) {
#pragma unroll
  for (int e = 0; e < 8; ++e) out[e] = cb[e];
#pragma unroll
  for (int j = 0; j < 4; ++j) {
    const int ts = t - 3 + j;
    if (ts >= 0) {
      const u32x4 row = *(const u32x4*)(raw + (size_t)ts * 64 + dg * 8);
#pragma unroll
      for (int e2 = 0; e2 < 4; ++e2) { out[2 * e2] += cw[j][2 * e2] * __uint_as_float(row[e2] << 16); out[2 * e2 + 1] += cw[j][2 * e2 + 1] * __uint_as_float(row[e2] & 0xffff0000u); }
    }
  }
#pragma unroll
  for (int e = 0; e < 8; ++e) out[e] = siluf_(out[e]);
}
DI void conv_rows_load(const bf16_t* raw, int tfirst, int dg, u32x4 (&r)[7]) {
#pragma unroll
  for (int j = 0; j < 7; ++j) {
    const int ts = tfirst + j;
    const u32x4 v = *(const u32x4*)(raw + (size_t)max(ts, 0) * 64 + dg * 8);
    r[j] = ts >= 0 ? v : (u32x4){0u, 0u, 0u, 0u};
  }
}
template <int I>
DI void conv_rows_compute(const u32x4 (&r)[7], const float (&cw)[4][8], const float (&cb)[8], float (&out)[8]) {
#pragma unroll
  for (int e = 0; e < 8; ++e) out[e] = cb[e];
#pragma unroll
  for (int j = 0; j < 4; ++j) {
    const u32x4 row = r[I + j];
#pragma unroll
    for (int e2 = 0; e2 < 4; ++e2) { out[2 * e2] += cw[j][2 * e2] * __uint_as_float(row[e2] << 16); out[2 * e2 + 1] += cw[j][2 * e2 + 1] * __uint_as_float(row[e2] & 0xffff0000u); }
  }
#pragma unroll
  for (int e = 0; e < 8; ++e) out[e] = siluf_(out[e]);
}
DI void load_conv_w(const Params& p, int layer, int ch0, int dg, float (&cw)[4][8], float (&cb)[8]) {
#pragma unroll
  for (int j = 0; j < 4; ++j)
#pragma unroll
    for (int e = 0; e < 8; ++e) cw[j][e] = p.conv_w[layer * 2048 + j * 512 + ch0 + dg * 8 + e];
#pragma unroll
  for (int e = 0; e < 8; ++e) cb[e] = p.conv_b[layer * 512 + ch0 + dg * 8 + e];
}
DI void delta_state_loadA(const bf16_t* VT, bf16x8 (&a)[8], int wid, int l31, int h2) {
  const int mt = wid >> 1;
#pragma unroll
  for (int ks = 0; ks < 8; ++ks) a[ks] = *(const bf16x8*)(VT + (size_t)(mt * 32 + l31) * T + ks * 16 + h2 * 8);
}
DI void delta_state(const bf16x8 (&a)[8], const bf16_t* KT, float* out, int wid, int l31, int h2) {
  const int mt = wid >> 1, nt = wid & 1;
  f32x16 acc = zero16();
#pragma unroll
  for (int ks = 0; ks < 8; ++ks) {
    const bf16x8 bb = *(const bf16x8*)(KT + (nt * 32 + l31) * 136 + ks * 16 + h2 * 8);
    acc = MFMA32(a[ks], bb, acc);
  }
#pragma unroll
  for (int r = 0; r < 16; ++r) out[(mt * 32 + crow(r, h2)) * 64 + nt * 32 + l31] = acc[r];
}
DI void ph_mlstm_local(const Params& p, int layer, int item, char* smem) {
  float* bc = (float*)smem; float* ig = bc + 128; float* wv = ig + 128;
  bf16_t* KwT = (bf16_t*)(smem + 2048);
  float* nred = (float*)(smem + 2048 + 64 * 136 * 2);
  const int tid = tid_opaque(), lane = tid & 63, wid = tid >> 6, l31 = lane & 31, h2 = lane >> 5;
  const int b = item >> 6, hh = (item >> 4) & 3, c = item & 15, t0 = c * 128;
  const size_t tok0 = (size_t)b * T + t0;
  const int dg = tid & 7, sb = tid >> 3;
  u32x4 rows[7];
  conv_rows_load(p.QKB() + ((size_t)(b * 8 + 4 + hh) * T) * 64, t0 + 4 * sb - 3, dg, rows);
  bf16x8 af[8];
  delta_state_loadA(p.VBT() + (size_t)(b * 4 + hh) * 64 * T + t0, af, wid, l31, h2);
  float cw[4][8], cb[8];
  load_conv_w(p, layer, 256 + hh * 64, dg, cw, cb);
  __syncthreads();
  mlstm_gates(p, tok0, hh, bc, ig, tid);
  __syncthreads();
  if (tid < 128) wv[tid] = __expf(bc[127] - bc[tid] + ig[tid]);
  __syncthreads();
  {
    float v0[8], v1[8], v2[8], v3[8];
    conv_rows_compute<0>(rows, cw, cb, v0); conv_rows_compute<1>(rows, cw, cb, v1);
    conv_rows_compute<2>(rows, cw, cb, v2); conv_rows_compute<3>(rows, cw, cb, v3);
    const f32x4 w4 = *(const f32x4*)(wv + 4 * sb);
#pragma unroll
    for (int e = 0; e < 8; ++e) {
      u32x2 pk = {pack2(v0[e] * w4[0], v1[e] * w4[1]), pack2(v2[e] * w4[2], v3[e] * w4[3])};
      *(u32x2*)(KwT + (dg * 8 + e) * 136 + 4 * sb) = pk;
    }
  }
  __syncthreads();
  delta_state(af, KwT, p.BST() + (size_t)item * 4096, wid, l31, h2);
  {
    const int k = tid & 63, qd = tid >> 6;
    float a = 0.f;
#pragma unroll 8
    for (int s = 0; s < 32; ++s) a += bf2f(KwT[k * 136 + qd * 32 + s]);
    nred[qd * 64 + k] = a;
  }
  __syncthreads();
  if (tid < 64) p.BN()[(size_t)item * 64 + tid] = (nred[tid] + nred[64 + tid]) + (nred[128 + tid] + nred[192 + tid]);
  if (tid == 0) p.BG()[item] = bc[127];
}
DI void ph_mlstm_scan(const Params& p, int bh) {
  const int tid = tid_opaque();
  f32x4 C[4];
#pragma unroll
  for (int i = 0; i < 4; ++i) C[i] = (f32x4){0.f, 0.f, 0.f, 0.f};
  float n = 0.f;
  for (int c = 0; c < 16; ++c) {
    const int item = bh * 16 + c;
    const float g = __expf(p.BG()[item]);
    f32x4* ptr = (f32x4*)(p.BST() + (size_t)item * 4096 + tid * 16);
#pragma unroll
    for (int i = 0; i < 4; ++i) { const f32x4 tmp = ptr[i]; ptr[i] = C[i]; C[i] = g * C[i] + tmp; }
    if (tid < 64) { const float tmp = p.BN()[(size_t)item * 64 + tid]; p.BN()[(size_t)item * 64 + tid] = n; n = g * n + tmp; }
  }
}
DI void pv_only(const f32x16& s, const bf16_t* VTp, int vstride, f32x16 (&o)[2], int l31, int h2) {
  const bf16x8 p0 = pack8<0>(s), p1 = pack8<8>(s);
#pragma unroll
  for (int dt = 0; dt < 2; ++dt) {
    const bf16_t* vp = VTp + (size_t)(dt * 32 + l31) * vstride + 4 * h2;
    o[dt] = MFMA32(ld_frag8x2(vp), p0, o[dt]);
    o[dt] = MFMA32(ld_frag8x2(vp + 16), p1, o[dt]);
  }
}
DI bf16x8 frag_from_f32(const float* ptr) {
  const f32x4 a = *(const f32x4*)ptr, b = *(const f32x4*)(ptr + 4);
  u32x4 t = {pack2(a[0], a[1]), pack2(a[2], a[3]), pack2(b[0], b[1]), pack2(b[2], b[3])};
  return __builtin_bit_cast(bf16x8, t);
}

struct MlRegs { u32x4 rows[7]; bf16x8 af[8]; float f0, f1, i0, i1; };
DI void mlstm_local_prefetch(const Params& p, int item, MlRegs& r, int tid) {
  const int lane = tid & 63, wid = tid >> 6, l31 = lane & 31, h2 = lane >> 5;
  const int b = item >> 6, hh = (item >> 4) & 3, c = item & 15, t0 = c * 128;
  const int dg = tid & 7, sb = tid >> 3;
  conv_rows_load(p.QKB() + ((size_t)(b * 8 + 4 + hh) * T) * 64, t0 + 4 * sb - 3, dg, r.rows);
  delta_state_loadA(p.VBT() + (size_t)(b * 4 + hh) * 64 * T + t0, r.af, wid, l31, h2);
  r.f0 = r.f1 = r.i0 = r.i1 = 0.f;
  if (tid < 64) {
    const size_t tok = (size_t)b * T + t0 + 2 * tid;
    r.f0 = p.IFG()[tok * 8 + 4 + hh]; r.f1 = p.IFG()[(tok + 1) * 8 + 4 + hh];
    r.i0 = p.IFG()[tok * 8 + hh]; r.i1 = p.IFG()[(tok + 1) * 8 + hh];
  }
}
DI void mlstm_local_compute(const Params& p, int layer, int item, const MlRegs& r, char* smem, int tid) {
  float* bc = (float*)smem; float* ig = bc + 128; float* wv = ig + 128;
  bf16_t* KwT = (bf16_t*)(smem + 2048);
  float* nred = (float*)(smem + 2048 + 64 * 136 * 2);
  const int lane = tid & 63, wid = tid >> 6, l31 = lane & 31, h2 = lane >> 5;
  const int hh = (item >> 4) & 3;
  const int dg = tid & 7, sb = tid >> 3;
  float cw[4][8], cb[8];
  load_conv_w(p, layer, 256 + hh * 64, dg, cw, cb);
  __syncthreads();
  if (tid < 64) {
    const int s0 = 2 * tid;
    const float lf0 = logsigmoidf_(r.f0), lf1 = logsigmoidf_(r.f1);
    const float pair = lf0 + lf1;
    float x = pair;
#pragma unroll
    for (int off = 1; off < 64; off <<= 1) { const float y = shup(x, off); if (tid >= off) x += y; }
    const float excl = x - pair;
    const float b0 = excl + lf0, b1 = excl + pair;
    const float bL = __builtin_bit_cast(float, __builtin_amdgcn_readlane(__builtin_bit_cast(int, x), 63));
    bc[s0] = b0; bc[s0 + 1] = b1;
    wv[s0] = __expf(bL - b0 + r.i0); wv[s0 + 1] = __expf(bL - b1 + r.i1);
  }
  __syncthreads();
  {
    float v0[8], v1[8], v2[8], v3[8];
    conv_rows_compute<0>(r.rows, cw, cb, v0); conv_rows_compute<1>(r.rows, cw, cb, v1);
    conv_rows_compute<2>(r.rows, cw, cb, v2); conv_rows_compute<3>(r.rows, cw, cb, v3);
    const f32x4 w4 = *(const f32x4*)(wv + 4 * sb);
#pragma unroll
    for (int e = 0; e < 8; ++e) {
      u32x2 pk = {pack2(v0[e] * w4[0], v1[e] * w4[1]), pack2(v2[e] * w4[2], v3[e] * w4[3])};
      *(u32x2*)(KwT + (dg * 8 + e) * 136 + 4 * sb) = pk;
    }
  }
  __syncthreads();
  delta_state(r.af, KwT, p.BST() + (size_t)item * 4096, wid, l31, h2);
  {
    const int k = tid & 63, qd = tid >> 6;
    float a = 0.f;
#pragma unroll 8
    for (int s = 0; s < 32; ++s) a += bf2f(KwT[k * 136 + qd * 32 + s]);
    nred[qd * 64 + k] = a;
  }
  __syncthreads();
  if (tid < 64) p.BN()[(size_t)item * 64 + tid] = (nred[tid] + nred[64 + tid]) + (nred[128 + tid] + nred[192 + tid]);
  if (tid == 0) p.BG()[item] = bc[127];
}
DI void ph_mlstm_local_loop(const Params& p, int layer, int vbid, int nvblk, char* smem) {
  const int tid = tid_opaque();
  if (vbid >= 2048) return;
  MlRegs cur;
  mlstm_local_prefetch(p, vbid, cur, tid);
  for (int item = vbid; item < 2048; item += nvblk) {
    MlRegs nxt;
    const bool has = item + nvblk < 2048;
    if (has) mlstm_local_prefetch(p, item + nvblk, nxt, tid);
    mlstm_local_compute(p, layer, item, cur, smem, tid);
    if (has) cur = nxt;
  }
}
struct HlRegs { bf16x8 af[8]; float g[32]; };
DI void hgrn_local_prefetch(const Params& p, int item, HlRegs& r, int tid) {
  const int lane = tid & 63, wid = tid >> 6, l31 = lane & 31, h2 = lane >> 5;
  const int b = item >> 6, hh = (item >> 4) & 3, c = item & 15, t0 = c * 128;
  const int k = tid & 63, qd = tid >> 6;
  delta_state_loadA(p.VCT() + (size_t)(b * 4 + hh) * 64 * T + t0, r.af, wid, l31, h2);
  const float* gp = p.GC() + ((size_t)(b * 4 + hh) * T + t0 + 32 * qd) * 64 + k;
#pragma unroll
  for (int s = 0; s < 32; ++s) r.g[s] = gp[s * 64];
}
DI void hgrn_local_compute(const Params& p, int item, const HlRegs& r, char* smem, int tid) {
  float* tot = (float*)smem;
  bf16_t* KdT = (bf16_t*)(smem + 1024);
  const int lane = tid & 63, wid = tid >> 6, l31 = lane & 31, h2 = lane >> 5;
  const int k = tid & 63, qd = tid >> 6;
  float al[32], kk[32];
  float run = 0.f;
#pragma unroll
  for (int s = 0; s < 32; ++s) { const float g = r.g[s]; run += g; al[s] = run; kk[s] = 1.f - __expf(g); }
  __syncthreads();
  tot[qd * 64 + k] = run;
  __syncthreads();
  float off = 0.f, aL = 0.f;
#pragma unroll
  for (int q = 0; q < 4; ++q) { const float v = tot[q * 64 + k]; aL += v; if (q < qd) off += v; }
#pragma unroll
  for (int s8 = 0; s8 < 4; ++s8) {
    float v[8];
#pragma unroll
    for (int e = 0; e < 8; ++e) v[e] = kk[s8 * 8 + e] * __expf(aL - (al[s8 * 8 + e] + off));
    u32x4 w = {pack2(v[0], v[1]), pack2(v[2], v[3]), pack2(v[4], v[5]), pack2(v[6], v[7])};
    *(u32x4*)(KdT + k * 136 + qd * 32 + s8 * 8) = w;
  }
  __syncthreads();
  delta_state(r.af, KdT, p.CST() + (size_t)item * 4096, wid, l31, h2);
  if (qd == 0) p.CAL()[(size_t)item * 64 + k] = aL;
}
DI void ph_hgrn_local_loop(const Params& p, int vbid, int nvblk, char* smem) {
  const int tid = tid_opaque();
  if (vbid >= 2048) return;
  HlRegs cur;
  hgrn_local_prefetch(p, vbid, cur, tid);
  for (int item = vbid; item < 2048; item += nvblk) {
    HlRegs nxt;
    const bool has = item + nvblk < 2048;
    if (has) hgrn_local_prefetch(p, item + nvblk, nxt, tid);
    hgrn_local_compute(p, item, cur, smem, tid);
    if (has) cur = nxt;
  }
}

constexpr int VT_LSTR = 132;
DI void vt_chunk_load(const bf16_t* VT, int tid, u32x4 (&r)[4]) {
  const int d = tid >> 2, part = tid & 3;
#pragma unroll
  for (int j = 0; j < 4; ++j) r[j] = *(const u32x4*)(VT + (size_t)d * T + part * 32 + j * 8);
}
DI void vt_chunk_store(const u32x4 (&r)[4], bf16_t* lds, int tid) {
  const int d = tid >> 2, part = tid & 3;
#pragma unroll
  for (int j = 0; j < 4; ++j) {
    bf16_t* q = lds + d * VT_LSTR + part * 32 + j * 8;
    *(u32x2*)q = (u32x2){r[j][0], r[j][1]}; *(u32x2*)(q + 4) = (u32x2){r[j][2], r[j][3]};
  }
}
DI void ph_mlstm_out(const Params& p, int layer, int item, char* smem) {
  float* bc = (float*)smem; float* ig = bc + 128;
  bf16_t* qc = (bf16_t*)(smem + 2048);
  bf16_t* kc = qc + 128 * 72;
  bf16_t* vt = kc + 128 * 72;
  const int tid = tid_opaque(), lane = tid & 63, wid = tid >> 6, l31 = lane & 31, h2 = lane >> 5;
  const int b = item >> 6, hh = (item >> 4) & 3, c = item & 15, t0 = c * 128;
  const size_t tok0 = (size_t)b * T + t0;
  const int dg = tid & 7, sb = tid >> 3;
  u32x4 rq[7], rk[7];
  conv_rows_load(p.QKB() + ((size_t)(b * 8 + hh) * T) * 64, t0 + 4 * sb - 3, dg, rq);
  conv_rows_load(p.QKB() + ((size_t)(b * 8 + 4 + hh) * T) * 64, t0 + 4 * sb - 3, dg, rk);
  u32x4 rv[4];
  vt_chunk_load(p.VBT() + (size_t)(b * 4 + hh) * 64 * T + t0, tid, rv);
  __syncthreads();
  mlstm_gates(p, tok0, hh, bc, ig, tid);
  {
    float cw[4][8], cb[8];
    load_conv_w(p, layer, hh * 64, dg, cw, cb);
    float v[8];
#define CONV_ST(I, R, DST, SC) do { conv_rows_compute<I>(R, cw, cb, v); \
      u32x4 w_ = {pack2(v[0] * (SC), v[1] * (SC)), pack2(v[2] * (SC), v[3] * (SC)), pack2(v[4] * (SC), v[5] * (SC)), pack2(v[6] * (SC), v[7] * (SC))}; \
      *(u32x4*)((DST) + (4 * sb + (I)) * 72 + dg * 8) = w_; } while (0)
    CONV_ST(0, rq, qc, 0.125f); CONV_ST(1, rq, qc, 0.125f); CONV_ST(2, rq, qc, 0.125f); CONV_ST(3, rq, qc, 0.125f);
    load_conv_w(p, layer, 256 + hh * 64, dg, cw, cb);
    CONV_ST(0, rk, kc, 1.f); CONV_ST(1, rk, kc, 1.f); CONV_ST(2, rk, kc, 1.f); CONV_ST(3, rk, kc, 1.f);
#undef CONV_ST
  }
  vt_chunk_store(rv, vt, tid);
  const int tq = 32 * wid + l31;
  const float* Cs = p.BST() + (size_t)item * 4096;
  const float* ns = p.BN() + (size_t)item * 64;
  f32x4 cst[2][4][2], nst[4][2];
#pragma unroll
  for (int ks = 0; ks < 4; ++ks) {
#pragma unroll
    for (int dt = 0; dt < 2; ++dt) { cst[dt][ks][0] = *(const f32x4*)(Cs + (dt * 32 + l31) * 64 + ks * 16 + h2 * 8); cst[dt][ks][1] = *(const f32x4*)(Cs + (dt * 32 + l31) * 64 + ks * 16 + h2 * 8 + 4); }
    nst[ks][0] = *(const f32x4*)(ns + ks * 16 + h2 * 8); nst[ks][1] = *(const f32x4*)(ns + ks * 16 + h2 * 8 + 4);
  }
  u32x2 gz1[2][4], gz2[2][4];
#pragma unroll
  for (int dt = 0; dt < 2; ++dt)
#pragma unroll
    for (int g = 0; g < 4; ++g) {
      const int d0 = dt * 32 + 8 * g + 4 * h2;
      gz1[dt][g] = *(const u32x2*)(p.GZ() + (size_t)1 * NTOK * 256 + (tok0 + tq) * 256 + hh * 64 + d0);
      gz2[dt][g] = *(const u32x2*)(p.GZ() + (size_t)2 * NTOK * 256 + (tok0 + tq) * 256 + hh * 64 + d0);
    }
  __syncthreads();
  if (tid < 128) ig[tid] = ig[tid] - bc[tid];
  __syncthreads();
  bf16x8 qf[4];
#pragma unroll
  for (int ks = 0; ks < 4; ++ks) qf[ks] = *(const bf16x8*)(qc + tq * 72 + ks * 16 + h2 * 8);
  const float bt = bc[tq];
  f32x16 o[2]; o[0] = zero16(); o[1] = zero16();
  float dsum = 0.f;
  for (int kt = 0; kt <= wid; ++kt) {
    f32x16 s = qk_tile_s(kc + kt * 32 * 72, 72, qf, l31, h2);
#pragma unroll
    for (int r = 0; r < 16; ++r) {
      const int sidx = 32 * kt + crow(r, h2);
      float val = s[r] * __expf(bt + ig[sidx]);
      if (sidx > tq) val = 0.f;
      s[r] = val; dsum += val;
    }
    pv_only(s, vt + kt * 32, VT_LSTR, o, l31, h2);
  }
  dsum += shx(dsum, 32);
  f32x16 oi[2]; oi[0] = zero16(); oi[1] = zero16();
  float qn = 0.f;
#pragma unroll
  for (int ks = 0; ks < 4; ++ks) {
#pragma unroll
    for (int dt = 0; dt < 2; ++dt) {
      const f32x4 a_ = cst[dt][ks][0], b_ = cst[dt][ks][1];
      u32x4 t_ = {pack2(a_[0], a_[1]), pack2(a_[2], a_[3]), pack2(b_[0], b_[1]), pack2(b_[2], b_[3])};
      oi[dt] = MFMA32(__builtin_bit_cast(bf16x8, t_), qf[ks], oi[dt]);
    }
    const u32x4 qu = __builtin_bit_cast(u32x4, qf[ks]);
    const f32x4 n0 = nst[ks][0], n1 = nst[ks][1];
    qn += __uint_as_float(qu[0] << 16) * n0[0] + __uint_as_float(qu[0] & 0xffff0000u) * n0[1] + __uint_as_float(qu[1] << 16) * n0[2] + __uint_as_float(qu[1] & 0xffff0000u) * n0[3];
    qn += __uint_as_float(qu[2] << 16) * n1[0] + __uint_as_float(qu[2] & 0xffff0000u) * n1[1] + __uint_as_float(qu[3] << 16) * n1[2] + __uint_as_float(qu[3] & 0xffff0000u) * n1[3];
  }
  qn += shx(qn, 32);
  const float ebt = __expf(bt);
  const float den = dsum + ebt * qn;
  const float inv = 1.f / fmaxf(fabsf(den), 1.f);
  const size_t tok = tok0 + tq;
#pragma unroll
  for (int dt = 0; dt < 2; ++dt)
#pragma unroll
    for (int g = 0; g < 4; ++g) {
      const int d0 = dt * 32 + 8 * g + 4 * h2;
      const u32x2 g1 = gz1[dt][g], g2 = gz2[dt][g];
      float z[4] = {__uint_as_float(g1.x << 16) * __uint_as_float(g2.x << 16), __uint_as_float(g1.x & 0xffff0000u) * __uint_as_float(g2.x & 0xffff0000u),
                    __uint_as_float(g1.y << 16) * __uint_as_float(g2.y << 16), __uint_as_float(g1.y & 0xffff0000u) * __uint_as_float(g2.y & 0xffff0000u)};
      float hv[4];
#pragma unroll
      for (int i = 0; i < 4; ++i) hv[i] = (o[dt][4 * g + i] + ebt * oi[dt][4 * g + i]) * inv * z[i];
      u32x2 o2 = {pack2(hv[0], hv[1]), pack2(hv[2], hv[3])};
      *(u32x2*)(p.YMIX() + tok * 1024 + 256 + hh * 64 + d0) = o2;
    }
}


DI void ph_hgrn_local(const Params& p, int layer, int item, char* smem) {
  float* tot = (float*)smem;
  bf16_t* KdT = (bf16_t*)(smem + 1024);
  const int tid = tid_opaque(), lane = tid & 63, wid = tid >> 6, l31 = lane & 31, h2 = lane >> 5;
  const int b = item >> 6, hh = (item >> 4) & 3, c = item & 15, t0 = c * 128;
  const int k = tid & 63, qd = tid >> 6;
  float al[32], kk[32];
  bf16x8 af[8];
  delta_state_loadA(p.VCT() + (size_t)(b * 4 + hh) * 64 * T + t0, af, wid, l31, h2);
  {
    const float* gp = p.GC() + ((size_t)(b * 4 + hh) * T + t0 + 32 * qd) * 64 + k;
    float run = 0.f;
#pragma unroll
    for (int s = 0; s < 32; ++s) { const float g = gp[s * 64]; run += g; al[s] = run; kk[s] = 1.f - __expf(g); }
    __syncthreads();
    tot[qd * 64 + k] = run;
  }
  __syncthreads();
  float off = 0.f, aL = 0.f;
#pragma unroll
  for (int q = 0; q < 4; ++q) { const float v = tot[q * 64 + k]; aL += v; if (q < qd) off += v; }
#pragma unroll
  for (int s8 = 0; s8 < 4; ++s8) {
    float v[8];
#pragma unroll
    for (int e = 0; e < 8; ++e) v[e] = kk[s8 * 8 + e] * __expf(aL - (al[s8 * 8 + e] + off));
    u32x4 w = {pack2(v[0], v[1]), pack2(v[2], v[3]), pack2(v[4], v[5]), pack2(v[6], v[7])};
    *(u32x4*)(KdT + k * 136 + qd * 32 + s8 * 8) = w;
  }
  __syncthreads();
  delta_state(af, KdT, p.CST() + (size_t)item * 4096, wid, l31, h2);
  if (qd == 0) p.CAL()[(size_t)item * 64 + k] = aL;
}
DI void ph_hgrn_scan(const Params& p, int bh) {
  const int tid = tid_opaque();
  f32x4 S[4];
#pragma unroll
  for (int i = 0; i < 4; ++i) S[i] = (f32x4){0.f, 0.f, 0.f, 0.f};
  for (int c = 0; c < 16; ++c) {
    const int item = bh * 16 + c;
    const f32x4* dp = (const f32x4*)(p.CAL() + (size_t)item * 64 + (tid & 3) * 16);
    f32x4* ptr = (f32x4*)(p.CST() + (size_t)item * 4096 + tid * 16);
#pragma unroll
    for (int i = 0; i < 4; ++i) {
      const f32x4 a = dp[i];
      const f32x4 dec = {__expf(a[0]), __expf(a[1]), __expf(a[2]), __expf(a[3])};
      const f32x4 tmp = ptr[i]; ptr[i] = S[i]; S[i] = dec * S[i] + tmp;
    }
  }
}
DI void ph_hgrn_out(const Params& p, int layer, int item, char* smem) {
  float* a_lds = (float*)smem;
  float* tot = (float*)(smem + 128 * 68 * 4);
  bf16_t* kk_lds = (bf16_t*)(smem + 128 * 68 * 4 + 1024);
  bf16_t* vt = kk_lds + 128 * 72;
  const int tid = tid_opaque(), lane = tid & 63, wid = tid >> 6, l31 = lane & 31, h2 = lane >> 5;
  const int b = item >> 6, hh = (item >> 4) & 3, c = item & 15, t0 = c * 128;
  const size_t hbase = (size_t)(b * 4 + hh) * T + t0;
  const int tq = 32 * wid + l31;
  const size_t tok = (size_t)b * T + t0 + tq;
  u32x4 qu[4];
#pragma unroll
  for (int ks = 0; ks < 4; ++ks) qu[ks] = *(const u32x4*)(p.QC() + (hbase + tq) * 64 + ks * 16 + h2 * 8);
  u32x4 rv[4];
  vt_chunk_load(p.VCT() + (size_t)(b * 4 + hh) * 64 * T + t0, tid, rv);
  u32x2 gzv[2][4];
#pragma unroll
  for (int dt = 0; dt < 2; ++dt)
#pragma unroll
    for (int g = 0; g < 4; ++g) gzv[dt][g] = *(const u32x2*)(p.GZ() + (size_t)3 * NTOK * 256 + tok * 256 + hh * 64 + dt * 32 + 8 * g + 4 * h2);
  {
    const int k = tid & 63, qd = tid >> 6;
    float al[32];
    const float* gp = p.GC() + (hbase + 32 * qd) * 64 + k;
    float run = 0.f;
    __syncthreads();
#pragma unroll
    for (int s = 0; s < 32; ++s) { const float g = gp[s * 64]; run += g; al[s] = run; kk_lds[(32 * qd + s) * 72 + k] = f2bf(1.f - __expf(g)); }
    tot[qd * 64 + k] = run;
    vt_chunk_store(rv, vt, tid);
    __syncthreads();
    float off = 0.f;
#pragma unroll
    for (int q = 0; q < 4; ++q) { const float v = tot[q * 64 + k]; if (q < qd) off += v; }
#pragma unroll
    for (int s = 0; s < 32; ++s) a_lds[(32 * qd + s) * 68 + k] = al[s] + off;
  }
  const float* Ss = p.CST() + (size_t)item * 4096;
  f32x4 cst[2][4][2];
#pragma unroll
  for (int ks = 0; ks < 4; ++ks)
#pragma unroll
    for (int dt = 0; dt < 2; ++dt) { cst[dt][ks][0] = *(const f32x4*)(Ss + (dt * 32 + l31) * 64 + ks * 16 + h2 * 8); cst[dt][ks][1] = *(const f32x4*)(Ss + (dt * 32 + l31) * 64 + ks * 16 + h2 * 8 + 4); }
  __syncthreads();
  bf16x8 qi[4], qh[4];
#pragma unroll
  for (int ks = 0; ks < 4; ++ks) {
    const int k0 = ks * 16 + h2 * 8;
    float q8[8], e1[8], e2[8];
#pragma unroll
    for (int e2i = 0; e2i < 4; ++e2i) { q8[2 * e2i] = __uint_as_float(qu[ks][e2i] << 16); q8[2 * e2i + 1] = __uint_as_float(qu[ks][e2i] & 0xffff0000u); }
#pragma unroll
    for (int e = 0; e < 8; ++e) {
      const float a = a_lds[tq * 68 + k0 + e];
      const float r = wid > 0 ? a_lds[(32 * wid - 1) * 68 + k0 + e] : 0.f;
      e1[e] = q8[e] * __expf(a - r); e2[e] = q8[e] * __expf(a);
    }
    u32x4 w1 = {pack2(e1[0], e1[1]), pack2(e1[2], e1[3]), pack2(e1[4], e1[5]), pack2(e1[6], e1[7])};
    u32x4 w2 = {pack2(e2[0], e2[1]), pack2(e2[2], e2[3]), pack2(e2[4], e2[5]), pack2(e2[6], e2[7])};
    qi[ks] = __builtin_bit_cast(bf16x8, w1); qh[ks] = __builtin_bit_cast(bf16x8, w2);
  }
  f32x16 o[2]; o[0] = zero16(); o[1] = zero16();
  for (int kt = 0; kt <= wid; ++kt) {
    f32x16 s = zero16();
    const int srow = 32 * kt + l31;
#pragma unroll
    for (int ks = 0; ks < 4; ++ks) {
      const int k0 = ks * 16 + h2 * 8;
      const u32x4 ku = *(const u32x4*)(kk_lds + srow * 72 + k0);
      float v[8];
#pragma unroll
      for (int e = 0; e < 8; ++e) {
        const float a = a_lds[srow * 68 + k0 + e];
        const float r = wid > 0 ? a_lds[(32 * wid - 1) * 68 + k0 + e] : 0.f;
        const float kkv = (e & 1) ? __uint_as_float(ku[e >> 1] & 0xffff0000u) : __uint_as_float(ku[e >> 1] << 16);
        v[e] = kkv * __expf(fminf(r - a, 80.f));
      }
      u32x4 w = {pack2(v[0], v[1]), pack2(v[2], v[3]), pack2(v[4], v[5]), pack2(v[6], v[7])};
      s = MFMA32(__builtin_bit_cast(bf16x8, w), qi[ks], s);
    }
    if (kt == wid) {
#pragma unroll
      for (int r = 0; r < 16; ++r) if (32 * kt + crow(r, h2) > tq) s[r] = 0.f;
    }
    pv_only(s, vt + kt * 32, VT_LSTR, o, l31, h2);
  }
#pragma unroll
  for (int ks = 0; ks < 4; ++ks)
#pragma unroll
    for (int dt = 0; dt < 2; ++dt) {
      const f32x4 a_ = cst[dt][ks][0], b_ = cst[dt][ks][1];
      u32x4 t_ = {pack2(a_[0], a_[1]), pack2(a_[2], a_[3]), pack2(b_[0], b_[1]), pack2(b_[2], b_[3])};
      o[dt] = MFMA32(__builtin_bit_cast(bf16x8, t_), qh[ks], o[dt]);
    }
  float ss = 0.f;
#pragma unroll
  for (int dt = 0; dt < 2; ++dt)
#pragma unroll
    for (int r = 0; r < 16; ++r) ss += o[dt][r] * o[dt][r];
  ss += shx(ss, 32);
  const float rs = rsqrtf(ss * (1.f / 64.f) + 1e-6f);
#pragma unroll
  for (int dt = 0; dt < 2; ++dt)
#pragma unroll
    for (int g = 0; g < 4; ++g) {
      const int d0 = dt * 32 + 8 * g + 4 * h2;
      const u32x2 gz = gzv[dt][g];
      const f32x4 gn = *(const f32x4*)(p.c_norm_g + layer * 256 + hh * 64 + d0);
      const float z0 = __uint_as_float(gz.x << 16), z1 = __uint_as_float(gz.x & 0xffff0000u), z2 = __uint_as_float(gz.y << 16), z3 = __uint_as_float(gz.y & 0xffff0000u);
      u32x2 o2 = {pack2(o[dt][4 * g] * rs * gn[0] * z0, o[dt][4 * g + 1] * rs * gn[1] * z1), pack2(o[dt][4 * g + 2] * rs * gn[2] * z2, o[dt][4 * g + 3] * rs * gn[3] * z3)};
      *(u32x2*)(p.YMIX() + tok * 1024 + 512 + hh * 64 + d0) = o2;
    }
}


DI void ph_attnA(const Params& p, int layer, int item, char* smem) {
  const int tid = tid_opaque(), lane = tid & 63, h = tid >> 6, l31 = lane & 31, h2 = lane >> 5;
  const int b = item >> 6, q0 = (item & 63) * 32, g = h >> 1;
  const int t = q0 + l31;
  const size_t tok = (size_t)b * T + t;
  bf16x8 qf[4];
  {
    const bf16_t* qp = p.QA() + ((size_t)(b * 4 + h) * T + t) * 64 + h2 * 8;
#pragma unroll
    for (int ks = 0; ks < 4; ++ks) qf[ks] = *(const bf16x8*)(qp + ks * 16);
  }
  const bf16_t* Kp = p.KA() + (size_t)(b * 2 + g) * T * 64;
  const bf16_t* Vp = p.VAT() + (size_t)(b * 2 + g) * 64 * T;
  f32x16 o[2]; o[0] = zero16(); o[1] = zero16();
  float m = -1e30f, l = 0.f;
  for (int key0 = max(0, q0 - 128); key0 <= q0; key0 += 32) {
    f32x16 s = qk_tile(Kp + (size_t)key0 * 64, qf, l31, h2);
    if (key0 == q0 - 128 || key0 == q0) {
#pragma unroll
      for (int r = 0; r < 16; ++r) { const int key = key0 + crow(r, h2); if (key > t || t - key >= 128) s[r] = -INFINITY; }
    }
    softmax_pv(s, Vp + key0, T, o, m, l, l31, h2);
  }
  l = xhalf_sum(l);
  const float sink = p.a_sinks[layer * 4 + h] * 1.4426950408889634f;
  const float M = fmaxf(m, sink);
  const float sc = __builtin_amdgcn_exp2f(m - M);
  const float inv = sc / (l * sc + __builtin_amdgcn_exp2f(sink - M));
#pragma unroll
  for (int dt = 0; dt < 2; ++dt)
#pragma unroll
    for (int gq = 0; gq < 4; ++gq) {
      const int d0 = dt * 32 + 8 * gq + 4 * h2;
      const u32x2 gz = *(const u32x2*)(p.GZ() + tok * 256 + h * 64 + d0);
      const float z0 = __uint_as_float(gz.x << 16), z1 = __uint_as_float(gz.x & 0xffff0000u), z2 = __uint_as_float(gz.y << 16), z3 = __uint_as_float(gz.y & 0xffff0000u);
      u32x2 o2 = {pack2(o[dt][4 * gq] * inv * z0, o[dt][4 * gq + 1] * inv * z1), pack2(o[dt][4 * gq + 2] * inv * z2, o[dt][4 * gq + 3] * inv * z3)};
      *(u32x2*)(p.YMIX() + tok * 1024 + h * 64 + d0) = o2;
    }
}

DI void ph_cmp(const Params& p, int layer, int item, char* smem) {
  float* red = (float*)smem;
  bf16_t* hid = (bf16_t*)(smem + 32768);
  const int tid = tid_opaque(), lane = tid & 63, wid = tid >> 6, l31 = lane & 31, h2 = lane >> 5;
  const int b = item >> 3, kvsel = (item >> 2) & 1, mt = item & 3;
  const int lk = layer * 2 + kvsel;
  const int n = min(mt * 32 + l31, 126);
  const bf16_t* src = p.KV() + ((size_t)(kvsel * NB + b) * T + 16 * n) * 64 + wid * 512 + h2 * 8;
  const bf16_t* w1t = p.W1T() + (size_t)lk * 64 * 2048 + wid * 512 + h2 * 8;
  f32x16 acc[2]; acc[0] = zero16(); acc[1] = zero16();
#pragma unroll 4
  for (int ks = 0; ks < 32; ++ks) {
    const bf16x8 a = *(const bf16x8*)(src + ks * 16);
    const bf16x8 b0 = *(const bf16x8*)(w1t + (size_t)l31 * 2048 + ks * 16);
    const bf16x8 b1 = *(const bf16x8*)(w1t + (size_t)(32 + l31) * 2048 + ks * 16);
    acc[0] = MFMA32(a, b0, acc[0]); acc[1] = MFMA32(a, b1, acc[1]);
  }
  __syncthreads();
#pragma unroll
  for (int nt = 0; nt < 2; ++nt)
#pragma unroll
    for (int r = 0; r < 16; ++r) red[(wid * 32 + crow(r, h2)) * 64 + nt * 32 + l31] = acc[nt][r];
  __syncthreads();
  {
    const int row = tid >> 3, c0 = (tid & 7) * 8;
    float v[8];
#pragma unroll
    for (int e = 0; e < 8; ++e) {
      const float x = (red[(0 * 32 + row) * 64 + c0 + e] + red[(1 * 32 + row) * 64 + c0 + e]) + (red[(2 * 32 + row) * 64 + c0 + e] + red[(3 * 32 + row) * 64 + c0 + e]) + p.CVEC()[lk * 64 + c0 + e];
      v[e] = siluf_(x);
    }
    u32x4 w = {pack2(v[0], v[1]), pack2(v[2], v[3]), pack2(v[4], v[5]), pack2(v[6], v[7])};
    *(u32x4*)(hid + row * 72 + c0) = w;
  }
  __syncthreads();
  if (wid == 0) {
    f32x16 o[2]; o[0] = zero16(); o[1] = zero16();
    const bf16_t* w2t = p.W2T() + (size_t)lk * 4096;
#pragma unroll
    for (int ks = 0; ks < 4; ++ks) {
      const bf16x8 a = *(const bf16x8*)(hid + l31 * 72 + ks * 16 + h2 * 8);
#pragma unroll
      for (int nt = 0; nt < 2; ++nt) o[nt] = MFMA32(a, *(const bf16x8*)(w2t + (nt * 32 + l31) * 64 + ks * 16 + h2 * 8), o[nt]);
    }
    if (kvsel == 0) {
#pragma unroll
      for (int r = 0; r < 16; ++r) {
        const int nn = mt * 32 + crow(r, h2);
        if (nn < 127) {
          const int pos = 16 * nn + 31;
          const float cs = p.ROPEC()[pos * 32 + l31], sn = p.ROPES()[pos * 32 + l31];
          p.KCMP()[((size_t)b * 128 + nn) * 64 + l31] = f2bf(o[0][r] * cs - o[1][r] * sn);
          p.KCMP()[((size_t)b * 128 + nn) * 64 + 32 + l31] = f2bf(o[0][r] * sn + o[1][r] * cs);
        }
      }
    } else {
#pragma unroll
      for (int nt = 0; nt < 2; ++nt)
#pragma unroll
        for (int r = 0; r < 16; ++r) {
          const int nn = mt * 32 + crow(r, h2);
          if (nn < 127) p.VCMPT()[((size_t)b * 64 + nt * 32 + l31) * 128 + nn] = f2bf(o[nt][r]);
        }
    }
  }
}


#define XB_TMO      128
#define XB_XCNT(j)  (256  + 64 * (j))
#define XB_XSUB(j)  (1280 + 64 * (j))
#define XB_XGEN(j)  (2304 + 64 * (j))
#define XB_TOP      3328
#define XB_TOPGEN   3392
#define XCD_BAR_WORDS 3456
#define XB_SPIN_CAP (1u << 22)
DI unsigned xb_ld(unsigned* p)              { return __hip_atomic_load(p, __ATOMIC_RELAXED, __HIP_MEMORY_SCOPE_AGENT); }
DI unsigned xb_add(unsigned* p, unsigned v) { return __hip_atomic_fetch_add(p, v, __ATOMIC_RELAXED, __HIP_MEMORY_SCOPE_AGENT); }
DI unsigned xb_xcc_id() { return (unsigned)__builtin_amdgcn_s_getreg((3 << 11) | 20) & 0xFu; }
#define XB_SPIN(cond, bar) do { unsigned _sp = 0; while (cond) { __builtin_amdgcn_s_sleep(1); \
    if ((++_sp & 255u) == 0u) { if (xb_ld(&(bar)[XB_TMO])) break; if (_sp > XB_SPIN_CAP) { atomicAdd(&(bar)[XB_TMO], 1u); break; } } } } while (0)
struct XcdBarrier { unsigned* bar; unsigned x; volatile LAS unsigned* st; };
DI XcdBarrier xcd_barrier_post(unsigned* bar, volatile LAS unsigned* st) {
  XcdBarrier b; b.bar = bar; b.x = xb_xcc_id(); b.st = st;
  if (threadIdx.x == 0) (void)xb_add(&bar[XB_XCNT(b.x)], 1u);
  return b;
}
DI void xcd_barrier_complete(unsigned* bar, unsigned x, unsigned& nloc, unsigned& nx) {
  const unsigned G = gridDim.x * gridDim.y * gridDim.z;
  unsigned sum, cnt, mine, sp = 0u;
  for (;;) {
    sum = 0u; cnt = 0u; mine = 0u;
#pragma unroll
    for (unsigned j = 0; j < 16; ++j) { const unsigned c = xb_ld(&bar[XB_XCNT(j)]); sum += c; cnt += (c > 0u) ? 1u : 0u; mine = (j == x) ? c : mine; }
    if (sum == G) break;
    __builtin_amdgcn_s_sleep(1);
    if ((++sp & 255u) == 0u) { if (xb_ld(&bar[XB_TMO])) break; if (sp > XB_SPIN_CAP) { atomicAdd(&bar[XB_TMO], 1u); break; } }
  }
  nloc = mine > 0u ? mine : 1u; nx = cnt > 0u ? cnt : 1u;
}
DI void xcd_barrier(const XcdBarrier& b) {
  asm volatile("s_waitcnt vmcnt(0)" ::: "memory");
  __syncthreads();
  int t0_ = threadIdx.x; asm volatile("" : "+v"(t0_));
  if (t0_ == 0) {
    unsigned* bar = b.bar;
    __builtin_amdgcn_s_waitcnt(0);
    unsigned nloc = b.st[0], nx = b.st[1];
    if (nloc == 0u) { xcd_barrier_complete(bar, b.x, nloc, nx); b.st[0] = nloc; b.st[1] = nx; }
    const unsigned old = xb_add(&bar[XB_XSUB(b.x)], 1u);
    const unsigned gen = old / nloc;
    if (old + 1u == (gen + 1u) * nloc) {
      __builtin_amdgcn_fence(__ATOMIC_RELEASE, "agent");
      asm volatile("s_waitcnt vmcnt(0)" ::: "memory");
      const unsigned og = xb_add(&bar[XB_TOP], 1u);
      const unsigned tg = og / nx;
      if (og + 1u == (tg + 1u) * nx) xb_add(&bar[XB_TOPGEN], 1u);
      else XB_SPIN(xb_ld(&bar[XB_TOPGEN]) == tg, bar);
      __builtin_amdgcn_fence(__ATOMIC_ACQUIRE, "agent");
      xb_add(&bar[XB_XGEN(b.x)], 1u);
      asm volatile("s_waitcnt vmcnt(0)" ::: "memory");
    } else {
      XB_SPIN(xb_ld(&bar[XB_XGEN(b.x)]) == gen, bar);
      __builtin_amdgcn_fence(__ATOMIC_ACQUIRE, "agent");
      asm volatile("s_waitcnt vmcnt(0)" ::: "memory");
    }
  }
  __syncthreads();
}

constexpr int HALF_LDS = 80000;
__global__ void __launch_bounds__(512) mega(Params p) {
  __shared__ __attribute__((aligned(16))) char smem_all[2 * HALF_LDS + 32];
  cg::grid_group grid = cg::this_grid();
  const int half = half_id();
  const int bid = blockIdx.x, nblk = gridDim.x;
  const int vbid = 2 * bid + half, nvblk = 2 * nblk;
  char* smem = smem_all + half * HALF_LDS;
  unsigned* xbw = (unsigned*)(smem_all + 2 * HALF_LDS);
  int* s_pair = (int*)(smem_all + 2 * HALF_LDS + 16);
  if (threadIdx.x == 0) { xbw[0] = 0u; xbw[1] = 0u; }
  __syncthreads();
  const XcdBarrier xb = xcd_barrier_post(p.XBAR(), (volatile LAS unsigned*)xbw);
  ph_prologue(p, vbid, nvblk, smem);
  ln_rows(p, 0, 0, vbid, nvblk);
  if (PROBE == 5) { ph_prologue(p, vbid, nvblk, smem); ln_rows(p, 0, 0, vbid, nvblk); }
  grid.sync();
  for (int l = 0; l < 2; ++l) {
    ph_gemm_in(p, l, bid, nblk, smem_all);
    if (PROBE == 1) ph_gemm_in(p, l, bid, nblk, smem_all);
    xcd_barrier(xb);
    for (int rep = 0; rep < (PROBE == 3 ? 2 : 1); ++rep) {
    PREP(8) ph_mlstm_local_loop(p, l, vbid, nvblk, smem);
    PREP(9) ph_hgrn_local_loop(p, vbid, nvblk, smem);
    __syncthreads();
    PREP(10) for (int item = vbid; item < 256; item += nvblk) ph_cmp(p, l, item, smem);
    __syncthreads();
    PREP(11) for (int item = bid; item < 1024; item += nblk) ph_attnA_fb(p, l, item, smem_all);
    }
    xcd_barrier(xb);
    if (vbid < 128) ph_mlstm_scan(p, vbid);
    else if (vbid < 256) ph_hgrn_scan(p, vbid - 128);
    __syncthreads();
    ph_attnD(p, l, p.CTR() + l, smem_all, s_pair);
    if (PROBE == 2) ph_attnD(p, l, p.CTR() + 2 + l, smem_all, s_pair);
    xcd_barrier(xb);
    for (int rep = 0; rep < (PROBE == 4 ? 2 : 1); ++rep) {
    PREP(12) for (int item = vbid; item < 2048; item += nvblk) ph_mlstm_out(p, l, item, smem);
    PREP(13) for (int item = vbid; item < 2048; item += nvblk) ph_hgrn_out(p, l, item, smem);
    }
    xcd_barrier(xb);
    if (PROBE == 15 && l == 1) ph_gemm_out_ln_x4(p, l, 2, bid, smem_all);
    ph_gemm_out_ln_x4(p, l, l, bid, smem_all);
    if (l == 0) xcd_barrier(xb);
  }
}

static inline size_t align_up(size_t v) { return (v + 255) & ~(size_t)255; }

extern "C" void kernel_launch(void* const* d_in, const int* in_sizes, int n_in, void* d_out, int out_size, void* d_ws, size_t ws_size, hipStream_t stream) {
  Params p{};
  p.x = (const float*)d_in[0]; p.ln0_g = (const float*)d_in[1]; p.ln0_b = (const float*)d_in[2]; p.w_in = (const float*)d_in[3];
  p.b_in = (const float*)d_in[4]; p.a_sinks = (const float*)d_in[5]; p.conv_w = (const float*)d_in[6]; p.conv_b = (const float*)d_in[7];
  p.c_lb = (const float*)d_in[8]; p.c_norm_g = (const float*)d_in[9]; p.pe = (const float*)d_in[10]; p.w1 = (const float*)d_in[11];
  p.w2 = (const float*)d_in[12]; p.w_out = (const float*)d_in[13]; p.ln_g = (const float*)d_in[14]; p.ln_b = (const float*)d_in[15];
  p.hf = (float*)d_out;
  p.ws = (char*)d_ws;
  if (WS_TOTAL > ws_size) { fprintf(stderr, "workspace too small: need %zu have %zu\n", (size_t)WS_TOTAL, ws_size); return; }

  static int grid_blocks = 0;
  if (!grid_blocks) {
    int dev = 0, cus = 0, per_cu = 0;
    (void)hipGetDevice(&dev);
    (void)hipDeviceGetAttribute(&cus, hipDeviceAttributeMultiprocessorCount, dev);
    (void)hipOccupancyMaxActiveBlocksPerMultiprocessor(&per_cu, mega, 512, 0);
    if (per_cu > 1) per_cu = 1;
    grid_blocks = cus * per_cu;
    if (grid_blocks != 256) fprintf(stderr, "this kernel is laid out for 256 co-resident workgroups (got %d)\n", grid_blocks);
    grid_blocks = 256;
  }
  (void)hipMemsetAsync((char*)d_ws + OFF_CVEC, 0, (OFF_XCNT - OFF_CVEC) + SZ_XCNT, stream);
  void* args[] = {&p};
  hipError_t e = hipLaunchCooperativeKernel((void*)mega, dim3(grid_blocks), dim3(512), args, 0, stream);
  if (e != hipSuccess) fprintf(stderr, "cooperative launch failed: %s (grid %d)\n", hipGetErrorString(e), grid_blocks);
}
```

```cpp
#include <hip/hip_runtime.h>
#include <hip/hip_cooperative_groups.h>
#include <stdio.h>
#include <stdint.h>
#include <stddef.h>

#ifndef PROBE
#define PROBE 0
#endif
#define PREP(n) for (int prep_ = 0; prep_ < (PROBE == (n) ? 2 : 1); ++prep_)
#define PREP_LAST(n) (prep_ == (PROBE == (n) ? 1 : 0))
#define DI __device__ __forceinline__
typedef unsigned short bf16_t;
typedef short bf16x8 __attribute__((ext_vector_type(8)));
typedef float f32x16 __attribute__((ext_vector_type(16)));
typedef unsigned u32x4 __attribute__((ext_vector_type(4)));
typedef float f32x4 __attribute__((ext_vector_type(4)));

constexpr int NB = 32, T = 2048, DM = 1024, NTOK = NB * T, NP = 4096;
constexpr float DN_ALPHA = 1.41421356237309515f;

constexpr size_t OFF_HB = 0;
constexpr size_t SZ_HB = (size_t)NTOK * 1024 * 2;
constexpr size_t OFF_YMIX = OFF_HB + ((SZ_HB + 255) & ~(size_t)255);
constexpr size_t SZ_YMIX = (size_t)NTOK * 1024 * 2;
constexpr size_t OFF_QA = OFF_YMIX + ((SZ_YMIX + 255) & ~(size_t)255);
constexpr size_t SZ_QA = (size_t)NTOK * 256 * 2;
constexpr size_t OFF_KA = OFF_QA + ((SZ_QA + 255) & ~(size_t)255);
constexpr size_t SZ_KA = (size_t)NTOK * 128 * 2;
constexpr size_t OFF_VAT = OFF_KA + ((SZ_KA + 255) & ~(size_t)255);
constexpr size_t SZ_VAT = (size_t)NTOK * 128 * 2;
constexpr size_t OFF_QKB = OFF_VAT + ((SZ_VAT + 255) & ~(size_t)255);
constexpr size_t SZ_QKB = (size_t)NTOK * 512 * 2;
constexpr size_t OFF_VBT = OFF_QKB + ((SZ_QKB + 255) & ~(size_t)255);
constexpr size_t SZ_VBT = (size_t)NTOK * 256 * 2;
constexpr size_t OFF_QC = OFF_VBT + ((SZ_VBT + 255) & ~(size_t)255);
constexpr size_t SZ_QC = (size_t)NTOK * 256 * 2;
constexpr size_t OFF_GC = OFF_QC + ((SZ_QC + 255) & ~(size_t)255);
constexpr size_t SZ_GC = (size_t)NTOK * 256 * 4;
constexpr size_t OFF_VCT = OFF_GC + ((SZ_GC + 255) & ~(size_t)255);
constexpr size_t SZ_VCT = (size_t)NTOK * 256 * 2;
constexpr size_t OFF_QD = OFF_VCT + ((SZ_VCT + 255) & ~(size_t)255);
constexpr size_t SZ_QD = (size_t)NTOK * 256 * 2;
constexpr size_t OFF_KV = OFF_QD + ((SZ_QD + 255) & ~(size_t)255);
constexpr size_t SZ_KV = (size_t)NTOK * 384 * 2;
constexpr size_t OFF_GZ = OFF_KV + ((SZ_KV + 255) & ~(size_t)255);
constexpr size_t SZ_GZ = (size_t)NTOK * 1280 * 2;
constexpr size_t OFF_IFG = OFF_GZ + ((SZ_GZ + 255) & ~(size_t)255);
constexpr size_t SZ_IFG = (size_t)NTOK * 8 * 4;
constexpr size_t OFF_DG = OFF_IFG + ((SZ_IFG + 255) & ~(size_t)255);
constexpr size_t SZ_DG = (size_t)NTOK * 12 * 4;
constexpr size_t OFF_WT = OFF_DG + ((SZ_DG + 255) & ~(size_t)255);
constexpr size_t SZ_WT = (size_t)2 * NP * 1024 * 2;
constexpr size_t OFF_WOT = OFF_WT + ((SZ_WT + 255) & ~(size_t)255);
constexpr size_t SZ_WOT = (size_t)2 * 1024 * 1024 * 2;
constexpr size_t OFF_KCMP = OFF_WOT + ((SZ_WOT + 255) & ~(size_t)255);
constexpr size_t SZ_KCMP = (size_t)NB * 128 * 64 * 2;
constexpr size_t OFF_VCMPT = OFF_KCMP + ((SZ_KCMP + 255) & ~(size_t)255);
constexpr size_t SZ_VCMPT = (size_t)NB * 64 * 128 * 2;
constexpr size_t OFF_BIASP = OFF_VCMPT + ((SZ_VCMPT + 255) & ~(size_t)255);
constexpr size_t SZ_BIASP = (size_t)2 * NP * 4;
constexpr size_t OFF_LB = OFF_BIASP + ((SZ_BIASP + 255) & ~(size_t)255);
constexpr size_t SZ_LB = (size_t)512 * 4;
constexpr size_t OFF_ROPEC = OFF_LB + ((SZ_LB + 255) & ~(size_t)255);
constexpr size_t SZ_ROPEC = (size_t)T * 32 * 4;
constexpr size_t OFF_ROPES = OFF_ROPEC + ((SZ_ROPEC + 255) & ~(size_t)255);
constexpr size_t SZ_ROPES = (size_t)T * 32 * 4;
constexpr size_t OFF_BST = OFF_ROPES + ((SZ_ROPES + 255) & ~(size_t)255);
constexpr size_t SZ_BST = (size_t)2048 * 4096 * 4;
constexpr size_t OFF_BN = OFF_BST + ((SZ_BST + 255) & ~(size_t)255);
constexpr size_t SZ_BN = (size_t)2048 * 64 * 4;
constexpr size_t OFF_BG = OFF_BN + ((SZ_BN + 255) & ~(size_t)255);
constexpr size_t SZ_BG = (size_t)2048 * 4;
constexpr size_t OFF_CST = OFF_BG + ((SZ_BG + 255) & ~(size_t)255);
constexpr size_t SZ_CST = (size_t)2048 * 4096 * 4;
constexpr size_t OFF_CAL = OFF_CST + ((SZ_CST + 255) & ~(size_t)255);
constexpr size_t SZ_CAL = (size_t)2048 * 64 * 4;
constexpr size_t OFF_W1T = OFF_CAL + ((SZ_CAL + 255) & ~(size_t)255);
constexpr size_t SZ_W1T = (size_t)4 * 64 * 2048 * 2;
constexpr size_t OFF_W2T = OFF_W1T + ((SZ_W1T + 255) & ~(size_t)255);
constexpr size_t SZ_W2T = (size_t)4 * 64 * 64 * 2;
constexpr size_t OFF_CVEC = OFF_W2T + ((SZ_W2T + 255) & ~(size_t)255);
constexpr size_t SZ_CVEC = (size_t)256 * 4;
constexpr size_t OFF_CTR = OFF_CVEC + ((SZ_CVEC + 255) & ~(size_t)255);
constexpr size_t SZ_CTR = (size_t)256;
constexpr size_t OFF_XBAR = OFF_CTR + ((SZ_CTR + 255) & ~(size_t)255);
constexpr size_t SZ_XBAR = (size_t)3456 * 4;
constexpr size_t OFF_XCNT = OFF_XBAR + ((SZ_XBAR + 255) & ~(size_t)255);
constexpr size_t SZ_XCNT = (size_t)3 * 256 * 64 * 4;
constexpr size_t OFF_XST = OFF_XCNT + ((SZ_XCNT + 255) & ~(size_t)255);
constexpr size_t SZ_XST = (size_t)3 * 256 * 4 * 256 * 2 * 4;
constexpr size_t OFF_LNS = OFF_XST + ((SZ_XST + 255) & ~(size_t)255);
constexpr size_t SZ_LNS = (size_t)NTOK * 2 * 4;
constexpr size_t OFF_BSTF = OFF_LNS + ((SZ_LNS + 255) & ~(size_t)255);
constexpr size_t SZ_STF = (size_t)2048 * 8192;
constexpr size_t OFF_CSTF = OFF_BSTF + SZ_STF;
constexpr size_t WS_TOTAL = OFF_CSTF + SZ_STF;
struct Params {
  const float *x, *ln0_g, *ln0_b, *w_in, *b_in, *a_sinks, *conv_w, *conv_b, *c_lb, *c_norm_g, *pe, *w1, *w2, *w_out, *ln_g, *ln_b;
  float* hf;
  char* ws;
  DI bf16_t* HB() const { return (bf16_t*)(ws + OFF_HB); }
  DI bf16_t* YMIX() const { return (bf16_t*)(ws + OFF_YMIX); }
  DI bf16_t* QA() const { return (bf16_t*)(ws + OFF_QA); }
  DI bf16_t* KA() const { return (bf16_t*)(ws + OFF_KA); }
  DI bf16_t* VAT() const { return (bf16_t*)(ws + OFF_VAT); }
  DI bf16_t* QKB() const { return (bf16_t*)(ws + OFF_QKB); }
  DI bf16_t* VBT() const { return (bf16_t*)(ws + OFF_VBT); }
  DI bf16_t* QC() const { return (bf16_t*)(ws + OFF_QC); }
  DI float* GC() const { return (float*)(ws + OFF_GC); }
  DI bf16_t* VCT() const { return (bf16_t*)(ws + OFF_VCT); }
  DI bf16_t* QD() const { return (bf16_t*)(ws + OFF_QD); }
  DI bf16_t* KV() const { return (bf16_t*)(ws + OFF_KV); }
  DI bf16_t* GZ() const { return (bf16_t*)(ws + OFF_GZ); }
  DI float* IFG() const { return (float*)(ws + OFF_IFG); }
  DI float* DG() const { return (float*)(ws + OFF_DG); }
  DI bf16_t* WT() const { return (bf16_t*)(ws + OFF_WT); }
  DI bf16_t* WOT() const { return (bf16_t*)(ws + OFF_WOT); }
  DI bf16_t* KCMP() const { return (bf16_t*)(ws + OFF_KCMP); }
  DI bf16_t* VCMPT() const { return (bf16_t*)(ws + OFF_VCMPT); }
  DI float* BIASP() const { return (float*)(ws + OFF_BIASP); }
  DI float* LB() const { return (float*)(ws + OFF_LB); }
  DI float* ROPEC() const { return (float*)(ws + OFF_ROPEC); }
  DI float* ROPES() const { return (float*)(ws + OFF_ROPES); }
  DI float* BST() const { return (float*)(ws + OFF_BST); }
  DI float* BN() const { return (float*)(ws + OFF_BN); }
  DI float* BG() const { return (float*)(ws + OFF_BG); }
  DI float* CST() const { return (float*)(ws + OFF_CST); }
  DI float* CAL() const { return (float*)(ws + OFF_CAL); }
  DI bf16_t* W1T() const { return (bf16_t*)(ws + OFF_W1T); }
  DI bf16_t* W2T() const { return (bf16_t*)(ws + OFF_W2T); }
  DI float* CVEC() const { return (float*)(ws + OFF_CVEC); }
  DI int* CTR() const { return (int*)(ws + OFF_CTR); }
  DI unsigned* XBAR() const { return (unsigned*)(ws + OFF_XBAR); }
  DI float* LNS() const { return (float*)(ws + OFF_LNS); }
  DI char* BSTF() const { return ws + OFF_BSTF; }
  DI char* CSTF() const { return ws + OFF_CSTF; }
  DI unsigned* XCNT() const { return (unsigned*)(ws + OFF_XCNT); }
  DI float* XST() const { return (float*)(ws + OFF_XST); }
};
namespace cg = cooperative_groups;

DI int tid_opaque() { int t = threadIdx.x; asm volatile("" : "+v"(t)); return t & 255; }
DI int half_id() { return __builtin_amdgcn_readfirstlane((int)(threadIdx.x >> 8)); }
DI float bf2f(bf16_t v) { return __uint_as_float(((unsigned)v) << 16); }
DI unsigned short f2h(float x) { return __builtin_bit_cast(unsigned short, (_Float16)x); }
DI bf16_t f2bf(float x) { unsigned u = __float_as_uint(x); u += 0x7fffu + ((u >> 16) & 1u); return (bf16_t)(u >> 16); }
DI float sigmoidf_(float x) { return __builtin_amdgcn_rcpf(1.f + __builtin_amdgcn_exp2f(-1.4426950408889634f * x)); }
DI float siluf_(float x) { return x * __builtin_amdgcn_rcpf(1.f + __builtin_amdgcn_exp2f(-1.4426950408889634f * x)); }
DI int lane_op() { int l = threadIdx.x; asm volatile("" : "+v"(l)); return l & 63; }
DI float shx(float v, int m) { return __builtin_bit_cast(float, __builtin_amdgcn_ds_bpermute((lane_op() ^ m) << 2, __builtin_bit_cast(int, v))); }
DI unsigned shx(unsigned v, int m) { return (unsigned)__builtin_amdgcn_ds_bpermute((lane_op() ^ m) << 2, (int)v); }
DI float shup(float v, int d) { const int l = lane_op(); const int s = l - d; return __builtin_bit_cast(float, __builtin_amdgcn_ds_bpermute((s < 0 ? l : s) << 2, __builtin_bit_cast(int, v))); }
DI float xhalf_max(float x) { int a = __builtin_bit_cast(int, x), b = a; asm volatile("" : "+v"(b)); auto r = __builtin_amdgcn_permlane32_swap(a, b, false, false); return fmaxf(__builtin_bit_cast(float, (int)r[0]), __builtin_bit_cast(float, (int)r[1])); }
DI float xhalf_sum(float x) { int a = __builtin_bit_cast(int, x), b = a; asm volatile("" : "+v"(b)); auto r = __builtin_amdgcn_permlane32_swap(a, b, false, false); return __builtin_bit_cast(float, (int)r[0]) + __builtin_bit_cast(float, (int)r[1]); }
DI float wave_sum(float v) { for (int o = 32; o > 0; o >>= 1) v += shx(v, o); return v; }
DI float wave_max(float v) { for (int o = 32; o > 0; o >>= 1) v = fmaxf(v, shx(v, o)); return v; }

DI int orig_col(int n) {
  if (n < 1536) return n;
  if (n < 3712) return n + 8;
  if (n < 3968) return n + 20;
  if (n < 3976) return 1536 + (n - 3968);
  if (n < 3988) return 3720 + (n - 3976);
  return -1;
}

DI bool head_is_paired(int hd);
DI void ph_prologue(const Params& p, int bid, int nblk, char* smem) {
  const long gtid = (long)bid * 256 + tid_opaque(), gsz = (long)nblk * 256;
  if (gtid < 64) p.CTR()[gtid] = 0;
  for (long idx = gtid; idx < 2L * 128 * NP; idx += gsz) {
    const int n = (int)(idx % NP), k8 = (int)((idx / NP) % 128), l = (int)(idx / (NP * 128));
    const int pp = n & 63, w_ = pp >> 5, rr = pp & 31, n_ = rr >> 4, fq_ = (rr >> 2) & 3, j_ = rr & 3;
    const int lc = head_is_paired(n >> 6) ? (32 * n_ + 16 * w_ + 4 * fq_ + j_) : (32 * w_ + 8 * fq_ + 4 * n_ + j_);
    const int oc = orig_col((n & ~63) + lc);
    unsigned w[4];
    for (int j = 0; j < 4; ++j) {
      float a = 0.f, b = 0.f;
      if (oc >= 0) { a = p.w_in[((size_t)l * 1024 + k8 * 8 + 2 * j) * 3988 + oc]; b = p.w_in[((size_t)l * 1024 + k8 * 8 + 2 * j + 1) * 3988 + oc]; }
      w[j] = (unsigned)f2h(a) | ((unsigned)f2h(b) << 16);
    }
    *(uint4*)(p.WT() + ((size_t)l * NP + n) * 1024 + k8 * 8) = make_uint4(w[0], w[1], w[2], w[3]);
  }
  for (long idx = gtid; idx < 2L * 128 * 1024; idx += gsz) {
    const int d = (int)(idx % 1024), m8 = (int)((idx / 1024) % 128), l = (int)(idx / (1024 * 128));
    unsigned w[4];
    for (int j = 0; j < 4; ++j) {
      float a = p.w_out[((size_t)l * 1024 + m8 * 8 + 2 * j) * 1024 + d], b = p.w_out[((size_t)l * 1024 + m8 * 8 + 2 * j + 1) * 1024 + d];
      w[j] = (unsigned)f2bf(a) | ((unsigned)f2bf(b) << 16);
    }
    *(uint4*)(p.WOT() + ((size_t)l * 1024 + d) * 1024 + m8 * 8) = make_uint4(w[0], w[1], w[2], w[3]);
  }
  for (long idx = gtid; idx < 4L * 256 * 64; idx += gsz) {
    const int j = (int)(idx % 64), i8 = (int)((idx / 64) % 256), lk = (int)(idx / (64 * 256));
    unsigned w[4];
    for (int e = 0; e < 4; ++e) {
      const float a = p.w1[((size_t)lk * 2048 + i8 * 8 + 2 * e) * 64 + j], b = p.w1[((size_t)lk * 2048 + i8 * 8 + 2 * e + 1) * 64 + j];
      w[e] = (unsigned)f2bf(a) | ((unsigned)f2bf(b) << 16);
    }
    *(uint4*)(p.W1T() + ((((size_t)lk * 128 + (i8 >> 1)) * 2 + (j >> 5)) * 64 + (i8 & 1) * 32 + (j & 31)) * 8) = make_uint4(w[0], w[1], w[2], w[3]);
  }
  for (long idx = gtid; idx < 4L * 64 * 64; idx += gsz) {
    const int jo = (int)(idx % 64), ji = (int)((idx / 64) % 64), lk = (int)(idx / 4096);
    p.W2T()[((size_t)lk * 64 + jo) * 64 + ji] = f2bf(p.w2[((size_t)lk * 64 + ji) * 64 + jo]);
  }
  if (bid < 64) {
    const int lk = bid >> 4, seg = bid & 15, j = tid_opaque() & 63, part = tid_opaque() >> 6;
    float a = 0.f;
    const int i0 = seg * 128 + part * 32;
#pragma unroll 8
    for (int i = i0; i < i0 + 32; ++i) a += p.pe[(size_t)lk * 2048 + i] * p.w1[((size_t)lk * 2048 + i) * 64 + j];
    float* red = (float*)smem;
    __syncthreads();
    red[part * 64 + j] = a;
    __syncthreads();
    if (part == 0) atomicAdd(p.CVEC() + lk * 64 + j, (red[j] + red[64 + j]) + (red[128 + j] + red[192 + j]));
    __syncthreads();
  }
  for (long idx = gtid; idx < 2L * NP; idx += gsz) {
    const int n = (int)(idx % NP), l = (int)(idx / NP); const int oc = orig_col(n);
    p.BIASP()[idx] = oc >= 0 ? p.b_in[l * 3988 + oc] : 0.f;
  }
  for (long idx = gtid; idx < (long)T * 32; idx += gsz) {
    const int t = (int)(idx / 32), i = (int)(idx % 32);
    const float inv = exp2f(-(float)i * (13.287712379549449f / 32.0f));
    const float ang = (float)t * inv;
    p.ROPEC()[idx] = cosf(ang); p.ROPES()[idx] = sinf(ang);
  }
  for (long idx = gtid; idx < 512; idx += gsz) {
    const int c = (int)(idx % 256), l = (int)(idx / 256);
    const float a = p.c_lb[c], b = p.c_lb[256 + c];
    const float m = fmaxf(a, b); const float ea = expf(a - m), eb = expf(b - m);
    p.LB()[idx] = l == 0 ? 0.f : eb / (ea + eb);
  }
}

DI void ln_rows(const Params& p, int mode, int layer, int bid, int nblk) {
  const int tid_ = tid_opaque(); const int lane = tid_ & 63, wid = tid_ >> 6, nw = 4;
  const float* g = mode == 0 ? p.ln0_g : p.ln_g + layer * 1024;
  const float* bb = mode == 0 ? p.ln0_b : p.ln_b + layer * 1024;
  const float* src = mode == 0 ? p.x : p.hf;
  const int stride = nblk * nw;
  int row = bid * nw + wid;
  f32x4 nx[4];
  if (row < NTOK) {
#pragma unroll
    for (int i = 0; i < 4; ++i) nx[i] = *(const f32x4*)(src + (size_t)row * 1024 + i * 256 + lane * 4);
  }
  for (; row < NTOK; row += stride) {
    f32x4 v[4];
#pragma unroll
    for (int i = 0; i < 4; ++i) v[i] = nx[i];
    if (row + stride < NTOK) {
#pragma unroll
      for (int i = 0; i < 4; ++i) nx[i] = *(const f32x4*)(src + (size_t)(row + stride) * 1024 + i * 256 + lane * 4);
    }
    float sum = 0.f;
#pragma unroll
    for (int i = 0; i < 4; ++i) sum += (v[i][0] + v[i][1]) + (v[i][2] + v[i][3]);
    sum = wave_sum(sum);
    const float mu = sum * (1.f / 1024.f);
    float q = 0.f;
#pragma unroll
    for (int i = 0; i < 4; ++i) { const f32x4 d = v[i] - mu; q += (d[0] * d[0] + d[1] * d[1]) + (d[2] * d[2] + d[3] * d[3]); }
    q = wave_sum(q);
    const float rs = rsqrtf(q * (1.f / 1024.f) + 1e-5f);
#pragma unroll
    for (int i = 0; i < 4; ++i) {
      const int c0 = i * 256 + lane * 4;
      const f32x4 gg = *(const f32x4*)(g + c0), b4 = *(const f32x4*)(bb + c0);
      const f32x4 o = (v[i] - mu) * rs * gg + b4;
      uint2 pk; pk.x = (unsigned)f2h(o[0]) | ((unsigned)f2h(o[1]) << 16); pk.y = (unsigned)f2h(o[2]) | ((unsigned)f2h(o[3]) << 16);
      *(uint2*)(p.HB() + (size_t)row * 1024 + c0) = pk;
    }
  }
}

typedef float f32x2 __attribute__((ext_vector_type(2)));
typedef __bf16 bf16v2 __attribute__((ext_vector_type(2)));
typedef unsigned u32x2 __attribute__((ext_vector_type(2)));
typedef _Float16 f16v2 __attribute__((ext_vector_type(2)));
DI unsigned pack2h(float a, float b) { f32x2 v = {a, b}; return __builtin_bit_cast(unsigned, __builtin_convertvector(v, f16v2)); }
DI unsigned pack2(float a, float b) { f32x2 v = {a, b}; return __builtin_bit_cast(unsigned, __builtin_convertvector(v, bf16v2)); }
DI f32x16 zero16() { f32x16 z;
#pragma unroll
  for (int i = 0; i < 16; ++i) z[i] = 0.f; return z; }
DI bf16x8 ld_frag8x2(const bf16_t* p) { const u32x2 lo = *(const u32x2*)p, hi = *(const u32x2*)(p + 8); u32x4 t = {lo.x, lo.y, hi.x, hi.y}; return __builtin_bit_cast(bf16x8, t); }
template <int BASE> DI bf16x8 pack8(const f32x16& s) {
  u32x4 t = {pack2(s[BASE + 0], s[BASE + 1]), pack2(s[BASE + 2], s[BASE + 3]), pack2(s[BASE + 4], s[BASE + 5]), pack2(s[BASE + 6], s[BASE + 7])};
  return __builtin_bit_cast(bf16x8, t);
}
DI int crow(int r, int h2) { return (r & 3) + 8 * (r >> 2) + 4 * h2; }
DI float max3f(float a, float b, float c) { float r; asm("v_max3_f32 %0, %1, %2, %3" : "=v"(r) : "v"(a), "v"(b), "v"(c)); return r; }
DI float max16(const f32x16& s) {
  float m = max3f(s[0], s[1], s[2]);
#pragma unroll
  for (int r = 3; r < 15; r += 2) m = max3f(m, s[r], s[r + 1]);
  return max3f(m, s[15], s[15]);
}
#define MFMA32(a, b, c) __builtin_amdgcn_mfma_f32_32x32x16_bf16((a), (b), (c), 0, 0, 0)
typedef _Float16 f16x8 __attribute__((ext_vector_type(8)));
typedef _Float16 f16x4 __attribute__((ext_vector_type(4)));
#define LAS __attribute__((address_space(3)))
enum { K_NONE = 0, K_ROPE, K_PLAIN, K_TR, K_GSILU, K_GSIG, K_SILUH, K_LOGF, K_SMALL };
namespace g8 {
constexpr int BK = 64, HALF = 128, HT = HALF * BK;
DI int lds_byte(int r, int c) { const int st = (r >> 4) * 2 + (c >> 5), rr = r & 15, cc = c & 31, ob = rr * 64 + cc * 2; return st * 1024 + (ob ^ (((ob >> 9) & 1) << 5)); }
DI void stage_rc(int b, int& R, int& C) { const int st = b / 1024, sb = b % 1024, swz = sb ^ (((sb >> 9) & 1) << 5); R = (st >> 1) * 16 + swz / 64; C = (st & 1) * 32 + (swz % 64) / 2; }
}
template <bool F16>
DI void gemm256_mainloop(const bf16_t* A, const bf16_t* Bt, bf16_t* shm, f32x4 (&acc)[2][2][4][2]) {
  using namespace g8;
  constexpr int K = 1024;
#define SA(b, h) (shm + ((b) * 2 + (h)) * HT)
#define SB(b, h) (shm + (4 + (b) * 2 + (h)) * HT)
#define STAGE(P, BASE, br, kt) do { const long g_ = (long)(br) * K + (long)(kt) * BK; \
    _Pragma("unroll") for (int i_ = 0; i_ < 2; ++i_) { const int b_ = tidf * 16 + i_ * 8192; int r_, c_; stage_rc(b_, r_, c_); \
      __builtin_amdgcn_global_load_lds((const unsigned*)((BASE) + g_ + (long)r_ * K + c_), (LAS unsigned*)((char*)(P) + b_), 16, 0, 0); } } while (0)
#define LDA(dst, b, h) _Pragma("unroll") for (int m = 0; m < 4; ++m) _Pragma("unroll") for (int k = 0; k < 2; ++k) \
    dst[m][k] = *reinterpret_cast<const bf16x8*>((const char*)SA(b, h) + lds_byte(wr * 64 + m * 16 + fr, k * 32 + fq * 8))
#define LDB(dst, b, h) _Pragma("unroll") for (int n = 0; n < 2; ++n) _Pragma("unroll") for (int k = 0; k < 2; ++k) \
    dst[n][k] = *reinterpret_cast<const bf16x8*>((const char*)SB(b, h) + lds_byte(wc * 32 + n * 16 + fr, k * 32 + fq * 8))
#define MMA(ai, bj, At_, Bt_) do { __builtin_amdgcn_s_setprio(1); \
    _Pragma("unroll") for (int m = 0; m < 4; ++m) _Pragma("unroll") for (int n = 0; n < 2; ++n) _Pragma("unroll") for (int k = 0; k < 2; ++k) \
      acc[ai][bj][m][n] = F16 ? __builtin_amdgcn_mfma_f32_16x16x32_f16(__builtin_bit_cast(f16x8, Bt_[n][k]), __builtin_bit_cast(f16x8, At_[m][k]), acc[ai][bj][m][n], 0, 0, 0) \
                              : __builtin_amdgcn_mfma_f32_16x16x32_bf16(Bt_[n][k], At_[m][k], acc[ai][bj][m][n], 0, 0, 0); \
    __builtin_amdgcn_s_setprio(0); } while (0)
#define WAIT_V(n) asm volatile("s_waitcnt vmcnt(" #n ")" ::: "memory")
#define WAIT_L(n) asm volatile("s_waitcnt lgkmcnt(" #n ")" ::: "memory")
#define BAR __builtin_amdgcn_s_barrier()
#define SCHED __builtin_amdgcn_sched_barrier(0)
  int tidf = threadIdx.x; asm volatile("" : "+v"(tidf));
  const int wid = tidf >> 6, lane = tidf & 63, wr = wid >> 2, wc = wid & 3, fr = lane & 15, fq = lane >> 4;
#pragma unroll
  for (int a = 0; a < 2; ++a)
#pragma unroll
    for (int b = 0; b < 2; ++b)
#pragma unroll
      for (int m = 0; m < 4; ++m)
#pragma unroll
        for (int n = 0; n < 2; ++n) acc[a][b][m][n] = (f32x4){0.f, 0.f, 0.f, 0.f};
  bf16x8 At[4][2], B0[2][2], B1[2][2];
  constexpr int nt = K / BK;
  WAIT_V(0);
  STAGE(SB(0, 0), Bt, 0, 0); STAGE(SA(0, 0), A, 0, 0);
  STAGE(SB(0, 1), Bt, HALF, 0); STAGE(SA(0, 1), A, HALF, 0);
  if (wr == 1) BAR;
  WAIT_V(4); BAR;
  STAGE(SB(1, 0), Bt, 0, 1); STAGE(SA(1, 0), A, 0, 1); STAGE(SB(1, 1), Bt, HALF, 1);
  WAIT_V(6); BAR;
  for (int t = 0; t < nt - 2; t += 2) {
    LDB(B0, 0, 0); SCHED; LDA(At, 0, 0); STAGE(SA(1, 1), A, HALF, t + 1);
    WAIT_L(8); BAR; WAIT_L(0); MMA(0, 0, At, B0); BAR; SCHED;
    LDB(B1, 0, 1); STAGE(SB(0, 0), Bt, 0, t + 2);
    BAR; WAIT_L(0); MMA(0, 1, At, B1); BAR;
    LDA(At, 0, 1); STAGE(SA(0, 0), A, 0, t + 2);
    BAR; WAIT_L(0); MMA(1, 0, At, B0); BAR; SCHED;
    STAGE(SB(0, 1), Bt, HALF, t + 2);
    WAIT_V(6); BAR; MMA(1, 1, At, B1); BAR;
    LDB(B0, 1, 0); SCHED; LDA(At, 1, 0); STAGE(SA(0, 1), A, HALF, t + 2);
    WAIT_L(8); BAR; WAIT_L(0); MMA(0, 0, At, B0); BAR; SCHED;
    LDB(B1, 1, 1); STAGE(SB(1, 0), Bt, 0, t + 3);
    BAR; WAIT_L(0); MMA(0, 1, At, B1); BAR;
    LDA(At, 1, 1); STAGE(SA(1, 0), A, 0, t + 3);
    BAR; WAIT_L(0); MMA(1, 0, At, B0); BAR; SCHED;
    STAGE(SB(1, 1), Bt, HALF, t + 3);
    WAIT_V(6); BAR; MMA(1, 1, At, B1); BAR;
  }
  { LDB(B0, 0, 0); LDA(At, 0, 0); STAGE(SA(1, 1), A, HALF, nt - 1);
    BAR; WAIT_L(0); MMA(0, 0, At, B0); BAR;
    LDB(B1, 0, 1); BAR; WAIT_L(0); MMA(0, 1, At, B1); BAR;
    LDA(At, 0, 1); WAIT_V(4); BAR; WAIT_L(0); MMA(1, 0, At, B0); MMA(1, 1, At, B1); BAR; }
  { LDB(B0, 1, 0); LDA(At, 1, 0); WAIT_V(2); BAR; WAIT_L(0); MMA(0, 0, At, B0); BAR;
    LDB(B1, 1, 1); WAIT_V(0); BAR; WAIT_L(0); MMA(0, 1, At, B1); BAR;
    LDA(At, 1, 1); BAR; WAIT_L(0); MMA(1, 0, At, B0); MMA(1, 1, At, B1); BAR; }
  if (wr == 0) BAR;
#undef SA
#undef SB
#undef STAGE
#undef LDA
#undef LDB
#undef MMA
#undef WAIT_V
#undef WAIT_L
#undef BAR
#undef SCHED
}

DI void classify_head(const Params& p, int hd, int b, int& kind, bf16_t*& dst, float*& fdst, float& scale) {
  kind = K_NONE; dst = nullptr; fdst = nullptr; scale = 1.f;
  if (hd < 4) { kind = K_ROPE; dst = p.QA() + ((size_t)(b * 4 + hd) * T) * 64; scale = 0.125f * 1.4426950408889634f; }
  else if (hd < 6) { kind = K_ROPE; dst = p.KA() + ((size_t)(b * 2 + hd - 4) * T) * 64; }
  else if (hd < 8) { kind = K_TR; dst = p.VAT() + (size_t)(b * 2 + hd - 6) * 64 * T; }
  else if (hd < 12) { kind = K_GSILU; dst = p.GZ() + (size_t)0 * NTOK * 256 + (hd - 8) * 64; }
  else if (hd < 20) { kind = K_PLAIN; dst = p.QKB() + ((size_t)(b * 8 + hd - 12) * T) * 64; }
  else if (hd < 24) { kind = K_TR; dst = p.VBT() + (size_t)(b * 4 + hd - 20) * 64 * T; }
  else if (hd < 28) { kind = K_GSIG; dst = p.GZ() + (size_t)1 * NTOK * 256 + (hd - 24) * 64; }
  else if (hd < 32) { kind = K_GSILU; dst = p.GZ() + (size_t)2 * NTOK * 256 + (hd - 28) * 64; }
  else if (hd < 36) { kind = K_SILUH; dst = p.QC() + ((size_t)(b * 4 + hd - 32) * T) * 64; }
  else if (hd < 40) { kind = K_LOGF; fdst = p.GC() + ((size_t)(b * 4 + hd - 36) * T) * 64; }
  else if (hd < 44) { kind = K_TR; dst = p.VCT() + (size_t)(b * 4 + hd - 40) * 64 * T; }
  else if (hd < 48) { kind = K_GSILU; dst = p.GZ() + (size_t)3 * NTOK * 256 + (hd - 44) * 64; }
  else if (hd < 52) { kind = K_ROPE; dst = p.QD() + ((size_t)(b * 4 + hd - 48) * T) * 64; scale = 0.125f * 1.4426950408889634f; }
  else if (hd < 58) {
    const int j = hd - 52;
    dst = p.KV() + (size_t)(j * NB + b) * T * 64;
    kind = (j == 0 || j == 1) ? K_PLAIN : ((j == 2 || j == 4) ? K_ROPE : K_TR);
  }
  else if (hd < 62) { kind = K_GSILU; dst = p.GZ() + (size_t)4 * NTOK * 256 + (hd - 58) * 64; }
  else if (hd == 62) { kind = K_SMALL; }
}

DI bool head_is_paired(int hd) { return hd < 6 || (hd >= 48 && hd < 52) || hd == 54 || hd == 56; }
template <int KIND>
DI void epi_direct(const Params& p, const f32x4 (&a)[4][2], bf16_t* dst, float* fdst, float scale, int layer, int hd, int b, int tq, int wr, int w, int fr, int fq) {
  if (KIND == K_ROPE) {
    const int c = 16 * w + 4 * fq;
    const f32x4 b0 = *(const f32x4*)(p.BIASP() + layer * NP + hd * 64 + c), b1 = *(const f32x4*)(p.BIASP() + layer * NP + hd * 64 + 32 + c);
#pragma unroll
    for (int m = 0; m < 4; ++m) {
      const int t = tq + wr * 64 + m * 16 + fr;
      const f32x4 cs = *(const f32x4*)(p.ROPEC() + t * 32 + c), sn = *(const f32x4*)(p.ROPES() + t * 32 + c);
      const f32x4 v0 = a[m][0] + b0, v1 = a[m][1] + b1;
      const f32x4 o0 = (v0 * cs - v1 * sn) * scale, o1 = (v0 * sn + v1 * cs) * scale;
      u32x2 w0 = {pack2(o0[0], o0[1]), pack2(o0[2], o0[3])}, w1 = {pack2(o1[0], o1[1]), pack2(o1[2], o1[3])};
      *(u32x2*)(dst + (size_t)t * 64 + c) = w0; *(u32x2*)(dst + (size_t)t * 64 + 32 + c) = w1;
    }
    return;
  }
  const int c = 32 * w + 8 * fq;
  const f32x4 b0 = *(const f32x4*)(p.BIASP() + layer * NP + hd * 64 + c), b1 = *(const f32x4*)(p.BIASP() + layer * NP + hd * 64 + c + 4);
  if (KIND == K_SMALL) {
#pragma unroll
    for (int m = 0; m < 4; ++m) {
      const size_t tok = (size_t)b * T + tq + wr * 64 + m * 16 + fr;
#pragma unroll
      for (int n = 0; n < 2; ++n)
#pragma unroll
        for (int j = 0; j < 4; ++j) {
          const int cc = c + 4 * n + j;
          const float v = a[m][n][j] + (n ? b1[j] : b0[j]);
          if (cc < 8) p.IFG()[tok * 8 + cc] = v;
          else if (cc < 20) p.DG()[tok * 12 + (cc - 8)] = sigmoidf_(v);
        }
    }
    return;
  }
  f32x4 lb0 = {0.f, 0.f, 0.f, 0.f}, lb1 = {0.f, 0.f, 0.f, 0.f};
  if (KIND == K_LOGF) { lb0 = *(const f32x4*)(p.LB() + layer * 256 + (hd - 36) * 64 + c); lb1 = *(const f32x4*)(p.LB() + layer * 256 + (hd - 36) * 64 + c + 4); }
#pragma unroll
  for (int m = 0; m < 4; ++m) {
    const int t = tq + wr * 64 + m * 16 + fr;
    const f32x4 v0 = a[m][0] + b0, v1 = a[m][1] + b1;
    if (KIND == K_LOGF) {
      f32x4 o0, o1;
#pragma unroll
      for (int j = 0; j < 4; ++j) { o0[j] = __logf(lb0[j] + (1.f - lb0[j]) * sigmoidf_(v0[j])); o1[j] = __logf(lb1[j] + (1.f - lb1[j]) * sigmoidf_(v1[j])); }
      *(f32x4*)(fdst + (size_t)t * 64 + c) = o0; *(f32x4*)(fdst + (size_t)t * 64 + c + 4) = o1;
    } else {
      f32x4 o0, o1;
#pragma unroll
      for (int j = 0; j < 4; ++j) {
        if (KIND == K_PLAIN) { o0[j] = v0[j]; o1[j] = v1[j]; }
        else if (KIND == K_SILUH || KIND == K_GSILU) { o0[j] = siluf_(v0[j]); o1[j] = siluf_(v1[j]); }
        else { o0[j] = sigmoidf_(v0[j]); o1[j] = sigmoidf_(v1[j]); }
      }
      u32x4 wv = {pack2(o0[0], o0[1]), pack2(o0[2], o0[3]), pack2(o1[0], o1[1]), pack2(o1[2], o1[3])};
      if (KIND == K_GSILU || KIND == K_GSIG) *(u32x4*)(dst + ((size_t)b * T + t) * 256 + c) = wv;
      else *(u32x4*)(dst + (size_t)t * 64 + c) = wv;
    }
  }
}
DI void epi_tr_write(const Params& p, const f32x4 (&a)[4][2], char* img, int layer, int hd, int wr, int w, int fr, int fq) {
  const int c = 32 * w + 8 * fq;
  const f32x4 b0 = *(const f32x4*)(p.BIASP() + layer * NP + hd * 64 + c), b1 = *(const f32x4*)(p.BIASP() + layer * NP + hd * 64 + c + 4);
  bf16_t* timg = (bf16_t*)img;
#pragma unroll
  for (int m = 0; m < 4; ++m)
#pragma unroll
    for (int n = 0; n < 2; ++n)
#pragma unroll
      for (int j = 0; j < 4; ++j) timg[(c + 4 * n + j) * 128 + wr * 64 + m * 16 + fr] = f2bf(a[m][n][j] + (n ? b1[j] : b0[j]));
}
DI void gemm_in_quadrant(const Params& p, int layer, int panel, int pn, int ai, int bj, const f32x4 (&a)[4][2], char* shm,
                         int b, int hq, int tid2, int wr, int wc, int fr, int fq) {
  const int tq = (panel & 7) * 256 + ai * 128;
  const int hd0 = pn * 4 + bj * 2;
  const int hd = hd0 + (wc >> 1), w = wc & 1;
  int kind; bf16_t* dst; float* fdst; float scale;
  classify_head(p, hd, b, kind, dst, fdst, scale);
  switch (kind) {
    case K_ROPE: epi_direct<K_ROPE>(p, a, dst, fdst, scale, layer, hd, b, tq, wr, w, fr, fq); break;
    case K_PLAIN: epi_direct<K_PLAIN>(p, a, dst, fdst, scale, layer, hd, b, tq, wr, w, fr, fq); break;
    case K_GSILU: epi_direct<K_GSILU>(p, a, dst, fdst, scale, layer, hd, b, tq, wr, w, fr, fq); break;
    case K_GSIG: epi_direct<K_GSIG>(p, a, dst, fdst, scale, layer, hd, b, tq, wr, w, fr, fq); break;
    case K_SILUH: epi_direct<K_SILUH>(p, a, dst, fdst, scale, layer, hd, b, tq, wr, w, fr, fq); break;
    case K_LOGF: epi_direct<K_LOGF>(p, a, dst, fdst, scale, layer, hd, b, tq, wr, w, fr, fq); break;
    case K_SMALL: epi_direct<K_SMALL>(p, a, dst, fdst, scale, layer, hd, b, tq, wr, w, fr, fq); break;
    default: break;
  }
  int k0, k1; { bf16_t* d_; float* f_; float s_; classify_head(p, hd0, b, k0, d_, f_, s_); classify_head(p, hd0 + 1, b, k1, d_, f_, s_); }
  if (k0 == K_TR || k1 == K_TR) {
    if (kind == K_TR) epi_tr_write(p, a, shm + (wc >> 1) * 16384, layer, hd, wr, w, fr, fq);
    __syncthreads();
    int kq; bf16_t* dq; float* fq_; float sq; classify_head(p, hd0 + hq, b, kq, dq, fq_, sq);
    if (kq == K_TR) {
      const char* img = shm + hq * 16384;
#pragma unroll
      for (int i = 0; i < 4; ++i) { const int q = tid2 + 256 * i, cc = q >> 4, rc = q & 15; *(u32x4*)(dq + (size_t)cc * T + tq + rc * 8) = *(const u32x4*)(img + q * 16); }
    }
    __syncthreads();
  }
}
template <int KIND, int BJ, int PASS>
DI void epi2_write(const Params& p, const f32x4 (&acc)[2][2][4][2], char* img, float scale, int layer, int hd, int tbase, int wr, int w, int fr, int fq) {
  if (KIND == K_ROPE) {
    const int c = 16 * w + 4 * fq;
    const f32x4 b0 = *(const f32x4*)(p.BIASP() + layer * NP + hd * 64 + c), b1 = *(const f32x4*)(p.BIASP() + layer * NP + hd * 64 + 32 + c);
    const int ch0 = 2 * w + (fq >> 1), sub = (fq & 1) * 8;
#pragma unroll
    for (int ai = 0; ai < 2; ++ai)
#pragma unroll
      for (int m = 0; m < 4; ++m) {
        const int row = ai * 128 + wr * 64 + m * 16 + fr, t = tbase + row;
        const f32x4 cs = *(const f32x4*)(p.ROPEC() + t * 32 + c), sn = *(const f32x4*)(p.ROPES() + t * 32 + c);
        const f32x4 v0 = acc[ai][BJ][m][0] + b0, v1 = acc[ai][BJ][m][1] + b1;
        const f32x4 o0 = (v0 * cs - v1 * sn) * scale, o1 = (v0 * sn + v1 * cs) * scale;
        u32x2 w0 = {pack2(o0[0], o0[1]), pack2(o0[2], o0[3])}, w1 = {pack2(o1[0], o1[1]), pack2(o1[2], o1[3])};
        *(u32x2*)(img + row * 128 + ((ch0 ^ (fr & 7)) * 16) + sub) = w0;
        *(u32x2*)(img + row * 128 + (((ch0 + 4) ^ (fr & 7)) * 16) + sub) = w1;
      }
    return;
  }
  const int c = 32 * w + 8 * fq;
  const f32x4 b0 = *(const f32x4*)(p.BIASP() + layer * NP + hd * 64 + c), b1 = *(const f32x4*)(p.BIASP() + layer * NP + hd * 64 + c + 4);
  if (KIND == K_TR) {
    bf16_t* timg = (bf16_t*)img;
#pragma unroll
    for (int ai = 0; ai < 2; ++ai)
#pragma unroll
      for (int m = 0; m < 4; ++m)
#pragma unroll
        for (int n = 0; n < 2; ++n)
#pragma unroll
          for (int j = 0; j < 4; ++j) timg[(c + 4 * n + j) * 256 + ai * 128 + wr * 64 + m * 16 + fr] = f2bf(acc[ai][BJ][m][n][j] + (n ? b1[j] : b0[j]));
    return;
  }
  if (KIND == K_LOGF) {
    const f32x4 lb0 = *(const f32x4*)(p.LB() + layer * 256 + (hd - 36) * 64 + c), lb1 = *(const f32x4*)(p.LB() + layer * 256 + (hd - 36) * 64 + c + 4);
    float* fimg = (float*)img;
#pragma unroll
    for (int m = 0; m < 4; ++m) {
      const f32x4 v0 = acc[PASS][BJ][m][0] + b0, v1 = acc[PASS][BJ][m][1] + b1;
      f32x4 o0, o1;
#pragma unroll
      for (int j = 0; j < 4; ++j) { o0[j] = __logf(lb0[j] + (1.f - lb0[j]) * sigmoidf_(v0[j])); o1[j] = __logf(lb1[j] + (1.f - lb1[j]) * sigmoidf_(v1[j])); }
      const int row = wr * 64 + m * 16 + fr;
      *(f32x4*)(fimg + row * 64 + c) = o0; *(f32x4*)(fimg + row * 64 + c + 4) = o1;
    }
    return;
  }
  const int ch = 4 * w + fq;
#pragma unroll
  for (int ai = 0; ai < 2; ++ai)
#pragma unroll
    for (int m = 0; m < 4; ++m) {
      const int row = ai * 128 + wr * 64 + m * 16 + fr;
      const f32x4 v0 = acc[ai][BJ][m][0] + b0, v1 = acc[ai][BJ][m][1] + b1;
      f32x4 o0, o1;
#pragma unroll
      for (int j = 0; j < 4; ++j) {
        if (KIND == K_PLAIN) { o0[j] = v0[j]; o1[j] = v1[j]; }
        else if (KIND == K_SILUH || KIND == K_GSILU) { o0[j] = siluf_(v0[j]); o1[j] = siluf_(v1[j]); }
        else { o0[j] = sigmoidf_(v0[j]); o1[j] = sigmoidf_(v1[j]); }
      }
      u32x4 wv = {pack2(o0[0], o0[1]), pack2(o0[2], o0[3]), pack2(o1[0], o1[1]), pack2(o1[2], o1[3])};
      *(u32x4*)(img + row * 128 + ((ch ^ (fr & 7)) * 16)) = wv;
    }
}
template <int BJ, int PASS>
DI void epi2_write_head(const Params& p, int layer, int pn, const f32x4 (&acc)[2][2][4][2], char* shm, int b, int tbase, int wr, int wc, int fr, int fq) {
  const int w = wc & 1, hq = BJ * 2 + (wc >> 1), hd = pn * 4 + hq;
  int kind; bf16_t* dst; float* fdst; float scale;
  classify_head(p, hd, b, kind, dst, fdst, scale);
  char* img = shm + hq * 32768;
  switch (kind) {
    case K_ROPE: epi2_write<K_ROPE, BJ, PASS>(p, acc, img, scale, layer, hd, tbase, wr, w, fr, fq); break;
    case K_PLAIN: epi2_write<K_PLAIN, BJ, PASS>(p, acc, img, scale, layer, hd, tbase, wr, w, fr, fq); break;
    case K_TR: epi2_write<K_TR, BJ, PASS>(p, acc, img, scale, layer, hd, tbase, wr, w, fr, fq); break;
    case K_GSILU: epi2_write<K_GSILU, BJ, PASS>(p, acc, img, scale, layer, hd, tbase, wr, w, fr, fq); break;
    case K_GSIG: epi2_write<K_GSIG, BJ, PASS>(p, acc, img, scale, layer, hd, tbase, wr, w, fr, fq); break;
    case K_SILUH: epi2_write<K_SILUH, BJ, PASS>(p, acc, img, scale, layer, hd, tbase, wr, w, fr, fq); break;
    case K_LOGF: epi2_write<K_LOGF, BJ, PASS>(p, acc, img, scale, layer, hd, tbase, wr, w, fr, fq); break;
    case K_SMALL: {
      const int c = 32 * w + 8 * fq;
      const f32x4 b0 = *(const f32x4*)(p.BIASP() + layer * NP + hd * 64 + c), b1 = *(const f32x4*)(p.BIASP() + layer * NP + hd * 64 + c + 4);
#pragma unroll
      for (int ai = 0; ai < 2; ++ai)
#pragma unroll
        for (int m = 0; m < 4; ++m) {
          const size_t tok = (size_t)b * T + tbase + ai * 128 + wr * 64 + m * 16 + fr;
#pragma unroll
          for (int n = 0; n < 2; ++n)
#pragma unroll
            for (int j = 0; j < 4; ++j) {
              const int cc = c + 4 * n + j;
              const float v = acc[ai][BJ][m][n][j] + (n ? b1[j] : b0[j]);
              if (cc < 8) p.IFG()[tok * 8 + cc] = v;
              else if (cc < 20) p.DG()[tok * 12 + (cc - 8)] = sigmoidf_(v);
            }
        }
    } break;
    default: break;
  }
}
template <int PASS>
DI void epi2_pass(const Params& p, int layer, int panel, int pn, const f32x4 (&acc)[2][2][4][2], char* shm, int tidf) {
  const int wid = tidf >> 6, lane = tidf & 63, wr = wid >> 2, wc = wid & 3, fr = lane & 15, fq = lane >> 4;
  const int b = panel >> 3, tbase = (panel & 7) * 256;
  epi2_write_head<0, PASS>(p, layer, pn, acc, shm, b, tbase, wr, wc, fr, fq);
  epi2_write_head<1, PASS>(p, layer, pn, acc, shm, b, tbase, wr, wc, fr, fq);
  __syncthreads();
  {
    const int hq = wid >> 1, hd = pn * 4 + hq, half = wid & 1;
    int kind; bf16_t* dst; float* fdst; float scale;
    classify_head(p, hd, b, kind, dst, fdst, scale);
    const char* img = shm + hq * 32768;
    if (kind == K_LOGF) {
#pragma unroll 4
      for (int i = 0; i < 16; ++i) {
        const int pi = half * 16 + i;
        const u32x4 v = *(const u32x4*)(img + pi * 1024 + lane * 16);
        const int row = 4 * pi + (lane >> 4), ch = lane & 15;
        *(u32x4*)(fdst + (size_t)(tbase + PASS * 128 + row) * 64 + ch * 4) = v;
      }
    } else if (kind == K_TR) {
#pragma unroll 4
      for (int i = 0; i < 16; ++i) {
        const int pi = half * 16 + i;
        const u32x4 v = *(const u32x4*)(img + pi * 1024 + lane * 16);
        const int d = 2 * pi + (lane >> 5), tc = lane & 31;
        *(u32x4*)(dst + (size_t)d * T + tbase + tc * 8) = v;
      }
    } else if (kind == K_ROPE || kind == K_PLAIN || kind == K_SILUH || kind == K_GSILU || kind == K_GSIG) {
      const bool gate = (kind == K_GSILU || kind == K_GSIG);
#pragma unroll 4
      for (int i = 0; i < 16; ++i) {
        const int pi = half * 16 + i;
        const int rl = lane >> 3, chl = lane & 7, row = 8 * pi + rl;
        const u32x4 v = *(const u32x4*)(img + row * 128 + ((chl ^ rl) * 16));
        if (gate) *(u32x4*)(dst + ((size_t)b * T + tbase + row) * 256 + chl * 8) = v;
        else *(u32x4*)(dst + (size_t)(tbase + row) * 64 + chl * 8) = v;
      }
    }
  }
  __syncthreads();
}
DI void gemm_in_epilogue(const Params& p, int layer, int panel, int pn, const f32x4 (&acc)[2][2][4][2], char* shm) {
  int tidf = threadIdx.x; asm volatile("" : "+v"(tidf));
  __syncthreads();
  epi2_pass<0>(p, layer, panel, pn, acc, shm, tidf);
  if (pn == 9) epi2_pass<1>(p, layer, panel, pn, acc, shm, tidf);
}
DI void ph_gemm_in(const Params& p, int layer, int bid, int nblk, char* shm) {
  asm volatile("" : "+s"(bid));
  if (nblk == 256) {
    const int x = bid & 7, c = bid >> 3;
    for (int g = 0; g < 4; ++g) {
      const int panel = 32 * x + 8 * g + (c & 7);
      const bf16_t* A = p.HB() + (size_t)panel * 256 * 1024;
      for (int s = 0; s < 4; ++s) {
        const int pn = (c >> 3) + 4 * s;
        f32x4 acc[2][2][4][2];
        gemm256_mainloop<true>(A, p.WT() + ((size_t)layer * NP + pn * 256) * 1024, (bf16_t*)shm, acc);
        if (PROBE == 6) { __syncthreads(); gemm256_mainloop<true>(A, p.WT() + ((size_t)layer * NP + pn * 256) * 1024, (bf16_t*)shm, acc); }
        gemm_in_epilogue(p, layer, panel, pn, acc, shm);
        if (PROBE == 7) gemm_in_epilogue(p, layer, panel, pn, acc, shm);
      }
    }
    return;
  }
  for (int panel = bid; panel < 256; panel += nblk) {
    const bf16_t* A = p.HB() + (size_t)panel * 256 * 1024;
    for (int pn = 0; pn < 16; ++pn) {
      f32x4 acc[2][2][4][2];
      gemm256_mainloop<true>(A, p.WT() + ((size_t)layer * NP + pn * 256) * 1024, (bf16_t*)shm, acc);
      gemm_in_epilogue(p, layer, panel, pn, acc, shm);
    }
  }
}
DI void gemm_out_epilogue_ln(const Params& p, int layer, int cset, int panel, int pn, f32x4 (&acc)[2][2][4][2], char* shm) {
  int tidf = threadIdx.x; asm volatile("" : "+v"(tidf));
  const int wid = tidf >> 6, lane = tidf & 63, wr = wid >> 2, wc = wid & 3, fr = lane & 15, fq = lane >> 4;
  float* rpart = (float*)(shm + 131072);
  float* rmu = rpart + 2048;
  {
    const bf16_t* hb_tile = p.HB() + (size_t)panel * 256 * 1024 + pn * 256;
#pragma unroll
    for (int i = 0; i < 16; ++i) {
      const int L = i * 512 + tidf, row = L >> 5, c16 = (L & 31) ^ (row & 31);
      __builtin_amdgcn_global_load_lds((const unsigned*)(hb_tile + (size_t)row * 1024 + c16 * 8), (LAS unsigned*)(shm + L * 16), 16, 0, 0);
    }
  }
  asm volatile("s_waitcnt vmcnt(0)" ::: "memory");
  __syncthreads();
  {
#pragma unroll
    for (int ai = 0; ai < 2; ++ai)
#pragma unroll
      for (int m = 0; m < 4; ++m) {
        const int rl = ai * 128 + wr * 64 + m * 16 + fr;
        float s1 = 0.f, s2 = 0.f;
#pragma unroll
        for (int bj = 0; bj < 2; ++bj)
#pragma unroll
          for (int n = 0; n < 2; ++n) {
            const int col = bj * 128 + wc * 32 + n * 16 + fq * 4;
            const u32x2 hr = *(const u32x2*)(shm + (rl * 32 + ((col >> 3) ^ (rl & 31))) * 16 + ((col >> 2) & 1) * 8);
            const f32x4 h = __builtin_convertvector(__builtin_bit_cast(f16x4, hr), f32x4);
            const f32x4 z = DN_ALPHA * h + acc[ai][bj][m][n];
            acc[ai][bj][m][n] = z;
            s1 += (z[0] + z[1]) + (z[2] + z[3]);
            s2 += (z[0] * z[0] + z[1] * z[1]) + (z[2] * z[2] + z[3] * z[3]);
          }
        s1 += shx(s1, 16); s2 += shx(s2, 16);
        s1 = xhalf_sum(s1); s2 = xhalf_sum(s2);
        if (fq == 0) { rpart[(rl * 4 + wc) * 2] = s1; rpart[(rl * 4 + wc) * 2 + 1] = s2; }
      }
  }
  f32x4 gg[2][2], bb[2][2];
#pragma unroll
  for (int bj = 0; bj < 2; ++bj)
#pragma unroll
    for (int n = 0; n < 2; ++n) {
      const int col = pn * 256 + bj * 128 + wc * 32 + n * 16 + fq * 4;
      gg[bj][n] = *(const f32x4*)(p.ln_g + layer * 1024 + col); bb[bj][n] = *(const f32x4*)(p.ln_b + layer * 1024 + col);
    }
  __syncthreads();
  float* xst = p.XST() + ((size_t)(cset * 256 + panel) * 4) * 512;
  if (tidf < 256) {
    const f32x4 a0 = *(const f32x4*)(rpart + tidf * 8), a1 = *(const f32x4*)(rpart + tidf * 8 + 4);
    f32x2 v = {(a0[0] + a0[2]) + (a1[0] + a1[2]), (a0[1] + a0[3]) + (a1[1] + a1[3])};
    __hip_atomic_store((unsigned long long*)(xst + (size_t)pn * 512 + tidf * 2), __builtin_bit_cast(unsigned long long, v), __ATOMIC_RELAXED, __HIP_MEMORY_SCOPE_AGENT);
  }
  asm volatile("s_waitcnt vmcnt(0)" ::: "memory");
  __syncthreads();
  if (tidf == 0) {
    unsigned* cnt = p.XCNT() + (size_t)(cset * 256 + panel) * 64;
    (void)__hip_atomic_fetch_add(cnt, 1u, __ATOMIC_RELAXED, __HIP_MEMORY_SCOPE_AGENT);
    unsigned sp = 0;
    while (__hip_atomic_load(cnt, __ATOMIC_RELAXED, __HIP_MEMORY_SCOPE_AGENT) < 4u) { __builtin_amdgcn_s_sleep(1); if (++sp > (1u << 24)) break; }
    asm volatile("s_waitcnt vmcnt(0)" ::: "memory");
  }
  __syncthreads();
  if (tidf < 256) {
    float S1 = 0.f, S2 = 0.f;
#pragma unroll
    for (int q = 0; q < 4; ++q) {
      const f32x2 v = __builtin_bit_cast(f32x2, __hip_atomic_load((unsigned long long*)(xst + (size_t)q * 512 + tidf * 2), __ATOMIC_RELAXED, __HIP_MEMORY_SCOPE_AGENT));
      S1 += v[0]; S2 += v[1];
    }
    const float mu = S1 * (1.f / 1024.f);
    const float var = fmaxf(S2 * (1.f / 1024.f) - mu * mu, 0.f);
    rmu[tidf * 2] = mu; rmu[tidf * 2 + 1] = rsqrtf(var + 1e-5f);
  }
  __syncthreads();
  if (layer == 0) {
#pragma unroll
    for (int ai = 0; ai < 2; ++ai)
#pragma unroll
      for (int m = 0; m < 4; ++m) {
        const int rl = ai * 128 + wr * 64 + m * 16 + fr;
        const f32x2 ms = *(const f32x2*)(rmu + rl * 2);
#pragma unroll
        for (int bj = 0; bj < 2; ++bj)
#pragma unroll
          for (int n = 0; n < 2; ++n) {
            const int col = bj * 128 + wc * 32 + n * 16 + fq * 4;
            const f32x4 o = (acc[ai][bj][m][n] - ms[0]) * ms[1] * gg[bj][n] + bb[bj][n];
            const u32x2 pk = {pack2h(o[0], o[1]), pack2h(o[2], o[3])};
            *(u32x2*)(shm + (rl * 32 + ((col >> 3) ^ (rl & 31))) * 16 + ((col >> 2) & 1) * 8) = pk;
          }
      }
    __syncthreads();
    bf16_t* hb_tile = p.HB() + (size_t)panel * 256 * 1024 + pn * 256;
#pragma unroll 4
    for (int i = 0; i < 16; ++i) {
      const int L = i * 512 + tidf, row = L >> 5, c16 = (L & 31) ^ (row & 31);
      *(u32x4*)(hb_tile + (size_t)row * 1024 + c16 * 8) = *(const u32x4*)(shm + L * 16);
    }
  } else {
#pragma unroll
    for (int ai = 0; ai < 2; ++ai) {
      if (ai == 1) __syncthreads();
#pragma unroll
      for (int m = 0; m < 4; ++m) {
        const int rh = wr * 64 + m * 16 + fr, rl = ai * 128 + rh;
        const f32x2 ms = *(const f32x2*)(rmu + rl * 2);
#pragma unroll
        for (int bj = 0; bj < 2; ++bj)
#pragma unroll
          for (int n = 0; n < 2; ++n) {
            const int c = bj * 32 + wc * 8 + n * 4 + fq;
            const f32x4 o = (acc[ai][bj][m][n] - ms[0]) * ms[1] * gg[bj][n] + bb[bj][n];
            *(f32x4*)(shm + (rh * 64 + (c ^ (rh & 63))) * 16) = o;
          }
      }
      __syncthreads();
      float* out_tile = p.hf + ((size_t)panel * 256 + ai * 128) * 1024 + pn * 256;
#pragma unroll 4
      for (int i = 0; i < 16; ++i) {
        const int L = i * 512 + tidf, row = L >> 6, c = (L & 63) ^ (row & 63);
        *(u32x4*)(out_tile + (size_t)row * 1024 + c * 4) = *(const u32x4*)(shm + L * 16);
      }
    }
  }
  __syncthreads();
}
DI void ph_gemm_out_ln_x4(const Params& p, int layer, int cset, int bid, char* shm) {
  asm volatile("" : "+s"(bid));
  const int x = bid & 7, c = bid >> 3, pn = c & 3;
  for (int r = 0; r < 4; ++r) {
    const int panel = 64 * r + 8 * x + (c >> 2);
    f32x4 acc[2][2][4][2];
    gemm256_mainloop<false>(p.YMIX() + (size_t)panel * 256 * 1024, p.WOT() + ((size_t)layer * 1024 + pn * 256) * 1024, (bf16_t*)shm, acc);
    if (PROBE == 14) { __syncthreads(); gemm256_mainloop<false>(p.YMIX() + (size_t)panel * 256 * 1024, p.WOT() + ((size_t)layer * 1024 + pn * 256) * 1024, (bf16_t*)shm, acc); }
    gemm_out_epilogue_ln(p, layer, cset, panel, pn, acc, shm);
  }
}
DI f32x16 qk_tile(const bf16_t* Krow, const bf16x8 (&qf)[4], int l31, int h2) {
  f32x16 s = zero16();
  const bf16_t* kp = Krow + l31 * 64 + h2 * 8;
#pragma unroll
  for (int ks = 0; ks < 4; ++ks) { const bf16x8 a = *(const bf16x8*)(kp + ks * 16); s = MFMA32(a, qf[ks], s); }
  return s;
}
DI f32x16 qk_tile_s(const bf16_t* Krow, int stride, const bf16x8 (&qf)[4], int l31, int h2) {
  f32x16 s = zero16();
  const bf16_t* kp = Krow + l31 * stride + h2 * 8;
#pragma unroll
  for (int ks = 0; ks < 4; ++ks) { const bf16x8 a = *(const bf16x8*)(kp + ks * 16); s = MFMA32(a, qf[ks], s); }
  return s;
}
template <bool HAS_SEL>
DI void softmax_pv_t(f32x16& s, const bf16_t* VTp, int vstride, f32x16 (&o)[2], float& m, float& l, int l31, int h2, bool sel) {
  bf16x8 va[2][2];
#pragma unroll
  for (int dt = 0; dt < 2; ++dt)
#pragma unroll
    for (int sk = 0; sk < 2; ++sk) va[dt][sk] = ld_frag8x2(VTp + (size_t)(dt * 32 + l31) * vstride + sk * 16 + 4 * h2);
  float mx = max16(s);
  if (HAS_SEL) mx = sel ? mx : -INFINITY;
  mx = xhalf_max(mx);
  const float mn = fmaxf(m, mx);
  const float alpha = __builtin_amdgcn_exp2f(m - mn);
  const float mref = (HAS_SEL && !sel) ? INFINITY : mn;
  float ps = 0.f;
#pragma unroll
  for (int r = 0; r < 16; ++r) { s[r] = __builtin_amdgcn_exp2f(s[r] - mref); ps += s[r]; }
  l = l * alpha + ps; m = mn;
#pragma unroll
  for (int dt = 0; dt < 2; ++dt)
#pragma unroll
    for (int r = 0; r < 16; ++r) o[dt][r] *= alpha;
  const bf16x8 p0 = pack8<0>(s), p1 = pack8<8>(s);
#pragma unroll
  for (int dt = 0; dt < 2; ++dt) { o[dt] = MFMA32(va[dt][0], p0, o[dt]); o[dt] = MFMA32(va[dt][1], p1, o[dt]); }
}
DI void softmax_pv(f32x16& s, const bf16_t* VTp, int vstride, f32x16 (&o)[2], float& m, float& l, int l31, int h2) { softmax_pv_t<false>(s, VTp, vstride, o, m, l, l31, h2, true); }

constexpr int AD_KSTR = 72, AD_VSTR = 68;
constexpr int AD_BUF = 64 * AD_KSTR * 2 + 64 * AD_VSTR * 2;
struct AdTile { u32x4 k, v; };
DI AdTile ad_load(const bf16_t* Kg, const bf16_t* Vg, int key0, int tidf) {
  AdTile r; const int row = tidf >> 3, ch = tidf & 7;
  r.k = *(const u32x4*)(Kg + (size_t)(key0 + row) * 64 + ch * 8);
  r.v = *(const u32x4*)(Vg + (size_t)row * T + key0 + ch * 8);
  return r;
}
DI void ad_store(const AdTile& r, char* buf, int tidf) {
  const int row = tidf >> 3, ch = tidf & 7;
  *(u32x4*)(buf + (row * AD_KSTR + ch * 8) * 2) = r.k;
  char* vp = buf + 64 * AD_KSTR * 2 + (row * AD_VSTR + ch * 8) * 2;
  *(u32x2*)vp = (u32x2){r.v[0], r.v[1]}; *(u32x2*)(vp + 8) = (u32x2){r.v[2], r.v[3]};
}
template <bool HAS_SEL>
DI void softmax_pv64(const bf16_t* Kb, const bf16_t* Vb, const bf16x8 (&qf)[4], f32x16 (&o)[2], float& m, float& l, int l31, int h2, bool sel) {
  bf16x8 ka[2][4];
  {
    const bf16_t* kp = Kb + l31 * AD_KSTR + h2 * 8;
#pragma unroll
    for (int ks = 0; ks < 4; ++ks) { ka[0][ks] = *(const bf16x8*)(kp + ks * 16); ka[1][ks] = *(const bf16x8*)(kp + 32 * AD_KSTR + ks * 16); }
  }
  __builtin_amdgcn_sched_barrier(0);
  f32x16 s0 = zero16(), s1 = zero16();
#pragma unroll
  for (int ks = 0; ks < 4; ++ks) { s0 = MFMA32(ka[0][ks], qf[ks], s0); s1 = MFMA32(ka[1][ks], qf[ks], s1); }
  bf16x8 va[2][4];
#pragma unroll
  for (int dt = 0; dt < 2; ++dt) {
    const bf16_t* vp = Vb + (size_t)(dt * 32 + l31) * AD_VSTR + 4 * h2;
#pragma unroll
    for (int q = 0; q < 4; ++q) va[dt][q] = ld_frag8x2(vp + 16 * q);
  }
  __builtin_amdgcn_sched_barrier(0);
  float mx; { const float ma = max16(s0), mb = max16(s1); mx = max3f(ma, mb, mb); }
  if (HAS_SEL) mx = sel ? mx : -INFINITY;
  mx = xhalf_max(mx);
  const float mn = fmaxf(m, mx);
  const float alpha = __builtin_amdgcn_exp2f(m - mn);
  const float mref = (HAS_SEL && !sel) ? INFINITY : mn;
  float ps = 0.f;
#pragma unroll
  for (int r = 0; r < 16; ++r) { s0[r] = __builtin_amdgcn_exp2f(s0[r] - mref); s1[r] = __builtin_amdgcn_exp2f(s1[r] - mref); ps += s0[r] + s1[r]; }
  l = l * alpha + ps; m = mn;
  if (__builtin_amdgcn_ballot_w64(alpha != 1.f) != 0ull) {
#pragma unroll
    for (int dt = 0; dt < 2; ++dt)
#pragma unroll
      for (int r = 0; r < 16; ++r) o[dt][r] *= alpha;
  }
  const bf16x8 p0 = pack8<0>(s0), p1 = pack8<8>(s0), p2 = pack8<0>(s1), p3 = pack8<8>(s1);
#pragma unroll
  for (int dt = 0; dt < 2; ++dt) {
    o[dt] = MFMA32(va[dt][0], p0, o[dt]);
    o[dt] = MFMA32(va[dt][1], p1, o[dt]);
    o[dt] = MFMA32(va[dt][2], p2, o[dt]);
    o[dt] = MFMA32(va[dt][3], p3, o[dt]);
  }
}
DI void qk64(const bf16_t* Kb, const bf16x8 (&qf)[4], f32x16& s0, f32x16& s1, int l31, int h2) {
  bf16x8 ka[2][4];
  const bf16_t* kp = Kb + l31 * AD_KSTR + h2 * 8;
#pragma unroll
  for (int ks = 0; ks < 4; ++ks) { ka[0][ks] = *(const bf16x8*)(kp + ks * 16); ka[1][ks] = *(const bf16x8*)(kp + 32 * AD_KSTR + ks * 16); }
  s0 = zero16(); s1 = zero16();
#pragma unroll
  for (int ks = 0; ks < 4; ++ks) { s0 = MFMA32(ka[0][ks], qf[ks], s0); s1 = MFMA32(ka[1][ks], qf[ks], s1); }
}
template <bool HAS_SEL>
DI void sm_pv64(f32x16& s0, f32x16& s1, const bf16_t* Vb, f32x16 (&o)[2], float& m, float& l, int l31, int h2, bool sel) {
  bf16x8 va[2][4];
#pragma unroll
  for (int dt = 0; dt < 2; ++dt) {
    const bf16_t* vp = Vb + (size_t)(dt * 32 + l31) * AD_VSTR + 4 * h2;
#pragma unroll
    for (int q = 0; q < 4; ++q) va[dt][q] = ld_frag8x2(vp + 16 * q);
  }
  float mx; { const float ma = max16(s0), mb = max16(s1); mx = max3f(ma, mb, mb); }
  if (HAS_SEL) mx = sel ? mx : -INFINITY;
  mx = xhalf_max(mx);
  const float mn = fmaxf(m, mx);
  const float alpha = __builtin_amdgcn_exp2f(m - mn);
  const float mref = (HAS_SEL && !sel) ? INFINITY : mn;
  float ps = 0.f;
#pragma unroll
  for (int r = 0; r < 16; ++r) { s0[r] = __builtin_amdgcn_exp2f(s0[r] - mref); s1[r] = __builtin_amdgcn_exp2f(s1[r] - mref); ps += s0[r] + s1[r]; }
  l = l * alpha + ps; m = mn;
  if (__builtin_amdgcn_ballot_w64(alpha != 1.f) != 0ull) {
#pragma unroll
    for (int dt = 0; dt < 2; ++dt)
#pragma unroll
      for (int r = 0; r < 16; ++r) o[dt][r] *= alpha;
  }
  const bf16x8 p0 = pack8<0>(s0), p1 = pack8<8>(s0), p2 = pack8<0>(s1), p3 = pack8<8>(s1);
#pragma unroll
  for (int dt = 0; dt < 2; ++dt) {
    o[dt] = MFMA32(va[dt][0], p0, o[dt]);
    o[dt] = MFMA32(va[dt][1], p1, o[dt]);
    o[dt] = MFMA32(va[dt][2], p2, o[dt]);
    o[dt] = MFMA32(va[dt][3], p3, o[dt]);
  }
}
template <bool HAS_SEL>
DI void sm_pv64_qk(f32x16& s0, f32x16& s1, const bf16_t* Vb, f32x16 (&o)[2], float& m, float& l, int l31, int h2, bool sel,
                   const bf16_t* Knext, const bf16x8 (&qf)[4], f32x16& n0, f32x16& n1) {
  float mx; { const float ma = max16(s0), mb = max16(s1); mx = max3f(ma, mb, mb); }
  if (HAS_SEL) mx = sel ? mx : -INFINITY;
  mx = xhalf_max(mx);
  const float mn = fmaxf(m, mx);
  const float alpha = __builtin_amdgcn_exp2f(m - mn);
  const float mref = (HAS_SEL && !sel) ? INFINITY : mn;
  if (__builtin_amdgcn_ballot_w64(alpha != 1.f) != 0ull) {
#pragma unroll
    for (int dt = 0; dt < 2; ++dt)
#pragma unroll
      for (int r = 0; r < 16; ++r) o[dt][r] *= alpha;
  }
  bf16x8 ka[2][4];
  {
    const bf16_t* kp = Knext + l31 * AD_KSTR + h2 * 8;
#pragma unroll
    for (int ks = 0; ks < 4; ++ks) { ka[0][ks] = *(const bf16x8*)(kp + ks * 16); ka[1][ks] = *(const bf16x8*)(kp + 32 * AD_KSTR + ks * 16); }
  }
  bf16x8 va[2][4];
#pragma unroll
  for (int dt = 0; dt < 2; ++dt) {
    const bf16_t* vp = Vb + (size_t)(dt * 32 + l31) * AD_VSTR + 4 * h2;
#pragma unroll
    for (int q = 0; q < 4; ++q) va[dt][q] = ld_frag8x2(vp + 16 * q);
  }
  n0 = zero16(); n1 = zero16();
  float ps = 0.f;
#define SBAR __builtin_amdgcn_sched_barrier(0)
#define EX4(S, R0) _Pragma("unroll") for (int r = (R0); r < (R0) + 4; ++r) { S[r] = __builtin_amdgcn_exp2f(S[r] - mref); ps += S[r]; }
  SBAR; n0 = MFMA32(ka[0][0], qf[0], n0); SBAR; EX4(s0, 0);
  SBAR; n1 = MFMA32(ka[1][0], qf[0], n1); SBAR; EX4(s0, 4);
  const bf16x8 p0 = pack8<0>(s0);
  SBAR; n0 = MFMA32(ka[0][1], qf[1], n0); SBAR; EX4(s0, 8);
  SBAR; o[0] = MFMA32(va[0][0], p0, o[0]); SBAR; EX4(s0, 12);
  const bf16x8 p1 = pack8<8>(s0);
  SBAR; n1 = MFMA32(ka[1][1], qf[1], n1); o[1] = MFMA32(va[1][0], p0, o[1]); SBAR; EX4(s1, 0);
  SBAR; n0 = MFMA32(ka[0][2], qf[2], n0); o[0] = MFMA32(va[0][1], p1, o[0]); SBAR; EX4(s1, 4);
  const bf16x8 p2 = pack8<0>(s1);
  SBAR; n1 = MFMA32(ka[1][2], qf[2], n1); o[1] = MFMA32(va[1][1], p1, o[1]); SBAR; EX4(s1, 8);
  SBAR; n0 = MFMA32(ka[0][3], qf[3], n0); o[0] = MFMA32(va[0][2], p2, o[0]); SBAR; EX4(s1, 12);
  const bf16x8 p3 = pack8<8>(s1);
  SBAR; n1 = MFMA32(ka[1][3], qf[3], n1); o[1] = MFMA32(va[1][2], p2, o[1]); SBAR;
  o[0] = MFMA32(va[0][3], p3, o[0]); o[1] = MFMA32(va[1][3], p3, o[1]);
#undef SBAR
#undef EX4
  l = l * alpha + ps; m = mn;
}
DI void ph_attnD(const Params& p, int layer, int* ctr, char* smem, int* s_pair) {
  float* imps = (float*)smem;
  float* impf = (float*)(smem + 34816);
  unsigned* smask = (unsigned*)(smem + 43008);
  unsigned* s_union = (unsigned*)(smem + 43008 + 256);
  char* kvbuf = smem + 49152;
  int nxt_item = 0;
  if (threadIdx.x == 0) nxt_item = atomicAdd(ctr, 1);
  for (;;) {
    int tidf = threadIdx.x; asm volatile("" : "+v"(tidf));
    const int lane = tidf & 63, wid = tidf >> 6, h = wid & 3, qs = wid >> 2, l31 = lane & 31, h2 = lane >> 5;
    float* ofl = (float*)(smem + (wid < 6 ? wid * 8192 : 49152 + 3 * AD_BUF + (wid - 6) * 8192));
    __syncthreads();
    if (tidf == 0) { *s_pair = nxt_item; *s_union = 0u; nxt_item = atomicAdd(ctr, 1); }
    __syncthreads();
    const int it = *s_pair;
    if (it >= 1024) break;
    const int b = it & 31, q0 = (31 - (it >> 5)) * 64;
    const int qw = q0 + 32 * qs;
    const int t = qw + l31, cur = q0 >> 6;
    const size_t tok = (size_t)b * T + t;
    bf16x8 qf[4];
    {
      const bf16_t* qp = p.QD() + ((size_t)(b * 4 + h) * T + t) * 64 + h2 * 8;
#pragma unroll
      for (int ks = 0; ks < 4; ++ks) qf[ks] = *(const bf16x8*)(qp + ks * 16);
    }
    const float g0 = p.DG()[tok * 12 + h * 3 + 0], g1 = p.DG()[tok * 12 + h * 3 + 1], g2 = p.DG()[tok * 12 + h * 3 + 2];
    f32x16 ofin[2];
    bf16_t* Kc_l = (bf16_t*)kvbuf;
    bf16_t* Vc_l = (bf16_t*)(kvbuf + 128 * 72 * 2);
    {
      const bf16_t* Kc = p.KCMP() + (size_t)b * 128 * 64;
      const bf16_t* Vc = p.VCMPT() + (size_t)b * 64 * 128;
      u32x4 ck[2], cv[2];
#pragma unroll
      for (int i = 0; i < 2; ++i) { const int q = tidf + 512 * i; ck[i] = *(const u32x4*)(Kc + q * 8); cv[i] = *(const u32x4*)(Vc + q * 8); }
#pragma unroll
      for (int i = 0; i < 2; ++i) {
        const int q = tidf + 512 * i;
        *(u32x4*)(Kc_l + (q >> 3) * 72 + (q & 7) * 8) = ck[i];
        bf16_t* vq = Vc_l + (q >> 4) * 136 + (q & 15) * 8;
        *(u32x2*)vq = (u32x2){cv[i][0], cv[i][1]}; *(u32x2*)(vq + 4) = (u32x2){cv[i][2], cv[i][3]};
      }
    }
    __syncthreads();
    PREP(18) { {
      const int nkt = min(4, (qw >> 9) + 1);
      f32x16 o[2]; o[0] = zero16(); o[1] = zero16();
      float m = -1e30f, l = 0.f;
      for (int kt = 0; kt < nkt; ++kt) {
        f32x16 s = qk_tile_s(Kc_l + kt * 32 * 72, 72, qf, l31, h2);
#pragma unroll
        for (int r = 0; r < 16; ++r) { const int n = kt * 32 + crow(r, h2); if (16 * n + 31 > t) s[r] = -INFINITY; }
        softmax_pv(s, Vc_l + kt * 32, 136, o, m, l, l31, h2);
      }
      l = xhalf_sum(l);
      const float il = l > 0.f ? 1.f / l : 0.f;
      const float gi = g0 * il;
#pragma unroll
      for (int dt = 0; dt < 2; ++dt)
#pragma unroll
        for (int r = 0; r < 16; ++r) ofin[dt][r] = gi * o[dt][r];
      float carry = 0.f;
#pragma unroll
      for (int kt = 0; kt < 4; ++kt) {
        f32x16 s;
        if (kt < nkt) {
          s = qk_tile_s(Kc_l + kt * 32 * 72, 72, qf, l31, h2);
#pragma unroll
          for (int r = 0; r < 16; ++r) { const int n = kt * 32 + crow(r, h2); s[r] = (16 * n + 31 > t) ? 0.f : __builtin_amdgcn_exp2f(s[r] - m) * il; }
        } else s = zero16();
        float X[4];
#pragma unroll
        for (int g = 0; g < 4; ++g) X[g] = shx(s[4 * g + 3], 32);
#pragma unroll
        for (int g = 0; g < 4; ++g) {
          const float G = (s[4 * g] + s[4 * g + 1]) + (s[4 * g + 2] + s[4 * g + 3]);
          const float prev_other = g > 0 ? X[g - 1] : carry;
          imps[(wid * 32 + l31) * 33 + 8 * kt + 2 * g + h2] = G + (h2 ? X[g] : prev_other);
        }
        carry = X[3];
      }
    }
    __syncthreads();
    {
      const int tt = tidf >> 3, jg = tidf & 7, wq = (tt >> 5) * 4, tl = tt & 31;
#pragma unroll
      for (int i = 0; i < 4; ++i) {
        const int j = jg * 4 + i;
        impf[tt * 32 + j] = (imps[((wq + 0) * 32 + tl) * 33 + j] + imps[((wq + 1) * 32 + tl) * 33 + j]) + (imps[((wq + 2) * 32 + tl) * 33 + j] + imps[((wq + 3) * 32 + tl) * 33 + j]);
      }
    }
    __syncthreads();
    {
      const int tt = tidf >> 3, jg = tidf & 7;
      float v[32];
#pragma unroll
      for (int j = 0; j < 32; ++j) {
        float x = impf[tt * 32 + j];
        if (j > cur) x = -1e30f; else if (j == 0 || j == cur || j == cur - 1) x = 1e6f;
        v[j] = x;
      }
      unsigned bits = 0u;
#pragma unroll
      for (int i = 0; i < 4; ++i) {
        int rank = 0; float vj = 0.f;
#pragma unroll
        for (int j = 0; j < 32; ++j) if (j == jg * 4 + i) vj = v[j];
        const int jj = jg * 4 + i;
#pragma unroll
        for (int j = 0; j < 32; ++j) rank += (v[j] > vj || (v[j] == vj && j < jj)) ? 1 : 0;
        if (rank < 8 && jj <= cur) bits |= 1u << jj;
      }
      bits |= shx(bits, 1); bits |= shx(bits, 2); bits |= shx(bits, 4);
      if (jg == 0) { smask[tt] = bits; atomicOr(s_union, bits); }
    }
    __syncthreads();
    }
    {
      const unsigned mymask = smask[32 * qs + l31];
      unsigned rem = *s_union;
      const bf16_t* Ks = p.KV() + (size_t)(2 * NB + b) * T * 64;
      const bf16_t* Vs = p.KV() + (size_t)(3 * NB + b) * 64 * T;
      f32x16 o[2]; o[0] = zero16(); o[1] = zero16();
      float m = -1e30f, l = 0.f;
      int j = __builtin_ctz(rem); rem &= rem - 1;
      int jn = -1, j2 = -1, j3 = -1;
      if (rem != 0u) { jn = __builtin_ctz(rem); rem &= rem - 1; }
      {
        const AdTile r0 = ad_load(Ks, Vs, j * 64, tidf);
        AdTile r1; r1.k = r1.v = (u32x4){0u, 0u, 0u, 0u};
        if (jn >= 0) r1 = ad_load(Ks, Vs, jn * 64, tidf);
        ad_store(r0, kvbuf, tidf);
        if (jn >= 0) ad_store(r1, kvbuf + AD_BUF, tidf);
      }
      AdTile ra, rb;
      ra.k = ra.v = rb.k = rb.v = (u32x4){0u, 0u, 0u, 0u};
      if (rem != 0u) { j2 = __builtin_ctz(rem); rem &= rem - 1; ra = ad_load(Ks, Vs, j2 * 64, tidf); }
      if (rem != 0u) { j3 = __builtin_ctz(rem); rem &= rem - 1; rb = ad_load(Ks, Vs, j3 * 64, tidf); }
      __syncthreads();
#pragma unroll
      for (int dt = 0; dt < 2; ++dt)
#pragma unroll
        for (int g4 = 0; g4 < 4; ++g4) *(f32x4*)(ofl + ((dt * 4 + g4) * 64 + lane) * 4) = (f32x4){ofin[dt][4 * g4], ofin[dt][4 * g4 + 1], ofin[dt][4 * g4 + 2], ofin[dt][4 * g4 + 3]};
      int pb0 = 0, pb1 = 1, pb2 = 2;
      f32x16 c0, c1;
      qk64((const bf16_t*)kvbuf, qf, c0, c1, l31, h2);
      auto step = [&](AdTile& tset) __attribute__((always_inline)) -> bool {
        f32x16 n0, n1;
        const bool sel = (mymask >> j) & 1u;
        if (j == cur) {
#pragma unroll
          for (int r = 0; r < 16; ++r) { const int key = j * 64 + crow(r, h2); if (key > t) c0[r] = -INFINITY; if (key + 32 > t) c1[r] = -INFINITY; }
        }
        sm_pv64_qk<true>(c0, c1, (const bf16_t*)(kvbuf + pb0 * AD_BUF + 64 * AD_KSTR * 2), o, m, l, l31, h2, sel, (const bf16_t*)(kvbuf + pb1 * AD_BUF), qf, n0, n1);
        int j4 = -1;
        if (j2 >= 0) {
          ad_store(tset, kvbuf + pb2 * AD_BUF, tidf);
          if (rem != 0u) { j4 = __builtin_ctz(rem); rem &= rem - 1; tset = ad_load(Ks, Vs, j4 * 64, tidf); }
        }
        __syncthreads();
        if (jn < 0) return false;
        c0 = n0; c1 = n1;
        j = jn; jn = j2; j2 = j3; j3 = j4;
        const int tp = pb0; pb0 = pb1; pb1 = pb2; pb2 = tp;
        return true;
      };
      for (;;) { if (!step(ra)) break; if (!step(rb)) break; }
      l = xhalf_sum(l);
      const float il = l > 0.f ? g1 / l : 0.f;
#pragma unroll
      for (int dt = 0; dt < 2; ++dt)
#pragma unroll
        for (int g4 = 0; g4 < 4; ++g4) {
          f32x4* q = (f32x4*)(ofl + ((dt * 4 + g4) * 64 + lane) * 4);
          const f32x4 add = {o[dt][4 * g4], o[dt][4 * g4 + 1], o[dt][4 * g4 + 2], o[dt][4 * g4 + 3]};
          *q = *q + il * add;
        }
    }

    {
      const bf16_t* Kw = p.KV() + (size_t)(4 * NB + b) * T * 64;
      const bf16_t* Vw = p.KV() + (size_t)(5 * NB + b) * 64 * T;
      f32x16 o[2]; o[0] = zero16(); o[1] = zero16();
      float m = -1e30f, l = 0.f;
      int k0 = max(0, q0 - 512);
      {
        const AdTile r0 = ad_load(Kw, Vw, k0, tidf);
        AdTile r1; r1.k = r1.v = (u32x4){0u, 0u, 0u, 0u};
        if (k0 + 64 <= q0) r1 = ad_load(Kw, Vw, k0 + 64, tidf);
        ad_store(r0, kvbuf, tidf);
        if (k0 + 64 <= q0) ad_store(r1, kvbuf + AD_BUF, tidf);
      }
      AdTile ra, rb;
      ra.k = ra.v = rb.k = rb.v = (u32x4){0u, 0u, 0u, 0u};
      if (k0 + 128 <= q0) ra = ad_load(Kw, Vw, k0 + 128, tidf);
      if (k0 + 192 <= q0) rb = ad_load(Kw, Vw, k0 + 192, tidf);
      __syncthreads();
      int pb0 = 0, pb1 = 1, pb2 = 2;
      f32x16 c0, c1;
      qk64((const bf16_t*)kvbuf, qf, c0, c1, l31, h2);
      auto step = [&](AdTile& tset) __attribute__((always_inline)) -> bool {
        const bool more = k0 + 64 <= q0;
        f32x16 n0, n1;
        if (!(k0 + 63 <= qw && k0 + 512 > qw + 31)) {
#pragma unroll
          for (int r = 0; r < 16; ++r) {
            const int key = k0 + crow(r, h2);
            if (key > t || t - key >= 512) c0[r] = -INFINITY;
            if (key + 32 > t || t - key - 32 >= 512) c1[r] = -INFINITY;
          }
        }
        sm_pv64_qk<false>(c0, c1, (const bf16_t*)(kvbuf + pb0 * AD_BUF + 64 * AD_KSTR * 2), o, m, l, l31, h2, true, (const bf16_t*)(kvbuf + pb1 * AD_BUF), qf, n0, n1);
        if (k0 + 128 <= q0) {
          ad_store(tset, kvbuf + pb2 * AD_BUF, tidf);
          if (k0 + 256 <= q0) tset = ad_load(Kw, Vw, k0 + 256, tidf);
        }
        __syncthreads();
        if (!more) return false;
        c0 = n0; c1 = n1;
        k0 += 64;
        const int tp = pb0; pb0 = pb1; pb1 = pb2; pb2 = tp;
        return true;
      };
      for (;;) { if (!step(ra)) break; if (!step(rb)) break; }
      l = xhalf_sum(l);
      const float il = l > 0.f ? g2 / l : 0.f;
#pragma unroll
      for (int dt = 0; dt < 2; ++dt)
#pragma unroll
        for (int g4 = 0; g4 < 4; ++g4) {
          const f32x4 q = *(const f32x4*)(ofl + ((dt * 4 + g4) * 64 + lane) * 4);
#pragma unroll
          for (int e = 0; e < 4; ++e) ofin[dt][4 * g4 + e] = q[e] + il * o[dt][4 * g4 + e];
        }
    }
    {
      char* gw = (char*)ofl;
      u32x4 gA[4];
#pragma unroll
      for (int i = 0; i < 4; ++i) gA[i] = *(const u32x4*)(p.GZ() + (size_t)4 * NTOK * 256 + ((size_t)b * T + qw + 8 * i + (lane >> 3)) * 256 + h * 64 + (lane & 7) * 8);
      asm volatile("" ::: "memory");
#pragma unroll
      for (int i = 0; i < 4; ++i) { const int row = 8 * i + (lane >> 3); *(u32x4*)(gw + row * 128 + (((lane & 7) ^ (row & 7)) * 16)) = gA[i]; }
      asm volatile("" ::: "memory");
#pragma unroll
      for (int dt = 0; dt < 2; ++dt)
#pragma unroll
        for (int g = 0; g < 4; ++g) {
          char* cell = gw + l31 * 128 + (((4 * dt + g) ^ (l31 & 7)) * 16) + 8 * h2;
          const u32x2 gz = *(const u32x2*)cell;
          const float z0 = __uint_as_float(gz.x << 16), z1 = __uint_as_float(gz.x & 0xffff0000u), z2 = __uint_as_float(gz.y << 16), z3 = __uint_as_float(gz.y & 0xffff0000u);
          const u32x2 o2 = {pack2(ofin[dt][4 * g] * z0, ofin[dt][4 * g + 1] * z1), pack2(ofin[dt][4 * g + 2] * z2, ofin[dt][4 * g + 3] * z3)};
          *(u32x2*)cell = o2;
        }
      asm volatile("" ::: "memory");
#pragma unroll
      for (int i = 0; i < 4; ++i) {
        const int row = 8 * i + (lane >> 3);
        const u32x4 v = *(const u32x4*)(gw + row * 128 + (((lane & 7) ^ (row & 7)) * 16));
        *(u32x4*)(p.YMIX() + ((size_t)b * T + qw + row) * 1024 + 768 + h * 64 + (lane & 7) * 8) = v;
      }
      asm volatile("" ::: "memory");
    }
  }
}


struct AaTile { u32x4 k0, v0, k1, v1; };
DI AaTile aa_load(const bf16_t* Kg, const bf16_t* Vg, int key0, int tidf) {
  AaTile r; const int row = tidf >> 3, ch = tidf & 7;
  r.k0 = *(const u32x4*)(Kg + (size_t)(key0 + row) * 64 + ch * 8);
  r.v0 = *(const u32x4*)(Vg + (size_t)row * T + key0 + ch * 8);
  r.k1 = *(const u32x4*)(Kg + (size_t)T * 64 + (size_t)(key0 + row) * 64 + ch * 8);
  r.v1 = *(const u32x4*)(Vg + (size_t)T * 64 + (size_t)row * T + key0 + ch * 8);
  return r;
}
DI void aa_store(const AaTile& r, char* buf, int tidf) {
  AdTile a; a.k = r.k0; a.v = r.v0; ad_store(a, buf, tidf);
  a.k = r.k1; a.v = r.v1; ad_store(a, buf + AD_BUF, tidf);
}
DI void ph_attnA_fb(const Params& p, int layer, int item, char* smem) {
  int tidf = threadIdx.x; asm volatile("" : "+v"(tidf));
  const int lane = tidf & 63, wid = tidf >> 6, h = wid & 3, qs = wid >> 2, l31 = lane & 31, h2 = lane >> 5, g = h >> 1;
  const int b = item >> 5, q0 = (item & 31) * 64;
  const int qw = q0 + 32 * qs, t = qw + l31;
  const size_t tok = (size_t)b * T + t;
  bf16x8 qf[4];
  {
    const bf16_t* qp = p.QA() + ((size_t)(b * 4 + h) * T + t) * 64 + h2 * 8;
#pragma unroll
    for (int ks = 0; ks < 4; ++ks) qf[ks] = *(const bf16x8*)(qp + ks * 16);
  }
  char* gw = smem + 81920 + wid * 4096;
  u32x4 gA[4];
#pragma unroll
  for (int i = 0; i < 4; ++i) gA[i] = *(const u32x4*)(p.GZ() + ((size_t)b * T + qw + 8 * i + (lane >> 3)) * 256 + h * 64 + (lane & 7) * 8);
  const bf16_t* Kg = p.KA() + (size_t)(b * 2) * T * 64;
  const bf16_t* Vg = p.VAT() + (size_t)(b * 2) * 64 * T;
  f32x16 o[2]; o[0] = zero16(); o[1] = zero16();
  float m = -1e30f, l = 0.f;
  int k0 = max(0, q0 - 128);
  __syncthreads();
  { const AaTile r = aa_load(Kg, Vg, k0, tidf); aa_store(r, smem, tidf); }
  __syncthreads();
  int pb = 0;
  for (;;) {
    const bool more = k0 + 64 <= q0;
    AaTile nx;
    if (more) nx = aa_load(Kg, Vg, k0 + 64, tidf);
    const char* buf = smem + pb * (2 * AD_BUF) + g * AD_BUF;
#pragma unroll
    for (int kh = 0; kh < 2; ++kh) {
      const int key0 = k0 + kh * 32;
      if (key0 <= qw + 31 && key0 + 31 + 128 > qw) {
        f32x16 s = qk_tile_s((const bf16_t*)buf + kh * 32 * AD_KSTR, AD_KSTR, qf, l31, h2);
        if (key0 + 31 > qw || key0 + 128 <= qw + 31) {
#pragma unroll
          for (int r = 0; r < 16; ++r) { const int key = key0 + crow(r, h2); if (key > t || t - key >= 128) s[r] = -INFINITY; }
        }
        softmax_pv(s, (const bf16_t*)(buf + 64 * AD_KSTR * 2) + kh * 32, AD_VSTR, o, m, l, l31, h2);
      }
    }
    if (more) aa_store(nx, smem + (pb ^ 1) * (2 * AD_BUF), tidf);
    __syncthreads();
    if (!more) break;
    k0 += 64; pb ^= 1;
  }
  l = xhalf_sum(l);
  const float sink = p.a_sinks[layer * 4 + h] * 1.4426950408889634f;
  const float M = fmaxf(m, sink);
  const float sc = __builtin_amdgcn_exp2f(m - M);
  const float inv = sc / (l * sc + __builtin_amdgcn_exp2f(sink - M));
#pragma unroll
  for (int i = 0; i < 4; ++i) { const int row = 8 * i + (lane >> 3); *(u32x4*)(gw + row * 128 + (((lane & 7) ^ (row & 7)) * 16)) = gA[i]; }
  asm volatile("" ::: "memory");
#pragma unroll
  for (int dt = 0; dt < 2; ++dt)
#pragma unroll
    for (int gq = 0; gq < 4; ++gq) {
      char* cell = gw + l31 * 128 + (((4 * dt + gq) ^ (l31 & 7)) * 16) + 8 * h2;
      const u32x2 gz = *(const u32x2*)cell;
      const float z0 = __uint_as_float(gz.x << 16), z1 = __uint_as_float(gz.x & 0xffff0000u), z2 = __uint_as_float(gz.y << 16), z3 = __uint_as_float(gz.y & 0xffff0000u);
      const u32x2 o2 = {pack2(o[dt][4 * gq] * inv * z0, o[dt][4 * gq + 1] * inv * z1), pack2(o[dt][4 * gq + 2] * inv * z2, o[dt][4 * gq + 3] * inv * z3)};
      *(u32x2*)cell = o2;
    }
  asm volatile("" ::: "memory");
#pragma unroll
  for (int i = 0; i < 4; ++i) {
    const int row = 8 * i + (lane >> 3);
    const u32x4 v = *(const u32x4*)(gw + row * 128 + (((lane & 7) ^ (row & 7)) * 16));
    *(u32x4*)(p.YMIX() + ((size_t)b * T + qw + row) * 1024 + h * 64 + (lane & 7) * 8) = v;
  }
  asm volatile("" ::: "memory");
}

DI float logsigmoidf_(float x) { return fminf(x, 0.f) - __logf(1.f + __expf(-fabsf(x))); }
DI void mlstm_gates(const Params& p, size_t tok0, int hh, float* bc, float* ig, int tid) {
  if (tid < 64) {
    const int s0 = 2 * tid;
    const float lf0 = logsigmoidf_(p.IFG()[(tok0 + s0) * 8 + 4 + hh]), lf1 = logsigmoidf_(p.IFG()[(tok0 + s0 + 1) * 8 + 4 + hh]);
    const float pair = lf0 + lf1;
    float x = pair;
#pragma unroll
    for (int off = 1; off < 64; off <<= 1) { const float y = shup(x, off); if (tid >= off) x += y; }
    const float excl = x - pair;
    bc[s0] = excl + lf0; bc[s0 + 1] = excl + pair;
    ig[s0] = p.IFG()[(tok0 + s0) * 8 + hh]; ig[s0 + 1] = p.IFG()[(tok0 + s0 + 1) * 8 + hh];
  }
}
DI void conv8(const bf16_t* raw, int t, int dg, const float (&cw)[4][8], const float (&cb)[8], float (&out)[8]) {
#pragma unroll
  for (int e = 0; e < 8; ++e) out[e] = cb[e];
#pragma unroll
  for (int j = 0; j < 4; ++j) {
    const int ts = t - 3 + j;
    if (ts >= 0) {
      const u32x4 row = *(const u32x4*)(raw + (size_t)ts * 64 + dg * 8);
#pragma unroll
      for (int e2 = 0; e2 < 4; ++e2) { out[2 * e2] += cw[j][2 * e2] * __uint_as_float(row[e2] << 16); out[2 * e2 + 1] += cw[j][2 * e2 + 1] * __uint_as_float(row[e2] & 0xffff0000u); }
    }
  }
#pragma unroll
  for (int e = 0; e < 8; ++e) out[e] = siluf_(out[e]);
}
DI void conv_rows_load(const bf16_t* raw, int tfirst, int dg, u32x4 (&r)[7]) {
#pragma unroll
  for (int j = 0; j < 7; ++j) {
    const int ts = tfirst + j;
    const u32x4 v = *(const u32x4*)(raw + (size_t)max(ts, 0) * 64 + dg * 8);
    r[j] = ts >= 0 ? v : (u32x4){0u, 0u, 0u, 0u};
  }
}
template <int I>
DI void conv_rows_compute(const u32x4 (&r)[7], const float (&cw)[4][8], const float (&cb)[8], float (&out)[8]) {
#pragma unroll
  for (int e = 0; e < 8; ++e) out[e] = cb[e];
#pragma unroll
  for (int j = 0; j < 4; ++j) {
    const u32x4 row = r[I + j];
#pragma unroll
    for (int e2 = 0; e2 < 4; ++e2) { out[2 * e2] += cw[j][2 * e2] * __uint_as_float(row[e2] << 16); out[2 * e2 + 1] += cw[j][2 * e2 + 1] * __uint_as_float(row[e2] & 0xffff0000u); }
  }
#pragma unroll
  for (int e = 0; e < 8; ++e) out[e] = siluf_(out[e]);
}
DI void load_conv_w(const Params& p, int layer, int ch0, int dg, float (&cw)[4][8], float (&cb)[8]) {
#pragma unroll
  for (int j = 0; j < 4; ++j)
#pragma unroll
    for (int e = 0; e < 8; ++e) cw[j][e] = p.conv_w[layer * 2048 + j * 512 + ch0 + dg * 8 + e];
#pragma unroll
  for (int e = 0; e < 8; ++e) cb[e] = p.conv_b[layer * 512 + ch0 + dg * 8 + e];
}
DI void delta_state_loadA(const bf16_t* VT, bf16x8 (&a)[8], int wid, int l31, int h2) {
  const int mt = wid >> 1;
#pragma unroll
  for (int ks = 0; ks < 8; ++ks) a[ks] = *(const bf16x8*)(VT + (size_t)(mt * 32 + l31) * T + ks * 16 + h2 * 8);
}
DI void delta_state(const bf16x8 (&a)[8], const bf16_t* KT, float* out, int wid, int l31, int h2) {
  const int mt = wid >> 1, nt = wid & 1;
  f32x16 acc = zero16();
#pragma unroll
  for (int ks = 0; ks < 8; ++ks) {
    const bf16x8 bb = *(const bf16x8*)(KT + (nt * 32 + l31) * 136 + ks * 16 + h2 * 8);
    acc = MFMA32(a[ks], bb, acc);
  }
#pragma unroll
  for (int r = 0; r < 16; ++r) out[(mt * 32 + crow(r, h2)) * 64 + nt * 32 + l31] = acc[r];
}
DI void ph_mlstm_local(const Params& p, int layer, int item, char* smem) {
  float* bc = (float*)smem; float* ig = bc + 128; float* wv = ig + 128;
  bf16_t* KwT = (bf16_t*)(smem + 2048);
  float* nred = (float*)(smem + 2048 + 64 * 136 * 2);
  const int tid = tid_opaque(), lane = tid & 63, wid = tid >> 6, l31 = lane & 31, h2 = lane >> 5;
  const int b = item >> 6, hh = (item >> 4) & 3, c = item & 15, t0 = c * 128;
  const size_t tok0 = (size_t)b * T + t0;
  const int dg = tid & 7, sb = tid >> 3;
  u32x4 rows[7];
  conv_rows_load(p.QKB() + ((size_t)(b * 8 + 4 + hh) * T) * 64, t0 + 4 * sb - 3, dg, rows);
  bf16x8 af[8];
  delta_state_loadA(p.VBT() + (size_t)(b * 4 + hh) * 64 * T + t0, af, wid, l31, h2);
  float cw[4][8], cb[8];
  load_conv_w(p, layer, 256 + hh * 64, dg, cw, cb);
  __syncthreads();
  mlstm_gates(p, tok0, hh, bc, ig, tid);
  __syncthreads();
  if (tid < 128) wv[tid] = __expf(bc[127] - bc[tid] + ig[tid]);
  __syncthreads();
  {
    float v0[8], v1[8], v2[8], v3[8];
    conv_rows_compute<0>(rows, cw, cb, v0); conv_rows_compute<1>(rows, cw, cb, v1);
    conv_rows_compute<2>(rows, cw, cb, v2); conv_rows_compute<3>(rows, cw, cb, v3);
    const f32x4 w4 = *(const f32x4*)(wv + 4 * sb);
#pragma unroll
    for (int e = 0; e < 8; ++e) {
      u32x2 pk = {pack2(v0[e] * w4[0], v1[e] * w4[1]), pack2(v2[e] * w4[2], v3[e] * w4[3])};
      *(u32x2*)(KwT + (dg * 8 + e) * 136 + 4 * sb) = pk;
    }
  }
  __syncthreads();
  delta_state(af, KwT, p.BST() + (size_t)item * 4096, wid, l31, h2);
  {
    const int k = tid & 63, qd = tid >> 6;
    float a = 0.f;
#pragma unroll 8
    for (int s = 0; s < 32; ++s) a += bf2f(KwT[k * 136 + qd * 32 + s]);
    nred[qd * 64 + k] = a;
  }
  __syncthreads();
  if (tid < 64) p.BN()[(size_t)item * 64 + tid] = (nred[tid] + nred[64 + tid]) + (nred[128 + tid] + nred[192 + tid]);
  if (tid == 0) p.BG()[item] = bc[127];
}
DI void ph_mlstm_scan(const Params& p, int bh) {
  const int tid = tid_opaque();
  f32x4 C[4];
#pragma unroll
  for (int i = 0; i < 4; ++i) C[i] = (f32x4){0.f, 0.f, 0.f, 0.f};
  float n = 0.f;
  for (int c = 0; c < 16; ++c) {
    const int item = bh * 16 + c;
    const float g = __expf(p.BG()[item]);
    const f32x4* ptr = (const f32x4*)(p.BST() + (size_t)item * 4096 + tid * 16);
    {
      char* fb = p.BSTF() + (size_t)item * 8192 + (((tid >> 7) * 4 + (tid & 3)) * 64 + ((tid >> 2) & 31)) * 16;
      const u32x4 lo = {pack2(C[0][0], C[0][1]), pack2(C[0][2], C[0][3]), pack2(C[1][0], C[1][1]), pack2(C[1][2], C[1][3])};
      const u32x4 hi = {pack2(C[2][0], C[2][1]), pack2(C[2][2], C[2][3]), pack2(C[3][0], C[3][1]), pack2(C[3][2], C[3][3])};
      *(u32x4*)fb = lo; *(u32x4*)(fb + 512) = hi;
    }
#pragma unroll
    for (int i = 0; i < 4; ++i) { const f32x4 tmp = ptr[i]; C[i] = g * C[i] + tmp; }
    if (tid < 64) { const float tmp = p.BN()[(size_t)item * 64 + tid]; p.BN()[(size_t)item * 64 + tid] = n; n = g * n + tmp; }
  }
}
DI void pv_only(const f32x16& s, const bf16_t* VTp, int vstride, f32x16 (&o)[2], int l31, int h2) {
  const bf16x8 p0 = pack8<0>(s), p1 = pack8<8>(s);
#pragma unroll
  for (int dt = 0; dt < 2; ++dt) {
    const bf16_t* vp = VTp + (size_t)(dt * 32 + l31) * vstride + 4 * h2;
    o[dt] = MFMA32(ld_frag8x2(vp), p0, o[dt]);
    o[dt] = MFMA32(ld_frag8x2(vp + 16), p1, o[dt]);
  }
}
DI bf16x8 frag_from_f32(const float* ptr) {
  const f32x4 a = *(const f32x4*)ptr, b = *(const f32x4*)(ptr + 4);
  u32x4 t = {pack2(a[0], a[1]), pack2(a[2], a[3]), pack2(b[0], b[1]), pack2(b[2], b[3])};
  return __builtin_bit_cast(bf16x8, t);
}

struct MlRegs { u32x4 rows[7]; u32x4 vr[4]; float f0, f1, i0, i1; };
DI void mlstm_local_prefetch(const Params& p, int item, MlRegs& r, int tid) {
  const int lane = tid & 63, wid = tid >> 6, l31 = lane & 31, h2 = lane >> 5;
  const int b = item >> 6, hh = (item >> 4) & 3, c = item & 15, t0 = c * 128;
  const int dg = tid & 7, sb = tid >> 3;
  conv_rows_load(p.QKB() + ((size_t)(b * 8 + 4 + hh) * T) * 64, t0 + 4 * sb - 3, dg, r.rows);
  {
    const bf16_t* VT = p.VBT() + (size_t)(b * 4 + hh) * 64 * T + t0;
#pragma unroll
    for (int j = 0; j < 4; ++j) r.vr[j] = *(const u32x4*)(VT + (size_t)((tid >> 4) + 16 * j) * T + (tid & 15) * 8);
  }
  r.f0 = r.f1 = r.i0 = r.i1 = 0.f;
  if (tid < 64) {
    const size_t tok = (size_t)b * T + t0 + 2 * tid;
    r.f0 = p.IFG()[tok * 8 + 4 + hh]; r.f1 = p.IFG()[(tok + 1) * 8 + 4 + hh];
    r.i0 = p.IFG()[tok * 8 + hh]; r.i1 = p.IFG()[(tok + 1) * 8 + hh];
  }
}
DI void mlstm_local_compute(const Params& p, int layer, int item, const MlRegs& r, char* smem, int tid) {
  float* bc = (float*)smem; float* ig = bc + 128; float* wv = ig + 128;
  bf16_t* KwT = (bf16_t*)(smem + 2048);
  float* nred = (float*)(smem + 2048 + 64 * 136 * 2);
  bf16_t* vtl = (bf16_t*)(smem + 20480);
  const int lane = tid & 63, wid = tid >> 6, l31 = lane & 31, h2 = lane >> 5;
  const int hh = (item >> 4) & 3;
  const int dg = tid & 7, sb = tid >> 3;
  float cw[4][8], cb[8];
  load_conv_w(p, layer, 256 + hh * 64, dg, cw, cb);
  __syncthreads();
  if (tid < 64) {
    const int s0 = 2 * tid;
    const float lf0 = logsigmoidf_(r.f0), lf1 = logsigmoidf_(r.f1);
    const float pair = lf0 + lf1;
    float x = pair;
#pragma unroll
    for (int off = 1; off < 64; off <<= 1) { const float y = shup(x, off); if (tid >= off) x += y; }
    const float excl = x - pair;
    const float b0 = excl + lf0, b1 = excl + pair;
    const float bL = __builtin_bit_cast(float, __builtin_amdgcn_readlane(__builtin_bit_cast(int, x), 63));
    bc[s0] = b0; bc[s0 + 1] = b1;
    wv[s0] = __expf(bL - b0 + r.i0); wv[s0 + 1] = __expf(bL - b1 + r.i1);
  }
  __syncthreads();
  {
    float v0[8], v1[8], v2[8], v3[8];
    conv_rows_compute<0>(r.rows, cw, cb, v0); conv_rows_compute<1>(r.rows, cw, cb, v1);
    conv_rows_compute<2>(r.rows, cw, cb, v2); conv_rows_compute<3>(r.rows, cw, cb, v3);
    const f32x4 w4 = *(const f32x4*)(wv + 4 * sb);
#pragma unroll
    for (int e = 0; e < 8; ++e) {
      u32x2 pk = {pack2(v0[e] * w4[0], v1[e] * w4[1]), pack2(v2[e] * w4[2], v3[e] * w4[3])};
      *(u32x2*)(KwT + (dg * 8 + e) * 136 + 4 * sb) = pk;
    }
#pragma unroll
    for (int j = 0; j < 4; ++j) *(u32x4*)(vtl + ((tid >> 4) + 16 * j) * 136 + (tid & 15) * 8) = r.vr[j];
  }
  __syncthreads();
  bf16x8 af[8];
  {
    const int mt = wid >> 1;
#pragma unroll
    for (int ks = 0; ks < 8; ++ks) af[ks] = *(const bf16x8*)(vtl + (mt * 32 + l31) * 136 + ks * 16 + h2 * 8);
  }
  delta_state(af, KwT, p.BST() + (size_t)item * 4096, wid, l31, h2);
  {
    const int k = tid & 63, qd = tid >> 6;
    float a = 0.f;
#pragma unroll 8
    for (int s = 0; s < 32; ++s) a += bf2f(KwT[k * 136 + qd * 32 + s]);
    nred[qd * 64 + k] = a;
  }
  __syncthreads();
  if (tid < 64) p.BN()[(size_t)item * 64 + tid] = (nred[tid] + nred[64 + tid]) + (nred[128 + tid] + nred[192 + tid]);
  if (tid == 0) p.BG()[item] = bc[127];
}
DI void ph_mlstm_local_loop(const Params& p, int layer, int vbid, int nvblk, char* smem) {
  const int tid = tid_opaque();
  if (vbid >= 2048) return;
  MlRegs cur;
  mlstm_local_prefetch(p, vbid, cur, tid);
  for (int item = vbid; item < 2048; item += nvblk) {
    MlRegs nxt;
    const bool has = item + nvblk < 2048;
    if (has) mlstm_local_prefetch(p, item + nvblk, nxt, tid);
    mlstm_local_compute(p, layer, item, cur, smem, tid);
    if (has) cur = nxt;
  }
}
struct HlRegs { bf16x8 af[8]; float g[32]; };
DI void hgrn_local_prefetch(const Params& p, int item, HlRegs& r, int tid) {
  const int lane = tid & 63, wid = tid >> 6, l31 = lane & 31, h2 = lane >> 5;
  const int b = item >> 6, hh = (item >> 4) & 3, c = item & 15, t0 = c * 128;
  const int k = tid & 63, qd = tid >> 6;
  delta_state_loadA(p.VCT() + (size_t)(b * 4 + hh) * 64 * T + t0, r.af, wid, l31, h2);
  const float* gp = p.GC() + ((size_t)(b * 4 + hh) * T + t0 + 32 * qd) * 64 + k;
#pragma unroll
  for (int s = 0; s < 32; ++s) r.g[s] = gp[s * 64];
}
DI void hgrn_local_compute(const Params& p, int item, const HlRegs& r, char* smem, int tid) {
  float* tot = (float*)smem;
  bf16_t* KdT = (bf16_t*)(smem + 1024);
  const int lane = tid & 63, wid = tid >> 6, l31 = lane & 31, h2 = lane >> 5;
  const int k = tid & 63, qd = tid >> 6;
  float al[32], kk[32];
  float run = 0.f;
#pragma unroll
  for (int s = 0; s < 32; ++s) { const float g = r.g[s]; run += g; al[s] = run; kk[s] = 1.f - __expf(g); }
  __syncthreads();
  tot[qd * 64 + k] = run;
  __syncthreads();
  float off = 0.f, aL = 0.f;
#pragma unroll
  for (int q = 0; q < 4; ++q) { const float v = tot[q * 64 + k]; aL += v; if (q < qd) off += v; }
#pragma unroll
  for (int s8 = 0; s8 < 4; ++s8) {
    float v[8];
#pragma unroll
    for (int e = 0; e < 8; ++e) v[e] = kk[s8 * 8 + e] * __expf(aL - (al[s8 * 8 + e] + off));
    u32x4 w = {pack2(v[0], v[1]), pack2(v[2], v[3]), pack2(v[4], v[5]), pack2(v[6], v[7])};
    *(u32x4*)(KdT + k * 136 + qd * 32 + s8 * 8) = w;
  }
  __syncthreads();
  delta_state(r.af, KdT, p.CST() + (size_t)item * 4096, wid, l31, h2);
  if (qd == 0) p.CAL()[(size_t)item * 64 + k] = aL;
}
DI void ph_hgrn_local_loop(const Params& p, int vbid, int nvblk, char* smem) {
  const int tid = tid_opaque();
  if (vbid >= 2048) return;
  HlRegs cur;
  hgrn_local_prefetch(p, vbid, cur, tid);
  for (int item = vbid; item < 2048; item += nvblk) {
    HlRegs nxt;
    const bool has = item + nvblk < 2048;
    if (has) hgrn_local_prefetch(p, item + nvblk, nxt, tid);
    hgrn_local_compute(p, item, cur, smem, tid);
    if (has) cur = nxt;
  }
}

constexpr int VT_LSTR = 132;
DI void vt_chunk_load(const bf16_t* VT, int tid, u32x4 (&r)[4]) {
  const int d = tid >> 2, part = tid & 3;
#pragma unroll
  for (int j = 0; j < 4; ++j) r[j] = *(const u32x4*)(VT + (size_t)d * T + part * 32 + j * 8);
}
DI void vt_chunk_store(const u32x4 (&r)[4], bf16_t* lds, int tid) {
  const int d = tid >> 2, part = tid & 3;
#pragma unroll
  for (int j = 0; j < 4; ++j) {
    bf16_t* q = lds + d * VT_LSTR + part * 32 + j * 8;
    *(u32x2*)q = (u32x2){r[j][0], r[j][1]}; *(u32x2*)(q + 4) = (u32x2){r[j][2], r[j][3]};
  }
}
DI void ph_mlstm_out(const Params& p, int layer, int item, char* smem) {
  float* bc = (float*)smem; float* ig = bc + 128;
  bf16_t* qc = (bf16_t*)(smem + 2048);
  bf16_t* kc = qc + 128 * 72;
  bf16_t* vt = kc + 128 * 72;
  const int tid = tid_opaque(), lane = tid & 63, wid = tid >> 6, l31 = lane & 31, h2 = lane >> 5;
  const int b = item >> 6, hh = (item >> 4) & 3, c = item & 15, t0 = c * 128;
  const size_t tok0 = (size_t)b * T + t0;
  const int dg = tid & 7, sb = tid >> 3;
  u32x4 rq[7], rk[7];
  conv_rows_load(p.QKB() + ((size_t)(b * 8 + hh) * T) * 64, t0 + 4 * sb - 3, dg, rq);
  conv_rows_load(p.QKB() + ((size_t)(b * 8 + 4 + hh) * T) * 64, t0 + 4 * sb - 3, dg, rk);
  u32x4 rv[4];
  vt_chunk_load(p.VBT() + (size_t)(b * 4 + hh) * 64 * T + t0, tid, rv);
  float gf0 = 0.f, gf1 = 0.f, gi0 = 0.f, gi1 = 0.f;
  if (tid < 64) {
    const int s0 = 2 * tid;
    gf0 = p.IFG()[(tok0 + s0) * 8 + 4 + hh]; gf1 = p.IFG()[(tok0 + s0 + 1) * 8 + 4 + hh];
    gi0 = p.IFG()[(tok0 + s0) * 8 + hh]; gi1 = p.IFG()[(tok0 + s0 + 1) * 8 + hh];
  }
  __syncthreads();
  if (tid < 64) {
    const int s0 = 2 * tid;
    const float lf0 = logsigmoidf_(gf0), lf1 = logsigmoidf_(gf1);
    const float pair = lf0 + lf1;
    float x = pair;
#pragma unroll
    for (int off = 1; off < 64; off <<= 1) { const float y = shup(x, off); if (tid >= off) x += y; }
    const float excl = x - pair;
    const float b0 = excl + lf0, b1 = excl + pair;
    bc[s0] = b0; bc[s0 + 1] = b1;
    ig[s0] = gi0 - b0; ig[s0 + 1] = gi1 - b1;
  }
  {
    float cw[4][8], cb[8];
    load_conv_w(p, layer, hh * 64, dg, cw, cb);
    float v[8];
#define CONV_ST(I, R, DST, SC) do { conv_rows_compute<I>(R, cw, cb, v); \
      u32x4 w_ = {pack2(v[0] * (SC), v[1] * (SC)), pack2(v[2] * (SC), v[3] * (SC)), pack2(v[4] * (SC), v[5] * (SC)), pack2(v[6] * (SC), v[7] * (SC))}; \
      *(u32x4*)((DST) + (4 * sb + (I)) * 72 + dg * 8) = w_; } while (0)
    CONV_ST(0, rq, qc, 0.125f); CONV_ST(1, rq, qc, 0.125f); CONV_ST(2, rq, qc, 0.125f); CONV_ST(3, rq, qc, 0.125f);
    load_conv_w(p, layer, 256 + hh * 64, dg, cw, cb);
    CONV_ST(0, rk, kc, 1.f); CONV_ST(1, rk, kc, 1.f); CONV_ST(2, rk, kc, 1.f); CONV_ST(3, rk, kc, 1.f);
#undef CONV_ST
  }
  vt_chunk_store(rv, vt, tid);
  const int tq = 32 * wid + l31;
  const char* Cs = p.BSTF() + (size_t)item * 8192 + lane * 16;
  const float* ns = p.BN() + (size_t)item * 64;
  u32x4 cst[2][4]; f32x4 nst[4][2];
#pragma unroll
  for (int ks = 0; ks < 4; ++ks) {
#pragma unroll
    for (int dt = 0; dt < 2; ++dt) cst[dt][ks] = *(const u32x4*)(Cs + (dt * 4 + ks) * 1024);
    nst[ks][0] = *(const f32x4*)(ns + ks * 16 + h2 * 8); nst[ks][1] = *(const f32x4*)(ns + ks * 16 + h2 * 8 + 4);
  }
  char* gw = smem + 57344 + wid * 4096;
  u32x4 gA[4], gB[4];
#pragma unroll
  for (int i = 0; i < 4; ++i) {
    const size_t trow = tok0 + 32 * wid + 8 * i + (lane >> 3);
    gA[i] = *(const u32x4*)(p.GZ() + (size_t)1 * NTOK * 256 + trow * 256 + hh * 64 + (lane & 7) * 8);
    gB[i] = *(const u32x4*)(p.GZ() + (size_t)2 * NTOK * 256 + trow * 256 + hh * 64 + (lane & 7) * 8);
  }
  __syncthreads();
  bf16x8 qf[4];
#pragma unroll
  for (int ks = 0; ks < 4; ++ks) qf[ks] = *(const bf16x8*)(qc + tq * 72 + ks * 16 + h2 * 8);
  const float bt = bc[tq];
  f32x16 o[2]; o[0] = zero16(); o[1] = zero16();
  float dsum = 0.f;
  for (int kt = 0; kt <= wid; ++kt) {
    f32x16 s = qk_tile_s(kc + kt * 32 * 72, 72, qf, l31, h2);
#pragma unroll
    for (int r = 0; r < 16; ++r) {
      const int sidx = 32 * kt + crow(r, h2);
      float val = s[r] * __expf(bt + ig[sidx]);
      if (sidx > tq) val = 0.f;
      s[r] = val; dsum += val;
    }
    pv_only(s, vt + kt * 32, VT_LSTR, o, l31, h2);
  }
  dsum += shx(dsum, 32);
  f32x16 oi[2]; oi[0] = zero16(); oi[1] = zero16();
  float qn = 0.f;
#pragma unroll
  for (int ks = 0; ks < 4; ++ks) {
#pragma unroll
    for (int dt = 0; dt < 2; ++dt) {
      oi[dt] = MFMA32(__builtin_bit_cast(bf16x8, cst[dt][ks]), qf[ks], oi[dt]);
    }
    const u32x4 qu = __builtin_bit_cast(u32x4, qf[ks]);
    const f32x4 n0 = nst[ks][0], n1 = nst[ks][1];
    qn += __uint_as_float(qu[0] << 16) * n0[0] + __uint_as_float(qu[0] & 0xffff0000u) * n0[1] + __uint_as_float(qu[1] << 16) * n0[2] + __uint_as_float(qu[1] & 0xffff0000u) * n0[3];
    qn += __uint_as_float(qu[2] << 16) * n1[0] + __uint_as_float(qu[2] & 0xffff0000u) * n1[1] + __uint_as_float(qu[3] << 16) * n1[2] + __uint_as_float(qu[3] & 0xffff0000u) * n1[3];
  }
  qn += shx(qn, 32);
  const float ebt = __expf(bt);
  const float den = dsum + ebt * qn;
  const float inv = 1.f / fmaxf(fabsf(den), 1.f);
  u32x2 gz1[2][4], gz2[2][4];
#pragma unroll
  for (int i = 0; i < 4; ++i) { const int row = 8 * i + (lane >> 3); *(u32x4*)(gw + row * 128 + (((lane & 7) ^ (row & 7)) * 16)) = gA[i]; }
  asm volatile("" ::: "memory");
#pragma unroll
  for (int dt = 0; dt < 2; ++dt)
#pragma unroll
    for (int g = 0; g < 4; ++g) gz1[dt][g] = *(const u32x2*)(gw + l31 * 128 + (((4 * dt + g) ^ (l31 & 7)) * 16) + 8 * h2);
  asm volatile("" ::: "memory");
#pragma unroll
  for (int i = 0; i < 4; ++i) { const int row = 8 * i + (lane >> 3); *(u32x4*)(gw + row * 128 + (((lane & 7) ^ (row & 7)) * 16)) = gB[i]; }
  asm volatile("" ::: "memory");
#pragma unroll
  for (int dt = 0; dt < 2; ++dt)
#pragma unroll
    for (int g = 0; g < 4; ++g) gz2[dt][g] = *(const u32x2*)(gw + l31 * 128 + (((4 * dt + g) ^ (l31 & 7)) * 16) + 8 * h2);
  asm volatile("" ::: "memory");
#pragma unroll
  for (int dt = 0; dt < 2; ++dt)
#pragma unroll
    for (int g = 0; g < 4; ++g) {
      const u32x2 g1 = gz1[dt][g], g2 = gz2[dt][g];
      float z[4] = {__uint_as_float(g1.x << 16) * __uint_as_float(g2.x << 16), __uint_as_float(g1.x & 0xffff0000u) * __uint_as_float(g2.x & 0xffff0000u),
                    __uint_as_float(g1.y << 16) * __uint_as_float(g2.y << 16), __uint_as_float(g1.y & 0xffff0000u) * __uint_as_float(g2.y & 0xffff0000u)};
      float hv[4];
#pragma unroll
      for (int i = 0; i < 4; ++i) hv[i] = (o[dt][4 * g + i] + ebt * oi[dt][4 * g + i]) * inv * z[i];
      const u32x2 o2 = {pack2(hv[0], hv[1]), pack2(hv[2], hv[3])};
      *(u32x2*)(gw + l31 * 128 + (((4 * dt + g) ^ (l31 & 7)) * 16) + 8 * h2) = o2;
    }
  asm volatile("" ::: "memory");
#pragma unroll
  for (int i = 0; i < 4; ++i) {
    const int row = 8 * i + (lane >> 3);
    const u32x4 v = *(const u32x4*)(gw + row * 128 + (((lane & 7) ^ (row & 7)) * 16));
    *(u32x4*)(p.YMIX() + (tok0 + 32 * wid + row) * 1024 + 256 + hh * 64 + (lane & 7) * 8) = v;
  }
}


DI void ph_hgrn_local(const Params& p, int layer, int item, char* smem) {
  float* tot = (float*)smem;
  bf16_t* KdT = (bf16_t*)(smem + 1024);
  const int tid = tid_opaque(), lane = tid & 63, wid = tid >> 6, l31 = lane & 31, h2 = lane >> 5;
  const int b = item >> 6, hh = (item >> 4) & 3, c = item & 15, t0 = c * 128;
  const int k = tid & 63, qd = tid >> 6;
  float al[32], kk[32];
  bf16x8 af[8];
  delta_state_loadA(p.VCT() + (size_t)(b * 4 + hh) * 64 * T + t0, af, wid, l31, h2);
  {
    const float* gp = p.GC() + ((size_t)(b * 4 + hh) * T + t0 + 32 * qd) * 64 + k;
    float run = 0.f;
#pragma unroll
    for (int s = 0; s < 32; ++s) { const float g = gp[s * 64]; run += g; al[s] = run; kk[s] = 1.f - __expf(g); }
    __syncthreads();
    tot[qd * 64 + k] = run;
  }
  __syncthreads();
  float off = 0.f, aL = 0.f;
#pragma unroll
  for (int q = 0; q < 4; ++q) { const float v = tot[q * 64 + k]; aL += v; if (q < qd) off += v; }
#pragma unroll
  for (int s8 = 0; s8 < 4; ++s8) {
    float v[8];
#pragma unroll
    for (int e = 0; e < 8; ++e) v[e] = kk[s8 * 8 + e] * __expf(aL - (al[s8 * 8 + e] + off));
    u32x4 w = {pack2(v[0], v[1]), pack2(v[2], v[3]), pack2(v[4], v[5]), pack2(v[6], v[7])};
    *(u32x4*)(KdT + k * 136 + qd * 32 + s8 * 8) = w;
  }
  __syncthreads();
  delta_state(af, KdT, p.CST() + (size_t)item * 4096, wid, l31, h2);
  if (qd == 0) p.CAL()[(size_t)item * 64 + k] = aL;
}
DI void ph_hgrn_scan(const Params& p, int bh) {
  const int tid = tid_opaque();
  f32x4 S[4];
#pragma unroll
  for (int i = 0; i < 4; ++i) S[i] = (f32x4){0.f, 0.f, 0.f, 0.f};
  for (int c = 0; c < 16; ++c) {
    const int item = bh * 16 + c;
    const f32x4* dp = (const f32x4*)(p.CAL() + (size_t)item * 64 + (tid & 3) * 16);
    const f32x4* ptr = (const f32x4*)(p.CST() + (size_t)item * 4096 + tid * 16);
    {
      char* fb = p.CSTF() + (size_t)item * 8192 + (((tid >> 7) * 4 + (tid & 3)) * 64 + ((tid >> 2) & 31)) * 16;
      const u32x4 lo = {pack2(S[0][0], S[0][1]), pack2(S[0][2], S[0][3]), pack2(S[1][0], S[1][1]), pack2(S[1][2], S[1][3])};
      const u32x4 hi = {pack2(S[2][0], S[2][1]), pack2(S[2][2], S[2][3]), pack2(S[3][0], S[3][1]), pack2(S[3][2], S[3][3])};
      *(u32x4*)fb = lo; *(u32x4*)(fb + 512) = hi;
    }
#pragma unroll
    for (int i = 0; i < 4; ++i) {
      const f32x4 a = dp[i];
      const f32x4 dec = {__expf(a[0]), __expf(a[1]), __expf(a[2]), __expf(a[3])};
      const f32x4 tmp = ptr[i]; S[i] = dec * S[i] + tmp;
    }
  }
}
DI void ph_hgrn_out(const Params& p, int layer, int item, char* smem) {
  float* a_lds = (float*)smem;
  float* tot = (float*)(smem + 128 * 68 * 4);
  bf16_t* kk_lds = (bf16_t*)(smem + 128 * 68 * 4 + 1024);
  bf16_t* vt = kk_lds + 128 * 72;
  const int tid = tid_opaque(), lane = tid & 63, wid = tid >> 6, l31 = lane & 31, h2 = lane >> 5;
  const int b = item >> 6, hh = (item >> 4) & 3, c = item & 15, t0 = c * 128;
  const size_t hbase = (size_t)(b * 4 + hh) * T + t0;
  const int tq = 32 * wid + l31;
  const size_t tok = (size_t)b * T + t0 + tq;
  u32x4 qu[4];
#pragma unroll
  for (int ks = 0; ks < 4; ++ks) qu[ks] = *(const u32x4*)(p.QC() + (hbase + tq) * 64 + ks * 16 + h2 * 8);
  u32x4 rv[4];
  vt_chunk_load(p.VCT() + (size_t)(b * 4 + hh) * 64 * T + t0, tid, rv);
  char* gw = smem + 71168 + wid * 2048;
  u32x4 gA[4];
#pragma unroll
  for (int i = 0; i < 4; ++i)
    gA[i] = *(const u32x4*)(p.GZ() + (size_t)3 * NTOK * 256 + ((size_t)b * T + t0 + 32 * wid + 8 * i + (lane >> 3)) * 256 + hh * 64 + (lane & 7) * 8);
  {
    const int k = tid & 63, qd = tid >> 6;
    float al[32];
    const float* gp = p.GC() + (hbase + 32 * qd) * 64 + k;
    float run = 0.f;
    __syncthreads();
#pragma unroll
    for (int s = 0; s < 32; ++s) { const float g = gp[s * 64]; run += g; al[s] = run; kk_lds[(32 * qd + s) * 72 + k] = f2bf(1.f - __expf(g)); }
    tot[qd * 64 + k] = run;
    vt_chunk_store(rv, vt, tid);
    __syncthreads();
    float off = 0.f;
#pragma unroll
    for (int q = 0; q < 4; ++q) { const float v = tot[q * 64 + k]; if (q < qd) off += v; }
#pragma unroll
    for (int s = 0; s < 32; ++s) a_lds[(32 * qd + s) * 68 + k] = al[s] + off;
  }
  const char* Ss = p.CSTF() + (size_t)item * 8192 + lane * 16;
  u32x4 cst[2][4];
#pragma unroll
  for (int ks = 0; ks < 4; ++ks)
#pragma unroll
    for (int dt = 0; dt < 2; ++dt) cst[dt][ks] = *(const u32x4*)(Ss + (dt * 4 + ks) * 1024);
  __syncthreads();
  bf16x8 qi[4], qh[4];
#pragma unroll
  for (int ks = 0; ks < 4; ++ks) {
    const int k0 = ks * 16 + h2 * 8;
    float q8[8], e1[8], e2[8];
#pragma unroll
    for (int e2i = 0; e2i < 4; ++e2i) { q8[2 * e2i] = __uint_as_float(qu[ks][e2i] << 16); q8[2 * e2i + 1] = __uint_as_float(qu[ks][e2i] & 0xffff0000u); }
#pragma unroll
    for (int e = 0; e < 8; ++e) {
      const float a = a_lds[tq * 68 + k0 + e];
      const float r = wid > 0 ? a_lds[(32 * wid - 1) * 68 + k0 + e] : 0.f;
      e1[e] = q8[e] * __expf(a - r); e2[e] = q8[e] * __expf(a);
    }
    u32x4 w1 = {pack2(e1[0], e1[1]), pack2(e1[2], e1[3]), pack2(e1[4], e1[5]), pack2(e1[6], e1[7])};
    u32x4 w2 = {pack2(e2[0], e2[1]), pack2(e2[2], e2[3]), pack2(e2[4], e2[5]), pack2(e2[6], e2[7])};
    qi[ks] = __builtin_bit_cast(bf16x8, w1); qh[ks] = __builtin_bit_cast(bf16x8, w2);
  }
  f32x16 o[2]; o[0] = zero16(); o[1] = zero16();
  for (int kt = 0; kt <= wid; ++kt) {
    f32x16 s = zero16();
    const int srow = 32 * kt + l31;
#pragma unroll
    for (int ks = 0; ks < 4; ++ks) {
      const int k0 = ks * 16 + h2 * 8;
      const u32x4 ku = *(const u32x4*)(kk_lds + srow * 72 + k0);
      float v[8];
#pragma unroll
      for (int e = 0; e < 8; ++e) {
        const float a = a_lds[srow * 68 + k0 + e];
        const float r = wid > 0 ? a_lds[(32 * wid - 1) * 68 + k0 + e] : 0.f;
        const float kkv = (e & 1) ? __uint_as_float(ku[e >> 1] & 0xffff0000u) : __uint_as_float(ku[e >> 1] << 16);
        v[e] = kkv * __expf(fminf(r - a, 80.f));
      }
      u32x4 w = {pack2(v[0], v[1]), pack2(v[2], v[3]), pack2(v[4], v[5]), pack2(v[6], v[7])};
      s = MFMA32(__builtin_bit_cast(bf16x8, w), qi[ks], s);
    }
    if (kt == wid) {
#pragma unroll
      for (int r = 0; r < 16; ++r) if (32 * kt + crow(r, h2) > tq) s[r] = 0.f;
    }
    pv_only(s, vt + kt * 32, VT_LSTR, o, l31, h2);
  }
#pragma unroll
  for (int ks = 0; ks < 4; ++ks)
#pragma unroll
    for (int dt = 0; dt < 2; ++dt) {
      o[dt] = MFMA32(__builtin_bit_cast(bf16x8, cst[dt][ks]), qh[ks], o[dt]);
    }
  float ss = 0.f;
#pragma unroll
  for (int dt = 0; dt < 2; ++dt)
#pragma unroll
    for (int r = 0; r < 16; ++r) ss += o[dt][r] * o[dt][r];
  ss += shx(ss, 32);
  const float rs = rsqrtf(ss * (1.f / 64.f) + 1e-6f);
#pragma unroll
  for (int u = 0; u < 2; ++u) {
#pragma unroll
    for (int i = 0; i < 2; ++i) { const int row = 8 * i + (lane >> 3); *(u32x4*)(gw + row * 128 + (((lane & 7) ^ (row & 7)) * 16)) = gA[2 * u + i]; }
    asm volatile("" ::: "memory");
    if ((l31 >> 4) == u) {
      const int rr = l31 & 15;
#pragma unroll
      for (int dt = 0; dt < 2; ++dt)
#pragma unroll
        for (int g = 0; g < 4; ++g) {
          const int d0 = dt * 32 + 8 * g + 4 * h2;
          char* cell = gw + rr * 128 + (((4 * dt + g) ^ (rr & 7)) * 16) + 8 * h2;
          const u32x2 gz = *(const u32x2*)cell;
          const f32x4 gn = *(const f32x4*)(p.c_norm_g + layer * 256 + hh * 64 + d0);
          const float z0 = __uint_as_float(gz.x << 16), z1 = __uint_as_float(gz.x & 0xffff0000u), z2 = __uint_as_float(gz.y << 16), z3 = __uint_as_float(gz.y & 0xffff0000u);
          const u32x2 o2 = {pack2(o[dt][4 * g] * rs * gn[0] * z0, o[dt][4 * g + 1] * rs * gn[1] * z1), pack2(o[dt][4 * g + 2] * rs * gn[2] * z2, o[dt][4 * g + 3] * rs * gn[3] * z3)};
          *(u32x2*)cell = o2;
        }
    }
    asm volatile("" ::: "memory");
#pragma unroll
    for (int i = 0; i < 2; ++i) {
      const int row = 8 * i + (lane >> 3);
      const u32x4 v = *(const u32x4*)(gw + row * 128 + (((lane & 7) ^ (row & 7)) * 16));
      *(u32x4*)(p.YMIX() + ((size_t)b * T + t0 + 32 * wid + 16 * u + row) * 1024 + 512 + hh * 64 + (lane & 7) * 8) = v;
    }
    asm volatile("" ::: "memory");
  }
}


DI void ph_attnA(const Params& p, int layer, int item, char* smem) {
  const int tid = tid_opaque(), lane = tid & 63, h = tid >> 6, l31 = lane & 31, h2 = lane >> 5;
  const int b = item >> 6, q0 = (item & 63) * 32, g = h >> 1;
  const int t = q0 + l31;
  const size_t tok = (size_t)b * T + t;
  bf16x8 qf[4];
  {
    const bf16_t* qp = p.QA() + ((size_t)(b * 4 + h) * T + t) * 64 + h2 * 8;
#pragma unroll
    for (int ks = 0; ks < 4; ++ks) qf[ks] = *(const bf16x8*)(qp + ks * 16);
  }
  const bf16_t* Kp = p.KA() + (size_t)(b * 2 + g) * T * 64;
  const bf16_t* Vp = p.VAT() + (size_t)(b * 2 + g) * 64 * T;
  f32x16 o[2]; o[0] = zero16(); o[1] = zero16();
  float m = -1e30f, l = 0.f;
  for (int key0 = max(0, q0 - 128); key0 <= q0; key0 += 32) {
    f32x16 s = qk_tile(Kp + (size_t)key0 * 64, qf, l31, h2);
    if (key0 == q0 - 128 || key0 == q0) {
#pragma unroll
      for (int r = 0; r < 16; ++r) { const int key = key0 + crow(r, h2); if (key > t || t - key >= 128) s[r] = -INFINITY; }
    }
    softmax_pv(s, Vp + key0, T, o, m, l, l31, h2);
  }
  l = xhalf_sum(l);
  const float sink = p.a_sinks[layer * 4 + h] * 1.4426950408889634f;
  const float M = fmaxf(m, sink);
  const float sc = __builtin_amdgcn_exp2f(m - M);
  const float inv = sc / (l * sc + __builtin_amdgcn_exp2f(sink - M));
#pragma unroll
  for (int dt = 0; dt < 2; ++dt)
#pragma unroll
    for (int gq = 0; gq < 4; ++gq) {
      const int d0 = dt * 32 + 8 * gq + 4 * h2;
      const u32x2 gz = *(const u32x2*)(p.GZ() + tok * 256 + h * 64 + d0);
      const float z0 = __uint_as_float(gz.x << 16), z1 = __uint_as_float(gz.x & 0xffff0000u), z2 = __uint_as_float(gz.y << 16), z3 = __uint_as_float(gz.y & 0xffff0000u);
      u32x2 o2 = {pack2(o[dt][4 * gq] * inv * z0, o[dt][4 * gq + 1] * inv * z1), pack2(o[dt][4 * gq + 2] * inv * z2, o[dt][4 * gq + 3] * inv * z3)};
      *(u32x2*)(p.YMIX() + tok * 1024 + h * 64 + d0) = o2;
    }
}

DI void ph_cmp(const Params& p, int layer, int item, char* smem) {
  float* red = (float*)smem;
  bf16_t* hid = (bf16_t*)(smem + 65536);
  int tid = threadIdx.x; asm volatile("" : "+v"(tid));
  const int lane = tid & 63, wid = tid >> 6, l31 = lane & 31, h2 = lane >> 5;
  const int b = item >> 3, kvsel = (item >> 2) & 1, mt = item & 3;
  const int lk = layer * 2 + kvsel;
  const int n = min(mt * 32 + l31, 126);
  const bf16_t* src = p.KV() + ((size_t)(kvsel * NB + b) * T + 16 * n) * 64 + wid * 256 + h2 * 8;
  const bf16_t* w1f = p.W1T() + (((size_t)lk * 128 + wid * 16) * 2 * 64 + lane) * 8;
  f32x16 acc[2]; acc[0] = zero16(); acc[1] = zero16();
#pragma unroll 4
  for (int ks = 0; ks < 16; ++ks) {
    const bf16x8 a = *(const bf16x8*)(src + ks * 16);
    const bf16x8 b0 = *(const bf16x8*)(w1f + (size_t)(ks * 2) * 512);
    const bf16x8 b1 = *(const bf16x8*)(w1f + (size_t)(ks * 2 + 1) * 512);
    acc[0] = MFMA32(a, b0, acc[0]); acc[1] = MFMA32(a, b1, acc[1]);
  }
  __syncthreads();
#pragma unroll
  for (int nt = 0; nt < 2; ++nt)
#pragma unroll
    for (int r = 0; r < 16; ++r) red[(wid * 32 + crow(r, h2)) * 64 + nt * 32 + l31] = acc[nt][r];
  __syncthreads();
  {
    const int row = tid >> 4, c0 = (tid & 15) * 4;
    float v[4];
#pragma unroll
    for (int e = 0; e < 4; ++e) {
      float x = p.CVEC()[lk * 64 + c0 + e];
#pragma unroll
      for (int w8 = 0; w8 < 8; ++w8) x += red[(w8 * 32 + row) * 64 + c0 + e];
      v[e] = siluf_(x);
    }
    u32x2 w = {pack2(v[0], v[1]), pack2(v[2], v[3])};
    *(u32x2*)(hid + row * 72 + c0) = w;
  }
  __syncthreads();
  if (wid == 0) {
    f32x16 o[2]; o[0] = zero16(); o[1] = zero16();
    const bf16_t* w2t = p.W2T() + (size_t)lk * 4096;
#pragma unroll
    for (int ks = 0; ks < 4; ++ks) {
      const bf16x8 a = *(const bf16x8*)(hid + l31 * 72 + ks * 16 + h2 * 8);
#pragma unroll
      for (int nt = 0; nt < 2; ++nt) o[nt] = MFMA32(a, *(const bf16x8*)(w2t + (nt * 32 + l31) * 64 + ks * 16 + h2 * 8), o[nt]);
    }
    if (kvsel == 0) {
#pragma unroll
      for (int r = 0; r < 16; ++r) {
        const int nn = mt * 32 + crow(r, h2);
        if (nn < 127) {
          const int pos = 16 * nn + 31;
          const float cs = p.ROPEC()[pos * 32 + l31], sn = p.ROPES()[pos * 32 + l31];
          p.KCMP()[((size_t)b * 128 + nn) * 64 + l31] = f2bf(o[0][r] * cs - o[1][r] * sn);
          p.KCMP()[((size_t)b * 128 + nn) * 64 + 32 + l31] = f2bf(o[0][r] * sn + o[1][r] * cs);
        }
      }
    } else {
#pragma unroll
      for (int nt = 0; nt < 2; ++nt)
#pragma unroll
        for (int r = 0; r < 16; ++r) {
          const int nn = mt * 32 + crow(r, h2);
          if (nn < 127) p.VCMPT()[((size_t)b * 64 + nt * 32 + l31) * 128 + nn] = f2bf(o[nt][r]);
        }
    }
  }
}


#define XB_TMO      128
#define XB_XCNT(j)  (256  + 64 * (j))
#define XB_XSUB(j)  (1280 + 64 * (j))
#define XB_XGEN(j)  (2304 + 64 * (j))
#define XB_TOP      3328
#define XB_TOPGEN   3392
#define XCD_BAR_WORDS 3456
#define XB_SPIN_CAP (1u << 22)
DI unsigned xb_ld(unsigned* p)              { return __hip_atomic_load(p, __ATOMIC_RELAXED, __HIP_MEMORY_SCOPE_AGENT); }
DI unsigned xb_add(unsigned* p, unsigned v) { return __hip_atomic_fetch_add(p, v, __ATOMIC_RELAXED, __HIP_MEMORY_SCOPE_AGENT); }
DI unsigned xb_xcc_id() { return (unsigned)__builtin_amdgcn_s_getreg((3 << 11) | 20) & 0xFu; }
#define XB_SPIN(cond, bar) do { unsigned _sp = 0; while (cond) { __builtin_amdgcn_s_sleep(1); \
    if ((++_sp & 255u) == 0u) { if (xb_ld(&(bar)[XB_TMO])) break; if (_sp > XB_SPIN_CAP) { atomicAdd(&(bar)[XB_TMO], 1u); break; } } } } while (0)
struct XcdBarrier { unsigned* bar; unsigned x; volatile LAS unsigned* st; };
DI XcdBarrier xcd_barrier_post(unsigned* bar, volatile LAS unsigned* st) {
  XcdBarrier b; b.bar = bar; b.x = xb_xcc_id(); b.st = st;
  if (threadIdx.x == 0) (void)xb_add(&bar[XB_XCNT(b.x)], 1u);
  return b;
}
DI void xcd_barrier_complete(unsigned* bar, unsigned x, unsigned& nloc, unsigned& nx) {
  const unsigned G = gridDim.x * gridDim.y * gridDim.z;
  unsigned sum, cnt, mine, sp = 0u;
  for (;;) {
    sum = 0u; cnt = 0u; mine = 0u;
#pragma unroll
    for (unsigned j = 0; j < 16; ++j) { const unsigned c = xb_ld(&bar[XB_XCNT(j)]); sum += c; cnt += (c > 0u) ? 1u : 0u; mine = (j == x) ? c : mine; }
    if (sum == G) break;
    __builtin_amdgcn_s_sleep(1);
    if ((++sp & 255u) == 0u) { if (xb_ld(&bar[XB_TMO])) break; if (sp > XB_SPIN_CAP) { atomicAdd(&bar[XB_TMO], 1u); break; } }
  }
  nloc = mine > 0u ? mine : 1u; nx = cnt > 0u ? cnt : 1u;
}
DI void xcd_barrier(const XcdBarrier& b) {
  asm volatile("s_waitcnt vmcnt(0)" ::: "memory");
  __syncthreads();
  int t0_ = threadIdx.x; asm volatile("" : "+v"(t0_));
  if (t0_ == 0) {
    unsigned* bar = b.bar;
    __builtin_amdgcn_s_waitcnt(0);
    unsigned nloc = b.st[0], nx = b.st[1];
    if (nloc == 0u) { xcd_barrier_complete(bar, b.x, nloc, nx); b.st[0] = nloc; b.st[1] = nx; }
    const unsigned old = xb_add(&bar[XB_XSUB(b.x)], 1u);
    const unsigned gen = old / nloc;
    if (old + 1u == (gen + 1u) * nloc) {
      __builtin_amdgcn_fence(__ATOMIC_RELEASE, "agent");
      asm volatile("s_waitcnt vmcnt(0)" ::: "memory");
      const unsigned og = xb_add(&bar[XB_TOP], 1u);
      const unsigned tg = og / nx;
      if (og + 1u == (tg + 1u) * nx) xb_add(&bar[XB_TOPGEN], 1u);
      else XB_SPIN(xb_ld(&bar[XB_TOPGEN]) == tg, bar);
      __builtin_amdgcn_fence(__ATOMIC_ACQUIRE, "agent");
      xb_add(&bar[XB_XGEN(b.x)], 1u);
      asm volatile("s_waitcnt vmcnt(0)" ::: "memory");
    } else {
      XB_SPIN(xb_ld(&bar[XB_XGEN(b.x)]) == gen, bar);
      __builtin_amdgcn_fence(__ATOMIC_ACQUIRE, "agent");
      asm volatile("s_waitcnt vmcnt(0)" ::: "memory");
    }
  }
  __syncthreads();
}

constexpr int HALF_LDS = 80000;
__global__ void __launch_bounds__(512) mega(Params p) {
  __shared__ __attribute__((aligned(16))) char smem_all[2 * HALF_LDS + 32];
  cg::grid_group grid = cg::this_grid();
  const int half = half_id();
  const int bid = blockIdx.x, nblk = gridDim.x;
  const int vbid = 2 * bid + half, nvblk = 2 * nblk;
  char* smem = smem_all + half * HALF_LDS;
  unsigned* xbw = (unsigned*)(smem_all + 2 * HALF_LDS);
  int* s_pair = (int*)(smem_all + 2 * HALF_LDS + 16);
  if (threadIdx.x == 0) { xbw[0] = 0u; xbw[1] = 0u; }
  __syncthreads();
  const XcdBarrier xb = xcd_barrier_post(p.XBAR(), (volatile LAS unsigned*)xbw);
  ph_prologue(p, vbid, nvblk, smem);
  ln_rows(p, 0, 0, vbid, nvblk);
  if (PROBE == 5) { ph_prologue(p, vbid, nvblk, smem); ln_rows(p, 0, 0, vbid, nvblk); }
  grid.sync();
  for (int l = 0; l < 2; ++l) {
    ph_gemm_in(p, l, bid, nblk, smem_all);
    if (PROBE == 1) ph_gemm_in(p, l, bid, nblk, smem_all);
    xcd_barrier(xb);
    for (int rep = 0; rep < (PROBE == 3 ? 2 : 1); ++rep) {
    PREP(8) ph_mlstm_local_loop(p, l, vbid, nvblk, smem);
    PREP(9) ph_hgrn_local_loop(p, vbid, nvblk, smem);
    __syncthreads();
    PREP(10) for (int item = bid; item < 256; item += nblk) ph_cmp(p, l, item, smem_all);
    __syncthreads();
    PREP(11) for (int item = bid; item < 1024; item += nblk) ph_attnA_fb(p, l, item, smem_all);
    }
    xcd_barrier(xb);
    if (vbid < 128) ph_mlstm_scan(p, vbid);
    else if (vbid < 256) ph_hgrn_scan(p, vbid - 128);
    __syncthreads();
    ph_attnD(p, l, p.CTR() + l, smem_all, s_pair);
    if (PROBE == 2) ph_attnD(p, l, p.CTR() + 2 + l, smem_all, s_pair);
    xcd_barrier(xb);
    for (int rep = 0; rep < (PROBE == 4 ? 2 : 1); ++rep) {
    PREP(12) for (int item = vbid; item < 2048; item += nvblk) ph_mlstm_out(p, l, item, smem);
    PREP(13) for (int item = vbid; item < 2048; item += nvblk) ph_hgrn_out(p, l, item, smem);
    }
    xcd_barrier(xb);
    if (PROBE == 15 && l == 1) ph_gemm_out_ln_x4(p, l, 2, bid, smem_all);
    ph_gemm_out_ln_x4(p, l, l, bid, smem_all);
    if (l == 0) xcd_barrier(xb);
  }
}

static inline size_t align_up(size_t v) { return (v + 255) & ~(size_t)255; }

extern "C" void kernel_launch(void* const* d_in, const int* in_sizes, int n_in, void* d_out, int out_size, void* d_ws, size_t ws_size, hipStream_t stream) {
  Params p{};
  p.x = (const float*)d_in[0]; p.ln0_g = (const float*)d_in[1]; p.ln0_b = (const float*)d_in[2]; p.w_in = (const float*)d_in[3];
  p.b_in = (const float*)d_in[4]; p.a_sinks = (const float*)d_in[5]; p.conv_w = (const float*)d_in[6]; p.conv_b = (const float*)d_in[7];
  p.c_lb = (const float*)d_in[8]; p.c_norm_g = (const float*)d_in[9]; p.pe = (const float*)d_in[10]; p.w1 = (const float*)d_in[11];
  p.w2 = (const float*)d_in[12]; p.w_out = (const float*)d_in[13]; p.ln_g = (const float*)d_in[14]; p.ln_b = (const float*)d_in[15];
  p.hf = (float*)d_out;
  p.ws = (char*)d_ws;
  if (WS_TOTAL > ws_size) { fprintf(stderr, "workspace too small: need %zu have %zu\n", (size_t)WS_TOTAL, ws_size); return; }

  static int grid_blocks = 0;
  if (!grid_blocks) {
    int dev = 0, cus = 0, per_cu = 0;
    (void)hipGetDevice(&dev);
    (void)hipDeviceGetAttribute(&cus, hipDeviceAttributeMultiprocessorCount, dev);
    (void)hipOccupancyMaxActiveBlocksPerMultiprocessor(&per_cu, mega, 512, 0);
    if (per_cu > 1) per_cu = 1;
    grid_blocks = cus * per_cu;
    if (grid_blocks != 256) fprintf(stderr, "this kernel is laid out for 256 co-resident workgroups (got %d)\n", grid_blocks);
    grid_blocks = 256;
  }
  (void)hipMemsetAsync((char*)d_ws + OFF_CVEC, 0, (OFF_XCNT - OFF_CVEC) + SZ_XCNT, stream);
  void* args[] = {&p};
  hipError_t e = hipLaunchCooperativeKernel((void*)mega, dim3(grid_blocks), dim3(512), args, 0, stream);
  if (e != hipSuccess) fprintf(stderr, "cooperative launch failed: %s (grid %d)\n", hipGetErrorString(e), grid_blocks);
}
```
